# Optimizing an MI355X kernel written in HIP

```python
import jax
import jax.numpy as jnp
from jax import lax
import numpy as np

D_MODEL = 2048
BATCH = 8
SEQ = 4096
DEPTH = 4

CTX_LEN = 256
GRID_W = 64
CONV_CH = 512
CONV_WIDTH = 31
MLA_HEADS = 8
MLA_Q_RANK = 512
MLA_KV_RANK = 256
MLA_NOPE = 128
MLA_ROPE = 64
MLA_V = 128
GQA_HEADS = 8
GQA_KV_HEADS = 2
GQA_HEAD_DIM = 64
WINDOW = 128
BLOCK = 128
N_BRANCH = 3
D_FF = -(-8 * D_MODEL // (3 * 256)) * 256
ROPE_DIM = 64
ROPE_BASE = 10000.0
EPS = 1e-6
NEG_INF = -1e30

COL_MLA_KV = 0
COL_MLA_KR = COL_MLA_KV + MLA_KV_RANK
COL_GQA_K = COL_MLA_KR + MLA_ROPE
COL_GQA_V = COL_GQA_K + GQA_KV_HEADS * GQA_HEAD_DIM
KV_COLS = COL_GQA_V + GQA_KV_HEADS * GQA_HEAD_DIM
COL_MLA_Q = KV_COLS
COL_GQA_Q = COL_MLA_Q + MLA_Q_RANK
COL_CONV = COL_GQA_Q + GQA_HEADS * GQA_HEAD_DIM
COL_GATE = COL_CONV + 2 * CONV_CH
IN_COLS = COL_GATE + N_BRANCH * D_MODEL

kernel_name = 'hybrid_conv_mla_swa_dit_block'


def _rmsnorm(x, g):
    xf = x.astype(jnp.float32)
    y = xf * lax.rsqrt(jnp.mean(xf * xf, axis=-1, keepdims=True) + EPS)
    return (y * g.astype(jnp.float32)).astype(x.dtype)


def _layernorm(x, g, b):
    xf = x.astype(jnp.float32)
    xc = xf - jnp.mean(xf, axis=-1, keepdims=True)
    y = xc * lax.rsqrt(jnp.mean(xc * xc, axis=-1, keepdims=True) + EPS)
    return (y * g.astype(jnp.float32) + b.astype(jnp.float32)).astype(x.dtype)


def _modulate(h, shift, scale):
    return h * (1 + scale) + shift


def _axial_rope_tables(length):
    rows = length // GRID_W
    row = jnp.repeat(jnp.arange(rows), GRID_W).astype(jnp.float32)
    col = jnp.tile(jnp.arange(GRID_W), rows).astype(jnp.float32)
    n_freq = ROPE_DIM // 4
    inv_freq = ROPE_BASE ** (-jnp.arange(n_freq, dtype=jnp.float32) / n_freq)
    a_row = row[:, None] * inv_freq[None, :]
    a_col = col[:, None] * inv_freq[None, :]
    ang = jnp.concatenate([a_row, a_row, a_col, a_col], axis=-1)
    return jnp.cos(ang), jnp.sin(ang)


def _apply_axial_rope(x, rope):
    cos, sin = rope
    xs = x.reshape(x.shape[:-1] + (2, 2, ROPE_DIM // 4))
    rot = jnp.concatenate([-xs[..., 1:, :], xs[..., :1, :]], axis=-2).reshape(x.shape)
    return x * cos[None, :, None, :].astype(x.dtype) + rot * sin[None, :, None, :].astype(x.dtype)


def _attend(qb, keys, values, masks, sink):
    scale = qb.shape[-1] ** -0.5
    scores = []
    for k, m in zip(keys, masks):
        s = jnp.einsum('bqgrd,bkgd->bgrqk', qb, k).astype(jnp.float32) * scale
        if m is not None:
            s = jnp.where(m, s, NEG_INF)
        scores.append(s)
    if sink is not None:
        scores.append(jnp.broadcast_to(sink.astype(jnp.float32)[None, :, :, None, None], scores[0].shape[:-1] + (1,)))
    p = jax.nn.softmax(jnp.concatenate(scores, axis=-1), axis=-1)
    out = None
    off = 0
    for v in values:
        n = v.shape[1]
        o = jnp.einsum('bgrqk,bkgd->bqgrd', p[..., off:off + n].astype(v.dtype), v)
        out = o if out is None else out + o
        off += n
    return out


def _latent_attention(q, k, v, k_ctx, v_ctx, sink, window):
    B, L, H, dk = q.shape
    G = k.shape[2]
    R = H // G
    dv = v.shape[-1]
    n_blk = L // BLOCK
    q_blocks = jnp.moveaxis(q.reshape(B, n_blk, BLOCK, G, R, dk), 1, 0)
    sink_gr = None if sink is None else sink.reshape(G, R)
    if window is not None:
        pad = ((0, 0), (window, window), (0, 0), (0, 0))
        k_pad = jnp.pad(k, pad)
        v_pad = jnp.pad(v, pad)
        span = BLOCK + 2 * window

    def one_block(args):
        qb, blk = args
        start = blk * BLOCK
        if window is None:
            kb, vb, mask = k, v, None
        else:
            kb = lax.dynamic_slice_in_dim(k_pad, start, span, axis=1)
            vb = lax.dynamic_slice_in_dim(v_pad, start, span, axis=1)
            q_pos = start + jnp.arange(BLOCK)
            k_pos = start - window + jnp.arange(span)
            mask = ((jnp.abs(q_pos[:, None] - k_pos[None, :]) <= window)
                    & (k_pos >= 0)[None, :] & (k_pos < L)[None, :])
        return _attend(qb, [kb, k_ctx], [vb, v_ctx], [mask, None], sink_gr)

    out = lax.map(one_block, (q_blocks, jnp.arange(n_blk)))
    return jnp.moveaxis(out, 0, 1).reshape(B, L, H, dv)


def _context_attention(q, k, v, sink):
    B, C, H, dk = q.shape
    G = k.shape[2]
    sink_gr = None if sink is None else sink.reshape(G, H // G)
    o = _attend(q.reshape(B, C, G, H // G, dk), [k], [v], [None], sink_gr)
    return o.reshape(B, C, H, v.shape[-1])


def _mla_q(p, g_q_a, w_q_up, rope):
    B, L = p.shape[:2]
    q = (_rmsnorm(p[..., COL_MLA_Q:COL_MLA_Q + MLA_Q_RANK], g_q_a) @ w_q_up).reshape(B, L, MLA_HEADS, MLA_NOPE + MLA_ROPE)
    q_nope, q_rope = q[..., :MLA_NOPE], q[..., MLA_NOPE:]
    if rope is not None:
        q_rope = _apply_axial_rope(q_rope, rope)
    return jnp.concatenate([q_nope, q_rope], axis=-1)


def _mla_kv(p, g_kv_a, w_kv_up, rope):
    B, L = p.shape[:2]
    c_kv = p[..., COL_MLA_KV:COL_MLA_KV + MLA_KV_RANK]
    k_rope = p[..., COL_MLA_KR:COL_MLA_KR + MLA_ROPE][:, :, None, :]
    if rope is not None:
        k_rope = _apply_axial_rope(k_rope, rope)
    kv = (_rmsnorm(c_kv, g_kv_a) @ w_kv_up).reshape(B, L, MLA_HEADS, MLA_NOPE + MLA_V)
    k = jnp.concatenate([kv[..., :MLA_NOPE], jnp.broadcast_to(k_rope, (B, L, MLA_HEADS, MLA_ROPE))], axis=-1)
    return k, kv[..., MLA_NOPE:]


def _gqa_q(p, rope):
    B, L = p.shape[:2]
    q = p[..., COL_GQA_Q:COL_GQA_Q + GQA_HEADS * GQA_HEAD_DIM].reshape(B, L, GQA_HEADS, GQA_HEAD_DIM)
    return q if rope is None else _apply_axial_rope(q, rope)


def _gqa_kv(p, rope):
    B, L = p.shape[:2]
    k = p[..., COL_GQA_K:COL_GQA_V].reshape(B, L, GQA_KV_HEADS, GQA_HEAD_DIM)
    v = p[..., COL_GQA_V:KV_COLS].reshape(B, L, GQA_KV_HEADS, GQA_HEAD_DIM)
    if rope is not None:
        k = _apply_axial_rope(k, rope)
    return k, v


def _conv_branch(p, conv_w, conv_b, ln_g, ln_b, w_conv_out):
    a = p[..., COL_CONV:COL_CONV + CONV_CH]
    b = p[..., COL_CONV + CONV_CH:COL_GATE]
    u = a * jax.nn.sigmoid(b)
    u = lax.conv_general_dilated(u, conv_w[:, None, :], window_strides=(1,),
                                 padding=[(CONV_WIDTH // 2, CONV_WIDTH // 2)],
                                 dimension_numbers=('NWC', 'WIO', 'NWC'),
                                 feature_group_count=CONV_CH) + conv_b
    u = jax.nn.silu(_layernorm(u, ln_g, ln_b))
    return u @ w_conv_out


def _merge(p, y_conv, y_mla, y_gqa, w_out):
    g = jax.nn.sigmoid(p[..., COL_GATE:IN_COLS]).reshape(p.shape[:-1] + (N_BRANCH, D_MODEL))
    y = g[..., 0, :] * y_conv + g[..., 1, :] * y_mla + g[..., 2, :] * y_gqa
    return y @ w_out


def _swiglu(h, w_in, w_out):
    u = h @ w_in
    return (jax.nn.silu(u[..., :D_FF]) * u[..., D_FF:]) @ w_out


def _mixing(p, ctx_kv, rope, lp):
    mk_c, mv_c, gk_c, gv_c = ctx_kv
    B, L = p.shape[:2]
    mq = _mla_q(p, lp['g_q_a'], lp['w_q_up'], rope)
    gq = _gqa_q(p, rope)
    if rope is None:
        o_mla = _context_attention(mq, mk_c, mv_c, None)
        o_gqa = _context_attention(gq, gk_c, gv_c, lp['gqa_sink'])
    else:
        mk, mv = _mla_kv(p, lp['g_kv_a'], lp['w_kv_up'], rope)
        gk, gv = _gqa_kv(p, rope)
        o_mla = _latent_attention(mq, mk, mv, mk_c, mv_c, None, None)
        o_gqa = _latent_attention(gq, gk, gv, gk_c, gv_c, lp['gqa_sink'], WINDOW)
    y_mla = o_mla.reshape(B, L, MLA_HEADS * MLA_V) @ lp['w_mla_out']
    y_gqa = o_gqa.reshape(B, L, GQA_HEADS * GQA_HEAD_DIM) @ lp['w_gqa_out']
    y_conv = _conv_branch(p, lp['conv_w'], lp['conv_b'], lp['conv_ln_g'], lp['conv_ln_b'], lp['w_conv_out'])
    return _merge(p, y_conv, y_mla, y_gqa, lp['w_out'])


def setup_inputs(seed: int = 0) -> dict:
    key = jax.random.key(seed)
    ks = jax.random.split(key, 25)

    def nrm(k, shape, scale):
        return jax.random.normal(k, shape, jnp.float32) * scale

    def gain(k, shape):
        return 1.0 + nrm(k, shape, 0.05)

    return {
        'x': nrm(ks[0], (BATCH, SEQ, D_MODEL), 1.0),
        'c': nrm(ks[1], (BATCH, D_MODEL), 1.0),
        'ctx': nrm(ks[2], (BATCH, CTX_LEN, D_MODEL), 1.0),
        'c_ctx': nrm(ks[3], (D_MODEL,), 1.0),
        'w_ada': nrm(ks[4], (DEPTH, D_MODEL, 6 * D_MODEL), 0.5 * D_MODEL ** -0.5),
        'b_ada': nrm(ks[5], (DEPTH, 6 * D_MODEL), 0.01),
        'g_mix': gain(ks[6], (DEPTH, D_MODEL)),
        'w_in': nrm(ks[7], (DEPTH, D_MODEL, IN_COLS), D_MODEL ** -0.5),
        'conv_w': nrm(ks[8], (DEPTH, CONV_WIDTH, CONV_CH), CONV_WIDTH ** -0.5),
        'conv_b': nrm(ks[9], (DEPTH, CONV_CH), 0.01),
        'conv_ln_g': gain(ks[10], (DEPTH, CONV_CH)),
        'conv_ln_b': nrm(ks[11], (DEPTH, CONV_CH), 0.01),
        'w_conv_out': nrm(ks[12], (DEPTH, CONV_CH, D_MODEL), CONV_CH ** -0.5),
        'g_q_a': gain(ks[13], (DEPTH, MLA_Q_RANK)),
        'w_q_up': nrm(ks[14], (DEPTH, MLA_Q_RANK, MLA_HEADS * (MLA_NOPE + MLA_ROPE)), MLA_Q_RANK ** -0.5),
        'g_kv_a': gain(ks[15], (DEPTH, MLA_KV_RANK)),
        'w_kv_up': nrm(ks[16], (DEPTH, MLA_KV_RANK, MLA_HEADS * (MLA_NOPE + MLA_V)), MLA_KV_RANK ** -0.5),
        'w_mla_out': nrm(ks[17], (DEPTH, MLA_HEADS * MLA_V, D_MODEL), (MLA_HEADS * MLA_V) ** -0.5),
        'gqa_sink': nrm(ks[18], (DEPTH, GQA_HEADS), 0.5),
        'w_gqa_out': nrm(ks[19], (DEPTH, GQA_HEADS * GQA_HEAD_DIM, D_MODEL), (GQA_HEADS * GQA_HEAD_DIM) ** -0.5),
        'w_out': nrm(ks[20], (DEPTH, D_MODEL, D_MODEL), D_MODEL ** -0.5),
        'g_ffn': gain(ks[21], (DEPTH, D_MODEL)),
        'w_ffn_in': nrm(ks[22], (DEPTH, D_MODEL, 2 * D_FF), D_MODEL ** -0.5),
        'w_ffn_out': nrm(ks[23], (DEPTH, D_FF, D_MODEL), D_FF ** -0.5),
        'g_final': gain(ks[24], (D_MODEL,)),
    }


def reference(x, c, ctx, c_ctx, w_ada, b_ada, g_mix, w_in, conv_w, conv_b, conv_ln_g, conv_ln_b,
              w_conv_out, g_q_a, w_q_up, g_kv_a, w_kv_up, w_mla_out, gqa_sink, w_gqa_out, w_out,
              g_ffn, w_ffn_in, w_ffn_out, g_final):
    L = x.shape[1]
    rope = _axial_rope_tables(L)
    xc = ctx
    for l in range(DEPTH):
        last = l == DEPTH - 1
        lp = {'g_q_a': g_q_a[l], 'w_q_up': w_q_up[l], 'g_kv_a': g_kv_a[l], 'w_kv_up': w_kv_up[l],
              'w_mla_out': w_mla_out[l], 'gqa_sink': gqa_sink[l], 'w_gqa_out': w_gqa_out[l],
              'conv_w': conv_w[l], 'conv_b': conv_b[l], 'conv_ln_g': conv_ln_g[l], 'conv_ln_b': conv_ln_b[l],
              'w_conv_out': w_conv_out[l], 'w_out': w_out[l]}
        mod = (jax.nn.silu(c) @ w_ada[l] + b_ada[l])[:, None, :]
        mod_c = (jax.nn.silu(c_ctx) @ w_ada[l] + b_ada[l])[None, None, :]
        sh1, sc1, gt1, sh2, sc2, gt2 = jnp.split(mod, 6, axis=-1)
        csh1, csc1, cgt1, csh2, csc2, cgt2 = jnp.split(mod_c, 6, axis=-1)
        w_in_l = w_in[l]
        p = _modulate(_rmsnorm(x, g_mix[l]), sh1, sc1) @ w_in_l
        hc = _modulate(_rmsnorm(xc, g_mix[l]), csh1, csc1)
        pc = hc @ (w_in_l[:, :KV_COLS] if last else w_in_l)
        ctx_kv = _mla_kv(pc, g_kv_a[l], w_kv_up[l], None) + _gqa_kv(pc, None)
        x = x + gt1 * _mixing(p, ctx_kv, rope, lp)
        if not last:
            xc = xc + cgt1 * _mixing(pc, ctx_kv, None, lp)
        x = x + gt2 * _swiglu(_modulate(_rmsnorm(x, g_ffn[l]), sh2, sc2), w_ffn_in[l], w_ffn_out[l])
        if not last:
            xc = xc + cgt2 * _swiglu(_modulate(_rmsnorm(xc, g_ffn[l]), csh2, csc2), w_ffn_in[l], w_ffn_out[l])
    return _rmsnorm(x, g_final)
```

```cpp
#include <hip/hip_runtime.h>
#include <cstdio>
#include <cstdint>
#define GAS __attribute__((address_space(1)))
#define LAS __attribute__((address_space(3)))
namespace pg8 {
#define PG8_LAS __attribute__((address_space(3)))
typedef unsigned short bf16_t;
typedef short bf16x8 __attribute__((ext_vector_type(8)));
typedef float f32x4 __attribute__((ext_vector_type(4)));
typedef unsigned u32x4 __attribute__((ext_vector_type(4)));
constexpr int BM = 256, BK = 64, HALF = 128, HTB = HALF * BK * 2  , STAGE_BYTES = 8 * HTB, NXCD = 8, WGM = 8;

__host__ __device__ __forceinline__ int lds_byte(int r, int c) { const int st = (r >> 4) * 2 + (c >> 5), rr = r & 15, cc = c & 31, ob = rr * 64 + cc * 2; return st * 1024 + (ob ^ (((ob >> 9) & 1) << 5)); }
__host__ __device__ __forceinline__ void stage_rc(int b, int& R, int& C) { const int st = b / 1024, sb = b % 1024, swz = sb ^ (((sb >> 9) & 1) << 5); R = (st >> 1) * 16 + swz / 64; C = (st & 1) * 32 + (swz % 64) / 2; }
__host__ __device__ __forceinline__ int perm32(int rho) { const int n = rho >> 4, i = rho & 15; return 8 * (i >> 2) + 4 * n + (i & 3); }

struct Unit { int pm, pn; };
struct Gemm { const bf16_t* A; const bf16_t* Bt; int M, N, K; };

struct StaticOrder {
    int nM, nN, nwg, G, c, ext_n, ext_pm0, ext_pn0, ext_w, wgm;
    __host__ __device__ void init(int M, int N, int G_, int c_) { nM = M / BM; nN = N / BM; nwg = nM * nN; G = G_; c = c_; ext_n = 0; ext_pm0 = 0; ext_pn0 = 0; ext_w = 1; wgm = WGM; }
    __host__ __device__ void set_extra(int n, int pm0, int pn0, int w) { ext_n = n; ext_pm0 = pm0; ext_pn0 = pn0; ext_w = w; }
    __host__ __device__ bool next(int i, Unit& u) const {
        const long L = (long)i * G + c; if (L >= nwg + ext_n) return false;
        if (L >= nwg) { const int e = (int)L - nwg; u.pm = ext_pm0 + e / ext_w; u.pn = ext_pn0 + e % ext_w; return true; }
        int wgid = (int)L; { const int q = nwg / NXCD, r = nwg % NXCD, xcd = wgid % NXCD, off = wgid / NXCD; wgid = (xcd < r ? xcd * (q + 1) : r * (q + 1) + (xcd - r) * q) + off; }
        const int nig = wgm * nN, gid = wgid / nig, fm = gid * wgm, gsz = (nM - fm) < wgm ? (nM - fm) : wgm;
        u.pm = fm + ((wgid % nig) % gsz); u.pn = (wgid % nig) / gsz; return true;
    }
    static __host__ __device__ __forceinline__ void map_entry(int nM_, int nN_, int L, Unit& u, int WGM_ = WGM) {
        const int nwg_ = nM_ * nN_; int wgid = L; { const int q = nwg_ / NXCD, r = nwg_ % NXCD, xcd = wgid % NXCD, off = wgid / NXCD; wgid = (xcd < r ? xcd * (q + 1) : r * (q + 1) + (xcd - r) * q) + off; }
        const int nig = WGM_ * nN_, gid = wgid / nig, fm = gid * WGM_, gsz = (nM_ - fm) < WGM_ ? (nM_ - fm) : WGM_;
        u.pm = fm + ((wgid % nig) % gsz); u.pn = (wgid % nig) / gsz;
    }
    __device__ __forceinline__ void a_ready(const Unit&) const {}
    __device__ __forceinline__ void done(const Unit&) const {}
};
typedef float f32x2_t __attribute__((ext_vector_type(2))); typedef __bf16 bf16x2_t __attribute__((ext_vector_type(2)));
__device__ __forceinline__ unsigned cvt_pk_bf16(float lo, float hi) { f32x2_t v = {lo, hi}; bf16x2_t b = __builtin_convertvector(v, bf16x2_t); return __builtin_bit_cast(unsigned, b); }
typedef float f32x2 __attribute__((ext_vector_type(2)));
template <class Epi, class Sched, bool ALIGN_EPI = false, bool SP2 = false>
__device__ __forceinline__ void gemm_phase(PG8_LAS unsigned char* lds, const Gemm g, const Sched& S, const Epi& E) {
    int tid_ = threadIdx.x; asm volatile("" : "+v"(tid_));
    const int tid = tid_, wid = __builtin_amdgcn_readfirstlane(tid >> 6), lane = tid & 63, wr = wid >> 2, wc = wid & 3, fr = lane & 15, fq = lane >> 4;
    const int K = g.K, nt = K / BK;
    unsigned voffA[2], voffB[2];
#pragma unroll
    for (int i = 0; i < 2; ++i) { int R, C; stage_rc(tid * 16 + i * 8192, R, C); const int Rb = Epi::PERM ? ((R & ~31) + perm32(R & 31)) : R;
        voffA[i] = (unsigned)(R * K + C) * 2u; voffB[i] = (unsigned)(Rb * K + C) * 2u; }
    const size_t kstep = (size_t)(BK * 2);
    const size_t hstep = (size_t)HALF * K * 2;
    const size_t tstep = 2 * hstep;
    const unsigned ldsw = (unsigned)wid * 1024u;
    const int aoff = lds_byte(wr * 64 + fr, fq * 8), boff = lds_byte(wc * 32 + fr, fq * 8);
#define PG8_SA(b, h) (((b) * 2 + (h)) * HTB)
#define PG8_SB(b, h) ((4 + (b) * 2 + (h)) * HTB)
#define PG8_STAGE(bufoff, gbase, voff) do { _Pragma("unroll") for (int _i = 0; _i < 2; ++_i) \
        __builtin_amdgcn_global_load_lds((const unsigned*)((const char*)(gbase) + (voff)[_i]), (PG8_LAS unsigned*)(lds + (bufoff) + ldsw + _i * 8192), 16, 0, 0); } while (0)
#define PG8_LDA(dst, b, h) do { _Pragma("unroll") for (int m = 0; m < 4; ++m) _Pragma("unroll") for (int k = 0; k < 2; ++k) dst[m][k] = *(const PG8_LAS bf16x8*)(lds + PG8_SA(b, h) + aoff + m * 2048 + k * 1024); } while (0)
#define PG8_LDB(dst, b, h) do { _Pragma("unroll") for (int n = 0; n < 2; ++n) _Pragma("unroll") for (int k = 0; k < 2; ++k) dst[n][k] = *(const PG8_LAS bf16x8*)(lds + PG8_SB(b, h) + boff + n * 2048 + k * 1024); } while (0)
#define PG8_MMA(ai, bj, At, Bt) do { __builtin_amdgcn_s_setprio(1); _Pragma("unroll") for (int m = 0; m < 4; ++m) _Pragma("unroll") for (int n = 0; n < 2; ++n) _Pragma("unroll") for (int k = 0; k < 2; ++k) \
        acc[ai][bj][m][n] = __builtin_amdgcn_mfma_f32_16x16x32_bf16(Bt[n][k], At[m][k], acc[ai][bj][m][n], 0, 0, 0); __builtin_amdgcn_s_setprio(0); } while (0)
#define PG8_WAIT_V(n) asm volatile("s_waitcnt vmcnt(" #n ")" ::: "memory")
#define PG8_WAIT_L(n) asm volatile("s_waitcnt lgkmcnt(" #n ")" ::: "memory")
#define PG8_BAR __builtin_amdgcn_s_barrier()
#define PG8_SCHED __builtin_amdgcn_sched_barrier(0)
    Unit cur, nxt; int ui = 0;
    if (!S.next(0, cur)) return;
    f32x4 acc[2][2][4][2];
#pragma unroll
    for (int a = 0; a < 2; ++a)
#pragma unroll
        for (int b = 0; b < 2; ++b)
#pragma unroll
            for (int m = 0; m < 4; ++m)
#pragma unroll
                for (int n = 0; n < 2; ++n) acc[a][b][m][n] = (f32x4){0.f, 0.f, 0.f, 0.f};
    bf16x8 At[4][2], B0[2][2], B1[2][2];
    const char* cA = (const char*)g.A + (size_t)cur.pm * tstep; const char* cB = (const char*)g.Bt + (size_t)cur.pn * tstep;
    S.a_ready(cur);
    if constexpr (SP2) {
        PG8_STAGE(PG8_SB(0, 0), cB, voffB); PG8_STAGE(PG8_SB(0, 1), cB + hstep, voffB); PG8_STAGE(PG8_SA(0, 0), cA, voffA); PG8_STAGE(PG8_SA(0, 1), cA + hstep, voffA);
        if (wr == 1) PG8_BAR;
        PG8_WAIT_V(2); PG8_BAR;
        PG8_STAGE(PG8_SB(1, 0), cB + kstep, voffB); PG8_STAGE(PG8_SA(1, 0), cA + kstep, voffA); PG8_STAGE(PG8_SB(1, 1), cB + hstep + kstep, voffB);
        PG8_WAIT_V(6); PG8_BAR;
    } else {
        PG8_STAGE(PG8_SB(0, 0), cB, voffB); PG8_STAGE(PG8_SA(0, 0), cA, voffA); PG8_STAGE(PG8_SB(0, 1), cB + hstep, voffB); PG8_STAGE(PG8_SA(0, 1), cA + hstep, voffA);
        if (wr == 1) PG8_BAR;
        PG8_WAIT_V(4); PG8_BAR;
        PG8_STAGE(PG8_SB(1, 0), cB + kstep, voffB); PG8_STAGE(PG8_SA(1, 0), cA + kstep, voffA); PG8_STAGE(PG8_SB(1, 1), cB + hstep + kstep, voffB);
        PG8_WAIT_V(6); PG8_BAR;
    }
    for (;;) {
        const bool has_next = S.next(ui + 1, nxt);
        const char* nA = has_next ? (const char*)g.A + (size_t)nxt.pm * tstep : cA; const char* nB = has_next ? (const char*)g.Bt + (size_t)nxt.pn * tstep : cB;
#pragma nounroll
        for (int t = 0; t < nt; t += 2) {
            const bool last = (t == nt - 2);
            const char* a1 = cA + (size_t)(t + 1) * kstep;
            const char* a2 = last ? nA : cA + (size_t)(t + 2) * kstep; const char* b2 = last ? nB : cB + (size_t)(t + 2) * kstep;
            const char* a3 = a2 + kstep; const char* b3 = b2 + kstep;
            if (last && has_next) S.a_ready(nxt);
            if constexpr (SP2) {
            PG8_LDB(B0, 0, 0); PG8_LDB(B1, 0, 1); PG8_SCHED; PG8_LDA(At, 0, 0); PG8_STAGE(PG8_SA(1, 1), a1 + hstep, voffA);
            PG8_WAIT_V(8); PG8_WAIT_L(0); PG8_BAR; PG8_MMA(0, 0, At, B0); PG8_MMA(0, 1, At, B1); PG8_BAR; PG8_SCHED;
            PG8_LDA(At, 0, 1); PG8_STAGE(PG8_SB(0, 0), b2, voffB); PG8_STAGE(PG8_SB(0, 1), b2 + hstep, voffB); PG8_STAGE(PG8_SA(0, 0), a2, voffA);
            PG8_WAIT_V(8); PG8_WAIT_L(0); PG8_BAR; PG8_MMA(1, 0, At, B0); PG8_MMA(1, 1, At, B1); PG8_BAR; PG8_SCHED;
            PG8_LDB(B0, 1, 0); PG8_LDB(B1, 1, 1); PG8_SCHED; PG8_LDA(At, 1, 0); PG8_STAGE(PG8_SA(0, 1), a2 + hstep, voffA);
            PG8_WAIT_V(8); PG8_WAIT_L(0); PG8_BAR; PG8_MMA(0, 0, At, B0); PG8_MMA(0, 1, At, B1); PG8_BAR; PG8_SCHED;
            PG8_LDA(At, 1, 1); PG8_STAGE(PG8_SB(1, 0), b3, voffB); PG8_STAGE(PG8_SB(1, 1), b3 + hstep, voffB); PG8_STAGE(PG8_SA(1, 0), a3, voffA);
            PG8_WAIT_V(8); PG8_WAIT_L(0); PG8_BAR; PG8_MMA(1, 0, At, B0); PG8_MMA(1, 1, At, B1); PG8_BAR; PG8_SCHED;
            } else {
            PG8_LDB(B0, 0, 0); PG8_SCHED; PG8_LDA(At, 0, 0); PG8_STAGE(PG8_SA(1, 1), a1 + hstep, voffA);
            PG8_WAIT_L(8); PG8_BAR; PG8_WAIT_L(0); PG8_MMA(0, 0, At, B0); PG8_BAR; PG8_SCHED;
            PG8_LDB(B1, 0, 1); PG8_STAGE(PG8_SB(0, 0), b2, voffB);
            PG8_BAR; PG8_WAIT_L(0); PG8_MMA(0, 1, At, B1); PG8_BAR;
            PG8_LDA(At, 0, 1); PG8_STAGE(PG8_SA(0, 0), a2, voffA);
            PG8_BAR; PG8_WAIT_L(0); PG8_MMA(1, 0, At, B0); PG8_BAR; PG8_SCHED;
            PG8_STAGE(PG8_SB(0, 1), b2 + hstep, voffB);
            PG8_WAIT_V(6); PG8_BAR; PG8_MMA(1, 1, At, B1); PG8_BAR;
            PG8_LDB(B0, 1, 0); PG8_SCHED; PG8_LDA(At, 1, 0); PG8_STAGE(PG8_SA(0, 1), a2 + hstep, voffA);
            PG8_WAIT_L(8); PG8_BAR; PG8_WAIT_L(0); PG8_MMA(0, 0, At, B0); PG8_BAR; PG8_SCHED;
            PG8_LDB(B1, 1, 1); PG8_STAGE(PG8_SB(1, 0), b3, voffB);
            PG8_BAR; PG8_WAIT_L(0); PG8_MMA(0, 1, At, B1); PG8_BAR;
            PG8_LDA(At, 1, 1); PG8_STAGE(PG8_SA(1, 0), a3, voffA);
            PG8_BAR; PG8_WAIT_L(0); PG8_MMA(1, 0, At, B0); PG8_BAR; PG8_SCHED;
            PG8_STAGE(PG8_SB(1, 1), b3 + hstep, voffB);
            PG8_WAIT_V(6); PG8_BAR; PG8_MMA(1, 1, At, B1); PG8_BAR;
            }
        }
        if constexpr (ALIGN_EPI) { if (wr == 0) PG8_BAR; }
        if constexpr (!Epi::AFTER_DRAIN) { E(acc, cur, wr, wc, fr, fq); S.done(cur); }
        if (!has_next) break;
#pragma unroll
        for (int a = 0; a < 2; ++a)
#pragma unroll
            for (int b = 0; b < 2; ++b)
#pragma unroll
                for (int m = 0; m < 4; ++m)
#pragma unroll
                    for (int n = 0; n < 2; ++n) acc[a][b][m][n] = (f32x4){0.f, 0.f, 0.f, 0.f};
        cur = nxt; cA = nA; cB = nB; ++ui;
        if constexpr (ALIGN_EPI) { if (wr == 1) PG8_BAR; }
    }
    PG8_WAIT_V(0);
    if constexpr (!ALIGN_EPI) { if (wr == 0) PG8_BAR; }
    PG8_BAR;
    if constexpr (Epi::AFTER_DRAIN) { E.fused(acc, cur, wr, wc, fr, fq, lds, wid, lane); S.done(cur); }
#undef PG8_SA
#undef PG8_SB
#undef PG8_STAGE
#undef PG8_LDA
#undef PG8_LDB
#undef PG8_MMA
#undef PG8_WAIT_V
#undef PG8_WAIT_L
#undef PG8_BAR
#undef PG8_SCHED
}
}
namespace pg8 {
typedef unsigned u32x2 __attribute__((ext_vector_type(2)));
constexpr int ML_ROWS = 32768;
__device__ __forceinline__ float sigm(float x) { return __builtin_amdgcn_rcpf(1.0f + __builtin_amdgcn_exp2f(-1.4426950408889634f * x)); }
__device__ __forceinline__ u32x2 pack4(const f32x4 v) { u32x2 w; w.x = cvt_pk_bf16(v[0], v[1]); w.y = cvt_pk_bf16(v[2], v[3]); return w; }
__device__ __forceinline__ void rope4(f32x4& x0, f32x4& x1, const float* rope, int row, int half, int fq) {
    const int t = row & 4095, p = half ? (t & 63) : (t >> 6);
    const f32x4* tp = (const f32x4*)(rope + (p * 16 + 4 * fq) * 2);
    const f32x4 a = tp[0], b = tp[1];
    const f32x4 c = {a[0], a[2], b[0], b[2]}, s = {a[1], a[3], b[1], b[3]};
    const f32x4 y0 = x0 * c - x1 * s, y1 = x1 * c + x0 * s;
    x0 = y0; x1 = y1;
}
struct EpiWin {
    static constexpr bool PERM = false, AFTER_DRAIN = false;
    unsigned char* G; bf16_t* CQ; bf16_t* KF; bf16_t* GK; bf16_t* GV; bf16_t* GQ; bf16_t* U; const float* rope;
    __device__ __forceinline__ void operator()(const f32x4 (&acc)[2][2][4][2], const Unit& u, int wr, int wc, int fr, int fq) const {
        const int row0 = u.pm * BM + wr * 64 + fr; const bool lat = u.pm < (ML_ROWS / BM);
#pragma unroll
        for (int bj = 0; bj < 2; ++bj) {
            const int colg = u.pn * BM + bj * HALF + wc * 32;
            if (colg < 6144) {
#pragma unroll
                for (int ai = 0; ai < 2; ++ai)
#pragma unroll
                    for (int m = 0; m < 4; ++m) { const size_t row = (size_t)(row0 + ai * HALF + m * 16);
#pragma unroll
                        for (int n = 0; n < 2; ++n) { const f32x4 v = acc[ai][bj][m][n];
#define SG8(x) ((unsigned)(__builtin_amdgcn_rcpf(1.0f + __builtin_amdgcn_exp2f(x)) * 255.0f + 0.5f))
                            const unsigned q0 = SG8(v[0]), q1 = SG8(v[1]), q2 = SG8(v[2]), q3 = SG8(v[3]);
#undef SG8
                            *(unsigned*)(G + row * 6144 + colg + 16 * n + 4 * fq) = q0 | (q1 << 8) | (q2 << 16) | (q3 << 24); } }
            } else {
                const int o = colg - 6144;
                if (o < 256 || (o >= 576 && o < 1088)) {
                    const int co = (o < 256) ? o : (256 + o - 576);
#pragma unroll
                    for (int ai = 0; ai < 2; ++ai)
#pragma unroll
                        for (int m = 0; m < 4; ++m) { const size_t row = (size_t)(row0 + ai * HALF + m * 16);
#pragma unroll
                            for (int n = 0; n < 2; ++n) *(u32x2*)(CQ + row * 768 + co + 16 * n + 4 * fq) = pack4(acc[ai][bj][m][n]); }
                } else if (o < 320) {
                    const int half = (o - 256) >> 5;
#pragma unroll
                    for (int ai = 0; ai < 2; ++ai)
#pragma unroll
                        for (int m = 0; m < 4; ++m) { const int r = row0 + ai * HALF + m * 16; f32x4 x0 = acc[ai][bj][m][0], x1 = acc[ai][bj][m][1];
                            if (lat) rope4(x0, x1, rope, r, half, fq);
                            const u32x2 w0 = pack4(x0), w1 = pack4(x1); bf16_t* p = KF + (size_t)r * 1536 + 128 + (o - 256) + 4 * fq;
#pragma unroll
                            for (int h = 0; h < 8; ++h) { *(u32x2*)(p + h * 192) = w0; *(u32x2*)(p + h * 192 + 16) = w1; } }
                } else if (o < 448 || (o >= 1088 && o < 1600)) {
                    const bool isk = o < 448; const int co = isk ? (o - 320) : (o - 1088); const int half = (co >> 5) & 1;
                    bf16_t* base = isk ? GK : GQ; const int ld = isk ? 128 : 512;
#pragma unroll
                    for (int ai = 0; ai < 2; ++ai)
#pragma unroll
                        for (int m = 0; m < 4; ++m) { const int r = row0 + ai * HALF + m * 16; f32x4 x0 = acc[ai][bj][m][0], x1 = acc[ai][bj][m][1];
                            if (lat) rope4(x0, x1, rope, r, half, fq);
                            bf16_t* p = base + (size_t)r * ld + co + 4 * fq; *(u32x2*)p = pack4(x0); *(u32x2*)(p + 16) = pack4(x1); }
                } else if (o < 576) {
#pragma unroll
                    for (int ai = 0; ai < 2; ++ai)
#pragma unroll
                        for (int m = 0; m < 4; ++m) { const size_t row = (size_t)(row0 + ai * HALF + m * 16); bf16_t* p = GV + row * 128 + (o - 448) + 4 * fq;
                            *(u32x2*)p = pack4(acc[ai][bj][m][0]); *(u32x2*)(p + 16) = pack4(acc[ai][bj][m][1]); }
                } else if (o < 2624) {
                    const int g = (o - 1600) >> 5;
#pragma unroll
                    for (int ai = 0; ai < 2; ++ai)
#pragma unroll
                        for (int m = 0; m < 4; ++m) { const size_t row = (size_t)(row0 + ai * HALF + m * 16); const f32x4 a = acc[ai][bj][m][0], b = acc[ai][bj][m][1];
                            const f32x4 uu = {a[0] * sigm(b[0]), a[1] * sigm(b[1]), a[2] * sigm(b[2]), a[3] * sigm(b[3])};
                            *(u32x2*)(U + row * 512 + 16 * g + 4 * fq) = pack4(uu); }
                }
            }
        }
    }
};
struct EpiQup {
    static constexpr bool PERM = false, AFTER_DRAIN = false;
    bf16_t* MQ; const float* rope;
    __device__ __forceinline__ void operator()(const f32x4 (&acc)[2][2][4][2], const Unit& u, int wr, int wc, int fr, int fq) const {
        const int row0 = u.pm * BM + wr * 64 + fr; const bool lat = u.pm < (ML_ROWS / BM);
#pragma unroll
        for (int bj = 0; bj < 2; ++bj) {
            const int colg = u.pn * BM + bj * HALF + wc * 32, hd = colg % 192; const bool isr = hd >= 128; const int half = (hd - 128) >> 5;
#pragma unroll
            for (int ai = 0; ai < 2; ++ai)
#pragma unroll
                for (int m = 0; m < 4; ++m) { const int r = row0 + ai * HALF + m * 16; f32x4 x0 = acc[ai][bj][m][0], x1 = acc[ai][bj][m][1];
                    if (isr && lat) rope4(x0, x1, rope, r, half, fq);
                    bf16_t* p = MQ + (size_t)r * 1536 + colg + 4 * fq; *(u32x2*)p = pack4(x0); *(u32x2*)(p + 16) = pack4(x1); }
        }
    }
};
struct EpiKV {
    static constexpr bool PERM = true, AFTER_DRAIN = false;
    bf16_t* KF; bf16_t* V;
    __device__ __forceinline__ void operator()(const f32x4 (&acc)[2][2][4][2], const Unit& u, int wr, int wc, int fr, int fq) const {
        const int row0 = u.pm * BM + wr * 64 + fr, c0 = wc * 32 + 8 * fq;
#pragma unroll
        for (int ai = 0; ai < 2; ++ai)
#pragma unroll
            for (int m = 0; m < 4; ++m) { const size_t row = (size_t)(row0 + ai * HALF + m * 16);
#pragma unroll
                for (int bj = 0; bj < 2; ++bj) { const f32x4 v0 = acc[ai][bj][m][0], v1 = acc[ai][bj][m][1];
                    u32x4 w; w.x = cvt_pk_bf16(v0[0], v0[1]); w.y = cvt_pk_bf16(v0[2], v0[3]); w.z = cvt_pk_bf16(v1[0], v1[1]); w.w = cvt_pk_bf16(v1[2], v1[3]);
                    if (bj == 0) *(u32x4*)(KF + row * 1536 + u.pn * 192 + c0) = w; else *(u32x4*)(V + row * 1024 + u.pn * 128 + c0) = w; } }
    }
};
template <int STEP> struct EpiMerge {
    static constexpr bool PERM = true, AFTER_DRAIN = false;
    const unsigned char* G; bf16_t* YF; bf16_t* Y;
    __device__ __forceinline__ void operator()(const f32x4 (&acc)[2][2][4][2], const Unit& u, int wr, int wc, int fr, int fq) const {
        constexpr int NBATCH = 4;
        const int row0 = u.pm * BM + wr * 64 + fr, col0 = u.pn * BM + wc * 32 + 8 * fq;
        bf16_t* dst = (STEP < 2) ? YF : Y;
#pragma unroll
        for (int ai = 0; ai < 2; ++ai)
#pragma unroll
            for (int mb = 0; mb < 4; mb += NBATCH) {
                u32x2 gw[NBATCH][2]; u32x4 yv[NBATCH][2];
#pragma unroll
                for (int q = 0; q < NBATCH; ++q) { const size_t row = (size_t)(row0 + ai * HALF + (mb + q) * 16);
#pragma unroll
                    for (int bj = 0; bj < 2; ++bj) { const int c = col0 + bj * HALF;
                        gw[q][bj] = *(const u32x2*)(G + row * 6144 + STEP * 2048 + c);
                        if (STEP > 0) yv[q][bj] = *(const u32x4*)(YF + row * 2048 + c); } }
#pragma unroll
                for (int q = 0; q < NBATCH; ++q) { const size_t row = (size_t)(row0 + ai * HALF + (mb + q) * 16); const int m = mb + q;
#pragma unroll
                    for (int bj = 0; bj < 2; ++bj) { const int c = col0 + bj * HALF; const u32x2 g2 = gw[q][bj]; constexpr float I255 = 1.0f / 255.0f;
                        const f32x4 g0 = {(float)(g2.x & 255u) * I255, (float)((g2.x >> 8) & 255u) * I255, (float)((g2.x >> 16) & 255u) * I255, (float)(g2.x >> 24) * I255};
                        const f32x4 g1 = {(float)(g2.y & 255u) * I255, (float)((g2.y >> 8) & 255u) * I255, (float)((g2.y >> 16) & 255u) * I255, (float)(g2.y >> 24) * I255};
                        f32x4 a0 = acc[ai][bj][m][0] * g0, a1 = acc[ai][bj][m][1] * g1;
                        if (STEP > 0) { const u32x4 y4 = yv[q][bj];
                            a0 += (f32x4){__uint_as_float(y4.x << 16), __uint_as_float(y4.x & 0xffff0000u), __uint_as_float(y4.y << 16), __uint_as_float(y4.y & 0xffff0000u)};
                            a1 += (f32x4){__uint_as_float(y4.z << 16), __uint_as_float(y4.z & 0xffff0000u), __uint_as_float(y4.w << 16), __uint_as_float(y4.w & 0xffff0000u)}; }
                        u32x4 w; w.x = cvt_pk_bf16(a0[0], a0[1]); w.y = cvt_pk_bf16(a0[2], a0[3]); w.z = cvt_pk_bf16(a1[0], a1[1]); w.w = cvt_pk_bf16(a1[2], a1[3]);
                        *(u32x4*)(dst + row * 2048 + c) = w; } }
                asm volatile("" ::: "memory"); }
    }
};
struct EpiResid {
    static constexpr bool PERM = false, AFTER_DRAIN = false;
    float* XL; float* XC; const float* modl; int goff; const float* XLin;
    __device__ __forceinline__ void operator()(const f32x4 (&acc)[2][2][4][2], const Unit& u, int wr, int wc, int fr, int fq) const {
        const bool lat = u.pm < (ML_ROWS / BM); const int sel = lat ? (u.pm >> 4) : 8;
        const int col0 = u.pn * BM + wc * 32 + 4 * fq; const float* gt = modl + sel * 12288 + goff + col0;
        float* base = lat ? XL + (size_t)(u.pm * BM + wr * 64 + fr) * 2048 : XC + (size_t)(u.pm * BM - ML_ROWS + wr * 64 + fr) * 2048;
        const float* rbase = lat ? XLin + (size_t)(u.pm * BM + wr * 64 + fr) * 2048 : (const float*)base;
        f32x4 gv[2][2];
#pragma unroll
        for (int bj = 0; bj < 2; ++bj)
#pragma unroll
            for (int n = 0; n < 2; ++n) gv[bj][n] = *(const f32x4*)(gt + bj * HALF + n * 16);
#pragma unroll
        for (int ai = 0; ai < 2; ++ai) {
            f32x4 xv[4][2][2];
#pragma unroll
            for (int m = 0; m < 4; ++m) { const float* rowp = rbase + (size_t)(ai * HALF + m * 16) * 2048 + col0;
#pragma unroll
                for (int bj = 0; bj < 2; ++bj)
#pragma unroll
                    for (int n = 0; n < 2; ++n) xv[m][bj][n] = *(const f32x4*)(rowp + bj * HALF + n * 16); }
#pragma unroll
            for (int m = 0; m < 4; ++m) { float* rowp = base + (size_t)(ai * HALF + m * 16) * 2048 + col0;
#pragma unroll
                for (int bj = 0; bj < 2; ++bj)
#pragma unroll
                    for (int n = 0; n < 2; ++n) *(f32x4*)(rowp + bj * HALF + n * 16) = xv[m][bj][n] + gv[bj][n] * acc[ai][bj][m][n]; }
            asm volatile("" ::: "memory"); }
    }
};
struct EpiSwiGLU {
    static constexpr bool PERM = false, AFTER_DRAIN = false;
    bf16_t* HID;
    __device__ __forceinline__ void operator()(const f32x4 (&acc)[2][2][4][2], const Unit& u, int wr, int wc, int fr, int fq) const {
        const int row0 = u.pm * BM + wr * 64 + fr, c0 = u.pn * 128 + wc * 16 + 4 * fq;
#pragma unroll
        for (int ai = 0; ai < 2; ++ai)
#pragma unroll
            for (int m = 0; m < 4; ++m) { bf16_t* rowp = HID + (size_t)(row0 + ai * HALF + m * 16) * 5632 + c0;
#pragma unroll
                for (int bj = 0; bj < 2; ++bj) { const f32x4 a = acc[ai][bj][m][0], b = acc[ai][bj][m][1];
                    const f32x4 h = {a[0] * sigm(a[0]) * b[0], a[1] * sigm(a[1]) * b[1], a[2] * sigm(a[2]) * b[2], a[3] * sigm(a[3]) * b[3]};
                    *(u32x2*)(rowp + bj * 64) = pack4(h); } }
    }
};
}
namespace pg8 {
struct UnitX { int pm, pn, kind; };
template <class Epi, class Sched>
__device__ __forceinline__ void gemm_stream(PG8_LAS unsigned char* lds, const Sched& S, const Epi& E) {
    int tid_ = threadIdx.x; asm volatile("" : "+v"(tid_));
    const int tid = tid_, wid = __builtin_amdgcn_readfirstlane(tid >> 6), lane = tid & 63, wr = wid >> 2, wc = wid & 3, fr = lane & 15, fq = lane >> 4;
    int Rn, Rp, C2; { int R, C; stage_rc(tid * 16, R, C); Rn = R; Rp = (R & ~31) + perm32(R & 31); C2 = C * 2; }
    const size_t kstep = (size_t)(BK * 2);
    const unsigned ldsw = (unsigned)wid * 1024u;
    const int aoff = lds_byte(wr * 64 + fr, fq * 8), boff = lds_byte(wc * 32 + fr, fq * 8);
#define PG8_SA(b, h) (((b) * 2 + (h)) * HTB)
#define PG8_SB(b, h) ((4 + (b) * 2 + (h)) * HTB)
#define PG8_STAGE(bufoff, gbase, voff, r64) do { \
        __builtin_amdgcn_global_load_lds((const unsigned*)((const char*)(gbase) + (voff)), (PG8_LAS unsigned*)(lds + (bufoff) + ldsw), 16, 0, 0); \
        __builtin_amdgcn_global_load_lds((const unsigned*)((const char*)(gbase) + (r64) + (voff)), (PG8_LAS unsigned*)(lds + (bufoff) + ldsw + 8192), 16, 0, 0); } while (0)
#define PG8_LDA(dst, b, h) do { _Pragma("unroll") for (int m = 0; m < 4; ++m) _Pragma("unroll") for (int k = 0; k < 2; ++k) dst[m][k] = *(const PG8_LAS bf16x8*)(lds + PG8_SA(b, h) + aoff + m * 2048 + k * 1024); } while (0)
#define PG8_LDB(dst, b, h) do { _Pragma("unroll") for (int n = 0; n < 2; ++n) _Pragma("unroll") for (int k = 0; k < 2; ++k) dst[n][k] = *(const PG8_LAS bf16x8*)(lds + PG8_SB(b, h) + boff + n * 2048 + k * 1024); } while (0)
#define PG8_MMA(ai, bj, At, Bt) do { __builtin_amdgcn_s_setprio(1); _Pragma("unroll") for (int m = 0; m < 4; ++m) _Pragma("unroll") for (int n = 0; n < 2; ++n) _Pragma("unroll") for (int k = 0; k < 2; ++k) \
        acc[ai][bj][m][n] = __builtin_amdgcn_mfma_f32_16x16x32_bf16(Bt[n][k], At[m][k], acc[ai][bj][m][n], 0, 0, 0); __builtin_amdgcn_s_setprio(0); } while (0)
#define PG8_WAIT_V(n) asm volatile("s_waitcnt vmcnt(" #n ")" ::: "memory")
#define PG8_WAIT_L(n) asm volatile("s_waitcnt lgkmcnt(" #n ")" ::: "memory")
#define PG8_BAR __builtin_amdgcn_s_barrier()
#define PG8_SCHED __builtin_amdgcn_sched_barrier(0)
    UnitX cur, nxt; int ui = 0;
    if (!S.next(0, cur)) return;
    f32x4 acc[2][2][4][2];
#pragma unroll
    for (int a = 0; a < 2; ++a)
#pragma unroll
        for (int b = 0; b < 2; ++b)
#pragma unroll
            for (int m = 0; m < 4; ++m)
#pragma unroll
                for (int n = 0; n < 2; ++n) acc[a][b][m][n] = (f32x4){0.f, 0.f, 0.f, 0.f};
    bf16x8 At[4][2], B0[2][2], B1[2][2];
    int K2 = S.gPitch(cur.kind) * 2;
    unsigned voA = (unsigned)(Rn * K2 + C2), voB = (unsigned)((S.gPerm(cur.kind) ? Rp : Rn) * K2 + C2);
    size_t r64 = (size_t)64 * K2, hstep = (size_t)HALF * K2;
    int nt = S.gNt(cur.kind);
    const char* cA = (const char*)S.gA(cur.kind) + (size_t)cur.pm * 2 * hstep + (size_t)S.gK0(cur.kind) * 2; const char* cB = (const char*)S.gB(cur.kind) + (size_t)cur.pn * 2 * hstep + (size_t)S.gK0(cur.kind) * 2;
    PG8_STAGE(PG8_SB(0, 0), cB, voB, r64); PG8_STAGE(PG8_SB(0, 1), cB + hstep, voB, r64); PG8_STAGE(PG8_SA(0, 0), cA, voA, r64); PG8_STAGE(PG8_SA(0, 1), cA + hstep, voA, r64);
    if (wr == 1) PG8_BAR;
    PG8_WAIT_V(2); PG8_BAR;
    PG8_STAGE(PG8_SB(1, 0), cB + kstep, voB, r64); PG8_STAGE(PG8_SA(1, 0), cA + kstep, voA, r64); PG8_STAGE(PG8_SB(1, 1), cB + hstep + kstep, voB, r64);
    PG8_WAIT_V(6); PG8_BAR;
    for (;;) {
        const bool has_next = S.next(ui + 1, nxt);
        const int nkind = has_next ? nxt.kind : cur.kind;
        const int nK2 = S.gPitch(nkind) * 2;
        const unsigned nvoA = (unsigned)(Rn * nK2 + C2), nvoB = (unsigned)((S.gPerm(nkind) ? Rp : Rn) * nK2 + C2);
        const size_t nr64 = (size_t)64 * nK2, nhstep = (size_t)HALF * nK2;
        const char* nA = has_next ? (const char*)S.gA(nkind) + (size_t)nxt.pm * 2 * nhstep + (size_t)S.gK0(nkind) * 2 : cA; const char* nB = has_next ? (const char*)S.gB(nkind) + (size_t)nxt.pn * 2 * nhstep + (size_t)S.gK0(nkind) * 2 : cB;
#pragma nounroll
        for (int t = 0; t < nt; t += 2) {
            const bool last = (t == nt - 2);
            const char* a1 = cA + (size_t)(t + 1) * kstep;
            const char* a2 = last ? nA : cA + (size_t)(t + 2) * kstep; const char* b2 = last ? nB : cB + (size_t)(t + 2) * kstep;
            const char* a3 = a2 + kstep; const char* b3 = b2 + kstep;
            const unsigned vA2 = last ? nvoA : voA, vB2 = last ? nvoB : voB; const size_t r2 = last ? nr64 : r64, h2 = last ? nhstep : hstep;
            PG8_LDB(B0, 0, 0); PG8_LDB(B1, 0, 1); PG8_SCHED; PG8_LDA(At, 0, 0); PG8_STAGE(PG8_SA(1, 1), a1 + hstep, voA, r64);
            PG8_WAIT_V(8); PG8_WAIT_L(0); PG8_BAR; PG8_MMA(0, 0, At, B0); PG8_MMA(0, 1, At, B1); PG8_BAR; PG8_SCHED;
            PG8_LDA(At, 0, 1); PG8_STAGE(PG8_SB(0, 0), b2, vB2, r2); PG8_STAGE(PG8_SB(0, 1), b2 + h2, vB2, r2); PG8_STAGE(PG8_SA(0, 0), a2, vA2, r2);
            PG8_WAIT_V(8); PG8_WAIT_L(0); PG8_BAR; PG8_MMA(1, 0, At, B0); PG8_MMA(1, 1, At, B1); PG8_BAR; PG8_SCHED;
            PG8_LDB(B0, 1, 0); PG8_LDB(B1, 1, 1); PG8_SCHED; PG8_LDA(At, 1, 0); PG8_STAGE(PG8_SA(0, 1), a2 + h2, vA2, r2);
            PG8_WAIT_V(8); PG8_WAIT_L(0); PG8_BAR; PG8_MMA(0, 0, At, B0); PG8_MMA(0, 1, At, B1); PG8_BAR; PG8_SCHED;
            PG8_LDA(At, 1, 1); PG8_STAGE(PG8_SB(1, 0), b3, vB2, r2); PG8_STAGE(PG8_SB(1, 1), b3 + h2, vB2, r2); PG8_STAGE(PG8_SA(1, 0), a3, vA2, r2);
            PG8_WAIT_V(8); PG8_WAIT_L(0); PG8_BAR; PG8_MMA(1, 0, At, B0); PG8_MMA(1, 1, At, B1); PG8_BAR; PG8_SCHED;
        }
        if (wr == 0) PG8_BAR;
        E(acc, cur.pm, cur.pn, cur.kind, wr, wc, fr, fq);
        if (!has_next) break;
#pragma unroll
        for (int a = 0; a < 2; ++a)
#pragma unroll
            for (int b = 0; b < 2; ++b)
#pragma unroll
                for (int m = 0; m < 4; ++m)
#pragma unroll
                    for (int n = 0; n < 2; ++n) acc[a][b][m][n] = (f32x4){0.f, 0.f, 0.f, 0.f};
        cur.pm = nxt.pm; cur.pn = nxt.pn; cur.kind = nxt.kind; cA = nA; cB = nB; K2 = nK2; voA = nvoA; voB = nvoB; r64 = nr64; hstep = nhstep; nt = S.gNt(nkind); ++ui;
        if (wr == 1) PG8_BAR;
    }
    PG8_WAIT_V(0);
    PG8_BAR;
#undef PG8_SA
#undef PG8_SB
#undef PG8_STAGE
#undef PG8_LDA
#undef PG8_LDB
#undef PG8_MMA
#undef PG8_WAIT_V
#undef PG8_WAIT_L
#undef PG8_BAR
#undef PG8_SCHED
}
struct SchedMerge {
    StaticOrder base; const char* a0; long da1, da2; const char* b0; long db1, db2;
    __device__ __forceinline__ bool next(int i, UnitX& u) const { Unit b; const int q = i / 3; const bool ok = base.next(q, b); u.pm = b.pm; u.pn = b.pn; u.kind = i - 3 * q; return ok; }
    __device__ __forceinline__ const bf16_t* gA(int k) const { return (const bf16_t*)(a0 + (k > 0 ? da1 : 0l) + (k > 1 ? da2 : 0l)); }
    __device__ __forceinline__ const bf16_t* gB(int k) const { return (const bf16_t*)(b0 + (k > 0 ? db1 : 0l) + (k > 1 ? db2 : 0l)); }
    __device__ __forceinline__ int gPitch(int k) const { return k == 1 ? 1024 : 512; }
    __device__ __forceinline__ int gNt(int k) const { return k == 1 ? 16 : 8; }
    __device__ __forceinline__ int gK0(int) const { return 0; }
    __device__ __forceinline__ int gPerm(int) const { return 1; }
};
struct EpiMergeAll {
    EpiMerge<0> e0; EpiMerge<1> e1; EpiMerge<2> e2;
    __device__ __forceinline__ void operator()(const f32x4 (&acc)[2][2][4][2], int pm, int pn, int kind, int wr, int wc, int fr, int fq) const {
        Unit u; u.pm = pm; u.pn = pn;
        if (kind == 0) e0(acc, u, wr, wc, fr, fq); else if (kind == 1) e1(acc, u, wr, wc, fr, fq); else e2(acc, u, wr, wc, fr, fq);
    }
};
struct SchedQKV {
    int nMq, nNq, nMk, nNk, G, c; const bf16_t* Aq; const bf16_t* Bq; const bf16_t* Ak; const bf16_t* Bk;
    __device__ __forceinline__ bool next(int i, UnitX& u) const {
        const int L = i * G + c, nq = nMq * nNq;
        Unit b; b.pm = 0; b.pn = 0; bool ok = true; int kind = 0;
        if (L < nq) StaticOrder::map_entry(nMq, nNq, L, b);
        else { const int L2 = L - nq; kind = 1; ok = L2 < nMk * nNk; if (ok) StaticOrder::map_entry(nMk, nNk, L2, b); }
        u.pm = b.pm; u.pn = b.pn; u.kind = kind; return ok;
    }
    __device__ __forceinline__ const bf16_t* gA(int k) const { return k == 0 ? Aq : Ak; }
    __device__ __forceinline__ const bf16_t* gB(int k) const { return k == 0 ? Bq : Bk; }
    __device__ __forceinline__ int gPitch(int k) const { return k == 0 ? 512 : 256; }
    __device__ __forceinline__ int gNt(int k) const { return k == 0 ? 8 : 4; }
    __device__ __forceinline__ int gK0(int) const { return 0; }
    __device__ __forceinline__ int gPerm(int k) const { return k; }
};
struct EpiQKV {
    EpiQup eq; EpiKV ek;
    __device__ __forceinline__ void operator()(const f32x4 (&acc)[2][2][4][2], int pm, int pn, int kind, int wr, int wc, int fr, int fq) const {
        Unit u; u.pm = pm; u.pn = pn;
        if (kind == 0) eq(acc, u, wr, wc, fr, fq); else ek(acc, u, wr, wc, fr, fq);
    }
};
struct SchedSplit {
    const bf16_t* A; const bf16_t* Bt; int K, nlat, nctx, G, c, wgm;
    __device__ __forceinline__ bool next(int i, UnitX& u) const {
        const int L = i * G + c; Unit b; b.pm = 0; b.pn = 0; int kind = 0; bool ok = true;
        if (L < nlat) StaticOrder::map_entry(ML_ROWS / BM, 8, L, b, wgm);
        else { const int e = L - nlat; ok = e < nctx; b.pm = ML_ROWS / BM + (e >> 5); b.pn = (e >> 2) & 7; kind = 1 + (e & 3); }
        u.pm = b.pm; u.pn = b.pn; u.kind = kind; return ok;
    }
    __device__ __forceinline__ const bf16_t* gA(int) const { return A; }
    __device__ __forceinline__ const bf16_t* gB(int) const { return Bt; }
    __device__ __forceinline__ int gPitch(int) const { return K; }
    __device__ __forceinline__ int gNt(int k) const { return k == 0 ? K / BK : K / (4 * BK); }
    __device__ __forceinline__ int gK0(int k) const { return k == 0 ? 0 : (k - 1) * (K / 4); }
    __device__ __forceinline__ int gPerm(int) const { return 0; }
};
struct EpiSplit {
    EpiResid er; float* PART;
    __device__ __forceinline__ void operator()(const f32x4 (&acc)[2][2][4][2], int pm, int pn, int kind, int wr, int wc, int fr, int fq) const {
        Unit u; u.pm = pm; u.pn = pn;
        if (kind == 0) { er(acc, u, wr, wc, fr, fq); return; }
        float* base = PART + ((size_t)(kind - 1) * 2048 + (size_t)(pm * BM - ML_ROWS + wr * 64 + fr)) * 2048 + pn * BM + wc * 32 + 4 * fq;
#pragma unroll
        for (int ai = 0; ai < 2; ++ai)
#pragma unroll
            for (int m = 0; m < 4; ++m) { float* rowp = base + (size_t)(ai * HALF + m * 16) * 2048;
#pragma unroll
                for (int bj = 0; bj < 2; ++bj)
#pragma unroll
                    for (int n = 0; n < 2; ++n) *(f32x4*)(rowp + bj * HALF + n * 16) = acc[ai][bj][m][n]; }
    }
};
}
#define XB_TMO      128
#define XB_XCNT(j)  (256  + 64 * (j))
#define XB_XSUB(j)  (1280 + 64 * (j))
#define XB_XGEN(j)  (2304 + 64 * (j))
#define XB_TOP      3328
#define XB_TOPGEN   3392
#define XCD_BAR_WORDS 3456
#define XB_SPIN_CAP (1u << 18)

__device__ __forceinline__ unsigned xb_ld(unsigned* p)              { return __hip_atomic_load(p, __ATOMIC_RELAXED, __HIP_MEMORY_SCOPE_AGENT); }
__device__ __forceinline__ unsigned xb_add(unsigned* p, unsigned v) { return __hip_atomic_fetch_add(p, v, __ATOMIC_RELAXED, __HIP_MEMORY_SCOPE_AGENT); }
__device__ __forceinline__ unsigned xb_xcc_id() { return (unsigned)__builtin_amdgcn_s_getreg((3 << 11) | 20) & 0xFu; }
#define XB_SPIN(cond, bar) do { unsigned _sp = 0; while (cond) { __builtin_amdgcn_s_sleep(1); \
    if ((++_sp & 255u) == 0u) { if (xb_ld(&(bar)[XB_TMO])) break; if (_sp > XB_SPIN_CAP) { atomicAdd(&(bar)[XB_TMO], 1u); break; } } } } while (0)

struct XcdBarrier {
    unsigned* bar; unsigned x;
    volatile LAS unsigned* st;
};

__device__ __forceinline__ XcdBarrier xcd_barrier_post(unsigned* bar, volatile LAS unsigned* st) {
    XcdBarrier b; b.bar = bar; b.x = xb_xcc_id(); b.st = st;
    if (threadIdx.x == 0) (void)xb_add(&bar[XB_XCNT(b.x)], 1u);
    return b;
}
__device__ __forceinline__ void xcd_barrier_complete(unsigned* bar, unsigned x, unsigned& nloc, unsigned& nx) {
    const unsigned G = gridDim.x * gridDim.y * gridDim.z;
    unsigned sum, cnt, mine, sp = 0u;
    for (;;) {
        sum = 0u; cnt = 0u; mine = 0u;
#pragma unroll
        for (unsigned j = 0; j < 16; ++j) { const unsigned c = xb_ld(&bar[XB_XCNT(j)]); sum += c; cnt += (c > 0u) ? 1u : 0u; mine = (j == x) ? c : mine; }
        if (sum == G) break;
        __builtin_amdgcn_s_sleep(1);
        if ((++sp & 255u) == 0u) { if (xb_ld(&bar[XB_TMO])) break; if (sp > XB_SPIN_CAP) { atomicAdd(&bar[XB_TMO], 1u); break; } }
    }
    nloc = mine > 0u ? mine : 1u; nx = cnt > 0u ? cnt : 1u;
}

__device__ __forceinline__ void xcd_barrier(const XcdBarrier& b) {
    asm volatile("s_waitcnt vmcnt(0)" ::: "memory");
    __syncthreads();
    if (threadIdx.x == 0) {
        unsigned* bar = b.bar;
        __builtin_amdgcn_s_waitcnt(0);
        unsigned nloc = b.st[0], nx = b.st[1];
        if (nloc == 0u) { xcd_barrier_complete(bar, b.x, nloc, nx); b.st[0] = nloc; b.st[1] = nx; }
        const unsigned old = xb_add(&bar[XB_XSUB(b.x)], 1u);
        const unsigned gen = old / nloc;
        if (old + 1u == (gen + 1u) * nloc) {
            __builtin_amdgcn_fence(__ATOMIC_RELEASE, "agent");
            asm volatile("s_waitcnt vmcnt(0)" ::: "memory");
            const unsigned og = xb_add(&bar[XB_TOP], 1u);
            const unsigned tg = og / nx;
            if (og + 1u == (tg + 1u) * nx) xb_add(&bar[XB_TOPGEN], 1u);
            else XB_SPIN(xb_ld(&bar[XB_TOPGEN]) == tg, bar);
            __builtin_amdgcn_fence(__ATOMIC_ACQUIRE, "agent");
            xb_add(&bar[XB_XGEN(b.x)], 1u);
            asm volatile("s_waitcnt vmcnt(0)" ::: "memory");
        } else {
            XB_SPIN(xb_ld(&bar[XB_XGEN(b.x)]) == gen, bar);
            __builtin_amdgcn_fence(__ATOMIC_ACQUIRE, "agent");
            asm volatile("s_waitcnt vmcnt(0)" ::: "memory");
        }
    }
    __syncthreads();
}
#ifndef ATT_ILV
#define ATT_ILV 1
#endif
#ifndef ATT_DMAW
#define ATT_DMAW 4
#endif
#ifndef ATT_YOUNG_FROM
#define ATT_YOUNG_FROM (ATT_ILV ? 512 : 256)
#endif
namespace att {
typedef unsigned short bf16_t;
using bf16x8 = __attribute__((ext_vector_type(8))) short;
using s16x4  = __attribute__((ext_vector_type(4))) short;
using f32x16 = __attribute__((ext_vector_type(16))) float;
using u32x4  = __attribute__((ext_vector_type(4))) unsigned;
typedef LAS char lchar;
#define ASBAR() __builtin_amdgcn_sched_barrier(0)
__device__ __forceinline__ int crow(int r, int hi) { return (r & 3) + 8 * (r >> 2) + 4 * hi; }
__device__ __forceinline__ unsigned cvtpk(float lo, float hi) { return pg8::cvt_pk_bf16(lo, hi); }
template <int DK> __device__ __forceinline__ int koff(int row, int chunk) {
    return row * (DK * 2) + ((chunk & ~7) << 4) + (((chunk & 7) ^ ((row >> 1) & 7)) << 4);
}
template <int DV> __device__ __forceinline__ int v_st(int k, int c) { constexpr int NCB = DV / 32; const int kk = (k & ~0xC) | ((k & 4) << 1) | ((k & 8) >> 1); return ((kk >> 3) * NCB + (c >> 5)) * 512 + ((kk & 7) * 32 + (c & 31)) * 2; }
__device__ __forceinline__ int v_rd_base(int lane) { return ((lane & 3) << 3) | (((lane >> 2) & 3) << 6) | (((lane >> 4) & 1) << 5) | (((lane >> 5) & 1) << 8); }
template <int DV> constexpr int v_rd_off(int d0, int ks, int half) { return d0 * 512 + ks * (2 * (DV / 32) * 512) + half * ((DV / 32) * 512); }
#if ATT_ILV
template <int OFF> __device__ __forceinline__ s16x4 tr_read(int vb) { return __builtin_amdgcn_ds_read_tr16_b64_v4i16((LAS s16x4*)(unsigned)(vb + OFF)); }
#else
template <int OFF> __device__ __forceinline__ s16x4 tr_read(int vb) { s16x4 r; asm volatile("ds_read_b64_tr_b16 %0, %1 offset:%2" : "=&v"(r) : "v"(vb), "i"(OFF) : "memory"); return r; }
#endif

__device__ __forceinline__ void glds16(const void* gsrc, unsigned lds_dst) { unsigned keep; lds_dst = __builtin_amdgcn_readfirstlane(lds_dst);
    asm volatile("s_mov_b32 %0, m0\n\ts_mov_b32 m0, %2\n\ts_nop 0\n\tglobal_load_lds_dwordx4 %1, off\n\ts_mov_b32 m0, %0" : "=&s"(keep) : "v"(gsrc), "s"(lds_dst) : "memory"); }
__device__ __forceinline__ void glds16s(const void* sbase, unsigned voff, unsigned lds_dst) { unsigned keep; lds_dst = __builtin_amdgcn_readfirstlane(lds_dst);
    const unsigned long long b = (unsigned long long)sbase; const unsigned blo = __builtin_amdgcn_readfirstlane((unsigned)b), bhi = __builtin_amdgcn_readfirstlane((unsigned)(b >> 32));
    const unsigned long long sb = ((unsigned long long)bhi << 32) | blo;
    asm volatile("s_mov_b32 %0, m0\n\ts_mov_b32 m0, %3\n\ts_nop 0\n\tglobal_load_lds_dwordx4 %1, %2\n\ts_mov_b32 m0, %0" : "=&s"(keep) : "v"(voff), "s"(sb), "s"(lds_dst) : "memory"); }
template <bool WIN>
__device__ __forceinline__ void partialSM(f32x16& p0, f32x16& p1, float& m_reg, float& mn, float& alpha, const float C, const float thr, const bool domask, const int dq, const int hi) {
#if ATT_ILV
    if constexpr (WIN) { const int dqq = domask ? dq : 0;
#pragma unroll
        for (int r = 0; r < 16; ++r) { const int d0 = dqq + crow(r, hi), d1 = d0 + 32; p0[r] = (d0 > 128 || d0 < -128) ? -1e30f : p0[r]; p1[r] = (d1 > 128 || d1 < -128) ? -1e30f : p1[r]; } }
#else
    if constexpr (WIN) { if (domask) {
#pragma unroll
        for (int r = 0; r < 16; ++r) { const int d0 = dq + crow(r, hi), d1 = d0 + 32; if (d0 > 128 || d0 < -128) p0[r] = -1e30f; if (d1 > 128 || d1 < -128) p1[r] = -1e30f; } } }
#endif
    float pmax = p0[0];
#pragma unroll
    for (int r = 1; r < 16; ++r) pmax = fmaxf(pmax, p0[r]);
#pragma unroll
    for (int r = 0; r < 16; ++r) pmax = fmaxf(pmax, p1[r]);
    { auto rr = __builtin_amdgcn_permlane32_swap(__float_as_uint(pmax), __float_as_uint(pmax), false, false); pmax = fmaxf(__uint_as_float(rr[0]), __uint_as_float(rr[1])); }
#if ATT_ILV
    { const bool keep = __all(pmax - m_reg <= thr); mn = fmaxf(m_reg, keep ? m_reg : pmax); alpha = __builtin_amdgcn_exp2f((m_reg - mn) * C); m_reg = mn; }
#else
    if (__builtin_expect(__all(pmax - m_reg <= thr), 1)) { mn = m_reg; alpha = 1.f; }
    else { mn = fmaxf(m_reg, pmax); alpha = __builtin_amdgcn_exp2f((m_reg - mn) * C); m_reg = mn; }
#endif
    const float mnC = -mn * C;
#pragma unroll
    for (int r = 0; r < 16; ++r) p0[r] = fmaf(p0[r], C, mnC);
#pragma unroll
    for (int r = 0; r < 16; ++r) p1[r] = fmaf(p1[r], C, mnC);
#pragma unroll
    for (int r = 0; r < 16; ++r) p0[r] = __builtin_amdgcn_exp2f(p0[r]);
}
__device__ __forceinline__ void finishSM(f32x16& p0, f32x16& p1, float alpha, float& l_reg, bf16x8& pa0, bf16x8& pa1, bf16x8& pa2, bf16x8& pa3) {
#pragma unroll
    for (int r = 0; r < 16; ++r) p1[r] = __builtin_amdgcn_exp2f(p1[r]);
    float ps = 0;
#pragma unroll
    for (int r = 0; r < 16; ++r) ps += p0[r];
#pragma unroll
    for (int r = 0; r < 16; ++r) ps += p1[r];
    { auto rr = __builtin_amdgcn_permlane32_swap(__float_as_uint(ps), __float_as_uint(ps), false, false); ps = __uint_as_float(rr[0]) + __uint_as_float(rr[1]); }
    l_reg = l_reg * alpha + ps;
#define ATT_PK4(P, BASE, OUT) do { unsigned a0 = cvtpk(P[BASE + 0], P[BASE + 1]), a1 = cvtpk(P[BASE + 2], P[BASE + 3]);   \
    unsigned b0 = cvtpk(P[BASE + 4], P[BASE + 5]), b1 = cvtpk(P[BASE + 6], P[BASE + 7]);                              \
    auto r0 = __builtin_amdgcn_permlane32_swap(a0, b0, false, false); auto r1 = __builtin_amdgcn_permlane32_swap(a1, b1, false, false); \
    u32x4 w = {r0[0], r1[0], r0[1], r1[1]}; OUT = *reinterpret_cast<bf16x8*>(&w); } while (0)
    ATT_PK4(p0, 0, pa0); ATT_PK4(p0, 8, pa1); ATT_PK4(p1, 0, pa2); ATT_PK4(p1, 8, pa3);
#undef ATT_PK4
}
template <int DK> __device__ __forceinline__ void qkt(f32x16& p0, f32x16& p1, const lchar* Ks, const bf16x8 (&qr)[DK / 16], const int (&kq)[4]) {
    p0 = f32x16{}; p1 = f32x16{};
    bf16x8 c0 = *(const LAS bf16x8*)(Ks + kq[0]), c1 = *(const LAS bf16x8*)(Ks + kq[0] + 32 * DK * 2);
#pragma unroll
    for (int d0 = 0; d0 < DK / 16; ++d0) {
        bf16x8 n0 = c0, n1 = c1;
        if (d0 + 1 < DK / 16) { n0 = *(const LAS bf16x8*)(Ks + kq[(d0 + 1) & 3] + ((d0 + 1) >> 2) * 128); n1 = *(const LAS bf16x8*)(Ks + kq[(d0 + 1) & 3] + ((d0 + 1) >> 2) * 128 + 32 * DK * 2); }
        p0 = __builtin_amdgcn_mfma_f32_32x32x16_bf16(c0, qr[d0], p0, 0, 0, 0);
        p1 = __builtin_amdgcn_mfma_f32_32x32x16_bf16(c1, qr[d0], p1, 0, 0, 0);
        c0 = n0; c1 = n1; }
}
struct VFrag { s16x4 l0, h0, l1, h1, l2, h2, l3, h3; };
template <int DV, int D0> __device__ __forceinline__ void pv_reads(VFrag& f, int vb) {
    f.l0 = tr_read<v_rd_off<DV>(D0, 0, 0)>(vb); f.h0 = tr_read<v_rd_off<DV>(D0, 0, 1)>(vb); f.l1 = tr_read<v_rd_off<DV>(D0, 1, 0)>(vb); f.h1 = tr_read<v_rd_off<DV>(D0, 1, 1)>(vb);
    f.l2 = tr_read<v_rd_off<DV>(D0, 2, 0)>(vb); f.h2 = tr_read<v_rd_off<DV>(D0, 2, 1)>(vb); f.l3 = tr_read<v_rd_off<DV>(D0, 3, 0)>(vb); f.h3 = tr_read<v_rd_off<DV>(D0, 3, 1)>(vb);
}
__device__ __forceinline__ void pv_mma(f32x16& od, const VFrag& f, bf16x8 pa0, bf16x8 pa1, bf16x8 pa2, bf16x8 pa3) {
#define ATT_PK(L, H) (bf16x8){L[0], L[1], L[2], L[3], H[0], H[1], H[2], H[3]}
    od = __builtin_amdgcn_mfma_f32_32x32x16_bf16(pa0, ATT_PK(f.l0, f.h0), od, 0, 0, 0);
    od = __builtin_amdgcn_mfma_f32_32x32x16_bf16(pa1, ATT_PK(f.l1, f.h1), od, 0, 0, 0);
    od = __builtin_amdgcn_mfma_f32_32x32x16_bf16(pa2, ATT_PK(f.l2, f.h2), od, 0, 0, 0);
    od = __builtin_amdgcn_mfma_f32_32x32x16_bf16(pa3, ATT_PK(f.l3, f.h3), od, 0, 0, 0);
#undef ATT_PK
}
#define ATT_LWAIT(n) do { asm volatile("s_waitcnt lgkmcnt(" #n ")" ::: "memory"); ASBAR(); } while (0)
#if ATT_ILV
template <int DV> __device__ __forceinline__ void pv_all(f32x16 (&o)[DV / 32], int vb, bf16x8 pa0, bf16x8 pa1, bf16x8 pa2, bf16x8 pa3) {
    { VFrag f; pv_reads<DV, 0>(f, vb); pv_mma(o[0], f, pa0, pa1, pa2, pa3); }
    { VFrag f; pv_reads<DV, 1>(f, vb); pv_mma(o[1], f, pa0, pa1, pa2, pa3); }
    if constexpr (DV == 128) {
        { VFrag f; pv_reads<DV, 2>(f, vb); pv_mma(o[2], f, pa0, pa1, pa2, pa3); }
        { VFrag f; pv_reads<DV, 3>(f, vb); pv_mma(o[3], f, pa0, pa1, pa2, pa3); } }
}
#define ATT_SWAP(A, B) __builtin_amdgcn_permlane32_swap((A), (B), false, false)
#define ATT_PIN(X) asm volatile("" : "+v"(X))
template <int PT, int B> __device__ __forceinline__ void pk_step(const f32x16& P, unsigned& a0, unsigned& a1, unsigned& b0, unsigned& b1, unsigned& x0, unsigned& y0, bf16x8& OUT) {
    if constexpr (PT == 0) { a0 = cvtpk(P[B + 0], P[B + 1]); b0 = cvtpk(P[B + 4], P[B + 5]); }
    if constexpr (PT == 1) { a1 = cvtpk(P[B + 2], P[B + 3]); b1 = cvtpk(P[B + 6], P[B + 7]); }
    if constexpr (PT == 2) { auto r0 = ATT_SWAP(a0, b0); x0 = r0[0]; y0 = r0[1]; }
    if constexpr (PT == 3) { auto r1 = ATT_SWAP(a1, b1); u32x4 w = {x0, r1[0], y0, r1[1]}; OUT = *reinterpret_cast<bf16x8*>(&w); }
}
template <int K> __device__ __forceinline__ void fin_atom(f32x16& q0, f32x16& q1, float alpha, float& l_reg, float& ps0, float& ps1, unsigned& a0, unsigned& a1, unsigned& b0, unsigned& b1, unsigned& x0, unsigned& y0,
                                                          bf16x8& pa0, bf16x8& pa1, bf16x8& pa2, bf16x8& pa3) {
    if constexpr (K < 16) { q1[K] = __builtin_amdgcn_exp2f(q1[K]); ATT_PIN(q1[K]); ps0 += q0[K]; ATT_PIN(ps0); }
    if constexpr (K >= 8) { ps1 += q1[K - 8]; ATT_PIN(ps1); }
    if constexpr (K < 4) pk_step<K & 3, 0>(q0, a0, a1, b0, b1, x0, y0, pa0);
    else if constexpr (K < 8) pk_step<K & 3, 8>(q0, a0, a1, b0, b1, x0, y0, pa1);
    else if constexpr (K >= 16 && K < 20) pk_step<K & 3, 0>(q1, a0, a1, b0, b1, x0, y0, pa2);
    else if constexpr (K >= 20) pk_step<K & 3, 8>(q1, a0, a1, b0, b1, x0, y0, pa3);
    if constexpr (K == 23) { float ps = ps0 + ps1; auto rr = ATT_SWAP(__float_as_uint(ps), __float_as_uint(ps)); ps = __uint_as_float(rr[0]) + __uint_as_float(rr[1]); l_reg = l_reg * alpha + ps; }
}
template <int I, int NM, int DK> __device__ __forceinline__ void qk_step(f32x16& p0, f32x16& p1, const lchar* Ks, const bf16x8 (&qr)[DK / 16], const int (&kq)[4], bf16x8 (&F)[4],
        f32x16& q0, f32x16& q1, float alpha, float& l_reg, float& ps0, float& ps1, unsigned& a0, unsigned& a1, unsigned& b0, unsigned& b1, unsigned& x0, unsigned& y0, bf16x8& pa0, bf16x8& pa1, bf16x8& pa2, bf16x8& pa3) {
    constexpr int d0 = I >> 1, APG = 24 / NM;
    if constexpr (I == 0) p0 = __builtin_amdgcn_mfma_f32_32x32x16_bf16(F[0], qr[0], f32x16{}, 0, 0, 0);
    else if constexpr (I == 1) p1 = __builtin_amdgcn_mfma_f32_32x32x16_bf16(F[1], qr[0], f32x16{}, 0, 0, 0);
    else if constexpr ((I & 1) == 0) p0 = __builtin_amdgcn_mfma_f32_32x32x16_bf16(F[I & 3], qr[d0], p0, 0, 0, 0);
    else p1 = __builtin_amdgcn_mfma_f32_32x32x16_bf16(F[I & 3], qr[d0], p1, 0, 0, 0);
    if constexpr (I + 4 < NM) { constexpr int J = I + 4, e0 = J >> 1; F[I & 3] = *(const LAS bf16x8*)(Ks + kq[e0 & 3] + (e0 >> 2) * 128 + (J & 1) * (32 * DK * 2)); }
    fin_atom<APG * I>(q0, q1, alpha, l_reg, ps0, ps1, a0, a1, b0, b1, x0, y0, pa0, pa1, pa2, pa3);
    if constexpr (APG >= 2) fin_atom<APG * I + 1>(q0, q1, alpha, l_reg, ps0, ps1, a0, a1, b0, b1, x0, y0, pa0, pa1, pa2, pa3);
    if constexpr (APG >= 3) fin_atom<APG * I + 2>(q0, q1, alpha, l_reg, ps0, ps1, a0, a1, b0, b1, x0, y0, pa0, pa1, pa2, pa3);
    ASBAR();
    if constexpr (I + 1 < NM) qk_step<I + 1, NM, DK>(p0, p1, Ks, qr, kq, F, q0, q1, alpha, l_reg, ps0, ps1, a0, a1, b0, b1, x0, y0, pa0, pa1, pa2, pa3);
}
template <int DK> __device__ __forceinline__ void qkt_fin(f32x16& p0, f32x16& p1, const lchar* Ks, const bf16x8 (&qr)[DK / 16], const int (&kq)[4],
        f32x16& q0, f32x16& q1, float alpha, float& l_reg, bf16x8& pa0, bf16x8& pa1, bf16x8& pa2, bf16x8& pa3) {
    constexpr int NM = DK / 8;
    bf16x8 F[4];
#pragma unroll
    for (int i = 0; i < 4; ++i) F[i] = *(const LAS bf16x8*)(Ks + kq[(i >> 1) & 3] + ((i >> 1) >> 2) * 128 + (i & 1) * (32 * DK * 2));
    float ps0 = 0.f, ps1 = 0.f; unsigned a0 = 0, a1 = 0, b0 = 0, b1 = 0, x0 = 0, y0 = 0;
    ASBAR();
    qk_step<0, NM, DK>(p0, p1, Ks, qr, kq, F, q0, q1, alpha, l_reg, ps0, ps1, a0, a1, b0, b1, x0, y0, pa0, pa1, pa2, pa3);
}
template <int K, bool WIN> __device__ __forceinline__ void par_atom(f32x16& p0, f32x16& p1, float& m_reg, float& mn, float& alpha, const float C, const float thr, const int dqq, const int hi,
                                                                    float& pm0, float& pm1, float& pm2, float& pm3, float& mnC) {
    if constexpr (K < 4) { f32x16& P = (K < 2) ? p0 : p1; constexpr int B = (K & 1) * 8;
        if constexpr (WIN) {
#pragma unroll
            for (int r = B; r < B + 8; ++r) { const int d = dqq + crow(r, hi) + (K < 2 ? 0 : 32); P[r] = (d > 128 || d < -128) ? -1e30f : P[r]; } }
        const float m = fmaxf(fmaxf(fmaxf(P[B], P[B + 1]), fmaxf(P[B + 2], P[B + 3])), fmaxf(fmaxf(P[B + 4], P[B + 5]), fmaxf(P[B + 6], P[B + 7])));
        if constexpr (K == 0) pm0 = m; else if constexpr (K == 1) pm1 = m; else if constexpr (K == 2) pm2 = m; else pm3 = m; }
    if constexpr (K == 4) { float pmax = fmaxf(fmaxf(pm0, pm1), fmaxf(pm2, pm3));
        auto rr = ATT_SWAP(__float_as_uint(pmax), __float_as_uint(pmax)); pmax = fmaxf(__uint_as_float(rr[0]), __uint_as_float(rr[1]));
        const bool keep = __all(pmax - m_reg <= thr); mn = fmaxf(m_reg, keep ? m_reg : pmax); alpha = __builtin_amdgcn_exp2f((m_reg - mn) * C); m_reg = mn; mnC = -mn * C; }
    if constexpr (K >= 5 && K <= 8) { f32x16& P = (K < 7) ? p0 : p1; constexpr int B = ((K - 5) & 1) * 8;
#pragma unroll
        for (int r = B; r < B + 8; ++r) { P[r] = fmaf(P[r], C, mnC); ATT_PIN(P[r]); } }
    if constexpr (K >= 8) { p0[2 * (K - 8)] = __builtin_amdgcn_exp2f(p0[2 * (K - 8)]); p0[2 * (K - 8) + 1] = __builtin_amdgcn_exp2f(p0[2 * (K - 8) + 1]); ATT_PIN(p0[2 * (K - 8)]); ATT_PIN(p0[2 * (K - 8) + 1]); }
}
template <int I, int NM, int DV, bool WIN> __device__ __forceinline__ void pv_step(f32x16 (&o)[DV / 32], const int vb, const bf16x8 (&pa)[4], s16x4 (&L)[4], s16x4 (&H)[4],
        f32x16& p0, f32x16& p1, float& m_reg, float& mn, float& alpha, const float C, const float thr, const int dqq, const int hi, float& pm0, float& pm1, float& pm2, float& pm3, float& mnC) {
    constexpr int b = I >> 2, k = I & 3, APG = 16 / NM;
    { const s16x4 l = L[k], h = H[k]; o[b] = __builtin_amdgcn_mfma_f32_32x32x16_bf16(pa[k], (bf16x8){l[0], l[1], l[2], l[3], h[0], h[1], h[2], h[3]}, o[b], 0, 0, 0); }
    if constexpr (b + 1 < DV / 32) { L[k] = tr_read<v_rd_off<DV>(b + 1, k, 0)>(vb); H[k] = tr_read<v_rd_off<DV>(b + 1, k, 1)>(vb); }
    par_atom<APG * I, WIN>(p0, p1, m_reg, mn, alpha, C, thr, dqq, hi, pm0, pm1, pm2, pm3, mnC);
    if constexpr (APG >= 2) par_atom<APG * I + 1, WIN>(p0, p1, m_reg, mn, alpha, C, thr, dqq, hi, pm0, pm1, pm2, pm3, mnC);
    ASBAR();
    if constexpr (I + 1 < NM) pv_step<I + 1, NM, DV, WIN>(o, vb, pa, L, H, p0, p1, m_reg, mn, alpha, C, thr, dqq, hi, pm0, pm1, pm2, pm3, mnC);
}
template <int DV, bool WIN> __device__ __forceinline__ void pv_part(f32x16 (&o)[DV / 32], const int vb, bf16x8 pa0, bf16x8 pa1, bf16x8 pa2, bf16x8 pa3,
        f32x16& p0, f32x16& p1, float& m_reg, float& mn, float& alpha, const float C, const float thr, const bool domask, const int dq, const int hi) {
    constexpr int NM = DV / 8;
    const bf16x8 pa[4] = {pa0, pa1, pa2, pa3}; s16x4 L[4], H[4];
    L[0] = tr_read<v_rd_off<DV>(0, 0, 0)>(vb); H[0] = tr_read<v_rd_off<DV>(0, 0, 1)>(vb); L[1] = tr_read<v_rd_off<DV>(0, 1, 0)>(vb); H[1] = tr_read<v_rd_off<DV>(0, 1, 1)>(vb);
    L[2] = tr_read<v_rd_off<DV>(0, 2, 0)>(vb); H[2] = tr_read<v_rd_off<DV>(0, 2, 1)>(vb); L[3] = tr_read<v_rd_off<DV>(0, 3, 0)>(vb); H[3] = tr_read<v_rd_off<DV>(0, 3, 1)>(vb);
    float pm0 = 0.f, pm1 = 0.f, pm2 = 0.f, pm3 = 0.f, mnC = 0.f; const int dqq = domask ? dq : 0;
    ASBAR();
    pv_step<0, NM, DV, WIN>(o, vb, pa, L, H, p0, p1, m_reg, mn, alpha, C, thr, dqq, hi, pm0, pm1, pm2, pm3, mnC);
}
#else
template <int NM, int ND, int NV> __device__ __forceinline__ void sgb_pattern() {}
template <int DV> __device__ __forceinline__ void pv_all(f32x16 (&o)[DV / 32], int vb, bf16x8 pa0, bf16x8 pa1, bf16x8 pa2, bf16x8 pa3) {
    VFrag f;
    pv_reads<DV, 0>(f, vb); ATT_LWAIT(0); pv_mma(o[0], f, pa0, pa1, pa2, pa3);
    pv_reads<DV, 1>(f, vb); ATT_LWAIT(0); pv_mma(o[1], f, pa0, pa1, pa2, pa3);
    if constexpr (DV == 128) {
        pv_reads<DV, 2>(f, vb); ATT_LWAIT(0); pv_mma(o[2], f, pa0, pa1, pa2, pa3);
        pv_reads<DV, 3>(f, vb); ATT_LWAIT(0); pv_mma(o[3], f, pa0, pa1, pa2, pa3); }
}
#endif
template <int DK, int DV, bool WIN, bool SINK, int MODE>
__device__ __forceinline__ void attn_unit(const bf16_t* __restrict__ Qb, const int ldq, const bf16_t* __restrict__ Kb, const int ldk, const bf16_t* __restrict__ Vb, const int ldv,
                                          bf16_t* __restrict__ Ob, const int ldo, const int cbase, const int lbase, const int NT, const int qpos0, const int kpos0, const float sinkl2, lchar* lds) {
    constexpr int KI = DK / 64, VI = DV / 64, ND = DK / 16, NO = DV / 32, SHM_K = 64 * DK * 2, SHM_V = 64 * DV * 2;
    constexpr float SCALE = (DK == 192) ? 0.07216878364870322f : 0.125f, C = SCALE * 1.4426950408889634f, THRR = 8.0f / SCALE;
    int tid_ = threadIdx.x; asm volatile("" : "+v"(tid_));
    const int tid = tid_, wid = tid >> 6, lane = tid & 63, r32 = lane & 31, hi = lane >> 5;
    constexpr int NSLOT = (MODE == 2) ? 3 : 2;
    lchar* V_lds = lds; lchar* K_lds = lds + NSLOT * SHM_V;
    LAS float* wsf = (LAS float*)(lds + NSLOT * SHM_V + NSLOT * SHM_K) + wid * 64; LAS float* li_l = wsf; LAS float* al_l = wsf + 32;
    float m_reg = -1e30f, l_reg = 0.f; f32x16 o[NO]; bf16x8 qr[ND];
#pragma unroll
    for (int d = 0; d < NO; ++d) o[d] = f32x16{};
    const bf16_t* Qw = Qb + (long)(wid * 32 + r32) * ldq + hi * 8;
#pragma unroll
    for (int d0 = 0; d0 < ND; ++d0) qr[d0] = *(const bf16x8*)(Qw + d0 * 16);
    const int srow = tid >> 3, scg = tid & 7;
    const int kgo = srow * ldk + scg * 8, vgo = srow * ldv + scg * 8;
    int klo[KI];
#pragma unroll
    for (int i = 0; i < KI; ++i) klo[i] = koff<DK>(srow, scg + 8 * i);
    const int vlo = v_st<DV>(srow, scg * 8);
    const int vb0 = (int)(uintptr_t)V_lds + v_rd_base(lane);
    const int qpos = qpos0 + wid * 32 + r32;
    int kq[4];
#pragma unroll
    for (int k = 0; k < 4; ++k) kq[k] = r32 * (DK * 2) + (((2 * k) ^ hi ^ ((r32 >> 1) & 7)) << 4);
    bf16x8 ks[KI], vs[VI];
#define ATT_ROWOF(j) ((j) < 4 ? cbase + 64 * (j) : lbase + 64 * ((j) - 4))
#define ATT_SLOAD(j) do { const long rb_ = ATT_ROWOF(j); const bf16_t* kp_ = Kb + rb_ * ldk + kgo; const bf16_t* vp_ = Vb + rb_ * ldv + vgo; \
    _Pragma("unroll") for (int i_ = 0; i_ < KI; ++i_) ks[i_] = *(const bf16x8*)(kp_ + 64 * i_); \
    _Pragma("unroll") for (int i_ = 0; i_ < VI; ++i_) vs[i_] = *(const bf16x8*)(vp_ + 64 * i_); } while (0)
#define ATT_SWRITE(b) do { _Pragma("unroll") for (int i_ = 0; i_ < KI; ++i_) *(LAS bf16x8*)(K_lds + (b) * SHM_K + klo[i_]) = ks[i_]; \
    _Pragma("unroll") for (int i_ = 0; i_ < VI; ++i_) *(LAS bf16x8*)(V_lds + (b) * SHM_V + vlo + i_ * 1024) = vs[i_]; } while (0)
#define ATT_RESC(a) do { if (__any((a) < 1.f)) { if (hi == 0) al_l[r32] = (a); asm volatile("s_waitcnt lgkmcnt(0)" ::: "memory"); \
    _Pragma("unroll") for (int d_ = 0; d_ < NO; ++d_) _Pragma("unroll") for (int r_ = 0; r_ < 16; ++r_) o[d_][r_] *= al_l[crow(r_, hi)]; } } while (0)
#define ATT_DQ(j) (kpos0 + 64 * ((j) - 4) - qpos)
    f32x16 pA0, pA1, pB0, pB1; float mnA, mnB, alA, alB; bf16x8 pa0, pa1, pa2, pa3;
    __syncthreads();
    if constexpr (MODE == 2) {
        const int wu = __builtin_amdgcn_readfirstlane(wid);
        constexpr int DW = ATT_DMAW, KP = KI * 8 / DW, VP = VI * 8 / DW;
        const bool dmaw = wu < DW;
        int kgs[KP], vgs[VP];
#pragma unroll
        for (int i = 0; i < KP; ++i) { const int p = (wu * KP + i) * 64 + lane, kr = p / (DK / 8), c2 = p % (DK / 8); kgs[i] = kr * ldk + (((c2 & ~7) | ((c2 & 7) ^ ((kr >> 1) & 7))) << 3); }
#pragma unroll
        for (int i = 0; i < VP; ++i) { const int u16 = (wu * VP + i) * 64 + lane, st = u16 >> 5, kk = (st / (DV / 32)) * 8 + ((u16 >> 2) & 7), c = (st % (DV / 32)) * 32 + (u16 & 3) * 8;
            const int k = (kk & ~0xC) | ((kk & 4) << 1) | ((kk & 8) >> 1); vgs[i] = k * ldv + c; }
        const unsigned kl0 = (unsigned)(uintptr_t)K_lds + (unsigned)(wu * KP) * 1024u, vl0 = (unsigned)(uintptr_t)V_lds + (unsigned)(wu * VP) * 1024u;
#define ATT_DMAK(j, slot) do { const bf16_t* kp_ = Kb + (long)ATT_ROWOF(j) * ldk; if (dmaw) { _Pragma("unroll") for (int i_ = 0; i_ < KP; ++i_) glds16s(kp_, (unsigned)kgs[i_] * 2u, kl0 + (unsigned)(slot) * SHM_K + i_ * 1024); } } while (0)
#define ATT_DMAV(j, slot) do { const bf16_t* vp_ = Vb + (long)ATT_ROWOF(j) * ldv; if (dmaw) { _Pragma("unroll") for (int i_ = 0; i_ < VP; ++i_) glds16s(vp_, (unsigned)vgs[i_] * 2u, vl0 + (unsigned)(slot) * SHM_V + i_ * 1024); } } while (0)
#define ATT_WAITN(n) asm volatile("s_waitcnt vmcnt(" #n ") lgkmcnt(0)" ::: "memory")
#define ATT_WAIT1() do { if constexpr (KP + VP == 10) ATT_WAITN(10); else if constexpr (KP + VP == 5) ATT_WAITN(5); else if constexpr (KP + VP == 4) ATT_WAITN(4); else { static_assert(KP + VP == 2); ATT_WAITN(2); } } while (0)
#define ATT_WAIT2() do { if constexpr (KP + VP == 10) ATT_WAITN(20); else if constexpr (KP + VP == 5) ATT_WAITN(10); else if constexpr (KP + VP == 4) ATT_WAITN(8); else ATT_WAITN(4); } while (0)
#define ATT_SYNC(j) do { const int sp_ = (sc == 0) ? 2 : sc - 1; if ((j) + 2 < NT) ATT_WAIT1(); else ATT_WAITN(0); \
        __builtin_amdgcn_s_barrier(); asm volatile("" ::: "memory"); \
        if ((j) + 3 < NT) ATT_DMAK((j) + 3, sc); if ((j) + 2 < NT) ATT_DMAV((j) + 2, sp_); } while (0)
#define ATT_STEP_OLD(j, PC0, PC1, MNC, ALC, PP0, PP1, MNP, ALP) do { const int spv_ = (sc == 0) ? 2 : sc - 1; \
        ASBAR(); qkt_fin<DK>(PC0, PC1, K_lds + sc * SHM_K, qr, kq, PP0, PP1, ALP, l_reg, pa0, pa1, pa2, pa3); \
        pv_part<DV, WIN>(o, vb0 + spv_ * SHM_V, pa0, pa1, pa2, pa3, PC0, PC1, m_reg, MNC, ALC, C, THRR, (j) >= 4, ATT_DQ(j), hi); \
        ATT_SYNC(j); ATT_RESC(ALC); sc = (sc == 2) ? 0 : sc + 1; } while (0)
#define ATT_STEP_YNG(j, PC0, PC1, MNC, ALC, PP0, PP1, MNP, ALP) do { const int spv_ = (sc == 0) ? 2 : sc - 1; \
        partialSM<WIN>(PP0, PP1, m_reg, MNP, ALP, C, THRR, (j) - 1 >= 4, ATT_DQ((j) - 1), hi); ATT_RESC(ALP); \
        ASBAR(); qkt<DK>(PC0, PC1, K_lds + sc * SHM_K, qr, kq); \
        finishSM(PP0, PP1, ALP, l_reg, pa0, pa1, pa2, pa3); ASBAR(); \
        pv_all<DV>(o, vb0 + spv_ * SHM_V, pa0, pa1, pa2, pa3); \
        ATT_SYNC(j); sc = (sc == 2) ? 0 : sc + 1; } while (0)
        const bool young = (ATT_YOUNG_FROM < 512) && __builtin_amdgcn_readfirstlane(tid) >= ATT_YOUNG_FROM;
        ATT_WAITN(0); __builtin_amdgcn_s_barrier(); asm volatile("" ::: "memory");
        ATT_DMAK(0, 0); ATT_DMAK(1, 1); ATT_DMAV(0, 0); ATT_DMAK(2, 2); ATT_DMAV(1, 1);
        ATT_WAIT2(); __builtin_amdgcn_s_barrier(); asm volatile("" ::: "memory");
        int sc = 0;
        if (young) {
            qkt<DK>(pA0, pA1, K_lds, qr, kq);
            ATT_SYNC(0); sc = 1;
            for (int j = 1; j + 1 < NT; j += 2) {
                ATT_STEP_YNG(j, pB0, pB1, mnB, alB, pA0, pA1, mnA, alA);
                ATT_STEP_YNG(j + 1, pA0, pA1, mnA, alA, pB0, pB1, mnB, alB);
            }
            ATT_STEP_YNG(NT - 1, pB0, pB1, mnB, alB, pA0, pA1, mnA, alA);
            partialSM<WIN>(pB0, pB1, m_reg, mnB, alB, C, THRR, NT - 1 >= 4, ATT_DQ(NT - 1), hi); ATT_RESC(alB);
        } else {
            qkt<DK>(pA0, pA1, K_lds, qr, kq); partialSM<WIN>(pA0, pA1, m_reg, mnA, alA, C, THRR, false, 0, hi);
            ATT_SYNC(0); ATT_RESC(alA); sc = 1;
            for (int j = 1; j + 1 < NT; j += 2) {
                ATT_STEP_OLD(j, pB0, pB1, mnB, alB, pA0, pA1, mnA, alA);
                ATT_STEP_OLD(j + 1, pA0, pA1, mnA, alA, pB0, pB1, mnB, alB);
            }
            ATT_STEP_OLD(NT - 1, pB0, pB1, mnB, alB, pA0, pA1, mnA, alA);
        }
        finishSM(pB0, pB1, alB, l_reg, pa0, pa1, pa2, pa3); ASBAR();
        pv_all<DV>(o, vb0 + ((sc == 0) ? 2 : sc - 1) * SHM_V, pa0, pa1, pa2, pa3);
#undef ATT_SYNC
#undef ATT_STEP_OLD
#undef ATT_STEP_YNG
#undef ATT_DMAK
#undef ATT_DMAV
#undef ATT_WAITN
#undef ATT_WAIT1
#undef ATT_WAIT2
    } else if constexpr (MODE == 1) {
        ATT_SLOAD(0); asm volatile("s_waitcnt vmcnt(0)" ::: "memory"); ATT_SWRITE(0); __syncthreads();
        for (int j = 0; j < NT; ++j) {
            const int b = j & 1;
            if (j + 1 < NT) ATT_SLOAD(j + 1);
            ASBAR(); qkt<DK>(pA0, pA1, K_lds + b * SHM_K, qr, kq);
            partialSM<WIN>(pA0, pA1, m_reg, mnA, alA, C, THRR, j >= 4, ATT_DQ(j), hi);
            ATT_RESC(alA);
            finishSM(pA0, pA1, alA, l_reg, pa0, pa1, pa2, pa3); ASBAR();
            pv_all<DV>(o, vb0 + b * SHM_V, pa0, pa1, pa2, pa3);
            if (j + 1 < NT) { asm volatile("s_waitcnt vmcnt(0)" ::: "memory"); ATT_SWRITE(b ^ 1); }
            __syncthreads();
        }
    } else {
    ATT_SLOAD(0); asm volatile("s_waitcnt vmcnt(0)" ::: "memory"); ATT_SWRITE(0); __syncthreads();
    qkt<DK>(pA0, pA1, K_lds, qr, kq); partialSM<WIN>(pA0, pA1, m_reg, mnA, alA, C, THRR, false, 0, hi);
    ATT_SLOAD(1); asm volatile("s_waitcnt vmcnt(0)" ::: "memory"); ATT_SWRITE(1); __syncthreads();
    for (int j = 1; j + 1 < NT; j += 2) {
        ASBAR(); qkt<DK>(pB0, pB1, K_lds + SHM_K, qr, kq);
        finishSM(pA0, pA1, alA, l_reg, pa0, pa1, pa2, pa3); ASBAR();
        ATT_SLOAD(j + 1); ASBAR();
        pv_all<DV>(o, vb0, pa0, pa1, pa2, pa3); partialSM<WIN>(pB0, pB1, m_reg, mnB, alB, C, THRR, j >= 4, ATT_DQ(j), hi);
        __syncthreads(); asm volatile("s_waitcnt vmcnt(0)" ::: "memory"); ATT_SWRITE(0);
        ATT_RESC(alB); __syncthreads();
        ASBAR(); qkt<DK>(pA0, pA1, K_lds, qr, kq);
        finishSM(pB0, pB1, alB, l_reg, pa0, pa1, pa2, pa3); ASBAR();
        ATT_SLOAD(j + 2); ASBAR();
        pv_all<DV>(o, vb0 + SHM_V, pa0, pa1, pa2, pa3); partialSM<WIN>(pA0, pA1, m_reg, mnA, alA, C, THRR, j + 1 >= 4, ATT_DQ(j + 1), hi);
        __syncthreads(); asm volatile("s_waitcnt vmcnt(0)" ::: "memory"); ATT_SWRITE(1);
        ATT_RESC(alA); __syncthreads();
    }
    ASBAR(); qkt<DK>(pB0, pB1, K_lds + SHM_K, qr, kq);
    finishSM(pA0, pA1, alA, l_reg, pa0, pa1, pa2, pa3); ASBAR();
    pv_all<DV>(o, vb0, pa0, pa1, pa2, pa3); partialSM<WIN>(pB0, pB1, m_reg, mnB, alB, C, THRR, NT - 1 >= 4, ATT_DQ(NT - 1), hi);
    __syncthreads(); ATT_RESC(alB);
    finishSM(pB0, pB1, alB, l_reg, pa0, pa1, pa2, pa3); ASBAR();
    pv_all<DV>(o, vb0 + SHM_V, pa0, pa1, pa2, pa3);
    }
    if constexpr (SINK) l_reg += __builtin_amdgcn_exp2f(sinkl2 - m_reg * C);
    if (hi == 0) li_l[r32] = l_reg;
    asm volatile("s_waitcnt lgkmcnt(0)" ::: "memory");
    float rli[16];
#pragma unroll
    for (int r = 0; r < 16; ++r) rli[r] = __builtin_amdgcn_rcpf(li_l[crow(r, hi)]);
    bf16_t* Ow = Ob + (long)(wid * 32) * ldo + r32;
#pragma unroll
    for (int r = 0; r < 16; ++r) { const int orow = crow(r, hi);
#pragma unroll
        for (int d0 = 0; d0 < NO; ++d0) Ow[(long)orow * ldo + d0 * 32] = (bf16_t)(cvtpk(o[d0][r] * rli[r], 0.f) & 0xffffu); }
#undef ATT_ROWOF
#undef ATT_SLOAD
#undef ATT_SWRITE
#undef ATT_RESC
#undef ATT_DQ
}
}
typedef unsigned short bf16;
typedef unsigned v4u __attribute__((ext_vector_type(4)));
typedef unsigned v2u __attribute__((ext_vector_type(2)));
typedef float f32x4 __attribute__((ext_vector_type(4)));
typedef short bf16x8 __attribute__((ext_vector_type(8)));
typedef GAS unsigned gu32;
#define LDS_WAIT() asm volatile("s_waitcnt lgkmcnt(0)" ::: "memory")
#define VM_WAIT() asm volatile("s_waitcnt vmcnt(0)" ::: "memory")

constexpr int NWAVES = 8;
constexpr int DM = 2048, NB = 8, SEQ = 4096, DEPTH = 4, CTXL = 256, DFF = 5632;
constexpr int ML = NB * SEQ, MC = NB * CTXL, MT = ML + MC;
constexpr int NIN = 8768, NINP = 8960, NMOD = 6 * DM;
constexpr float EPS = 1e-6f;
static_assert(ML == pg8::ML_ROWS, "row split");

constexpr size_t MiB = 1u << 20;
constexpr size_t WS_CTL = 0, CTL_ZERO_BYTES = 1 * MiB;
constexpr size_t WS_MOD = 1 * MiB;
constexpr size_t WS_ROPE = 3 * MiB;
constexpr size_t WS_W = 4 * MiB;
constexpr size_t WO_IN = 0, WO_Q = WO_IN + (size_t)NINP * DM * 2, WO_KV = WO_Q + (size_t)1536 * 512 * 2, WO_C = WO_KV + (size_t)2048 * 256 * 2, WO_M = WO_C + (size_t)2048 * 512 * 2,
                 WO_G = WO_M + (size_t)2048 * 1024 * 2, WO_O = WO_G + (size_t)2048 * 512 * 2, WO_F1 = WO_O + (size_t)2048 * 2048 * 2, WO_F2 = WO_F1 + (size_t)2 * DFF * DM * 2,
                 WO_END = WO_F2 + (size_t)DM * DFF * 2;
static_assert(WO_END <= 120 * MiB, "weights");
constexpr size_t WS_XC = 124 * MiB;
constexpr size_t WS_A = 140 * MiB;
constexpr size_t WS_B = 548 * MiB;
constexpr size_t WS_C = 684 * MiB;
constexpr size_t WS_D = 786 * MiB;
constexpr size_t WD_KF = 0, WD_V = 102 * MiB, WD_GQ = 170 * MiB, WD_GK = 204 * MiB, WD_GV = 213 * MiB, WD_U = 222 * MiB;
constexpr size_t WS_E = 1058 * MiB;
constexpr size_t WE_UC = 0, WE_CKV = 34 * MiB, WE_QA = 51 * MiB;
constexpr size_t WS_END = 1144 * MiB;
static_assert((size_t)MT * 6144 * 2 <= 408 * MiB && (size_t)MT * 2048 * 2 <= 136 * MiB && (size_t)MT * 768 * 4 <= 102 * MiB && (size_t)MT * 2048 * 4 <= 272 * MiB && WD_U + (size_t)MT * 512 * 2 <= 272 * MiB, "ws map");
constexpr int CW_BAR = 4096;

constexpr int RING_OFF = 0, RING_BYTES = 131072, LDSCTL_OFF = RING_BYTES, MISC_OFF = LDSCTL_OFF + 320, LDS_BYTES = 147456;

__device__ __forceinline__ unsigned f2bf(float f) { unsigned u = __builtin_bit_cast(unsigned, f); return (u + 0x7fffu + ((u >> 16) & 1u)) >> 16; }
__device__ __forceinline__ unsigned pk2(float lo, float hi) { return pg8::cvt_pk_bf16(lo, hi); }
__device__ __forceinline__ float wave_sum(float v) {
#pragma unroll
    for (int o = 1; o < 64; o <<= 1) v += __shfl_xor(v, o);
    return v;
}
__device__ __forceinline__ float bflo(unsigned w) { return __uint_as_float(w << 16); }
__device__ __forceinline__ float bfhi(unsigned w) { return __uint_as_float(w & 0xffff0000u); }
__device__ __forceinline__ float sigmf(float x) { return __builtin_amdgcn_rcpf(1.0f + __builtin_amdgcn_exp2f(-1.4426950408889634f * x)); }

__device__ __forceinline__ int srccol(int mode, int n) {
    if (mode == 0) return n;
    if (mode == 1) {
        if (n < 6144) return 2624 + n;
        if (n < 7744) return n - 6144;
        if (n < 8768) { const int q = n - 7744, g = q >> 5, i = q & 31; return 1600 + (i < 16 ? 16 * g + i : 512 + 16 * g + (i - 16)); }
        return -1;
    }
    { const int g = n >> 5, i = n & 31; return i < 16 ? 16 * g + i : DFF + 16 * g + (i - 16); }
}
__device__ __forceinline__ void cvt_item(const float* W, int K, int N, bf16* WT, LAS float* scr, int item, int nblk, int lane, int mode) {
    const int kb = item / nblk, nb = item % nblk, k0 = 64 * kb, n0 = 32 * nb;
    const int sc = srccol(mode, n0 + (lane & 31));
    const float wsc = (mode == 1 && n0 < 6144) ? -1.4426950408889634f : 1.0f;
    const float* wp = W + (size_t)(k0 + (lane >> 5)) * N + (sc >= 0 ? sc : 0);
#pragma unroll 8
    for (int i = 0; i < 32; ++i) { const float v = wp[(size_t)(2 * i) * N] * wsc; scr[(2 * i + (lane >> 5)) * 33 + (lane & 31)] = sc >= 0 ? v : 0.f; }
    LDS_WAIT(); asm volatile("" ::: "memory");
    const int c = lane & 7;
#pragma unroll
    for (int j = 0; j < 4; ++j) { const int n = (lane >> 3) + 8 * j; const LAS float* s = scr + (8 * c) * 33 + n;
        v4u o; o.x = pk2(s[0 * 33], s[1 * 33]); o.y = pk2(s[2 * 33], s[3 * 33]); o.z = pk2(s[4 * 33], s[5 * 33]); o.w = pk2(s[6 * 33], s[7 * 33]);
        *(GAS v4u*)(WT + (size_t)(n0 + n) * K + k0 + 8 * c) = o; }
    LDS_WAIT(); asm volatile("" ::: "memory");
}

#ifndef ATT_MLA_MODE
#define ATT_MLA_MODE 2
#endif
#ifndef ATT_GQA_MODE
#define ATT_GQA_MODE 2
#endif
#ifndef P5_WGM
#define P5_WGM 8
#endif
#ifndef P1_WGM
#define P1_WGM 4
#endif
#ifndef P8_WGM
#define P8_WGM 4
#endif
#ifndef SPLIT_WGM
#define SPLIT_WGM 2
#endif
struct Args { const float* in[25]; float* out; unsigned char* ws; int multi, l_lo, l_hi, ph, pad0, pad1; };
enum { PH_PRE = -1, PH_POST = 10, PH_DUMP = 11 };

struct __attribute__((packed, aligned(4))) F3 { float x, y, z; };
#define PHASE_BEGIN \
    const __attribute__((address_space(4))) Args* ap = (const __attribute__((address_space(4))) Args*)__builtin_amdgcn_kernarg_segment_ptr(); asm volatile("" : "+s"(ap)); \
    unsigned char* ws = ap->ws; \
    int tid = threadIdx.x; asm volatile("" : "+v"(tid)); const int lane = tid & 63, wave = __builtin_amdgcn_readfirstlane(tid >> 6); \
    const int gw = vcu * NWAVES + wave, NGW = G * NWAVES; (void)gw; (void)NGW; (void)lane; \
    const float* in_x = ap->in[0]; const float* in_c = ap->in[1]; const float* in_ctx = ap->in[2]; const float* in_cctx = ap->in[3]; const float* w_ada = ap->in[4]; const float* b_ada = ap->in[5]; const float* g_mix = ap->in[6]; const float* w_in = ap->in[7]; const float* conv_w = ap->in[8]; const float* conv_b = ap->in[9]; const float* conv_ln_g = ap->in[10]; const float* conv_ln_b = ap->in[11]; const float* w_conv_out = ap->in[12]; const float* g_q_a = ap->in[13]; const float* w_q_up = ap->in[14]; const float* g_kv_a = ap->in[15]; const float* w_kv_up = ap->in[16]; const float* w_mla_out = ap->in[17]; const float* gqa_sink = ap->in[18]; const float* w_gqa_out = ap->in[19]; const float* w_out = ap->in[20]; const float* g_ffn = ap->in[21]; const float* w_ffn_in = ap->in[22]; const float* w_ffn_out = ap->in[23]; const float* g_final = ap->in[24]; float* XL = ap->out; float* MOD = (float*)(ws + WS_MOD); float* ROPE = (float*)(ws + WS_ROPE); float* XC = (float*)(ws + WS_XC); bf16* Win_t = (bf16*)(ws + WS_W + WO_IN); bf16* Wq_t = (bf16*)(ws + WS_W + WO_Q); bf16* Wkv_t = (bf16*)(ws + WS_W + WO_KV); bf16* Wc_t = (bf16*)(ws + WS_W + WO_C); bf16* Wm_t = (bf16*)(ws + WS_W + WO_M); bf16* Wg_t = (bf16*)(ws + WS_W + WO_G); bf16* Wo_t = (bf16*)(ws + WS_W + WO_O); bf16* Wf1_t = (bf16*)(ws + WS_W + WO_F1); bf16* Wf2_t = (bf16*)(ws + WS_W + WO_F2); unsigned char* Gb = (unsigned char*)(ws + WS_A); bf16* HID = (bf16*)(ws + WS_A); bf16* Hb = (bf16*)(ws + WS_B); bf16* MQ = (bf16*)(ws + WS_B); bf16* Yb = (bf16*)(ws + WS_B); bf16* CQ = (bf16*)(ws + WS_C); float* PART = (float*)(ws + WS_C); bf16* OM = (bf16*)(ws + WS_C); bf16* OG = (bf16*)(ws + WS_C + (size_t)MT * 1024 * 2); bf16* KF = (bf16*)(ws + WS_D + WD_KF); bf16* Vb = (bf16*)(ws + WS_D + WD_V); bf16* GQ = (bf16*)(ws + WS_D + WD_GQ); bf16* GK = (bf16*)(ws + WS_D + WD_GK); bf16* GV = (bf16*)(ws + WS_D + WD_GV); bf16* Ub = (bf16*)(ws + WS_D + WD_U); bf16* YF = (bf16*)(ws + WS_D); bf16* UC = (bf16*)(ws + WS_E + WE_UC); bf16* CKVn = (bf16*)(ws + WS_E + WE_CKV); bf16* QAn = (bf16*)(ws + WS_E + WE_QA); \
    const float* modl = MOD + (size_t)l_cur * 9 * NMOD; (void)modl;
__global__ void __launch_bounds__(NWAVES * 64, 2) mega_fwd(Args args) {
    extern __shared__ __attribute__((aligned(16))) unsigned char lds_raw[];
    LAS unsigned char* lds = (LAS unsigned char*)lds_raw;
    volatile LAS unsigned* MISC = (volatile LAS unsigned*)(lds + MISC_OFF);
    const int tid0 = threadIdx.x;
    const int G = gridDim.x; const int bx = blockIdx.x; const int vcu = (G % 8 == 0) ? (bx % 8) * (G / 8) + bx / 8 : bx;
    gu32* ctl = (gu32*)(args.ws + WS_CTL);
    int l_cur = 0;
    for (int u = tid0; u < (LDS_BYTES - LDSCTL_OFF) / 4; u += NWAVES * 64) ((LAS unsigned*)(lds + LDSCTL_OFF))[u] = 0u;
    __syncthreads();
    XcdBarrier bar = xcd_barrier_post((unsigned*)(ctl + CW_BAR), MISC + 8);
    const int multi = args.multi, ph = args.ph;
#ifndef PHASE_MASK
#define PHASE_MASK 0x1fff
#endif
#define RUN(k) ((((PHASE_MASK) >> ((k) + 1)) & 1) && (!multi || ph == (k)))
#define GRID_BAR() do { if (!multi) xcd_barrier(bar); } while (0)

    if (RUN(PH_PRE)) { PHASE_BEGIN
        LAS float* sil = (LAS float*)(lds + RING_OFF);
        LAS float* red = (LAS float*)(lds + RING_OFF + 9 * DM * 4);
        for (int i = tid; i < 9 * DM; i += NWAVES * 64) { const float v = i < 8 * DM ? in_c[i] : in_cctx[i - 8 * DM]; sil[(i & (DM - 1)) * 9 + (i >> 11)] = v * sigmf(v); }
        __syncthreads();
#define ADA_LOAD(W_, I0) do { _Pragma("unroll") for (int u = 0; u < 8; ++u) W_[u] = *(const F3*)(Wl + (size_t)((I0) + u) * 8 * NMOD); } while (0)
#define ADA_FMA(W_, I0) do { _Pragma("unroll") for (int u = 0; u < 8; ++u) { const LAS float* sp = sil + (((I0) + u) * 8 + wave) * 9; \
            _Pragma("unroll") for (int v = 0; v < 9; ++v) { const float sv = sp[v]; acc[v][0] += W_[u].x * sv; acc[v][1] += W_[u].y * sv; acc[v][2] += W_[u].z * sv; } asm volatile("" ::: "memory"); } } while (0)
        for (int s = vcu; s < DEPTH * 64; s += G) {
            const int l = s >> 6, col0 = (s & 63) * 192;
            const float* Wl = w_ada + (size_t)l * DM * NMOD + (size_t)wave * NMOD + col0 + 3 * lane;
            float acc[9][3];
#pragma unroll
            for (int v = 0; v < 9; ++v) { acc[v][0] = 0.f; acc[v][1] = 0.f; acc[v][2] = 0.f; }
            F3 wa[8], wb[8];
            ADA_LOAD(wa, 0);
#pragma nounroll
            for (int i = 0; i < DM / 8; i += 16) {
                ADA_LOAD(wb, i + 8);
                ADA_FMA(wa, i);
                { const int in_ = (i + 16 < DM / 8) ? i + 16 : 0; ADA_LOAD(wa, in_); }
                ADA_FMA(wb, i + 8);
            }
#pragma unroll
            for (int v = 0; v < 9; ++v) {
#pragma unroll
                for (int e = 0; e < 3; ++e) red[(wave * 9 + v) * 192 + 3 * lane + e] = acc[v][e]; }
            __syncthreads();
            for (int i = tid; i < 9 * 192; i += NWAVES * 64) { const int v = i / 192, cc = i - v * 192; float t = 0.f;
#pragma unroll
                for (int w8 = 0; w8 < 8; ++w8) t += red[(w8 * 9 + v) * 192 + cc];
                MOD[((size_t)l * 9 + v) * NMOD + col0 + cc] = t + b_ada[(size_t)l * NMOD + col0 + cc]; }
            __syncthreads();
        }
        { const int i = bx * (NWAVES * 64) + tid; if (i < 64 * 16) { const int p = i >> 4, f = i & 15; const float invf = powf(10000.0f, -(float)f / 16.0f), a = (float)p * invf;
              ROPE[2 * i] = cosf(a); ROPE[2 * i + 1] = sinf(a); } }
    }
    GRID_BAR();

    for (int l = args.l_lo; l < args.l_hi; ++l) {
        l_cur = l;
        const bool lastl = (l == DEPTH - 1); const int Mg = lastl ? ML : MT;
        if (RUN(0)) { PHASE_BEGIN
            LAS float* scr = (LAS float*)(lds + RING_OFF + wave * 16384);
            constexpr int I_IN = (DM / 64) * (NINP / 32), I_Q = (512 / 64) * (1536 / 32), I_KV = (256 / 64) * (2048 / 32), I_C = (512 / 64) * (DM / 32), I_M = (1024 / 64) * (DM / 32),
                          I_G = (512 / 64) * (DM / 32), I_O = (DM / 64) * (DM / 32), I_F1 = (DM / 64) * (2 * DFF / 32), I_F2 = (DFF / 64) * (DM / 32);
            constexpr int NITEMS = I_IN + I_Q + I_KV + I_C + I_M + I_G + I_O + I_F1 + I_F2;
            for (int it = gw; it < NITEMS; it += NGW) {
                int r = it; const float* W; bf16* WT; int K, N, nblk, mode = 0;
                if (r < I_IN) { W = w_in + (size_t)l * DM * NIN; K = DM; N = NIN; WT = Win_t; nblk = NINP / 32; mode = 1; }
                else if ((r -= I_IN) < I_Q) { W = w_q_up + (size_t)l * 512 * 1536; K = 512; N = 1536; WT = Wq_t; nblk = 1536 / 32; }
                else if ((r -= I_Q) < I_KV) { W = w_kv_up + (size_t)l * 256 * 2048; K = 256; N = 2048; WT = Wkv_t; nblk = 2048 / 32; }
                else if ((r -= I_KV) < I_C) { W = w_conv_out + (size_t)l * 512 * DM; K = 512; N = DM; WT = Wc_t; nblk = DM / 32; }
                else if ((r -= I_C) < I_M) { W = w_mla_out + (size_t)l * 1024 * DM; K = 1024; N = DM; WT = Wm_t; nblk = DM / 32; }
                else if ((r -= I_M) < I_G) { W = w_gqa_out + (size_t)l * 512 * DM; K = 512; N = DM; WT = Wg_t; nblk = DM / 32; }
                else if ((r -= I_G) < I_O) { W = w_out + (size_t)l * DM * DM; K = DM; N = DM; WT = Wo_t; nblk = DM / 32; }
                else if ((r -= I_O) < I_F1) { W = w_ffn_in + (size_t)l * DM * 2 * DFF; K = DM; N = 2 * DFF; WT = Wf1_t; nblk = 2 * DFF / 32; mode = 2; }
                else { r -= I_F1; W = w_ffn_out + (size_t)l * DFF * DM; K = DFF; N = DM; WT = Wf2_t; nblk = DM / 32; }
                cvt_item(W, K, N, WT, scr, r, nblk, lane, mode);
            }
        }
#define NORM_ROWS(GVEC, SHOFF, SCOFF, FIRST, WITHCTX, PARTG) do { \
            int cur = -1; f32x4 Aa[8], Ss[8]; \
            _Pragma("unroll") for (int j = 0; j < 8; ++j) { Aa[j] = (f32x4){0.f, 0.f, 0.f, 0.f}; Ss[j] = (f32x4){0.f, 0.f, 0.f, 0.f}; } \
            const int nrow_ = (WITHCTX) ? 17 : 16; \
            for (int gv_ = gw; gv_ < 2048; gv_ += NGW) \
            _Pragma("nounroll") for (int ri = 0; ri < nrow_; ++ri) { const int r = ri < 16 ? gv_ * 16 + ri : ML + gv_; const int sel = r < ML ? (r >> 12) : 8; \
                if (sel != cur) { cur = sel; const float* mp = modl + (size_t)sel * NMOD; \
                    _Pragma("unroll") for (int j = 0; j < 8; ++j) { const int c = 4 * lane + 256 * j; const f32x4 g = *(const f32x4*)((GVEC) + c), sc = *(const f32x4*)(mp + (SCOFF) + c); \
                        Aa[j] = g * (sc + 1.0f); Ss[j] = *(const f32x4*)(mp + (SHOFF) + c); } } \
                const float* src; float* dst; \
                if (r < ML) { src = ((FIRST) == 1 ? in_x : XL) + (size_t)r * DM; dst = XL + (size_t)r * DM; } else { src = ((FIRST) != 0 ? in_ctx : XC) + (size_t)(r - ML) * DM; dst = XC + (size_t)(r - ML) * DM; } \
                f32x4 v[8]; float ss = 0.f; \
                _Pragma("unroll") for (int j = 0; j < 8; ++j) v[j] = *(const f32x4*)(src + 4 * lane + 256 * j); \
                const bool addp_ = (r >= ML) && ((PARTG) != nullptr); \
                if (addp_) { const float* pp = PART + (size_t)(r - ML) * DM + 4 * lane; \
                    _Pragma("unroll") for (int j = 0; j < 8; ++j) { const f32x4 p = (*(const f32x4*)(pp + 256 * j) + *(const f32x4*)(pp + (size_t)2048 * DM + 256 * j)) + (*(const f32x4*)(pp + (size_t)2 * 2048 * DM + 256 * j) + *(const f32x4*)(pp + (size_t)3 * 2048 * DM + 256 * j)); \
                        v[j] += *(const f32x4*)((PARTG) + 4 * lane + 256 * j) * p; } } \
                _Pragma("unroll") for (int j = 0; j < 8; ++j) ss += (v[j][0] * v[j][0] + v[j][1] * v[j][1]) + (v[j][2] * v[j][2] + v[j][3] * v[j][3]); \
                const float rstd = 1.0f / sqrtf(wave_sum(ss) * (1.0f / DM) + EPS); \
                if (addp_) { _Pragma("unroll") for (int j = 0; j < 8; ++j) *(f32x4*)(dst + 4 * lane + 256 * j) = v[j]; } \
                bf16* hp = Hb + (size_t)r * DM + 4 * lane; \
                _Pragma("unroll") for (int j = 0; j < 8; ++j) { const f32x4 y = v[j] * rstd * Aa[j] + Ss[j]; v2u w; w.x = pk2(y[0], y[1]); w.y = pk2(y[2], y[3]); *(v2u*)(hp + 256 * j) = w; } } \
        } while (0)
        if (RUN(0)) { PHASE_BEGIN const float* gv = g_mix + (size_t)l * DM; const int first = (l == 0) ? 1 : 0;
            const float* pg = first ? nullptr : (MOD + ((size_t)(l - 1) * 9 + 8) * NMOD + 5 * DM);
            NORM_ROWS(gv, 0, DM, first, true, pg); }
        GRID_BAR();

        if (RUN(1)) { PHASE_BEGIN
            const bf16* A_ = Hb; const bf16* B_ = Win_t; asm volatile("" : "+s"(A_), "+s"(B_)); pg8::Gemm g{A_, B_, MT, NINP, DM}; pg8::StaticOrder S; S.init(Mg, NINP, G, bx); S.wgm = P1_WGM; if (lastl) S.set_extra(24, ML / 256, 24, 3);
            pg8::EpiWin E{Gb, CQ, KF, GK, GV, GQ, Ub, ROPE};
            pg8::gemm_phase<pg8::EpiWin, pg8::StaticOrder, true, true>(lds + RING_OFF, g, S, E);
        }
        GRID_BAR();

        if (RUN(2)) { PHASE_BEGIN
            LAS float* cw = (LAS float*)(lds + RING_OFF);
            for (int i = tid; i < 31 * 512; i += NWAVES * 64) cw[i] = conv_w[(size_t)l * 31 * 512 + i];
            __syncthreads();
            { const f32x4 gk = *(const f32x4*)(g_kv_a + (size_t)l * 256 + 4 * lane), gq0 = *(const f32x4*)(g_q_a + (size_t)l * 512 + 4 * lane), gq1 = *(const f32x4*)(g_q_a + (size_t)l * 512 + 256 + 4 * lane);
              for (int r0 = gw; r0 < MT; r0 += 2 * NGW) { const int r1 = (r0 + NGW < MT) ? r0 + NGW : r0;
                const bf16* p = CQ + (size_t)r0 * 768 + 4 * lane; const bf16* q = CQ + (size_t)r1 * 768 + 4 * lane;
#define LD4(P) ({ const v2u t_ = *(const v2u*)(P); (f32x4){bflo(t_.x), bfhi(t_.x), bflo(t_.y), bfhi(t_.y)}; })
                const f32x4 a = LD4(p), b0 = LD4(p + 256), b1 = LD4(p + 512), c = LD4(q), d0 = LD4(q + 256), d1 = LD4(q + 512);
#undef LD4
#define LR_ROW(R, A_, B0_, B1_) do { \
                const float sa = wave_sum((A_[0] * A_[0] + A_[1] * A_[1]) + (A_[2] * A_[2] + A_[3] * A_[3])); \
                const float sb = wave_sum(((B0_[0] * B0_[0] + B0_[1] * B0_[1]) + (B0_[2] * B0_[2] + B0_[3] * B0_[3])) + ((B1_[0] * B1_[0] + B1_[1] * B1_[1]) + (B1_[2] * B1_[2] + B1_[3] * B1_[3]))); \
                const float ra = 1.0f / sqrtf(sa * (1.0f / 256.0f) + EPS), rb = 1.0f / sqrtf(sb * (1.0f / 512.0f) + EPS); \
                const f32x4 ya = A_ * ra * gk, y0 = B0_ * rb * gq0, y1 = B1_ * rb * gq1; \
                v2u w; w.x = pk2(ya[0], ya[1]); w.y = pk2(ya[2], ya[3]); *(v2u*)(CKVn + (size_t)(R) * 256 + 4 * lane) = w; \
                w.x = pk2(y0[0], y0[1]); w.y = pk2(y0[2], y0[3]); *(v2u*)(QAn + (size_t)(R) * 512 + 4 * lane) = w; \
                w.x = pk2(y1[0], y1[1]); w.y = pk2(y1[2], y1[3]); *(v2u*)(QAn + (size_t)(R) * 512 + 256 + 4 * lane) = w; } while (0)
                LR_ROW(r0, a, b0, b1); LR_ROW(r1, c, d0, d1);
#undef LR_ROW
              } }
            { const int ch = 8 * lane;
              const f32x4 cb0 = *(const f32x4*)(conv_b + (size_t)l * 512 + ch), cb1 = *(const f32x4*)(conv_b + (size_t)l * 512 + ch + 4);
              const f32x4 lg0 = *(const f32x4*)(conv_ln_g + (size_t)l * 512 + ch), lg1 = *(const f32x4*)(conv_ln_g + (size_t)l * 512 + ch + 4);
              const f32x4 lb0 = *(const f32x4*)(conv_ln_b + (size_t)l * 512 + ch), lb1 = *(const f32x4*)(conv_ln_b + (size_t)l * 512 + ch + 4);
              for (int tok = gw; tok < Mg; tok += NGW) {
                int sb, pos, L; if (tok < ML) { sb = tok & ~4095; pos = tok & 4095; L = SEQ; } else { const int c = tok - ML; sb = ML + (c & ~255); pos = c & 255; L = CTXL; }
                f32x4 a0 = cb0, a1 = cb1;
                v4u xr[31];
                if (pos >= 15 && pos < L - 15) {
                    const bf16* up = Ub + (size_t)(sb + pos - 15) * 512 + ch;
#pragma unroll
                    for (int j = 0; j < 31; ++j) xr[j] = *(const v4u*)(up + (size_t)j * 512);
                    asm volatile("" ::: "memory");
#pragma unroll
                    for (int j = 0; j < 31; ++j) { const v4u x = xr[j];
                        const f32x4 w0 = *(const LAS f32x4*)(cw + j * 512 + ch), w1 = *(const LAS f32x4*)(cw + j * 512 + ch + 4);
                        const f32x4 x0 = {bflo(x.x), bfhi(x.x), bflo(x.y), bfhi(x.y)}, x1 = {bflo(x.z), bfhi(x.z), bflo(x.w), bfhi(x.w)};
                        a0 += w0 * x0; a1 += w1 * x1; if ((j & 3) == 3) asm volatile("" ::: "memory"); }
                } else {
#pragma unroll
                    for (int j = 0; j < 31; ++j) { int p = pos + j - 15; p = p < 0 ? 0 : (p >= L ? L - 1 : p); xr[j] = *(const v4u*)(Ub + (size_t)(sb + p) * 512 + ch); }
                    asm volatile("" ::: "memory");
#pragma unroll
                    for (int j = 0; j < 31; ++j) { const int p = pos + j - 15; const float ok = (p >= 0 && p < L) ? 1.0f : 0.0f; const v4u x = xr[j];
                        const f32x4 w0 = *(const LAS f32x4*)(cw + j * 512 + ch) * ok, w1 = *(const LAS f32x4*)(cw + j * 512 + ch + 4) * ok;
                        const f32x4 x0 = {bflo(x.x), bfhi(x.x), bflo(x.y), bfhi(x.y)}, x1 = {bflo(x.z), bfhi(x.z), bflo(x.w), bfhi(x.w)};
                        a0 += w0 * x0; a1 += w1 * x1; if ((j & 3) == 3) asm volatile("" ::: "memory"); }
                }
                const float mean = wave_sum((a0[0] + a0[1]) + (a0[2] + a0[3]) + (a1[0] + a1[1]) + (a1[2] + a1[3])) * (1.0f / 512.0f);
                const f32x4 d0 = a0 - mean, d1 = a1 - mean;
                const float var = wave_sum((d0[0] * d0[0] + d0[1] * d0[1]) + (d0[2] * d0[2] + d0[3] * d0[3]) + (d1[0] * d1[0] + d1[1] * d1[1]) + (d1[2] * d1[2] + d1[3] * d1[3])) * (1.0f / 512.0f);
                const float rstd = 1.0f / sqrtf(var + EPS);
                const f32x4 y0 = d0 * rstd * lg0 + lb0, y1 = d1 * rstd * lg1 + lb1;
                v4u w; w.x = pk2(y0[0] * sigmf(y0[0]), y0[1] * sigmf(y0[1])); w.y = pk2(y0[2] * sigmf(y0[2]), y0[3] * sigmf(y0[3]));
                w.z = pk2(y1[0] * sigmf(y1[0]), y1[1] * sigmf(y1[1])); w.w = pk2(y1[2] * sigmf(y1[2]), y1[3] * sigmf(y1[3]));
                *(v4u*)(UC + (size_t)tok * 512 + ch) = w; } }
        }
        GRID_BAR();

        if (RUN(3)) { PHASE_BEGIN
            const bf16* A0_ = QAn; const bf16* B0_ = Wq_t; const bf16* A1_ = CKVn; const bf16* B1_ = Wkv_t; asm volatile("" : "+s"(A0_), "+s"(B0_), "+s"(A1_), "+s"(B1_));
            pg8::SchedQKV S; S.nMq = Mg / 256; S.nNq = 1536 / 256; S.nMk = MT / 256; S.nNk = 2048 / 256; S.G = G; S.c = bx; S.Aq = A0_; S.Bq = B0_; S.Ak = A1_; S.Bk = B1_;
            pg8::EpiQKV E{pg8::EpiQup{MQ, ROPE}, pg8::EpiKV{KF, Vb}};
            pg8::gemm_stream<pg8::EpiQKV, pg8::SchedQKV>(lds + RING_OFF, S, E);
        }
        GRID_BAR();

        if (RUN(4)) { PHASE_BEGIN
            att::lchar* alds = (att::lchar*)(lds + RING_OFF);
            for (int u = vcu; u < 1024 + (lastl ? 0 : 64); u += G) {
                int b, h, q0row, NT;
                if (u < 1024) { const int bh = u >> 4, qb = u & 15; b = bh >> 3; h = bh & 7; q0row = b * SEQ + qb * 256; NT = 4 + SEQ / 64; }
                else { const int bh = u - 1024; b = bh >> 3; h = bh & 7; q0row = ML + b * CTXL; NT = 4; }
                att::attn_unit<192, 128, false, false, ATT_MLA_MODE>(MQ + (size_t)q0row * 1536 + h * 192, 1536, KF + h * 192, 1536, Vb + h * 128, 1024, OM + (size_t)q0row * 1024 + h * 128, 1024,
                                                       ML + b * CTXL, b * SEQ, NT, 0, 0, 0.f, alds);
            }
            for (int u = vcu; u < 1024 + (lastl ? 0 : 64); u += G) {
                int b, h, q0row, NT, qpos0, kpos0;
                if (u < 1024) { const int bh = u >> 4, qb = u & 15; b = bh >> 3; h = bh & 7; q0row = b * SEQ + qb * 256; qpos0 = qb * 256;
                    const int klo = qpos0 - 128 < 0 ? 0 : qpos0 - 128, khi = qpos0 + 384 > SEQ ? SEQ : qpos0 + 384; kpos0 = klo; NT = 4 + (khi - klo) / 64; }
                else { const int bh = u - 1024; b = bh >> 3; h = bh & 7; q0row = ML + b * CTXL; NT = 4; qpos0 = 0; kpos0 = 0; }
                const float sk = gqa_sink[l * 8 + h] * 1.4426950408889634f;
                att::attn_unit<64, 64, true, true, ATT_GQA_MODE>(GQ + (size_t)q0row * 512 + h * 64, 512, GK + (h >> 2) * 64, 128, GV + (h >> 2) * 64, 128, OG + (size_t)q0row * 512 + h * 64, 512,
                                                   ML + b * CTXL, b * SEQ + kpos0, NT, qpos0, kpos0, sk, alds);
            }
            __syncthreads();
        }
        GRID_BAR();

        if (RUN(5)) { PHASE_BEGIN
            pg8::StaticOrder S; S.init(Mg, DM, G, bx); S.wgm = P5_WGM;
            { const bf16* A_ = UC; const bf16* B_ = Wc_t; asm volatile("" : "+s"(A_), "+s"(B_)); pg8::Gemm g{A_, B_, MT, DM, 512}; pg8::EpiMerge<0> E{Gb, YF, Yb}; pg8::gemm_phase<pg8::EpiMerge<0>, pg8::StaticOrder, true, true>(lds + RING_OFF, g, S, E); }
            { const bf16* A_ = OM; const bf16* B_ = Wm_t; asm volatile("" : "+s"(A_), "+s"(B_)); pg8::Gemm g{A_, B_, MT, DM, 1024}; pg8::EpiMerge<1> E{Gb, YF, Yb}; pg8::gemm_phase<pg8::EpiMerge<1>, pg8::StaticOrder, true, true>(lds + RING_OFF, g, S, E); }
            { const bf16* A_ = OG; const bf16* B_ = Wg_t; asm volatile("" : "+s"(A_), "+s"(B_)); pg8::Gemm g{A_, B_, MT, DM, 512}; pg8::EpiMerge<2> E{Gb, YF, Yb}; pg8::gemm_phase<pg8::EpiMerge<2>, pg8::StaticOrder, true, true>(lds + RING_OFF, g, S, E); }
        }
        GRID_BAR();

        if (RUN(6)) { PHASE_BEGIN
            const bf16* A_ = Yb; const bf16* B_ = Wo_t; asm volatile("" : "+s"(A_), "+s"(B_));
            pg8::SchedSplit S; S.A = A_; S.Bt = B_; S.K = DM; S.nlat = 1024; S.nctx = lastl ? 0 : 256; S.G = G; S.c = bx; S.wgm = SPLIT_WGM;
            pg8::EpiSplit E{pg8::EpiResid{XL, XC, modl, 2 * DM, (l == 0) ? in_x : (const float*)XL}, PART};
            pg8::gemm_stream<pg8::EpiSplit, pg8::SchedSplit>(lds + RING_OFF, S, E);
        }
        GRID_BAR();

        if (RUN(7)) { PHASE_BEGIN const float* gv = g_ffn + (size_t)l * DM; const float* pg = lastl ? nullptr : (modl + (size_t)8 * NMOD + 2 * DM);
            const int first = (l == 0) ? 2 : 0; NORM_ROWS(gv, 3 * DM, 4 * DM, first, !lastl, pg); }
        GRID_BAR();

        if (RUN(8)) { PHASE_BEGIN
            const bf16* A_ = Hb; const bf16* B_ = Wf1_t; asm volatile("" : "+s"(A_), "+s"(B_)); pg8::Gemm g{A_, B_, MT, 2 * DFF, DM}; pg8::StaticOrder S; S.init(Mg, 2 * DFF, G, bx); S.wgm = P8_WGM; pg8::EpiSwiGLU E{HID};
            pg8::gemm_phase<pg8::EpiSwiGLU, pg8::StaticOrder, true, true>(lds + RING_OFF, g, S, E);
        }
        GRID_BAR();

        if (RUN(9)) { PHASE_BEGIN
            const bf16* A_ = HID; const bf16* B_ = Wf2_t; asm volatile("" : "+s"(A_), "+s"(B_));
            pg8::SchedSplit S; S.A = A_; S.Bt = B_; S.K = DFF; S.nlat = 1024; S.nctx = lastl ? 0 : 256; S.G = G; S.c = bx; S.wgm = SPLIT_WGM;
            pg8::EpiSplit E{pg8::EpiResid{XL, XC, modl, 5 * DM, (const float*)XL}, PART};
            pg8::gemm_stream<pg8::EpiSplit, pg8::SchedSplit>(lds + RING_OFF, S, E);
        }
        GRID_BAR();
    }

    if (RUN(PH_POST)) { PHASE_BEGIN
        f32x4 gf[8];
#pragma unroll
        for (int j = 0; j < 8; ++j) gf[j] = *(const f32x4*)(g_final + 4 * lane + 256 * j);
        for (int r = gw; r < ML; r += NGW) { float* p = XL + (size_t)r * DM + 4 * lane; f32x4 v[8]; float ss = 0.f;
#pragma unroll
            for (int j = 0; j < 8; ++j) { v[j] = *(const f32x4*)(p + 256 * j); ss += (v[j][0] * v[j][0] + v[j][1] * v[j][1]) + (v[j][2] * v[j][2] + v[j][3] * v[j][3]); }
            const float rstd = 1.0f / sqrtf(wave_sum(ss) * (1.0f / DM) + EPS);
#pragma unroll
            for (int j = 0; j < 8; ++j) *(f32x4*)(p + 256 * j) = v[j] * rstd * gf[j]; }
    }

#if defined(DBG_STAGE)
    if (RUN(PH_DUMP)) { PHASE_BEGIN
        const int sel = ap->pad0; const size_t total = (size_t)G * NWAVES * 64, gt = (size_t)bx * NWAVES * 64 + tid;
        for (size_t i = gt; i < (size_t)ML * DM; i += total) { float v = 0.f;
#define DB16(bit, P, N) if (sel & (bit)) v += __uint_as_float((unsigned)(P)[i % (size_t)(N)] << 16)
            if (sel & 1) v += MOD[i % (size_t)(DEPTH * 9 * NMOD)];
            DB16(2, Hb, (size_t)MT * 2048); DB16(4, Gb, (size_t)MT * 6144); DB16(8, KF, (size_t)MT * 1536); DB16(16, Vb, (size_t)MT * 1024); DB16(32, GQ, (size_t)MT * 512);
            DB16(64, UC, (size_t)MT * 512); DB16(128, MQ, (size_t)MT * 1536); DB16(256, OM, (size_t)MT * 1024); DB16(512, OG, (size_t)MT * 512); DB16(1024, Yb, (size_t)MT * 2048);
            DB16(2048, Win_t, (size_t)NINP * 2048); DB16(4096, GK, (size_t)MT * 128); DB16(8192, GV, (size_t)MT * 128); DB16(16384, CKVn, (size_t)MT * 256); DB16(32768, QAn, (size_t)MT * 512);
            DB16(65536, Ub, (size_t)MT * 512); DB16(131072, Wf1_t, (size_t)2 * DFF * DM); DB16(262144, Wf2_t, (size_t)DM * DFF); DB16(524288, HID, (size_t)MT * DFF);
            if (sel & 1048576) v += CQ[i % ((size_t)MT * 768)];
            XL[i] = v; }
    }
#endif
#undef RUN
#undef GRID_BAR
#undef NORM_ROWS
}

#ifndef MK_MULTI
#define MK_MULTI 0
#endif
extern "C" void kernel_launch(void* const* d_in, const int* in_sizes, int n_in, void* d_out, int out_size, void* d_ws, size_t ws_size, hipStream_t stream) {
    static int grid = 0;
    if (grid == 0) {
        if (n_in != 25 || in_sizes[0] != ML * DM || out_size != ML * DM || ws_size < WS_END) {
            fprintf(stderr, "kernel_launch: shape mismatch: n_in %d in0 %d out %d ws %zu (need %zu)\n", n_in, n_in > 0 ? in_sizes[0] : -1, out_size, ws_size, (size_t)WS_END); grid = -1; return; }
        int dev = 0, cus = 0, per_cu = 0;
        if (hipGetDevice(&dev) != hipSuccess || hipDeviceGetAttribute(&cus, hipDeviceAttributeMultiprocessorCount, dev) != hipSuccess) { grid = -1; return; }
        if (hipFuncSetAttribute((const void*)mega_fwd, hipFuncAttributeMaxDynamicSharedMemorySize, LDS_BYTES) != hipSuccess) { fprintf(stderr, "kernel_launch: hipFuncSetAttribute failed\n"); grid = -1; return; }
        if (hipOccupancyMaxActiveBlocksPerMultiprocessor(&per_cu, (const void*)mega_fwd, NWAVES * 64, LDS_BYTES) != hipSuccess || per_cu < 1)
            fprintf(stderr, "kernel_launch: note: occupancy query reports %d workgroups per CU\n", per_cu);
        (void)hipGetLastError();
        grid = cus;
    }
    if (grid < 0) return;
    if (hipMemsetAsync((char*)d_ws + WS_CTL, 0, CTL_ZERO_BYTES, stream) != hipSuccess) return;
    Args a{};
    for (int i = 0; i < 25; ++i) a.in[i] = (const float*)d_in[i];
    a.out = (float*)d_out; a.ws = (unsigned char*)d_ws;
#if defined(DBG_STAGE)
    a.multi = 1;
    a.l_lo = 0; a.l_hi = 0; a.ph = PH_PRE; hipLaunchKernelGGL(mega_fwd, dim3(grid), dim3(NWAVES * 64), LDS_BYTES, stream, a);
    for (int p = 0; p <= DBG_STAGE; ++p) { a.l_lo = 0; a.l_hi = 1; a.ph = p; hipLaunchKernelGGL(mega_fwd, dim3(grid), dim3(NWAVES * 64), LDS_BYTES, stream, a); }
    a.l_lo = 0; a.l_hi = 0; a.ph = PH_DUMP; a.pad0 = DBG_SEL; hipLaunchKernelGGL(mega_fwd, dim3(grid), dim3(NWAVES * 64), LDS_BYTES, stream, a);
#elif MK_MULTI
    a.multi = 1;
    a.l_lo = 0; a.l_hi = 0; a.ph = PH_PRE; hipLaunchKernelGGL(mega_fwd, dim3(grid), dim3(NWAVES * 64), LDS_BYTES, stream, a);
    for (int l = 0; l < DEPTH; ++l) for (int p = 0; p < 10; ++p) { a.l_lo = l; a.l_hi = l + 1; a.ph = p; hipLaunchKernelGGL(mega_fwd, dim3(grid), dim3(NWAVES * 64), LDS_BYTES, stream, a); }
    a.l_lo = 0; a.l_hi = 0; a.ph = PH_POST; hipLaunchKernelGGL(mega_fwd, dim3(grid), dim3(NWAVES * 64), LDS_BYTES, stream, a);
#else
    a.multi = 0; a.l_lo = 0; a.l_hi = DEPTH; a.ph = 0;
    hipLaunchKernelGGL(mega_fwd, dim3(grid), dim3(NWAVES * 64), LDS_BYTES, stream, a);
#endif
    const hipError_t le = hipPeekAtLastError();
    if (le != hipSuccess) fprintf(stderr, "kernel_launch: launch failed: %s\n", hipGetErrorName(le));
}
```

```cpp
#include <hip/hip_runtime.h>
#include <cstdio>
#include <cstdint>
#define GAS __attribute__((address_space(1)))
#define LAS __attribute__((address_space(3)))
namespace pg8 {
#define PG8_LAS __attribute__((address_space(3)))
typedef unsigned short bf16_t;
typedef short bf16x8 __attribute__((ext_vector_type(8)));
typedef float f32x4 __attribute__((ext_vector_type(4)));
typedef unsigned u32x4 __attribute__((ext_vector_type(4)));
constexpr int BM = 256, BK = 64, HALF = 128, HTB = HALF * BK * 2  , STAGE_BYTES = 8 * HTB, NXCD = 8, WGM = 8;

__host__ __device__ __forceinline__ int lds_byte(int r, int c) { const int st = (r >> 4) * 2 + (c >> 5), rr = r & 15, cc = c & 31, ob = rr * 64 + cc * 2; return st * 1024 + (ob ^ (((ob >> 9) & 1) << 5)); }
__host__ __device__ __forceinline__ void stage_rc(int b, int& R, int& C) { const int st = b / 1024, sb = b % 1024, swz = sb ^ (((sb >> 9) & 1) << 5); R = (st >> 1) * 16 + swz / 64; C = (st & 1) * 32 + (swz % 64) / 2; }
__host__ __device__ __forceinline__ int perm32(int rho) { const int n = rho >> 4, i = rho & 15; return 8 * (i >> 2) + 4 * n + (i & 3); }

struct Unit { int pm, pn; };
struct Gemm { const bf16_t* A; const bf16_t* Bt; int M, N, K; };

struct StaticOrder {
    int nM, nN, nwg, G, c, ext_n, ext_pm0, ext_pn0, ext_w, wgm, ext_c0;
    __host__ __device__ void init(int M, int N, int G_, int c_) { nM = M / BM; nN = N / BM; nwg = nM * nN; G = G_; c = c_; ext_n = 0; ext_pm0 = 0; ext_pn0 = 0; ext_w = 1; wgm = WGM; ext_c0 = 0; }
    __host__ __device__ void set_extra(int n, int pm0, int pn0, int w) { ext_n = n; ext_pm0 = pm0; ext_pn0 = pn0; ext_w = w; }
    __host__ __device__ bool next(int i, Unit& u) const {
        const long L = (long)i * G + c;
        if (L >= nwg) { const int e = (int)(L - nwg) - ext_c0; if (e < 0 || e >= ext_n) return false; u.pm = ext_pm0 + e / ext_w; u.pn = ext_pn0 + e % ext_w; return true; }
        int wgid = (int)L; { const int q = nwg / NXCD, r = nwg % NXCD, xcd = wgid % NXCD, off = wgid / NXCD; wgid = (xcd < r ? xcd * (q + 1) : r * (q + 1) + (xcd - r) * q) + off; }
        const int nig = wgm * nN, gid = wgid / nig, fm = gid * wgm, gsz = (nM - fm) < wgm ? (nM - fm) : wgm;
        u.pm = fm + ((wgid % nig) % gsz); u.pn = (wgid % nig) / gsz; return true;
    }
    static __host__ __device__ __forceinline__ void map_entry(int nM_, int nN_, int L, Unit& u, int WGM_ = WGM) {
        const int nwg_ = nM_ * nN_; int wgid = L; { const int q = nwg_ / NXCD, r = nwg_ % NXCD, xcd = wgid % NXCD, off = wgid / NXCD; wgid = (xcd < r ? xcd * (q + 1) : r * (q + 1) + (xcd - r) * q) + off; }
        const int nig = WGM_ * nN_, gid = wgid / nig, fm = gid * WGM_, gsz = (nM_ - fm) < WGM_ ? (nM_ - fm) : WGM_;
        u.pm = fm + ((wgid % nig) % gsz); u.pn = (wgid % nig) / gsz;
    }
    __device__ __forceinline__ void a_ready(const Unit&) const {}
    __device__ __forceinline__ void done(const Unit&) const {}
};
struct MergeOrder : StaticOrder {
    const unsigned* wflag; unsigned* tmo;
    __device__ __forceinline__ void a_ready(const Unit& u) const {
        if (wflag == nullptr || ext_n == 0 || u.pm < ext_pm0) return;
        if (threadIdx.x < 64) {
            const unsigned* f = wflag + (size_t)((u.pm - ext_pm0) * ext_w + (u.pn - ext_pn0)) * 16;
            const unsigned long long t0 = __builtin_amdgcn_s_memrealtime(); unsigned polls = 0;
            while ((unsigned)__builtin_amdgcn_readfirstlane(__hip_atomic_load(f, __ATOMIC_RELAXED, __HIP_MEMORY_SCOPE_AGENT)) == 0u) {
                if ((++polls & 255u) == 0u && __builtin_amdgcn_readfirstlane(__hip_atomic_load(tmo, __ATOMIC_RELAXED, __HIP_MEMORY_SCOPE_AGENT)) != 0u) break;
                if (__builtin_amdgcn_s_memrealtime() - t0 > 2000000ull) { if (threadIdx.x == 0) __hip_atomic_store(tmo, 1u, __ATOMIC_RELAXED, __HIP_MEMORY_SCOPE_AGENT); break; }
                __builtin_amdgcn_s_sleep(2); }
            __builtin_amdgcn_fence(__ATOMIC_ACQUIRE, "agent");
            asm volatile("s_waitcnt vmcnt(0)" ::: "memory");
        }
        asm volatile("" ::: "memory"); __builtin_amdgcn_s_barrier(); asm volatile("" ::: "memory");
    }
};
typedef float f32x2_t __attribute__((ext_vector_type(2))); typedef __bf16 bf16x2_t __attribute__((ext_vector_type(2)));
__device__ __forceinline__ unsigned cvt_pk_bf16(float lo, float hi) { f32x2_t v = {lo, hi}; bf16x2_t b = __builtin_convertvector(v, bf16x2_t); return __builtin_bit_cast(unsigned, b); }
typedef float f32x2 __attribute__((ext_vector_type(2)));
template <class Epi, class Sched, bool ALIGN_EPI = false, bool SP2 = false>
__device__ __forceinline__ void gemm_phase(PG8_LAS unsigned char* lds, const Gemm g, const Sched& S, const Epi& E) {
    int tid_ = threadIdx.x; asm volatile("" : "+v"(tid_));
    const int tid = tid_, wid = __builtin_amdgcn_readfirstlane(tid >> 6), lane = tid & 63, wr = wid >> 2, wc = wid & 3, fr = lane & 15, fq = lane >> 4;
    const int K = g.K, nt = K / BK;
    unsigned voffA[2], voffB[2];
#pragma unroll
    for (int i = 0; i < 2; ++i) { int R, C; stage_rc(tid * 16 + i * 8192, R, C); const int Rb = Epi::PERM ? ((R & ~31) + perm32(R & 31)) : R;
        voffA[i] = (unsigned)(R * K + C) * 2u; voffB[i] = (unsigned)(Rb * K + C) * 2u; }
    const size_t kstep = (size_t)(BK * 2);
    const size_t hstep = (size_t)HALF * K * 2;
    const size_t tstep = 2 * hstep;
    const unsigned ldsw = (unsigned)wid * 1024u;
    const int aoff = lds_byte(wr * 64 + fr, fq * 8), boff = lds_byte(wc * 32 + fr, fq * 8);
#define PG8_SA(b, h) (((b) * 2 + (h)) * HTB)
#define PG8_SB(b, h) ((4 + (b) * 2 + (h)) * HTB)
#define PG8_STAGE(bufoff, gbase, voff) do { _Pragma("unroll") for (int _i = 0; _i < 2; ++_i) \
        __builtin_amdgcn_global_load_lds((const unsigned*)((const char*)(gbase) + (voff)[_i]), (PG8_LAS unsigned*)(lds + (bufoff) + ldsw + _i * 8192), 16, 0, 0); } while (0)
#define PG8_LDA(dst, b, h) do { _Pragma("unroll") for (int m = 0; m < 4; ++m) _Pragma("unroll") for (int k = 0; k < 2; ++k) dst[m][k] = *(const PG8_LAS bf16x8*)(lds + PG8_SA(b, h) + aoff + m * 2048 + k * 1024); } while (0)
#define PG8_LDB(dst, b, h) do { _Pragma("unroll") for (int n = 0; n < 2; ++n) _Pragma("unroll") for (int k = 0; k < 2; ++k) dst[n][k] = *(const PG8_LAS bf16x8*)(lds + PG8_SB(b, h) + boff + n * 2048 + k * 1024); } while (0)
#define PG8_MMA(ai, bj, At, Bt) do { __builtin_amdgcn_s_setprio(1); _Pragma("unroll") for (int m = 0; m < 4; ++m) _Pragma("unroll") for (int n = 0; n < 2; ++n) _Pragma("unroll") for (int k = 0; k < 2; ++k) \
        acc[ai][bj][m][n] = __builtin_amdgcn_mfma_f32_16x16x32_bf16(Bt[n][k], At[m][k], acc[ai][bj][m][n], 0, 0, 0); __builtin_amdgcn_s_setprio(0); } while (0)
#define PG8_WAIT_V(n) asm volatile("s_waitcnt vmcnt(" #n ")" ::: "memory")
#define PG8_WAIT_L(n) asm volatile("s_waitcnt lgkmcnt(" #n ")" ::: "memory")
#define PG8_BAR __builtin_amdgcn_s_barrier()
#define PG8_SCHED __builtin_amdgcn_sched_barrier(0)
    Unit cur, nxt; int ui = 0;
    if (!S.next(0, cur)) return;
    f32x4 acc[2][2][4][2];
#pragma unroll
    for (int a = 0; a < 2; ++a)
#pragma unroll
        for (int b = 0; b < 2; ++b)
#pragma unroll
            for (int m = 0; m < 4; ++m)
#pragma unroll
                for (int n = 0; n < 2; ++n) acc[a][b][m][n] = (f32x4){0.f, 0.f, 0.f, 0.f};
    bf16x8 At[4][2], B0[2][2], B1[2][2];
    const char* cA = (const char*)g.A + (size_t)cur.pm * tstep; const char* cB = (const char*)g.Bt + (size_t)cur.pn * tstep;
    S.a_ready(cur);
    if constexpr (SP2) {
        PG8_STAGE(PG8_SB(0, 0), cB, voffB); PG8_STAGE(PG8_SB(0, 1), cB + hstep, voffB); PG8_STAGE(PG8_SA(0, 0), cA, voffA); PG8_STAGE(PG8_SA(0, 1), cA + hstep, voffA);
        if (wr == 1) PG8_BAR;
        PG8_WAIT_V(2); PG8_BAR;
        PG8_STAGE(PG8_SB(1, 0), cB + kstep, voffB); PG8_STAGE(PG8_SA(1, 0), cA + kstep, voffA); PG8_STAGE(PG8_SB(1, 1), cB + hstep + kstep, voffB);
        PG8_WAIT_V(6); PG8_BAR;
    } else {
        PG8_STAGE(PG8_SB(0, 0), cB, voffB); PG8_STAGE(PG8_SA(0, 0), cA, voffA); PG8_STAGE(PG8_SB(0, 1), cB + hstep, voffB); PG8_STAGE(PG8_SA(0, 1), cA + hstep, voffA);
        if (wr == 1) PG8_BAR;
        PG8_WAIT_V(4); PG8_BAR;
        PG8_STAGE(PG8_SB(1, 0), cB + kstep, voffB); PG8_STAGE(PG8_SA(1, 0), cA + kstep, voffA); PG8_STAGE(PG8_SB(1, 1), cB + hstep + kstep, voffB);
        PG8_WAIT_V(6); PG8_BAR;
    }
    for (;;) {
        const bool has_next = S.next(ui + 1, nxt);
        const char* nA = has_next ? (const char*)g.A + (size_t)nxt.pm * tstep : cA; const char* nB = has_next ? (const char*)g.Bt + (size_t)nxt.pn * tstep : cB;
#pragma nounroll
        for (int t = 0; t < nt; t += 2) {
            const bool last = (t == nt - 2);
            const char* a1 = cA + (size_t)(t + 1) * kstep;
            const char* a2 = last ? nA : cA + (size_t)(t + 2) * kstep; const char* b2 = last ? nB : cB + (size_t)(t + 2) * kstep;
            const char* a3 = a2 + kstep; const char* b3 = b2 + kstep;
            if (last && has_next) S.a_ready(nxt);
            if constexpr (SP2) {
            PG8_LDB(B0, 0, 0); PG8_LDB(B1, 0, 1); PG8_SCHED; PG8_LDA(At, 0, 0); PG8_STAGE(PG8_SA(1, 1), a1 + hstep, voffA);
            PG8_WAIT_V(8); PG8_WAIT_L(0); PG8_BAR; PG8_MMA(0, 0, At, B0); PG8_MMA(0, 1, At, B1); PG8_BAR; PG8_SCHED;
            PG8_LDA(At, 0, 1); PG8_STAGE(PG8_SB(0, 0), b2, voffB); PG8_STAGE(PG8_SB(0, 1), b2 + hstep, voffB); PG8_STAGE(PG8_SA(0, 0), a2, voffA);
            PG8_WAIT_V(8); PG8_WAIT_L(0); PG8_BAR; PG8_MMA(1, 0, At, B0); PG8_MMA(1, 1, At, B1); PG8_BAR; PG8_SCHED;
            PG8_LDB(B0, 1, 0); PG8_LDB(B1, 1, 1); PG8_SCHED; PG8_LDA(At, 1, 0); PG8_STAGE(PG8_SA(0, 1), a2 + hstep, voffA);
            PG8_WAIT_V(8); PG8_WAIT_L(0); PG8_BAR; PG8_MMA(0, 0, At, B0); PG8_MMA(0, 1, At, B1); PG8_BAR; PG8_SCHED;
            PG8_LDA(At, 1, 1); PG8_STAGE(PG8_SB(1, 0), b3, voffB); PG8_STAGE(PG8_SB(1, 1), b3 + hstep, voffB); PG8_STAGE(PG8_SA(1, 0), a3, voffA);
            PG8_WAIT_V(8); PG8_WAIT_L(0); PG8_BAR; PG8_MMA(1, 0, At, B0); PG8_MMA(1, 1, At, B1); PG8_BAR; PG8_SCHED;
            } else {
            PG8_LDB(B0, 0, 0); PG8_SCHED; PG8_LDA(At, 0, 0); PG8_STAGE(PG8_SA(1, 1), a1 + hstep, voffA);
            PG8_WAIT_L(8); PG8_BAR; PG8_WAIT_L(0); PG8_MMA(0, 0, At, B0); PG8_BAR; PG8_SCHED;
            PG8_LDB(B1, 0, 1); PG8_STAGE(PG8_SB(0, 0), b2, voffB);
            PG8_BAR; PG8_WAIT_L(0); PG8_MMA(0, 1, At, B1); PG8_BAR;
            PG8_LDA(At, 0, 1); PG8_STAGE(PG8_SA(0, 0), a2, voffA);
            PG8_BAR; PG8_WAIT_L(0); PG8_MMA(1, 0, At, B0); PG8_BAR; PG8_SCHED;
            PG8_STAGE(PG8_SB(0, 1), b2 + hstep, voffB);
            PG8_WAIT_V(6); PG8_BAR; PG8_MMA(1, 1, At, B1); PG8_BAR;
            PG8_LDB(B0, 1, 0); PG8_SCHED; PG8_LDA(At, 1, 0); PG8_STAGE(PG8_SA(0, 1), a2 + hstep, voffA);
            PG8_WAIT_L(8); PG8_BAR; PG8_WAIT_L(0); PG8_MMA(0, 0, At, B0); PG8_BAR; PG8_SCHED;
            PG8_LDB(B1, 1, 1); PG8_STAGE(PG8_SB(1, 0), b3, voffB);
            PG8_BAR; PG8_WAIT_L(0); PG8_MMA(0, 1, At, B1); PG8_BAR;
            PG8_LDA(At, 1, 1); PG8_STAGE(PG8_SA(1, 0), a3, voffA);
            PG8_BAR; PG8_WAIT_L(0); PG8_MMA(1, 0, At, B0); PG8_BAR; PG8_SCHED;
            PG8_STAGE(PG8_SB(1, 1), b3 + hstep, voffB);
            PG8_WAIT_V(6); PG8_BAR; PG8_MMA(1, 1, At, B1); PG8_BAR;
            }
        }
        if constexpr (ALIGN_EPI) { if (wr == 0) PG8_BAR; }
        if constexpr (!Epi::AFTER_DRAIN) { E(acc, cur, wr, wc, fr, fq); S.done(cur); }
        if (!has_next) break;
#pragma unroll
        for (int a = 0; a < 2; ++a)
#pragma unroll
            for (int b = 0; b < 2; ++b)
#pragma unroll
                for (int m = 0; m < 4; ++m)
#pragma unroll
                    for (int n = 0; n < 2; ++n) acc[a][b][m][n] = (f32x4){0.f, 0.f, 0.f, 0.f};
        cur = nxt; cA = nA; cB = nB; ++ui;
        if constexpr (ALIGN_EPI) { if (wr == 1) PG8_BAR; }
    }
    PG8_WAIT_V(0);
    if constexpr (!ALIGN_EPI) { if (wr == 0) PG8_BAR; }
    PG8_BAR;
    if constexpr (Epi::AFTER_DRAIN) { E.fused(acc, cur, wr, wc, fr, fq, lds, wid, lane); S.done(cur); }
#undef PG8_SA
#undef PG8_SB
#undef PG8_STAGE
#undef PG8_LDA
#undef PG8_LDB
#undef PG8_MMA
#undef PG8_WAIT_V
#undef PG8_WAIT_L
#undef PG8_BAR
#undef PG8_SCHED
}
}
namespace pg8 {
typedef unsigned u32x2 __attribute__((ext_vector_type(2)));
constexpr int ML_ROWS = 32768;
__device__ __forceinline__ float sigm(float x) { return __builtin_amdgcn_rcpf(1.0f + __builtin_amdgcn_exp2f(-1.4426950408889634f * x)); }
__device__ __forceinline__ u32x2 pack4(const f32x4 v) { u32x2 w; w.x = cvt_pk_bf16(v[0], v[1]); w.y = cvt_pk_bf16(v[2], v[3]); return w; }
__device__ __forceinline__ void rope4(f32x4& x0, f32x4& x1, const float* rope, int row, int half, int fq) {
    const int t = row & 4095, p = half ? (t & 63) : (t >> 6);
    const f32x4* tp = (const f32x4*)(rope + (p * 16 + 4 * fq) * 2);
    const f32x4 a = tp[0], b = tp[1];
    const f32x4 c = {a[0], a[2], b[0], b[2]}, s = {a[1], a[3], b[1], b[3]};
    const f32x4 y0 = x0 * c - x1 * s, y1 = x1 * c + x0 * s;
    x0 = y0; x1 = y1;
}
struct EpiWin {
    static constexpr bool PERM = false, AFTER_DRAIN = false;
    unsigned char* G; bf16_t* CQ; bf16_t* KF; bf16_t* GK; bf16_t* GV; bf16_t* GQ; bf16_t* U; const float* rope;
    __device__ __forceinline__ void operator()(const f32x4 (&acc)[2][2][4][2], const Unit& u, int wr, int wc, int fr, int fq) const {
        const int row0 = u.pm * BM + wr * 64 + fr; const bool lat = u.pm < (ML_ROWS / BM);
#pragma unroll
        for (int bj = 0; bj < 2; ++bj) {
            const int colg = u.pn * BM + bj * HALF + wc * 32;
            if (colg < 6144) {
#pragma unroll
                for (int ai = 0; ai < 2; ++ai)
#pragma unroll
                    for (int m = 0; m < 4; ++m) { const size_t row = (size_t)(row0 + ai * HALF + m * 16);
#pragma unroll
                        for (int n = 0; n < 2; ++n) { const f32x4 v = acc[ai][bj][m][n];
#define SG8(x) ((unsigned)(__builtin_amdgcn_rcpf(1.0f + __builtin_amdgcn_exp2f(x)) * 255.0f + 0.5f))
                            const unsigned q0 = SG8(v[0]), q1 = SG8(v[1]), q2 = SG8(v[2]), q3 = SG8(v[3]);
#undef SG8
                            *(unsigned*)(G + row * 6144 + colg + 16 * n + 4 * fq) = q0 | (q1 << 8) | (q2 << 16) | (q3 << 24); } }
            } else {
                const int o = colg - 6144;
                if (o < 256 || (o >= 576 && o < 1088)) {
                    const int co = (o < 256) ? o : (256 + o - 576);
#pragma unroll
                    for (int ai = 0; ai < 2; ++ai)
#pragma unroll
                        for (int m = 0; m < 4; ++m) { const size_t row = (size_t)(row0 + ai * HALF + m * 16);
#pragma unroll
                            for (int n = 0; n < 2; ++n) *(u32x2*)(CQ + row * 768 + co + 16 * n + 4 * fq) = pack4(acc[ai][bj][m][n]); }
                } else if (o < 320) {
                    const int half = (o - 256) >> 5;
#pragma unroll
                    for (int ai = 0; ai < 2; ++ai)
#pragma unroll
                        for (int m = 0; m < 4; ++m) { const int r = row0 + ai * HALF + m * 16; f32x4 x0 = acc[ai][bj][m][0], x1 = acc[ai][bj][m][1];
                            if (lat) rope4(x0, x1, rope, r, half, fq);
                            const u32x2 w0 = pack4(x0), w1 = pack4(x1); bf16_t* p = KF + (size_t)r * 1536 + 128 + (o - 256) + 4 * fq;
#pragma unroll
                            for (int h = 0; h < 8; ++h) { *(u32x2*)(p + h * 192) = w0; *(u32x2*)(p + h * 192 + 16) = w1; } }
                } else if (o < 448 || (o >= 1088 && o < 1600)) {
                    const bool isk = o < 448; const int co = isk ? (o - 320) : (o - 1088); const int half = (co >> 5) & 1;
                    bf16_t* base = isk ? GK : GQ; const int ld = isk ? 128 : 512;
#pragma unroll
                    for (int ai = 0; ai < 2; ++ai)
#pragma unroll
                        for (int m = 0; m < 4; ++m) { const int r = row0 + ai * HALF + m * 16; f32x4 x0 = acc[ai][bj][m][0], x1 = acc[ai][bj][m][1];
                            if (lat) rope4(x0, x1, rope, r, half, fq);
                            bf16_t* p = base + (size_t)r * ld + co + 4 * fq; *(u32x2*)p = pack4(x0); *(u32x2*)(p + 16) = pack4(x1); }
                } else if (o < 576) {
#pragma unroll
                    for (int ai = 0; ai < 2; ++ai)
#pragma unroll
                        for (int m = 0; m < 4; ++m) { const size_t row = (size_t)(row0 + ai * HALF + m * 16); bf16_t* p = GV + row * 128 + (o - 448) + 4 * fq;
                            *(u32x2*)p = pack4(acc[ai][bj][m][0]); *(u32x2*)(p + 16) = pack4(acc[ai][bj][m][1]); }
                } else if (o < 2624) {
                    const int g = (o - 1600) >> 5;
#pragma unroll
                    for (int ai = 0; ai < 2; ++ai)
#pragma unroll
                        for (int m = 0; m < 4; ++m) { const size_t row = (size_t)(row0 + ai * HALF + m * 16); const f32x4 a = acc[ai][bj][m][0], b = acc[ai][bj][m][1];
                            const f32x4 uu = {a[0] * sigm(b[0]), a[1] * sigm(b[1]), a[2] * sigm(b[2]), a[3] * sigm(b[3])};
                            *(u32x2*)(U + row * 512 + 16 * g + 4 * fq) = pack4(uu); }
                }
            }
        }
    }
};
struct EpiQup {
    static constexpr bool PERM = false, AFTER_DRAIN = false;
    bf16_t* MQ; const float* rope;
    __device__ __forceinline__ void operator()(const f32x4 (&acc)[2][2][4][2], const Unit& u, int wr, int wc, int fr, int fq) const {
        const int row0 = u.pm * BM + wr * 64 + fr; const bool lat = u.pm < (ML_ROWS / BM);
#pragma unroll
        for (int bj = 0; bj < 2; ++bj) {
            const int colg = u.pn * BM + bj * HALF + wc * 32, hd = colg % 192; const bool isr = hd >= 128; const int half = (hd - 128) >> 5;
#pragma unroll
            for (int ai = 0; ai < 2; ++ai)
#pragma unroll
                for (int m = 0; m < 4; ++m) { const int r = row0 + ai * HALF + m * 16; f32x4 x0 = acc[ai][bj][m][0], x1 = acc[ai][bj][m][1];
                    if (isr && lat) rope4(x0, x1, rope, r, half, fq);
                    bf16_t* p = MQ + (size_t)r * 1536 + colg + 4 * fq; *(u32x2*)p = pack4(x0); *(u32x2*)(p + 16) = pack4(x1); }
        }
    }
};
struct EpiKV {
    static constexpr bool PERM = true, AFTER_DRAIN = false;
    bf16_t* KF; bf16_t* V;
    __device__ __forceinline__ void operator()(const f32x4 (&acc)[2][2][4][2], const Unit& u, int wr, int wc, int fr, int fq) const {
        const int row0 = u.pm * BM + wr * 64 + fr, c0 = wc * 32 + 8 * fq;
#pragma unroll
        for (int ai = 0; ai < 2; ++ai)
#pragma unroll
            for (int m = 0; m < 4; ++m) { const size_t row = (size_t)(row0 + ai * HALF + m * 16);
#pragma unroll
                for (int bj = 0; bj < 2; ++bj) { const f32x4 v0 = acc[ai][bj][m][0], v1 = acc[ai][bj][m][1];
                    u32x4 w; w.x = cvt_pk_bf16(v0[0], v0[1]); w.y = cvt_pk_bf16(v0[2], v0[3]); w.z = cvt_pk_bf16(v1[0], v1[1]); w.w = cvt_pk_bf16(v1[2], v1[3]);
                    if (bj == 0) *(u32x4*)(KF + row * 1536 + u.pn * 192 + c0) = w; else *(u32x4*)(V + row * 1024 + u.pn * 128 + c0) = w; } }
    }
};
template <int STEP> struct EpiMerge {
    static constexpr bool PERM = true, AFTER_DRAIN = false;
    const unsigned char* G; bf16_t* YF; bf16_t* Y; int wt_pm;
    __device__ __forceinline__ void operator()(const f32x4 (&acc)[2][2][4][2], const Unit& u, int wr, int wc, int fr, int fq) const {
        constexpr int NBATCH = 4;
        const int row0 = u.pm * BM + wr * 64 + fr, col0 = u.pn * BM + wc * 32 + 8 * fq;
        bf16_t* dst = (STEP < 2) ? YF : Y;
        const bool wt = (STEP < 2) && (u.pm >= wt_pm);
#pragma unroll
        for (int ai = 0; ai < 2; ++ai)
#pragma unroll
            for (int mb = 0; mb < 4; mb += NBATCH) {
                u32x2 gw[NBATCH][2]; u32x4 yv[NBATCH][2];
#pragma unroll
                for (int q = 0; q < NBATCH; ++q) { const size_t row = (size_t)(row0 + ai * HALF + (mb + q) * 16);
#pragma unroll
                    for (int bj = 0; bj < 2; ++bj) { const int c = col0 + bj * HALF;
                        gw[q][bj] = *(const u32x2*)(G + row * 6144 + STEP * 2048 + c);
                        if (STEP > 0) yv[q][bj] = *(const u32x4*)(YF + row * 2048 + c); } }
#pragma unroll
                for (int q = 0; q < NBATCH; ++q) { const size_t row = (size_t)(row0 + ai * HALF + (mb + q) * 16); const int m = mb + q;
#pragma unroll
                    for (int bj = 0; bj < 2; ++bj) { const int c = col0 + bj * HALF; const u32x2 g2 = gw[q][bj]; constexpr float I255 = 1.0f / 255.0f;
                        const f32x4 g0 = {(float)(g2.x & 255u) * I255, (float)((g2.x >> 8) & 255u) * I255, (float)((g2.x >> 16) & 255u) * I255, (float)(g2.x >> 24) * I255};
                        const f32x4 g1 = {(float)(g2.y & 255u) * I255, (float)((g2.y >> 8) & 255u) * I255, (float)((g2.y >> 16) & 255u) * I255, (float)(g2.y >> 24) * I255};
                        f32x4 a0 = acc[ai][bj][m][0] * g0, a1 = acc[ai][bj][m][1] * g1;
                        if (STEP > 0) { const u32x4 y4 = yv[q][bj];
                            a0 += (f32x4){__uint_as_float(y4.x << 16), __uint_as_float(y4.x & 0xffff0000u), __uint_as_float(y4.y << 16), __uint_as_float(y4.y & 0xffff0000u)};
                            a1 += (f32x4){__uint_as_float(y4.z << 16), __uint_as_float(y4.z & 0xffff0000u), __uint_as_float(y4.w << 16), __uint_as_float(y4.w & 0xffff0000u)}; }
                        u32x4 w; w.x = cvt_pk_bf16(a0[0], a0[1]); w.y = cvt_pk_bf16(a0[2], a0[3]); w.z = cvt_pk_bf16(a1[0], a1[1]); w.w = cvt_pk_bf16(a1[2], a1[3]);
                        if (wt) asm volatile("global_store_dwordx4 %0, %1, off sc1" :: "v"(dst + row * 2048 + c), "v"(w) : "memory");
                        else *(u32x4*)(dst + row * 2048 + c) = w; } }
                asm volatile("" ::: "memory"); }
    }
};
struct EpiResid {
    static constexpr bool PERM = false, AFTER_DRAIN = false;
    bf16_t* XB; const float* modl; int goff;
    __device__ __forceinline__ void operator()(const f32x4 (&acc)[2][2][4][2], const Unit& u, int wr, int wc, int fr, int fq) const {
        const int sel = u.pm >> 4;
        const int col0 = u.pn * BM + wc * 32 + 4 * fq; const float* gt = modl + sel * 12288 + goff + col0;
        bf16_t* base = XB + (size_t)(u.pm * BM + wr * 64 + fr) * 2048;
        f32x4 gv[2][2];
#pragma unroll
        for (int bj = 0; bj < 2; ++bj)
#pragma unroll
            for (int n = 0; n < 2; ++n) gv[bj][n] = *(const f32x4*)(gt + bj * HALF + n * 16);
#pragma unroll
        for (int ai = 0; ai < 2; ++ai) {
            u32x2 xr[4][2][2];
#pragma unroll
            for (int m = 0; m < 4; ++m) { const bf16_t* rowp = base + (size_t)(ai * HALF + m * 16) * 2048 + col0;
#pragma unroll
                for (int bj = 0; bj < 2; ++bj)
#pragma unroll
                    for (int n = 0; n < 2; ++n) xr[m][bj][n] = *(const u32x2*)(rowp + bj * HALF + n * 16); }
#pragma unroll
            for (int m = 0; m < 4; ++m) { bf16_t* rowp = base + (size_t)(ai * HALF + m * 16) * 2048 + col0;
#pragma unroll
                for (int bj = 0; bj < 2; ++bj)
#pragma unroll
                    for (int n = 0; n < 2; ++n) { const u32x2 t = xr[m][bj][n];
                        const f32x4 x = {__uint_as_float(t.x << 16), __uint_as_float(t.x & 0xffff0000u), __uint_as_float(t.y << 16), __uint_as_float(t.y & 0xffff0000u)};
                        *(u32x2*)(rowp + bj * HALF + n * 16) = pack4(x + gv[bj][n] * acc[ai][bj][m][n]); } }
            asm volatile("" ::: "memory"); }
    }
};
struct EpiSwiGLU {
    static constexpr bool PERM = false, AFTER_DRAIN = false;
    bf16_t* HID;
    __device__ __forceinline__ void operator()(const f32x4 (&acc)[2][2][4][2], const Unit& u, int wr, int wc, int fr, int fq) const {
        const int row0 = u.pm * BM + wr * 64 + fr, c0 = u.pn * 128 + wc * 16 + 4 * fq;
#pragma unroll
        for (int ai = 0; ai < 2; ++ai)
#pragma unroll
            for (int m = 0; m < 4; ++m) { bf16_t* rowp = HID + (size_t)(row0 + ai * HALF + m * 16) * 5632 + c0;
#pragma unroll
                for (int bj = 0; bj < 2; ++bj) { const f32x4 a = acc[ai][bj][m][0], b = acc[ai][bj][m][1];
                    const f32x4 h = {a[0] * sigm(a[0]) * b[0], a[1] * sigm(a[1]) * b[1], a[2] * sigm(a[2]) * b[2], a[3] * sigm(a[3]) * b[3]};
                    *(u32x2*)(rowp + bj * 64) = pack4(h); } }
    }
};
}
namespace pg8 {
struct UnitX { int pm, pn, kind; };
template <class Epi, class Sched, bool CHAIN = false>
__device__ __forceinline__ void gemm_stream(PG8_LAS unsigned char* lds, const Sched& S, const Epi& E) {
    int tid_ = threadIdx.x; asm volatile("" : "+v"(tid_));
    const int tid = tid_, wid = __builtin_amdgcn_readfirstlane(tid >> 6), lane = tid & 63, wr = wid >> 2, wc = wid & 3, fr = lane & 15, fq = lane >> 4;
    int Rn, Rp, C2; { int R, C; stage_rc(tid * 16, R, C); Rn = R; Rp = (R & ~31) + perm32(R & 31); C2 = C * 2; }
    const size_t kstep = (size_t)(BK * 2);
    const unsigned ldsw = (unsigned)wid * 1024u;
    const int aoff = lds_byte(wr * 64 + fr, fq * 8), boff = lds_byte(wc * 32 + fr, fq * 8);
#define PG8_SA(b, h) (((b) * 2 + (h)) * HTB)
#define PG8_SB(b, h) ((4 + (b) * 2 + (h)) * HTB)
#define PG8_STAGE(bufoff, gbase, voff, r64) do { \
        __builtin_amdgcn_global_load_lds((const unsigned*)((const char*)(gbase) + (voff)), (PG8_LAS unsigned*)(lds + (bufoff) + ldsw), 16, 0, 0); \
        __builtin_amdgcn_global_load_lds((const unsigned*)((const char*)(gbase) + (r64) + (voff)), (PG8_LAS unsigned*)(lds + (bufoff) + ldsw + 8192), 16, 0, 0); } while (0)
#define PG8_LDA(dst, b, h) do { _Pragma("unroll") for (int m = 0; m < 4; ++m) _Pragma("unroll") for (int k = 0; k < 2; ++k) dst[m][k] = *(const PG8_LAS bf16x8*)(lds + PG8_SA(b, h) + aoff + m * 2048 + k * 1024); } while (0)
#define PG8_LDB(dst, b, h) do { _Pragma("unroll") for (int n = 0; n < 2; ++n) _Pragma("unroll") for (int k = 0; k < 2; ++k) dst[n][k] = *(const PG8_LAS bf16x8*)(lds + PG8_SB(b, h) + boff + n * 2048 + k * 1024); } while (0)
#define PG8_MMA(ai, bj, At, Bt) do { __builtin_amdgcn_s_setprio(1); _Pragma("unroll") for (int m = 0; m < 4; ++m) _Pragma("unroll") for (int n = 0; n < 2; ++n) _Pragma("unroll") for (int k = 0; k < 2; ++k) \
        acc[ai][bj][m][n] = __builtin_amdgcn_mfma_f32_16x16x32_bf16(Bt[n][k], At[m][k], acc[ai][bj][m][n], 0, 0, 0); __builtin_amdgcn_s_setprio(0); } while (0)
#define PG8_WAIT_V(n) asm volatile("s_waitcnt vmcnt(" #n ")" ::: "memory")
#define PG8_WAIT_L(n) asm volatile("s_waitcnt lgkmcnt(" #n ")" ::: "memory")
#define PG8_BAR __builtin_amdgcn_s_barrier()
#define PG8_SCHED __builtin_amdgcn_sched_barrier(0)
    UnitX cur, nxt; int ui = 0;
    if (!S.next(0, cur)) return;
    f32x4 acc[2][2][4][2];
#pragma unroll
    for (int a = 0; a < 2; ++a)
#pragma unroll
        for (int b = 0; b < 2; ++b)
#pragma unroll
            for (int m = 0; m < 4; ++m)
#pragma unroll
                for (int n = 0; n < 2; ++n) acc[a][b][m][n] = (f32x4){0.f, 0.f, 0.f, 0.f};
    bf16x8 At[4][2], B0[2][2], B1[2][2];
    int K2 = S.gPitch(cur.kind) * 2;
    unsigned voA = (unsigned)(Rn * K2 + C2), voB = (unsigned)((S.gPerm(cur.kind) ? Rp : Rn) * K2 + C2);
    size_t r64 = (size_t)64 * K2, hstep = (size_t)HALF * K2;
    int nt = S.gNt(cur.kind);
    const char* cA = (const char*)S.gA(cur.kind) + (size_t)cur.pm * 2 * hstep + (size_t)S.gK0(cur.kind) * 2; const char* cB = (const char*)S.gB(cur.kind) + (size_t)cur.pn * 2 * hstep + (size_t)S.gK0(cur.kind) * 2;
    PG8_STAGE(PG8_SB(0, 0), cB, voB, r64); PG8_STAGE(PG8_SB(0, 1), cB + hstep, voB, r64); PG8_STAGE(PG8_SA(0, 0), cA, voA, r64); PG8_STAGE(PG8_SA(0, 1), cA + hstep, voA, r64);
    if (wr == 1) PG8_BAR;
    PG8_WAIT_V(2); PG8_BAR;
    PG8_STAGE(PG8_SB(1, 0), cB + kstep, voB, r64); PG8_STAGE(PG8_SA(1, 0), cA + kstep, voA, r64); PG8_STAGE(PG8_SB(1, 1), cB + hstep + kstep, voB, r64);
    PG8_WAIT_V(6); PG8_BAR;
    for (;;) {
        const bool has_next = S.next(ui + 1, nxt);
        const int nkind = has_next ? nxt.kind : cur.kind;
        const int nK2 = S.gPitch(nkind) * 2;
        const unsigned nvoA = (unsigned)(Rn * nK2 + C2), nvoB = (unsigned)((S.gPerm(nkind) ? Rp : Rn) * nK2 + C2);
        const size_t nr64 = (size_t)64 * nK2, nhstep = (size_t)HALF * nK2;
        const char* nA = has_next ? (const char*)S.gA(nkind) + (size_t)nxt.pm * 2 * nhstep + (size_t)S.gK0(nkind) * 2 : cA; const char* nB = has_next ? (const char*)S.gB(nkind) + (size_t)nxt.pn * 2 * nhstep + (size_t)S.gK0(nkind) * 2 : cB;
#pragma nounroll
        for (int t = 0; t < nt; t += 2) {
            const bool last = (t == nt - 2);
            const char* a1 = cA + (size_t)(t + 1) * kstep;
            const char* a2 = last ? nA : cA + (size_t)(t + 2) * kstep; const char* b2 = last ? nB : cB + (size_t)(t + 2) * kstep;
            const char* a3 = a2 + kstep; const char* b3 = b2 + kstep;
            const unsigned vA2 = last ? nvoA : voA, vB2 = last ? nvoB : voB; const size_t r2 = last ? nr64 : r64, h2 = last ? nhstep : hstep;
            PG8_LDB(B0, 0, 0); PG8_LDB(B1, 0, 1); PG8_SCHED; PG8_LDA(At, 0, 0); PG8_STAGE(PG8_SA(1, 1), a1 + hstep, voA, r64);
            PG8_WAIT_V(8); PG8_WAIT_L(0); PG8_BAR; PG8_MMA(0, 0, At, B0); PG8_MMA(0, 1, At, B1); PG8_BAR; PG8_SCHED;
            PG8_LDA(At, 0, 1); PG8_STAGE(PG8_SB(0, 0), b2, vB2, r2); PG8_STAGE(PG8_SB(0, 1), b2 + h2, vB2, r2); PG8_STAGE(PG8_SA(0, 0), a2, vA2, r2);
            PG8_WAIT_V(8); PG8_WAIT_L(0); PG8_BAR; PG8_MMA(1, 0, At, B0); PG8_MMA(1, 1, At, B1); PG8_BAR; PG8_SCHED;
            PG8_LDB(B0, 1, 0); PG8_LDB(B1, 1, 1); PG8_SCHED; PG8_LDA(At, 1, 0); PG8_STAGE(PG8_SA(0, 1), a2 + h2, vA2, r2);
            PG8_WAIT_V(8); PG8_WAIT_L(0); PG8_BAR; PG8_MMA(0, 0, At, B0); PG8_MMA(0, 1, At, B1); PG8_BAR; PG8_SCHED;
            PG8_LDA(At, 1, 1); PG8_STAGE(PG8_SB(1, 0), b3, vB2, r2); PG8_STAGE(PG8_SB(1, 1), b3 + h2, vB2, r2); PG8_STAGE(PG8_SA(1, 0), a3, vA2, r2);
            PG8_WAIT_V(8); PG8_WAIT_L(0); PG8_BAR; PG8_MMA(1, 0, At, B0); PG8_MMA(1, 1, At, B1); PG8_BAR; PG8_SCHED;
        }
        if (wr == 0) PG8_BAR;
        if constexpr (CHAIN) E.chain(acc, cur.pm, cur.pn, cur.kind, wr, wc, fr, fq); else E(acc, cur.pm, cur.pn, cur.kind, wr, wc, fr, fq);
        if (!has_next) break;
        bool clr_ = true; if constexpr (CHAIN) clr_ = (cur.kind == Epi::LAST_KIND);
        if (clr_)
#pragma unroll
        for (int a = 0; a < 2; ++a)
#pragma unroll
            for (int b = 0; b < 2; ++b)
#pragma unroll
                for (int m = 0; m < 4; ++m)
#pragma unroll
                    for (int n = 0; n < 2; ++n) acc[a][b][m][n] = (f32x4){0.f, 0.f, 0.f, 0.f};
        cur.pm = nxt.pm; cur.pn = nxt.pn; cur.kind = nxt.kind; cA = nA; cB = nB; K2 = nK2; voA = nvoA; voB = nvoB; r64 = nr64; hstep = nhstep; nt = S.gNt(nkind); ++ui;
        if (wr == 1) PG8_BAR;
    }
    PG8_WAIT_V(0);
    PG8_BAR;
#undef PG8_SA
#undef PG8_SB
#undef PG8_STAGE
#undef PG8_LDA
#undef PG8_LDB
#undef PG8_MMA
#undef PG8_WAIT_V
#undef PG8_WAIT_L
#undef PG8_BAR
#undef PG8_SCHED
}
struct SchedMerge {
    StaticOrder base; const char* a0; long da1, da2; const char* b0; long db1, db2;
    __device__ __forceinline__ bool next(int i, UnitX& u) const { Unit b; const int q = i / 3; const bool ok = base.next(q, b); u.pm = b.pm; u.pn = b.pn; u.kind = i - 3 * q; return ok; }
    __device__ __forceinline__ const bf16_t* gA(int k) const { return (const bf16_t*)(a0 + (k > 0 ? da1 : 0l) + (k > 1 ? da2 : 0l)); }
    __device__ __forceinline__ const bf16_t* gB(int k) const { return (const bf16_t*)(b0 + (k > 0 ? db1 : 0l) + (k > 1 ? db2 : 0l)); }
    __device__ __forceinline__ int gPitch(int k) const { return k == 1 ? 1024 : 512; }
    __device__ __forceinline__ int gNt(int k) const { return k == 1 ? 16 : 8; }
    __device__ __forceinline__ int gK0(int) const { return 0; }
    __device__ __forceinline__ int gPerm(int) const { return 1; }
};
struct EpiMergeAll {
    EpiMerge<0> e0; EpiMerge<1> e1; EpiMerge<2> e2;
    __device__ __forceinline__ void operator()(const f32x4 (&acc)[2][2][4][2], int pm, int pn, int kind, int wr, int wc, int fr, int fq) const {
        Unit u; u.pm = pm; u.pn = pn;
        if (kind == 0) e0(acc, u, wr, wc, fr, fq); else if (kind == 1) e1(acc, u, wr, wc, fr, fq); else e2(acc, u, wr, wc, fr, fq);
    }
};
struct EpiChain {
    static constexpr int LAST_KIND = 2;
    const unsigned char* G; bf16_t* Y;
    __device__ __forceinline__ void chain(f32x4 (&acc)[2][2][4][2], int pm, int pn, int kind, int wr, int wc, int fr, int fq) const {
        const int row0 = pm * BM + wr * 64 + fr, col0 = pn * BM + wc * 32 + 8 * fq;
        const unsigned char* ga = G + (kind == 2 ? 2 : kind) * 2048; const unsigned char* gb = G + (kind == 0 ? 1 : 2) * 2048;
#pragma unroll
        for (int ai = 0; ai < 2; ++ai) {
            u32x2 qa[4][2], qb[4][2];
#pragma unroll
            for (int m = 0; m < 4; ++m) { const size_t row = (size_t)(row0 + ai * HALF + m * 16);
#pragma unroll
                for (int bj = 0; bj < 2; ++bj) { const int c = col0 + bj * HALF; qa[m][bj] = *(const u32x2*)(ga + row * 6144 + c); qb[m][bj] = *(const u32x2*)(gb + row * 6144 + c); } }
#pragma unroll
            for (int m = 0; m < 4; ++m) { const size_t row = (size_t)(row0 + ai * HALF + m * 16);
#pragma unroll
                for (int bj = 0; bj < 2; ++bj) { const int c = col0 + bj * HALF;
                    f32x4 r[2];
#pragma unroll
                    for (int n = 0; n < 2; ++n) { const unsigned wa = n == 0 ? qa[m][bj].x : qa[m][bj].y, wb = n == 0 ? qb[m][bj].x : qb[m][bj].y;
#pragma unroll
                        for (int e = 0; e < 4; ++e) { const unsigned a8 = (wa >> (8 * e)) & 255u, b8 = (wb >> (8 * e)) & 255u;
                            const float fa = (float)(kind == 0 ? a8 : (a8 > 1u ? a8 : 1u)), fb = (float)(b8 > 1u ? b8 : 1u);
                            r[n][e] = (kind == 2) ? fa * (1.0f / 255.0f) : fa * __builtin_amdgcn_rcpf(fb); } }
                    acc[ai][bj][m][0] *= r[0]; acc[ai][bj][m][1] *= r[1];
                    if (kind == 2) { const f32x4 a0 = acc[ai][bj][m][0], a1 = acc[ai][bj][m][1];
                        u32x4 w; w.x = cvt_pk_bf16(a0[0], a0[1]); w.y = cvt_pk_bf16(a0[2], a0[3]); w.z = cvt_pk_bf16(a1[0], a1[1]); w.w = cvt_pk_bf16(a1[2], a1[3]);
                        *(u32x4*)(Y + row * 2048 + c) = w; } } }
            asm volatile("" ::: "memory"); }
    }
};
struct SchedQKV {
    int nMq, nNq, nMk, nNk, G, c; const bf16_t* Aq; const bf16_t* Bq; const bf16_t* Ak; const bf16_t* Bk;
    __device__ __forceinline__ bool next(int i, UnitX& u) const {
        const int L = i * G + c, nq = nMq * nNq;
        Unit b; b.pm = 0; b.pn = 0; bool ok = true; int kind = 0;
        if (L < nq) StaticOrder::map_entry(nMq, nNq, L, b);
        else { const int L2 = L - nq; kind = 1; ok = L2 < nMk * nNk; if (ok) StaticOrder::map_entry(nMk, nNk, L2, b); }
        u.pm = b.pm; u.pn = b.pn; u.kind = kind; return ok;
    }
    __device__ __forceinline__ const bf16_t* gA(int k) const { return k == 0 ? Aq : Ak; }
    __device__ __forceinline__ const bf16_t* gB(int k) const { return k == 0 ? Bq : Bk; }
    __device__ __forceinline__ int gPitch(int k) const { return k == 0 ? 512 : 256; }
    __device__ __forceinline__ int gNt(int k) const { return k == 0 ? 8 : 4; }
    __device__ __forceinline__ int gK0(int) const { return 0; }
    __device__ __forceinline__ int gPerm(int k) const { return k; }
};
struct EpiQKV {
    EpiQup eq; EpiKV ek;
    __device__ __forceinline__ void operator()(const f32x4 (&acc)[2][2][4][2], int pm, int pn, int kind, int wr, int wc, int fr, int fq) const {
        Unit u; u.pm = pm; u.pn = pn;
        if (kind == 0) eq(acc, u, wr, wc, fr, fq); else ek(acc, u, wr, wc, fr, fq);
    }
};
struct SchedSplit {
    const bf16_t* A; const bf16_t* Bt; int K, nlat, nctx, G, c, wgm;
    __device__ __forceinline__ bool next(int i, UnitX& u) const {
        const int L = i * G + c; Unit b; b.pm = 0; b.pn = 0; int kind = 0; bool ok = true;
        if (L < nlat) StaticOrder::map_entry(ML_ROWS / BM, 8, L, b, wgm);
        else { const int e = L - nlat; ok = e < nctx; b.pm = ML_ROWS / BM + (e >> 5); b.pn = (e >> 2) & 7; kind = 1 + (e & 3); }
        u.pm = b.pm; u.pn = b.pn; u.kind = kind; return ok;
    }
    __device__ __forceinline__ const bf16_t* gA(int) const { return A; }
    __device__ __forceinline__ const bf16_t* gB(int) const { return Bt; }
    __device__ __forceinline__ int gPitch(int) const { return K; }
    __device__ __forceinline__ int gNt(int k) const { return k == 0 ? K / BK : K / (4 * BK); }
    __device__ __forceinline__ int gK0(int k) const { return k == 0 ? 0 : (k - 1) * (K / 4); }
    __device__ __forceinline__ int gPerm(int) const { return 0; }
};
struct EpiSplit {
    EpiResid er; bf16_t* PART;
    __device__ __forceinline__ void operator()(const f32x4 (&acc)[2][2][4][2], int pm, int pn, int kind, int wr, int wc, int fr, int fq) const {
        Unit u; u.pm = pm; u.pn = pn;
        if (kind == 0) { er(acc, u, wr, wc, fr, fq); return; }
        bf16_t* base = PART + ((size_t)(kind - 1) * 2048 + (size_t)(pm * BM - ML_ROWS + wr * 64 + fr)) * 2048 + pn * BM + wc * 32 + 4 * fq;
#pragma unroll
        for (int ai = 0; ai < 2; ++ai)
#pragma unroll
            for (int m = 0; m < 4; ++m) { bf16_t* rowp = base + (size_t)(ai * HALF + m * 16) * 2048;
#pragma unroll
                for (int bj = 0; bj < 2; ++bj)
#pragma unroll
                    for (int n = 0; n < 2; ++n) *(u32x2*)(rowp + bj * HALF + n * 16) = pack4(acc[ai][bj][m][n]); }
    }
};
}
#define XB_TMO      128
#define XB_XCNT(j)  (256  + 64 * (j))
#define XB_XSUB(j)  (1280 + 64 * (j))
#define XB_XGEN(j)  (2304 + 64 * (j))
#define XB_TOP      3328
#define XB_TOPGEN   3392
#define XCD_BAR_WORDS 3456
#define XB_SPIN_CAP (1u << 18)

__device__ __forceinline__ unsigned xb_ld(unsigned* p)              { return __hip_atomic_load(p, __ATOMIC_RELAXED, __HIP_MEMORY_SCOPE_AGENT); }
__device__ __forceinline__ unsigned xb_add(unsigned* p, unsigned v) { return __hip_atomic_fetch_add(p, v, __ATOMIC_RELAXED, __HIP_MEMORY_SCOPE_AGENT); }
__device__ __forceinline__ unsigned xb_xcc_id() { return (unsigned)__builtin_amdgcn_s_getreg((3 << 11) | 20) & 0xFu; }
#define XB_SPIN(cond, bar) do { unsigned _sp = 0; while (cond) { __builtin_amdgcn_s_sleep(1); \
    if ((++_sp & 255u) == 0u) { if (xb_ld(&(bar)[XB_TMO])) break; if (_sp > XB_SPIN_CAP) { atomicAdd(&(bar)[XB_TMO], 1u); break; } } } } while (0)

struct XcdBarrier {
    unsigned* bar; unsigned x;
    volatile LAS unsigned* st;
};

__device__ __forceinline__ XcdBarrier xcd_barrier_post(unsigned* bar, volatile LAS unsigned* st) {
    XcdBarrier b; b.bar = bar; b.x = xb_xcc_id(); b.st = st;
    if (threadIdx.x == 0) (void)xb_add(&bar[XB_XCNT(b.x)], 1u);
    return b;
}
__device__ __forceinline__ void xcd_barrier_complete(unsigned* bar, unsigned x, unsigned& nloc, unsigned& nx) {
    const unsigned G = gridDim.x * gridDim.y * gridDim.z;
    unsigned sum, cnt, mine, sp = 0u;
    for (;;) {
        sum = 0u; cnt = 0u; mine = 0u;
#pragma unroll
        for (unsigned j = 0; j < 16; ++j) { const unsigned c = xb_ld(&bar[XB_XCNT(j)]); sum += c; cnt += (c > 0u) ? 1u : 0u; mine = (j == x) ? c : mine; }
        if (sum == G) break;
        __builtin_amdgcn_s_sleep(1);
        if ((++sp & 255u) == 0u) { if (xb_ld(&bar[XB_TMO])) break; if (sp > XB_SPIN_CAP) { atomicAdd(&bar[XB_TMO], 1u); break; } }
    }
    nloc = mine > 0u ? mine : 1u; nx = cnt > 0u ? cnt : 1u;
}

__device__ __forceinline__ void xcd_barrier(const XcdBarrier& b) {
    asm volatile("s_waitcnt vmcnt(0)" ::: "memory");
    __syncthreads();
    if (threadIdx.x == 0) {
        unsigned* bar = b.bar;
        __builtin_amdgcn_s_waitcnt(0);
        unsigned nloc = b.st[0], nx = b.st[1];
        if (nloc == 0u) { xcd_barrier_complete(bar, b.x, nloc, nx); b.st[0] = nloc; b.st[1] = nx; }
        const unsigned old = xb_add(&bar[XB_XSUB(b.x)], 1u);
        const unsigned gen = old / nloc;
        if (old + 1u == (gen + 1u) * nloc) {
            __builtin_amdgcn_fence(__ATOMIC_RELEASE, "agent");
            asm volatile("s_waitcnt vmcnt(0)" ::: "memory");
            const unsigned og = xb_add(&bar[XB_TOP], 1u);
            const unsigned tg = og / nx;
            if (og + 1u == (tg + 1u) * nx) xb_add(&bar[XB_TOPGEN], 1u);
            else XB_SPIN(xb_ld(&bar[XB_TOPGEN]) == tg, bar);
            __builtin_amdgcn_fence(__ATOMIC_ACQUIRE, "agent");
            xb_add(&bar[XB_XGEN(b.x)], 1u);
            asm volatile("s_waitcnt vmcnt(0)" ::: "memory");
        } else {
            XB_SPIN(xb_ld(&bar[XB_XGEN(b.x)]) == gen, bar);
            __builtin_amdgcn_fence(__ATOMIC_ACQUIRE, "agent");
            asm volatile("s_waitcnt vmcnt(0)" ::: "memory");
        }
    }
    __syncthreads();
}
#ifndef ATT_ILV
#define ATT_ILV 1
#endif
#ifndef ATT_DMAW
#define ATT_DMAW 4
#endif
#ifndef ATT_YOUNG_FROM
#define ATT_YOUNG_FROM (ATT_ILV ? 512 : 256)
#endif
namespace att {
typedef unsigned short bf16_t;
using bf16x8 = __attribute__((ext_vector_type(8))) short;
using s16x4  = __attribute__((ext_vector_type(4))) short;
using f32x16 = __attribute__((ext_vector_type(16))) float;
using u32x4  = __attribute__((ext_vector_type(4))) unsigned;
typedef LAS char lchar;
#define ASBAR() __builtin_amdgcn_sched_barrier(0)
__device__ __forceinline__ int crow(int r, int hi) { return (r & 3) + 8 * (r >> 2) + 4 * hi; }
__device__ __forceinline__ unsigned cvtpk(float lo, float hi) { return pg8::cvt_pk_bf16(lo, hi); }
template <int DK> __device__ __forceinline__ int koff(int row, int chunk) {
    return row * (DK * 2) + ((chunk & ~7) << 4) + (((chunk & 7) ^ ((row >> 1) & 7)) << 4);
}
template <int DV> __device__ __forceinline__ int v_st(int k, int c) { constexpr int NCB = DV / 32; const int kk = (k & ~0xC) | ((k & 4) << 1) | ((k & 8) >> 1); return ((kk >> 3) * NCB + (c >> 5)) * 512 + ((kk & 7) * 32 + (c & 31)) * 2; }
__device__ __forceinline__ int v_rd_base(int lane) { return ((lane & 3) << 3) | (((lane >> 2) & 3) << 6) | (((lane >> 4) & 1) << 5) | (((lane >> 5) & 1) << 8); }
template <int DV> constexpr int v_rd_off(int d0, int ks, int half) { return d0 * 512 + ks * (2 * (DV / 32) * 512) + half * ((DV / 32) * 512); }
#if ATT_ILV
template <int OFF> __device__ __forceinline__ s16x4 tr_read(int vb) { return __builtin_amdgcn_ds_read_tr16_b64_v4i16((LAS s16x4*)(unsigned)(vb + OFF)); }
#else
template <int OFF> __device__ __forceinline__ s16x4 tr_read(int vb) { s16x4 r; asm volatile("ds_read_b64_tr_b16 %0, %1 offset:%2" : "=&v"(r) : "v"(vb), "i"(OFF) : "memory"); return r; }
#endif

__device__ __forceinline__ void glds16(const void* gsrc, unsigned lds_dst) { unsigned keep; lds_dst = __builtin_amdgcn_readfirstlane(lds_dst);
    asm volatile("s_mov_b32 %0, m0\n\ts_mov_b32 m0, %2\n\ts_nop 0\n\tglobal_load_lds_dwordx4 %1, off\n\ts_mov_b32 m0, %0" : "=&s"(keep) : "v"(gsrc), "s"(lds_dst) : "memory"); }
__device__ __forceinline__ void glds16s(const void* sbase, unsigned voff, unsigned lds_dst) { unsigned keep; lds_dst = __builtin_amdgcn_readfirstlane(lds_dst);
    const unsigned long long b = (unsigned long long)sbase; const unsigned blo = __builtin_amdgcn_readfirstlane((unsigned)b), bhi = __builtin_amdgcn_readfirstlane((unsigned)(b >> 32));
    const unsigned long long sb = ((unsigned long long)bhi << 32) | blo;
    asm volatile("s_mov_b32 %0, m0\n\ts_mov_b32 m0, %3\n\ts_nop 0\n\tglobal_load_lds_dwordx4 %1, %2\n\ts_mov_b32 m0, %0" : "=&s"(keep) : "v"(voff), "s"(sb), "s"(lds_dst) : "memory"); }
template <bool WIN>
__device__ __forceinline__ void partialSM(f32x16& p0, f32x16& p1, float& m_reg, float& mn, float& alpha, const float C, const float thr, const bool domask, const int dq, const int hi) {
#if ATT_ILV
    if constexpr (WIN) { const int dqq = domask ? dq : 0;
#pragma unroll
        for (int r = 0; r < 16; ++r) { const int d0 = dqq + crow(r, hi), d1 = d0 + 32; p0[r] = (d0 > 128 || d0 < -128) ? -1e30f : p0[r]; p1[r] = (d1 > 128 || d1 < -128) ? -1e30f : p1[r]; } }
#else
    if constexpr (WIN) { if (domask) {
#pragma unroll
        for (int r = 0; r < 16; ++r) { const int d0 = dq + crow(r, hi), d1 = d0 + 32; if (d0 > 128 || d0 < -128) p0[r] = -1e30f; if (d1 > 128 || d1 < -128) p1[r] = -1e30f; } } }
#endif
    float pmax = p0[0];
#pragma unroll
    for (int r = 1; r < 16; ++r) pmax = fmaxf(pmax, p0[r]);
#pragma unroll
    for (int r = 0; r < 16; ++r) pmax = fmaxf(pmax, p1[r]);
    { auto rr = __builtin_amdgcn_permlane32_swap(__float_as_uint(pmax), __float_as_uint(pmax), false, false); pmax = fmaxf(__uint_as_float(rr[0]), __uint_as_float(rr[1])); }
#if ATT_ILV
    { const bool keep = __all(pmax - m_reg <= thr); mn = fmaxf(m_reg, keep ? m_reg : pmax); alpha = __builtin_amdgcn_exp2f((m_reg - mn) * C); m_reg = mn; }
#else
    if (__builtin_expect(__all(pmax - m_reg <= thr), 1)) { mn = m_reg; alpha = 1.f; }
    else { mn = fmaxf(m_reg, pmax); alpha = __builtin_amdgcn_exp2f((m_reg - mn) * C); m_reg = mn; }
#endif
    const float mnC = -mn * C;
#pragma unroll
    for (int r = 0; r < 16; ++r) p0[r] = fmaf(p0[r], C, mnC);
#pragma unroll
    for (int r = 0; r < 16; ++r) p1[r] = fmaf(p1[r], C, mnC);
#pragma unroll
    for (int r = 0; r < 16; ++r) p0[r] = __builtin_amdgcn_exp2f(p0[r]);
}
__device__ __forceinline__ void finishSM(f32x16& p0, f32x16& p1, float alpha, float& l_reg, bf16x8& pa0, bf16x8& pa1, bf16x8& pa2, bf16x8& pa3) {
#pragma unroll
    for (int r = 0; r < 16; ++r) p1[r] = __builtin_amdgcn_exp2f(p1[r]);
    float ps = 0;
#pragma unroll
    for (int r = 0; r < 16; ++r) ps += p0[r];
#pragma unroll
    for (int r = 0; r < 16; ++r) ps += p1[r];
    { auto rr = __builtin_amdgcn_permlane32_swap(__float_as_uint(ps), __float_as_uint(ps), false, false); ps = __uint_as_float(rr[0]) + __uint_as_float(rr[1]); }
    l_reg = l_reg * alpha + ps;
#define ATT_PK4(P, BASE, OUT) do { unsigned a0 = cvtpk(P[BASE + 0], P[BASE + 1]), a1 = cvtpk(P[BASE + 2], P[BASE + 3]);   \
    unsigned b0 = cvtpk(P[BASE + 4], P[BASE + 5]), b1 = cvtpk(P[BASE + 6], P[BASE + 7]);                              \
    auto r0 = __builtin_amdgcn_permlane32_swap(a0, b0, false, false); auto r1 = __builtin_amdgcn_permlane32_swap(a1, b1, false, false); \
    u32x4 w = {r0[0], r1[0], r0[1], r1[1]}; OUT = *reinterpret_cast<bf16x8*>(&w); } while (0)
    ATT_PK4(p0, 0, pa0); ATT_PK4(p0, 8, pa1); ATT_PK4(p1, 0, pa2); ATT_PK4(p1, 8, pa3);
#undef ATT_PK4
}
template <int DK> __device__ __forceinline__ void qkt(f32x16& p0, f32x16& p1, const lchar* Ks, const bf16x8 (&qr)[DK / 16], const int (&kq)[4]) {
    p0 = f32x16{}; p1 = f32x16{};
    bf16x8 c0 = *(const LAS bf16x8*)(Ks + kq[0]), c1 = *(const LAS bf16x8*)(Ks + kq[0] + 32 * DK * 2);
#pragma unroll
    for (int d0 = 0; d0 < DK / 16; ++d0) {
        bf16x8 n0 = c0, n1 = c1;
        if (d0 + 1 < DK / 16) { n0 = *(const LAS bf16x8*)(Ks + kq[(d0 + 1) & 3] + ((d0 + 1) >> 2) * 128); n1 = *(const LAS bf16x8*)(Ks + kq[(d0 + 1) & 3] + ((d0 + 1) >> 2) * 128 + 32 * DK * 2); }
        p0 = __builtin_amdgcn_mfma_f32_32x32x16_bf16(c0, qr[d0], p0, 0, 0, 0);
        p1 = __builtin_amdgcn_mfma_f32_32x32x16_bf16(c1, qr[d0], p1, 0, 0, 0);
        c0 = n0; c1 = n1; }
}
struct VFrag { s16x4 l0, h0, l1, h1, l2, h2, l3, h3; };
template <int DV, int D0> __device__ __forceinline__ void pv_reads(VFrag& f, int vb) {
    f.l0 = tr_read<v_rd_off<DV>(D0, 0, 0)>(vb); f.h0 = tr_read<v_rd_off<DV>(D0, 0, 1)>(vb); f.l1 = tr_read<v_rd_off<DV>(D0, 1, 0)>(vb); f.h1 = tr_read<v_rd_off<DV>(D0, 1, 1)>(vb);
    f.l2 = tr_read<v_rd_off<DV>(D0, 2, 0)>(vb); f.h2 = tr_read<v_rd_off<DV>(D0, 2, 1)>(vb); f.l3 = tr_read<v_rd_off<DV>(D0, 3, 0)>(vb); f.h3 = tr_read<v_rd_off<DV>(D0, 3, 1)>(vb);
}
__device__ __forceinline__ void pv_mma(f32x16& od, const VFrag& f, bf16x8 pa0, bf16x8 pa1, bf16x8 pa2, bf16x8 pa3) {
#define ATT_PK(L, H) (bf16x8){L[0], L[1], L[2], L[3], H[0], H[1], H[2], H[3]}
    od = __builtin_amdgcn_mfma_f32_32x32x16_bf16(pa0, ATT_PK(f.l0, f.h0), od, 0, 0, 0);
    od = __builtin_amdgcn_mfma_f32_32x32x16_bf16(pa1, ATT_PK(f.l1, f.h1), od, 0, 0, 0);
    od = __builtin_amdgcn_mfma_f32_32x32x16_bf16(pa2, ATT_PK(f.l2, f.h2), od, 0, 0, 0);
    od = __builtin_amdgcn_mfma_f32_32x32x16_bf16(pa3, ATT_PK(f.l3, f.h3), od, 0, 0, 0);
#undef ATT_PK
}
#define ATT_LWAIT(n) do { asm volatile("s_waitcnt lgkmcnt(" #n ")" ::: "memory"); ASBAR(); } while (0)
#if ATT_ILV
template <int DV> __device__ __forceinline__ void pv_all(f32x16 (&o)[DV / 32], int vb, bf16x8 pa0, bf16x8 pa1, bf16x8 pa2, bf16x8 pa3) {
    { VFrag f; pv_reads<DV, 0>(f, vb); pv_mma(o[0], f, pa0, pa1, pa2, pa3); }
    { VFrag f; pv_reads<DV, 1>(f, vb); pv_mma(o[1], f, pa0, pa1, pa2, pa3); }
    if constexpr (DV == 128) {
        { VFrag f; pv_reads<DV, 2>(f, vb); pv_mma(o[2], f, pa0, pa1, pa2, pa3); }
        { VFrag f; pv_reads<DV, 3>(f, vb); pv_mma(o[3], f, pa0, pa1, pa2, pa3); } }
}
#define ATT_SWAP(A, B) __builtin_amdgcn_permlane32_swap((A), (B), false, false)
#define ATT_PIN(X) asm volatile("" : "+v"(X))
template <int PT, int B> __device__ __forceinline__ void pk_step(const f32x16& P, unsigned& a0, unsigned& a1, unsigned& b0, unsigned& b1, unsigned& x0, unsigned& y0, bf16x8& OUT) {
    if constexpr (PT == 0) { a0 = cvtpk(P[B + 0], P[B + 1]); b0 = cvtpk(P[B + 4], P[B + 5]); }
    if constexpr (PT == 1) { a1 = cvtpk(P[B + 2], P[B + 3]); b1 = cvtpk(P[B + 6], P[B + 7]); }
    if constexpr (PT == 2) { auto r0 = ATT_SWAP(a0, b0); x0 = r0[0]; y0 = r0[1]; }
    if constexpr (PT == 3) { auto r1 = ATT_SWAP(a1, b1); u32x4 w = {x0, r1[0], y0, r1[1]}; OUT = *reinterpret_cast<bf16x8*>(&w); }
}
template <int K> __device__ __forceinline__ void fin_atom(f32x16& q0, f32x16& q1, float alpha, float& l_reg, float& ps0, float& ps1, unsigned& a0, unsigned& a1, unsigned& b0, unsigned& b1, unsigned& x0, unsigned& y0,
                                                          bf16x8& pa0, bf16x8& pa1, bf16x8& pa2, bf16x8& pa3) {
    if constexpr (K < 16) { q1[K] = __builtin_amdgcn_exp2f(q1[K]); ATT_PIN(q1[K]); ps0 += q0[K]; ATT_PIN(ps0); }
    if constexpr (K >= 8) { ps1 += q1[K - 8]; ATT_PIN(ps1); }
    if constexpr (K < 4) pk_step<K & 3, 0>(q0, a0, a1, b0, b1, x0, y0, pa0);
    else if constexpr (K < 8) pk_step<K & 3, 8>(q0, a0, a1, b0, b1, x0, y0, pa1);
    else if constexpr (K >= 16 && K < 20) pk_step<K & 3, 0>(q1, a0, a1, b0, b1, x0, y0, pa2);
    else if constexpr (K >= 20) pk_step<K & 3, 8>(q1, a0, a1, b0, b1, x0, y0, pa3);
    if constexpr (K == 23) { float ps = ps0 + ps1; auto rr = ATT_SWAP(__float_as_uint(ps), __float_as_uint(ps)); ps = __uint_as_float(rr[0]) + __uint_as_float(rr[1]); l_reg = l_reg * alpha + ps; }
}
template <int I, int NM, int DK> __device__ __forceinline__ void qk_step(f32x16& p0, f32x16& p1, const lchar* Ks, const bf16x8 (&qr)[DK / 16], const int (&kq)[4], bf16x8 (&F)[4],
        f32x16& q0, f32x16& q1, float alpha, float& l_reg, float& ps0, float& ps1, unsigned& a0, unsigned& a1, unsigned& b0, unsigned& b1, unsigned& x0, unsigned& y0, bf16x8& pa0, bf16x8& pa1, bf16x8& pa2, bf16x8& pa3) {
    constexpr int d0 = I >> 1, APG = 24 / NM;
    if constexpr (I == 0) p0 = __builtin_amdgcn_mfma_f32_32x32x16_bf16(F[0], qr[0], f32x16{}, 0, 0, 0);
    else if constexpr (I == 1) p1 = __builtin_amdgcn_mfma_f32_32x32x16_bf16(F[1], qr[0], f32x16{}, 0, 0, 0);
    else if constexpr ((I & 1) == 0) p0 = __builtin_amdgcn_mfma_f32_32x32x16_bf16(F[I & 3], qr[d0], p0, 0, 0, 0);
    else p1 = __builtin_amdgcn_mfma_f32_32x32x16_bf16(F[I & 3], qr[d0], p1, 0, 0, 0);
    if constexpr (I + 4 < NM) { constexpr int J = I + 4, e0 = J >> 1; F[I & 3] = *(const LAS bf16x8*)(Ks + kq[e0 & 3] + (e0 >> 2) * 128 + (J & 1) * (32 * DK * 2)); }
    fin_atom<APG * I>(q0, q1, alpha, l_reg, ps0, ps1, a0, a1, b0, b1, x0, y0, pa0, pa1, pa2, pa3);
    if constexpr (APG >= 2) fin_atom<APG * I + 1>(q0, q1, alpha, l_reg, ps0, ps1, a0, a1, b0, b1, x0, y0, pa0, pa1, pa2, pa3);
    if constexpr (APG >= 3) fin_atom<APG * I + 2>(q0, q1, alpha, l_reg, ps0, ps1, a0, a1, b0, b1, x0, y0, pa0, pa1, pa2, pa3);
    ASBAR();
    if constexpr (I + 1 < NM) qk_step<I + 1, NM, DK>(p0, p1, Ks, qr, kq, F, q0, q1, alpha, l_reg, ps0, ps1, a0, a1, b0, b1, x0, y0, pa0, pa1, pa2, pa3);
}
template <int DK> __device__ __forceinline__ void qkt_fin(f32x16& p0, f32x16& p1, const lchar* Ks, const bf16x8 (&qr)[DK / 16], const int (&kq)[4],
        f32x16& q0, f32x16& q1, float alpha, float& l_reg, bf16x8& pa0, bf16x8& pa1, bf16x8& pa2, bf16x8& pa3) {
    constexpr int NM = DK / 8;
    bf16x8 F[4];
#pragma unroll
    for (int i = 0; i < 4; ++i) F[i] = *(const LAS bf16x8*)(Ks + kq[(i >> 1) & 3] + ((i >> 1) >> 2) * 128 + (i & 1) * (32 * DK * 2));
    float ps0 = 0.f, ps1 = 0.f; unsigned a0 = 0, a1 = 0, b0 = 0, b1 = 0, x0 = 0, y0 = 0;
    ASBAR();
    qk_step<0, NM, DK>(p0, p1, Ks, qr, kq, F, q0, q1, alpha, l_reg, ps0, ps1, a0, a1, b0, b1, x0, y0, pa0, pa1, pa2, pa3);
}
template <int K, bool WIN> __device__ __forceinline__ void par_atom(f32x16& p0, f32x16& p1, float& m_reg, float& mn, float& alpha, const float C, const float thr, const int dqq, const int hi,
                                                                    float& pm0, float& pm1, float& pm2, float& pm3, float& mnC) {
    if constexpr (K < 4) { f32x16& P = (K < 2) ? p0 : p1; constexpr int B = (K & 1) * 8;
        if constexpr (WIN) {
#pragma unroll
            for (int r = B; r < B + 8; ++r) { const int d = dqq + crow(r, hi) + (K < 2 ? 0 : 32); P[r] = (d > 128 || d < -128) ? -1e30f : P[r]; } }
        const float m = fmaxf(fmaxf(fmaxf(P[B], P[B + 1]), fmaxf(P[B + 2], P[B + 3])), fmaxf(fmaxf(P[B + 4], P[B + 5]), fmaxf(P[B + 6], P[B + 7])));
        if constexpr (K == 0) pm0 = m; else if constexpr (K == 1) pm1 = m; else if constexpr (K == 2) pm2 = m; else pm3 = m; }
    if constexpr (K == 4) { float pmax = fmaxf(fmaxf(pm0, pm1), fmaxf(pm2, pm3));
        auto rr = ATT_SWAP(__float_as_uint(pmax), __float_as_uint(pmax)); pmax = fmaxf(__uint_as_float(rr[0]), __uint_as_float(rr[1]));
        const bool keep = __all(pmax - m_reg <= thr); mn = fmaxf(m_reg, keep ? m_reg : pmax); alpha = __builtin_amdgcn_exp2f((m_reg - mn) * C); m_reg = mn; mnC = -mn * C; }
    if constexpr (K >= 5 && K <= 8) { f32x16& P = (K < 7) ? p0 : p1; constexpr int B = ((K - 5) & 1) * 8;
#pragma unroll
        for (int r = B; r < B + 8; ++r) { P[r] = fmaf(P[r], C, mnC); ATT_PIN(P[r]); } }
    if constexpr (K >= 8) { p0[2 * (K - 8)] = __builtin_amdgcn_exp2f(p0[2 * (K - 8)]); p0[2 * (K - 8) + 1] = __builtin_amdgcn_exp2f(p0[2 * (K - 8) + 1]); ATT_PIN(p0[2 * (K - 8)]); ATT_PIN(p0[2 * (K - 8) + 1]); }
}
template <int I, int NM, int DV, bool WIN> __device__ __forceinline__ void pv_step(f32x16 (&o)[DV / 32], const int vb, const bf16x8 (&pa)[4], s16x4 (&L)[4], s16x4 (&H)[4],
        f32x16& p0, f32x16& p1, float& m_reg, float& mn, float& alpha, const float C, const float thr, const int dqq, const int hi, float& pm0, float& pm1, float& pm2, float& pm3, float& mnC) {
    constexpr int b = I >> 2, k = I & 3, APG = 16 / NM;
    { const s16x4 l = L[k], h = H[k]; o[b] = __builtin_amdgcn_mfma_f32_32x32x16_bf16(pa[k], (bf16x8){l[0], l[1], l[2], l[3], h[0], h[1], h[2], h[3]}, o[b], 0, 0, 0); }
    if constexpr (b + 1 < DV / 32) { L[k] = tr_read<v_rd_off<DV>(b + 1, k, 0)>(vb); H[k] = tr_read<v_rd_off<DV>(b + 1, k, 1)>(vb); }
    par_atom<APG * I, WIN>(p0, p1, m_reg, mn, alpha, C, thr, dqq, hi, pm0, pm1, pm2, pm3, mnC);
    if constexpr (APG >= 2) par_atom<APG * I + 1, WIN>(p0, p1, m_reg, mn, alpha, C, thr, dqq, hi, pm0, pm1, pm2, pm3, mnC);
    ASBAR();
    if constexpr (I + 1 < NM) pv_step<I + 1, NM, DV, WIN>(o, vb, pa, L, H, p0, p1, m_reg, mn, alpha, C, thr, dqq, hi, pm0, pm1, pm2, pm3, mnC);
}
template <int DV, bool WIN> __device__ __forceinline__ void pv_part(f32x16 (&o)[DV / 32], const int vb, bf16x8 pa0, bf16x8 pa1, bf16x8 pa2, bf16x8 pa3,
        f32x16& p0, f32x16& p1, float& m_reg, float& mn, float& alpha, const float C, const float thr, const bool domask, const int dq, const int hi) {
    constexpr int NM = DV / 8;
    const bf16x8 pa[4] = {pa0, pa1, pa2, pa3}; s16x4 L[4], H[4];
    L[0] = tr_read<v_rd_off<DV>(0, 0, 0)>(vb); H[0] = tr_read<v_rd_off<DV>(0, 0, 1)>(vb); L[1] = tr_read<v_rd_off<DV>(0, 1, 0)>(vb); H[1] = tr_read<v_rd_off<DV>(0, 1, 1)>(vb);
    L[2] = tr_read<v_rd_off<DV>(0, 2, 0)>(vb); H[2] = tr_read<v_rd_off<DV>(0, 2, 1)>(vb); L[3] = tr_read<v_rd_off<DV>(0, 3, 0)>(vb); H[3] = tr_read<v_rd_off<DV>(0, 3, 1)>(vb);
    float pm0 = 0.f, pm1 = 0.f, pm2 = 0.f, pm3 = 0.f, mnC = 0.f; const int dqq = domask ? dq : 0;
    ASBAR();
    pv_step<0, NM, DV, WIN>(o, vb, pa, L, H, p0, p1, m_reg, mn, alpha, C, thr, dqq, hi, pm0, pm1, pm2, pm3, mnC);
}
#else
template <int NM, int ND, int NV> __device__ __forceinline__ void sgb_pattern() {}
template <int DV> __device__ __forceinline__ void pv_all(f32x16 (&o)[DV / 32], int vb, bf16x8 pa0, bf16x8 pa1, bf16x8 pa2, bf16x8 pa3) {
    VFrag f;
    pv_reads<DV, 0>(f, vb); ATT_LWAIT(0); pv_mma(o[0], f, pa0, pa1, pa2, pa3);
    pv_reads<DV, 1>(f, vb); ATT_LWAIT(0); pv_mma(o[1], f, pa0, pa1, pa2, pa3);
    if constexpr (DV == 128) {
        pv_reads<DV, 2>(f, vb); ATT_LWAIT(0); pv_mma(o[2], f, pa0, pa1, pa2, pa3);
        pv_reads<DV, 3>(f, vb); ATT_LWAIT(0); pv_mma(o[3], f, pa0, pa1, pa2, pa3); }
}
#endif
template <int DK, int DV, bool WIN, bool SINK, int MODE>
__device__ __forceinline__ void attn_unit(const bf16_t* __restrict__ Qb, const int ldq, const bf16_t* __restrict__ Kb, const int ldk, const bf16_t* __restrict__ Vb, const int ldv,
                                          bf16_t* __restrict__ Ob, const int ldo, const int cbase, const int lbase, const int NT, const int qpos0, const int kpos0, const float sinkl2, lchar* lds) {
    constexpr int KI = DK / 64, VI = DV / 64, ND = DK / 16, NO = DV / 32, SHM_K = 64 * DK * 2, SHM_V = 64 * DV * 2;
    constexpr float SCALE = (DK == 192) ? 0.07216878364870322f : 0.125f, C = SCALE * 1.4426950408889634f, THRR = 8.0f / SCALE;
    int tid_ = threadIdx.x; asm volatile("" : "+v"(tid_));
    const int tid = tid_, wid = tid >> 6, lane = tid & 63, r32 = lane & 31, hi = lane >> 5;
    constexpr int NSLOT = (MODE == 2) ? 3 : 2;
    lchar* V_lds = lds; lchar* K_lds = lds + NSLOT * SHM_V;
    LAS float* wsf = (LAS float*)(lds + NSLOT * SHM_V + NSLOT * SHM_K) + wid * 64; LAS float* li_l = wsf; LAS float* al_l = wsf + 32;
    float m_reg = -1e30f, l_reg = 0.f; f32x16 o[NO]; bf16x8 qr[ND];
#pragma unroll
    for (int d = 0; d < NO; ++d) o[d] = f32x16{};
    const bf16_t* Qw = Qb + (long)(wid * 32 + r32) * ldq + hi * 8;
#pragma unroll
    for (int d0 = 0; d0 < ND; ++d0) qr[d0] = *(const bf16x8*)(Qw + d0 * 16);
    const int srow = tid >> 3, scg = tid & 7;
    const int kgo = srow * ldk + scg * 8, vgo = srow * ldv + scg * 8;
    int klo[KI];
#pragma unroll
    for (int i = 0; i < KI; ++i) klo[i] = koff<DK>(srow, scg + 8 * i);
    const int vlo = v_st<DV>(srow, scg * 8);
    const int vb0 = (int)(uintptr_t)V_lds + v_rd_base(lane);
    const int qpos = qpos0 + wid * 32 + r32;
    int kq[4];
#pragma unroll
    for (int k = 0; k < 4; ++k) kq[k] = r32 * (DK * 2) + (((2 * k) ^ hi ^ ((r32 >> 1) & 7)) << 4);
    bf16x8 ks[KI], vs[VI];
#define ATT_ROWOF(j) ((j) < 4 ? cbase + 64 * (j) : lbase + 64 * ((j) - 4))
#define ATT_SLOAD(j) do { const long rb_ = ATT_ROWOF(j); const bf16_t* kp_ = Kb + rb_ * ldk + kgo; const bf16_t* vp_ = Vb + rb_ * ldv + vgo; \
    _Pragma("unroll") for (int i_ = 0; i_ < KI; ++i_) ks[i_] = *(const bf16x8*)(kp_ + 64 * i_); \
    _Pragma("unroll") for (int i_ = 0; i_ < VI; ++i_) vs[i_] = *(const bf16x8*)(vp_ + 64 * i_); } while (0)
#define ATT_SWRITE(b) do { _Pragma("unroll") for (int i_ = 0; i_ < KI; ++i_) *(LAS bf16x8*)(K_lds + (b) * SHM_K + klo[i_]) = ks[i_]; \
    _Pragma("unroll") for (int i_ = 0; i_ < VI; ++i_) *(LAS bf16x8*)(V_lds + (b) * SHM_V + vlo + i_ * 1024) = vs[i_]; } while (0)
#define ATT_RESC(a) do { if (__any((a) < 1.f)) { if (hi == 0) al_l[r32] = (a); asm volatile("s_waitcnt lgkmcnt(0)" ::: "memory"); \
    _Pragma("unroll") for (int d_ = 0; d_ < NO; ++d_) _Pragma("unroll") for (int r_ = 0; r_ < 16; ++r_) o[d_][r_] *= al_l[crow(r_, hi)]; } } while (0)
#define ATT_DQ(j) (kpos0 + 64 * ((j) - 4) - qpos)
    f32x16 pA0, pA1, pB0, pB1; float mnA, mnB, alA, alB; bf16x8 pa0, pa1, pa2, pa3;
    __syncthreads();
    if constexpr (MODE == 2) {
        const int wu = __builtin_amdgcn_readfirstlane(wid);
        constexpr int DW = ATT_DMAW, KP = KI * 8 / DW, VP = VI * 8 / DW;
        const bool dmaw = wu < DW;
        int kgs[KP], vgs[VP];
#pragma unroll
        for (int i = 0; i < KP; ++i) { const int p = (wu * KP + i) * 64 + lane, kr = p / (DK / 8), c2 = p % (DK / 8); kgs[i] = kr * ldk + (((c2 & ~7) | ((c2 & 7) ^ ((kr >> 1) & 7))) << 3); }
#pragma unroll
        for (int i = 0; i < VP; ++i) { const int u16 = (wu * VP + i) * 64 + lane, st = u16 >> 5, kk = (st / (DV / 32)) * 8 + ((u16 >> 2) & 7), c = (st % (DV / 32)) * 32 + (u16 & 3) * 8;
            const int k = (kk & ~0xC) | ((kk & 4) << 1) | ((kk & 8) >> 1); vgs[i] = k * ldv + c; }
        const unsigned kl0 = (unsigned)(uintptr_t)K_lds + (unsigned)(wu * KP) * 1024u, vl0 = (unsigned)(uintptr_t)V_lds + (unsigned)(wu * VP) * 1024u;
#define ATT_DMAK(j, slot) do { const bf16_t* kp_ = Kb + (long)ATT_ROWOF(j) * ldk; if (dmaw) { _Pragma("unroll") for (int i_ = 0; i_ < KP; ++i_) glds16s(kp_, (unsigned)kgs[i_] * 2u, kl0 + (unsigned)(slot) * SHM_K + i_ * 1024); } } while (0)
#define ATT_DMAV(j, slot) do { const bf16_t* vp_ = Vb + (long)ATT_ROWOF(j) * ldv; if (dmaw) { _Pragma("unroll") for (int i_ = 0; i_ < VP; ++i_) glds16s(vp_, (unsigned)vgs[i_] * 2u, vl0 + (unsigned)(slot) * SHM_V + i_ * 1024); } } while (0)
#define ATT_WAITN(n) asm volatile("s_waitcnt vmcnt(" #n ") lgkmcnt(0)" ::: "memory")
#define ATT_WAIT1() do { if constexpr (KP + VP == 10) ATT_WAITN(10); else if constexpr (KP + VP == 5) ATT_WAITN(5); else if constexpr (KP + VP == 4) ATT_WAITN(4); else { static_assert(KP + VP == 2); ATT_WAITN(2); } } while (0)
#define ATT_WAIT2() do { if constexpr (KP + VP == 10) ATT_WAITN(20); else if constexpr (KP + VP == 5) ATT_WAITN(10); else if constexpr (KP + VP == 4) ATT_WAITN(8); else ATT_WAITN(4); } while (0)
#define ATT_SYNC(j) do { const int sp_ = (sc == 0) ? 2 : sc - 1; if ((j) + 2 < NT) ATT_WAIT1(); else ATT_WAITN(0); \
        __builtin_amdgcn_s_barrier(); asm volatile("" ::: "memory"); \
        if ((j) + 3 < NT) ATT_DMAK((j) + 3, sc); if ((j) + 2 < NT) ATT_DMAV((j) + 2, sp_); } while (0)
#define ATT_STEP_OLD(j, PC0, PC1, MNC, ALC, PP0, PP1, MNP, ALP) do { const int spv_ = (sc == 0) ? 2 : sc - 1; \
        ASBAR(); qkt_fin<DK>(PC0, PC1, K_lds + sc * SHM_K, qr, kq, PP0, PP1, ALP, l_reg, pa0, pa1, pa2, pa3); \
        pv_part<DV, WIN>(o, vb0 + spv_ * SHM_V, pa0, pa1, pa2, pa3, PC0, PC1, m_reg, MNC, ALC, C, THRR, (j) >= 4, ATT_DQ(j), hi); \
        ATT_SYNC(j); ATT_RESC(ALC); sc = (sc == 2) ? 0 : sc + 1; } while (0)
#define ATT_STEP_YNG(j, PC0, PC1, MNC, ALC, PP0, PP1, MNP, ALP) do { const int spv_ = (sc == 0) ? 2 : sc - 1; \
        partialSM<WIN>(PP0, PP1, m_reg, MNP, ALP, C, THRR, (j) - 1 >= 4, ATT_DQ((j) - 1), hi); ATT_RESC(ALP); \
        ASBAR(); qkt<DK>(PC0, PC1, K_lds + sc * SHM_K, qr, kq); \
        finishSM(PP0, PP1, ALP, l_reg, pa0, pa1, pa2, pa3); ASBAR(); \
        pv_all<DV>(o, vb0 + spv_ * SHM_V, pa0, pa1, pa2, pa3); \
        ATT_SYNC(j); sc = (sc == 2) ? 0 : sc + 1; } while (0)
        const bool young = (ATT_YOUNG_FROM < 512) && __builtin_amdgcn_readfirstlane(tid) >= ATT_YOUNG_FROM;
        ATT_WAITN(0); __builtin_amdgcn_s_barrier(); asm volatile("" ::: "memory");
        ATT_DMAK(0, 0); ATT_DMAK(1, 1); ATT_DMAV(0, 0); ATT_DMAK(2, 2); ATT_DMAV(1, 1);
        ATT_WAIT2(); __builtin_amdgcn_s_barrier(); asm volatile("" ::: "memory");
        int sc = 0;
        if (young) {
            qkt<DK>(pA0, pA1, K_lds, qr, kq);
            ATT_SYNC(0); sc = 1;
            for (int j = 1; j + 1 < NT; j += 2) {
                ATT_STEP_YNG(j, pB0, pB1, mnB, alB, pA0, pA1, mnA, alA);
                ATT_STEP_YNG(j + 1, pA0, pA1, mnA, alA, pB0, pB1, mnB, alB);
            }
            ATT_STEP_YNG(NT - 1, pB0, pB1, mnB, alB, pA0, pA1, mnA, alA);
            partialSM<WIN>(pB0, pB1, m_reg, mnB, alB, C, THRR, NT - 1 >= 4, ATT_DQ(NT - 1), hi); ATT_RESC(alB);
        } else {
            qkt<DK>(pA0, pA1, K_lds, qr, kq); partialSM<WIN>(pA0, pA1, m_reg, mnA, alA, C, THRR, false, 0, hi);
            ATT_SYNC(0); ATT_RESC(alA); sc = 1;
            for (int j = 1; j + 1 < NT; j += 2) {
                ATT_STEP_OLD(j, pB0, pB1, mnB, alB, pA0, pA1, mnA, alA);
                ATT_STEP_OLD(j + 1, pA0, pA1, mnA, alA, pB0, pB1, mnB, alB);
            }
            ATT_STEP_OLD(NT - 1, pB0, pB1, mnB, alB, pA0, pA1, mnA, alA);
        }
        finishSM(pB0, pB1, alB, l_reg, pa0, pa1, pa2, pa3); ASBAR();
        pv_all<DV>(o, vb0 + ((sc == 0) ? 2 : sc - 1) * SHM_V, pa0, pa1, pa2, pa3);
#undef ATT_SYNC
#undef ATT_STEP_OLD
#undef ATT_STEP_YNG
#undef ATT_DMAK
#undef ATT_DMAV
#undef ATT_WAITN
#undef ATT_WAIT1
#undef ATT_WAIT2
    } else if constexpr (MODE == 1) {
        ATT_SLOAD(0); asm volatile("s_waitcnt vmcnt(0)" ::: "memory"); ATT_SWRITE(0); __syncthreads();
        for (int j = 0; j < NT; ++j) {
            const int b = j & 1;
            if (j + 1 < NT) ATT_SLOAD(j + 1);
            ASBAR(); qkt<DK>(pA0, pA1, K_lds + b * SHM_K, qr, kq);
            partialSM<WIN>(pA0, pA1, m_reg, mnA, alA, C, THRR, j >= 4, ATT_DQ(j), hi);
            ATT_RESC(alA);
            finishSM(pA0, pA1, alA, l_reg, pa0, pa1, pa2, pa3); ASBAR();
            pv_all<DV>(o, vb0 + b * SHM_V, pa0, pa1, pa2, pa3);
            if (j + 1 < NT) { asm volatile("s_waitcnt vmcnt(0)" ::: "memory"); ATT_SWRITE(b ^ 1); }
            __syncthreads();
        }
    } else {
    ATT_SLOAD(0); asm volatile("s_waitcnt vmcnt(0)" ::: "memory"); ATT_SWRITE(0); __syncthreads();
    qkt<DK>(pA0, pA1, K_lds, qr, kq); partialSM<WIN>(pA0, pA1, m_reg, mnA, alA, C, THRR, false, 0, hi);
    ATT_SLOAD(1); asm volatile("s_waitcnt vmcnt(0)" ::: "memory"); ATT_SWRITE(1); __syncthreads();
    for (int j = 1; j + 1 < NT; j += 2) {
        ASBAR(); qkt<DK>(pB0, pB1, K_lds + SHM_K, qr, kq);
        finishSM(pA0, pA1, alA, l_reg, pa0, pa1, pa2, pa3); ASBAR();
        ATT_SLOAD(j + 1); ASBAR();
        pv_all<DV>(o, vb0, pa0, pa1, pa2, pa3); partialSM<WIN>(pB0, pB1, m_reg, mnB, alB, C, THRR, j >= 4, ATT_DQ(j), hi);
        __syncthreads(); asm volatile("s_waitcnt vmcnt(0)" ::: "memory"); ATT_SWRITE(0);
        ATT_RESC(alB); __syncthreads();
        ASBAR(); qkt<DK>(pA0, pA1, K_lds, qr, kq);
        finishSM(pB0, pB1, alB, l_reg, pa0, pa1, pa2, pa3); ASBAR();
        ATT_SLOAD(j + 2); ASBAR();
        pv_all<DV>(o, vb0 + SHM_V, pa0, pa1, pa2, pa3); partialSM<WIN>(pA0, pA1, m_reg, mnA, alA, C, THRR, j + 1 >= 4, ATT_DQ(j + 1), hi);
        __syncthreads(); asm volatile("s_waitcnt vmcnt(0)" ::: "memory"); ATT_SWRITE(1);
        ATT_RESC(alA); __syncthreads();
    }
    ASBAR(); qkt<DK>(pB0, pB1, K_lds + SHM_K, qr, kq);
    finishSM(pA0, pA1, alA, l_reg, pa0, pa1, pa2, pa3); ASBAR();
    pv_all<DV>(o, vb0, pa0, pa1, pa2, pa3); partialSM<WIN>(pB0, pB1, m_reg, mnB, alB, C, THRR, NT - 1 >= 4, ATT_DQ(NT - 1), hi);
    __syncthreads(); ATT_RESC(alB);
    finishSM(pB0, pB1, alB, l_reg, pa0, pa1, pa2, pa3); ASBAR();
    pv_all<DV>(o, vb0 + SHM_V, pa0, pa1, pa2, pa3);
    }
    if constexpr (SINK) l_reg += __builtin_amdgcn_exp2f(sinkl2 - m_reg * C);
    if (hi == 0) li_l[r32] = l_reg;
    asm volatile("s_waitcnt lgkmcnt(0)" ::: "memory");
    float rli[16];
#pragma unroll
    for (int r = 0; r < 16; ++r) rli[r] = __builtin_amdgcn_rcpf(li_l[crow(r, hi)]);
    bf16_t* Ow = Ob + (long)(wid * 32) * ldo + r32;
#pragma unroll
    for (int r = 0; r < 16; ++r) { const int orow = crow(r, hi);
#pragma unroll
        for (int d0 = 0; d0 < NO; ++d0) Ow[(long)orow * ldo + d0 * 32] = (bf16_t)(cvtpk(o[d0][r] * rli[r], 0.f) & 0xffffu); }
#undef ATT_ROWOF
#undef ATT_SLOAD
#undef ATT_SWRITE
#undef ATT_RESC
#undef ATT_DQ
}
}
typedef unsigned short bf16;
typedef unsigned v4u __attribute__((ext_vector_type(4)));
typedef unsigned v2u __attribute__((ext_vector_type(2)));
typedef float f32x4 __attribute__((ext_vector_type(4)));
typedef short bf16x8 __attribute__((ext_vector_type(8)));
typedef GAS unsigned gu32;
#define LDS_WAIT() asm volatile("s_waitcnt lgkmcnt(0)" ::: "memory")
#define VM_WAIT() asm volatile("s_waitcnt vmcnt(0)" ::: "memory")

constexpr int NWAVES = 8;
constexpr int DM = 2048, NB = 8, SEQ = 4096, DEPTH = 4, CTXL = 256, DFF = 5632;
constexpr int ML = NB * SEQ, MC = NB * CTXL, MT = ML + MC;
constexpr int NIN = 8768, NINP = 8960, NMOD = 6 * DM;
constexpr float EPS = 1e-6f;
static_assert(ML == pg8::ML_ROWS, "row split");

constexpr size_t MiB = 1u << 20;
constexpr size_t WS_CTL = 0, CTL_ZERO_BYTES = 1 * MiB;
constexpr size_t WS_MOD = 1 * MiB;
constexpr size_t WS_ROPE = 3 * MiB;
constexpr size_t WS_W = 4 * MiB;
constexpr size_t WO_IN = 0, WO_Q = WO_IN + (size_t)NINP * DM * 2, WO_KV = WO_Q + (size_t)1536 * 512 * 2, WO_C = WO_KV + (size_t)2048 * 256 * 2, WO_M = WO_C + (size_t)2048 * 512 * 2,
                 WO_G = WO_M + (size_t)2048 * 1024 * 2, WO_O = WO_G + (size_t)2048 * 512 * 2, WO_F1 = WO_O + (size_t)2048 * 2048 * 2, WO_F2 = WO_F1 + (size_t)2 * DFF * DM * 2,
                 WO_END = WO_F2 + (size_t)DM * DFF * 2;
static_assert(WO_END <= 120 * MiB, "weights");
constexpr size_t WS_XC = 124 * MiB;
constexpr size_t WS_A = 140 * MiB;
constexpr size_t WS_B = 548 * MiB;
constexpr size_t WS_C = 684 * MiB;
constexpr size_t WS_D = 786 * MiB;
constexpr size_t WD_KF = 0, WD_V = 102 * MiB, WD_GQ = 170 * MiB, WD_GK = 204 * MiB, WD_GV = 213 * MiB, WD_U = 222 * MiB;
constexpr size_t WS_E = 1058 * MiB;
constexpr size_t WE_UC = 0, WE_CKV = 34 * MiB, WE_QA = 51 * MiB;
constexpr size_t WS_XB = 1144 * MiB;
constexpr size_t WS_END = 1272 * MiB;
static_assert((size_t)MT * 6144 * 2 <= 408 * MiB && (size_t)MT * 2048 * 2 <= 136 * MiB && (size_t)MT * 768 * 4 <= 102 * MiB && (size_t)MT * 2048 * 4 <= 272 * MiB && WD_U + (size_t)MT * 512 * 2 <= 272 * MiB, "ws map");
constexpr int CW_BAR = 4096;

constexpr int RING_OFF = 0, RING_BYTES = 131072, LDSCTL_OFF = RING_BYTES, MISC_OFF = LDSCTL_OFF + 320, LDS_BYTES = 147456;

__device__ __forceinline__ unsigned f2bf(float f) { unsigned u = __builtin_bit_cast(unsigned, f); return (u + 0x7fffu + ((u >> 16) & 1u)) >> 16; }
__device__ __forceinline__ unsigned pk2(float lo, float hi) { return pg8::cvt_pk_bf16(lo, hi); }
__device__ __forceinline__ float wave_sum(float v) {
#pragma unroll
    for (int o = 1; o < 64; o <<= 1) v += __shfl_xor(v, o);
    return v;
}
__device__ __forceinline__ float bflo(unsigned w) { return __uint_as_float(w << 16); }
__device__ __forceinline__ float bfhi(unsigned w) { return __uint_as_float(w & 0xffff0000u); }
__device__ __forceinline__ float sigmf(float x) { return __builtin_amdgcn_rcpf(1.0f + __builtin_amdgcn_exp2f(-1.4426950408889634f * x)); }

__device__ __forceinline__ int srccol(int mode, int n) {
    if (mode == 0) return n;
    if (mode == 1) {
        if (n < 6144) return 2624 + n;
        if (n < 7744) return n - 6144;
        if (n < 8768) { const int q = n - 7744, g = q >> 5, i = q & 31; return 1600 + (i < 16 ? 16 * g + i : 512 + 16 * g + (i - 16)); }
        return -1;
    }
    { const int g = n >> 5, i = n & 31; return i < 16 ? 16 * g + i : DFF + 16 * g + (i - 16); }
}
__device__ __forceinline__ void cvt_item(const float* W, int K, int N, bf16* WT, LAS float* scr, int item, int nblk, int lane, int mode) {
    const int kb = item / nblk, nb = item % nblk, k0 = 64 * kb, n0 = 32 * nb;
    const int sc = srccol(mode, n0 + (lane & 31));
    const float wsc = (mode == 1 && n0 < 6144) ? -1.4426950408889634f : 1.0f;
    const float* wp = W + (size_t)(k0 + (lane >> 5)) * N + (sc >= 0 ? sc : 0);
#pragma unroll 8
    for (int i = 0; i < 32; ++i) { const float v = wp[(size_t)(2 * i) * N] * wsc; scr[(2 * i + (lane >> 5)) * 33 + (lane & 31)] = sc >= 0 ? v : 0.f; }
    LDS_WAIT(); asm volatile("" ::: "memory");
    const int c = lane & 7;
#pragma unroll
    for (int j = 0; j < 4; ++j) { const int n = (lane >> 3) + 8 * j; const LAS float* s = scr + (8 * c) * 33 + n;
        v4u o; o.x = pk2(s[0 * 33], s[1 * 33]); o.y = pk2(s[2 * 33], s[3 * 33]); o.z = pk2(s[4 * 33], s[5 * 33]); o.w = pk2(s[6 * 33], s[7 * 33]);
        *(GAS v4u*)(WT + (size_t)(n0 + n) * K + k0 + 8 * c) = o; }
    LDS_WAIT(); asm volatile("" ::: "memory");
}

#ifndef ATT_MLA_MODE
#define ATT_MLA_MODE 2
#endif
#ifndef ATT_GQA_MODE
#define ATT_GQA_MODE 2
#endif
#ifndef P5_WGM
#define P5_WGM 8
#endif
#ifndef P1_WGM
#define P1_WGM 4
#endif
#ifndef P8_WGM
#define P8_WGM 4
#endif
#ifndef SPLIT_WGM
#define SPLIT_WGM 2
#endif
struct Args { const float* in[25]; float* out; unsigned char* ws; int multi, l_lo, l_hi, ph, pad0, pad1; };
enum { PH_PRE = -1, PH_POST = 10, PH_DUMP = 11 };

struct __attribute__((packed, aligned(4))) F3 { float x, y, z; };
#define PHASE_BEGIN \
    const __attribute__((address_space(4))) Args* ap = (const __attribute__((address_space(4))) Args*)__builtin_amdgcn_kernarg_segment_ptr(); asm volatile("" : "+s"(ap)); \
    unsigned char* ws = ap->ws; \
    int tid = threadIdx.x; asm volatile("" : "+v"(tid)); const int lane = tid & 63, wave = __builtin_amdgcn_readfirstlane(tid >> 6); \
    const int gw = vcu * NWAVES + wave, NGW = G * NWAVES; (void)gw; (void)NGW; (void)lane; \
    const float* in_x = ap->in[0]; const float* in_c = ap->in[1]; const float* in_ctx = ap->in[2]; const float* in_cctx = ap->in[3]; const float* w_ada = ap->in[4]; const float* b_ada = ap->in[5]; const float* g_mix = ap->in[6]; const float* w_in = ap->in[7]; const float* conv_w = ap->in[8]; const float* conv_b = ap->in[9]; const float* conv_ln_g = ap->in[10]; const float* conv_ln_b = ap->in[11]; const float* w_conv_out = ap->in[12]; const float* g_q_a = ap->in[13]; const float* w_q_up = ap->in[14]; const float* g_kv_a = ap->in[15]; const float* w_kv_up = ap->in[16]; const float* w_mla_out = ap->in[17]; const float* gqa_sink = ap->in[18]; const float* w_gqa_out = ap->in[19]; const float* w_out = ap->in[20]; const float* g_ffn = ap->in[21]; const float* w_ffn_in = ap->in[22]; const float* w_ffn_out = ap->in[23]; const float* g_final = ap->in[24]; float* XL = ap->out; bf16* XB = (bf16*)(ws + WS_XB); bf16* XCB = (bf16*)(ws + WS_XC); (void)XL; (void)XCB; float* MOD = (float*)(ws + WS_MOD); float* ROPE = (float*)(ws + WS_ROPE); float* XC = (float*)(ws + WS_XC); bf16* Win_t = (bf16*)(ws + WS_W + WO_IN); bf16* Wq_t = (bf16*)(ws + WS_W + WO_Q); bf16* Wkv_t = (bf16*)(ws + WS_W + WO_KV); bf16* Wc_t = (bf16*)(ws + WS_W + WO_C); bf16* Wm_t = (bf16*)(ws + WS_W + WO_M); bf16* Wg_t = (bf16*)(ws + WS_W + WO_G); bf16* Wo_t = (bf16*)(ws + WS_W + WO_O); bf16* Wf1_t = (bf16*)(ws + WS_W + WO_F1); bf16* Wf2_t = (bf16*)(ws + WS_W + WO_F2); unsigned char* Gb = (unsigned char*)(ws + WS_A); bf16* HID = (bf16*)(ws + WS_A); bf16* Hb = (bf16*)(ws + WS_B); bf16* MQ = (bf16*)(ws + WS_B); bf16* Yb = (bf16*)(ws + WS_B); bf16* CQ = (bf16*)(ws + WS_C); bf16* PART = (bf16*)(ws + WS_C); bf16* OM = (bf16*)(ws + WS_C); bf16* OG = (bf16*)(ws + WS_C + (size_t)MT * 1024 * 2); bf16* KF = (bf16*)(ws + WS_D + WD_KF); bf16* Vb = (bf16*)(ws + WS_D + WD_V); bf16* GQ = (bf16*)(ws + WS_D + WD_GQ); bf16* GK = (bf16*)(ws + WS_D + WD_GK); bf16* GV = (bf16*)(ws + WS_D + WD_GV); bf16* Ub = (bf16*)(ws + WS_D + WD_U); bf16* YF = (bf16*)(ws + WS_D); bf16* UC = (bf16*)(ws + WS_E + WE_UC); bf16* CKVn = (bf16*)(ws + WS_E + WE_CKV); bf16* QAn = (bf16*)(ws + WS_E + WE_QA); \
    const float* modl = MOD + (size_t)l_cur * 9 * NMOD; (void)modl;
__global__ void __launch_bounds__(NWAVES * 64, 2) mega_fwd(Args args) {
    extern __shared__ __attribute__((aligned(16))) unsigned char lds_raw[];
    LAS unsigned char* lds = (LAS unsigned char*)lds_raw;
    volatile LAS unsigned* MISC = (volatile LAS unsigned*)(lds + MISC_OFF);
    const int tid0 = threadIdx.x;
    const int G = gridDim.x; const int bx = blockIdx.x; const int vcu = (G % 8 == 0) ? (bx % 8) * (G / 8) + bx / 8 : bx;
    gu32* ctl = (gu32*)(args.ws + WS_CTL);
    int l_cur = 0;
    for (int u = tid0; u < (LDS_BYTES - LDSCTL_OFF) / 4; u += NWAVES * 64) ((LAS unsigned*)(lds + LDSCTL_OFF))[u] = 0u;
    __syncthreads();
    XcdBarrier bar = xcd_barrier_post((unsigned*)(ctl + CW_BAR), MISC + 8);
    const int multi = args.multi, ph = args.ph;
#ifndef PHASE_MASK
#define PHASE_MASK 0x1fff
#endif
#define RUN(k) ((((PHASE_MASK) >> ((k) + 1)) & 1) && (!multi || ph == (k)))
#define GRID_BAR() do { if (!multi) xcd_barrier(bar); } while (0)

    if (RUN(PH_PRE)) { PHASE_BEGIN
        LAS float* sil = (LAS float*)(lds + RING_OFF);
        LAS float* red = (LAS float*)(lds + RING_OFF + 9 * DM * 4);
        for (int i = tid; i < 9 * DM; i += NWAVES * 64) { const float v = i < 8 * DM ? in_c[i] : in_cctx[i - 8 * DM]; sil[(i & (DM - 1)) * 9 + (i >> 11)] = v * sigmf(v); }
        __syncthreads();
#define ADA_LOAD(W_, I0) do { _Pragma("unroll") for (int u = 0; u < 8; ++u) W_[u] = *(const F3*)(Wl + (size_t)((I0) + u) * 8 * NMOD); } while (0)
#define ADA_FMA(W_, I0) do { _Pragma("unroll") for (int u = 0; u < 8; ++u) { const LAS float* sp = sil + (((I0) + u) * 8 + wave) * 9; \
            _Pragma("unroll") for (int v = 0; v < 9; ++v) { const float sv = sp[v]; acc[v][0] += W_[u].x * sv; acc[v][1] += W_[u].y * sv; acc[v][2] += W_[u].z * sv; } asm volatile("" ::: "memory"); } } while (0)
        for (int s = vcu; s < DEPTH * 64; s += G) {
            const int l = s >> 6, col0 = (s & 63) * 192;
            const float* Wl = w_ada + (size_t)l * DM * NMOD + (size_t)wave * NMOD + col0 + 3 * lane;
            float acc[9][3];
#pragma unroll
            for (int v = 0; v < 9; ++v) { acc[v][0] = 0.f; acc[v][1] = 0.f; acc[v][2] = 0.f; }
            F3 wa[8], wb[8];
            ADA_LOAD(wa, 0);
#pragma nounroll
            for (int i = 0; i < DM / 8; i += 16) {
                ADA_LOAD(wb, i + 8);
                ADA_FMA(wa, i);
                { const int in_ = (i + 16 < DM / 8) ? i + 16 : 0; ADA_LOAD(wa, in_); }
                ADA_FMA(wb, i + 8);
            }
#pragma unroll
            for (int v = 0; v < 9; ++v) {
#pragma unroll
                for (int e = 0; e < 3; ++e) red[(wave * 9 + v) * 192 + 3 * lane + e] = acc[v][e]; }
            __syncthreads();
            for (int i = tid; i < 9 * 192; i += NWAVES * 64) { const int v = i / 192, cc = i - v * 192; float t = 0.f;
#pragma unroll
                for (int w8 = 0; w8 < 8; ++w8) t += red[(w8 * 9 + v) * 192 + cc];
                MOD[((size_t)l * 9 + v) * NMOD + col0 + cc] = t + b_ada[(size_t)l * NMOD + col0 + cc]; }
            __syncthreads();
        }
        { bf16* XB = (bf16*)(ws + WS_XB);
          for (size_t i = ((size_t)gw * 64 + lane) * 8; i < (size_t)ML * DM; i += (size_t)NGW * 64 * 8) { const f32x4 a = *(const f32x4*)(in_x + i), b = *(const f32x4*)(in_x + i + 4);
              v4u w; w.x = pk2(a[0], a[1]); w.y = pk2(a[2], a[3]); w.z = pk2(b[0], b[1]); w.w = pk2(b[2], b[3]); *(v4u*)(XB + i) = w; }
          bf16* XCB = (bf16*)(ws + WS_XC);
          for (size_t i = ((size_t)gw * 64 + lane) * 8; i < (size_t)MC * DM; i += (size_t)NGW * 64 * 8) { const f32x4 a = *(const f32x4*)(in_ctx + i), b = *(const f32x4*)(in_ctx + i + 4);
              v4u w; w.x = pk2(a[0], a[1]); w.y = pk2(a[2], a[3]); w.z = pk2(b[0], b[1]); w.w = pk2(b[2], b[3]); *(v4u*)(XCB + i) = w; } }
        { const int i = bx * (NWAVES * 64) + tid; if (i < 64 * 16) { const int p = i >> 4, f = i & 15; const float invf = powf(10000.0f, -(float)f / 16.0f), a = (float)p * invf;
              ROPE[2 * i] = cosf(a); ROPE[2 * i + 1] = sinf(a); } }
    }
    GRID_BAR();

    for (int l = args.l_lo; l < args.l_hi; ++l) {
        l_cur = l;
        const bool lastl = (l == DEPTH - 1); const int Mg = lastl ? ML : MT;
        if (RUN(0)) { PHASE_BEGIN
            LAS float* scr = (LAS float*)(lds + RING_OFF + wave * 16384);
            constexpr int I_IN = (DM / 64) * (NINP / 32), I_Q = (512 / 64) * (1536 / 32), I_KV = (256 / 64) * (2048 / 32), I_C = (512 / 64) * (DM / 32), I_M = (1024 / 64) * (DM / 32),
                          I_G = (512 / 64) * (DM / 32), I_O = (DM / 64) * (DM / 32), I_F1 = (DM / 64) * (2 * DFF / 32), I_F2 = (DFF / 64) * (DM / 32);
            constexpr int NITEMS = I_IN + I_Q + I_KV + I_C + I_M + I_G + I_O + I_F1 + I_F2;
            for (int it = gw; it < NITEMS; it += NGW) {
                int r = it; const float* W; bf16* WT; int K, N, nblk, mode = 0;
                if (r < I_IN) { W = w_in + (size_t)l * DM * NIN; K = DM; N = NIN; WT = Win_t; nblk = NINP / 32; mode = 1; }
                else if ((r -= I_IN) < I_Q) { W = w_q_up + (size_t)l * 512 * 1536; K = 512; N = 1536; WT = Wq_t; nblk = 1536 / 32; }
                else if ((r -= I_Q) < I_KV) { W = w_kv_up + (size_t)l * 256 * 2048; K = 256; N = 2048; WT = Wkv_t; nblk = 2048 / 32; }
                else if ((r -= I_KV) < I_C) { W = w_conv_out + (size_t)l * 512 * DM; K = 512; N = DM; WT = Wc_t; nblk = DM / 32; }
                else if ((r -= I_C) < I_M) { W = w_mla_out + (size_t)l * 1024 * DM; K = 1024; N = DM; WT = Wm_t; nblk = DM / 32; }
                else if ((r -= I_M) < I_G) { W = w_gqa_out + (size_t)l * 512 * DM; K = 512; N = DM; WT = Wg_t; nblk = DM / 32; }
                else if ((r -= I_G) < I_O) { W = w_out + (size_t)l * DM * DM; K = DM; N = DM; WT = Wo_t; nblk = DM / 32; }
                else if ((r -= I_O) < I_F1) { W = w_ffn_in + (size_t)l * DM * 2 * DFF; K = DM; N = 2 * DFF; WT = Wf1_t; nblk = 2 * DFF / 32; mode = 2; }
                else { r -= I_F1; W = w_ffn_out + (size_t)l * DFF * DM; K = DFF; N = DM; WT = Wf2_t; nblk = DM / 32; }
                cvt_item(W, K, N, WT, scr, r, nblk, lane, mode);
            }
        }
#define NORM_LDMOD(SEL, GVEC, SHOFF, SCOFF) do { const float* mp = modl + (size_t)(SEL) * NMOD; \
                _Pragma("unroll") for (int j = 0; j < 8; ++j) { const int c = 4 * ln_ + 256 * j; const f32x4 g = *(const f32x4*)((GVEC) + c), sc = *(const f32x4*)(mp + (SCOFF) + c); \
                    Aa[j] = g * (sc + 1.0f); Ss[j] = *(const f32x4*)(mp + (SHOFF) + c); } } while (0)
#define NORM_FINISH(R) do { float ss = 0.f; \
                _Pragma("unroll") for (int j = 0; j < 8; ++j) ss += (v[j][0] * v[j][0] + v[j][1] * v[j][1]) + (v[j][2] * v[j][2] + v[j][3] * v[j][3]); \
                const float rstd = 1.0f / sqrtf(wave_sum(ss) * (1.0f / DM) + EPS); \
                bf16* hp = Hb + (size_t)(R) * DM + 4 * ln_; \
                _Pragma("unroll") for (int j = 0; j < 8; ++j) { const f32x4 y = v[j] * rstd * Aa[j] + Ss[j]; v2u w; w.x = pk2(y[0], y[1]); w.y = pk2(y[2], y[3]); *(v2u*)(hp + 256 * j) = w; } } while (0)
#define NORM_ROWS(GVEC, SHOFF, SCOFF, FIRST, WITHCTX, PARTG) do { \
            int ln_ = lane; asm volatile("" : "+v"(ln_)); \
            f32x4 Aa[8], Ss[8]; \
            _Pragma("unroll") for (int j = 0; j < 8; ++j) { Aa[j] = (f32x4){0.f, 0.f, 0.f, 0.f}; Ss[j] = (f32x4){0.f, 0.f, 0.f, 0.f}; } \
            for (int gv_ = gw; gv_ < 2048; gv_ += NGW) { \
                NORM_LDMOD((gv_ * 16) >> 12, GVEC, SHOFF, SCOFF);                                   \
                _Pragma("nounroll") for (int ri = 0; ri < 16; ++ri) { int r = gv_ * 16 + ri; asm volatile("" : "+s"(r)); \
                    const bf16* sb_ = XB + (size_t)r * DM + 4 * ln_; f32x4 v[8]; \
                    _Pragma("unroll") for (int j = 0; j < 8; ++j) { const v2u t_ = *(const v2u*)(sb_ + 256 * j); v[j] = (f32x4){bflo(t_.x), bfhi(t_.x), bflo(t_.y), bfhi(t_.y)}; } \
                    NORM_FINISH(r); } \
                if (WITHCTX) { NORM_LDMOD(8, GVEC, SHOFF, SCOFF); int rc = gv_; asm volatile("" : "+s"(rc));     \
                    bf16* sb_ = XCB + (size_t)rc * DM + 4 * ln_; f32x4 v[8]; \
                    _Pragma("unroll") for (int j = 0; j < 8; ++j) { const v2u t_ = *(const v2u*)(sb_ + 256 * j); v[j] = (f32x4){bflo(t_.x), bfhi(t_.x), bflo(t_.y), bfhi(t_.y)}; } \
                    if ((PARTG) != nullptr) { const bf16* pp = PART + (size_t)rc * DM + 4 * ln_; \
                        _Pragma("unroll") for (int j = 0; j < 8; ++j) { const v2u q0_ = *(const v2u*)(pp + 256 * j), q1_ = *(const v2u*)(pp + (size_t)2048 * DM + 256 * j), q2_ = *(const v2u*)(pp + (size_t)2 * 2048 * DM + 256 * j), q3_ = *(const v2u*)(pp + (size_t)3 * 2048 * DM + 256 * j); \
                            const f32x4 p = ((f32x4){bflo(q0_.x), bfhi(q0_.x), bflo(q0_.y), bfhi(q0_.y)} + (f32x4){bflo(q1_.x), bfhi(q1_.x), bflo(q1_.y), bfhi(q1_.y)}) + ((f32x4){bflo(q2_.x), bfhi(q2_.x), bflo(q2_.y), bfhi(q2_.y)} + (f32x4){bflo(q3_.x), bfhi(q3_.x), bflo(q3_.y), bfhi(q3_.y)}); \
                            v[j] += *(const f32x4*)((PARTG) + 4 * ln_ + 256 * j) * p; } \
                        _Pragma("unroll") for (int j = 0; j < 8; ++j) { v2u w_; w_.x = pk2(v[j][0], v[j][1]); w_.y = pk2(v[j][2], v[j][3]); *(v2u*)(sb_ + 256 * j) = w_; } } \
                    NORM_FINISH(ML + rc); } } \
        } while (0)
        if (RUN(0)) { PHASE_BEGIN const float* gv = g_mix + (size_t)l * DM; const int first = (l == 0) ? 1 : 0;
            const float* pg = first ? nullptr : (MOD + ((size_t)(l - 1) * 9 + 8) * NMOD + 5 * DM);
            NORM_ROWS(gv, 0, DM, first, true, pg); }
        GRID_BAR();

        if (RUN(1)) { PHASE_BEGIN
            const bf16* A_ = Hb; const bf16* B_ = Win_t; asm volatile("" : "+s"(A_), "+s"(B_)); pg8::Gemm g{A_, B_, MT, NINP, DM}; pg8::StaticOrder S; S.init(Mg, NINP, G, bx); S.wgm = P1_WGM; if (lastl) S.set_extra(24, ML / 256, 24, 3);
            pg8::EpiWin E{Gb, CQ, KF, GK, GV, GQ, Ub, ROPE};
            pg8::gemm_phase<pg8::EpiWin, pg8::StaticOrder, true, true>(lds + RING_OFF, g, S, E);
        }
        GRID_BAR();

        if (RUN(2)) { PHASE_BEGIN
            LAS float* cw = (LAS float*)(lds + RING_OFF);
            for (int i = tid; i < 31 * 512; i += NWAVES * 64) cw[i] = conv_w[(size_t)l * 31 * 512 + i];
            __syncthreads();
            { const f32x4 gk = *(const f32x4*)(g_kv_a + (size_t)l * 256 + 4 * lane), gq0 = *(const f32x4*)(g_q_a + (size_t)l * 512 + 4 * lane), gq1 = *(const f32x4*)(g_q_a + (size_t)l * 512 + 256 + 4 * lane);
              for (int r0 = gw; r0 < MT; r0 += 2 * NGW) { const int r1 = (r0 + NGW < MT) ? r0 + NGW : r0;
                const bf16* p = CQ + (size_t)r0 * 768 + 4 * lane; const bf16* q = CQ + (size_t)r1 * 768 + 4 * lane;
#define LD4(P) ({ const v2u t_ = *(const v2u*)(P); (f32x4){bflo(t_.x), bfhi(t_.x), bflo(t_.y), bfhi(t_.y)}; })
                const f32x4 a = LD4(p), b0 = LD4(p + 256), b1 = LD4(p + 512), c = LD4(q), d0 = LD4(q + 256), d1 = LD4(q + 512);
#undef LD4
#define LR_ROW(R, A_, B0_, B1_) do { \
                const float sa = wave_sum((A_[0] * A_[0] + A_[1] * A_[1]) + (A_[2] * A_[2] + A_[3] * A_[3])); \
                const float sb = wave_sum(((B0_[0] * B0_[0] + B0_[1] * B0_[1]) + (B0_[2] * B0_[2] + B0_[3] * B0_[3])) + ((B1_[0] * B1_[0] + B1_[1] * B1_[1]) + (B1_[2] * B1_[2] + B1_[3] * B1_[3]))); \
                const float ra = 1.0f / sqrtf(sa * (1.0f / 256.0f) + EPS), rb = 1.0f / sqrtf(sb * (1.0f / 512.0f) + EPS); \
                const f32x4 ya = A_ * ra * gk, y0 = B0_ * rb * gq0, y1 = B1_ * rb * gq1; \
                v2u w; w.x = pk2(ya[0], ya[1]); w.y = pk2(ya[2], ya[3]); *(v2u*)(CKVn + (size_t)(R) * 256 + 4 * lane) = w; \
                w.x = pk2(y0[0], y0[1]); w.y = pk2(y0[2], y0[3]); *(v2u*)(QAn + (size_t)(R) * 512 + 4 * lane) = w; \
                w.x = pk2(y1[0], y1[1]); w.y = pk2(y1[2], y1[3]); *(v2u*)(QAn + (size_t)(R) * 512 + 256 + 4 * lane) = w; } while (0)
                LR_ROW(r0, a, b0, b1); LR_ROW(r1, c, d0, d1);
#undef LR_ROW
              } }
            { const int ch = 8 * lane;
              const f32x4 cb0 = *(const f32x4*)(conv_b + (size_t)l * 512 + ch), cb1 = *(const f32x4*)(conv_b + (size_t)l * 512 + ch + 4);
              const f32x4 lg0 = *(const f32x4*)(conv_ln_g + (size_t)l * 512 + ch), lg1 = *(const f32x4*)(conv_ln_g + (size_t)l * 512 + ch + 4);
              const f32x4 lb0 = *(const f32x4*)(conv_ln_b + (size_t)l * 512 + ch), lb1 = *(const f32x4*)(conv_ln_b + (size_t)l * 512 + ch + 4);
              for (int tok = gw; tok < Mg; tok += NGW) {
                int sb, pos, L; if (tok < ML) { sb = tok & ~4095; pos = tok & 4095; L = SEQ; } else { const int c = tok - ML; sb = ML + (c & ~255); pos = c & 255; L = CTXL; }
                f32x4 a0 = cb0, a1 = cb1;
                v4u xr[31];
                if (pos >= 15 && pos < L - 15) {
                    const bf16* up = Ub + (size_t)(sb + pos - 15) * 512 + ch;
#pragma unroll
                    for (int j = 0; j < 31; ++j) xr[j] = *(const v4u*)(up + (size_t)j * 512);
                    asm volatile("" ::: "memory");
#pragma unroll
                    for (int j = 0; j < 31; ++j) { const v4u x = xr[j];
                        const f32x4 w0 = *(const LAS f32x4*)(cw + j * 512 + ch), w1 = *(const LAS f32x4*)(cw + j * 512 + ch + 4);
                        const f32x4 x0 = {bflo(x.x), bfhi(x.x), bflo(x.y), bfhi(x.y)}, x1 = {bflo(x.z), bfhi(x.z), bflo(x.w), bfhi(x.w)};
                        a0 += w0 * x0; a1 += w1 * x1; if ((j & 3) == 3) asm volatile("" ::: "memory"); }
                } else {
#pragma unroll
                    for (int j = 0; j < 31; ++j) { int p = pos + j - 15; p = p < 0 ? 0 : (p >= L ? L - 1 : p); xr[j] = *(const v4u*)(Ub + (size_t)(sb + p) * 512 + ch); }
                    asm volatile("" ::: "memory");
#pragma unroll
                    for (int j = 0; j < 31; ++j) { const int p = pos + j - 15; const float ok = (p >= 0 && p < L) ? 1.0f : 0.0f; const v4u x = xr[j];
                        const f32x4 w0 = *(const LAS f32x4*)(cw + j * 512 + ch) * ok, w1 = *(const LAS f32x4*)(cw + j * 512 + ch + 4) * ok;
                        const f32x4 x0 = {bflo(x.x), bfhi(x.x), bflo(x.y), bfhi(x.y)}, x1 = {bflo(x.z), bfhi(x.z), bflo(x.w), bfhi(x.w)};
                        a0 += w0 * x0; a1 += w1 * x1; if ((j & 3) == 3) asm volatile("" ::: "memory"); }
                }
                const float mean = wave_sum((a0[0] + a0[1]) + (a0[2] + a0[3]) + (a1[0] + a1[1]) + (a1[2] + a1[3])) * (1.0f / 512.0f);
                const f32x4 d0 = a0 - mean, d1 = a1 - mean;
                const float var = wave_sum((d0[0] * d0[0] + d0[1] * d0[1]) + (d0[2] * d0[2] + d0[3] * d0[3]) + (d1[0] * d1[0] + d1[1] * d1[1]) + (d1[2] * d1[2] + d1[3] * d1[3])) * (1.0f / 512.0f);
                const float rstd = 1.0f / sqrtf(var + EPS);
                const f32x4 y0 = d0 * rstd * lg0 + lb0, y1 = d1 * rstd * lg1 + lb1;
                v4u w; w.x = pk2(y0[0] * sigmf(y0[0]), y0[1] * sigmf(y0[1])); w.y = pk2(y0[2] * sigmf(y0[2]), y0[3] * sigmf(y0[3]));
                w.z = pk2(y1[0] * sigmf(y1[0]), y1[1] * sigmf(y1[1])); w.w = pk2(y1[2] * sigmf(y1[2]), y1[3] * sigmf(y1[3]));
                *(v4u*)(UC + (size_t)tok * 512 + ch) = w; } }
        }
        GRID_BAR();

        if (RUN(3)) { PHASE_BEGIN
            const bf16* A0_ = QAn; const bf16* B0_ = Wq_t; const bf16* A1_ = CKVn; const bf16* B1_ = Wkv_t; asm volatile("" : "+s"(A0_), "+s"(B0_), "+s"(A1_), "+s"(B1_));
            pg8::SchedQKV S; S.nMq = Mg / 256; S.nNq = 1536 / 256; S.nMk = MT / 256; S.nNk = 2048 / 256; S.G = G; S.c = bx; S.Aq = A0_; S.Bq = B0_; S.Ak = A1_; S.Bk = B1_;
            pg8::EpiQKV E{pg8::EpiQup{MQ, ROPE}, pg8::EpiKV{KF, Vb}};
            pg8::gemm_stream<pg8::EpiQKV, pg8::SchedQKV>(lds + RING_OFF, S, E);
        }
        GRID_BAR();

        if (RUN(4)) { PHASE_BEGIN
            att::lchar* alds = (att::lchar*)(lds + RING_OFF);
            for (int u = vcu; u < 1024 + (lastl ? 0 : 64); u += G) {
                int b, h, q0row, NT;
                if (u < 1024) { const int bh = u >> 4, qb = u & 15; b = bh >> 3; h = bh & 7; q0row = b * SEQ + qb * 256; NT = 4 + SEQ / 64; }
                else { const int bh = u - 1024; b = bh >> 3; h = bh & 7; q0row = ML + b * CTXL; NT = 4; }
                att::attn_unit<192, 128, false, false, ATT_MLA_MODE>(MQ + (size_t)q0row * 1536 + h * 192, 1536, KF + h * 192, 1536, Vb + h * 128, 1024, OM + (size_t)q0row * 1024 + h * 128, 1024,
                                                       ML + b * CTXL, b * SEQ, NT, 0, 0, 0.f, alds);
            }
            for (int u = vcu; u < 1024 + (lastl ? 0 : 128); u += G) {
                int b, h, q0row, NT, qpos0, kpos0;
                if (u >= 1024 && u < 1088) continue;
                if (u < 1024) { const int bh = u >> 4, qb = u & 15; b = bh >> 3; h = bh & 7; q0row = b * SEQ + qb * 256; qpos0 = qb * 256;
                    const int klo = qpos0 - 128 < 0 ? 0 : qpos0 - 128, khi = qpos0 + 384 > SEQ ? SEQ : qpos0 + 384; kpos0 = klo; NT = 4 + (khi - klo) / 64; }
                else { const int bh = u - 1088; b = bh >> 3; h = bh & 7; q0row = ML + b * CTXL; NT = 4; qpos0 = 0; kpos0 = 0; }
                const float sk = gqa_sink[l * 8 + h] * 1.4426950408889634f;
                att::attn_unit<64, 64, true, true, ATT_GQA_MODE>(GQ + (size_t)q0row * 512 + h * 64, 512, GK + (h >> 2) * 64, 128, GV + (h >> 2) * 64, 128, OG + (size_t)q0row * 512 + h * 64, 512,
                                                   ML + b * CTXL, b * SEQ + kpos0, NT, qpos0, kpos0, sk, alds);
            }
            __syncthreads();
        }
        GRID_BAR();

        if (RUN(5)) { PHASE_BEGIN
            pg8::SchedMerge S; S.base.init(Mg, DM, G, bx); S.base.wgm = P5_WGM;
            { const bf16* a0_ = UC; const bf16* a1_ = OM; const bf16* a2_ = OG; const bf16* b0_ = Wc_t; const bf16* b1_ = Wm_t; const bf16* b2_ = Wg_t; asm volatile("" : "+s"(a0_), "+s"(a1_), "+s"(a2_), "+s"(b0_), "+s"(b1_), "+s"(b2_));
              S.a0 = (const char*)a0_; S.da1 = (const char*)a1_ - (const char*)a0_; S.da2 = (const char*)a2_ - (const char*)a1_; S.b0 = (const char*)b0_; S.db1 = (const char*)b1_ - (const char*)b0_; S.db2 = (const char*)b2_ - (const char*)b1_; }
            pg8::EpiChain E{Gb, Yb};
            pg8::gemm_stream<pg8::EpiChain, pg8::SchedMerge, true>(lds + RING_OFF, S, E);
        }
        GRID_BAR();

        if (RUN(6)) { PHASE_BEGIN
            const bf16* A_ = Yb; const bf16* B_ = Wo_t; asm volatile("" : "+s"(A_), "+s"(B_));
            pg8::SchedSplit S; S.A = A_; S.Bt = B_; S.K = DM; S.nlat = 1024; S.nctx = lastl ? 0 : 256; S.G = G; S.c = bx; S.wgm = SPLIT_WGM;
            pg8::EpiSplit E{pg8::EpiResid{XB, modl, 2 * DM}, PART};
            pg8::gemm_stream<pg8::EpiSplit, pg8::SchedSplit>(lds + RING_OFF, S, E);
        }
        GRID_BAR();

        if (RUN(7)) { PHASE_BEGIN const float* gv = g_ffn + (size_t)l * DM; const float* pg = lastl ? nullptr : (modl + (size_t)8 * NMOD + 2 * DM);
            const int first = (l == 0) ? 2 : 0; NORM_ROWS(gv, 3 * DM, 4 * DM, first, !lastl, pg); }
        GRID_BAR();

        if (RUN(8)) { PHASE_BEGIN
            const bf16* A_ = Hb; const bf16* B_ = Wf1_t; asm volatile("" : "+s"(A_), "+s"(B_)); pg8::Gemm g{A_, B_, MT, 2 * DFF, DM}; pg8::StaticOrder S; S.init(Mg, 2 * DFF, G, bx); S.wgm = P8_WGM; pg8::EpiSwiGLU E{HID};
            pg8::gemm_phase<pg8::EpiSwiGLU, pg8::StaticOrder, true, true>(lds + RING_OFF, g, S, E);
        }
        GRID_BAR();

        if (RUN(9)) { PHASE_BEGIN
            const bf16* A_ = HID; const bf16* B_ = Wf2_t; asm volatile("" : "+s"(A_), "+s"(B_));
            pg8::SchedSplit S; S.A = A_; S.Bt = B_; S.K = DFF; S.nlat = 1024; S.nctx = lastl ? 0 : 256; S.G = G; S.c = bx; S.wgm = SPLIT_WGM;
            pg8::EpiSplit E{pg8::EpiResid{XB, modl, 5 * DM}, PART};
            pg8::gemm_stream<pg8::EpiSplit, pg8::SchedSplit>(lds + RING_OFF, S, E);
        }
        GRID_BAR();
    }

    if (RUN(PH_POST)) { PHASE_BEGIN
        f32x4 gf[8];
#pragma unroll
        for (int j = 0; j < 8; ++j) gf[j] = *(const f32x4*)(g_final + 4 * lane + 256 * j);
        for (int r = gw; r < ML; r += NGW) { float* p = XL + (size_t)r * DM + 4 * lane; const bf16* sb = XB + (size_t)r * DM + 4 * lane; f32x4 v[8]; float ss = 0.f;
#pragma unroll
            for (int j = 0; j < 8; ++j) { const v2u t_ = *(const v2u*)(sb + 256 * j); v[j] = (f32x4){bflo(t_.x), bfhi(t_.x), bflo(t_.y), bfhi(t_.y)}; ss += (v[j][0] * v[j][0] + v[j][1] * v[j][1]) + (v[j][2] * v[j][2] + v[j][3] * v[j][3]); }
            const float rstd = 1.0f / sqrtf(wave_sum(ss) * (1.0f / DM) + EPS);
#pragma unroll
            for (int j = 0; j < 8; ++j) *(f32x4*)(p + 256 * j) = v[j] * rstd * gf[j]; }
    }

#if defined(DBG_STAGE)
    if (RUN(PH_DUMP)) { PHASE_BEGIN
        const int sel = ap->pad0; const size_t total = (size_t)G * NWAVES * 64, gt = (size_t)bx * NWAVES * 64 + tid;
        for (size_t i = gt; i < (size_t)ML * DM; i += total) { float v = 0.f;
#define DB16(bit, P, N) if (sel & (bit)) v += __uint_as_float((unsigned)(P)[i % (size_t)(N)] << 16)
            if (sel & 1) v += MOD[i % (size_t)(DEPTH * 9 * NMOD)];
            DB16(2, Hb, (size_t)MT * 2048); DB16(4, Gb, (size_t)MT * 6144); DB16(8, KF, (size_t)MT * 1536); DB16(16, Vb, (size_t)MT * 1024); DB16(32, GQ, (size_t)MT * 512);
            DB16(64, UC, (size_t)MT * 512); DB16(128, MQ, (size_t)MT * 1536); DB16(256, OM, (size_t)MT * 1024); DB16(512, OG, (size_t)MT * 512); DB16(1024, Yb, (size_t)MT * 2048);
            DB16(2048, Win_t, (size_t)NINP * 2048); DB16(4096, GK, (size_t)MT * 128); DB16(8192, GV, (size_t)MT * 128); DB16(16384, CKVn, (size_t)MT * 256); DB16(32768, QAn, (size_t)MT * 512);
            DB16(65536, Ub, (size_t)MT * 512); DB16(131072, Wf1_t, (size_t)2 * DFF * DM); DB16(262144, Wf2_t, (size_t)DM * DFF); DB16(524288, HID, (size_t)MT * DFF);
            if (sel & 1048576) v += CQ[i % ((size_t)MT * 768)];
            XL[i] = v; }
    }
#endif
#undef RUN
#undef GRID_BAR
#undef NORM_ROWS
}

#ifndef MK_MULTI
#define MK_MULTI 0
#endif
extern "C" void kernel_launch(void* const* d_in, const int* in_sizes, int n_in, void* d_out, int out_size, void* d_ws, size_t ws_size, hipStream_t stream) {
    static int grid = 0;
    if (grid == 0) {
        if (n_in != 25 || in_sizes[0] != ML * DM || out_size != ML * DM || ws_size < WS_END) {
            fprintf(stderr, "kernel_launch: shape mismatch: n_in %d in0 %d out %d ws %zu (need %zu)\n", n_in, n_in > 0 ? in_sizes[0] : -1, out_size, ws_size, (size_t)WS_END); grid = -1; return; }
        int dev = 0, cus = 0, per_cu = 0;
        if (hipGetDevice(&dev) != hipSuccess || hipDeviceGetAttribute(&cus, hipDeviceAttributeMultiprocessorCount, dev) != hipSuccess) { grid = -1; return; }
        if (hipFuncSetAttribute((const void*)mega_fwd, hipFuncAttributeMaxDynamicSharedMemorySize, LDS_BYTES) != hipSuccess) { fprintf(stderr, "kernel_launch: hipFuncSetAttribute failed\n"); grid = -1; return; }
        if (hipOccupancyMaxActiveBlocksPerMultiprocessor(&per_cu, (const void*)mega_fwd, NWAVES * 64, LDS_BYTES) != hipSuccess || per_cu < 1)
            fprintf(stderr, "kernel_launch: note: occupancy query reports %d workgroups per CU\n", per_cu);
        (void)hipGetLastError();
        grid = cus;
    }
    if (grid < 0) return;
    if (hipMemsetAsync((char*)d_ws + WS_CTL, 0, CTL_ZERO_BYTES, stream) != hipSuccess) return;
    Args a{};
    for (int i = 0; i < 25; ++i) a.in[i] = (const float*)d_in[i];
    a.out = (float*)d_out; a.ws = (unsigned char*)d_ws;
#if defined(DBG_STAGE)
    a.multi = 1;
    a.l_lo = 0; a.l_hi = 0; a.ph = PH_PRE; hipLaunchKernelGGL(mega_fwd, dim3(grid), dim3(NWAVES * 64), LDS_BYTES, stream, a);
    for (int p = 0; p <= DBG_STAGE; ++p) { a.l_lo = 0; a.l_hi = 1; a.ph = p; hipLaunchKernelGGL(mega_fwd, dim3(grid), dim3(NWAVES * 64), LDS_BYTES, stream, a); }
    a.l_lo = 0; a.l_hi = 0; a.ph = PH_DUMP; a.pad0 = DBG_SEL; hipLaunchKernelGGL(mega_fwd, dim3(grid), dim3(NWAVES * 64), LDS_BYTES, stream, a);
#elif MK_MULTI
    a.multi = 1;
    a.l_lo = 0; a.l_hi = 0; a.ph = PH_PRE; hipLaunchKernelGGL(mega_fwd, dim3(grid), dim3(NWAVES * 64), LDS_BYTES, stream, a);
    for (int l = 0; l < DEPTH; ++l) for (int p = 0; p < 10; ++p) { a.l_lo = l; a.l_hi = l + 1; a.ph = p; hipLaunchKernelGGL(mega_fwd, dim3(grid), dim3(NWAVES * 64), LDS_BYTES, stream, a); }
    a.l_lo = 0; a.l_hi = 0; a.ph = PH_POST; hipLaunchKernelGGL(mega_fwd, dim3(grid), dim3(NWAVES * 64), LDS_BYTES, stream, a);
#else
    a.multi = 0; a.l_lo = 0; a.l_hi = DEPTH; a.ph = 0;
    hipLaunchKernelGGL(mega_fwd, dim3(grid), dim3(NWAVES * 64), LDS_BYTES, stream, a);
#endif
    const hipError_t le = hipPeekAtLastError();
    if (le != hipSuccess) fprintf(stderr, "kernel_launch: launch failed: %s\n", hipGetErrorName(le));
}
```

```cpp
#include <hip/hip_runtime.h>
#include <cstdio>
#include <cstdint>
#define GAS __attribute__((address_space(1)))
#define LAS __attribute__((address_space(3)))
namespace pg8 {
#define PG8_LAS __attribute__((address_space(3)))
typedef unsigned short bf16_t;
typedef short bf16x8 __attribute__((ext_vector_type(8)));
typedef float f32x4 __attribute__((ext_vector_type(4)));
typedef unsigned u32x4 __attribute__((ext_vector_type(4)));
constexpr int BM = 256, BK = 64, HALF = 128, HTB = HALF * BK * 2  , STAGE_BYTES = 8 * HTB, NXCD = 8, WGM = 8;

__host__ __device__ __forceinline__ int lds_byte(int r, int c) { const int st = (r >> 4) * 2 + (c >> 5), rr = r & 15, cc = c & 31, ob = rr * 64 + cc * 2; return st * 1024 + (ob ^ (((ob >> 9) & 1) << 5)); }
__host__ __device__ __forceinline__ void stage_rc(int b, int& R, int& C) { const int st = b / 1024, sb = b % 1024, swz = sb ^ (((sb >> 9) & 1) << 5); R = (st >> 1) * 16 + swz / 64; C = (st & 1) * 32 + (swz % 64) / 2; }
__host__ __device__ __forceinline__ int perm32(int rho) { const int n = rho >> 4, i = rho & 15; return 8 * (i >> 2) + 4 * n + (i & 3); }

struct Unit { int pm, pn; };
struct Gemm { const bf16_t* A; const bf16_t* Bt; int M, N, K; };

struct StaticOrder {
    int nM, nN, nwg, G, c, ext_n, ext_pm0, ext_pn0, ext_w, wgm, ext_c0;
    __host__ __device__ void init(int M, int N, int G_, int c_) { nM = M / BM; nN = N / BM; nwg = nM * nN; G = G_; c = c_; ext_n = 0; ext_pm0 = 0; ext_pn0 = 0; ext_w = 1; wgm = WGM; ext_c0 = 0; }
    __host__ __device__ void set_extra(int n, int pm0, int pn0, int w) { ext_n = n; ext_pm0 = pm0; ext_pn0 = pn0; ext_w = w; }
    __host__ __device__ bool next(int i, Unit& u) const {
        const long L = (long)i * G + c;
        if (L >= nwg) { const int e = (int)(L - nwg) - ext_c0; if (e < 0 || e >= ext_n) return false; u.pm = ext_pm0 + e / ext_w; u.pn = ext_pn0 + e % ext_w; return true; }
        int wgid = (int)L; { const int q = nwg / NXCD, r = nwg % NXCD, xcd = wgid % NXCD, off = wgid / NXCD; wgid = (xcd < r ? xcd * (q + 1) : r * (q + 1) + (xcd - r) * q) + off; }
        const int nig = wgm * nN, gid = wgid / nig, fm = gid * wgm, gsz = (nM - fm) < wgm ? (nM - fm) : wgm;
        u.pm = fm + ((wgid % nig) % gsz); u.pn = (wgid % nig) / gsz; return true;
    }
    static __host__ __device__ __forceinline__ void map_entry(int nM_, int nN_, int L, Unit& u, int WGM_ = WGM) {
        const int nwg_ = nM_ * nN_; int wgid = L; { const int q = nwg_ / NXCD, r = nwg_ % NXCD, xcd = wgid % NXCD, off = wgid / NXCD; wgid = (xcd < r ? xcd * (q + 1) : r * (q + 1) + (xcd - r) * q) + off; }
        const int nig = WGM_ * nN_, gid = wgid / nig, fm = gid * WGM_, gsz = (nM_ - fm) < WGM_ ? (nM_ - fm) : WGM_;
        u.pm = fm + ((wgid % nig) % gsz); u.pn = (wgid % nig) / gsz;
    }
    __device__ __forceinline__ void a_ready(const Unit&) const {}
    __device__ __forceinline__ void done(const Unit&) const {}
};
struct MergeOrder : StaticOrder {
    const unsigned* wflag; unsigned* tmo;
    __device__ __forceinline__ void a_ready(const Unit& u) const {
        if (wflag == nullptr || ext_n == 0 || u.pm < ext_pm0) return;
        if (threadIdx.x < 64) {
            const unsigned* f = wflag + (size_t)((u.pm - ext_pm0) * ext_w + (u.pn - ext_pn0)) * 16;
            const unsigned long long t0 = __builtin_amdgcn_s_memrealtime(); unsigned polls = 0;
            while ((unsigned)__builtin_amdgcn_readfirstlane(__hip_atomic_load(f, __ATOMIC_RELAXED, __HIP_MEMORY_SCOPE_AGENT)) == 0u) {
                if ((++polls & 255u) == 0u && __builtin_amdgcn_readfirstlane(__hip_atomic_load(tmo, __ATOMIC_RELAXED, __HIP_MEMORY_SCOPE_AGENT)) != 0u) break;
                if (__builtin_amdgcn_s_memrealtime() - t0 > 2000000ull) { if (threadIdx.x == 0) __hip_atomic_store(tmo, 1u, __ATOMIC_RELAXED, __HIP_MEMORY_SCOPE_AGENT); break; }
                __builtin_amdgcn_s_sleep(2); }
            __builtin_amdgcn_fence(__ATOMIC_ACQUIRE, "agent");
            asm volatile("s_waitcnt vmcnt(0)" ::: "memory");
        }
        asm volatile("" ::: "memory"); __builtin_amdgcn_s_barrier(); asm volatile("" ::: "memory");
    }
};
typedef float f32x2_t __attribute__((ext_vector_type(2))); typedef __bf16 bf16x2_t __attribute__((ext_vector_type(2)));
__device__ __forceinline__ unsigned cvt_pk_bf16(float lo, float hi) { f32x2_t v = {lo, hi}; bf16x2_t b = __builtin_convertvector(v, bf16x2_t); return __builtin_bit_cast(unsigned, b); }
typedef float f32x2 __attribute__((ext_vector_type(2)));
template <class Epi, class Sched, bool ALIGN_EPI = false, bool SP2 = false>
__device__ __forceinline__ void gemm_phase(PG8_LAS unsigned char* lds, const Gemm g, const Sched& S, const Epi& E) {
    int tid_ = threadIdx.x; asm volatile("" : "+v"(tid_));
    const int tid = tid_, wid = __builtin_amdgcn_readfirstlane(tid >> 6), lane = tid & 63, wr = wid >> 2, wc = wid & 3, fr = lane & 15, fq = lane >> 4;
    const int K = g.K, nt = K / BK;
    unsigned voffA[2], voffB[2];
#pragma unroll
    for (int i = 0; i < 2; ++i) { int R, C; stage_rc(tid * 16 + i * 8192, R, C); const int Rb = Epi::PERM ? ((R & ~31) + perm32(R & 31)) : R;
        voffA[i] = (unsigned)(R * K + C) * 2u; voffB[i] = (unsigned)(Rb * K + C) * 2u; }
    const size_t kstep = (size_t)(BK * 2);
    const size_t hstep = (size_t)HALF * K * 2;
    const size_t tstep = 2 * hstep;
    const unsigned ldsw = (unsigned)wid * 1024u;
    const int aoff = lds_byte(wr * 64 + fr, fq * 8), boff = lds_byte(wc * 32 + fr, fq * 8);
#define PG8_SA(b, h) (((b) * 2 + (h)) * HTB)
#define PG8_SB(b, h) ((4 + (b) * 2 + (h)) * HTB)
#define PG8_STAGE(bufoff, gbase, voff) do { _Pragma("unroll") for (int _i = 0; _i < 2; ++_i) \
        __builtin_amdgcn_global_load_lds((const unsigned*)((const char*)(gbase) + (voff)[_i]), (PG8_LAS unsigned*)(lds + (bufoff) + ldsw + _i * 8192), 16, 0, 0); } while (0)
#define PG8_LDA(dst, b, h) do { _Pragma("unroll") for (int m = 0; m < 4; ++m) _Pragma("unroll") for (int k = 0; k < 2; ++k) dst[m][k] = *(const PG8_LAS bf16x8*)(lds + PG8_SA(b, h) + aoff + m * 2048 + k * 1024); } while (0)
#define PG8_LDB(dst, b, h) do { _Pragma("unroll") for (int n = 0; n < 2; ++n) _Pragma("unroll") for (int k = 0; k < 2; ++k) dst[n][k] = *(const PG8_LAS bf16x8*)(lds + PG8_SB(b, h) + boff + n * 2048 + k * 1024); } while (0)
#define PG8_MMA(ai, bj, At, Bt) do { __builtin_amdgcn_s_setprio(1); _Pragma("unroll") for (int m = 0; m < 4; ++m) _Pragma("unroll") for (int n = 0; n < 2; ++n) _Pragma("unroll") for (int k = 0; k < 2; ++k) \
        acc[ai][bj][m][n] = __builtin_amdgcn_mfma_f32_16x16x32_bf16(Bt[n][k], At[m][k], acc[ai][bj][m][n], 0, 0, 0); __builtin_amdgcn_s_setprio(0); } while (0)
#define PG8_WAIT_V(n) asm volatile("s_waitcnt vmcnt(" #n ")" ::: "memory")
#define PG8_WAIT_L(n) asm volatile("s_waitcnt lgkmcnt(" #n ")" ::: "memory")
#define PG8_BAR __builtin_amdgcn_s_barrier()
#define PG8_SCHED __builtin_amdgcn_sched_barrier(0)
    Unit cur, nxt; int ui = 0;
    if (!S.next(0, cur)) return;
    f32x4 acc[2][2][4][2];
#pragma unroll
    for (int a = 0; a < 2; ++a)
#pragma unroll
        for (int b = 0; b < 2; ++b)
#pragma unroll
            for (int m = 0; m < 4; ++m)
#pragma unroll
                for (int n = 0; n < 2; ++n) acc[a][b][m][n] = (f32x4){0.f, 0.f, 0.f, 0.f};
    bf16x8 At[4][2], B0[2][2], B1[2][2];
    const char* cA = (const char*)g.A + (size_t)cur.pm * tstep; const char* cB = (const char*)g.Bt + (size_t)cur.pn * tstep;
    S.a_ready(cur);
    if constexpr (SP2) {
        PG8_STAGE(PG8_SB(0, 0), cB, voffB); PG8_STAGE(PG8_SB(0, 1), cB + hstep, voffB); PG8_STAGE(PG8_SA(0, 0), cA, voffA); PG8_STAGE(PG8_SA(0, 1), cA + hstep, voffA);
        if (wr == 1) PG8_BAR;
        PG8_WAIT_V(2); PG8_BAR;
        PG8_STAGE(PG8_SB(1, 0), cB + kstep, voffB); PG8_STAGE(PG8_SA(1, 0), cA + kstep, voffA); PG8_STAGE(PG8_SB(1, 1), cB + hstep + kstep, voffB);
        PG8_WAIT_V(6); PG8_BAR;
    } else {
        PG8_STAGE(PG8_SB(0, 0), cB, voffB); PG8_STAGE(PG8_SA(0, 0), cA, voffA); PG8_STAGE(PG8_SB(0, 1), cB + hstep, voffB); PG8_STAGE(PG8_SA(0, 1), cA + hstep, voffA);
        if (wr == 1) PG8_BAR;
        PG8_WAIT_V(4); PG8_BAR;
        PG8_STAGE(PG8_SB(1, 0), cB + kstep, voffB); PG8_STAGE(PG8_SA(1, 0), cA + kstep, voffA); PG8_STAGE(PG8_SB(1, 1), cB + hstep + kstep, voffB);
        PG8_WAIT_V(6); PG8_BAR;
    }
    for (;;) {
        const bool has_next = S.next(ui + 1, nxt);
        const char* nA = has_next ? (const char*)g.A + (size_t)nxt.pm * tstep : cA; const char* nB = has_next ? (const char*)g.Bt + (size_t)nxt.pn * tstep : cB;
#pragma nounroll
        for (int t = 0; t < nt; t += 2) {
            const bool last = (t == nt - 2);
            const char* a1 = cA + (size_t)(t + 1) * kstep;
            const char* a2 = last ? nA : cA + (size_t)(t + 2) * kstep; const char* b2 = last ? nB : cB + (size_t)(t + 2) * kstep;
            const char* a3 = a2 + kstep; const char* b3 = b2 + kstep;
            if (last && has_next) S.a_ready(nxt);
            if constexpr (SP2) {
            PG8_LDB(B0, 0, 0); PG8_LDB(B1, 0, 1); PG8_SCHED; PG8_LDA(At, 0, 0); PG8_STAGE(PG8_SA(1, 1), a1 + hstep, voffA);
            PG8_WAIT_V(8); PG8_WAIT_L(0); PG8_BAR; PG8_MMA(0, 0, At, B0); PG8_MMA(0, 1, At, B1); PG8_BAR; PG8_SCHED;
            PG8_LDA(At, 0, 1); PG8_STAGE(PG8_SB(0, 0), b2, voffB); PG8_STAGE(PG8_SB(0, 1), b2 + hstep, voffB); PG8_STAGE(PG8_SA(0, 0), a2, voffA);
            PG8_WAIT_V(8); PG8_WAIT_L(0); PG8_BAR; PG8_MMA(1, 0, At, B0); PG8_MMA(1, 1, At, B1); PG8_BAR; PG8_SCHED;
            PG8_LDB(B0, 1, 0); PG8_LDB(B1, 1, 1); PG8_SCHED; PG8_LDA(At, 1, 0); PG8_STAGE(PG8_SA(0, 1), a2 + hstep, voffA);
            PG8_WAIT_V(8); PG8_WAIT_L(0); PG8_BAR; PG8_MMA(0, 0, At, B0); PG8_MMA(0, 1, At, B1); PG8_BAR; PG8_SCHED;
            PG8_LDA(At, 1, 1); PG8_STAGE(PG8_SB(1, 0), b3, voffB); PG8_STAGE(PG8_SB(1, 1), b3 + hstep, voffB); PG8_STAGE(PG8_SA(1, 0), a3, voffA);
            PG8_WAIT_V(8); PG8_WAIT_L(0); PG8_BAR; PG8_MMA(1, 0, At, B0); PG8_MMA(1, 1, At, B1); PG8_BAR; PG8_SCHED;
            } else {
            PG8_LDB(B0, 0, 0); PG8_SCHED; PG8_LDA(At, 0, 0); PG8_STAGE(PG8_SA(1, 1), a1 + hstep, voffA);
            PG8_WAIT_L(8); PG8_BAR; PG8_WAIT_L(0); PG8_MMA(0, 0, At, B0); PG8_BAR; PG8_SCHED;
            PG8_LDB(B1, 0, 1); PG8_STAGE(PG8_SB(0, 0), b2, voffB);
            PG8_BAR; PG8_WAIT_L(0); PG8_MMA(0, 1, At, B1); PG8_BAR;
            PG8_LDA(At, 0, 1); PG8_STAGE(PG8_SA(0, 0), a2, voffA);
            PG8_BAR; PG8_WAIT_L(0); PG8_MMA(1, 0, At, B0); PG8_BAR; PG8_SCHED;
            PG8_STAGE(PG8_SB(0, 1), b2 + hstep, voffB);
            PG8_WAIT_V(6); PG8_BAR; PG8_MMA(1, 1, At, B1); PG8_BAR;
            PG8_LDB(B0, 1, 0); PG8_SCHED; PG8_LDA(At, 1, 0); PG8_STAGE(PG8_SA(0, 1), a2 + hstep, voffA);
            PG8_WAIT_L(8); PG8_BAR; PG8_WAIT_L(0); PG8_MMA(0, 0, At, B0); PG8_BAR; PG8_SCHED;
            PG8_LDB(B1, 1, 1); PG8_STAGE(PG8_SB(1, 0), b3, voffB);
            PG8_BAR; PG8_WAIT_L(0); PG8_MMA(0, 1, At, B1); PG8_BAR;
            PG8_LDA(At, 1, 1); PG8_STAGE(PG8_SA(1, 0), a3, voffA);
            PG8_BAR; PG8_WAIT_L(0); PG8_MMA(1, 0, At, B0); PG8_BAR; PG8_SCHED;
            PG8_STAGE(PG8_SB(1, 1), b3 + hstep, voffB);
            PG8_WAIT_V(6); PG8_BAR; PG8_MMA(1, 1, At, B1); PG8_BAR;
            }
        }
        if constexpr (ALIGN_EPI) { if (wr == 0) PG8_BAR; }
        if constexpr (!Epi::AFTER_DRAIN) { E(acc, cur, wr, wc, fr, fq); S.done(cur); }
        if (!has_next) break;
#pragma unroll
        for (int a = 0; a < 2; ++a)
#pragma unroll
            for (int b = 0; b < 2; ++b)
#pragma unroll
                for (int m = 0; m < 4; ++m)
#pragma unroll
                    for (int n = 0; n < 2; ++n) acc[a][b][m][n] = (f32x4){0.f, 0.f, 0.f, 0.f};
        cur = nxt; cA = nA; cB = nB; ++ui;
        if constexpr (ALIGN_EPI) { if (wr == 1) PG8_BAR; }
    }
    PG8_WAIT_V(0);
    if constexpr (!ALIGN_EPI) { if (wr == 0) PG8_BAR; }
    PG8_BAR;
    if constexpr (Epi::AFTER_DRAIN) { E.fused(acc, cur, wr, wc, fr, fq, lds, wid, lane); S.done(cur); }
#undef PG8_SA
#undef PG8_SB
#undef PG8_STAGE
#undef PG8_LDA
#undef PG8_LDB
#undef PG8_MMA
#undef PG8_WAIT_V
#undef PG8_WAIT_L
#undef PG8_BAR
#undef PG8_SCHED
}
}
namespace pg8 {
typedef unsigned u32x2 __attribute__((ext_vector_type(2)));
constexpr int ML_ROWS = 32768;
__device__ __forceinline__ float sigm(float x) { return __builtin_amdgcn_rcpf(1.0f + __builtin_amdgcn_exp2f(-1.4426950408889634f * x)); }
__device__ __forceinline__ u32x2 pack4(const f32x4 v) { u32x2 w; w.x = cvt_pk_bf16(v[0], v[1]); w.y = cvt_pk_bf16(v[2], v[3]); return w; }
__device__ __forceinline__ void rope4(f32x4& x0, f32x4& x1, const float* rope, int row, int half, int fq) {
    const int t = row & 4095, p = half ? (t & 63) : (t >> 6);
    const f32x4* tp = (const f32x4*)(rope + (p * 16 + 4 * fq) * 2);
    const f32x4 a = tp[0], b = tp[1];
    const f32x4 c = {a[0], a[2], b[0], b[2]}, s = {a[1], a[3], b[1], b[3]};
    const f32x4 y0 = x0 * c - x1 * s, y1 = x1 * c + x0 * s;
    x0 = y0; x1 = y1;
}
struct EpiWin {
    static constexpr bool PERM = false, AFTER_DRAIN = false;
    unsigned char* G; bf16_t* CQ; bf16_t* KF; bf16_t* GK; bf16_t* GV; bf16_t* GQ; bf16_t* U; const float* rope;
    __device__ __forceinline__ void operator()(const f32x4 (&acc)[2][2][4][2], const Unit& u, int wr, int wc, int fr, int fq) const {
        const int row0 = u.pm * BM + wr * 64 + fr; const bool lat = u.pm < (ML_ROWS / BM);
#pragma unroll
        for (int bj = 0; bj < 2; ++bj) {
            const int colg = u.pn * BM + bj * HALF + wc * 32;
            if (colg < 6144) {
#pragma unroll
                for (int ai = 0; ai < 2; ++ai)
#pragma unroll
                    for (int m = 0; m < 4; ++m) { const size_t row = (size_t)(row0 + ai * HALF + m * 16);
#pragma unroll
                        for (int n = 0; n < 2; ++n) { const f32x4 v = acc[ai][bj][m][n];
#define SG8(x) ((unsigned)(__builtin_amdgcn_rcpf(1.0f + __builtin_amdgcn_exp2f(x)) * 255.0f + 0.5f))
                            const unsigned q0 = SG8(v[0]), q1 = SG8(v[1]), q2 = SG8(v[2]), q3 = SG8(v[3]);
#undef SG8
                            *(unsigned*)(G + row * 6144 + colg + 16 * n + 4 * fq) = q0 | (q1 << 8) | (q2 << 16) | (q3 << 24); } }
            } else {
                const int o = colg - 6144;
                if (o < 256 || (o >= 576 && o < 1088)) {
                    const int co = (o < 256) ? o : (256 + o - 576);
#pragma unroll
                    for (int ai = 0; ai < 2; ++ai)
#pragma unroll
                        for (int m = 0; m < 4; ++m) { const size_t row = (size_t)(row0 + ai * HALF + m * 16);
#pragma unroll
                            for (int n = 0; n < 2; ++n) *(u32x2*)(CQ + row * 768 + co + 16 * n + 4 * fq) = pack4(acc[ai][bj][m][n]); }
                } else if (o < 320) {
                    const int half = (o - 256) >> 5;
#pragma unroll
                    for (int ai = 0; ai < 2; ++ai)
#pragma unroll
                        for (int m = 0; m < 4; ++m) { const int r = row0 + ai * HALF + m * 16; f32x4 x0 = acc[ai][bj][m][0], x1 = acc[ai][bj][m][1];
                            if (lat) rope4(x0, x1, rope, r, half, fq);
                            const u32x2 w0 = pack4(x0), w1 = pack4(x1); bf16_t* p = KF + (size_t)r * 1536 + 128 + (o - 256) + 4 * fq;
#pragma unroll
                            for (int h = 0; h < 8; ++h) { *(u32x2*)(p + h * 192) = w0; *(u32x2*)(p + h * 192 + 16) = w1; } }
                } else if (o < 448 || (o >= 1088 && o < 1600)) {
                    const bool isk = o < 448; const int co = isk ? (o - 320) : (o - 1088); const int half = (co >> 5) & 1;
                    bf16_t* base = isk ? GK : GQ; const int ld = isk ? 128 : 512;
#pragma unroll
                    for (int ai = 0; ai < 2; ++ai)
#pragma unroll
                        for (int m = 0; m < 4; ++m) { const int r = row0 + ai * HALF + m * 16; f32x4 x0 = acc[ai][bj][m][0], x1 = acc[ai][bj][m][1];
                            if (lat) rope4(x0, x1, rope, r, half, fq);
                            bf16_t* p = base + (size_t)r * ld + co + 4 * fq; *(u32x2*)p = pack4(x0); *(u32x2*)(p + 16) = pack4(x1); }
                } else if (o < 576) {
#pragma unroll
                    for (int ai = 0; ai < 2; ++ai)
#pragma unroll
                        for (int m = 0; m < 4; ++m) { const size_t row = (size_t)(row0 + ai * HALF + m * 16); bf16_t* p = GV + row * 128 + (o - 448) + 4 * fq;
                            *(u32x2*)p = pack4(acc[ai][bj][m][0]); *(u32x2*)(p + 16) = pack4(acc[ai][bj][m][1]); }
                } else if (o < 2624) {
                    const int g = (o - 1600) >> 5;
#pragma unroll
                    for (int ai = 0; ai < 2; ++ai)
#pragma unroll
                        for (int m = 0; m < 4; ++m) { const size_t row = (size_t)(row0 + ai * HALF + m * 16); const f32x4 a = acc[ai][bj][m][0], b = acc[ai][bj][m][1];
                            const f32x4 uu = {a[0] * sigm(b[0]), a[1] * sigm(b[1]), a[2] * sigm(b[2]), a[3] * sigm(b[3])};
                            *(u32x2*)(U + row * 512 + 16 * g + 4 * fq) = pack4(uu); }
                }
            }
        }
    }
};
struct EpiQup {
    static constexpr bool PERM = false, AFTER_DRAIN = false;
    bf16_t* MQ; const float* rope;
    __device__ __forceinline__ void operator()(const f32x4 (&acc)[2][2][4][2], const Unit& u, int wr, int wc, int fr, int fq) const {
        const int row0 = u.pm * BM + wr * 64 + fr; const bool lat = u.pm < (ML_ROWS / BM);
#pragma unroll
        for (int bj = 0; bj < 2; ++bj) {
            const int colg = u.pn * BM + bj * HALF + wc * 32, hd = colg % 192; const bool isr = hd >= 128; const int half = (hd - 128) >> 5;
#pragma unroll
            for (int ai = 0; ai < 2; ++ai)
#pragma unroll
                for (int m = 0; m < 4; ++m) { const int r = row0 + ai * HALF + m * 16; f32x4 x0 = acc[ai][bj][m][0], x1 = acc[ai][bj][m][1];
                    if (isr && lat) rope4(x0, x1, rope, r, half, fq);
                    bf16_t* p = MQ + (size_t)r * 1536 + colg + 4 * fq; *(u32x2*)p = pack4(x0); *(u32x2*)(p + 16) = pack4(x1); }
        }
    }
};
struct EpiKV {
    static constexpr bool PERM = true, AFTER_DRAIN = false;
    bf16_t* KF; bf16_t* V;
    __device__ __forceinline__ void operator()(const f32x4 (&acc)[2][2][4][2], const Unit& u, int wr, int wc, int fr, int fq) const {
        const int row0 = u.pm * BM + wr * 64 + fr, c0 = wc * 32 + 8 * fq;
#pragma unroll
        for (int ai = 0; ai < 2; ++ai)
#pragma unroll
            for (int m = 0; m < 4; ++m) { const size_t row = (size_t)(row0 + ai * HALF + m * 16);
#pragma unroll
                for (int bj = 0; bj < 2; ++bj) { const f32x4 v0 = acc[ai][bj][m][0], v1 = acc[ai][bj][m][1];
                    u32x4 w; w.x = cvt_pk_bf16(v0[0], v0[1]); w.y = cvt_pk_bf16(v0[2], v0[3]); w.z = cvt_pk_bf16(v1[0], v1[1]); w.w = cvt_pk_bf16(v1[2], v1[3]);
                    if (bj == 0) *(u32x4*)(KF + row * 1536 + u.pn * 192 + c0) = w; else *(u32x4*)(V + row * 1024 + u.pn * 128 + c0) = w; } }
    }
};
template <int STEP> struct EpiMerge {
    static constexpr bool PERM = true, AFTER_DRAIN = false;
    const unsigned char* G; bf16_t* YF; bf16_t* Y; int wt_pm;
    __device__ __forceinline__ void operator()(const f32x4 (&acc)[2][2][4][2], const Unit& u, int wr, int wc, int fr, int fq) const {
        constexpr int NBATCH = 4;
        const int row0 = u.pm * BM + wr * 64 + fr, col0 = u.pn * BM + wc * 32 + 8 * fq;
        bf16_t* dst = (STEP < 2) ? YF : Y;
        const bool wt = (STEP < 2) && (u.pm >= wt_pm);
#pragma unroll
        for (int ai = 0; ai < 2; ++ai)
#pragma unroll
            for (int mb = 0; mb < 4; mb += NBATCH) {
                u32x2 gw[NBATCH][2]; u32x4 yv[NBATCH][2];
#pragma unroll
                for (int q = 0; q < NBATCH; ++q) { const size_t row = (size_t)(row0 + ai * HALF + (mb + q) * 16);
#pragma unroll
                    for (int bj = 0; bj < 2; ++bj) { const int c = col0 + bj * HALF;
                        gw[q][bj] = *(const u32x2*)(G + row * 6144 + STEP * 2048 + c);
                        if (STEP > 0) yv[q][bj] = *(const u32x4*)(YF + row * 2048 + c); } }
#pragma unroll
                for (int q = 0; q < NBATCH; ++q) { const size_t row = (size_t)(row0 + ai * HALF + (mb + q) * 16); const int m = mb + q;
#pragma unroll
                    for (int bj = 0; bj < 2; ++bj) { const int c = col0 + bj * HALF; const u32x2 g2 = gw[q][bj]; constexpr float I255 = 1.0f / 255.0f;
                        const f32x4 g0 = {(float)(g2.x & 255u) * I255, (float)((g2.x >> 8) & 255u) * I255, (float)((g2.x >> 16) & 255u) * I255, (float)(g2.x >> 24) * I255};
                        const f32x4 g1 = {(float)(g2.y & 255u) * I255, (float)((g2.y >> 8) & 255u) * I255, (float)((g2.y >> 16) & 255u) * I255, (float)(g2.y >> 24) * I255};
                        f32x4 a0 = acc[ai][bj][m][0] * g0, a1 = acc[ai][bj][m][1] * g1;
                        if (STEP > 0) { const u32x4 y4 = yv[q][bj];
                            a0 += (f32x4){__uint_as_float(y4.x << 16), __uint_as_float(y4.x & 0xffff0000u), __uint_as_float(y4.y << 16), __uint_as_float(y4.y & 0xffff0000u)};
                            a1 += (f32x4){__uint_as_float(y4.z << 16), __uint_as_float(y4.z & 0xffff0000u), __uint_as_float(y4.w << 16), __uint_as_float(y4.w & 0xffff0000u)}; }
                        u32x4 w; w.x = cvt_pk_bf16(a0[0], a0[1]); w.y = cvt_pk_bf16(a0[2], a0[3]); w.z = cvt_pk_bf16(a1[0], a1[1]); w.w = cvt_pk_bf16(a1[2], a1[3]);
                        if (wt) asm volatile("global_store_dwordx4 %0, %1, off sc1" :: "v"(dst + row * 2048 + c), "v"(w) : "memory");
                        else *(u32x4*)(dst + row * 2048 + c) = w; } }
                asm volatile("" ::: "memory"); }
    }
};
struct EpiResid {
    static constexpr bool PERM = true, AFTER_DRAIN = false;
    bf16_t* XB; const float* modl; int goff;
    __device__ __forceinline__ void operator()(const f32x4 (&acc)[2][2][4][2], const Unit& u, int wr, int wc, int fr, int fq) const {
        const int sel = u.pm >> 4;
        const int col0 = u.pn * BM + wc * 32 + 8 * fq; const float* gt = modl + sel * 12288 + goff + col0;
        bf16_t* base = XB + (size_t)(u.pm * BM + wr * 64 + fr) * 2048;
        f32x4 gv[2][2];
#pragma unroll
        for (int bj = 0; bj < 2; ++bj)
#pragma unroll
            for (int n = 0; n < 2; ++n) gv[bj][n] = *(const f32x4*)(gt + bj * HALF + n * 4);
#pragma unroll
        for (int ai = 0; ai < 2; ++ai) {
            u32x4 xr[4][2];
#pragma unroll
            for (int m = 0; m < 4; ++m) { const bf16_t* rowp = base + (size_t)(ai * HALF + m * 16) * 2048 + col0;
#pragma unroll
                for (int bj = 0; bj < 2; ++bj) xr[m][bj] = *(const u32x4*)(rowp + bj * HALF); }
#pragma unroll
            for (int m = 0; m < 4; ++m) { bf16_t* rowp = base + (size_t)(ai * HALF + m * 16) * 2048 + col0;
#pragma unroll
                for (int bj = 0; bj < 2; ++bj) { const u32x4 t = xr[m][bj];
                    const f32x4 x0 = {__uint_as_float(t.x << 16), __uint_as_float(t.x & 0xffff0000u), __uint_as_float(t.y << 16), __uint_as_float(t.y & 0xffff0000u)};
                    const f32x4 x1 = {__uint_as_float(t.z << 16), __uint_as_float(t.z & 0xffff0000u), __uint_as_float(t.w << 16), __uint_as_float(t.w & 0xffff0000u)};
                    const u32x2 w0 = pack4(x0 + gv[bj][0] * acc[ai][bj][m][0]), w1 = pack4(x1 + gv[bj][1] * acc[ai][bj][m][1]);
                    u32x4 w; w.x = w0.x; w.y = w0.y; w.z = w1.x; w.w = w1.y; *(u32x4*)(rowp + bj * HALF) = w; } }
            asm volatile("" ::: "memory"); }
    }
};
struct EpiSwiGLU {
    static constexpr bool PERM = false, AFTER_DRAIN = false;
    bf16_t* HID;
    __device__ __forceinline__ void operator()(const f32x4 (&acc)[2][2][4][2], const Unit& u, int wr, int wc, int fr, int fq) const {
        const int row0 = u.pm * BM + wr * 64 + fr, c0 = u.pn * 128 + wc * 16 + 4 * fq;
#pragma unroll
        for (int ai = 0; ai < 2; ++ai)
#pragma unroll
            for (int m = 0; m < 4; ++m) { bf16_t* rowp = HID + (size_t)(row0 + ai * HALF + m * 16) * 5632 + c0;
#pragma unroll
                for (int bj = 0; bj < 2; ++bj) { const f32x4 a = acc[ai][bj][m][0], b = acc[ai][bj][m][1];
                    const f32x4 h = {a[0] * sigm(a[0]) * b[0], a[1] * sigm(a[1]) * b[1], a[2] * sigm(a[2]) * b[2], a[3] * sigm(a[3]) * b[3]};
                    *(u32x2*)(rowp + bj * 64) = pack4(h); } }
    }
};
}
namespace pg8 {
struct UnitX { int pm, pn, kind; };
template <class Epi, class Sched, bool CHAIN = false>
__device__ __forceinline__ void gemm_stream(PG8_LAS unsigned char* lds, const Sched& S, const Epi& E) {
    int tid_ = threadIdx.x; asm volatile("" : "+v"(tid_));
    const int tid = tid_, wid = __builtin_amdgcn_readfirstlane(tid >> 6), lane = tid & 63, wr = wid >> 2, wc = wid & 3, fr = lane & 15, fq = lane >> 4;
    int Rn, Rp, C2; { int R, C; stage_rc(tid * 16, R, C); Rn = R; Rp = (R & ~31) + perm32(R & 31); C2 = C * 2; }
    const size_t kstep = (size_t)(BK * 2);
    const unsigned ldsw = (unsigned)wid * 1024u;
    const int aoff = lds_byte(wr * 64 + fr, fq * 8), boff = lds_byte(wc * 32 + fr, fq * 8);
#define PG8_SA(b, h) (((b) * 2 + (h)) * HTB)
#define PG8_SB(b, h) ((4 + (b) * 2 + (h)) * HTB)
#define PG8_STAGE(bufoff, gbase, voff, r64) do { \
        __builtin_amdgcn_global_load_lds((const unsigned*)((const char*)(gbase) + (voff)), (PG8_LAS unsigned*)(lds + (bufoff) + ldsw), 16, 0, 0); \
        __builtin_amdgcn_global_load_lds((const unsigned*)((const char*)(gbase) + (r64) + (voff)), (PG8_LAS unsigned*)(lds + (bufoff) + ldsw + 8192), 16, 0, 0); } while (0)
#define PG8_LDA(dst, b, h) do { _Pragma("unroll") for (int m = 0; m < 4; ++m) _Pragma("unroll") for (int k = 0; k < 2; ++k) dst[m][k] = *(const PG8_LAS bf16x8*)(lds + PG8_SA(b, h) + aoff + m * 2048 + k * 1024); } while (0)
#define PG8_LDB(dst, b, h) do { _Pragma("unroll") for (int n = 0; n < 2; ++n) _Pragma("unroll") for (int k = 0; k < 2; ++k) dst[n][k] = *(const PG8_LAS bf16x8*)(lds + PG8_SB(b, h) + boff + n * 2048 + k * 1024); } while (0)
#define PG8_MMA(ai, bj, At, Bt) do { __builtin_amdgcn_s_setprio(1); _Pragma("unroll") for (int m = 0; m < 4; ++m) _Pragma("unroll") for (int n = 0; n < 2; ++n) _Pragma("unroll") for (int k = 0; k < 2; ++k) \
        acc[ai][bj][m][n] = __builtin_amdgcn_mfma_f32_16x16x32_bf16(Bt[n][k], At[m][k], acc[ai][bj][m][n], 0, 0, 0); __builtin_amdgcn_s_setprio(0); } while (0)
#define PG8_WAIT_V(n) asm volatile("s_waitcnt vmcnt(" #n ")" ::: "memory")
#define PG8_WAIT_L(n) asm volatile("s_waitcnt lgkmcnt(" #n ")" ::: "memory")
#define PG8_BAR __builtin_amdgcn_s_barrier()
#define PG8_SCHED __builtin_amdgcn_sched_barrier(0)
    UnitX cur, nxt; int ui = 0;
    if (!S.next(0, cur)) return;
    f32x4 acc[2][2][4][2];
#pragma unroll
    for (int a = 0; a < 2; ++a)
#pragma unroll
        for (int b = 0; b < 2; ++b)
#pragma unroll
            for (int m = 0; m < 4; ++m)
#pragma unroll
                for (int n = 0; n < 2; ++n) acc[a][b][m][n] = (f32x4){0.f, 0.f, 0.f, 0.f};
    bf16x8 At[4][2], B0[2][2], B1[2][2];
    int K2 = S.gPitch(cur.kind) * 2;
    unsigned voA = (unsigned)(Rn * K2 + C2), voB = (unsigned)((S.gPerm(cur.kind) ? Rp : Rn) * K2 + C2);
    size_t r64 = (size_t)64 * K2, hstep = (size_t)HALF * K2;
    int nt = S.gNt(cur.kind);
    const char* cA = (const char*)S.gA(cur.kind) + (size_t)cur.pm * 2 * hstep + (size_t)S.gK0(cur.kind) * 2; const char* cB = (const char*)S.gB(cur.kind) + (size_t)cur.pn * 2 * hstep + (size_t)S.gK0(cur.kind) * 2;
    PG8_STAGE(PG8_SB(0, 0), cB, voB, r64); PG8_STAGE(PG8_SB(0, 1), cB + hstep, voB, r64); PG8_STAGE(PG8_SA(0, 0), cA, voA, r64); PG8_STAGE(PG8_SA(0, 1), cA + hstep, voA, r64);
    if (wr == 1) PG8_BAR;
    PG8_WAIT_V(2); PG8_BAR;
    PG8_STAGE(PG8_SB(1, 0), cB + kstep, voB, r64); PG8_STAGE(PG8_SA(1, 0), cA + kstep, voA, r64); PG8_STAGE(PG8_SB(1, 1), cB + hstep + kstep, voB, r64);
    PG8_WAIT_V(6); PG8_BAR;
    for (;;) {
        const bool has_next = S.next(ui + 1, nxt);
        const int nkind = has_next ? nxt.kind : cur.kind;
        const int nK2 = S.gPitch(nkind) * 2;
        const unsigned nvoA = (unsigned)(Rn * nK2 + C2), nvoB = (unsigned)((S.gPerm(nkind) ? Rp : Rn) * nK2 + C2);
        const size_t nr64 = (size_t)64 * nK2, nhstep = (size_t)HALF * nK2;
        const char* nA = has_next ? (const char*)S.gA(nkind) + (size_t)nxt.pm * 2 * nhstep + (size_t)S.gK0(nkind) * 2 : cA; const char* nB = has_next ? (const char*)S.gB(nkind) + (size_t)nxt.pn * 2 * nhstep + (size_t)S.gK0(nkind) * 2 : cB;
#pragma nounroll
        for (int t = 0; t < nt; t += 2) {
            const bool last = (t == nt - 2);
            const char* a1 = cA + (size_t)(t + 1) * kstep;
            const char* a2 = last ? nA : cA + (size_t)(t + 2) * kstep; const char* b2 = last ? nB : cB + (size_t)(t + 2) * kstep;
            const char* a3 = a2 + kstep; const char* b3 = b2 + kstep;
            const unsigned vA2 = last ? nvoA : voA, vB2 = last ? nvoB : voB; const size_t r2 = last ? nr64 : r64, h2 = last ? nhstep : hstep;
            PG8_LDB(B0, 0, 0); PG8_LDB(B1, 0, 1); PG8_SCHED; PG8_LDA(At, 0, 0); PG8_STAGE(PG8_SA(1, 1), a1 + hstep, voA, r64);
            PG8_WAIT_V(8); PG8_WAIT_L(0); PG8_BAR; PG8_MMA(0, 0, At, B0); PG8_MMA(0, 1, At, B1); PG8_BAR; PG8_SCHED;
            PG8_LDA(At, 0, 1); PG8_STAGE(PG8_SB(0, 0), b2, vB2, r2); PG8_STAGE(PG8_SB(0, 1), b2 + h2, vB2, r2); PG8_STAGE(PG8_SA(0, 0), a2, vA2, r2);
            PG8_WAIT_V(8); PG8_WAIT_L(0); PG8_BAR; PG8_MMA(1, 0, At, B0); PG8_MMA(1, 1, At, B1); PG8_BAR; PG8_SCHED;
            PG8_LDB(B0, 1, 0); PG8_LDB(B1, 1, 1); PG8_SCHED; PG8_LDA(At, 1, 0); PG8_STAGE(PG8_SA(0, 1), a2 + h2, vA2, r2);
            PG8_WAIT_V(8); PG8_WAIT_L(0); PG8_BAR; PG8_MMA(0, 0, At, B0); PG8_MMA(0, 1, At, B1); PG8_BAR; PG8_SCHED;
            PG8_LDA(At, 1, 1); PG8_STAGE(PG8_SB(1, 0), b3, vB2, r2); PG8_STAGE(PG8_SB(1, 1), b3 + h2, vB2, r2); PG8_STAGE(PG8_SA(1, 0), a3, vA2, r2);
            PG8_WAIT_V(8); PG8_WAIT_L(0); PG8_BAR; PG8_MMA(1, 0, At, B0); PG8_MMA(1, 1, At, B1); PG8_BAR; PG8_SCHED;
        }
        if (wr == 0) PG8_BAR;
        if constexpr (CHAIN) E.chain(acc, cur.pm, cur.pn, cur.kind, wr, wc, fr, fq); else E(acc, cur.pm, cur.pn, cur.kind, wr, wc, fr, fq);
        if (!has_next) break;
        bool clr_ = true; if constexpr (CHAIN) clr_ = (cur.kind == Epi::LAST_KIND);
        if (clr_)
#pragma unroll
        for (int a = 0; a < 2; ++a)
#pragma unroll
            for (int b = 0; b < 2; ++b)
#pragma unroll
                for (int m = 0; m < 4; ++m)
#pragma unroll
                    for (int n = 0; n < 2; ++n) acc[a][b][m][n] = (f32x4){0.f, 0.f, 0.f, 0.f};
        cur.pm = nxt.pm; cur.pn = nxt.pn; cur.kind = nxt.kind; cA = nA; cB = nB; K2 = nK2; voA = nvoA; voB = nvoB; r64 = nr64; hstep = nhstep; nt = S.gNt(nkind); ++ui;
        if (wr == 1) PG8_BAR;
    }
    PG8_WAIT_V(0);
    PG8_BAR;
#undef PG8_SA
#undef PG8_SB
#undef PG8_STAGE
#undef PG8_LDA
#undef PG8_LDB
#undef PG8_MMA
#undef PG8_WAIT_V
#undef PG8_WAIT_L
#undef PG8_BAR
#undef PG8_SCHED
}
struct SchedMerge {
    StaticOrder base; const char* a0; long da1, da2; const char* b0; long db1, db2;
    __device__ __forceinline__ bool next(int i, UnitX& u) const { Unit b; const int q = i / 3; const bool ok = base.next(q, b); u.pm = b.pm; u.pn = b.pn; u.kind = i - 3 * q; return ok; }
    __device__ __forceinline__ const bf16_t* gA(int k) const { return (const bf16_t*)(a0 + (k > 0 ? da1 : 0l) + (k > 1 ? da2 : 0l)); }
    __device__ __forceinline__ const bf16_t* gB(int k) const { return (const bf16_t*)(b0 + (k > 0 ? db1 : 0l) + (k > 1 ? db2 : 0l)); }
    __device__ __forceinline__ int gPitch(int k) const { return k == 1 ? 1024 : 512; }
    __device__ __forceinline__ int gNt(int k) const { return k == 1 ? 16 : 8; }
    __device__ __forceinline__ int gK0(int) const { return 0; }
    __device__ __forceinline__ int gPerm(int) const { return 1; }
};
struct EpiMergeAll {
    EpiMerge<0> e0; EpiMerge<1> e1; EpiMerge<2> e2;
    __device__ __forceinline__ void operator()(const f32x4 (&acc)[2][2][4][2], int pm, int pn, int kind, int wr, int wc, int fr, int fq) const {
        Unit u; u.pm = pm; u.pn = pn;
        if (kind == 0) e0(acc, u, wr, wc, fr, fq); else if (kind == 1) e1(acc, u, wr, wc, fr, fq); else e2(acc, u, wr, wc, fr, fq);
    }
};
struct EpiChain {
    static constexpr int LAST_KIND = 2;
    const unsigned char* G; bf16_t* Y;
    __device__ __forceinline__ void chain(f32x4 (&acc)[2][2][4][2], int pm, int pn, int kind, int wr, int wc, int fr, int fq) const {
        const int row0 = pm * BM + wr * 64 + fr, col0 = pn * BM + wc * 32 + 8 * fq;
        const unsigned char* ga = G + (kind == 2 ? 2 : kind) * 2048; const unsigned char* gb = G + (kind == 0 ? 1 : 2) * 2048;
#pragma unroll
        for (int ai = 0; ai < 2; ++ai) {
            u32x2 qa[4][2], qb[4][2];
#pragma unroll
            for (int m = 0; m < 4; ++m) { const size_t row = (size_t)(row0 + ai * HALF + m * 16);
#pragma unroll
                for (int bj = 0; bj < 2; ++bj) { const int c = col0 + bj * HALF; qa[m][bj] = *(const u32x2*)(ga + row * 6144 + c); qb[m][bj] = *(const u32x2*)(gb + row * 6144 + c); } }
#pragma unroll
            for (int m = 0; m < 4; ++m) { const size_t row = (size_t)(row0 + ai * HALF + m * 16);
#pragma unroll
                for (int bj = 0; bj < 2; ++bj) { const int c = col0 + bj * HALF;
                    f32x4 r[2];
#pragma unroll
                    for (int n = 0; n < 2; ++n) { const unsigned wa = n == 0 ? qa[m][bj].x : qa[m][bj].y, wb = n == 0 ? qb[m][bj].x : qb[m][bj].y;
#pragma unroll
                        for (int e = 0; e < 4; ++e) { const unsigned a8 = (wa >> (8 * e)) & 255u, b8 = (wb >> (8 * e)) & 255u;
                            const float fa = (float)(kind == 0 ? a8 : (a8 > 1u ? a8 : 1u)), fb = (float)(b8 > 1u ? b8 : 1u);
                            r[n][e] = (kind == 2) ? fa * (1.0f / 255.0f) : fa * __builtin_amdgcn_rcpf(fb); } }
                    acc[ai][bj][m][0] *= r[0]; acc[ai][bj][m][1] *= r[1];
                    if (kind == 2) { const f32x4 a0 = acc[ai][bj][m][0], a1 = acc[ai][bj][m][1];
                        u32x4 w; w.x = cvt_pk_bf16(a0[0], a0[1]); w.y = cvt_pk_bf16(a0[2], a0[3]); w.z = cvt_pk_bf16(a1[0], a1[1]); w.w = cvt_pk_bf16(a1[2], a1[3]);
                        *(u32x4*)(Y + row * 2048 + c) = w; } } }
            asm volatile("" ::: "memory"); }
    }
};
struct SchedQKV {
    int nMq, nNq, nMk, nNk, G, c; const bf16_t* Aq; const bf16_t* Bq; const bf16_t* Ak; const bf16_t* Bk;
    __device__ __forceinline__ bool next(int i, UnitX& u) const {
        const int L = i * G + c, nq = nMq * nNq;
        Unit b; b.pm = 0; b.pn = 0; bool ok = true; int kind = 0;
        if (L < nq) StaticOrder::map_entry(nMq, nNq, L, b);
        else { const int L2 = L - nq; kind = 1; ok = L2 < nMk * nNk; if (ok) StaticOrder::map_entry(nMk, nNk, L2, b); }
        u.pm = b.pm; u.pn = b.pn; u.kind = kind; return ok;
    }
    __device__ __forceinline__ const bf16_t* gA(int k) const { return k == 0 ? Aq : Ak; }
    __device__ __forceinline__ const bf16_t* gB(int k) const { return k == 0 ? Bq : Bk; }
    __device__ __forceinline__ int gPitch(int k) const { return k == 0 ? 512 : 256; }
    __device__ __forceinline__ int gNt(int k) const { return k == 0 ? 8 : 4; }
    __device__ __forceinline__ int gK0(int) const { return 0; }
    __device__ __forceinline__ int gPerm(int k) const { return k; }
};
struct EpiQKV {
    EpiQup eq; EpiKV ek;
    __device__ __forceinline__ void operator()(const f32x4 (&acc)[2][2][4][2], int pm, int pn, int kind, int wr, int wc, int fr, int fq) const {
        Unit u; u.pm = pm; u.pn = pn;
        if (kind == 0) eq(acc, u, wr, wc, fr, fq); else ek(acc, u, wr, wc, fr, fq);
    }
};
struct SchedSplit {
    const bf16_t* A; const bf16_t* Bt; int K, nlat, nctx, G, c, wgm;
    __device__ __forceinline__ bool next(int i, UnitX& u) const {
        const int L = i * G + c; Unit b; b.pm = 0; b.pn = 0; int kind = 0; bool ok = true;
        if (L < nlat) StaticOrder::map_entry(ML_ROWS / BM, 8, L, b, wgm);
        else { const int e = L - nlat; ok = e < nctx; b.pm = ML_ROWS / BM + (e >> 5); b.pn = (e >> 2) & 7; kind = 1 + (e & 3); }
        u.pm = b.pm; u.pn = b.pn; u.kind = kind; return ok;
    }
    __device__ __forceinline__ const bf16_t* gA(int) const { return A; }
    __device__ __forceinline__ const bf16_t* gB(int) const { return Bt; }
    __device__ __forceinline__ int gPitch(int) const { return K; }
    __device__ __forceinline__ int gNt(int k) const { return k == 0 ? K / BK : K / (4 * BK); }
    __device__ __forceinline__ int gK0(int k) const { return k == 0 ? 0 : (k - 1) * (K / 4); }
    __device__ __forceinline__ int gPerm(int) const { return 1; }
};
struct EpiSplit {
    EpiResid er; bf16_t* PART;
    __device__ __forceinline__ void operator()(const f32x4 (&acc)[2][2][4][2], int pm, int pn, int kind, int wr, int wc, int fr, int fq) const {
        Unit u; u.pm = pm; u.pn = pn;
        if (kind == 0) { er(acc, u, wr, wc, fr, fq); return; }
        bf16_t* base = PART + ((size_t)(kind - 1) * 2048 + (size_t)(pm * BM - ML_ROWS + wr * 64 + fr)) * 2048 + pn * BM + wc * 32 + 8 * fq;
#pragma unroll
        for (int ai = 0; ai < 2; ++ai)
#pragma unroll
            for (int m = 0; m < 4; ++m) { bf16_t* rowp = base + (size_t)(ai * HALF + m * 16) * 2048;
#pragma unroll
                for (int bj = 0; bj < 2; ++bj) { const u32x2 w0 = pack4(acc[ai][bj][m][0]), w1 = pack4(acc[ai][bj][m][1]); u32x4 w; w.x = w0.x; w.y = w0.y; w.z = w1.x; w.w = w1.y; *(u32x4*)(rowp + bj * HALF) = w; } }
    }
};
}
#define XB_TMO      128
#define XB_XCNT(j)  (256  + 64 * (j))
#define XB_XSUB(j)  (1280 + 64 * (j))
#define XB_XGEN(j)  (2304 + 64 * (j))
#define XB_TOP      3328
#define XB_TOPGEN   3392
#define XCD_BAR_WORDS 3456
#define XB_SPIN_CAP (1u << 18)

__device__ __forceinline__ unsigned xb_ld(unsigned* p)              { return __hip_atomic_load(p, __ATOMIC_RELAXED, __HIP_MEMORY_SCOPE_AGENT); }
__device__ __forceinline__ unsigned xb_add(unsigned* p, unsigned v) { return __hip_atomic_fetch_add(p, v, __ATOMIC_RELAXED, __HIP_MEMORY_SCOPE_AGENT); }
__device__ __forceinline__ unsigned xb_xcc_id() { return (unsigned)__builtin_amdgcn_s_getreg((3 << 11) | 20) & 0xFu; }
#define XB_SPIN(cond, bar) do { unsigned _sp = 0; while (cond) { __builtin_amdgcn_s_sleep(1); \
    if ((++_sp & 255u) == 0u) { if (xb_ld(&(bar)[XB_TMO])) break; if (_sp > XB_SPIN_CAP) { atomicAdd(&(bar)[XB_TMO], 1u); break; } } } } while (0)

struct XcdBarrier {
    unsigned* bar; unsigned x;
    volatile LAS unsigned* st;
};

__device__ __forceinline__ XcdBarrier xcd_barrier_post(unsigned* bar, volatile LAS unsigned* st) {
    XcdBarrier b; b.bar = bar; b.x = xb_xcc_id(); b.st = st;
    if (threadIdx.x == 0) (void)xb_add(&bar[XB_XCNT(b.x)], 1u);
    return b;
}
__device__ __forceinline__ void xcd_barrier_complete(unsigned* bar, unsigned x, unsigned& nloc, unsigned& nx) {
    const unsigned G = gridDim.x * gridDim.y * gridDim.z;
    unsigned sum, cnt, mine, sp = 0u;
    for (;;) {
        sum = 0u; cnt = 0u; mine = 0u;
#pragma unroll
        for (unsigned j = 0; j < 16; ++j) { const unsigned c = xb_ld(&bar[XB_XCNT(j)]); sum += c; cnt += (c > 0u) ? 1u : 0u; mine = (j == x) ? c : mine; }
        if (sum == G) break;
        __builtin_amdgcn_s_sleep(1);
        if ((++sp & 255u) == 0u) { if (xb_ld(&bar[XB_TMO])) break; if (sp > XB_SPIN_CAP) { atomicAdd(&bar[XB_TMO], 1u); break; } }
    }
    nloc = mine > 0u ? mine : 1u; nx = cnt > 0u ? cnt : 1u;
}

__device__ __forceinline__ void xcd_barrier(const XcdBarrier& b) {
    asm volatile("s_waitcnt vmcnt(0)" ::: "memory");
    __syncthreads();
    if (threadIdx.x == 0) {
        unsigned* bar = b.bar;
        __builtin_amdgcn_s_waitcnt(0);
        unsigned nloc = b.st[0], nx = b.st[1];
        if (nloc == 0u) { xcd_barrier_complete(bar, b.x, nloc, nx); b.st[0] = nloc; b.st[1] = nx; }
        const unsigned old = xb_add(&bar[XB_XSUB(b.x)], 1u);
        const unsigned gen = old / nloc;
        if (old + 1u == (gen + 1u) * nloc) {
            __builtin_amdgcn_fence(__ATOMIC_RELEASE, "agent");
            asm volatile("s_waitcnt vmcnt(0)" ::: "memory");
            const unsigned og = xb_add(&bar[XB_TOP], 1u);
            const unsigned tg = og / nx;
            if (og + 1u == (tg + 1u) * nx) xb_add(&bar[XB_TOPGEN], 1u);
            else XB_SPIN(xb_ld(&bar[XB_TOPGEN]) == tg, bar);
            __builtin_amdgcn_fence(__ATOMIC_ACQUIRE, "agent");
            xb_add(&bar[XB_XGEN(b.x)], 1u);
            asm volatile("s_waitcnt vmcnt(0)" ::: "memory");
        } else {
            XB_SPIN(xb_ld(&bar[XB_XGEN(b.x)]) == gen, bar);
            __builtin_amdgcn_fence(__ATOMIC_ACQUIRE, "agent");
            asm volatile("s_waitcnt vmcnt(0)" ::: "memory");
        }
    }
    __syncthreads();
}
#ifndef ATT_ILV
#define ATT_ILV 1
#endif
#ifndef ATT_DMAW
#define ATT_DMAW 4
#endif
#ifndef ATT_YOUNG_FROM
#define ATT_YOUNG_FROM (ATT_ILV ? 512 : 256)
#endif
namespace att {
typedef unsigned short bf16_t;
using bf16x8 = __attribute__((ext_vector_type(8))) short;
using s16x4  = __attribute__((ext_vector_type(4))) short;
using f32x16 = __attribute__((ext_vector_type(16))) float;
using u32x4  = __attribute__((ext_vector_type(4))) unsigned;
typedef LAS char lchar;
#define ASBAR() __builtin_amdgcn_sched_barrier(0)
__device__ __forceinline__ int crow(int r, int hi) { return (r & 3) + 8 * (r >> 2) + 4 * hi; }
__device__ __forceinline__ unsigned cvtpk(float lo, float hi) { return pg8::cvt_pk_bf16(lo, hi); }
template <int DK> __device__ __forceinline__ int koff(int row, int chunk) {
    return row * (DK * 2) + ((chunk & ~7) << 4) + (((chunk & 7) ^ ((row >> 1) & 7)) << 4);
}
template <int DV> __device__ __forceinline__ int v_st(int k, int c) { constexpr int NCB = DV / 32; const int kk = (k & ~0xC) | ((k & 4) << 1) | ((k & 8) >> 1); return ((kk >> 3) * NCB + (c >> 5)) * 512 + ((kk & 7) * 32 + (c & 31)) * 2; }
__device__ __forceinline__ int v_rd_base(int lane) { return ((lane & 3) << 3) | (((lane >> 2) & 3) << 6) | (((lane >> 4) & 1) << 5) | (((lane >> 5) & 1) << 8); }
template <int DV> constexpr int v_rd_off(int d0, int ks, int half) { return d0 * 512 + ks * (2 * (DV / 32) * 512) + half * ((DV / 32) * 512); }
#if ATT_ILV
template <int OFF> __device__ __forceinline__ s16x4 tr_read(int vb) { return __builtin_amdgcn_ds_read_tr16_b64_v4i16((LAS s16x4*)(unsigned)(vb + OFF)); }
#else
template <int OFF> __device__ __forceinline__ s16x4 tr_read(int vb) { s16x4 r; asm volatile("ds_read_b64_tr_b16 %0, %1 offset:%2" : "=&v"(r) : "v"(vb), "i"(OFF) : "memory"); return r; }
#endif

__device__ __forceinline__ void glds16(const void* gsrc, unsigned lds_dst) { unsigned keep; lds_dst = __builtin_amdgcn_readfirstlane(lds_dst);
    asm volatile("s_mov_b32 %0, m0\n\ts_mov_b32 m0, %2\n\ts_nop 0\n\tglobal_load_lds_dwordx4 %1, off\n\ts_mov_b32 m0, %0" : "=&s"(keep) : "v"(gsrc), "s"(lds_dst) : "memory"); }
__device__ __forceinline__ void glds16s(const void* sbase, unsigned voff, unsigned lds_dst) { unsigned keep; lds_dst = __builtin_amdgcn_readfirstlane(lds_dst);
    const unsigned long long b = (unsigned long long)sbase; const unsigned blo = __builtin_amdgcn_readfirstlane((unsigned)b), bhi = __builtin_amdgcn_readfirstlane((unsigned)(b >> 32));
    const unsigned long long sb = ((unsigned long long)bhi << 32) | blo;
    asm volatile("s_mov_b32 %0, m0\n\ts_mov_b32 m0, %3\n\ts_nop 0\n\tglobal_load_lds_dwordx4 %1, %2\n\ts_mov_b32 m0, %0" : "=&s"(keep) : "v"(voff), "s"(sb), "s"(lds_dst) : "memory"); }
template <bool WIN>
__device__ __forceinline__ void partialSM(f32x16& p0, f32x16& p1, float& m_reg, float& mn, float& alpha, const float C, const float thr, const bool domask, const int dq, const int hi) {
#if ATT_ILV
    if constexpr (WIN) { const int dqq = domask ? dq : 0;
#pragma unroll
        for (int r = 0; r < 16; ++r) { const int d0 = dqq + crow(r, hi), d1 = d0 + 32; p0[r] = (d0 > 128 || d0 < -128) ? -1e30f : p0[r]; p1[r] = (d1 > 128 || d1 < -128) ? -1e30f : p1[r]; } }
#else
    if constexpr (WIN) { if (domask) {
#pragma unroll
        for (int r = 0; r < 16; ++r) { const int d0 = dq + crow(r, hi), d1 = d0 + 32; if (d0 > 128 || d0 < -128) p0[r] = -1e30f; if (d1 > 128 || d1 < -128) p1[r] = -1e30f; } } }
#endif
    float pmax = p0[0];
#pragma unroll
    for (int r = 1; r < 16; ++r) pmax = fmaxf(pmax, p0[r]);
#pragma unroll
    for (int r = 0; r < 16; ++r) pmax = fmaxf(pmax, p1[r]);
    { auto rr = __builtin_amdgcn_permlane32_swap(__float_as_uint(pmax), __float_as_uint(pmax), false, false); pmax = fmaxf(__uint_as_float(rr[0]), __uint_as_float(rr[1])); }
#if ATT_ILV
    { const bool keep = __all(pmax - m_reg <= thr); mn = fmaxf(m_reg, keep ? m_reg : pmax); alpha = __builtin_amdgcn_exp2f((m_reg - mn) * C); m_reg = mn; }
#else
    if (__builtin_expect(__all(pmax - m_reg <= thr), 1)) { mn = m_reg; alpha = 1.f; }
    else { mn = fmaxf(m_reg, pmax); alpha = __builtin_amdgcn_exp2f((m_reg - mn) * C); m_reg = mn; }
#endif
    const float mnC = -mn * C;
#pragma unroll
    for (int r = 0; r < 16; ++r) p0[r] = fmaf(p0[r], C, mnC);
#pragma unroll
    for (int r = 0; r < 16; ++r) p1[r] = fmaf(p1[r], C, mnC);
#pragma unroll
    for (int r = 0; r < 16; ++r) p0[r] = __builtin_amdgcn_exp2f(p0[r]);
}
__device__ __forceinline__ void finishSM(f32x16& p0, f32x16& p1, float alpha, float& l_reg, bf16x8& pa0, bf16x8& pa1, bf16x8& pa2, bf16x8& pa3) {
#pragma unroll
    for (int r = 0; r < 16; ++r) p1[r] = __builtin_amdgcn_exp2f(p1[r]);
    float ps = 0;
#pragma unroll
    for (int r = 0; r < 16; ++r) ps += p0[r];
#pragma unroll
    for (int r = 0; r < 16; ++r) ps += p1[r];
    { auto rr = __builtin_amdgcn_permlane32_swap(__float_as_uint(ps), __float_as_uint(ps), false, false); ps = __uint_as_float(rr[0]) + __uint_as_float(rr[1]); }
    l_reg = l_reg * alpha + ps;
#define ATT_PK4(P, BASE, OUT) do { unsigned a0 = cvtpk(P[BASE + 0], P[BASE + 1]), a1 = cvtpk(P[BASE + 2], P[BASE + 3]);   \
    unsigned b0 = cvtpk(P[BASE + 4], P[BASE + 5]), b1 = cvtpk(P[BASE + 6], P[BASE + 7]);                              \
    auto r0 = __builtin_amdgcn_permlane32_swap(a0, b0, false, false); auto r1 = __builtin_amdgcn_permlane32_swap(a1, b1, false, false); \
    u32x4 w = {r0[0], r1[0], r0[1], r1[1]}; OUT = *reinterpret_cast<bf16x8*>(&w); } while (0)
    ATT_PK4(p0, 0, pa0); ATT_PK4(p0, 8, pa1); ATT_PK4(p1, 0, pa2); ATT_PK4(p1, 8, pa3);
#undef ATT_PK4
}
template <int DK> __device__ __forceinline__ void qkt(f32x16& p0, f32x16& p1, const lchar* Ks, const bf16x8 (&qr)[DK / 16], const int (&kq)[4]) {
    p0 = f32x16{}; p1 = f32x16{};
    bf16x8 c0 = *(const LAS bf16x8*)(Ks + kq[0]), c1 = *(const LAS bf16x8*)(Ks + kq[0] + 32 * DK * 2);
#pragma unroll
    for (int d0 = 0; d0 < DK / 16; ++d0) {
        bf16x8 n0 = c0, n1 = c1;
        if (d0 + 1 < DK / 16) { n0 = *(const LAS bf16x8*)(Ks + kq[(d0 + 1) & 3] + ((d0 + 1) >> 2) * 128); n1 = *(const LAS bf16x8*)(Ks + kq[(d0 + 1) & 3] + ((d0 + 1) >> 2) * 128 + 32 * DK * 2); }
        p0 = __builtin_amdgcn_mfma_f32_32x32x16_bf16(c0, qr[d0], p0, 0, 0, 0);
        p1 = __builtin_amdgcn_mfma_f32_32x32x16_bf16(c1, qr[d0], p1, 0, 0, 0);
        c0 = n0; c1 = n1; }
}
struct VFrag { s16x4 l0, h0, l1, h1, l2, h2, l3, h3; };
template <int DV, int D0> __device__ __forceinline__ void pv_reads(VFrag& f, int vb) {
    f.l0 = tr_read<v_rd_off<DV>(D0, 0, 0)>(vb); f.h0 = tr_read<v_rd_off<DV>(D0, 0, 1)>(vb); f.l1 = tr_read<v_rd_off<DV>(D0, 1, 0)>(vb); f.h1 = tr_read<v_rd_off<DV>(D0, 1, 1)>(vb);
    f.l2 = tr_read<v_rd_off<DV>(D0, 2, 0)>(vb); f.h2 = tr_read<v_rd_off<DV>(D0, 2, 1)>(vb); f.l3 = tr_read<v_rd_off<DV>(D0, 3, 0)>(vb); f.h3 = tr_read<v_rd_off<DV>(D0, 3, 1)>(vb);
}
__device__ __forceinline__ void pv_mma(f32x16& od, const VFrag& f, bf16x8 pa0, bf16x8 pa1, bf16x8 pa2, bf16x8 pa3) {
#define ATT_PK(L, H) (bf16x8){L[0], L[1], L[2], L[3], H[0], H[1], H[2], H[3]}
    od = __builtin_amdgcn_mfma_f32_32x32x16_bf16(pa0, ATT_PK(f.l0, f.h0), od, 0, 0, 0);
    od = __builtin_amdgcn_mfma_f32_32x32x16_bf16(pa1, ATT_PK(f.l1, f.h1), od, 0, 0, 0);
    od = __builtin_amdgcn_mfma_f32_32x32x16_bf16(pa2, ATT_PK(f.l2, f.h2), od, 0, 0, 0);
    od = __builtin_amdgcn_mfma_f32_32x32x16_bf16(pa3, ATT_PK(f.l3, f.h3), od, 0, 0, 0);
#undef ATT_PK
}
#define ATT_LWAIT(n) do { asm volatile("s_waitcnt lgkmcnt(" #n ")" ::: "memory"); ASBAR(); } while (0)
#if ATT_ILV
template <int DV> __device__ __forceinline__ void pv_all(f32x16 (&o)[DV / 32], int vb, bf16x8 pa0, bf16x8 pa1, bf16x8 pa2, bf16x8 pa3) {
    { VFrag f; pv_reads<DV, 0>(f, vb); pv_mma(o[0], f, pa0, pa1, pa2, pa3); }
    { VFrag f; pv_reads<DV, 1>(f, vb); pv_mma(o[1], f, pa0, pa1, pa2, pa3); }
    if constexpr (DV == 128) {
        { VFrag f; pv_reads<DV, 2>(f, vb); pv_mma(o[2], f, pa0, pa1, pa2, pa3); }
        { VFrag f; pv_reads<DV, 3>(f, vb); pv_mma(o[3], f, pa0, pa1, pa2, pa3); } }
}
#define ATT_SWAP(A, B) __builtin_amdgcn_permlane32_swap((A), (B), false, false)
#define ATT_PIN(X) asm volatile("" : "+v"(X))
template <int PT, int B> __device__ __forceinline__ void pk_step(const f32x16& P, unsigned& a0, unsigned& a1, unsigned& b0, unsigned& b1, unsigned& x0, unsigned& y0, bf16x8& OUT) {
    if constexpr (PT == 0) { a0 = cvtpk(P[B + 0], P[B + 1]); b0 = cvtpk(P[B + 4], P[B + 5]); }
    if constexpr (PT == 1) { a1 = cvtpk(P[B + 2], P[B + 3]); b1 = cvtpk(P[B + 6], P[B + 7]); }
    if constexpr (PT == 2) { auto r0 = ATT_SWAP(a0, b0); x0 = r0[0]; y0 = r0[1]; }
    if constexpr (PT == 3) { auto r1 = ATT_SWAP(a1, b1); u32x4 w = {x0, r1[0], y0, r1[1]}; OUT = *reinterpret_cast<bf16x8*>(&w); }
}
template <int K> __device__ __forceinline__ void fin_atom(f32x16& q0, f32x16& q1, float alpha, float& l_reg, float& ps0, float& ps1, unsigned& a0, unsigned& a1, unsigned& b0, unsigned& b1, unsigned& x0, unsigned& y0,
                                                          bf16x8& pa0, bf16x8& pa1, bf16x8& pa2, bf16x8& pa3) {
    if constexpr (K < 16) { q1[K] = __builtin_amdgcn_exp2f(q1[K]); ATT_PIN(q1[K]); ps0 += q0[K]; ATT_PIN(ps0); }
    if constexpr (K >= 8) { ps1 += q1[K - 8]; ATT_PIN(ps1); }
    if constexpr (K < 4) pk_step<K & 3, 0>(q0, a0, a1, b0, b1, x0, y0, pa0);
    else if constexpr (K < 8) pk_step<K & 3, 8>(q0, a0, a1, b0, b1, x0, y0, pa1);
    else if constexpr (K >= 16 && K < 20) pk_step<K & 3, 0>(q1, a0, a1, b0, b1, x0, y0, pa2);
    else if constexpr (K >= 20) pk_step<K & 3, 8>(q1, a0, a1, b0, b1, x0, y0, pa3);
    if constexpr (K == 23) { float ps = ps0 + ps1; auto rr = ATT_SWAP(__float_as_uint(ps), __float_as_uint(ps)); ps = __uint_as_float(rr[0]) + __uint_as_float(rr[1]); l_reg = l_reg * alpha + ps; }
}
template <int I, int NM, int DK> __device__ __forceinline__ void qk_step(f32x16& p0, f32x16& p1, const lchar* Ks, const bf16x8 (&qr)[DK / 16], const int (&kq)[4], bf16x8 (&F)[4],
        f32x16& q0, f32x16& q1, float alpha, float& l_reg, float& ps0, float& ps1, unsigned& a0, unsigned& a1, unsigned& b0, unsigned& b1, unsigned& x0, unsigned& y0, bf16x8& pa0, bf16x8& pa1, bf16x8& pa2, bf16x8& pa3) {
    constexpr int d0 = I >> 1, APG = 24 / NM;
    if constexpr (I == 0) p0 = __builtin_amdgcn_mfma_f32_32x32x16_bf16(F[0], qr[0], f32x16{}, 0, 0, 0);
    else if constexpr (I == 1) p1 = __builtin_amdgcn_mfma_f32_32x32x16_bf16(F[1], qr[0], f32x16{}, 0, 0, 0);
    else if constexpr ((I & 1) == 0) p0 = __builtin_amdgcn_mfma_f32_32x32x16_bf16(F[I & 3], qr[d0], p0, 0, 0, 0);
    else p1 = __builtin_amdgcn_mfma_f32_32x32x16_bf16(F[I & 3], qr[d0], p1, 0, 0, 0);
    if constexpr (I + 4 < NM) { constexpr int J = I + 4, e0 = J >> 1; F[I & 3] = *(const LAS bf16x8*)(Ks + kq[e0 & 3] + (e0 >> 2) * 128 + (J & 1) * (32 * DK * 2)); }
    fin_atom<APG * I>(q0, q1, alpha, l_reg, ps0, ps1, a0, a1, b0, b1, x0, y0, pa0, pa1, pa2, pa3);
    if constexpr (APG >= 2) fin_atom<APG * I + 1>(q0, q1, alpha, l_reg, ps0, ps1, a0, a1, b0, b1, x0, y0, pa0, pa1, pa2, pa3);
    if constexpr (APG >= 3) fin_atom<APG * I + 2>(q0, q1, alpha, l_reg, ps0, ps1, a0, a1, b0, b1, x0, y0, pa0, pa1, pa2, pa3);
    ASBAR();
    if constexpr (I + 1 < NM) qk_step<I + 1, NM, DK>(p0, p1, Ks, qr, kq, F, q0, q1, alpha, l_reg, ps0, ps1, a0, a1, b0, b1, x0, y0, pa0, pa1, pa2, pa3);
}
template <int DK> __device__ __forceinline__ void qkt_fin(f32x16& p0, f32x16& p1, const lchar* Ks, const bf16x8 (&qr)[DK / 16], const int (&kq)[4],
        f32x16& q0, f32x16& q1, float alpha, float& l_reg, bf16x8& pa0, bf16x8& pa1, bf16x8& pa2, bf16x8& pa3) {
    constexpr int NM = DK / 8;
    bf16x8 F[4];
#pragma unroll
    for (int i = 0; i < 4; ++i) F[i] = *(const LAS bf16x8*)(Ks + kq[(i >> 1) & 3] + ((i >> 1) >> 2) * 128 + (i & 1) * (32 * DK * 2));
    float ps0 = 0.f, ps1 = 0.f; unsigned a0 = 0, a1 = 0, b0 = 0, b1 = 0, x0 = 0, y0 = 0;
    ASBAR();
    qk_step<0, NM, DK>(p0, p1, Ks, qr, kq, F, q0, q1, alpha, l_reg, ps0, ps1, a0, a1, b0, b1, x0, y0, pa0, pa1, pa2, pa3);
}
template <int K, bool WIN> __device__ __forceinline__ void par_atom(f32x16& p0, f32x16& p1, float& m_reg, float& mn, float& alpha, const float C, const float thr, const int dqq, const int hi,
                                                                    float& pm0, float& pm1, float& pm2, float& pm3, float& mnC) {
    if constexpr (K < 4) { f32x16& P = (K < 2) ? p0 : p1; constexpr int B = (K & 1) * 8;
        if constexpr (WIN) {
#pragma unroll
            for (int r = B; r < B + 8; ++r) { const int d = dqq + crow(r, hi) + (K < 2 ? 0 : 32); P[r] = (d > 128 || d < -128) ? -1e30f : P[r]; } }
        const float m = fmaxf(fmaxf(fmaxf(P[B], P[B + 1]), fmaxf(P[B + 2], P[B + 3])), fmaxf(fmaxf(P[B + 4], P[B + 5]), fmaxf(P[B + 6], P[B + 7])));
        if constexpr (K == 0) pm0 = m; else if constexpr (K == 1) pm1 = m; else if constexpr (K == 2) pm2 = m; else pm3 = m; }
    if constexpr (K == 4) { float pmax = fmaxf(fmaxf(pm0, pm1), fmaxf(pm2, pm3));
        auto rr = ATT_SWAP(__float_as_uint(pmax), __float_as_uint(pmax)); pmax = fmaxf(__uint_as_float(rr[0]), __uint_as_float(rr[1]));
        const bool keep = __all(pmax - m_reg <= thr); mn = fmaxf(m_reg, keep ? m_reg : pmax); alpha = __builtin_amdgcn_exp2f((m_reg - mn) * C); m_reg = mn; mnC = -mn * C; }
    if constexpr (K >= 5 && K <= 8) { f32x16& P = (K < 7) ? p0 : p1; constexpr int B = ((K - 5) & 1) * 8;
#pragma unroll
        for (int r = B; r < B + 8; ++r) { P[r] = fmaf(P[r], C, mnC); ATT_PIN(P[r]); } }
    if constexpr (K >= 8) { p0[2 * (K - 8)] = __builtin_amdgcn_exp2f(p0[2 * (K - 8)]); p0[2 * (K - 8) + 1] = __builtin_amdgcn_exp2f(p0[2 * (K - 8) + 1]); ATT_PIN(p0[2 * (K - 8)]); ATT_PIN(p0[2 * (K - 8) + 1]); }
}
template <int I, int NM, int DV, bool WIN> __device__ __forceinline__ void pv_step(f32x16 (&o)[DV / 32], const int vb, const bf16x8 (&pa)[4], s16x4 (&L)[4], s16x4 (&H)[4],
        f32x16& p0, f32x16& p1, float& m_reg, float& mn, float& alpha, const float C, const float thr, const int dqq, const int hi, float& pm0, float& pm1, float& pm2, float& pm3, float& mnC) {
    constexpr int b = I >> 2, k = I & 3, APG = 16 / NM;
    { const s16x4 l = L[k], h = H[k]; o[b] = __builtin_amdgcn_mfma_f32_32x32x16_bf16(pa[k], (bf16x8){l[0], l[1], l[2], l[3], h[0], h[1], h[2], h[3]}, o[b], 0, 0, 0); }
    if constexpr (b + 1 < DV / 32) { L[k] = tr_read<v_rd_off<DV>(b + 1, k, 0)>(vb); H[k] = tr_read<v_rd_off<DV>(b + 1, k, 1)>(vb); }
    par_atom<APG * I, WIN>(p0, p1, m_reg, mn, alpha, C, thr, dqq, hi, pm0, pm1, pm2, pm3, mnC);
    if constexpr (APG >= 2) par_atom<APG * I + 1, WIN>(p0, p1, m_reg, mn, alpha, C, thr, dqq, hi, pm0, pm1, pm2, pm3, mnC);
    ASBAR();
    if constexpr (I + 1 < NM) pv_step<I + 1, NM, DV, WIN>(o, vb, pa, L, H, p0, p1, m_reg, mn, alpha, C, thr, dqq, hi, pm0, pm1, pm2, pm3, mnC);
}
template <int DV, bool WIN> __device__ __forceinline__ void pv_part(f32x16 (&o)[DV / 32], const int vb, bf16x8 pa0, bf16x8 pa1, bf16x8 pa2, bf16x8 pa3,
        f32x16& p0, f32x16& p1, float& m_reg, float& mn, float& alpha, const float C, const float thr, const bool domask, const int dq, const int hi) {
    constexpr int NM = DV / 8;
    const bf16x8 pa[4] = {pa0, pa1, pa2, pa3}; s16x4 L[4], H[4];
    L[0] = tr_read<v_rd_off<DV>(0, 0, 0)>(vb); H[0] = tr_read<v_rd_off<DV>(0, 0, 1)>(vb); L[1] = tr_read<v_rd_off<DV>(0, 1, 0)>(vb); H[1] = tr_read<v_rd_off<DV>(0, 1, 1)>(vb);
    L[2] = tr_read<v_rd_off<DV>(0, 2, 0)>(vb); H[2] = tr_read<v_rd_off<DV>(0, 2, 1)>(vb); L[3] = tr_read<v_rd_off<DV>(0, 3, 0)>(vb); H[3] = tr_read<v_rd_off<DV>(0, 3, 1)>(vb);
    float pm0 = 0.f, pm1 = 0.f, pm2 = 0.f, pm3 = 0.f, mnC = 0.f; const int dqq = domask ? dq : 0;
    ASBAR();
    pv_step<0, NM, DV, WIN>(o, vb, pa, L, H, p0, p1, m_reg, mn, alpha, C, thr, dqq, hi, pm0, pm1, pm2, pm3, mnC);
}
#else
template <int NM, int ND, int NV> __device__ __forceinline__ void sgb_pattern() {}
template <int DV> __device__ __forceinline__ void pv_all(f32x16 (&o)[DV / 32], int vb, bf16x8 pa0, bf16x8 pa1, bf16x8 pa2, bf16x8 pa3) {
    VFrag f;
    pv_reads<DV, 0>(f, vb); ATT_LWAIT(0); pv_mma(o[0], f, pa0, pa1, pa2, pa3);
    pv_reads<DV, 1>(f, vb); ATT_LWAIT(0); pv_mma(o[1], f, pa0, pa1, pa2, pa3);
    if constexpr (DV == 128) {
        pv_reads<DV, 2>(f, vb); ATT_LWAIT(0); pv_mma(o[2], f, pa0, pa1, pa2, pa3);
        pv_reads<DV, 3>(f, vb); ATT_LWAIT(0); pv_mma(o[3], f, pa0, pa1, pa2, pa3); }
}
#endif
template <int DK, int DV, bool WIN, bool SINK, int MODE>
__device__ __forceinline__ void attn_unit(const bf16_t* __restrict__ Qb, const int ldq, const bf16_t* __restrict__ Kb, const int ldk, const bf16_t* __restrict__ Vb, const int ldv,
                                          bf16_t* __restrict__ Ob, const int ldo, const int cbase, const int lbase, const int NT, const int qpos0, const int kpos0, const float sinkl2, lchar* lds) {
    constexpr int KI = DK / 64, VI = DV / 64, ND = DK / 16, NO = DV / 32, SHM_K = 64 * DK * 2, SHM_V = 64 * DV * 2;
    constexpr float SCALE = (DK == 192) ? 0.07216878364870322f : 0.125f, C = SCALE * 1.4426950408889634f, THRR = 8.0f / SCALE;
    int tid_ = threadIdx.x; asm volatile("" : "+v"(tid_));
    const int tid = tid_, wid = tid >> 6, lane = tid & 63, r32 = lane & 31, hi = lane >> 5;
    constexpr int NSLOT = (MODE == 2) ? 3 : 2;
    lchar* V_lds = lds; lchar* K_lds = lds + NSLOT * SHM_V;
    LAS float* wsf = (LAS float*)(lds + NSLOT * SHM_V + NSLOT * SHM_K) + wid * 64; LAS float* li_l = wsf; LAS float* al_l = wsf + 32;
    float m_reg = -1e30f, l_reg = 0.f; f32x16 o[NO]; bf16x8 qr[ND];
#pragma unroll
    for (int d = 0; d < NO; ++d) o[d] = f32x16{};
    const bf16_t* Qw = Qb + (long)(wid * 32 + r32) * ldq + hi * 8;
#pragma unroll
    for (int d0 = 0; d0 < ND; ++d0) qr[d0] = *(const bf16x8*)(Qw + d0 * 16);
    const int srow = tid >> 3, scg = tid & 7;
    const int kgo = srow * ldk + scg * 8, vgo = srow * ldv + scg * 8;
    int klo[KI];
#pragma unroll
    for (int i = 0; i < KI; ++i) klo[i] = koff<DK>(srow, scg + 8 * i);
    const int vlo = v_st<DV>(srow, scg * 8);
    const int vb0 = (int)(uintptr_t)V_lds + v_rd_base(lane);
    const int qpos = qpos0 + wid * 32 + r32;
    int kq[4];
#pragma unroll
    for (int k = 0; k < 4; ++k) kq[k] = r32 * (DK * 2) + (((2 * k) ^ hi ^ ((r32 >> 1) & 7)) << 4);
    bf16x8 ks[KI], vs[VI];
#define ATT_ROWOF(j) ((j) < 4 ? cbase + 64 * (j) : lbase + 64 * ((j) - 4))
#define ATT_SLOAD(j) do { const long rb_ = ATT_ROWOF(j); const bf16_t* kp_ = Kb + rb_ * ldk + kgo; const bf16_t* vp_ = Vb + rb_ * ldv + vgo; \
    _Pragma("unroll") for (int i_ = 0; i_ < KI; ++i_) ks[i_] = *(const bf16x8*)(kp_ + 64 * i_); \
    _Pragma("unroll") for (int i_ = 0; i_ < VI; ++i_) vs[i_] = *(const bf16x8*)(vp_ + 64 * i_); } while (0)
#define ATT_SWRITE(b) do { _Pragma("unroll") for (int i_ = 0; i_ < KI; ++i_) *(LAS bf16x8*)(K_lds + (b) * SHM_K + klo[i_]) = ks[i_]; \
    _Pragma("unroll") for (int i_ = 0; i_ < VI; ++i_) *(LAS bf16x8*)(V_lds + (b) * SHM_V + vlo + i_ * 1024) = vs[i_]; } while (0)
#define ATT_RESC(a) do { if (__any((a) < 1.f)) { if (hi == 0) al_l[r32] = (a); asm volatile("s_waitcnt lgkmcnt(0)" ::: "memory"); \
    _Pragma("unroll") for (int d_ = 0; d_ < NO; ++d_) _Pragma("unroll") for (int r_ = 0; r_ < 16; ++r_) o[d_][r_] *= al_l[crow(r_, hi)]; } } while (0)
#define ATT_DQ(j) (kpos0 + 64 * ((j) - 4) - qpos)
    f32x16 pA0, pA1, pB0, pB1; float mnA, mnB, alA, alB; bf16x8 pa0, pa1, pa2, pa3;
    __syncthreads();
    if constexpr (MODE == 2) {
        const int wu = __builtin_amdgcn_readfirstlane(wid);
        constexpr int DW = ATT_DMAW, KP = KI * 8 / DW, VP = VI * 8 / DW;
        const bool dmaw = wu < DW;
        int kgs[KP], vgs[VP];
#pragma unroll
        for (int i = 0; i < KP; ++i) { const int p = (wu * KP + i) * 64 + lane, kr = p / (DK / 8), c2 = p % (DK / 8); kgs[i] = kr * ldk + (((c2 & ~7) | ((c2 & 7) ^ ((kr >> 1) & 7))) << 3); }
#pragma unroll
        for (int i = 0; i < VP; ++i) { const int u16 = (wu * VP + i) * 64 + lane, st = u16 >> 5, kk = (st / (DV / 32)) * 8 + ((u16 >> 2) & 7), c = (st % (DV / 32)) * 32 + (u16 & 3) * 8;
            const int k = (kk & ~0xC) | ((kk & 4) << 1) | ((kk & 8) >> 1); vgs[i] = k * ldv + c; }
        const unsigned kl0 = (unsigned)(uintptr_t)K_lds + (unsigned)(wu * KP) * 1024u, vl0 = (unsigned)(uintptr_t)V_lds + (unsigned)(wu * VP) * 1024u;
#define ATT_DMAK(j, slot) do { const bf16_t* kp_ = Kb + (long)ATT_ROWOF(j) * ldk; if (dmaw) { _Pragma("unroll") for (int i_ = 0; i_ < KP; ++i_) glds16s(kp_, (unsigned)kgs[i_] * 2u, kl0 + (unsigned)(slot) * SHM_K + i_ * 1024); } } while (0)
#define ATT_DMAV(j, slot) do { const bf16_t* vp_ = Vb + (long)ATT_ROWOF(j) * ldv; if (dmaw) { _Pragma("unroll") for (int i_ = 0; i_ < VP; ++i_) glds16s(vp_, (unsigned)vgs[i_] * 2u, vl0 + (unsigned)(slot) * SHM_V + i_ * 1024); } } while (0)
#define ATT_WAITN(n) asm volatile("s_waitcnt vmcnt(" #n ") lgkmcnt(0)" ::: "memory")
#define ATT_WAIT1() do { if constexpr (KP + VP == 10) ATT_WAITN(10); else if constexpr (KP + VP == 5) ATT_WAITN(5); else if constexpr (KP + VP == 4) ATT_WAITN(4); else { static_assert(KP + VP == 2); ATT_WAITN(2); } } while (0)
#define ATT_WAIT2() do { if constexpr (KP + VP == 10) ATT_WAITN(20); else if constexpr (KP + VP == 5) ATT_WAITN(10); else if constexpr (KP + VP == 4) ATT_WAITN(8); else ATT_WAITN(4); } while (0)
#define ATT_SYNC(j) do { const int sp_ = (sc == 0) ? 2 : sc - 1; if ((j) + 2 < NT) ATT_WAIT1(); else ATT_WAITN(0); \
        __builtin_amdgcn_s_barrier(); asm volatile("" ::: "memory"); \
        if ((j) + 3 < NT) ATT_DMAK((j) + 3, sc); if ((j) + 2 < NT) ATT_DMAV((j) + 2, sp_); } while (0)
#define ATT_STEP_OLD(j, PC0, PC1, MNC, ALC, PP0, PP1, MNP, ALP) do { const int spv_ = (sc == 0) ? 2 : sc - 1; \
        ASBAR(); qkt_fin<DK>(PC0, PC1, K_lds + sc * SHM_K, qr, kq, PP0, PP1, ALP, l_reg, pa0, pa1, pa2, pa3); \
        pv_part<DV, WIN>(o, vb0 + spv_ * SHM_V, pa0, pa1, pa2, pa3, PC0, PC1, m_reg, MNC, ALC, C, THRR, (j) >= 4, ATT_DQ(j), hi); \
        ATT_SYNC(j); ATT_RESC(ALC); sc = (sc == 2) ? 0 : sc + 1; } while (0)
#define ATT_STEP_YNG(j, PC0, PC1, MNC, ALC, PP0, PP1, MNP, ALP) do { const int spv_ = (sc == 0) ? 2 : sc - 1; \
        partialSM<WIN>(PP0, PP1, m_reg, MNP, ALP, C, THRR, (j) - 1 >= 4, ATT_DQ((j) - 1), hi); ATT_RESC(ALP); \
        ASBAR(); qkt<DK>(PC0, PC1, K_lds + sc * SHM_K, qr, kq); \
        finishSM(PP0, PP1, ALP, l_reg, pa0, pa1, pa2, pa3); ASBAR(); \
        pv_all<DV>(o, vb0 + spv_ * SHM_V, pa0, pa1, pa2, pa3); \
        ATT_SYNC(j); sc = (sc == 2) ? 0 : sc + 1; } while (0)
        const bool young = (ATT_YOUNG_FROM < 512) && __builtin_amdgcn_readfirstlane(tid) >= ATT_YOUNG_FROM;
        ATT_WAITN(0); __builtin_amdgcn_s_barrier(); asm volatile("" ::: "memory");
        ATT_DMAK(0, 0); ATT_DMAK(1, 1); ATT_DMAV(0, 0); ATT_DMAK(2, 2); ATT_DMAV(1, 1);
        ATT_WAIT2(); __builtin_amdgcn_s_barrier(); asm volatile("" ::: "memory");
        int sc = 0;
        if (young) {
            qkt<DK>(pA0, pA1, K_lds, qr, kq);
            ATT_SYNC(0); sc = 1;
            for (int j = 1; j + 1 < NT; j += 2) {
                ATT_STEP_YNG(j, pB0, pB1, mnB, alB, pA0, pA1, mnA, alA);
                ATT_STEP_YNG(j + 1, pA0, pA1, mnA, alA, pB0, pB1, mnB, alB);
            }
            ATT_STEP_YNG(NT - 1, pB0, pB1, mnB, alB, pA0, pA1, mnA, alA);
            partialSM<WIN>(pB0, pB1, m_reg, mnB, alB, C, THRR, NT - 1 >= 4, ATT_DQ(NT - 1), hi); ATT_RESC(alB);
        } else {
            qkt<DK>(pA0, pA1, K_lds, qr, kq); partialSM<WIN>(pA0, pA1, m_reg, mnA, alA, C, THRR, false, 0, hi);
            ATT_SYNC(0); ATT_RESC(alA); sc = 1;
            for (int j = 1; j + 1 < NT; j += 2) {
                ATT_STEP_OLD(j, pB0, pB1, mnB, alB, pA0, pA1, mnA, alA);
                ATT_STEP_OLD(j + 1, pA0, pA1, mnA, alA, pB0, pB1, mnB, alB);
            }
            ATT_STEP_OLD(NT - 1, pB0, pB1, mnB, alB, pA0, pA1, mnA, alA);
        }
        finishSM(pB0, pB1, alB, l_reg, pa0, pa1, pa2, pa3); ASBAR();
        pv_all<DV>(o, vb0 + ((sc == 0) ? 2 : sc - 1) * SHM_V, pa0, pa1, pa2, pa3);
#undef ATT_SYNC
#undef ATT_STEP_OLD
#undef ATT_STEP_YNG
#undef ATT_DMAK
#undef ATT_DMAV
#undef ATT_WAITN
#undef ATT_WAIT1
#undef ATT_WAIT2
    } else if constexpr (MODE == 1) {
        ATT_SLOAD(0); asm volatile("s_waitcnt vmcnt(0)" ::: "memory"); ATT_SWRITE(0); __syncthreads();
        for (int j = 0; j < NT; ++j) {
            const int b = j & 1;
            if (j + 1 < NT) ATT_SLOAD(j + 1);
            ASBAR(); qkt<DK>(pA0, pA1, K_lds + b * SHM_K, qr, kq);
            partialSM<WIN>(pA0, pA1, m_reg, mnA, alA, C, THRR, j >= 4, ATT_DQ(j), hi);
            ATT_RESC(alA);
            finishSM(pA0, pA1, alA, l_reg, pa0, pa1, pa2, pa3); ASBAR();
            pv_all<DV>(o, vb0 + b * SHM_V, pa0, pa1, pa2, pa3);
            if (j + 1 < NT) { asm volatile("s_waitcnt vmcnt(0)" ::: "memory"); ATT_SWRITE(b ^ 1); }
            __syncthreads();
        }
    } else {
    ATT_SLOAD(0); asm volatile("s_waitcnt vmcnt(0)" ::: "memory"); ATT_SWRITE(0); __syncthreads();
    qkt<DK>(pA0, pA1, K_lds, qr, kq); partialSM<WIN>(pA0, pA1, m_reg, mnA, alA, C, THRR, false, 0, hi);
    ATT_SLOAD(1); asm volatile("s_waitcnt vmcnt(0)" ::: "memory"); ATT_SWRITE(1); __syncthreads();
    for (int j = 1; j + 1 < NT; j += 2) {
        ASBAR(); qkt<DK>(pB0, pB1, K_lds + SHM_K, qr, kq);
        finishSM(pA0, pA1, alA, l_reg, pa0, pa1, pa2, pa3); ASBAR();
        ATT_SLOAD(j + 1); ASBAR();
        pv_all<DV>(o, vb0, pa0, pa1, pa2, pa3); partialSM<WIN>(pB0, pB1, m_reg, mnB, alB, C, THRR, j >= 4, ATT_DQ(j), hi);
        __syncthreads(); asm volatile("s_waitcnt vmcnt(0)" ::: "memory"); ATT_SWRITE(0);
        ATT_RESC(alB); __syncthreads();
        ASBAR(); qkt<DK>(pA0, pA1, K_lds, qr, kq);
        finishSM(pB0, pB1, alB, l_reg, pa0, pa1, pa2, pa3); ASBAR();
        ATT_SLOAD(j + 2); ASBAR();
        pv_all<DV>(o, vb0 + SHM_V, pa0, pa1, pa2, pa3); partialSM<WIN>(pA0, pA1, m_reg, mnA, alA, C, THRR, j + 1 >= 4, ATT_DQ(j + 1), hi);
        __syncthreads(); asm volatile("s_waitcnt vmcnt(0)" ::: "memory"); ATT_SWRITE(1);
        ATT_RESC(alA); __syncthreads();
    }
    ASBAR(); qkt<DK>(pB0, pB1, K_lds + SHM_K, qr, kq);
    finishSM(pA0, pA1, alA, l_reg, pa0, pa1, pa2, pa3); ASBAR();
    pv_all<DV>(o, vb0, pa0, pa1, pa2, pa3); partialSM<WIN>(pB0, pB1, m_reg, mnB, alB, C, THRR, NT - 1 >= 4, ATT_DQ(NT - 1), hi);
    __syncthreads(); ATT_RESC(alB);
    finishSM(pB0, pB1, alB, l_reg, pa0, pa1, pa2, pa3); ASBAR();
    pv_all<DV>(o, vb0 + SHM_V, pa0, pa1, pa2, pa3);
    }
    if constexpr (SINK) l_reg += __builtin_amdgcn_exp2f(sinkl2 - m_reg * C);
    if (hi == 0) li_l[r32] = l_reg;
    asm volatile("s_waitcnt lgkmcnt(0)" ::: "memory");
    float rli[16];
#pragma unroll
    for (int r = 0; r < 16; ++r) rli[r] = __builtin_amdgcn_rcpf(li_l[crow(r, hi)]);
    bf16_t* Ow = Ob + (long)(wid * 32) * ldo + r32;
#pragma unroll
    for (int r = 0; r < 16; ++r) { const int orow = crow(r, hi);
#pragma unroll
        for (int d0 = 0; d0 < NO; ++d0) Ow[(long)orow * ldo + d0 * 32] = (bf16_t)(cvtpk(o[d0][r] * rli[r], 0.f) & 0xffffu); }
#undef ATT_ROWOF
#undef ATT_SLOAD
#undef ATT_SWRITE
#undef ATT_RESC
#undef ATT_DQ
}
}
typedef unsigned short bf16;
typedef unsigned v4u __attribute__((ext_vector_type(4)));
typedef unsigned v2u __attribute__((ext_vector_type(2)));
typedef float f32x4 __attribute__((ext_vector_type(4)));
typedef short bf16x8 __attribute__((ext_vector_type(8)));
typedef GAS unsigned gu32;
#define LDS_WAIT() asm volatile("s_waitcnt lgkmcnt(0)" ::: "memory")
#define VM_WAIT() asm volatile("s_waitcnt vmcnt(0)" ::: "memory")

constexpr int NWAVES = 8;
constexpr int DM = 2048, NB = 8, SEQ = 4096, DEPTH = 4, CTXL = 256, DFF = 5632;
constexpr int ML = NB * SEQ, MC = NB * CTXL, MT = ML + MC;
constexpr int NIN = 8768, NINP = 8960, NMOD = 6 * DM;
constexpr float EPS = 1e-6f;
static_assert(ML == pg8::ML_ROWS, "row split");

constexpr size_t MiB = 1u << 20;
constexpr size_t WS_CTL = 0, CTL_ZERO_BYTES = 1 * MiB;
constexpr size_t WS_MOD = 1 * MiB;
constexpr size_t WS_ROPE = 3 * MiB;
constexpr size_t WS_W = 4 * MiB;
constexpr size_t WO_IN = 0, WO_Q = WO_IN + (size_t)NINP * DM * 2, WO_KV = WO_Q + (size_t)1536 * 512 * 2, WO_C = WO_KV + (size_t)2048 * 256 * 2, WO_M = WO_C + (size_t)2048 * 512 * 2,
                 WO_G = WO_M + (size_t)2048 * 1024 * 2, WO_O = WO_G + (size_t)2048 * 512 * 2, WO_F1 = WO_O + (size_t)2048 * 2048 * 2, WO_F2 = WO_F1 + (size_t)2 * DFF * DM * 2,
                 WO_END = WO_F2 + (size_t)DM * DFF * 2;
static_assert(WO_END <= 120 * MiB, "weights");
constexpr size_t WS_XC = 124 * MiB;
constexpr size_t WS_A = 140 * MiB;
constexpr size_t WS_B = 548 * MiB;
constexpr size_t WS_C = 684 * MiB;
constexpr size_t WS_D = 786 * MiB;
constexpr size_t WD_KF = 0, WD_V = 102 * MiB, WD_GQ = 170 * MiB, WD_GK = 204 * MiB, WD_GV = 213 * MiB, WD_U = 222 * MiB;
constexpr size_t WS_E = 1058 * MiB;
constexpr size_t WE_UC = 0, WE_CKV = 34 * MiB, WE_QA = 51 * MiB;
constexpr size_t WS_XB = 1144 * MiB;
constexpr size_t WS_END = 1272 * MiB;
static_assert((size_t)MT * 6144 * 2 <= 408 * MiB && (size_t)MT * 2048 * 2 <= 136 * MiB && (size_t)MT * 768 * 4 <= 102 * MiB && (size_t)MT * 2048 * 4 <= 272 * MiB && WD_U + (size_t)MT * 512 * 2 <= 272 * MiB, "ws map");
constexpr int CW_BAR = 4096;

constexpr int RING_OFF = 0, RING_BYTES = 131072, LDSCTL_OFF = RING_BYTES, MISC_OFF = LDSCTL_OFF + 320, LDS_BYTES = 147456;

__device__ __forceinline__ unsigned f2bf(float f) { unsigned u = __builtin_bit_cast(unsigned, f); return (u + 0x7fffu + ((u >> 16) & 1u)) >> 16; }
__device__ __forceinline__ unsigned pk2(float lo, float hi) { return pg8::cvt_pk_bf16(lo, hi); }
__device__ __forceinline__ float wave_sum(float v) {
#pragma unroll
    for (int o = 1; o < 64; o <<= 1) v += __shfl_xor(v, o);
    return v;
}
__device__ __forceinline__ float bflo(unsigned w) { return __uint_as_float(w << 16); }
__device__ __forceinline__ float bfhi(unsigned w) { return __uint_as_float(w & 0xffff0000u); }
__device__ __forceinline__ float sigmf(float x) { return __builtin_amdgcn_rcpf(1.0f + __builtin_amdgcn_exp2f(-1.4426950408889634f * x)); }

__device__ __forceinline__ int srccol(int mode, int n) {
    if (mode == 0) return n;
    if (mode == 1) {
        if (n < 6144) return 2624 + n;
        if (n < 7744) return n - 6144;
        if (n < 8768) { const int q = n - 7744, g = q >> 5, i = q & 31; return 1600 + (i < 16 ? 16 * g + i : 512 + 16 * g + (i - 16)); }
        return -1;
    }
    { const int g = n >> 5, i = n & 31; return i < 16 ? 16 * g + i : DFF + 16 * g + (i - 16); }
}
__device__ __forceinline__ void cvt_item(const float* W, int K, int N, bf16* WT, LAS float* scr, int item, int nblk, int lane, int mode) {
    const int kb = item / nblk, nb = item % nblk, k0 = 64 * kb, n0 = 32 * nb;
    const int sc = srccol(mode, n0 + (lane & 31));
    const float wsc = (mode == 1 && n0 < 6144) ? -1.4426950408889634f : 1.0f;
    const float* wp = W + (size_t)(k0 + (lane >> 5)) * N + (sc >= 0 ? sc : 0);
#pragma unroll 8
    for (int i = 0; i < 32; ++i) { const float v = wp[(size_t)(2 * i) * N] * wsc; scr[(2 * i + (lane >> 5)) * 33 + (lane & 31)] = sc >= 0 ? v : 0.f; }
    LDS_WAIT(); asm volatile("" ::: "memory");
    const int c = lane & 7;
#pragma unroll
    for (int j = 0; j < 4; ++j) { const int n = (lane >> 3) + 8 * j; const LAS float* s = scr + (8 * c) * 33 + n;
        v4u o; o.x = pk2(s[0 * 33], s[1 * 33]); o.y = pk2(s[2 * 33], s[3 * 33]); o.z = pk2(s[4 * 33], s[5 * 33]); o.w = pk2(s[6 * 33], s[7 * 33]);
        *(GAS v4u*)(WT + (size_t)(n0 + n) * K + k0 + 8 * c) = o; }
    LDS_WAIT(); asm volatile("" ::: "memory");
}

#ifndef ATT_MLA_MODE
#define ATT_MLA_MODE 2
#endif
#ifndef ATT_GQA_MODE
#define ATT_GQA_MODE 2
#endif
#ifndef P5_WGM
#define P5_WGM 8
#endif
#ifndef P1_WGM
#define P1_WGM 4
#endif
#ifndef P8_WGM
#define P8_WGM 4
#endif
#ifndef SPLIT_WGM
#define SPLIT_WGM 2
#endif
struct Args { const float* in[25]; float* out; unsigned char* ws; int multi, l_lo, l_hi, ph, pad0, pad1; };
enum { PH_PRE = -1, PH_POST = 10, PH_DUMP = 11 };

struct __attribute__((packed, aligned(4))) F3 { float x, y, z; };
#define PHASE_BEGIN \
    const __attribute__((address_space(4))) Args* ap = (const __attribute__((address_space(4))) Args*)__builtin_amdgcn_kernarg_segment_ptr(); asm volatile("" : "+s"(ap)); \
    unsigned char* ws = ap->ws; \
    int tid = threadIdx.x; asm volatile("" : "+v"(tid)); const int lane = tid & 63, wave = __builtin_amdgcn_readfirstlane(tid >> 6); \
    const int gw = vcu * NWAVES + wave, NGW = G * NWAVES; (void)gw; (void)NGW; (void)lane; \
    const float* in_x = ap->in[0]; const float* in_c = ap->in[1]; const float* in_ctx = ap->in[2]; const float* in_cctx = ap->in[3]; const float* w_ada = ap->in[4]; const float* b_ada = ap->in[5]; const float* g_mix = ap->in[6]; const float* w_in = ap->in[7]; const float* conv_w = ap->in[8]; const float* conv_b = ap->in[9]; const float* conv_ln_g = ap->in[10]; const float* conv_ln_b = ap->in[11]; const float* w_conv_out = ap->in[12]; const float* g_q_a = ap->in[13]; const float* w_q_up = ap->in[14]; const float* g_kv_a = ap->in[15]; const float* w_kv_up = ap->in[16]; const float* w_mla_out = ap->in[17]; const float* gqa_sink = ap->in[18]; const float* w_gqa_out = ap->in[19]; const float* w_out = ap->in[20]; const float* g_ffn = ap->in[21]; const float* w_ffn_in = ap->in[22]; const float* w_ffn_out = ap->in[23]; const float* g_final = ap->in[24]; float* XL = ap->out; bf16* XB = (bf16*)(ws + WS_XB); bf16* XCB = (bf16*)(ws + WS_XC); (void)XL; (void)XCB; float* MOD = (float*)(ws + WS_MOD); float* ROPE = (float*)(ws + WS_ROPE); float* XC = (float*)(ws + WS_XC); bf16* Win_t = (bf16*)(ws + WS_W + WO_IN); bf16* Wq_t = (bf16*)(ws + WS_W + WO_Q); bf16* Wkv_t = (bf16*)(ws + WS_W + WO_KV); bf16* Wc_t = (bf16*)(ws + WS_W + WO_C); bf16* Wm_t = (bf16*)(ws + WS_W + WO_M); bf16* Wg_t = (bf16*)(ws + WS_W + WO_G); bf16* Wo_t = (bf16*)(ws + WS_W + WO_O); bf16* Wf1_t = (bf16*)(ws + WS_W + WO_F1); bf16* Wf2_t = (bf16*)(ws + WS_W + WO_F2); unsigned char* Gb = (unsigned char*)(ws + WS_A); bf16* HID = (bf16*)(ws + WS_A); bf16* Hb = (bf16*)(ws + WS_B); bf16* MQ = (bf16*)(ws + WS_B); bf16* Yb = (bf16*)(ws + WS_B); bf16* CQ = (bf16*)(ws + WS_C); bf16* PART = (bf16*)(ws + WS_C); bf16* OM = (bf16*)(ws + WS_C); bf16* OG = (bf16*)(ws + WS_C + (size_t)MT * 1024 * 2); bf16* KF = (bf16*)(ws + WS_D + WD_KF); bf16* Vb = (bf16*)(ws + WS_D + WD_V); bf16* GQ = (bf16*)(ws + WS_D + WD_GQ); bf16* GK = (bf16*)(ws + WS_D + WD_GK); bf16* GV = (bf16*)(ws + WS_D + WD_GV); bf16* Ub = (bf16*)(ws + WS_D + WD_U); bf16* YF = (bf16*)(ws + WS_D); bf16* UC = (bf16*)(ws + WS_E + WE_UC); bf16* CKVn = (bf16*)(ws + WS_E + WE_CKV); bf16* QAn = (bf16*)(ws + WS_E + WE_QA); \
    const float* modl = MOD + (size_t)l_cur * 9 * NMOD; (void)modl;
__global__ void __launch_bounds__(NWAVES * 64, 2) mega_fwd(Args args) {
    extern __shared__ __attribute__((aligned(16))) unsigned char lds_raw[];
    LAS unsigned char* lds = (LAS unsigned char*)lds_raw;
    volatile LAS unsigned* MISC = (volatile LAS unsigned*)(lds + MISC_OFF);
    const int tid0 = threadIdx.x;
    const int G = gridDim.x; const int bx = blockIdx.x; const int vcu = (G % 8 == 0) ? (bx % 8) * (G / 8) + bx / 8 : bx;
    gu32* ctl = (gu32*)(args.ws + WS_CTL);
    int l_cur = 0;
    for (int u = tid0; u < (LDS_BYTES - LDSCTL_OFF) / 4; u += NWAVES * 64) ((LAS unsigned*)(lds + LDSCTL_OFF))[u] = 0u;
    __syncthreads();
    XcdBarrier bar = xcd_barrier_post((unsigned*)(ctl + CW_BAR), MISC + 8);
    const int multi = args.multi, ph = args.ph;
#ifndef PHASE_MASK
#define PHASE_MASK 0x1fff
#endif
#define RUN(k) ((((PHASE_MASK) >> ((k) + 1)) & 1) && (!multi || ph == (k)))
#define GRID_BAR() do { if (!multi) xcd_barrier(bar); } while (0)

    if (RUN(PH_PRE)) { PHASE_BEGIN
        LAS float* sil = (LAS float*)(lds + RING_OFF);
        LAS float* red = (LAS float*)(lds + RING_OFF + 9 * DM * 4);
        for (int i = tid; i < 9 * DM; i += NWAVES * 64) { const float v = i < 8 * DM ? in_c[i] : in_cctx[i - 8 * DM]; sil[(i & (DM - 1)) * 9 + (i >> 11)] = v * sigmf(v); }
        __syncthreads();
#define ADA_LOAD(W_, I0) do { _Pragma("unroll") for (int u = 0; u < 8; ++u) W_[u] = *(const F3*)(Wl + (size_t)((I0) + u) * 8 * NMOD); } while (0)
#define ADA_FMA(W_, I0) do { _Pragma("unroll") for (int u = 0; u < 8; ++u) { const LAS float* sp = sil + (((I0) + u) * 8 + wave) * 9; \
            _Pragma("unroll") for (int v = 0; v < 9; ++v) { const float sv = sp[v]; acc[v][0] += W_[u].x * sv; acc[v][1] += W_[u].y * sv; acc[v][2] += W_[u].z * sv; } asm volatile("" ::: "memory"); } } while (0)
        for (int s = vcu; s < DEPTH * 64; s += G) {
            const int l = s >> 6, col0 = (s & 63) * 192;
            const float* Wl = w_ada + (size_t)l * DM * NMOD + (size_t)wave * NMOD + col0 + 3 * lane;
            float acc[9][3];
#pragma unroll
            for (int v = 0; v < 9; ++v) { acc[v][0] = 0.f; acc[v][1] = 0.f; acc[v][2] = 0.f; }
            F3 wa[8], wb[8];
            ADA_LOAD(wa, 0);
#pragma nounroll
            for (int i = 0; i < DM / 8; i += 16) {
                ADA_LOAD(wb, i + 8);
                ADA_FMA(wa, i);
                { const int in_ = (i + 16 < DM / 8) ? i + 16 : 0; ADA_LOAD(wa, in_); }
                ADA_FMA(wb, i + 8);
            }
#pragma unroll
            for (int v = 0; v < 9; ++v) {
#pragma unroll
                for (int e = 0; e < 3; ++e) red[(wave * 9 + v) * 192 + 3 * lane + e] = acc[v][e]; }
            __syncthreads();
            for (int i = tid; i < 9 * 192; i += NWAVES * 64) { const int v = i / 192, cc = i - v * 192; float t = 0.f;
#pragma unroll
                for (int w8 = 0; w8 < 8; ++w8) t += red[(w8 * 9 + v) * 192 + cc];
                MOD[((size_t)l * 9 + v) * NMOD + col0 + cc] = t + b_ada[(size_t)l * NMOD + col0 + cc]; }
            __syncthreads();
        }
        { bf16* XB = (bf16*)(ws + WS_XB);
          for (size_t i = ((size_t)gw * 64 + lane) * 8; i < (size_t)ML * DM; i += (size_t)NGW * 64 * 8) { const f32x4 a = *(const f32x4*)(in_x + i), b = *(const f32x4*)(in_x + i + 4);
              v4u w; w.x = pk2(a[0], a[1]); w.y = pk2(a[2], a[3]); w.z = pk2(b[0], b[1]); w.w = pk2(b[2], b[3]); *(v4u*)(XB + i) = w; }
          bf16* XCB = (bf16*)(ws + WS_XC);
          for (size_t i = ((size_t)gw * 64 + lane) * 8; i < (size_t)MC * DM; i += (size_t)NGW * 64 * 8) { const f32x4 a = *(const f32x4*)(in_ctx + i), b = *(const f32x4*)(in_ctx + i + 4);
              v4u w; w.x = pk2(a[0], a[1]); w.y = pk2(a[2], a[3]); w.z = pk2(b[0], b[1]); w.w = pk2(b[2], b[3]); *(v4u*)(XCB + i) = w; } }
        { const int i = bx * (NWAVES * 64) + tid; if (i < 64 * 16) { const int p = i >> 4, f = i & 15; const float invf = powf(10000.0f, -(float)f / 16.0f), a = (float)p * invf;
              ROPE[2 * i] = cosf(a); ROPE[2 * i + 1] = sinf(a); } }
    }
    GRID_BAR();

    for (int l = args.l_lo; l < args.l_hi; ++l) {
        l_cur = l;
        const bool lastl = (l == DEPTH - 1); const int Mg = lastl ? ML : MT;
        if (RUN(0)) { PHASE_BEGIN
            LAS float* scr = (LAS float*)(lds + RING_OFF + wave * 16384);
            constexpr int I_IN = (DM / 64) * (NINP / 32), I_Q = (512 / 64) * (1536 / 32), I_KV = (256 / 64) * (2048 / 32), I_C = (512 / 64) * (DM / 32), I_M = (1024 / 64) * (DM / 32),
                          I_G = (512 / 64) * (DM / 32), I_O = (DM / 64) * (DM / 32), I_F1 = (DM / 64) * (2 * DFF / 32), I_F2 = (DFF / 64) * (DM / 32);
            constexpr int NITEMS = I_IN + I_Q + I_KV + I_C + I_M + I_G + I_O + I_F1 + I_F2;
            for (int it = gw; it < NITEMS; it += NGW) {
                int r = it; const float* W; bf16* WT; int K, N, nblk, mode = 0;
                if (r < I_IN) { W = w_in + (size_t)l * DM * NIN; K = DM; N = NIN; WT = Win_t; nblk = NINP / 32; mode = 1; }
                else if ((r -= I_IN) < I_Q) { W = w_q_up + (size_t)l * 512 * 1536; K = 512; N = 1536; WT = Wq_t; nblk = 1536 / 32; }
                else if ((r -= I_Q) < I_KV) { W = w_kv_up + (size_t)l * 256 * 2048; K = 256; N = 2048; WT = Wkv_t; nblk = 2048 / 32; }
                else if ((r -= I_KV) < I_C) { W = w_conv_out + (size_t)l * 512 * DM; K = 512; N = DM; WT = Wc_t; nblk = DM / 32; }
                else if ((r -= I_C) < I_M) { W = w_mla_out + (size_t)l * 1024 * DM; K = 1024; N = DM; WT = Wm_t; nblk = DM / 32; }
                else if ((r -= I_M) < I_G) { W = w_gqa_out + (size_t)l * 512 * DM; K = 512; N = DM; WT = Wg_t; nblk = DM / 32; }
                else if ((r -= I_G) < I_O) { W = w_out + (size_t)l * DM * DM; K = DM; N = DM; WT = Wo_t; nblk = DM / 32; }
                else if ((r -= I_O) < I_F1) { W = w_ffn_in + (size_t)l * DM * 2 * DFF; K = DM; N = 2 * DFF; WT = Wf1_t; nblk = 2 * DFF / 32; mode = 2; }
                else { r -= I_F1; W = w_ffn_out + (size_t)l * DFF * DM; K = DFF; N = DM; WT = Wf2_t; nblk = DM / 32; }
                cvt_item(W, K, N, WT, scr, r, nblk, lane, mode);
            }
        }
#define NORM_LDMOD(SEL, GVEC, SHOFF, SCOFF) do { const float* mp = modl + (size_t)(SEL) * NMOD; \
                _Pragma("unroll") for (int j = 0; j < 8; ++j) { const int c = 4 * ln_ + 256 * j; const f32x4 g = *(const f32x4*)((GVEC) + c), sc = *(const f32x4*)(mp + (SCOFF) + c); \
                    Aa[j] = g * (sc + 1.0f); Ss[j] = *(const f32x4*)(mp + (SHOFF) + c); } } while (0)
#define NORM_FINISH(R) do { float ss = 0.f; \
                _Pragma("unroll") for (int j = 0; j < 8; ++j) ss += (v[j][0] * v[j][0] + v[j][1] * v[j][1]) + (v[j][2] * v[j][2] + v[j][3] * v[j][3]); \
                const float rstd = 1.0f / sqrtf(wave_sum(ss) * (1.0f / DM) + EPS); \
                bf16* hp = Hb + (size_t)(R) * DM + 4 * ln_; \
                _Pragma("unroll") for (int j = 0; j < 8; ++j) { const f32x4 y = v[j] * rstd * Aa[j] + Ss[j]; v2u w; w.x = pk2(y[0], y[1]); w.y = pk2(y[2], y[3]); *(v2u*)(hp + 256 * j) = w; } } while (0)
#define NORM_ROWS(GVEC, SHOFF, SCOFF, FIRST, WITHCTX, PARTG) do { \
            int ln_ = lane; asm volatile("" : "+v"(ln_)); \
            f32x4 Aa[8], Ss[8]; \
            _Pragma("unroll") for (int j = 0; j < 8; ++j) { Aa[j] = (f32x4){0.f, 0.f, 0.f, 0.f}; Ss[j] = (f32x4){0.f, 0.f, 0.f, 0.f}; } \
            for (int gv_ = gw; gv_ < 2048; gv_ += NGW) { \
                NORM_LDMOD((gv_ * 16) >> 12, GVEC, SHOFF, SCOFF);                                   \
                _Pragma("nounroll") for (int ri = 0; ri < 16; ++ri) { int r = gv_ * 16 + ri; asm volatile("" : "+s"(r)); \
                    const bf16* sb_ = XB + (size_t)r * DM + 4 * ln_; f32x4 v[8]; \
                    _Pragma("unroll") for (int j = 0; j < 8; ++j) { const v2u t_ = *(const v2u*)(sb_ + 256 * j); v[j] = (f32x4){bflo(t_.x), bfhi(t_.x), bflo(t_.y), bfhi(t_.y)}; } \
                    NORM_FINISH(r); } \
                if (WITHCTX) { NORM_LDMOD(8, GVEC, SHOFF, SCOFF); int rc = gv_; asm volatile("" : "+s"(rc));     \
                    bf16* sb_ = XCB + (size_t)rc * DM + 4 * ln_; f32x4 v[8]; \
                    _Pragma("unroll") for (int j = 0; j < 8; ++j) { const v2u t_ = *(const v2u*)(sb_ + 256 * j); v[j] = (f32x4){bflo(t_.x), bfhi(t_.x), bflo(t_.y), bfhi(t_.y)}; } \
                    if ((PARTG) != nullptr) { const bf16* pp = PART + (size_t)rc * DM + 4 * ln_; \
                        _Pragma("unroll") for (int j = 0; j < 8; ++j) { const v2u q0_ = *(const v2u*)(pp + 256 * j), q1_ = *(const v2u*)(pp + (size_t)2048 * DM + 256 * j), q2_ = *(const v2u*)(pp + (size_t)2 * 2048 * DM + 256 * j), q3_ = *(const v2u*)(pp + (size_t)3 * 2048 * DM + 256 * j); \
                            const f32x4 p = ((f32x4){bflo(q0_.x), bfhi(q0_.x), bflo(q0_.y), bfhi(q0_.y)} + (f32x4){bflo(q1_.x), bfhi(q1_.x), bflo(q1_.y), bfhi(q1_.y)}) + ((f32x4){bflo(q2_.x), bfhi(q2_.x), bflo(q2_.y), bfhi(q2_.y)} + (f32x4){bflo(q3_.x), bfhi(q3_.x), bflo(q3_.y), bfhi(q3_.y)}); \
                            v[j] += *(const f32x4*)((PARTG) + 4 * ln_ + 256 * j) * p; } \
                        _Pragma("unroll") for (int j = 0; j < 8; ++j) { v2u w_; w_.x = pk2(v[j][0], v[j][1]); w_.y = pk2(v[j][2], v[j][3]); *(v2u*)(sb_ + 256 * j) = w_; } } \
                    NORM_FINISH(ML + rc); } } \
        } while (0)
        if (RUN(0)) { PHASE_BEGIN const float* gv = g_mix + (size_t)l * DM; const int first = (l == 0) ? 1 : 0;
            const float* pg = first ? nullptr : (MOD + ((size_t)(l - 1) * 9 + 8) * NMOD + 5 * DM);
            NORM_ROWS(gv, 0, DM, first, true, pg); }
        GRID_BAR();

        if (RUN(1)) { PHASE_BEGIN
            const bf16* A_ = Hb; const bf16* B_ = Win_t; asm volatile("" : "+s"(A_), "+s"(B_)); pg8::Gemm g{A_, B_, MT, NINP, DM}; pg8::StaticOrder S; S.init(Mg, NINP, G, bx); S.wgm = P1_WGM; if (lastl) S.set_extra(24, ML / 256, 24, 3);
            pg8::EpiWin E{Gb, CQ, KF, GK, GV, GQ, Ub, ROPE};
            pg8::gemm_phase<pg8::EpiWin, pg8::StaticOrder, true, true>(lds + RING_OFF, g, S, E);
        }
        GRID_BAR();

        if (RUN(2)) { PHASE_BEGIN
            LAS float* cw = (LAS float*)(lds + RING_OFF);
            for (int i = tid; i < 31 * 512; i += NWAVES * 64) cw[i] = conv_w[(size_t)l * 31 * 512 + i];
            __syncthreads();
            { const f32x4 gk = *(const f32x4*)(g_kv_a + (size_t)l * 256 + 4 * lane), gq0 = *(const f32x4*)(g_q_a + (size_t)l * 512 + 4 * lane), gq1 = *(const f32x4*)(g_q_a + (size_t)l * 512 + 256 + 4 * lane);
              for (int r0 = gw; r0 < MT; r0 += 2 * NGW) { const int r1 = (r0 + NGW < MT) ? r0 + NGW : r0;
                const bf16* p = CQ + (size_t)r0 * 768 + 4 * lane; const bf16* q = CQ + (size_t)r1 * 768 + 4 * lane;
#define LD4(P) ({ const v2u t_ = *(const v2u*)(P); (f32x4){bflo(t_.x), bfhi(t_.x), bflo(t_.y), bfhi(t_.y)}; })
                const f32x4 a = LD4(p), b0 = LD4(p + 256), b1 = LD4(p + 512), c = LD4(q), d0 = LD4(q + 256), d1 = LD4(q + 512);
#undef LD4
#define LR_ROW(R, A_, B0_, B1_) do { \
                const float sa = wave_sum((A_[0] * A_[0] + A_[1] * A_[1]) + (A_[2] * A_[2] + A_[3] * A_[3])); \
                const float sb = wave_sum(((B0_[0] * B0_[0] + B0_[1] * B0_[1]) + (B0_[2] * B0_[2] + B0_[3] * B0_[3])) + ((B1_[0] * B1_[0] + B1_[1] * B1_[1]) + (B1_[2] * B1_[2] + B1_[3] * B1_[3]))); \
                const float ra = 1.0f / sqrtf(sa * (1.0f / 256.0f) + EPS), rb = 1.0f / sqrtf(sb * (1.0f / 512.0f) + EPS); \
                const f32x4 ya = A_ * ra * gk, y0 = B0_ * rb * gq0, y1 = B1_ * rb * gq1; \
                v2u w; w.x = pk2(ya[0], ya[1]); w.y = pk2(ya[2], ya[3]); *(v2u*)(CKVn + (size_t)(R) * 256 + 4 * lane) = w; \
                w.x = pk2(y0[0], y0[1]); w.y = pk2(y0[2], y0[3]); *(v2u*)(QAn + (size_t)(R) * 512 + 4 * lane) = w; \
                w.x = pk2(y1[0], y1[1]); w.y = pk2(y1[2], y1[3]); *(v2u*)(QAn + (size_t)(R) * 512 + 256 + 4 * lane) = w; } while (0)
                LR_ROW(r0, a, b0, b1); LR_ROW(r1, c, d0, d1);
#undef LR_ROW
              } }
            { const int ch = 8 * lane;
              const f32x4 cb0 = *(const f32x4*)(conv_b + (size_t)l * 512 + ch), cb1 = *(const f32x4*)(conv_b + (size_t)l * 512 + ch + 4);
              const f32x4 lg0 = *(const f32x4*)(conv_ln_g + (size_t)l * 512 + ch), lg1 = *(const f32x4*)(conv_ln_g + (size_t)l * 512 + ch + 4);
              const f32x4 lb0 = *(const f32x4*)(conv_ln_b + (size_t)l * 512 + ch), lb1 = *(const f32x4*)(conv_ln_b + (size_t)l * 512 + ch + 4);
              for (int tok = gw; tok < Mg; tok += NGW) {
                int sb, pos, L; if (tok < ML) { sb = tok & ~4095; pos = tok & 4095; L = SEQ; } else { const int c = tok - ML; sb = ML + (c & ~255); pos = c & 255; L = CTXL; }
                f32x4 a0 = cb0, a1 = cb1;
                v4u xr[31];
                if (pos >= 15 && pos < L - 15) {
                    const bf16* up = Ub + (size_t)(sb + pos - 15) * 512 + ch;
#pragma unroll
                    for (int j = 0; j < 31; ++j) xr[j] = *(const v4u*)(up + (size_t)j * 512);
                    asm volatile("" ::: "memory");
#pragma unroll
                    for (int j = 0; j < 31; ++j) { const v4u x = xr[j];
                        const f32x4 w0 = *(const LAS f32x4*)(cw + j * 512 + ch), w1 = *(const LAS f32x4*)(cw + j * 512 + ch + 4);
                        const f32x4 x0 = {bflo(x.x), bfhi(x.x), bflo(x.y), bfhi(x.y)}, x1 = {bflo(x.z), bfhi(x.z), bflo(x.w), bfhi(x.w)};
                        a0 += w0 * x0; a1 += w1 * x1; if ((j & 3) == 3) asm volatile("" ::: "memory"); }
                } else {
#pragma unroll
                    for (int j = 0; j < 31; ++j) { int p = pos + j - 15; p = p < 0 ? 0 : (p >= L ? L - 1 : p); xr[j] = *(const v4u*)(Ub + (size_t)(sb + p) * 512 + ch); }
                    asm volatile("" ::: "memory");
#pragma unroll
                    for (int j = 0; j < 31; ++j) { const int p = pos + j - 15; const float ok = (p >= 0 && p < L) ? 1.0f : 0.0f; const v4u x = xr[j];
                        const f32x4 w0 = *(const LAS f32x4*)(cw + j * 512 + ch) * ok, w1 = *(const LAS f32x4*)(cw + j * 512 + ch + 4) * ok;
                        const f32x4 x0 = {bflo(x.x), bfhi(x.x), bflo(x.y), bfhi(x.y)}, x1 = {bflo(x.z), bfhi(x.z), bflo(x.w), bfhi(x.w)};
                        a0 += w0 * x0; a1 += w1 * x1; if ((j & 3) == 3) asm volatile("" ::: "memory"); }
                }
                const float mean = wave_sum((a0[0] + a0[1]) + (a0[2] + a0[3]) + (a1[0] + a1[1]) + (a1[2] + a1[3])) * (1.0f / 512.0f);
                const f32x4 d0 = a0 - mean, d1 = a1 - mean;
                const float var = wave_sum((d0[0] * d0[0] + d0[1] * d0[1]) + (d0[2] * d0[2] + d0[3] * d0[3]) + (d1[0] * d1[0] + d1[1] * d1[1]) + (d1[2] * d1[2] + d1[3] * d1[3])) * (1.0f / 512.0f);
                const float rstd = 1.0f / sqrtf(var + EPS);
                const f32x4 y0 = d0 * rstd * lg0 + lb0, y1 = d1 * rstd * lg1 + lb1;
                v4u w; w.x = pk2(y0[0] * sigmf(y0[0]), y0[1] * sigmf(y0[1])); w.y = pk2(y0[2] * sigmf(y0[2]), y0[3] * sigmf(y0[3]));
                w.z = pk2(y1[0] * sigmf(y1[0]), y1[1] * sigmf(y1[1])); w.w = pk2(y1[2] * sigmf(y1[2]), y1[3] * sigmf(y1[3]));
                *(v4u*)(UC + (size_t)tok * 512 + ch) = w; } }
        }
        GRID_BAR();

        if (RUN(3)) { PHASE_BEGIN
            const bf16* A0_ = QAn; const bf16* B0_ = Wq_t; const bf16* A1_ = CKVn; const bf16* B1_ = Wkv_t; asm volatile("" : "+s"(A0_), "+s"(B0_), "+s"(A1_), "+s"(B1_));
            pg8::SchedQKV S; S.nMq = Mg / 256; S.nNq = 1536 / 256; S.nMk = MT / 256; S.nNk = 2048 / 256; S.G = G; S.c = bx; S.Aq = A0_; S.Bq = B0_; S.Ak = A1_; S.Bk = B1_;
            pg8::EpiQKV E{pg8::EpiQup{MQ, ROPE}, pg8::EpiKV{KF, Vb}};
            pg8::gemm_stream<pg8::EpiQKV, pg8::SchedQKV>(lds + RING_OFF, S, E);
        }
        GRID_BAR();

        if (RUN(4)) { PHASE_BEGIN
            att::lchar* alds = (att::lchar*)(lds + RING_OFF);
            for (int u = vcu; u < 1024 + (lastl ? 0 : 64); u += G) {
                int b, h, q0row, NT;
                if (u < 1024) { const int bh = u >> 4, qb = u & 15; b = bh >> 3; h = bh & 7; q0row = b * SEQ + qb * 256; NT = 4 + SEQ / 64; }
                else { const int bh = u - 1024; b = bh >> 3; h = bh & 7; q0row = ML + b * CTXL; NT = 4; }
                att::attn_unit<192, 128, false, false, ATT_MLA_MODE>(MQ + (size_t)q0row * 1536 + h * 192, 1536, KF + h * 192, 1536, Vb + h * 128, 1024, OM + (size_t)q0row * 1024 + h * 128, 1024,
                                                       ML + b * CTXL, b * SEQ, NT, 0, 0, 0.f, alds);
            }
            for (int u = vcu; u < 1024 + (lastl ? 0 : 128); u += G) {
                int b, h, q0row, NT, qpos0, kpos0;
                if (u >= 1024 && u < 1088) continue;
                if (u < 1024) { const int bh = u >> 4, qb = u & 15; b = bh >> 3; h = bh & 7; q0row = b * SEQ + qb * 256; qpos0 = qb * 256;
                    const int klo = qpos0 - 128 < 0 ? 0 : qpos0 - 128, khi = qpos0 + 384 > SEQ ? SEQ : qpos0 + 384; kpos0 = klo; NT = 4 + (khi - klo) / 64; }
                else { const int bh = u - 1088; b = bh >> 3; h = bh & 7; q0row = ML + b * CTXL; NT = 4; qpos0 = 0; kpos0 = 0; }
                const float sk = gqa_sink[l * 8 + h] * 1.4426950408889634f;
                att::attn_unit<64, 64, true, true, ATT_GQA_MODE>(GQ + (size_t)q0row * 512 + h * 64, 512, GK + (h >> 2) * 64, 128, GV + (h >> 2) * 64, 128, OG + (size_t)q0row * 512 + h * 64, 512,
                                                   ML + b * CTXL, b * SEQ + kpos0, NT, qpos0, kpos0, sk, alds);
            }
            __syncthreads();
        }
        GRID_BAR();

        if (RUN(5)) { PHASE_BEGIN
            pg8::SchedMerge S; S.base.init(Mg, DM, G, bx); S.base.wgm = P5_WGM;
            { const bf16* a0_ = UC; const bf16* a1_ = OM; const bf16* a2_ = OG; const bf16* b0_ = Wc_t; const bf16* b1_ = Wm_t; const bf16* b2_ = Wg_t; asm volatile("" : "+s"(a0_), "+s"(a1_), "+s"(a2_), "+s"(b0_), "+s"(b1_), "+s"(b2_));
              S.a0 = (const char*)a0_; S.da1 = (const char*)a1_ - (const char*)a0_; S.da2 = (const char*)a2_ - (const char*)a1_; S.b0 = (const char*)b0_; S.db1 = (const char*)b1_ - (const char*)b0_; S.db2 = (const char*)b2_ - (const char*)b1_; }
            pg8::EpiChain E{Gb, Yb};
            pg8::gemm_stream<pg8::EpiChain, pg8::SchedMerge, true>(lds + RING_OFF, S, E);
        }
        GRID_BAR();

        if (RUN(6)) { PHASE_BEGIN
            const bf16* A_ = Yb; const bf16* B_ = Wo_t; asm volatile("" : "+s"(A_), "+s"(B_));
            pg8::SchedSplit S; S.A = A_; S.Bt = B_; S.K = DM; S.nlat = 1024; S.nctx = lastl ? 0 : 256; S.G = G; S.c = bx; S.wgm = SPLIT_WGM;
            pg8::EpiSplit E{pg8::EpiResid{XB, modl, 2 * DM}, PART};
            pg8::gemm_stream<pg8::EpiSplit, pg8::SchedSplit>(lds + RING_OFF, S, E);
        }
        GRID_BAR();

        if (RUN(7)) { PHASE_BEGIN const float* gv = g_ffn + (size_t)l * DM; const float* pg = lastl ? nullptr : (modl + (size_t)8 * NMOD + 2 * DM);
            const int first = (l == 0) ? 2 : 0; NORM_ROWS(gv, 3 * DM, 4 * DM, first, !lastl, pg); }
        GRID_BAR();

        if (RUN(8)) { PHASE_BEGIN
            const bf16* A_ = Hb; const bf16* B_ = Wf1_t; asm volatile("" : "+s"(A_), "+s"(B_)); pg8::Gemm g{A_, B_, MT, 2 * DFF, DM}; pg8::StaticOrder S; S.init(Mg, 2 * DFF, G, bx); S.wgm = P8_WGM; pg8::EpiSwiGLU E{HID};
            pg8::gemm_phase<pg8::EpiSwiGLU, pg8::StaticOrder, true, true>(lds + RING_OFF, g, S, E);
        }
        GRID_BAR();

        if (RUN(9)) { PHASE_BEGIN
            const bf16* A_ = HID; const bf16* B_ = Wf2_t; asm volatile("" : "+s"(A_), "+s"(B_));
            pg8::SchedSplit S; S.A = A_; S.Bt = B_; S.K = DFF; S.nlat = 1024; S.nctx = lastl ? 0 : 256; S.G = G; S.c = bx; S.wgm = SPLIT_WGM;
            pg8::EpiSplit E{pg8::EpiResid{XB, modl, 5 * DM}, PART};
            pg8::gemm_stream<pg8::EpiSplit, pg8::SchedSplit>(lds + RING_OFF, S, E);
        }
        GRID_BAR();
    }

    if (RUN(PH_POST)) { PHASE_BEGIN
        f32x4 gf[8];
#pragma unroll
        for (int j = 0; j < 8; ++j) gf[j] = *(const f32x4*)(g_final + 4 * lane + 256 * j);
        for (int r = gw; r < ML; r += NGW) { float* p = XL + (size_t)r * DM + 4 * lane; const bf16* sb = XB + (size_t)r * DM + 4 * lane; f32x4 v[8]; float ss = 0.f;
#pragma unroll
            for (int j = 0; j < 8; ++j) { const v2u t_ = *(const v2u*)(sb + 256 * j); v[j] = (f32x4){bflo(t_.x), bfhi(t_.x), bflo(t_.y), bfhi(t_.y)}; ss += (v[j][0] * v[j][0] + v[j][1] * v[j][1]) + (v[j][2] * v[j][2] + v[j][3] * v[j][3]); }
            const float rstd = 1.0f / sqrtf(wave_sum(ss) * (1.0f / DM) + EPS);
#pragma unroll
            for (int j = 0; j < 8; ++j) *(f32x4*)(p + 256 * j) = v[j] * rstd * gf[j]; }
    }

#if defined(DBG_STAGE)
    if (RUN(PH_DUMP)) { PHASE_BEGIN
        const int sel = ap->pad0; const size_t total = (size_t)G * NWAVES * 64, gt = (size_t)bx * NWAVES * 64 + tid;
        for (size_t i = gt; i < (size_t)ML * DM; i += total) { float v = 0.f;
#define DB16(bit, P, N) if (sel & (bit)) v += __uint_as_float((unsigned)(P)[i % (size_t)(N)] << 16)
            if (sel & 1) v += MOD[i % (size_t)(DEPTH * 9 * NMOD)];
            DB16(2, Hb, (size_t)MT * 2048); DB16(4, Gb, (size_t)MT * 6144); DB16(8, KF, (size_t)MT * 1536); DB16(16, Vb, (size_t)MT * 1024); DB16(32, GQ, (size_t)MT * 512);
            DB16(64, UC, (size_t)MT * 512); DB16(128, MQ, (size_t)MT * 1536); DB16(256, OM, (size_t)MT * 1024); DB16(512, OG, (size_t)MT * 512); DB16(1024, Yb, (size_t)MT * 2048);
            DB16(2048, Win_t, (size_t)NINP * 2048); DB16(4096, GK, (size_t)MT * 128); DB16(8192, GV, (size_t)MT * 128); DB16(16384, CKVn, (size_t)MT * 256); DB16(32768, QAn, (size_t)MT * 512);
            DB16(65536, Ub, (size_t)MT * 512); DB16(131072, Wf1_t, (size_t)2 * DFF * DM); DB16(262144, Wf2_t, (size_t)DM * DFF); DB16(524288, HID, (size_t)MT * DFF);
            if (sel & 1048576) v += CQ[i % ((size_t)MT * 768)];
            XL[i] = v; }
    }
#endif
#undef RUN
#undef GRID_BAR
#undef NORM_ROWS
}

#ifndef MK_MULTI
#define MK_MULTI 0
#endif
extern "C" void kernel_launch(void* const* d_in, const int* in_sizes, int n_in, void* d_out, int out_size, void* d_ws, size_t ws_size, hipStream_t stream) {
    static int grid = 0;
    if (grid == 0) {
        if (n_in != 25 || in_sizes[0] != ML * DM || out_size != ML * DM || ws_size < WS_END) {
            fprintf(stderr, "kernel_launch: shape mismatch: n_in %d in0 %d out %d ws %zu (need %zu)\n", n_in, n_in > 0 ? in_sizes[0] : -1, out_size, ws_size, (size_t)WS_END); grid = -1; return; }
        int dev = 0, cus = 0, per_cu = 0;
        if (hipGetDevice(&dev) != hipSuccess || hipDeviceGetAttribute(&cus, hipDeviceAttributeMultiprocessorCount, dev) != hipSuccess) { grid = -1; return; }
        if (hipFuncSetAttribute((const void*)mega_fwd, hipFuncAttributeMaxDynamicSharedMemorySize, LDS_BYTES) != hipSuccess) { fprintf(stderr, "kernel_launch: hipFuncSetAttribute failed\n"); grid = -1; return; }
        if (hipOccupancyMaxActiveBlocksPerMultiprocessor(&per_cu, (const void*)mega_fwd, NWAVES * 64, LDS_BYTES) != hipSuccess || per_cu < 1)
            fprintf(stderr, "kernel_launch: note: occupancy query reports %d workgroups per CU\n", per_cu);
        (void)hipGetLastError();
        grid = cus;
    }
    if (grid < 0) return;
    if (hipMemsetAsync((char*)d_ws + WS_CTL, 0, CTL_ZERO_BYTES, stream) != hipSuccess) return;
    Args a{};
    for (int i = 0; i < 25; ++i) a.in[i] = (const float*)d_in[i];
    a.out = (float*)d_out; a.ws = (unsigned char*)d_ws;
#if defined(DBG_STAGE)
    a.multi = 1;
    a.l_lo = 0; a.l_hi = 0; a.ph = PH_PRE; hipLaunchKernelGGL(mega_fwd, dim3(grid), dim3(NWAVES * 64), LDS_BYTES, stream, a);
    for (int p = 0; p <= DBG_STAGE; ++p) { a.l_lo = 0; a.l_hi = 1; a.ph = p; hipLaunchKernelGGL(mega_fwd, dim3(grid), dim3(NWAVES * 64), LDS_BYTES, stream, a); }
    a.l_lo = 0; a.l_hi = 0; a.ph = PH_DUMP; a.pad0 = DBG_SEL; hipLaunchKernelGGL(mega_fwd, dim3(grid), dim3(NWAVES * 64), LDS_BYTES, stream, a);
#elif MK_MULTI
    a.multi = 1;
    a.l_lo = 0; a.l_hi = 0; a.ph = PH_PRE; hipLaunchKernelGGL(mega_fwd, dim3(grid), dim3(NWAVES * 64), LDS_BYTES, stream, a);
    for (int l = 0; l < DEPTH; ++l) for (int p = 0; p < 10; ++p) { a.l_lo = l; a.l_hi = l + 1; a.ph = p; hipLaunchKernelGGL(mega_fwd, dim3(grid), dim3(NWAVES * 64), LDS_BYTES, stream, a); }
    a.l_lo = 0; a.l_hi = 0; a.ph = PH_POST; hipLaunchKernelGGL(mega_fwd, dim3(grid), dim3(NWAVES * 64), LDS_BYTES, stream, a);
#else
    a.multi = 0; a.l_lo = 0; a.l_hi = DEPTH; a.ph = 0;
    hipLaunchKernelGGL(mega_fwd, dim3(grid), dim3(NWAVES * 64), LDS_BYTES, stream, a);
#endif
    const hipError_t le = hipPeekAtLastError();
    if (le != hipSuccess) fprintf(stderr, "kernel_launch: launch failed: %s\n", hipGetErrorName(le));
}
```

```cpp
#include <hip/hip_runtime.h>
#include <cstdio>
#include <cstdint>
#define GAS __attribute__((address_space(1)))
#define LAS __attribute__((address_space(3)))
namespace pg8 {
#define PG8_LAS __attribute__((address_space(3)))
typedef unsigned short bf16_t;
typedef short bf16x8 __attribute__((ext_vector_type(8)));
typedef float f32x4 __attribute__((ext_vector_type(4)));
typedef unsigned u32x4 __attribute__((ext_vector_type(4)));
constexpr int BM = 256, BK = 64, HALF = 128, HTB = HALF * BK * 2  , STAGE_BYTES = 8 * HTB, NXCD = 8, WGM = 8;

__host__ __device__ __forceinline__ int lds_byte(int r, int c) { const int st = (r >> 4) * 2 + (c >> 5), rr = r & 15, cc = c & 31, ob = rr * 64 + cc * 2; return st * 1024 + (ob ^ (((ob >> 9) & 1) << 5)); }
__host__ __device__ __forceinline__ void stage_rc(int b, int& R, int& C) { const int st = b / 1024, sb = b % 1024, swz = sb ^ (((sb >> 9) & 1) << 5); R = (st >> 1) * 16 + swz / 64; C = (st & 1) * 32 + (swz % 64) / 2; }
__host__ __device__ __forceinline__ int perm32(int rho) { const int n = rho >> 4, i = rho & 15; return 8 * (i >> 2) + 4 * n + (i & 3); }

struct Unit { int pm, pn; };
struct Gemm { const bf16_t* A; const bf16_t* Bt; int M, N, K; };

struct StaticOrder {
    int nM, nN, nwg, G, c, ext_n, ext_pm0, ext_pn0, ext_w, wgm, ext_c0;
    __host__ __device__ void init(int M, int N, int G_, int c_) { nM = M / BM; nN = N / BM; nwg = nM * nN; G = G_; c = c_; ext_n = 0; ext_pm0 = 0; ext_pn0 = 0; ext_w = 1; wgm = WGM; ext_c0 = 0; }
    __host__ __device__ void set_extra(int n, int pm0, int pn0, int w) { ext_n = n; ext_pm0 = pm0; ext_pn0 = pn0; ext_w = w; }
    __host__ __device__ bool next(int i, Unit& u) const {
        const long L = (long)i * G + c;
        if (L >= nwg) { const int e = (int)(L - nwg) - ext_c0; if (e < 0 || e >= ext_n) return false; u.pm = ext_pm0 + e / ext_w; u.pn = ext_pn0 + e % ext_w; return true; }
        int wgid = (int)L; { const int q = nwg / NXCD, r = nwg % NXCD, xcd = wgid % NXCD, off = wgid / NXCD; wgid = (xcd < r ? xcd * (q + 1) : r * (q + 1) + (xcd - r) * q) + off; }
        const int nig = wgm * nN, gid = wgid / nig, fm = gid * wgm, gsz = (nM - fm) < wgm ? (nM - fm) : wgm;
        u.pm = fm + ((wgid % nig) % gsz); u.pn = (wgid % nig) / gsz; return true;
    }
    static __host__ __device__ __forceinline__ void map_entry(int nM_, int nN_, int L, Unit& u, int WGM_ = WGM) {
        const int nwg_ = nM_ * nN_; int wgid = L; { const int q = nwg_ / NXCD, r = nwg_ % NXCD, xcd = wgid % NXCD, off = wgid / NXCD; wgid = (xcd < r ? xcd * (q + 1) : r * (q + 1) + (xcd - r) * q) + off; }
        const int nig = WGM_ * nN_, gid = wgid / nig, fm = gid * WGM_, gsz = (nM_ - fm) < WGM_ ? (nM_ - fm) : WGM_;
        u.pm = fm + ((wgid % nig) % gsz); u.pn = (wgid % nig) / gsz;
    }
    __device__ __forceinline__ void a_ready(const Unit&) const {}
    __device__ __forceinline__ void done(const Unit&) const {}
};
struct MergeOrder : StaticOrder {
    const unsigned* wflag; unsigned* tmo;
    __device__ __forceinline__ void a_ready(const Unit& u) const {
        if (wflag == nullptr || ext_n == 0 || u.pm < ext_pm0) return;
        if (threadIdx.x < 64) {
            const unsigned* f = wflag + (size_t)((u.pm - ext_pm0) * ext_w + (u.pn - ext_pn0)) * 16;
            const unsigned long long t0 = __builtin_amdgcn_s_memrealtime(); unsigned polls = 0;
            while ((unsigned)__builtin_amdgcn_readfirstlane(__hip_atomic_load(f, __ATOMIC_RELAXED, __HIP_MEMORY_SCOPE_AGENT)) == 0u) {
                if ((++polls & 255u) == 0u && __builtin_amdgcn_readfirstlane(__hip_atomic_load(tmo, __ATOMIC_RELAXED, __HIP_MEMORY_SCOPE_AGENT)) != 0u) break;
                if (__builtin_amdgcn_s_memrealtime() - t0 > 2000000ull) { if (threadIdx.x == 0) __hip_atomic_store(tmo, 1u, __ATOMIC_RELAXED, __HIP_MEMORY_SCOPE_AGENT); break; }
                __builtin_amdgcn_s_sleep(2); }
            __builtin_amdgcn_fence(__ATOMIC_ACQUIRE, "agent");
            asm volatile("s_waitcnt vmcnt(0)" ::: "memory");
        }
        asm volatile("" ::: "memory"); __builtin_amdgcn_s_barrier(); asm volatile("" ::: "memory");
    }
};
typedef float f32x2_t __attribute__((ext_vector_type(2))); typedef __bf16 bf16x2_t __attribute__((ext_vector_type(2)));
__device__ __forceinline__ unsigned cvt_pk_bf16(float lo, float hi) { f32x2_t v = {lo, hi}; bf16x2_t b = __builtin_convertvector(v, bf16x2_t); return __builtin_bit_cast(unsigned, b); }
typedef float f32x2 __attribute__((ext_vector_type(2)));
template <class Epi, class Sched, bool ALIGN_EPI = false, bool SP2 = false>
__device__ __forceinline__ void gemm_phase(PG8_LAS unsigned char* lds, const Gemm g, const Sched& S, const Epi& E) {
    int tid_ = threadIdx.x; asm volatile("" : "+v"(tid_));
    const int tid = tid_, wid = __builtin_amdgcn_readfirstlane(tid >> 6), lane = tid & 63, wr = wid >> 2, wc = wid & 3, fr = lane & 15, fq = lane >> 4;
    const int K = g.K, nt = K / BK;
    unsigned voffA[2], voffB[2];
#pragma unroll
    for (int i = 0; i < 2; ++i) { int R, C; stage_rc(tid * 16 + i * 8192, R, C); const int Rb = Epi::PERM ? ((R & ~31) + perm32(R & 31)) : R;
        voffA[i] = (unsigned)(R * K + C) * 2u; voffB[i] = (unsigned)(Rb * K + C) * 2u; }
    const size_t kstep = (size_t)(BK * 2);
    const size_t hstep = (size_t)HALF * K * 2;
    const size_t tstep = 2 * hstep;
    const unsigned ldsw = (unsigned)wid * 1024u;
    const int aoff = lds_byte(wr * 64 + fr, fq * 8), boff = lds_byte(wc * 32 + fr, fq * 8);
#define PG8_SA(b, h) (((b) * 2 + (h)) * HTB)
#define PG8_SB(b, h) ((4 + (b) * 2 + (h)) * HTB)
#define PG8_STAGE(bufoff, gbase, voff) do { _Pragma("unroll") for (int _i = 0; _i < 2; ++_i) \
        __builtin_amdgcn_global_load_lds((const unsigned*)((const char*)(gbase) + (voff)[_i]), (PG8_LAS unsigned*)(lds + (bufoff) + ldsw + _i * 8192), 16, 0, 0); } while (0)
#define PG8_LDA(dst, b, h) do { _Pragma("unroll") for (int m = 0; m < 4; ++m) _Pragma("unroll") for (int k = 0; k < 2; ++k) dst[m][k] = *(const PG8_LAS bf16x8*)(lds + PG8_SA(b, h) + aoff + m * 2048 + k * 1024); } while (0)
#define PG8_LDB(dst, b, h) do { _Pragma("unroll") for (int n = 0; n < 2; ++n) _Pragma("unroll") for (int k = 0; k < 2; ++k) dst[n][k] = *(const PG8_LAS bf16x8*)(lds + PG8_SB(b, h) + boff + n * 2048 + k * 1024); } while (0)
#define PG8_MMA(ai, bj, At, Bt) do { __builtin_amdgcn_s_setprio(1); _Pragma("unroll") for (int m = 0; m < 4; ++m) _Pragma("unroll") for (int n = 0; n < 2; ++n) _Pragma("unroll") for (int k = 0; k < 2; ++k) \
        acc[ai][bj][m][n] = __builtin_amdgcn_mfma_f32_16x16x32_bf16(Bt[n][k], At[m][k], acc[ai][bj][m][n], 0, 0, 0); __builtin_amdgcn_s_setprio(0); } while (0)
#define PG8_WAIT_V(n) asm volatile("s_waitcnt vmcnt(" #n ")" ::: "memory")
#define PG8_WAIT_L(n) asm volatile("s_waitcnt lgkmcnt(" #n ")" ::: "memory")
#define PG8_BAR __builtin_amdgcn_s_barrier()
#define PG8_SCHED __builtin_amdgcn_sched_barrier(0)
    Unit cur, nxt; int ui = 0;
    if (!S.next(0, cur)) return;
    f32x4 acc[2][2][4][2];
#pragma unroll
    for (int a = 0; a < 2; ++a)
#pragma unroll
        for (int b = 0; b < 2; ++b)
#pragma unroll
            for (int m = 0; m < 4; ++m)
#pragma unroll
                for (int n = 0; n < 2; ++n) acc[a][b][m][n] = (f32x4){0.f, 0.f, 0.f, 0.f};
    bf16x8 At[4][2], B0[2][2], B1[2][2];
    const char* cA = (const char*)g.A + (size_t)cur.pm * tstep; const char* cB = (const char*)g.Bt + (size_t)cur.pn * tstep;
    S.a_ready(cur);
    if constexpr (SP2) {
        PG8_STAGE(PG8_SB(0, 0), cB, voffB); PG8_STAGE(PG8_SB(0, 1), cB + hstep, voffB); PG8_STAGE(PG8_SA(0, 0), cA, voffA); PG8_STAGE(PG8_SA(0, 1), cA + hstep, voffA);
        if (wr == 1) PG8_BAR;
        PG8_WAIT_V(2); PG8_BAR;
        PG8_STAGE(PG8_SB(1, 0), cB + kstep, voffB); PG8_STAGE(PG8_SA(1, 0), cA + kstep, voffA); PG8_STAGE(PG8_SB(1, 1), cB + hstep + kstep, voffB);
        PG8_WAIT_V(6); PG8_BAR;
    } else {
        PG8_STAGE(PG8_SB(0, 0), cB, voffB); PG8_STAGE(PG8_SA(0, 0), cA, voffA); PG8_STAGE(PG8_SB(0, 1), cB + hstep, voffB); PG8_STAGE(PG8_SA(0, 1), cA + hstep, voffA);
        if (wr == 1) PG8_BAR;
        PG8_WAIT_V(4); PG8_BAR;
        PG8_STAGE(PG8_SB(1, 0), cB + kstep, voffB); PG8_STAGE(PG8_SA(1, 0), cA + kstep, voffA); PG8_STAGE(PG8_SB(1, 1), cB + hstep + kstep, voffB);
        PG8_WAIT_V(6); PG8_BAR;
    }
    for (;;) {
        const bool has_next = S.next(ui + 1, nxt);
        const char* nA = has_next ? (const char*)g.A + (size_t)nxt.pm * tstep : cA; const char* nB = has_next ? (const char*)g.Bt + (size_t)nxt.pn * tstep : cB;
#pragma nounroll
        for (int t = 0; t < nt; t += 2) {
            const bool last = (t == nt - 2);
            const char* a1 = cA + (size_t)(t + 1) * kstep;
            const char* a2 = last ? nA : cA + (size_t)(t + 2) * kstep; const char* b2 = last ? nB : cB + (size_t)(t + 2) * kstep;
            const char* a3 = a2 + kstep; const char* b3 = b2 + kstep;
            if (last && has_next) S.a_ready(nxt);
            if constexpr (SP2) {
            PG8_LDB(B0, 0, 0); PG8_LDB(B1, 0, 1); PG8_SCHED; PG8_LDA(At, 0, 0); PG8_STAGE(PG8_SA(1, 1), a1 + hstep, voffA);
            PG8_WAIT_V(8); PG8_WAIT_L(0); PG8_BAR; PG8_MMA(0, 0, At, B0); PG8_MMA(0, 1, At, B1); PG8_BAR; PG8_SCHED;
            PG8_LDA(At, 0, 1); PG8_STAGE(PG8_SB(0, 0), b2, voffB); PG8_STAGE(PG8_SB(0, 1), b2 + hstep, voffB); PG8_STAGE(PG8_SA(0, 0), a2, voffA);
            PG8_WAIT_V(8); PG8_WAIT_L(0); PG8_BAR; PG8_MMA(1, 0, At, B0); PG8_MMA(1, 1, At, B1); PG8_BAR; PG8_SCHED;
            PG8_LDB(B0, 1, 0); PG8_LDB(B1, 1, 1); PG8_SCHED; PG8_LDA(At, 1, 0); PG8_STAGE(PG8_SA(0, 1), a2 + hstep, voffA);
            PG8_WAIT_V(8); PG8_WAIT_L(0); PG8_BAR; PG8_MMA(0, 0, At, B0); PG8_MMA(0, 1, At, B1); PG8_BAR; PG8_SCHED;
            PG8_LDA(At, 1, 1); PG8_STAGE(PG8_SB(1, 0), b3, voffB); PG8_STAGE(PG8_SB(1, 1), b3 + hstep, voffB); PG8_STAGE(PG8_SA(1, 0), a3, voffA);
            PG8_WAIT_V(8); PG8_WAIT_L(0); PG8_BAR; PG8_MMA(1, 0, At, B0); PG8_MMA(1, 1, At, B1); PG8_BAR; PG8_SCHED;
            } else {
            PG8_LDB(B0, 0, 0); PG8_SCHED; PG8_LDA(At, 0, 0); PG8_STAGE(PG8_SA(1, 1), a1 + hstep, voffA);
            PG8_WAIT_L(8); PG8_BAR; PG8_WAIT_L(0); PG8_MMA(0, 0, At, B0); PG8_BAR; PG8_SCHED;
            PG8_LDB(B1, 0, 1); PG8_STAGE(PG8_SB(0, 0), b2, voffB);
            PG8_BAR; PG8_WAIT_L(0); PG8_MMA(0, 1, At, B1); PG8_BAR;
            PG8_LDA(At, 0, 1); PG8_STAGE(PG8_SA(0, 0), a2, voffA);
            PG8_BAR; PG8_WAIT_L(0); PG8_MMA(1, 0, At, B0); PG8_BAR; PG8_SCHED;
            PG8_STAGE(PG8_SB(0, 1), b2 + hstep, voffB);
            PG8_WAIT_V(6); PG8_BAR; PG8_MMA(1, 1, At, B1); PG8_BAR;
            PG8_LDB(B0, 1, 0); PG8_SCHED; PG8_LDA(At, 1, 0); PG8_STAGE(PG8_SA(0, 1), a2 + hstep, voffA);
            PG8_WAIT_L(8); PG8_BAR; PG8_WAIT_L(0); PG8_MMA(0, 0, At, B0); PG8_BAR; PG8_SCHED;
            PG8_LDB(B1, 1, 1); PG8_STAGE(PG8_SB(1, 0), b3, voffB);
            PG8_BAR; PG8_WAIT_L(0); PG8_MMA(0, 1, At, B1); PG8_BAR;
            PG8_LDA(At, 1, 1); PG8_STAGE(PG8_SA(1, 0), a3, voffA);
            PG8_BAR; PG8_WAIT_L(0); PG8_MMA(1, 0, At, B0); PG8_BAR; PG8_SCHED;
            PG8_STAGE(PG8_SB(1, 1), b3 + hstep, voffB);
            PG8_WAIT_V(6); PG8_BAR; PG8_MMA(1, 1, At, B1); PG8_BAR;
            }
        }
        if constexpr (ALIGN_EPI) { if (wr == 0) PG8_BAR; }
        if constexpr (!Epi::AFTER_DRAIN) { E(acc, cur, wr, wc, fr, fq); S.done(cur); }
        if (!has_next) break;
#pragma unroll
        for (int a = 0; a < 2; ++a)
#pragma unroll
            for (int b = 0; b < 2; ++b)
#pragma unroll
                for (int m = 0; m < 4; ++m)
#pragma unroll
                    for (int n = 0; n < 2; ++n) acc[a][b][m][n] = (f32x4){0.f, 0.f, 0.f, 0.f};
        cur = nxt; cA = nA; cB = nB; ++ui;
        if constexpr (ALIGN_EPI) { if (wr == 1) PG8_BAR; }
    }
    PG8_WAIT_V(0);
    if constexpr (!ALIGN_EPI) { if (wr == 0) PG8_BAR; }
    PG8_BAR;
    if constexpr (Epi::AFTER_DRAIN) { E.fused(acc, cur, wr, wc, fr, fq, lds, wid, lane); S.done(cur); }
#undef PG8_SA
#undef PG8_SB
#undef PG8_STAGE
#undef PG8_LDA
#undef PG8_LDB
#undef PG8_MMA
#undef PG8_WAIT_V
#undef PG8_WAIT_L
#undef PG8_BAR
#undef PG8_SCHED
}
}
namespace pg8 {
typedef unsigned u32x2 __attribute__((ext_vector_type(2)));
constexpr int ML_ROWS = 32768;
__device__ __forceinline__ float sigm(float x) { return __builtin_amdgcn_rcpf(1.0f + __builtin_amdgcn_exp2f(-1.4426950408889634f * x)); }
__device__ __forceinline__ u32x2 pack4(const f32x4 v) { u32x2 w; w.x = cvt_pk_bf16(v[0], v[1]); w.y = cvt_pk_bf16(v[2], v[3]); return w; }
__device__ __forceinline__ void rope4(f32x4& x0, f32x4& x1, const float* rope, int row, int half, int fq) {
    const int t = row & 4095, p = half ? (t & 63) : (t >> 6);
    const f32x4* tp = (const f32x4*)(rope + (p * 16 + 4 * fq) * 2);
    const f32x4 a = tp[0], b = tp[1];
    const f32x4 c = {a[0], a[2], b[0], b[2]}, s = {a[1], a[3], b[1], b[3]};
    const f32x4 y0 = x0 * c - x1 * s, y1 = x1 * c + x0 * s;
    x0 = y0; x1 = y1;
}
struct EpiWin {
    static constexpr bool PERM = false, AFTER_DRAIN = false;
    unsigned char* G; bf16_t* CQ; bf16_t* KF; bf16_t* GK; bf16_t* GV; bf16_t* GQ; bf16_t* U; const float* rope;
    __device__ __forceinline__ void operator()(const f32x4 (&acc)[2][2][4][2], const Unit& u, int wr, int wc, int fr, int fq) const {
        const int row0 = u.pm * BM + wr * 64 + fr; const bool lat = u.pm < (ML_ROWS / BM);
#pragma unroll
        for (int bj = 0; bj < 2; ++bj) {
            const int colg = u.pn * BM + bj * HALF + wc * 32;
            if (colg < 6144) {
#pragma unroll
                for (int ai = 0; ai < 2; ++ai)
#pragma unroll
                    for (int m = 0; m < 4; ++m) { const size_t row = (size_t)(row0 + ai * HALF + m * 16);
#pragma unroll
                        for (int n = 0; n < 2; ++n) { const f32x4 v = acc[ai][bj][m][n];
#define SG8(x) ((unsigned)(__builtin_amdgcn_rcpf(1.0f + __builtin_amdgcn_exp2f(x)) * 255.0f + 0.5f))
                            const unsigned q0 = SG8(v[0]), q1 = SG8(v[1]), q2 = SG8(v[2]), q3 = SG8(v[3]);
#undef SG8
                            *(unsigned*)(G + row * 6144 + colg + 16 * n + 4 * fq) = q0 | (q1 << 8) | (q2 << 16) | (q3 << 24); } }
            } else {
                const int o = colg - 6144;
                if (o < 256 || (o >= 576 && o < 1088)) {
                    const int co = (o < 256) ? o : (256 + o - 576);
#pragma unroll
                    for (int ai = 0; ai < 2; ++ai)
#pragma unroll
                        for (int m = 0; m < 4; ++m) { const size_t row = (size_t)(row0 + ai * HALF + m * 16);
#pragma unroll
                            for (int n = 0; n < 2; ++n) *(u32x2*)(CQ + row * 768 + co + 16 * n + 4 * fq) = pack4(acc[ai][bj][m][n]); }
                } else if (o < 320) {
                    const int half = (o - 256) >> 5;
#pragma unroll
                    for (int ai = 0; ai < 2; ++ai)
#pragma unroll
                        for (int m = 0; m < 4; ++m) { const int r = row0 + ai * HALF + m * 16; f32x4 x0 = acc[ai][bj][m][0], x1 = acc[ai][bj][m][1];
                            if (lat) rope4(x0, x1, rope, r, half, fq);
                            const u32x2 w0 = pack4(x0), w1 = pack4(x1); bf16_t* p = KF + (size_t)r * 1536 + 128 + (o - 256) + 4 * fq;
#pragma unroll
                            for (int h = 0; h < 8; ++h) { *(u32x2*)(p + h * 192) = w0; *(u32x2*)(p + h * 192 + 16) = w1; } }
                } else if (o < 448 || (o >= 1088 && o < 1600)) {
                    const bool isk = o < 448; const int co = isk ? (o - 320) : (o - 1088); const int half = (co >> 5) & 1;
                    bf16_t* base = isk ? GK : GQ; const int ld = isk ? 128 : 512;
#pragma unroll
                    for (int ai = 0; ai < 2; ++ai)
#pragma unroll
                        for (int m = 0; m < 4; ++m) { const int r = row0 + ai * HALF + m * 16; f32x4 x0 = acc[ai][bj][m][0], x1 = acc[ai][bj][m][1];
                            if (lat) rope4(x0, x1, rope, r, half, fq);
                            bf16_t* p = base + (size_t)r * ld + co + 4 * fq; *(u32x2*)p = pack4(x0); *(u32x2*)(p + 16) = pack4(x1); }
                } else if (o < 576) {
#pragma unroll
                    for (int ai = 0; ai < 2; ++ai)
#pragma unroll
                        for (int m = 0; m < 4; ++m) { const size_t row = (size_t)(row0 + ai * HALF + m * 16); bf16_t* p = GV + row * 128 + (o - 448) + 4 * fq;
                            *(u32x2*)p = pack4(acc[ai][bj][m][0]); *(u32x2*)(p + 16) = pack4(acc[ai][bj][m][1]); }
                } else if (o < 2624) {
                    const int g = (o - 1600) >> 5;
#pragma unroll
                    for (int ai = 0; ai < 2; ++ai)
#pragma unroll
                        for (int m = 0; m < 4; ++m) { const size_t row = (size_t)(row0 + ai * HALF + m * 16); const f32x4 a = acc[ai][bj][m][0], b = acc[ai][bj][m][1];
                            const f32x4 uu = {a[0] * sigm(b[0]), a[1] * sigm(b[1]), a[2] * sigm(b[2]), a[3] * sigm(b[3])};
                            *(u32x2*)(U + row * 512 + 16 * g + 4 * fq) = pack4(uu); }
                }
            }
        }
    }
};
struct EpiQup {
    static constexpr bool PERM = false, AFTER_DRAIN = false;
    bf16_t* MQ; const float* rope;
    __device__ __forceinline__ void operator()(const f32x4 (&acc)[2][2][4][2], const Unit& u, int wr, int wc, int fr, int fq) const {
        const int row0 = u.pm * BM + wr * 64 + fr; const bool lat = u.pm < (ML_ROWS / BM);
#pragma unroll
        for (int bj = 0; bj < 2; ++bj) {
            const int colg = u.pn * BM + bj * HALF + wc * 32, hd = colg % 192; const bool isr = hd >= 128; const int half = (hd - 128) >> 5;
#pragma unroll
            for (int ai = 0; ai < 2; ++ai)
#pragma unroll
                for (int m = 0; m < 4; ++m) { const int r = row0 + ai * HALF + m * 16; f32x4 x0 = acc[ai][bj][m][0], x1 = acc[ai][bj][m][1];
                    if (isr && lat) rope4(x0, x1, rope, r, half, fq);
                    bf16_t* p = MQ + (size_t)r * 1536 + colg + 4 * fq; *(u32x2*)p = pack4(x0); *(u32x2*)(p + 16) = pack4(x1); }
        }
    }
};
struct EpiKV {
    static constexpr bool PERM = true, AFTER_DRAIN = false;
    bf16_t* KF; bf16_t* V;
    __device__ __forceinline__ void operator()(const f32x4 (&acc)[2][2][4][2], const Unit& u, int wr, int wc, int fr, int fq) const {
        const int row0 = u.pm * BM + wr * 64 + fr, c0 = wc * 32 + 8 * fq;
#pragma unroll
        for (int ai = 0; ai < 2; ++ai)
#pragma unroll
            for (int m = 0; m < 4; ++m) { const size_t row = (size_t)(row0 + ai * HALF + m * 16);
#pragma unroll
                for (int bj = 0; bj < 2; ++bj) { const f32x4 v0 = acc[ai][bj][m][0], v1 = acc[ai][bj][m][1];
                    u32x4 w; w.x = cvt_pk_bf16(v0[0], v0[1]); w.y = cvt_pk_bf16(v0[2], v0[3]); w.z = cvt_pk_bf16(v1[0], v1[1]); w.w = cvt_pk_bf16(v1[2], v1[3]);
                    if (bj == 0) *(u32x4*)(KF + row * 1536 + u.pn * 192 + c0) = w; else *(u32x4*)(V + row * 1024 + u.pn * 128 + c0) = w; } }
    }
};
template <int STEP> struct EpiMerge {
    static constexpr bool PERM = true, AFTER_DRAIN = false;
    const unsigned char* G; bf16_t* YF; bf16_t* Y; int wt_pm;
    __device__ __forceinline__ void operator()(const f32x4 (&acc)[2][2][4][2], const Unit& u, int wr, int wc, int fr, int fq) const {
        constexpr int NBATCH = 4;
        const int row0 = u.pm * BM + wr * 64 + fr, col0 = u.pn * BM + wc * 32 + 8 * fq;
        bf16_t* dst = (STEP < 2) ? YF : Y;
        const bool wt = (STEP < 2) && (u.pm >= wt_pm);
#pragma unroll
        for (int ai = 0; ai < 2; ++ai)
#pragma unroll
            for (int mb = 0; mb < 4; mb += NBATCH) {
                u32x2 gw[NBATCH][2]; u32x4 yv[NBATCH][2];
#pragma unroll
                for (int q = 0; q < NBATCH; ++q) { const size_t row = (size_t)(row0 + ai * HALF + (mb + q) * 16);
#pragma unroll
                    for (int bj = 0; bj < 2; ++bj) { const int c = col0 + bj * HALF;
                        gw[q][bj] = *(const u32x2*)(G + row * 6144 + STEP * 2048 + c);
                        if (STEP > 0) yv[q][bj] = *(const u32x4*)(YF + row * 2048 + c); } }
#pragma unroll
                for (int q = 0; q < NBATCH; ++q) { const size_t row = (size_t)(row0 + ai * HALF + (mb + q) * 16); const int m = mb + q;
#pragma unroll
                    for (int bj = 0; bj < 2; ++bj) { const int c = col0 + bj * HALF; const u32x2 g2 = gw[q][bj]; constexpr float I255 = 1.0f / 255.0f;
                        const f32x4 g0 = {(float)(g2.x & 255u) * I255, (float)((g2.x >> 8) & 255u) * I255, (float)((g2.x >> 16) & 255u) * I255, (float)(g2.x >> 24) * I255};
                        const f32x4 g1 = {(float)(g2.y & 255u) * I255, (float)((g2.y >> 8) & 255u) * I255, (float)((g2.y >> 16) & 255u) * I255, (float)(g2.y >> 24) * I255};
                        f32x4 a0 = acc[ai][bj][m][0] * g0, a1 = acc[ai][bj][m][1] * g1;
                        if (STEP > 0) { const u32x4 y4 = yv[q][bj];
                            a0 += (f32x4){__uint_as_float(y4.x << 16), __uint_as_float(y4.x & 0xffff0000u), __uint_as_float(y4.y << 16), __uint_as_float(y4.y & 0xffff0000u)};
                            a1 += (f32x4){__uint_as_float(y4.z << 16), __uint_as_float(y4.z & 0xffff0000u), __uint_as_float(y4.w << 16), __uint_as_float(y4.w & 0xffff0000u)}; }
                        u32x4 w; w.x = cvt_pk_bf16(a0[0], a0[1]); w.y = cvt_pk_bf16(a0[2], a0[3]); w.z = cvt_pk_bf16(a1[0], a1[1]); w.w = cvt_pk_bf16(a1[2], a1[3]);
                        if (wt) asm volatile("global_store_dwordx4 %0, %1, off sc1" :: "v"(dst + row * 2048 + c), "v"(w) : "memory");
                        else *(u32x4*)(dst + row * 2048 + c) = w; } }
                asm volatile("" ::: "memory"); }
    }
};
struct EpiResid {
    static constexpr bool PERM = true, AFTER_DRAIN = false;
    bf16_t* XB; const float* modl; int goff;
    __device__ __forceinline__ void operator()(const f32x4 (&acc)[2][2][4][2], const Unit& u, int wr, int wc, int fr, int fq) const {
        const int sel = u.pm >> 4;
        const int col0 = u.pn * BM + wc * 32 + 8 * fq; const float* gt = modl + sel * 12288 + goff + col0;
        bf16_t* base = XB + (size_t)(u.pm * BM + wr * 64 + fr) * 2048;
        f32x4 gv[2][2];
#pragma unroll
        for (int bj = 0; bj < 2; ++bj)
#pragma unroll
            for (int n = 0; n < 2; ++n) gv[bj][n] = *(const f32x4*)(gt + bj * HALF + n * 4);
#pragma unroll
        for (int ai = 0; ai < 2; ++ai) {
            u32x4 xr[4][2];
#pragma unroll
            for (int m = 0; m < 4; ++m) { const bf16_t* rowp = base + (size_t)(ai * HALF + m * 16) * 2048 + col0;
#pragma unroll
                for (int bj = 0; bj < 2; ++bj) xr[m][bj] = *(const u32x4*)(rowp + bj * HALF); }
#pragma unroll
            for (int m = 0; m < 4; ++m) { bf16_t* rowp = base + (size_t)(ai * HALF + m * 16) * 2048 + col0;
#pragma unroll
                for (int bj = 0; bj < 2; ++bj) { const u32x4 t = xr[m][bj];
                    const f32x4 x0 = {__uint_as_float(t.x << 16), __uint_as_float(t.x & 0xffff0000u), __uint_as_float(t.y << 16), __uint_as_float(t.y & 0xffff0000u)};
                    const f32x4 x1 = {__uint_as_float(t.z << 16), __uint_as_float(t.z & 0xffff0000u), __uint_as_float(t.w << 16), __uint_as_float(t.w & 0xffff0000u)};
                    const u32x2 w0 = pack4(x0 + gv[bj][0] * acc[ai][bj][m][0]), w1 = pack4(x1 + gv[bj][1] * acc[ai][bj][m][1]);
                    u32x4 w; w.x = w0.x; w.y = w0.y; w.z = w1.x; w.w = w1.y; *(u32x4*)(rowp + bj * HALF) = w; } }
            asm volatile("" ::: "memory"); }
    }
};
struct EpiSwiGLU {
    static constexpr bool PERM = true, AFTER_DRAIN = false;
    bf16_t* HID;
    __device__ __forceinline__ void operator()(const f32x4 (&acc)[2][2][4][2], const Unit& u, int wr, int wc, int fr, int fq) const {
        const int row0 = u.pm * BM + wr * 64 + fr, h0 = u.pn * 128 + wc * 32 + 8 * fq;
#pragma unroll
        for (int ai = 0; ai < 2; ++ai)
#pragma unroll
            for (int m = 0; m < 4; ++m) { bf16_t* rowp = HID + (size_t)(row0 + ai * HALF + m * 16) * 5632 + h0;
                u32x2 w2[2];
#pragma unroll
                for (int n = 0; n < 2; ++n) { const f32x4 a = acc[ai][0][m][n], b = acc[ai][1][m][n];
                    const f32x4 h = {a[0] * sigm(a[0]) * b[0], a[1] * sigm(a[1]) * b[1], a[2] * sigm(a[2]) * b[2], a[3] * sigm(a[3]) * b[3]};
                    w2[n] = pack4(h); }
                u32x4 w; w.x = w2[0].x; w.y = w2[0].y; w.z = w2[1].x; w.w = w2[1].y; *(u32x4*)rowp = w; }
    }
};
}
namespace pg8 {
struct UnitX { int pm, pn, kind; };
template <class Epi, class Sched, bool CHAIN = false>
__device__ __forceinline__ void gemm_stream(PG8_LAS unsigned char* lds, const Sched& S, const Epi& E) {
    int tid_ = threadIdx.x; asm volatile("" : "+v"(tid_));
    const int tid = tid_, wid = __builtin_amdgcn_readfirstlane(tid >> 6), lane = tid & 63, wr = wid >> 2, wc = wid & 3, fr = lane & 15, fq = lane >> 4;
    int Rn, Rp, C2; { int R, C; stage_rc(tid * 16, R, C); Rn = R; Rp = (R & ~31) + perm32(R & 31); C2 = C * 2; }
    const size_t kstep = (size_t)(BK * 2);
    const unsigned ldsw = (unsigned)wid * 1024u;
    const int aoff = lds_byte(wr * 64 + fr, fq * 8), boff = lds_byte(wc * 32 + fr, fq * 8);
#define PG8_SA(b, h) (((b) * 2 + (h)) * HTB)
#define PG8_SB(b, h) ((4 + (b) * 2 + (h)) * HTB)
#define PG8_STAGE(bufoff, gbase, voff, r64) do { \
        __builtin_amdgcn_global_load_lds((const unsigned*)((const char*)(gbase) + (voff)), (PG8_LAS unsigned*)(lds + (bufoff) + ldsw), 16, 0, 0); \
        __builtin_amdgcn_global_load_lds((const unsigned*)((const char*)(gbase) + (r64) + (voff)), (PG8_LAS unsigned*)(lds + (bufoff) + ldsw + 8192), 16, 0, 0); } while (0)
#define PG8_LDA(dst, b, h) do { _Pragma("unroll") for (int m = 0; m < 4; ++m) _Pragma("unroll") for (int k = 0; k < 2; ++k) dst[m][k] = *(const PG8_LAS bf16x8*)(lds + PG8_SA(b, h) + aoff + m * 2048 + k * 1024); } while (0)
#define PG8_LDB(dst, b, h) do { _Pragma("unroll") for (int n = 0; n < 2; ++n) _Pragma("unroll") for (int k = 0; k < 2; ++k) dst[n][k] = *(const PG8_LAS bf16x8*)(lds + PG8_SB(b, h) + boff + n * 2048 + k * 1024); } while (0)
#define PG8_MMA(ai, bj, At, Bt) do { __builtin_amdgcn_s_setprio(1); _Pragma("unroll") for (int m = 0; m < 4; ++m) _Pragma("unroll") for (int n = 0; n < 2; ++n) _Pragma("unroll") for (int k = 0; k < 2; ++k) \
        acc[ai][bj][m][n] = __builtin_amdgcn_mfma_f32_16x16x32_bf16(Bt[n][k], At[m][k], acc[ai][bj][m][n], 0, 0, 0); __builtin_amdgcn_s_setprio(0); } while (0)
#define PG8_WAIT_V(n) asm volatile("s_waitcnt vmcnt(" #n ")" ::: "memory")
#define PG8_WAIT_L(n) asm volatile("s_waitcnt lgkmcnt(" #n ")" ::: "memory")
#define PG8_BAR __builtin_amdgcn_s_barrier()
#define PG8_SCHED __builtin_amdgcn_sched_barrier(0)
    UnitX cur, nxt; int ui = 0;
    if (!S.next(0, cur)) return;
    f32x4 acc[2][2][4][2];
#pragma unroll
    for (int a = 0; a < 2; ++a)
#pragma unroll
        for (int b = 0; b < 2; ++b)
#pragma unroll
            for (int m = 0; m < 4; ++m)
#pragma unroll
                for (int n = 0; n < 2; ++n) acc[a][b][m][n] = (f32x4){0.f, 0.f, 0.f, 0.f};
    bf16x8 At[4][2], B0[2][2], B1[2][2];
    int K2 = S.gPitch(cur.kind) * 2;
    unsigned voA = (unsigned)(Rn * K2 + C2), voB = (unsigned)((S.gPerm(cur.kind) ? Rp : Rn) * K2 + C2);
    size_t r64 = (size_t)64 * K2, hstep = (size_t)HALF * K2;
    int nt = S.gNt(cur.kind);
    const char* cA = (const char*)S.gA(cur.kind) + (size_t)cur.pm * 2 * hstep + (size_t)S.gK0(cur.kind) * 2; const char* cB = (const char*)S.gB(cur.kind) + (size_t)cur.pn * 2 * hstep + (size_t)S.gK0(cur.kind) * 2;
    PG8_STAGE(PG8_SB(0, 0), cB, voB, r64); PG8_STAGE(PG8_SB(0, 1), cB + hstep, voB, r64); PG8_STAGE(PG8_SA(0, 0), cA, voA, r64); PG8_STAGE(PG8_SA(0, 1), cA + hstep, voA, r64);
    if (wr == 1) PG8_BAR;
    PG8_WAIT_V(2); PG8_BAR;
    PG8_STAGE(PG8_SB(1, 0), cB + kstep, voB, r64); PG8_STAGE(PG8_SA(1, 0), cA + kstep, voA, r64); PG8_STAGE(PG8_SB(1, 1), cB + hstep + kstep, voB, r64);
    PG8_WAIT_V(6); PG8_BAR;
    for (;;) {
        const bool has_next = S.next(ui + 1, nxt);
        const int nkind = has_next ? nxt.kind : cur.kind;
        const int nK2 = S.gPitch(nkind) * 2;
        const unsigned nvoA = (unsigned)(Rn * nK2 + C2), nvoB = (unsigned)((S.gPerm(nkind) ? Rp : Rn) * nK2 + C2);
        const size_t nr64 = (size_t)64 * nK2, nhstep = (size_t)HALF * nK2;
        const char* nA = has_next ? (const char*)S.gA(nkind) + (size_t)nxt.pm * 2 * nhstep + (size_t)S.gK0(nkind) * 2 : cA; const char* nB = has_next ? (const char*)S.gB(nkind) + (size_t)nxt.pn * 2 * nhstep + (size_t)S.gK0(nkind) * 2 : cB;
#pragma nounroll
        for (int t = 0; t < nt; t += 2) {
            const bool last = (t == nt - 2);
            const char* a1 = cA + (size_t)(t + 1) * kstep;
            const char* a2 = last ? nA : cA + (size_t)(t + 2) * kstep; const char* b2 = last ? nB : cB + (size_t)(t + 2) * kstep;
            const char* a3 = a2 + kstep; const char* b3 = b2 + kstep;
            const unsigned vA2 = last ? nvoA : voA, vB2 = last ? nvoB : voB; const size_t r2 = last ? nr64 : r64, h2 = last ? nhstep : hstep;
            PG8_LDB(B0, 0, 0); PG8_LDB(B1, 0, 1); PG8_SCHED; PG8_LDA(At, 0, 0); PG8_STAGE(PG8_SA(1, 1), a1 + hstep, voA, r64);
            PG8_WAIT_V(8); PG8_WAIT_L(0); PG8_BAR; PG8_MMA(0, 0, At, B0); PG8_MMA(0, 1, At, B1); PG8_BAR; PG8_SCHED;
            PG8_LDA(At, 0, 1); PG8_STAGE(PG8_SB(0, 0), b2, vB2, r2); PG8_STAGE(PG8_SB(0, 1), b2 + h2, vB2, r2); PG8_STAGE(PG8_SA(0, 0), a2, vA2, r2);
            PG8_WAIT_V(8); PG8_WAIT_L(0); PG8_BAR; PG8_MMA(1, 0, At, B0); PG8_MMA(1, 1, At, B1); PG8_BAR; PG8_SCHED;
            PG8_LDB(B0, 1, 0); PG8_LDB(B1, 1, 1); PG8_SCHED; PG8_LDA(At, 1, 0); PG8_STAGE(PG8_SA(0, 1), a2 + h2, vA2, r2);
            PG8_WAIT_V(8); PG8_WAIT_L(0); PG8_BAR; PG8_MMA(0, 0, At, B0); PG8_MMA(0, 1, At, B1); PG8_BAR; PG8_SCHED;
            PG8_LDA(At, 1, 1); PG8_STAGE(PG8_SB(1, 0), b3, vB2, r2); PG8_STAGE(PG8_SB(1, 1), b3 + h2, vB2, r2); PG8_STAGE(PG8_SA(1, 0), a3, vA2, r2);
            PG8_WAIT_V(8); PG8_WAIT_L(0); PG8_BAR; PG8_MMA(1, 0, At, B0); PG8_MMA(1, 1, At, B1); PG8_BAR; PG8_SCHED;
        }
        if (wr == 0) PG8_BAR;
        if constexpr (CHAIN) E.chain(acc, cur.pm, cur.pn, cur.kind, wr, wc, fr, fq); else E(acc, cur.pm, cur.pn, cur.kind, wr, wc, fr, fq);
        if (!has_next) break;
        bool clr_ = true; if constexpr (CHAIN) clr_ = (cur.kind == Epi::LAST_KIND);
        if (clr_)
#pragma unroll
        for (int a = 0; a < 2; ++a)
#pragma unroll
            for (int b = 0; b < 2; ++b)
#pragma unroll
                for (int m = 0; m < 4; ++m)
#pragma unroll
                    for (int n = 0; n < 2; ++n) acc[a][b][m][n] = (f32x4){0.f, 0.f, 0.f, 0.f};
        cur.pm = nxt.pm; cur.pn = nxt.pn; cur.kind = nxt.kind; cA = nA; cB = nB; K2 = nK2; voA = nvoA; voB = nvoB; r64 = nr64; hstep = nhstep; nt = S.gNt(nkind); ++ui;
        if (wr == 1) PG8_BAR;
    }
    PG8_WAIT_V(0);
    PG8_BAR;
#undef PG8_SA
#undef PG8_SB
#undef PG8_STAGE
#undef PG8_LDA
#undef PG8_LDB
#undef PG8_MMA
#undef PG8_WAIT_V
#undef PG8_WAIT_L
#undef PG8_BAR
#undef PG8_SCHED
}
struct SchedMerge {
    StaticOrder base; const char* a0; long da1, da2; const char* b0; long db1, db2;
    __device__ __forceinline__ bool next(int i, UnitX& u) const { Unit b; const int q = i / 3; const bool ok = base.next(q, b); u.pm = b.pm; u.pn = b.pn; u.kind = i - 3 * q; return ok; }
    __device__ __forceinline__ const bf16_t* gA(int k) const { return (const bf16_t*)(a0 + (k > 0 ? da1 : 0l) + (k > 1 ? da2 : 0l)); }
    __device__ __forceinline__ const bf16_t* gB(int k) const { return (const bf16_t*)(b0 + (k > 0 ? db1 : 0l) + (k > 1 ? db2 : 0l)); }
    __device__ __forceinline__ int gPitch(int k) const { return k == 1 ? 1024 : 512; }
    __device__ __forceinline__ int gNt(int k) const { return k == 1 ? 16 : 8; }
    __device__ __forceinline__ int gK0(int) const { return 0; }
    __device__ __forceinline__ int gPerm(int) const { return 1; }
};
struct EpiMergeAll {
    EpiMerge<0> e0; EpiMerge<1> e1; EpiMerge<2> e2;
    __device__ __forceinline__ void operator()(const f32x4 (&acc)[2][2][4][2], int pm, int pn, int kind, int wr, int wc, int fr, int fq) const {
        Unit u; u.pm = pm; u.pn = pn;
        if (kind == 0) e0(acc, u, wr, wc, fr, fq); else if (kind == 1) e1(acc, u, wr, wc, fr, fq); else e2(acc, u, wr, wc, fr, fq);
    }
};
struct EpiChain {
    static constexpr int LAST_KIND = 2;
    const unsigned char* G; bf16_t* Y;
    __device__ __forceinline__ void chain(f32x4 (&acc)[2][2][4][2], int pm, int pn, int kind, int wr, int wc, int fr, int fq) const {
        const int row0 = pm * BM + wr * 64 + fr, col0 = pn * BM + wc * 32 + 8 * fq;
        const unsigned char* ga = G + (kind == 2 ? 2 : kind) * 2048; const unsigned char* gb = G + (kind == 0 ? 1 : 2) * 2048;
#pragma unroll
        for (int ai = 0; ai < 2; ++ai) {
            u32x2 qa[4][2], qb[4][2];
#pragma unroll
            for (int m = 0; m < 4; ++m) { const size_t row = (size_t)(row0 + ai * HALF + m * 16);
#pragma unroll
                for (int bj = 0; bj < 2; ++bj) { const int c = col0 + bj * HALF; qa[m][bj] = *(const u32x2*)(ga + row * 6144 + c); qb[m][bj] = *(const u32x2*)(gb + row * 6144 + c); } }
#pragma unroll
            for (int m = 0; m < 4; ++m) { const size_t row = (size_t)(row0 + ai * HALF + m * 16);
#pragma unroll
                for (int bj = 0; bj < 2; ++bj) { const int c = col0 + bj * HALF;
                    f32x4 r[2];
#pragma unroll
                    for (int n = 0; n < 2; ++n) { const unsigned wa = n == 0 ? qa[m][bj].x : qa[m][bj].y, wb = n == 0 ? qb[m][bj].x : qb[m][bj].y;
#pragma unroll
                        for (int e = 0; e < 4; ++e) { const unsigned a8 = (wa >> (8 * e)) & 255u, b8 = (wb >> (8 * e)) & 255u;
                            const float fa = (float)(kind == 0 ? a8 : (a8 > 1u ? a8 : 1u)), fb = (float)(b8 > 1u ? b8 : 1u);
                            r[n][e] = (kind == 2) ? fa * (1.0f / 255.0f) : fa * __builtin_amdgcn_rcpf(fb); } }
                    acc[ai][bj][m][0] *= r[0]; acc[ai][bj][m][1] *= r[1];
                    if (kind == 2) { const f32x4 a0 = acc[ai][bj][m][0], a1 = acc[ai][bj][m][1];
                        u32x4 w; w.x = cvt_pk_bf16(a0[0], a0[1]); w.y = cvt_pk_bf16(a0[2], a0[3]); w.z = cvt_pk_bf16(a1[0], a1[1]); w.w = cvt_pk_bf16(a1[2], a1[3]);
                        *(u32x4*)(Y + row * 2048 + c) = w; } } }
            asm volatile("" ::: "memory"); }
    }
};
struct SchedQKV {
    int nMq, nNq, nMk, nNk, G, c; const bf16_t* Aq; const bf16_t* Bq; const bf16_t* Ak; const bf16_t* Bk;
    __device__ __forceinline__ bool next(int i, UnitX& u) const {
        const int L = i * G + c, nq = nMq * nNq;
        Unit b; b.pm = 0; b.pn = 0; bool ok = true; int kind = 0;
        if (L < nq) StaticOrder::map_entry(nMq, nNq, L, b);
        else { const int L2 = L - nq; kind = 1; ok = L2 < nMk * nNk; if (ok) StaticOrder::map_entry(nMk, nNk, L2, b); }
        u.pm = b.pm; u.pn = b.pn; u.kind = kind; return ok;
    }
    __device__ __forceinline__ const bf16_t* gA(int k) const { return k == 0 ? Aq : Ak; }
    __device__ __forceinline__ const bf16_t* gB(int k) const { return k == 0 ? Bq : Bk; }
    __device__ __forceinline__ int gPitch(int k) const { return k == 0 ? 512 : 256; }
    __device__ __forceinline__ int gNt(int k) const { return k == 0 ? 8 : 4; }
    __device__ __forceinline__ int gK0(int) const { return 0; }
    __device__ __forceinline__ int gPerm(int k) const { return k; }
};
struct EpiQKV {
    EpiQup eq; EpiKV ek;
    __device__ __forceinline__ void operator()(const f32x4 (&acc)[2][2][4][2], int pm, int pn, int kind, int wr, int wc, int fr, int fq) const {
        Unit u; u.pm = pm; u.pn = pn;
        if (kind == 0) eq(acc, u, wr, wc, fr, fq); else ek(acc, u, wr, wc, fr, fq);
    }
};
struct SchedSplit {
    const bf16_t* A; const bf16_t* Bt; int K, nlat, nctx, G, c, wgm;
    __device__ __forceinline__ bool next(int i, UnitX& u) const {
        const int L = i * G + c; Unit b; b.pm = 0; b.pn = 0; int kind = 0; bool ok = true;
        if (L < nlat) StaticOrder::map_entry(ML_ROWS / BM, 8, L, b, wgm);
        else { const int e = L - nlat; ok = e < nctx; b.pm = ML_ROWS / BM + (e >> 5); b.pn = (e >> 2) & 7; kind = 1 + (e & 3); }
        u.pm = b.pm; u.pn = b.pn; u.kind = kind; return ok;
    }
    __device__ __forceinline__ const bf16_t* gA(int) const { return A; }
    __device__ __forceinline__ const bf16_t* gB(int) const { return Bt; }
    __device__ __forceinline__ int gPitch(int) const { return K; }
    __device__ __forceinline__ int gNt(int k) const { return k == 0 ? K / BK : K / (4 * BK); }
    __device__ __forceinline__ int gK0(int k) const { return k == 0 ? 0 : (k - 1) * (K / 4); }
    __device__ __forceinline__ int gPerm(int) const { return 1; }
};
struct EpiSplit {
    EpiResid er; bf16_t* PART;
    __device__ __forceinline__ void operator()(const f32x4 (&acc)[2][2][4][2], int pm, int pn, int kind, int wr, int wc, int fr, int fq) const {
        Unit u; u.pm = pm; u.pn = pn;
        if (kind == 0) { er(acc, u, wr, wc, fr, fq); return; }
        bf16_t* base = PART + ((size_t)(kind - 1) * 2048 + (size_t)(pm * BM - ML_ROWS + wr * 64 + fr)) * 2048 + pn * BM + wc * 32 + 8 * fq;
#pragma unroll
        for (int ai = 0; ai < 2; ++ai)
#pragma unroll
            for (int m = 0; m < 4; ++m) { bf16_t* rowp = base + (size_t)(ai * HALF + m * 16) * 2048;
#pragma unroll
                for (int bj = 0; bj < 2; ++bj) { const u32x2 w0 = pack4(acc[ai][bj][m][0]), w1 = pack4(acc[ai][bj][m][1]); u32x4 w; w.x = w0.x; w.y = w0.y; w.z = w1.x; w.w = w1.y; *(u32x4*)(rowp + bj * HALF) = w; } }
    }
};
}
#define XB_TMO      128
#define XB_XCNT(j)  (256  + 64 * (j))
#define XB_XSUB(j)  (1280 + 64 * (j))
#define XB_XGEN(j)  (2304 + 64 * (j))
#define XB_TOP      3328
#define XB_TOPGEN   3392
#define XCD_BAR_WORDS 3456
#define XB_SPIN_CAP (1u << 18)

__device__ __forceinline__ unsigned xb_ld(unsigned* p)              { return __hip_atomic_load(p, __ATOMIC_RELAXED, __HIP_MEMORY_SCOPE_AGENT); }
__device__ __forceinline__ unsigned xb_add(unsigned* p, unsigned v) { return __hip_atomic_fetch_add(p, v, __ATOMIC_RELAXED, __HIP_MEMORY_SCOPE_AGENT); }
__device__ __forceinline__ unsigned xb_xcc_id() { return (unsigned)__builtin_amdgcn_s_getreg((3 << 11) | 20) & 0xFu; }
#define XB_SPIN(cond, bar) do { unsigned _sp = 0; while (cond) { __builtin_amdgcn_s_sleep(1); \
    if ((++_sp & 255u) == 0u) { if (xb_ld(&(bar)[XB_TMO])) break; if (_sp > XB_SPIN_CAP) { atomicAdd(&(bar)[XB_TMO], 1u); break; } } } } while (0)

struct XcdBarrier {
    unsigned* bar; unsigned x;
    volatile LAS unsigned* st;
};

__device__ __forceinline__ XcdBarrier xcd_barrier_post(unsigned* bar, volatile LAS unsigned* st) {
    XcdBarrier b; b.bar = bar; b.x = xb_xcc_id(); b.st = st;
    if (threadIdx.x == 0) (void)xb_add(&bar[XB_XCNT(b.x)], 1u);
    return b;
}
__device__ __forceinline__ void xcd_barrier_complete(unsigned* bar, unsigned x, unsigned& nloc, unsigned& nx) {
    const unsigned G = gridDim.x * gridDim.y * gridDim.z;
    unsigned sum, cnt, mine, sp = 0u;
    for (;;) {
        sum = 0u; cnt = 0u; mine = 0u;
#pragma unroll
        for (unsigned j = 0; j < 16; ++j) { const unsigned c = xb_ld(&bar[XB_XCNT(j)]); sum += c; cnt += (c > 0u) ? 1u : 0u; mine = (j == x) ? c : mine; }
        if (sum == G) break;
        __builtin_amdgcn_s_sleep(1);
        if ((++sp & 255u) == 0u) { if (xb_ld(&bar[XB_TMO])) break; if (sp > XB_SPIN_CAP) { atomicAdd(&bar[XB_TMO], 1u); break; } }
    }
    nloc = mine > 0u ? mine : 1u; nx = cnt > 0u ? cnt : 1u;
}

__device__ __forceinline__ void xcd_barrier(const XcdBarrier& b) {
    asm volatile("s_waitcnt vmcnt(0)" ::: "memory");
    __syncthreads();
    if (threadIdx.x == 0) {
        unsigned* bar = b.bar;
        __builtin_amdgcn_s_waitcnt(0);
        unsigned nloc = b.st[0], nx = b.st[1];
        if (nloc == 0u) { xcd_barrier_complete(bar, b.x, nloc, nx); b.st[0] = nloc; b.st[1] = nx; }
        const unsigned old = xb_add(&bar[XB_XSUB(b.x)], 1u);
        const unsigned gen = old / nloc;
        if (old + 1u == (gen + 1u) * nloc) {
            __builtin_amdgcn_fence(__ATOMIC_RELEASE, "agent");
            asm volatile("s_waitcnt vmcnt(0)" ::: "memory");
            const unsigned og = xb_add(&bar[XB_TOP], 1u);
            const unsigned tg = og / nx;
            if (og + 1u == (tg + 1u) * nx) xb_add(&bar[XB_TOPGEN], 1u);
            else XB_SPIN(xb_ld(&bar[XB_TOPGEN]) == tg, bar);
            __builtin_amdgcn_fence(__ATOMIC_ACQUIRE, "agent");
            xb_add(&bar[XB_XGEN(b.x)], 1u);
            asm volatile("s_waitcnt vmcnt(0)" ::: "memory");
        } else {
            XB_SPIN(xb_ld(&bar[XB_XGEN(b.x)]) == gen, bar);
            __builtin_amdgcn_fence(__ATOMIC_ACQUIRE, "agent");
            asm volatile("s_waitcnt vmcnt(0)" ::: "memory");
        }
    }
    __syncthreads();
}
#ifndef ATT_ILV
#define ATT_ILV 1
#endif
#ifndef ATT_DMAW
#define ATT_DMAW 4
#endif
#ifndef ATT_YOUNG_FROM
#define ATT_YOUNG_FROM (ATT_ILV ? 512 : 256)
#endif
namespace att {
typedef unsigned short bf16_t;
using bf16x8 = __attribute__((ext_vector_type(8))) short;
using s16x4  = __attribute__((ext_vector_type(4))) short;
using f32x16 = __attribute__((ext_vector_type(16))) float;
using u32x4  = __attribute__((ext_vector_type(4))) unsigned;
typedef LAS char lchar;
#define ASBAR() __builtin_amdgcn_sched_barrier(0)
__device__ __forceinline__ int crow(int r, int hi) { return (r & 3) + 8 * (r >> 2) + 4 * hi; }
__device__ __forceinline__ unsigned cvtpk(float lo, float hi) { return pg8::cvt_pk_bf16(lo, hi); }
template <int DK> __device__ __forceinline__ int koff(int row, int chunk) {
    return row * (DK * 2) + ((chunk & ~7) << 4) + (((chunk & 7) ^ ((row >> 1) & 7)) << 4);
}
template <int DV> __device__ __forceinline__ int v_st(int k, int c) { constexpr int NCB = DV / 32; const int kk = (k & ~0xC) | ((k & 4) << 1) | ((k & 8) >> 1); return ((kk >> 3) * NCB + (c >> 5)) * 512 + ((kk & 7) * 32 + (c & 31)) * 2; }
__device__ __forceinline__ int v_rd_base(int lane) { return ((lane & 3) << 3) | (((lane >> 2) & 3) << 6) | (((lane >> 4) & 1) << 5) | (((lane >> 5) & 1) << 8); }
template <int DV> constexpr int v_rd_off(int d0, int ks, int half) { return d0 * 512 + ks * (2 * (DV / 32) * 512) + half * ((DV / 32) * 512); }
#if ATT_ILV
template <int OFF> __device__ __forceinline__ s16x4 tr_read(int vb) { return __builtin_amdgcn_ds_read_tr16_b64_v4i16((LAS s16x4*)(unsigned)(vb + OFF)); }
#else
template <int OFF> __device__ __forceinline__ s16x4 tr_read(int vb) { s16x4 r; asm volatile("ds_read_b64_tr_b16 %0, %1 offset:%2" : "=&v"(r) : "v"(vb), "i"(OFF) : "memory"); return r; }
#endif

__device__ __forceinline__ void glds16(const void* gsrc, unsigned lds_dst) { unsigned keep; lds_dst = __builtin_amdgcn_readfirstlane(lds_dst);
    asm volatile("s_mov_b32 %0, m0\n\ts_mov_b32 m0, %2\n\ts_nop 0\n\tglobal_load_lds_dwordx4 %1, off\n\ts_mov_b32 m0, %0" : "=&s"(keep) : "v"(gsrc), "s"(lds_dst) : "memory"); }
__device__ __forceinline__ void glds16s(const void* sbase, unsigned voff, unsigned lds_dst) { unsigned keep; lds_dst = __builtin_amdgcn_readfirstlane(lds_dst);
    const unsigned long long b = (unsigned long long)sbase; const unsigned blo = __builtin_amdgcn_readfirstlane((unsigned)b), bhi = __builtin_amdgcn_readfirstlane((unsigned)(b >> 32));
    const unsigned long long sb = ((unsigned long long)bhi << 32) | blo;
    asm volatile("s_mov_b32 %0, m0\n\ts_mov_b32 m0, %3\n\ts_nop 0\n\tglobal_load_lds_dwordx4 %1, %2\n\ts_mov_b32 m0, %0" : "=&s"(keep) : "v"(voff), "s"(sb), "s"(lds_dst) : "memory"); }
template <bool WIN>
__device__ __forceinline__ void partialSM(f32x16& p0, f32x16& p1, float& m_reg, float& mn, float& alpha, const float C, const float thr, const bool domask, const int dq, const int hi) {
#if ATT_ILV
    if constexpr (WIN) { const int dqq = domask ? dq : 0;
#pragma unroll
        for (int r = 0; r < 16; ++r) { const int d0 = dqq + crow(r, hi), d1 = d0 + 32; p0[r] = (d0 > 128 || d0 < -128) ? -1e30f : p0[r]; p1[r] = (d1 > 128 || d1 < -128) ? -1e30f : p1[r]; } }
#else
    if constexpr (WIN) { if (domask) {
#pragma unroll
        for (int r = 0; r < 16; ++r) { const int d0 = dq + crow(r, hi), d1 = d0 + 32; if (d0 > 128 || d0 < -128) p0[r] = -1e30f; if (d1 > 128 || d1 < -128) p1[r] = -1e30f; } } }
#endif
    float pmax = p0[0];
#pragma unroll
    for (int r = 1; r < 16; ++r) pmax = fmaxf(pmax, p0[r]);
#pragma unroll
    for (int r = 0; r < 16; ++r) pmax = fmaxf(pmax, p1[r]);
    { auto rr = __builtin_amdgcn_permlane32_swap(__float_as_uint(pmax), __float_as_uint(pmax), false, false); pmax = fmaxf(__uint_as_float(rr[0]), __uint_as_float(rr[1])); }
#if ATT_ILV
    { const bool keep = __all(pmax - m_reg <= thr); mn = fmaxf(m_reg, keep ? m_reg : pmax); alpha = __builtin_amdgcn_exp2f((m_reg - mn) * C); m_reg = mn; }
#else
    if (__builtin_expect(__all(pmax - m_reg <= thr), 1)) { mn = m_reg; alpha = 1.f; }
    else { mn = fmaxf(m_reg, pmax); alpha = __builtin_amdgcn_exp2f((m_reg - mn) * C); m_reg = mn; }
#endif
    const float mnC = -mn * C;
#pragma unroll
    for (int r = 0; r < 16; ++r) p0[r] = fmaf(p0[r], C, mnC);
#pragma unroll
    for (int r = 0; r < 16; ++r) p1[r] = fmaf(p1[r], C, mnC);
#pragma unroll
    for (int r = 0; r < 16; ++r) p0[r] = __builtin_amdgcn_exp2f(p0[r]);
}
__device__ __forceinline__ void finishSM(f32x16& p0, f32x16& p1, float alpha, float& l_reg, bf16x8& pa0, bf16x8& pa1, bf16x8& pa2, bf16x8& pa3) {
#pragma unroll
    for (int r = 0; r < 16; ++r) p1[r] = __builtin_amdgcn_exp2f(p1[r]);
    float ps = 0;
#pragma unroll
    for (int r = 0; r < 16; ++r) ps += p0[r];
#pragma unroll
    for (int r = 0; r < 16; ++r) ps += p1[r];
    { auto rr = __builtin_amdgcn_permlane32_swap(__float_as_uint(ps), __float_as_uint(ps), false, false); ps = __uint_as_float(rr[0]) + __uint_as_float(rr[1]); }
    l_reg = l_reg * alpha + ps;
#define ATT_PK4(P, BASE, OUT) do { unsigned a0 = cvtpk(P[BASE + 0], P[BASE + 1]), a1 = cvtpk(P[BASE + 2], P[BASE + 3]);   \
    unsigned b0 = cvtpk(P[BASE + 4], P[BASE + 5]), b1 = cvtpk(P[BASE + 6], P[BASE + 7]);                              \
    auto r0 = __builtin_amdgcn_permlane32_swap(a0, b0, false, false); auto r1 = __builtin_amdgcn_permlane32_swap(a1, b1, false, false); \
    u32x4 w = {r0[0], r1[0], r0[1], r1[1]}; OUT = *reinterpret_cast<bf16x8*>(&w); } while (0)
    ATT_PK4(p0, 0, pa0); ATT_PK4(p0, 8, pa1); ATT_PK4(p1, 0, pa2); ATT_PK4(p1, 8, pa3);
#undef ATT_PK4
}
template <int DK> __device__ __forceinline__ void qkt(f32x16& p0, f32x16& p1, const lchar* Ks, const bf16x8 (&qr)[DK / 16], const int (&kq)[4]) {
    p0 = f32x16{}; p1 = f32x16{};
    bf16x8 c0 = *(const LAS bf16x8*)(Ks + kq[0]), c1 = *(const LAS bf16x8*)(Ks + kq[0] + 32 * DK * 2);
#pragma unroll
    for (int d0 = 0; d0 < DK / 16; ++d0) {
        bf16x8 n0 = c0, n1 = c1;
        if (d0 + 1 < DK / 16) { n0 = *(const LAS bf16x8*)(Ks + kq[(d0 + 1) & 3] + ((d0 + 1) >> 2) * 128); n1 = *(const LAS bf16x8*)(Ks + kq[(d0 + 1) & 3] + ((d0 + 1) >> 2) * 128 + 32 * DK * 2); }
        p0 = __builtin_amdgcn_mfma_f32_32x32x16_bf16(c0, qr[d0], p0, 0, 0, 0);
        p1 = __builtin_amdgcn_mfma_f32_32x32x16_bf16(c1, qr[d0], p1, 0, 0, 0);
        c0 = n0; c1 = n1; }
}
struct VFrag { s16x4 l0, h0, l1, h1, l2, h2, l3, h3; };
template <int DV, int D0> __device__ __forceinline__ void pv_reads(VFrag& f, int vb) {
    f.l0 = tr_read<v_rd_off<DV>(D0, 0, 0)>(vb); f.h0 = tr_read<v_rd_off<DV>(D0, 0, 1)>(vb); f.l1 = tr_read<v_rd_off<DV>(D0, 1, 0)>(vb); f.h1 = tr_read<v_rd_off<DV>(D0, 1, 1)>(vb);
    f.l2 = tr_read<v_rd_off<DV>(D0, 2, 0)>(vb); f.h2 = tr_read<v_rd_off<DV>(D0, 2, 1)>(vb); f.l3 = tr_read<v_rd_off<DV>(D0, 3, 0)>(vb); f.h3 = tr_read<v_rd_off<DV>(D0, 3, 1)>(vb);
}
__device__ __forceinline__ void pv_mma(f32x16& od, const VFrag& f, bf16x8 pa0, bf16x8 pa1, bf16x8 pa2, bf16x8 pa3) {
#define ATT_PK(L, H) (bf16x8){L[0], L[1], L[2], L[3], H[0], H[1], H[2], H[3]}
    od = __builtin_amdgcn_mfma_f32_32x32x16_bf16(pa0, ATT_PK(f.l0, f.h0), od, 0, 0, 0);
    od = __builtin_amdgcn_mfma_f32_32x32x16_bf16(pa1, ATT_PK(f.l1, f.h1), od, 0, 0, 0);
    od = __builtin_amdgcn_mfma_f32_32x32x16_bf16(pa2, ATT_PK(f.l2, f.h2), od, 0, 0, 0);
    od = __builtin_amdgcn_mfma_f32_32x32x16_bf16(pa3, ATT_PK(f.l3, f.h3), od, 0, 0, 0);
#undef ATT_PK
}
#define ATT_LWAIT(n) do { asm volatile("s_waitcnt lgkmcnt(" #n ")" ::: "memory"); ASBAR(); } while (0)
#if ATT_ILV
template <int DV> __device__ __forceinline__ void pv_all(f32x16 (&o)[DV / 32], int vb, bf16x8 pa0, bf16x8 pa1, bf16x8 pa2, bf16x8 pa3) {
    { VFrag f; pv_reads<DV, 0>(f, vb); pv_mma(o[0], f, pa0, pa1, pa2, pa3); }
    { VFrag f; pv_reads<DV, 1>(f, vb); pv_mma(o[1], f, pa0, pa1, pa2, pa3); }
    if constexpr (DV == 128) {
        { VFrag f; pv_reads<DV, 2>(f, vb); pv_mma(o[2], f, pa0, pa1, pa2, pa3); }
        { VFrag f; pv_reads<DV, 3>(f, vb); pv_mma(o[3], f, pa0, pa1, pa2, pa3); } }
}
#define ATT_SWAP(A, B) __builtin_amdgcn_permlane32_swap((A), (B), false, false)
#define ATT_PIN(X) asm volatile("" : "+v"(X))
template <int PT, int B> __device__ __forceinline__ void pk_step(const f32x16& P, unsigned& a0, unsigned& a1, unsigned& b0, unsigned& b1, unsigned& x0, unsigned& y0, bf16x8& OUT) {
    if constexpr (PT == 0) { a0 = cvtpk(P[B + 0], P[B + 1]); b0 = cvtpk(P[B + 4], P[B + 5]); }
    if constexpr (PT == 1) { a1 = cvtpk(P[B + 2], P[B + 3]); b1 = cvtpk(P[B + 6], P[B + 7]); }
    if constexpr (PT == 2) { auto r0 = ATT_SWAP(a0, b0); x0 = r0[0]; y0 = r0[1]; }
    if constexpr (PT == 3) { auto r1 = ATT_SWAP(a1, b1); u32x4 w = {x0, r1[0], y0, r1[1]}; OUT = *reinterpret_cast<bf16x8*>(&w); }
}
template <int K> __device__ __forceinline__ void fin_atom(f32x16& q0, f32x16& q1, float alpha, float& l_reg, float& ps0, float& ps1, unsigned& a0, unsigned& a1, unsigned& b0, unsigned& b1, unsigned& x0, unsigned& y0,
                                                          bf16x8& pa0, bf16x8& pa1, bf16x8& pa2, bf16x8& pa3) {
    if constexpr (K < 16) { q1[K] = __builtin_amdgcn_exp2f(q1[K]); ATT_PIN(q1[K]); ps0 += q0[K]; ATT_PIN(ps0); }
    if constexpr (K >= 8) { ps1 += q1[K - 8]; ATT_PIN(ps1); }
    if constexpr (K < 4) pk_step<K & 3, 0>(q0, a0, a1, b0, b1, x0, y0, pa0);
    else if constexpr (K < 8) pk_step<K & 3, 8>(q0, a0, a1, b0, b1, x0, y0, pa1);
    else if constexpr (K >= 16 && K < 20) pk_step<K & 3, 0>(q1, a0, a1, b0, b1, x0, y0, pa2);
    else if constexpr (K >= 20) pk_step<K & 3, 8>(q1, a0, a1, b0, b1, x0, y0, pa3);
    if constexpr (K == 23) { float ps = ps0 + ps1; auto rr = ATT_SWAP(__float_as_uint(ps), __float_as_uint(ps)); ps = __uint_as_float(rr[0]) + __uint_as_float(rr[1]); l_reg = l_reg * alpha + ps; }
}
template <int I, int NM, int DK> __device__ __forceinline__ void qk_step(f32x16& p0, f32x16& p1, const lchar* Ks, const bf16x8 (&qr)[DK / 16], const int (&kq)[4], bf16x8 (&F)[4],
        f32x16& q0, f32x16& q1, float alpha, float& l_reg, float& ps0, float& ps1, unsigned& a0, unsigned& a1, unsigned& b0, unsigned& b1, unsigned& x0, unsigned& y0, bf16x8& pa0, bf16x8& pa1, bf16x8& pa2, bf16x8& pa3) {
    constexpr int d0 = I >> 1, APG = 24 / NM;
    if constexpr (I == 0) p0 = __builtin_amdgcn_mfma_f32_32x32x16_bf16(F[0], qr[0], f32x16{}, 0, 0, 0);
    else if constexpr (I == 1) p1 = __builtin_amdgcn_mfma_f32_32x32x16_bf16(F[1], qr[0], f32x16{}, 0, 0, 0);
    else if constexpr ((I & 1) == 0) p0 = __builtin_amdgcn_mfma_f32_32x32x16_bf16(F[I & 3], qr[d0], p0, 0, 0, 0);
    else p1 = __builtin_amdgcn_mfma_f32_32x32x16_bf16(F[I & 3], qr[d0], p1, 0, 0, 0);
    if constexpr (I + 4 < NM) { constexpr int J = I + 4, e0 = J >> 1; F[I & 3] = *(const LAS bf16x8*)(Ks + kq[e0 & 3] + (e0 >> 2) * 128 + (J & 1) * (32 * DK * 2)); }
    fin_atom<APG * I>(q0, q1, alpha, l_reg, ps0, ps1, a0, a1, b0, b1, x0, y0, pa0, pa1, pa2, pa3);
    if constexpr (APG >= 2) fin_atom<APG * I + 1>(q0, q1, alpha, l_reg, ps0, ps1, a0, a1, b0, b1, x0, y0, pa0, pa1, pa2, pa3);
    if constexpr (APG >= 3) fin_atom<APG * I + 2>(q0, q1, alpha, l_reg, ps0, ps1, a0, a1, b0, b1, x0, y0, pa0, pa1, pa2, pa3);
    ASBAR();
    if constexpr (I + 1 < NM) qk_step<I + 1, NM, DK>(p0, p1, Ks, qr, kq, F, q0, q1, alpha, l_reg, ps0, ps1, a0, a1, b0, b1, x0, y0, pa0, pa1, pa2, pa3);
}
template <int DK> __device__ __forceinline__ void qkt_fin(f32x16& p0, f32x16& p1, const lchar* Ks, const bf16x8 (&qr)[DK / 16], const int (&kq)[4],
        f32x16& q0, f32x16& q1, float alpha, float& l_reg, bf16x8& pa0, bf16x8& pa1, bf16x8& pa2, bf16x8& pa3) {
    constexpr int NM = DK / 8;
    bf16x8 F[4];
#pragma unroll
    for (int i = 0; i < 4; ++i) F[i] = *(const LAS bf16x8*)(Ks + kq[(i >> 1) & 3] + ((i >> 1) >> 2) * 128 + (i & 1) * (32 * DK * 2));
    float ps0 = 0.f, ps1 = 0.f; unsigned a0 = 0, a1 = 0, b0 = 0, b1 = 0, x0 = 0, y0 = 0;
    ASBAR();
    qk_step<0, NM, DK>(p0, p1, Ks, qr, kq, F, q0, q1, alpha, l_reg, ps0, ps1, a0, a1, b0, b1, x0, y0, pa0, pa1, pa2, pa3);
}
template <int K, bool WIN> __device__ __forceinline__ void par_atom(f32x16& p0, f32x16& p1, float& m_reg, float& mn, float& alpha, const float C, const float thr, const int dqq, const int hi,
                                                                    float& pm0, float& pm1, float& pm2, float& pm3, float& mnC) {
    if constexpr (K < 4) { f32x16& P = (K < 2) ? p0 : p1; constexpr int B = (K & 1) * 8;
        if constexpr (WIN) {
#pragma unroll
            for (int r = B; r < B + 8; ++r) { const int d = dqq + crow(r, hi) + (K < 2 ? 0 : 32); P[r] = (d > 128 || d < -128) ? -1e30f : P[r]; } }
        const float m = fmaxf(fmaxf(fmaxf(P[B], P[B + 1]), fmaxf(P[B + 2], P[B + 3])), fmaxf(fmaxf(P[B + 4], P[B + 5]), fmaxf(P[B + 6], P[B + 7])));
        if constexpr (K == 0) pm0 = m; else if constexpr (K == 1) pm1 = m; else if constexpr (K == 2) pm2 = m; else pm3 = m; }
    if constexpr (K == 4) { float pmax = fmaxf(fmaxf(pm0, pm1), fmaxf(pm2, pm3));
        auto rr = ATT_SWAP(__float_as_uint(pmax), __float_as_uint(pmax)); pmax = fmaxf(__uint_as_float(rr[0]), __uint_as_float(rr[1]));
        const bool keep = __all(pmax - m_reg <= thr); mn = fmaxf(m_reg, keep ? m_reg : pmax); alpha = __builtin_amdgcn_exp2f((m_reg - mn) * C); m_reg = mn; mnC = -mn * C; }
    if constexpr (K >= 5 && K <= 8) { f32x16& P = (K < 7) ? p0 : p1; constexpr int B = ((K - 5) & 1) * 8;
#pragma unroll
        for (int r = B; r < B + 8; ++r) { P[r] = fmaf(P[r], C, mnC); ATT_PIN(P[r]); } }
    if constexpr (K >= 8) { p0[2 * (K - 8)] = __builtin_amdgcn_exp2f(p0[2 * (K - 8)]); p0[2 * (K - 8) + 1] = __builtin_amdgcn_exp2f(p0[2 * (K - 8) + 1]); ATT_PIN(p0[2 * (K - 8)]); ATT_PIN(p0[2 * (K - 8) + 1]); }
}
template <int I, int NM, int DV, bool WIN> __device__ __forceinline__ void pv_step(f32x16 (&o)[DV / 32], const int vb, const bf16x8 (&pa)[4], s16x4 (&L)[4], s16x4 (&H)[4],
        f32x16& p0, f32x16& p1, float& m_reg, float& mn, float& alpha, const float C, const float thr, const int dqq, const int hi, float& pm0, float& pm1, float& pm2, float& pm3, float& mnC) {
    constexpr int b = I >> 2, k = I & 3, APG = 16 / NM;
    { const s16x4 l = L[k], h = H[k]; o[b] = __builtin_amdgcn_mfma_f32_32x32x16_bf16(pa[k], (bf16x8){l[0], l[1], l[2], l[3], h[0], h[1], h[2], h[3]}, o[b], 0, 0, 0); }
    if constexpr (b + 1 < DV / 32) { L[k] = tr_read<v_rd_off<DV>(b + 1, k, 0)>(vb); H[k] = tr_read<v_rd_off<DV>(b + 1, k, 1)>(vb); }
    par_atom<APG * I, WIN>(p0, p1, m_reg, mn, alpha, C, thr, dqq, hi, pm0, pm1, pm2, pm3, mnC);
    if constexpr (APG >= 2) par_atom<APG * I + 1, WIN>(p0, p1, m_reg, mn, alpha, C, thr, dqq, hi, pm0, pm1, pm2, pm3, mnC);
    ASBAR();
    if constexpr (I + 1 < NM) pv_step<I + 1, NM, DV, WIN>(o, vb, pa, L, H, p0, p1, m_reg, mn, alpha, C, thr, dqq, hi, pm0, pm1, pm2, pm3, mnC);
}
template <int DV, bool WIN> __device__ __forceinline__ void pv_part(f32x16 (&o)[DV / 32], const int vb, bf16x8 pa0, bf16x8 pa1, bf16x8 pa2, bf16x8 pa3,
        f32x16& p0, f32x16& p1, float& m_reg, float& mn, float& alpha, const float C, const float thr, const bool domask, const int dq, const int hi) {
    constexpr int NM = DV / 8;
    const bf16x8 pa[4] = {pa0, pa1, pa2, pa3}; s16x4 L[4], H[4];
    L[0] = tr_read<v_rd_off<DV>(0, 0, 0)>(vb); H[0] = tr_read<v_rd_off<DV>(0, 0, 1)>(vb); L[1] = tr_read<v_rd_off<DV>(0, 1, 0)>(vb); H[1] = tr_read<v_rd_off<DV>(0, 1, 1)>(vb);
    L[2] = tr_read<v_rd_off<DV>(0, 2, 0)>(vb); H[2] = tr_read<v_rd_off<DV>(0, 2, 1)>(vb); L[3] = tr_read<v_rd_off<DV>(0, 3, 0)>(vb); H[3] = tr_read<v_rd_off<DV>(0, 3, 1)>(vb);
    float pm0 = 0.f, pm1 = 0.f, pm2 = 0.f, pm3 = 0.f, mnC = 0.f; const int dqq = domask ? dq : 0;
    ASBAR();
    pv_step<0, NM, DV, WIN>(o, vb, pa, L, H, p0, p1, m_reg, mn, alpha, C, thr, dqq, hi, pm0, pm1, pm2, pm3, mnC);
}
#else
template <int NM, int ND, int NV> __device__ __forceinline__ void sgb_pattern() {}
template <int DV> __device__ __forceinline__ void pv_all(f32x16 (&o)[DV / 32], int vb, bf16x8 pa0, bf16x8 pa1, bf16x8 pa2, bf16x8 pa3) {
    VFrag f;
    pv_reads<DV, 0>(f, vb); ATT_LWAIT(0); pv_mma(o[0], f, pa0, pa1, pa2, pa3);
    pv_reads<DV, 1>(f, vb); ATT_LWAIT(0); pv_mma(o[1], f, pa0, pa1, pa2, pa3);
    if constexpr (DV == 128) {
        pv_reads<DV, 2>(f, vb); ATT_LWAIT(0); pv_mma(o[2], f, pa0, pa1, pa2, pa3);
        pv_reads<DV, 3>(f, vb); ATT_LWAIT(0); pv_mma(o[3], f, pa0, pa1, pa2, pa3); }
}
#endif
template <int DK, int DV, bool WIN, bool SINK, int MODE>
__device__ __forceinline__ void attn_unit(const bf16_t* __restrict__ Qb, const int ldq, const bf16_t* __restrict__ Kb, const int ldk, const bf16_t* __restrict__ Vb, const int ldv,
                                          bf16_t* __restrict__ Ob, const int ldo, const int cbase, const int lbase, const int NT, const int qpos0, const int kpos0, const float sinkl2, lchar* lds) {
    constexpr int KI = DK / 64, VI = DV / 64, ND = DK / 16, NO = DV / 32, SHM_K = 64 * DK * 2, SHM_V = 64 * DV * 2;
    constexpr float SCALE = (DK == 192) ? 0.07216878364870322f : 0.125f, C = SCALE * 1.4426950408889634f, THRR = 8.0f / SCALE;
    int tid_ = threadIdx.x; asm volatile("" : "+v"(tid_));
    const int tid = tid_, wid = tid >> 6, lane = tid & 63, r32 = lane & 31, hi = lane >> 5;
    constexpr int NSLOT = (MODE == 2) ? 3 : 2;
    lchar* V_lds = lds; lchar* K_lds = lds + NSLOT * SHM_V;
    LAS float* wsf = (LAS float*)(lds + NSLOT * SHM_V + NSLOT * SHM_K) + wid * 64; LAS float* li_l = wsf; LAS float* al_l = wsf + 32;
    float m_reg = -1e30f, l_reg = 0.f; f32x16 o[NO]; bf16x8 qr[ND];
#pragma unroll
    for (int d = 0; d < NO; ++d) o[d] = f32x16{};
    const bf16_t* Qw = Qb + (long)(wid * 32 + r32) * ldq + hi * 8;
#pragma unroll
    for (int d0 = 0; d0 < ND; ++d0) qr[d0] = *(const bf16x8*)(Qw + d0 * 16);
    const int srow = tid >> 3, scg = tid & 7;
    const int kgo = srow * ldk + scg * 8, vgo = srow * ldv + scg * 8;
    int klo[KI];
#pragma unroll
    for (int i = 0; i < KI; ++i) klo[i] = koff<DK>(srow, scg + 8 * i);
    const int vlo = v_st<DV>(srow, scg * 8);
    const int vb0 = (int)(uintptr_t)V_lds + v_rd_base(lane);
    const int qpos = qpos0 + wid * 32 + r32;
    int kq[4];
#pragma unroll
    for (int k = 0; k < 4; ++k) kq[k] = r32 * (DK * 2) + (((2 * k) ^ hi ^ ((r32 >> 1) & 7)) << 4);
    bf16x8 ks[KI], vs[VI];
#define ATT_ROWOF(j) ((j) < 4 ? cbase + 64 * (j) : lbase + 64 * ((j) - 4))
#define ATT_SLOAD(j) do { const long rb_ = ATT_ROWOF(j); const bf16_t* kp_ = Kb + rb_ * ldk + kgo; const bf16_t* vp_ = Vb + rb_ * ldv + vgo; \
    _Pragma("unroll") for (int i_ = 0; i_ < KI; ++i_) ks[i_] = *(const bf16x8*)(kp_ + 64 * i_); \
    _Pragma("unroll") for (int i_ = 0; i_ < VI; ++i_) vs[i_] = *(const bf16x8*)(vp_ + 64 * i_); } while (0)
#define ATT_SWRITE(b) do { _Pragma("unroll") for (int i_ = 0; i_ < KI; ++i_) *(LAS bf16x8*)(K_lds + (b) * SHM_K + klo[i_]) = ks[i_]; \
    _Pragma("unroll") for (int i_ = 0; i_ < VI; ++i_) *(LAS bf16x8*)(V_lds + (b) * SHM_V + vlo + i_ * 1024) = vs[i_]; } while (0)
#define ATT_RESC(a) do { if (__any((a) < 1.f)) { if (hi == 0) al_l[r32] = (a); asm volatile("s_waitcnt lgkmcnt(0)" ::: "memory"); \
    _Pragma("unroll") for (int d_ = 0; d_ < NO; ++d_) _Pragma("unroll") for (int r_ = 0; r_ < 16; ++r_) o[d_][r_] *= al_l[crow(r_, hi)]; } } while (0)
#define ATT_DQ(j) (kpos0 + 64 * ((j) - 4) - qpos)
    f32x16 pA0, pA1, pB0, pB1; float mnA, mnB, alA, alB; bf16x8 pa0, pa1, pa2, pa3;
    __syncthreads();
    if constexpr (MODE == 2) {
        const int wu = __builtin_amdgcn_readfirstlane(wid);
        constexpr int DW = ATT_DMAW, KP = KI * 8 / DW, VP = VI * 8 / DW;
        const bool dmaw = wu < DW;
        int kgs[KP], vgs[VP];
#pragma unroll
        for (int i = 0; i < KP; ++i) { const int p = (wu * KP + i) * 64 + lane, kr = p / (DK / 8), c2 = p % (DK / 8); kgs[i] = kr * ldk + (((c2 & ~7) | ((c2 & 7) ^ ((kr >> 1) & 7))) << 3); }
#pragma unroll
        for (int i = 0; i < VP; ++i) { const int u16 = (wu * VP + i) * 64 + lane, st = u16 >> 5, kk = (st / (DV / 32)) * 8 + ((u16 >> 2) & 7), c = (st % (DV / 32)) * 32 + (u16 & 3) * 8;
            const int k = (kk & ~0xC) | ((kk & 4) << 1) | ((kk & 8) >> 1); vgs[i] = k * ldv + c; }
        const unsigned kl0 = (unsigned)(uintptr_t)K_lds + (unsigned)(wu * KP) * 1024u, vl0 = (unsigned)(uintptr_t)V_lds + (unsigned)(wu * VP) * 1024u;
#define ATT_DMAK(j, slot) do { const bf16_t* kp_ = Kb + (long)ATT_ROWOF(j) * ldk; if (dmaw) { _Pragma("unroll") for (int i_ = 0; i_ < KP; ++i_) glds16s(kp_, (unsigned)kgs[i_] * 2u, kl0 + (unsigned)(slot) * SHM_K + i_ * 1024); } } while (0)
#define ATT_DMAV(j, slot) do { const bf16_t* vp_ = Vb + (long)ATT_ROWOF(j) * ldv; if (dmaw) { _Pragma("unroll") for (int i_ = 0; i_ < VP; ++i_) glds16s(vp_, (unsigned)vgs[i_] * 2u, vl0 + (unsigned)(slot) * SHM_V + i_ * 1024); } } while (0)
#define ATT_WAITN(n) asm volatile("s_waitcnt vmcnt(" #n ") lgkmcnt(0)" ::: "memory")
#define ATT_WAIT1() do { if constexpr (KP + VP == 10) ATT_WAITN(10); else if constexpr (KP + VP == 5) ATT_WAITN(5); else if constexpr (KP + VP == 4) ATT_WAITN(4); else { static_assert(KP + VP == 2); ATT_WAITN(2); } } while (0)
#define ATT_WAIT2() do { if constexpr (KP + VP == 10) ATT_WAITN(20); else if constexpr (KP + VP == 5) ATT_WAITN(10); else if constexpr (KP + VP == 4) ATT_WAITN(8); else ATT_WAITN(4); } while (0)
#define ATT_SYNC(j) do { const int sp_ = (sc == 0) ? 2 : sc - 1; if ((j) + 2 < NT) ATT_WAIT1(); else ATT_WAITN(0); \
        __builtin_amdgcn_s_barrier(); asm volatile("" ::: "memory"); \
        if ((j) + 3 < NT) ATT_DMAK((j) + 3, sc); if ((j) + 2 < NT) ATT_DMAV((j) + 2, sp_); } while (0)
#define ATT_STEP_OLD(j, PC0, PC1, MNC, ALC, PP0, PP1, MNP, ALP) do { const int spv_ = (sc == 0) ? 2 : sc - 1; \
        ASBAR(); qkt_fin<DK>(PC0, PC1, K_lds + sc * SHM_K, qr, kq, PP0, PP1, ALP, l_reg, pa0, pa1, pa2, pa3); \
        pv_part<DV, WIN>(o, vb0 + spv_ * SHM_V, pa0, pa1, pa2, pa3, PC0, PC1, m_reg, MNC, ALC, C, THRR, (j) >= 4, ATT_DQ(j), hi); \
        ATT_SYNC(j); ATT_RESC(ALC); sc = (sc == 2) ? 0 : sc + 1; } while (0)
#define ATT_STEP_YNG(j, PC0, PC1, MNC, ALC, PP0, PP1, MNP, ALP) do { const int spv_ = (sc == 0) ? 2 : sc - 1; \
        partialSM<WIN>(PP0, PP1, m_reg, MNP, ALP, C, THRR, (j) - 1 >= 4, ATT_DQ((j) - 1), hi); ATT_RESC(ALP); \
        ASBAR(); qkt<DK>(PC0, PC1, K_lds + sc * SHM_K, qr, kq); \
        finishSM(PP0, PP1, ALP, l_reg, pa0, pa1, pa2, pa3); ASBAR(); \
        pv_all<DV>(o, vb0 + spv_ * SHM_V, pa0, pa1, pa2, pa3); \
        ATT_SYNC(j); sc = (sc == 2) ? 0 : sc + 1; } while (0)
        const bool young = (ATT_YOUNG_FROM < 512) && __builtin_amdgcn_readfirstlane(tid) >= ATT_YOUNG_FROM;
        ATT_WAITN(0); __builtin_amdgcn_s_barrier(); asm volatile("" ::: "memory");
        ATT_DMAK(0, 0); ATT_DMAK(1, 1); ATT_DMAV(0, 0); ATT_DMAK(2, 2); ATT_DMAV(1, 1);
        ATT_WAIT2(); __builtin_amdgcn_s_barrier(); asm volatile("" ::: "memory");
        int sc = 0;
        if (young) {
            qkt<DK>(pA0, pA1, K_lds, qr, kq);
            ATT_SYNC(0); sc = 1;
            for (int j = 1; j + 1 < NT; j += 2) {
                ATT_STEP_YNG(j, pB0, pB1, mnB, alB, pA0, pA1, mnA, alA);
                ATT_STEP_YNG(j + 1, pA0, pA1, mnA, alA, pB0, pB1, mnB, alB);
            }
            ATT_STEP_YNG(NT - 1, pB0, pB1, mnB, alB, pA0, pA1, mnA, alA);
            partialSM<WIN>(pB0, pB1, m_reg, mnB, alB, C, THRR, NT - 1 >= 4, ATT_DQ(NT - 1), hi); ATT_RESC(alB);
        } else {
            qkt<DK>(pA0, pA1, K_lds, qr, kq); partialSM<WIN>(pA0, pA1, m_reg, mnA, alA, C, THRR, false, 0, hi);
            ATT_SYNC(0); ATT_RESC(alA); sc = 1;
            for (int j = 1; j + 1 < NT; j += 2) {
                ATT_STEP_OLD(j, pB0, pB1, mnB, alB, pA0, pA1, mnA, alA);
                ATT_STEP_OLD(j + 1, pA0, pA1, mnA, alA, pB0, pB1, mnB, alB);
            }
            ATT_STEP_OLD(NT - 1, pB0, pB1, mnB, alB, pA0, pA1, mnA, alA);
        }
        finishSM(pB0, pB1, alB, l_reg, pa0, pa1, pa2, pa3); ASBAR();
        pv_all<DV>(o, vb0 + ((sc == 0) ? 2 : sc - 1) * SHM_V, pa0, pa1, pa2, pa3);
#undef ATT_SYNC
#undef ATT_STEP_OLD
#undef ATT_STEP_YNG
#undef ATT_DMAK
#undef ATT_DMAV
#undef ATT_WAITN
#undef ATT_WAIT1
#undef ATT_WAIT2
    } else if constexpr (MODE == 1) {
        ATT_SLOAD(0); asm volatile("s_waitcnt vmcnt(0)" ::: "memory"); ATT_SWRITE(0); __syncthreads();
        for (int j = 0; j < NT; ++j) {
            const int b = j & 1;
            if (j + 1 < NT) ATT_SLOAD(j + 1);
            ASBAR(); qkt<DK>(pA0, pA1, K_lds + b * SHM_K, qr, kq);
            partialSM<WIN>(pA0, pA1, m_reg, mnA, alA, C, THRR, j >= 4, ATT_DQ(j), hi);
            ATT_RESC(alA);
            finishSM(pA0, pA1, alA, l_reg, pa0, pa1, pa2, pa3); ASBAR();
            pv_all<DV>(o, vb0 + b * SHM_V, pa0, pa1, pa2, pa3);
            if (j + 1 < NT) { asm volatile("s_waitcnt vmcnt(0)" ::: "memory"); ATT_SWRITE(b ^ 1); }
            __syncthreads();
        }
    } else {
    ATT_SLOAD(0); asm volatile("s_waitcnt vmcnt(0)" ::: "memory"); ATT_SWRITE(0); __syncthreads();
    qkt<DK>(pA0, pA1, K_lds, qr, kq); partialSM<WIN>(pA0, pA1, m_reg, mnA, alA, C, THRR, false, 0, hi);
    ATT_SLOAD(1); asm volatile("s_waitcnt vmcnt(0)" ::: "memory"); ATT_SWRITE(1); __syncthreads();
    for (int j = 1; j + 1 < NT; j += 2) {
        ASBAR(); qkt<DK>(pB0, pB1, K_lds + SHM_K, qr, kq);
        finishSM(pA0, pA1, alA, l_reg, pa0, pa1, pa2, pa3); ASBAR();
        ATT_SLOAD(j + 1); ASBAR();
        pv_all<DV>(o, vb0, pa0, pa1, pa2, pa3); partialSM<WIN>(pB0, pB1, m_reg, mnB, alB, C, THRR, j >= 4, ATT_DQ(j), hi);
        __syncthreads(); asm volatile("s_waitcnt vmcnt(0)" ::: "memory"); ATT_SWRITE(0);
        ATT_RESC(alB); __syncthreads();
        ASBAR(); qkt<DK>(pA0, pA1, K_lds, qr, kq);
        finishSM(pB0, pB1, alB, l_reg, pa0, pa1, pa2, pa3); ASBAR();
        ATT_SLOAD(j + 2); ASBAR();
        pv_all<DV>(o, vb0 + SHM_V, pa0, pa1, pa2, pa3); partialSM<WIN>(pA0, pA1, m_reg, mnA, alA, C, THRR, j + 1 >= 4, ATT_DQ(j + 1), hi);
        __syncthreads(); asm volatile("s_waitcnt vmcnt(0)" ::: "memory"); ATT_SWRITE(1);
        ATT_RESC(alA); __syncthreads();
    }
    ASBAR(); qkt<DK>(pB0, pB1, K_lds + SHM_K, qr, kq);
    finishSM(pA0, pA1, alA, l_reg, pa0, pa1, pa2, pa3); ASBAR();
    pv_all<DV>(o, vb0, pa0, pa1, pa2, pa3); partialSM<WIN>(pB0, pB1, m_reg, mnB, alB, C, THRR, NT - 1 >= 4, ATT_DQ(NT - 1), hi);
    __syncthreads(); ATT_RESC(alB);
    finishSM(pB0, pB1, alB, l_reg, pa0, pa1, pa2, pa3); ASBAR();
    pv_all<DV>(o, vb0 + SHM_V, pa0, pa1, pa2, pa3);
    }
    if constexpr (SINK) l_reg += __builtin_amdgcn_exp2f(sinkl2 - m_reg * C);
    if (hi == 0) li_l[r32] = l_reg;
    asm volatile("s_waitcnt lgkmcnt(0)" ::: "memory");
    float rli[16];
#pragma unroll
    for (int r = 0; r < 16; ++r) rli[r] = __builtin_amdgcn_rcpf(li_l[crow(r, hi)]);
    bf16_t* Ow = Ob + (long)(wid * 32) * ldo + r32;
#pragma unroll
    for (int r = 0; r < 16; ++r) { const int orow = crow(r, hi);
#pragma unroll
        for (int d0 = 0; d0 < NO; ++d0) Ow[(long)orow * ldo + d0 * 32] = (bf16_t)(cvtpk(o[d0][r] * rli[r], 0.f) & 0xffffu); }
#undef ATT_ROWOF
#undef ATT_SLOAD
#undef ATT_SWRITE
#undef ATT_RESC
#undef ATT_DQ
}
}
typedef unsigned short bf16;
typedef unsigned v4u __attribute__((ext_vector_type(4)));
typedef unsigned v2u __attribute__((ext_vector_type(2)));
typedef float f32x4 __attribute__((ext_vector_type(4)));
typedef short bf16x8 __attribute__((ext_vector_type(8)));
typedef GAS unsigned gu32;
#define LDS_WAIT() asm volatile("s_waitcnt lgkmcnt(0)" ::: "memory")
#define VM_WAIT() asm volatile("s_waitcnt vmcnt(0)" ::: "memory")

constexpr int NWAVES = 8;
constexpr int DM = 2048, NB = 8, SEQ = 4096, DEPTH = 4, CTXL = 256, DFF = 5632;
constexpr int ML = NB * SEQ, MC = NB * CTXL, MT = ML + MC;
constexpr int NIN = 8768, NINP = 8960, NMOD = 6 * DM;
constexpr float EPS = 1e-6f;
static_assert(ML == pg8::ML_ROWS, "row split");

constexpr size_t MiB = 1u << 20;
constexpr size_t WS_CTL = 0, CTL_ZERO_BYTES = 1 * MiB;
constexpr size_t WS_MOD = 1 * MiB;
constexpr size_t WS_ROPE = 3 * MiB;
constexpr size_t WS_W = 4 * MiB;
constexpr size_t WO_IN = 0, WO_Q = WO_IN + (size_t)NINP * DM * 2, WO_KV = WO_Q + (size_t)1536 * 512 * 2, WO_C = WO_KV + (size_t)2048 * 256 * 2, WO_M = WO_C + (size_t)2048 * 512 * 2,
                 WO_G = WO_M + (size_t)2048 * 1024 * 2, WO_O = WO_G + (size_t)2048 * 512 * 2, WO_F1 = WO_O + (size_t)2048 * 2048 * 2, WO_F2 = WO_F1 + (size_t)2 * DFF * DM * 2,
                 WO_END = WO_F2 + (size_t)DM * DFF * 2;
static_assert(WO_END <= 120 * MiB, "weights");
constexpr size_t WS_XC = 124 * MiB;
constexpr size_t WS_A = 140 * MiB;
constexpr size_t WS_B = 548 * MiB;
constexpr size_t WS_C = 684 * MiB;
constexpr size_t WS_D = 786 * MiB;
constexpr size_t WD_KF = 0, WD_V = 102 * MiB, WD_GQ = 170 * MiB, WD_GK = 204 * MiB, WD_GV = 213 * MiB, WD_U = 222 * MiB;
constexpr size_t WS_E = 1058 * MiB;
constexpr size_t WE_UC = 0, WE_CKV = 34 * MiB, WE_QA = 51 * MiB;
constexpr size_t WS_XB = 1144 * MiB;
constexpr size_t WS_END = 1272 * MiB;
static_assert((size_t)MT * 6144 * 2 <= 408 * MiB && (size_t)MT * 2048 * 2 <= 136 * MiB && (size_t)MT * 768 * 4 <= 102 * MiB && (size_t)MT * 2048 * 4 <= 272 * MiB && WD_U + (size_t)MT * 512 * 2 <= 272 * MiB, "ws map");
constexpr int CW_BAR = 4096;

constexpr int RING_OFF = 0, RING_BYTES = 131072, LDSCTL_OFF = RING_BYTES, MISC_OFF = LDSCTL_OFF + 320, LDS_BYTES = 147456;

__device__ __forceinline__ unsigned f2bf(float f) { unsigned u = __builtin_bit_cast(unsigned, f); return (u + 0x7fffu + ((u >> 16) & 1u)) >> 16; }
__device__ __forceinline__ unsigned pk2(float lo, float hi) { return pg8::cvt_pk_bf16(lo, hi); }
__device__ __forceinline__ float wave_sum(float v) {
#pragma unroll
    for (int o = 1; o < 64; o <<= 1) v += __shfl_xor(v, o);
    return v;
}
__device__ __forceinline__ float bflo(unsigned w) { return __uint_as_float(w << 16); }
__device__ __forceinline__ float bfhi(unsigned w) { return __uint_as_float(w & 0xffff0000u); }
__device__ __forceinline__ float sigmf(float x) { return __builtin_amdgcn_rcpf(1.0f + __builtin_amdgcn_exp2f(-1.4426950408889634f * x)); }

__device__ __forceinline__ int srccol(int mode, int n) {
    if (mode == 0) return n;
    if (mode == 1) {
        if (n < 6144) return 2624 + n;
        if (n < 7744) return n - 6144;
        if (n < 8768) { const int q = n - 7744, g = q >> 5, i = q & 31; return 1600 + (i < 16 ? 16 * g + i : 512 + 16 * g + (i - 16)); }
        return -1;
    }
    { const int t = n >> 8, j = n & 255; return j < 128 ? 128 * t + j : DFF + 128 * t + (j - 128); }
}
__device__ __forceinline__ void cvt_item(const float* W, int K, int N, bf16* WT, LAS float* scr, int item, int nblk, int lane, int mode) {
    const int kb = item / nblk, nb = item % nblk, k0 = 64 * kb, n0 = 32 * nb;
    const int sc = srccol(mode, n0 + (lane & 31));
    const float wsc = (mode == 1 && n0 < 6144) ? -1.4426950408889634f : 1.0f;
    const float* wp = W + (size_t)(k0 + (lane >> 5)) * N + (sc >= 0 ? sc : 0);
#pragma unroll 8
    for (int i = 0; i < 32; ++i) { const float v = wp[(size_t)(2 * i) * N] * wsc; scr[(2 * i + (lane >> 5)) * 33 + (lane & 31)] = sc >= 0 ? v : 0.f; }
    LDS_WAIT(); asm volatile("" ::: "memory");
    const int c = lane & 7;
#pragma unroll
    for (int j = 0; j < 4; ++j) { const int n = (lane >> 3) + 8 * j; const LAS float* s = scr + (8 * c) * 33 + n;
        v4u o; o.x = pk2(s[0 * 33], s[1 * 33]); o.y = pk2(s[2 * 33], s[3 * 33]); o.z = pk2(s[4 * 33], s[5 * 33]); o.w = pk2(s[6 * 33], s[7 * 33]);
        *(GAS v4u*)(WT + (size_t)(n0 + n) * K + k0 + 8 * c) = o; }
    LDS_WAIT(); asm volatile("" ::: "memory");
}

#ifndef ATT_MLA_MODE
#define ATT_MLA_MODE 2
#endif
#ifndef ATT_GQA_MODE
#define ATT_GQA_MODE 2
#endif
#ifndef P5_WGM
#define P5_WGM 8
#endif
#ifndef P1_WGM
#define P1_WGM 4
#endif
#ifndef P8_WGM
#define P8_WGM 4
#endif
#ifndef SPLIT_WGM
#define SPLIT_WGM 2
#endif
struct Args { const float* in[25]; float* out; unsigned char* ws; int multi, l_lo, l_hi, ph, pad0, pad1; };
enum { PH_PRE = -1, PH_POST = 10, PH_DUMP = 11 };

struct __attribute__((packed, aligned(4))) F3 { float x, y, z; };
#define PHASE_BEGIN \
    const __attribute__((address_space(4))) Args* ap = (const __attribute__((address_space(4))) Args*)__builtin_amdgcn_kernarg_segment_ptr(); asm volatile("" : "+s"(ap)); \
    unsigned char* ws = ap->ws; \
    int tid = threadIdx.x; asm volatile("" : "+v"(tid)); const int lane = tid & 63, wave = __builtin_amdgcn_readfirstlane(tid >> 6); \
    const int gw = vcu * NWAVES + wave, NGW = G * NWAVES; (void)gw; (void)NGW; (void)lane; \
    const float* in_x = ap->in[0]; const float* in_c = ap->in[1]; const float* in_ctx = ap->in[2]; const float* in_cctx = ap->in[3]; const float* w_ada = ap->in[4]; const float* b_ada = ap->in[5]; const float* g_mix = ap->in[6]; const float* w_in = ap->in[7]; const float* conv_w = ap->in[8]; const float* conv_b = ap->in[9]; const float* conv_ln_g = ap->in[10]; const float* conv_ln_b = ap->in[11]; const float* w_conv_out = ap->in[12]; const float* g_q_a = ap->in[13]; const float* w_q_up = ap->in[14]; const float* g_kv_a = ap->in[15]; const float* w_kv_up = ap->in[16]; const float* w_mla_out = ap->in[17]; const float* gqa_sink = ap->in[18]; const float* w_gqa_out = ap->in[19]; const float* w_out = ap->in[20]; const float* g_ffn = ap->in[21]; const float* w_ffn_in = ap->in[22]; const float* w_ffn_out = ap->in[23]; const float* g_final = ap->in[24]; float* XL = ap->out; bf16* XB = (bf16*)(ws + WS_XB); bf16* XCB = (bf16*)(ws + WS_XC); (void)XL; (void)XCB; float* MOD = (float*)(ws + WS_MOD); float* ROPE = (float*)(ws + WS_ROPE); float* XC = (float*)(ws + WS_XC); bf16* Win_t = (bf16*)(ws + WS_W + WO_IN); bf16* Wq_t = (bf16*)(ws + WS_W + WO_Q); bf16* Wkv_t = (bf16*)(ws + WS_W + WO_KV); bf16* Wc_t = (bf16*)(ws + WS_W + WO_C); bf16* Wm_t = (bf16*)(ws + WS_W + WO_M); bf16* Wg_t = (bf16*)(ws + WS_W + WO_G); bf16* Wo_t = (bf16*)(ws + WS_W + WO_O); bf16* Wf1_t = (bf16*)(ws + WS_W + WO_F1); bf16* Wf2_t = (bf16*)(ws + WS_W + WO_F2); unsigned char* Gb = (unsigned char*)(ws + WS_A); bf16* HID = (bf16*)(ws + WS_A); bf16* Hb = (bf16*)(ws + WS_B); bf16* MQ = (bf16*)(ws + WS_B); bf16* Yb = (bf16*)(ws + WS_B); bf16* CQ = (bf16*)(ws + WS_C); bf16* PART = (bf16*)(ws + WS_C); bf16* OM = (bf16*)(ws + WS_C); bf16* OG = (bf16*)(ws + WS_C + (size_t)MT * 1024 * 2); bf16* KF = (bf16*)(ws + WS_D + WD_KF); bf16* Vb = (bf16*)(ws + WS_D + WD_V); bf16* GQ = (bf16*)(ws + WS_D + WD_GQ); bf16* GK = (bf16*)(ws + WS_D + WD_GK); bf16* GV = (bf16*)(ws + WS_D + WD_GV); bf16* Ub = (bf16*)(ws + WS_D + WD_U); bf16* YF = (bf16*)(ws + WS_D); bf16* UC = (bf16*)(ws + WS_E + WE_UC); bf16* CKVn = (bf16*)(ws + WS_E + WE_CKV); bf16* QAn = (bf16*)(ws + WS_E + WE_QA); \
    const float* modl = MOD + (size_t)l_cur * 9 * NMOD; (void)modl;
__global__ void __launch_bounds__(NWAVES * 64, 2) mega_fwd(Args args) {
    extern __shared__ __attribute__((aligned(16))) unsigned char lds_raw[];
    LAS unsigned char* lds = (LAS unsigned char*)lds_raw;
    volatile LAS unsigned* MISC = (volatile LAS unsigned*)(lds + MISC_OFF);
    const int tid0 = threadIdx.x;
    const int G = gridDim.x; const int bx = blockIdx.x; const int vcu = (G % 8 == 0) ? (bx % 8) * (G / 8) + bx / 8 : bx;
    gu32* ctl = (gu32*)(args.ws + WS_CTL);
    int l_cur = 0;
    for (int u = tid0; u < (LDS_BYTES - LDSCTL_OFF) / 4; u += NWAVES * 64) ((LAS unsigned*)(lds + LDSCTL_OFF))[u] = 0u;
    __syncthreads();
    XcdBarrier bar = xcd_barrier_post((unsigned*)(ctl + CW_BAR), MISC + 8);
    const int multi = args.multi, ph = args.ph;
#ifndef PHASE_MASK
#define PHASE_MASK 0x1fff
#endif
#define RUN(k) ((((PHASE_MASK) >> ((k) + 1)) & 1) && (!multi || ph == (k)))
#define GRID_BAR() do { if (!multi) xcd_barrier(bar); } while (0)

    if (RUN(PH_PRE)) { PHASE_BEGIN
        LAS float* sil = (LAS float*)(lds + RING_OFF);
        LAS float* red = (LAS float*)(lds + RING_OFF + 9 * DM * 4);
        for (int i = tid; i < 9 * DM; i += NWAVES * 64) { const float v = i < 8 * DM ? in_c[i] : in_cctx[i - 8 * DM]; sil[(i & (DM - 1)) * 9 + (i >> 11)] = v * sigmf(v); }
        __syncthreads();
#define ADA_LOAD(W_, I0) do { _Pragma("unroll") for (int u = 0; u < 8; ++u) W_[u] = *(const F3*)(Wl + (size_t)((I0) + u) * 8 * NMOD); } while (0)
#define ADA_FMA(W_, I0) do { _Pragma("unroll") for (int u = 0; u < 8; ++u) { const LAS float* sp = sil + (((I0) + u) * 8 + wave) * 9; \
            _Pragma("unroll") for (int v = 0; v < 9; ++v) { const float sv = sp[v]; acc[v][0] += W_[u].x * sv; acc[v][1] += W_[u].y * sv; acc[v][2] += W_[u].z * sv; } asm volatile("" ::: "memory"); } } while (0)
        for (int s = vcu; s < DEPTH * 64; s += G) {
            const int l = s >> 6, col0 = (s & 63) * 192;
            const float* Wl = w_ada + (size_t)l * DM * NMOD + (size_t)wave * NMOD + col0 + 3 * lane;
            float acc[9][3];
#pragma unroll
            for (int v = 0; v < 9; ++v) { acc[v][0] = 0.f; acc[v][1] = 0.f; acc[v][2] = 0.f; }
            F3 wa[8], wb[8];
            ADA_LOAD(wa, 0);
#pragma nounroll
            for (int i = 0; i < DM / 8; i += 16) {
                ADA_LOAD(wb, i + 8);
                ADA_FMA(wa, i);
                { const int in_ = (i + 16 < DM / 8) ? i + 16 : 0; ADA_LOAD(wa, in_); }
                ADA_FMA(wb, i + 8);
            }
#pragma unroll
            for (int v = 0; v < 9; ++v) {
#pragma unroll
                for (int e = 0; e < 3; ++e) red[(wave * 9 + v) * 192 + 3 * lane + e] = acc[v][e]; }
            __syncthreads();
            for (int i = tid; i < 9 * 192; i += NWAVES * 64) { const int v = i / 192, cc = i - v * 192; float t = 0.f;
#pragma unroll
                for (int w8 = 0; w8 < 8; ++w8) t += red[(w8 * 9 + v) * 192 + cc];
                MOD[((size_t)l * 9 + v) * NMOD + col0 + cc] = t + b_ada[(size_t)l * NMOD + col0 + cc]; }
            __syncthreads();
        }
        { bf16* XB = (bf16*)(ws + WS_XB);
          for (size_t i = ((size_t)gw * 64 + lane) * 8; i < (size_t)ML * DM; i += (size_t)NGW * 64 * 8) { const f32x4 a = *(const f32x4*)(in_x + i), b = *(const f32x4*)(in_x + i + 4);
              v4u w; w.x = pk2(a[0], a[1]); w.y = pk2(a[2], a[3]); w.z = pk2(b[0], b[1]); w.w = pk2(b[2], b[3]); *(v4u*)(XB + i) = w; }
          bf16* XCB = (bf16*)(ws + WS_XC);
          for (size_t i = ((size_t)gw * 64 + lane) * 8; i < (size_t)MC * DM; i += (size_t)NGW * 64 * 8) { const f32x4 a = *(const f32x4*)(in_ctx + i), b = *(const f32x4*)(in_ctx + i + 4);
              v4u w; w.x = pk2(a[0], a[1]); w.y = pk2(a[2], a[3]); w.z = pk2(b[0], b[1]); w.w = pk2(b[2], b[3]); *(v4u*)(XCB + i) = w; } }
        { const int i = bx * (NWAVES * 64) + tid; if (i < 64 * 16) { const int p = i >> 4, f = i & 15; const float invf = powf(10000.0f, -(float)f / 16.0f), a = (float)p * invf;
              ROPE[2 * i] = cosf(a); ROPE[2 * i + 1] = sinf(a); } }
    }
    GRID_BAR();

    for (int l = args.l_lo; l < args.l_hi; ++l) {
        l_cur = l;
        const bool lastl = (l == DEPTH - 1); const int Mg = lastl ? ML : MT;
        if (RUN(0)) { PHASE_BEGIN
            LAS float* scr = (LAS float*)(lds + RING_OFF + wave * 16384);
            constexpr int I_IN = (DM / 64) * (NINP / 32), I_Q = (512 / 64) * (1536 / 32), I_KV = (256 / 64) * (2048 / 32), I_C = (512 / 64) * (DM / 32), I_M = (1024 / 64) * (DM / 32),
                          I_G = (512 / 64) * (DM / 32), I_O = (DM / 64) * (DM / 32), I_F1 = (DM / 64) * (2 * DFF / 32), I_F2 = (DFF / 64) * (DM / 32);
            constexpr int NITEMS = I_IN + I_Q + I_KV + I_C + I_M + I_G + I_O + I_F1 + I_F2;
            for (int it = gw; it < NITEMS; it += NGW) {
                int r = it; const float* W; bf16* WT; int K, N, nblk, mode = 0;
                if (r < I_IN) { W = w_in + (size_t)l * DM * NIN; K = DM; N = NIN; WT = Win_t; nblk = NINP / 32; mode = 1; }
                else if ((r -= I_IN) < I_Q) { W = w_q_up + (size_t)l * 512 * 1536; K = 512; N = 1536; WT = Wq_t; nblk = 1536 / 32; }
                else if ((r -= I_Q) < I_KV) { W = w_kv_up + (size_t)l * 256 * 2048; K = 256; N = 2048; WT = Wkv_t; nblk = 2048 / 32; }
                else if ((r -= I_KV) < I_C) { W = w_conv_out + (size_t)l * 512 * DM; K = 512; N = DM; WT = Wc_t; nblk = DM / 32; }
                else if ((r -= I_C) < I_M) { W = w_mla_out + (size_t)l * 1024 * DM; K = 1024; N = DM; WT = Wm_t; nblk = DM / 32; }
                else if ((r -= I_M) < I_G) { W = w_gqa_out + (size_t)l * 512 * DM; K = 512; N = DM; WT = Wg_t; nblk = DM / 32; }
                else if ((r -= I_G) < I_O) { W = w_out + (size_t)l * DM * DM; K = DM; N = DM; WT = Wo_t; nblk = DM / 32; }
                else if ((r -= I_O) < I_F1) { W = w_ffn_in + (size_t)l * DM * 2 * DFF; K = DM; N = 2 * DFF; WT = Wf1_t; nblk = 2 * DFF / 32; mode = 2; }
                else { r -= I_F1; W = w_ffn_out + (size_t)l * DFF * DM; K = DFF; N = DM; WT = Wf2_t; nblk = DM / 32; }
                cvt_item(W, K, N, WT, scr, r, nblk, lane, mode);
            }
        }
#define NORM_LDMOD(SEL, GVEC, SHOFF, SCOFF) do { const float* mp = modl + (size_t)(SEL) * NMOD; \
                _Pragma("unroll") for (int j = 0; j < 8; ++j) { const int c = 4 * ln_ + 256 * j; const f32x4 g = *(const f32x4*)((GVEC) + c), sc = *(const f32x4*)(mp + (SCOFF) + c); \
                    Aa[j] = g * (sc + 1.0f); Ss[j] = *(const f32x4*)(mp + (SHOFF) + c); } } while (0)
#define NORM_FINISH(R) do { float ss = 0.f; \
                _Pragma("unroll") for (int j = 0; j < 8; ++j) ss += (v[j][0] * v[j][0] + v[j][1] * v[j][1]) + (v[j][2] * v[j][2] + v[j][3] * v[j][3]); \
                const float rstd = 1.0f / sqrtf(wave_sum(ss) * (1.0f / DM) + EPS); \
                bf16* hp = Hb + (size_t)(R) * DM + 4 * ln_; \
                _Pragma("unroll") for (int j = 0; j < 8; ++j) { const f32x4 y = v[j] * rstd * Aa[j] + Ss[j]; v2u w; w.x = pk2(y[0], y[1]); w.y = pk2(y[2], y[3]); *(v2u*)(hp + 256 * j) = w; } } while (0)
#define NORM_ROWS(GVEC, SHOFF, SCOFF, FIRST, WITHCTX, PARTG) do { \
            int ln_ = lane; asm volatile("" : "+v"(ln_)); \
            f32x4 Aa[8], Ss[8]; \
            _Pragma("unroll") for (int j = 0; j < 8; ++j) { Aa[j] = (f32x4){0.f, 0.f, 0.f, 0.f}; Ss[j] = (f32x4){0.f, 0.f, 0.f, 0.f}; } \
            for (int gv_ = gw; gv_ < 2048; gv_ += NGW) { \
                NORM_LDMOD((gv_ * 16) >> 12, GVEC, SHOFF, SCOFF);                                   \
                _Pragma("nounroll") for (int ri = 0; ri < 16; ++ri) { int r = gv_ * 16 + ri; asm volatile("" : "+s"(r)); \
                    const bf16* sb_ = XB + (size_t)r * DM + 4 * ln_; f32x4 v[8]; \
                    _Pragma("unroll") for (int j = 0; j < 8; ++j) { const v2u t_ = *(const v2u*)(sb_ + 256 * j); v[j] = (f32x4){bflo(t_.x), bfhi(t_.x), bflo(t_.y), bfhi(t_.y)}; } \
                    NORM_FINISH(r); } \
                if (WITHCTX) { NORM_LDMOD(8, GVEC, SHOFF, SCOFF); int rc = gv_; asm volatile("" : "+s"(rc));     \
                    bf16* sb_ = XCB + (size_t)rc * DM + 4 * ln_; f32x4 v[8]; \
                    _Pragma("unroll") for (int j = 0; j < 8; ++j) { const v2u t_ = *(const v2u*)(sb_ + 256 * j); v[j] = (f32x4){bflo(t_.x), bfhi(t_.x), bflo(t_.y), bfhi(t_.y)}; } \
                    if ((PARTG) != nullptr) { const bf16* pp = PART + (size_t)rc * DM + 4 * ln_; \
                        _Pragma("unroll") for (int j = 0; j < 8; ++j) { const v2u q0_ = *(const v2u*)(pp + 256 * j), q1_ = *(const v2u*)(pp + (size_t)2048 * DM + 256 * j), q2_ = *(const v2u*)(pp + (size_t)2 * 2048 * DM + 256 * j), q3_ = *(const v2u*)(pp + (size_t)3 * 2048 * DM + 256 * j); \
                            const f32x4 p = ((f32x4){bflo(q0_.x), bfhi(q0_.x), bflo(q0_.y), bfhi(q0_.y)} + (f32x4){bflo(q1_.x), bfhi(q1_.x), bflo(q1_.y), bfhi(q1_.y)}) + ((f32x4){bflo(q2_.x), bfhi(q2_.x), bflo(q2_.y), bfhi(q2_.y)} + (f32x4){bflo(q3_.x), bfhi(q3_.x), bflo(q3_.y), bfhi(q3_.y)}); \
                            v[j] += *(const f32x4*)((PARTG) + 4 * ln_ + 256 * j) * p; } \
                        _Pragma("unroll") for (int j = 0; j < 8; ++j) { v2u w_; w_.x = pk2(v[j][0], v[j][1]); w_.y = pk2(v[j][2], v[j][3]); *(v2u*)(sb_ + 256 * j) = w_; } } \
                    NORM_FINISH(ML + rc); } } \
        } while (0)
        if (RUN(0)) { PHASE_BEGIN const float* gv = g_mix + (size_t)l * DM; const int first = (l == 0) ? 1 : 0;
            const float* pg = first ? nullptr : (MOD + ((size_t)(l - 1) * 9 + 8) * NMOD + 5 * DM);
            NORM_ROWS(gv, 0, DM, first, true, pg); }
        GRID_BAR();

        if (RUN(1)) { PHASE_BEGIN
            const bf16* A_ = Hb; const bf16* B_ = Win_t; asm volatile("" : "+s"(A_), "+s"(B_)); pg8::Gemm g{A_, B_, MT, NINP, DM}; pg8::StaticOrder S; S.init(Mg, NINP, G, bx); S.wgm = P1_WGM; if (lastl) S.set_extra(24, ML / 256, 24, 3);
            pg8::EpiWin E{Gb, CQ, KF, GK, GV, GQ, Ub, ROPE};
            pg8::gemm_phase<pg8::EpiWin, pg8::StaticOrder, true, true>(lds + RING_OFF, g, S, E);
        }
        GRID_BAR();

        if (RUN(2)) { PHASE_BEGIN
            LAS float* cw = (LAS float*)(lds + RING_OFF);
            for (int i = tid; i < 31 * 512; i += NWAVES * 64) cw[i] = conv_w[(size_t)l * 31 * 512 + i];
            __syncthreads();
            { const f32x4 gk = *(const f32x4*)(g_kv_a + (size_t)l * 256 + 4 * lane), gq0 = *(const f32x4*)(g_q_a + (size_t)l * 512 + 4 * lane), gq1 = *(const f32x4*)(g_q_a + (size_t)l * 512 + 256 + 4 * lane);
              for (int r0 = gw; r0 < MT; r0 += 2 * NGW) { const int r1 = (r0 + NGW < MT) ? r0 + NGW : r0;
                const bf16* p = CQ + (size_t)r0 * 768 + 4 * lane; const bf16* q = CQ + (size_t)r1 * 768 + 4 * lane;
#define LD4(P) ({ const v2u t_ = *(const v2u*)(P); (f32x4){bflo(t_.x), bfhi(t_.x), bflo(t_.y), bfhi(t_.y)}; })
                const f32x4 a = LD4(p), b0 = LD4(p + 256), b1 = LD4(p + 512), c = LD4(q), d0 = LD4(q + 256), d1 = LD4(q + 512);
#undef LD4
#define LR_ROW(R, A_, B0_, B1_) do { \
                const float sa = wave_sum((A_[0] * A_[0] + A_[1] * A_[1]) + (A_[2] * A_[2] + A_[3] * A_[3])); \
                const float sb = wave_sum(((B0_[0] * B0_[0] + B0_[1] * B0_[1]) + (B0_[2] * B0_[2] + B0_[3] * B0_[3])) + ((B1_[0] * B1_[0] + B1_[1] * B1_[1]) + (B1_[2] * B1_[2] + B1_[3] * B1_[3]))); \
                const float ra = 1.0f / sqrtf(sa * (1.0f / 256.0f) + EPS), rb = 1.0f / sqrtf(sb * (1.0f / 512.0f) + EPS); \
                const f32x4 ya = A_ * ra * gk, y0 = B0_ * rb * gq0, y1 = B1_ * rb * gq1; \
                v2u w; w.x = pk2(ya[0], ya[1]); w.y = pk2(ya[2], ya[3]); *(v2u*)(CKVn + (size_t)(R) * 256 + 4 * lane) = w; \
                w.x = pk2(y0[0], y0[1]); w.y = pk2(y0[2], y0[3]); *(v2u*)(QAn + (size_t)(R) * 512 + 4 * lane) = w; \
                w.x = pk2(y1[0], y1[1]); w.y = pk2(y1[2], y1[3]); *(v2u*)(QAn + (size_t)(R) * 512 + 256 + 4 * lane) = w; } while (0)
                LR_ROW(r0, a, b0, b1); LR_ROW(r1, c, d0, d1);
#undef LR_ROW
              } }
            { const int ch = 8 * lane;
              const f32x4 cb0 = *(const f32x4*)(conv_b + (size_t)l * 512 + ch), cb1 = *(const f32x4*)(conv_b + (size_t)l * 512 + ch + 4);
              const f32x4 lg0 = *(const f32x4*)(conv_ln_g + (size_t)l * 512 + ch), lg1 = *(const f32x4*)(conv_ln_g + (size_t)l * 512 + ch + 4);
              const f32x4 lb0 = *(const f32x4*)(conv_ln_b + (size_t)l * 512 + ch), lb1 = *(const f32x4*)(conv_ln_b + (size_t)l * 512 + ch + 4);
              for (int tok = gw; tok < Mg; tok += NGW) {
                int sb, pos, L; if (tok < ML) { sb = tok & ~4095; pos = tok & 4095; L = SEQ; } else { const int c = tok - ML; sb = ML + (c & ~255); pos = c & 255; L = CTXL; }
                f32x4 a0 = cb0, a1 = cb1;
                v4u xr[31];
                if (pos >= 15 && pos < L - 15) {
                    const bf16* up = Ub + (size_t)(sb + pos - 15) * 512 + ch;
#pragma unroll
                    for (int j = 0; j < 31; ++j) xr[j] = *(const v4u*)(up + (size_t)j * 512);
                    asm volatile("" ::: "memory");
#pragma unroll
                    for (int j = 0; j < 31; ++j) { const v4u x = xr[j];
                        const f32x4 w0 = *(const LAS f32x4*)(cw + j * 512 + ch), w1 = *(const LAS f32x4*)(cw + j * 512 + ch + 4);
                        const f32x4 x0 = {bflo(x.x), bfhi(x.x), bflo(x.y), bfhi(x.y)}, x1 = {bflo(x.z), bfhi(x.z), bflo(x.w), bfhi(x.w)};
                        a0 += w0 * x0; a1 += w1 * x1; if ((j & 3) == 3) asm volatile("" ::: "memory"); }
                } else {
#pragma unroll
                    for (int j = 0; j < 31; ++j) { int p = pos + j - 15; p = p < 0 ? 0 : (p >= L ? L - 1 : p); xr[j] = *(const v4u*)(Ub + (size_t)(sb + p) * 512 + ch); }
                    asm volatile("" ::: "memory");
#pragma unroll
                    for (int j = 0; j < 31; ++j) { const int p = pos + j - 15; const float ok = (p >= 0 && p < L) ? 1.0f : 0.0f; const v4u x = xr[j];
                        const f32x4 w0 = *(const LAS f32x4*)(cw + j * 512 + ch) * ok, w1 = *(const LAS f32x4*)(cw + j * 512 + ch + 4) * ok;
                        const f32x4 x0 = {bflo(x.x), bfhi(x.x), bflo(x.y), bfhi(x.y)}, x1 = {bflo(x.z), bfhi(x.z), bflo(x.w), bfhi(x.w)};
                        a0 += w0 * x0; a1 += w1 * x1; if ((j & 3) == 3) asm volatile("" ::: "memory"); }
                }
                const float mean = wave_sum((a0[0] + a0[1]) + (a0[2] + a0[3]) + (a1[0] + a1[1]) + (a1[2] + a1[3])) * (1.0f / 512.0f);
                const f32x4 d0 = a0 - mean, d1 = a1 - mean;
                const float var = wave_sum((d0[0] * d0[0] + d0[1] * d0[1]) + (d0[2] * d0[2] + d0[3] * d0[3]) + (d1[0] * d1[0] + d1[1] * d1[1]) + (d1[2] * d1[2] + d1[3] * d1[3])) * (1.0f / 512.0f);
                const float rstd = 1.0f / sqrtf(var + EPS);
                const f32x4 y0 = d0 * rstd * lg0 + lb0, y1 = d1 * rstd * lg1 + lb1;
                v4u w; w.x = pk2(y0[0] * sigmf(y0[0]), y0[1] * sigmf(y0[1])); w.y = pk2(y0[2] * sigmf(y0[2]), y0[3] * sigmf(y0[3]));
                w.z = pk2(y1[0] * sigmf(y1[0]), y1[1] * sigmf(y1[1])); w.w = pk2(y1[2] * sigmf(y1[2]), y1[3] * sigmf(y1[3]));
                *(v4u*)(UC + (size_t)tok * 512 + ch) = w; } }
        }
        GRID_BAR();

        if (RUN(3)) { PHASE_BEGIN
            const bf16* A0_ = QAn; const bf16* B0_ = Wq_t; const bf16* A1_ = CKVn; const bf16* B1_ = Wkv_t; asm volatile("" : "+s"(A0_), "+s"(B0_), "+s"(A1_), "+s"(B1_));
            pg8::SchedQKV S; S.nMq = Mg / 256; S.nNq = 1536 / 256; S.nMk = MT / 256; S.nNk = 2048 / 256; S.G = G; S.c = bx; S.Aq = A0_; S.Bq = B0_; S.Ak = A1_; S.Bk = B1_;
            pg8::EpiQKV E{pg8::EpiQup{MQ, ROPE}, pg8::EpiKV{KF, Vb}};
            pg8::gemm_stream<pg8::EpiQKV, pg8::SchedQKV>(lds + RING_OFF, S, E);
        }
        GRID_BAR();

        if (RUN(4)) { PHASE_BEGIN
            att::lchar* alds = (att::lchar*)(lds + RING_OFF);
            for (int u = vcu; u < 1024 + (lastl ? 0 : 64); u += G) {
                int b, h, q0row, NT;
                if (u < 1024) { const int bh = u >> 4, qb = u & 15; b = bh >> 3; h = bh & 7; q0row = b * SEQ + qb * 256; NT = 4 + SEQ / 64; }
                else { const int bh = u - 1024; b = bh >> 3; h = bh & 7; q0row = ML + b * CTXL; NT = 4; }
                att::attn_unit<192, 128, false, false, ATT_MLA_MODE>(MQ + (size_t)q0row * 1536 + h * 192, 1536, KF + h * 192, 1536, Vb + h * 128, 1024, OM + (size_t)q0row * 1024 + h * 128, 1024,
                                                       ML + b * CTXL, b * SEQ, NT, 0, 0, 0.f, alds);
            }
            for (int u = vcu; u < 1024 + (lastl ? 0 : 128); u += G) {
                int b, h, q0row, NT, qpos0, kpos0;
                if (u >= 1024 && u < 1088) continue;
                if (u < 1024) { const int bh = u >> 4, qb = u & 15; b = bh >> 3; h = bh & 7; q0row = b * SEQ + qb * 256; qpos0 = qb * 256;
                    const int klo = qpos0 - 128 < 0 ? 0 : qpos0 - 128, khi = qpos0 + 384 > SEQ ? SEQ : qpos0 + 384; kpos0 = klo; NT = 4 + (khi - klo) / 64; }
                else { const int bh = u - 1088; b = bh >> 3; h = bh & 7; q0row = ML + b * CTXL; NT = 4; qpos0 = 0; kpos0 = 0; }
                const float sk = gqa_sink[l * 8 + h] * 1.4426950408889634f;
                att::attn_unit<64, 64, true, true, ATT_GQA_MODE>(GQ + (size_t)q0row * 512 + h * 64, 512, GK + (h >> 2) * 64, 128, GV + (h >> 2) * 64, 128, OG + (size_t)q0row * 512 + h * 64, 512,
                                                   ML + b * CTXL, b * SEQ + kpos0, NT, qpos0, kpos0, sk, alds);
            }
            __syncthreads();
        }
        GRID_BAR();

        if (RUN(5)) { PHASE_BEGIN
            pg8::SchedMerge S; S.base.init(Mg, DM, G, bx); S.base.wgm = P5_WGM;
            { const bf16* a0_ = UC; const bf16* a1_ = OM; const bf16* a2_ = OG; const bf16* b0_ = Wc_t; const bf16* b1_ = Wm_t; const bf16* b2_ = Wg_t; asm volatile("" : "+s"(a0_), "+s"(a1_), "+s"(a2_), "+s"(b0_), "+s"(b1_), "+s"(b2_));
              S.a0 = (const char*)a0_; S.da1 = (const char*)a1_ - (const char*)a0_; S.da2 = (const char*)a2_ - (const char*)a1_; S.b0 = (const char*)b0_; S.db1 = (const char*)b1_ - (const char*)b0_; S.db2 = (const char*)b2_ - (const char*)b1_; }
            pg8::EpiChain E{Gb, Yb};
            pg8::gemm_stream<pg8::EpiChain, pg8::SchedMerge, true>(lds + RING_OFF, S, E);
        }
        GRID_BAR();

        if (RUN(6)) { PHASE_BEGIN
            const bf16* A_ = Yb; const bf16* B_ = Wo_t; asm volatile("" : "+s"(A_), "+s"(B_));
            pg8::SchedSplit S; S.A = A_; S.Bt = B_; S.K = DM; S.nlat = 1024; S.nctx = lastl ? 0 : 256; S.G = G; S.c = bx; S.wgm = SPLIT_WGM;
            pg8::EpiSplit E{pg8::EpiResid{XB, modl, 2 * DM}, PART};
            pg8::gemm_stream<pg8::EpiSplit, pg8::SchedSplit>(lds + RING_OFF, S, E);
        }
        GRID_BAR();

        if (RUN(7)) { PHASE_BEGIN const float* gv = g_ffn + (size_t)l * DM; const float* pg = lastl ? nullptr : (modl + (size_t)8 * NMOD + 2 * DM);
            const int first = (l == 0) ? 2 : 0; NORM_ROWS(gv, 3 * DM, 4 * DM, first, !lastl, pg); }
        GRID_BAR();

        if (RUN(8)) { PHASE_BEGIN
            const bf16* A_ = Hb; const bf16* B_ = Wf1_t; asm volatile("" : "+s"(A_), "+s"(B_)); pg8::Gemm g{A_, B_, MT, 2 * DFF, DM}; pg8::StaticOrder S; S.init(Mg, 2 * DFF, G, bx); S.wgm = P8_WGM; pg8::EpiSwiGLU E{HID};
            pg8::gemm_phase<pg8::EpiSwiGLU, pg8::StaticOrder, true, true>(lds + RING_OFF, g, S, E);
        }
        GRID_BAR();

        if (RUN(9)) { PHASE_BEGIN
            const bf16* A_ = HID; const bf16* B_ = Wf2_t; asm volatile("" : "+s"(A_), "+s"(B_));
            pg8::SchedSplit S; S.A = A_; S.Bt = B_; S.K = DFF; S.nlat = 1024; S.nctx = lastl ? 0 : 256; S.G = G; S.c = bx; S.wgm = SPLIT_WGM;
            pg8::EpiSplit E{pg8::EpiResid{XB, modl, 5 * DM}, PART};
            pg8::gemm_stream<pg8::EpiSplit, pg8::SchedSplit>(lds + RING_OFF, S, E);
        }
        GRID_BAR();
    }

    if (RUN(PH_POST)) { PHASE_BEGIN
        f32x4 gf[8];
#pragma unroll
        for (int j = 0; j < 8; ++j) gf[j] = *(const f32x4*)(g_final + 4 * lane + 256 * j);
        for (int r = gw; r < ML; r += NGW) { float* p = XL + (size_t)r * DM + 4 * lane; const bf16* sb = XB + (size_t)r * DM + 4 * lane; f32x4 v[8]; float ss = 0.f;
#pragma unroll
            for (int j = 0; j < 8; ++j) { const v2u t_ = *(const v2u*)(sb + 256 * j); v[j] = (f32x4){bflo(t_.x), bfhi(t_.x), bflo(t_.y), bfhi(t_.y)}; ss += (v[j][0] * v[j][0] + v[j][1] * v[j][1]) + (v[j][2] * v[j][2] + v[j][3] * v[j][3]); }
            const float rstd = 1.0f / sqrtf(wave_sum(ss) * (1.0f / DM) + EPS);
#pragma unroll
            for (int j = 0; j < 8; ++j) *(f32x4*)(p + 256 * j) = v[j] * rstd * gf[j]; }
    }

#if defined(DBG_STAGE)
    if (RUN(PH_DUMP)) { PHASE_BEGIN
        const int sel = ap->pad0; const size_t total = (size_t)G * NWAVES * 64, gt = (size_t)bx * NWAVES * 64 + tid;
        for (size_t i = gt; i < (size_t)ML * DM; i += total) { float v = 0.f;
#define DB16(bit, P, N) if (sel & (bit)) v += __uint_as_float((unsigned)(P)[i % (size_t)(N)] << 16)
            if (sel & 1) v += MOD[i % (size_t)(DEPTH * 9 * NMOD)];
            DB16(2, Hb, (size_t)MT * 2048); DB16(4, Gb, (size_t)MT * 6144); DB16(8, KF, (size_t)MT * 1536); DB16(16, Vb, (size_t)MT * 1024); DB16(32, GQ, (size_t)MT * 512);
            DB16(64, UC, (size_t)MT * 512); DB16(128, MQ, (size_t)MT * 1536); DB16(256, OM, (size_t)MT * 1024); DB16(512, OG, (size_t)MT * 512); DB16(1024, Yb, (size_t)MT * 2048);
            DB16(2048, Win_t, (size_t)NINP * 2048); DB16(4096, GK, (size_t)MT * 128); DB16(8192, GV, (size_t)MT * 128); DB16(16384, CKVn, (size_t)MT * 256); DB16(32768, QAn, (size_t)MT * 512);
            DB16(65536, Ub, (size_t)MT * 512); DB16(131072, Wf1_t, (size_t)2 * DFF * DM); DB16(262144, Wf2_t, (size_t)DM * DFF); DB16(524288, HID, (size_t)MT * DFF);
            if (sel & 1048576) v += CQ[i % ((size_t)MT * 768)];
            XL[i] = v; }
    }
#endif
#undef RUN
#undef GRID_BAR
#undef NORM_ROWS
}

#ifndef MK_MULTI
#define MK_MULTI 0
#endif
extern "C" void kernel_launch(void* const* d_in, const int* in_sizes, int n_in, void* d_out, int out_size, void* d_ws, size_t ws_size, hipStream_t stream) {
    static int grid = 0;
    if (grid == 0) {
        if (n_in != 25 || in_sizes[0] != ML * DM || out_size != ML * DM || ws_size < WS_END) {
            fprintf(stderr, "kernel_launch: shape mismatch: n_in %d in0 %d out %d ws %zu (need %zu)\n", n_in, n_in > 0 ? in_sizes[0] : -1, out_size, ws_size, (size_t)WS_END); grid = -1; return; }
        int dev = 0, cus = 0, per_cu = 0;
        if (hipGetDevice(&dev) != hipSuccess || hipDeviceGetAttribute(&cus, hipDeviceAttributeMultiprocessorCount, dev) != hipSuccess) { grid = -1; return; }
        if (hipFuncSetAttribute((const void*)mega_fwd, hipFuncAttributeMaxDynamicSharedMemorySize, LDS_BYTES) != hipSuccess) { fprintf(stderr, "kernel_launch: hipFuncSetAttribute failed\n"); grid = -1; return; }
        if (hipOccupancyMaxActiveBlocksPerMultiprocessor(&per_cu, (const void*)mega_fwd, NWAVES * 64, LDS_BYTES) != hipSuccess || per_cu < 1)
            fprintf(stderr, "kernel_launch: note: occupancy query reports %d workgroups per CU\n", per_cu);
        (void)hipGetLastError();
        grid = cus;
    }
    if (grid < 0) return;
    if (hipMemsetAsync((char*)d_ws + WS_CTL, 0, CTL_ZERO_BYTES, stream) != hipSuccess) return;
    Args a{};
    for (int i = 0; i < 25; ++i) a.in[i] = (const float*)d_in[i];
    a.out = (float*)d_out; a.ws = (unsigned char*)d_ws;
#if defined(DBG_STAGE)
    a.multi = 1;
    a.l_lo = 0; a.l_hi = 0; a.ph = PH_PRE; hipLaunchKernelGGL(mega_fwd, dim3(grid), dim3(NWAVES * 64), LDS_BYTES, stream, a);
    for (int p = 0; p <= DBG_STAGE; ++p) { a.l_lo = 0; a.l_hi = 1; a.ph = p; hipLaunchKernelGGL(mega_fwd, dim3(grid), dim3(NWAVES * 64), LDS_BYTES, stream, a); }
    a.l_lo = 0; a.l_hi = 0; a.ph = PH_DUMP; a.pad0 = DBG_SEL; hipLaunchKernelGGL(mega_fwd, dim3(grid), dim3(NWAVES * 64), LDS_BYTES, stream, a);
#elif MK_MULTI
    a.multi = 1;
    a.l_lo = 0; a.l_hi = 0; a.ph = PH_PRE; hipLaunchKernelGGL(mega_fwd, dim3(grid), dim3(NWAVES * 64), LDS_BYTES, stream, a);
    for (int l = 0; l < DEPTH; ++l) for (int p = 0; p < 10; ++p) { a.l_lo = l; a.l_hi = l + 1; a.ph = p; hipLaunchKernelGGL(mega_fwd, dim3(grid), dim3(NWAVES * 64), LDS_BYTES, stream, a); }
    a.l_lo = 0; a.l_hi = 0; a.ph = PH_POST; hipLaunchKernelGGL(mega_fwd, dim3(grid), dim3(NWAVES * 64), LDS_BYTES, stream, a);
#else
    a.multi = 0; a.l_lo = 0; a.l_hi = DEPTH; a.ph = 0;
    hipLaunchKernelGGL(mega_fwd, dim3(grid), dim3(NWAVES * 64), LDS_BYTES, stream, a);
#endif
    const hipError_t le = hipPeekAtLastError();
    if (le != hipSuccess) fprintf(stderr, "kernel_launch: launch failed: %s\n", hipGetErrorName(le));
}
```

```cpp
#include <hip/hip_runtime.h>
#include <cstdio>
#include <cstdint>
#define GAS __attribute__((address_space(1)))
#define LAS __attribute__((address_space(3)))
namespace pg8 {
#define PG8_LAS __attribute__((address_space(3)))
typedef unsigned short bf16_t;
typedef short bf16x8 __attribute__((ext_vector_type(8)));
typedef float f32x4 __attribute__((ext_vector_type(4)));
typedef unsigned u32x4 __attribute__((ext_vector_type(4)));
constexpr int BM = 256, BK = 64, HALF = 128, HTB = HALF * BK * 2  , STAGE_BYTES = 8 * HTB, NXCD = 8, WGM = 8;

__host__ __device__ __forceinline__ int lds_byte(int r, int c) { const int st = (r >> 4) * 2 + (c >> 5), rr = r & 15, cc = c & 31, ob = rr * 64 + cc * 2; return st * 1024 + (ob ^ (((ob >> 9) & 1) << 5)); }
__host__ __device__ __forceinline__ void stage_rc(int b, int& R, int& C) { const int st = b / 1024, sb = b % 1024, swz = sb ^ (((sb >> 9) & 1) << 5); R = (st >> 1) * 16 + swz / 64; C = (st & 1) * 32 + (swz % 64) / 2; }
__host__ __device__ __forceinline__ int perm32(int rho) { const int n = rho >> 4, i = rho & 15; return 8 * (i >> 2) + 4 * n + (i & 3); }

struct Unit { int pm, pn; };
struct Gemm { const bf16_t* A; const bf16_t* Bt; int M, N, K; };

struct StaticOrder {
    int nM, nN, nwg, G, c, ext_n, ext_pm0, ext_pn0, ext_w, wgm, ext_c0;
    __host__ __device__ void init(int M, int N, int G_, int c_) { nM = M / BM; nN = N / BM; nwg = nM * nN; G = G_; c = c_; ext_n = 0; ext_pm0 = 0; ext_pn0 = 0; ext_w = 1; wgm = WGM; ext_c0 = 0; }
    __host__ __device__ void set_extra(int n, int pm0, int pn0, int w) { ext_n = n; ext_pm0 = pm0; ext_pn0 = pn0; ext_w = w; }
    __host__ __device__ bool next(int i, Unit& u) const {
        const long L = (long)i * G + c;
        if (L >= nwg) { const int e = (int)(L - nwg) - ext_c0; if (e < 0 || e >= ext_n) return false; u.pm = ext_pm0 + e / ext_w; u.pn = ext_pn0 + e % ext_w; return true; }
        int wgid = (int)L; { const int q = nwg / NXCD, r = nwg % NXCD, xcd = wgid % NXCD, off = wgid / NXCD; wgid = (xcd < r ? xcd * (q + 1) : r * (q + 1) + (xcd - r) * q) + off; }
        const int nig = wgm * nN, gid = wgid / nig, fm = gid * wgm, gsz = (nM - fm) < wgm ? (nM - fm) : wgm;
        u.pm = fm + ((wgid % nig) % gsz); u.pn = (wgid % nig) / gsz; return true;
    }
    static __host__ __device__ __forceinline__ void map_entry(int nM_, int nN_, int L, Unit& u, int WGM_ = WGM) {
        const int nwg_ = nM_ * nN_; int wgid = L; { const int q = nwg_ / NXCD, r = nwg_ % NXCD, xcd = wgid % NXCD, off = wgid / NXCD; wgid = (xcd < r ? xcd * (q + 1) : r * (q + 1) + (xcd - r) * q) + off; }
        const int nig = WGM_ * nN_, gid = wgid / nig, fm = gid * WGM_, gsz = (nM_ - fm) < WGM_ ? (nM_ - fm) : WGM_;
        u.pm = fm + ((wgid % nig) % gsz); u.pn = (wgid % nig) / gsz;
    }
    __device__ __forceinline__ void a_ready(const Unit&) const {}
    __device__ __forceinline__ void done(const Unit&) const {}
};
struct MergeOrder : StaticOrder {
    const unsigned* wflag; unsigned* tmo;
    __device__ __forceinline__ void a_ready(const Unit& u) const {
        if (wflag == nullptr || ext_n == 0 || u.pm < ext_pm0) return;
        if (threadIdx.x < 64) {
            const unsigned* f = wflag + (size_t)((u.pm - ext_pm0) * ext_w + (u.pn - ext_pn0)) * 16;
            const unsigned long long t0 = __builtin_amdgcn_s_memrealtime(); unsigned polls = 0;
            while ((unsigned)__builtin_amdgcn_readfirstlane(__hip_atomic_load(f, __ATOMIC_RELAXED, __HIP_MEMORY_SCOPE_AGENT)) == 0u) {
                if ((++polls & 255u) == 0u && __builtin_amdgcn_readfirstlane(__hip_atomic_load(tmo, __ATOMIC_RELAXED, __HIP_MEMORY_SCOPE_AGENT)) != 0u) break;
                if (__builtin_amdgcn_s_memrealtime() - t0 > 2000000ull) { if (threadIdx.x == 0) __hip_atomic_store(tmo, 1u, __ATOMIC_RELAXED, __HIP_MEMORY_SCOPE_AGENT); break; }
                __builtin_amdgcn_s_sleep(2); }
            __builtin_amdgcn_fence(__ATOMIC_ACQUIRE, "agent");
            asm volatile("s_waitcnt vmcnt(0)" ::: "memory");
        }
        asm volatile("" ::: "memory"); __builtin_amdgcn_s_barrier(); asm volatile("" ::: "memory");
    }
};
typedef float f32x2_t __attribute__((ext_vector_type(2))); typedef __bf16 bf16x2_t __attribute__((ext_vector_type(2)));
__device__ __forceinline__ unsigned cvt_pk_bf16(float lo, float hi) { f32x2_t v = {lo, hi}; bf16x2_t b = __builtin_convertvector(v, bf16x2_t); return __builtin_bit_cast(unsigned, b); }
typedef float f32x2 __attribute__((ext_vector_type(2)));
template <class Epi, class Sched, bool ALIGN_EPI = false, bool SP2 = false>
__device__ __forceinline__ void gemm_phase(PG8_LAS unsigned char* lds, const Gemm g, const Sched& S, const Epi& E) {
    int tid_ = threadIdx.x; asm volatile("" : "+v"(tid_));
    const int tid = tid_, wid = __builtin_amdgcn_readfirstlane(tid >> 6), lane = tid & 63, wr = wid >> 2, wc = wid & 3, fr = lane & 15, fq = lane >> 4;
    const int K = g.K, nt = K / BK;
    unsigned voffA[2], voffB[2];
#pragma unroll
    for (int i = 0; i < 2; ++i) { int R, C; stage_rc(tid * 16 + i * 8192, R, C); const int Rb = Epi::PERM ? ((R & ~31) + perm32(R & 31)) : R;
        voffA[i] = (unsigned)(R * K + C) * 2u; voffB[i] = (unsigned)(Rb * K + C) * 2u; }
    const size_t kstep = (size_t)(BK * 2);
    const size_t hstep = (size_t)HALF * K * 2;
    const size_t tstep = 2 * hstep;
    const unsigned ldsw = (unsigned)wid * 1024u;
    const int aoff = lds_byte(wr * 64 + fr, fq * 8), boff = lds_byte(wc * 32 + fr, fq * 8);
#define PG8_SA(b, h) (((b) * 2 + (h)) * HTB)
#define PG8_SB(b, h) ((4 + (b) * 2 + (h)) * HTB)
#define PG8_STAGE(bufoff, gbase, voff) do { _Pragma("unroll") for (int _i = 0; _i < 2; ++_i) \
        __builtin_amdgcn_global_load_lds((const unsigned*)((const char*)(gbase) + (voff)[_i]), (PG8_LAS unsigned*)(lds + (bufoff) + ldsw + _i * 8192), 16, 0, 0); } while (0)
#define PG8_LDA(dst, b, h) do { _Pragma("unroll") for (int m = 0; m < 4; ++m) _Pragma("unroll") for (int k = 0; k < 2; ++k) dst[m][k] = *(const PG8_LAS bf16x8*)(lds + PG8_SA(b, h) + aoff + m * 2048 + k * 1024); } while (0)
#define PG8_LDB(dst, b, h) do { _Pragma("unroll") for (int n = 0; n < 2; ++n) _Pragma("unroll") for (int k = 0; k < 2; ++k) dst[n][k] = *(const PG8_LAS bf16x8*)(lds + PG8_SB(b, h) + boff + n * 2048 + k * 1024); } while (0)
#define PG8_MMA(ai, bj, At, Bt) do { __builtin_amdgcn_s_setprio(1); _Pragma("unroll") for (int m = 0; m < 4; ++m) _Pragma("unroll") for (int n = 0; n < 2; ++n) _Pragma("unroll") for (int k = 0; k < 2; ++k) \
        acc[ai][bj][m][n] = __builtin_amdgcn_mfma_f32_16x16x32_bf16(Bt[n][k], At[m][k], acc[ai][bj][m][n], 0, 0, 0); __builtin_amdgcn_s_setprio(0); } while (0)
#define PG8_WAIT_V(n) asm volatile("s_waitcnt vmcnt(" #n ")" ::: "memory")
#define PG8_WAIT_L(n) asm volatile("s_waitcnt lgkmcnt(" #n ")" ::: "memory")
#define PG8_BAR __builtin_amdgcn_s_barrier()
#define PG8_SCHED __builtin_amdgcn_sched_barrier(0)
    Unit cur, nxt; int ui = 0;
    if (!S.next(0, cur)) return;
    f32x4 acc[2][2][4][2];
#pragma unroll
    for (int a = 0; a < 2; ++a)
#pragma unroll
        for (int b = 0; b < 2; ++b)
#pragma unroll
            for (int m = 0; m < 4; ++m)
#pragma unroll
                for (int n = 0; n < 2; ++n) acc[a][b][m][n] = (f32x4){0.f, 0.f, 0.f, 0.f};
    bf16x8 At[4][2], B0[2][2], B1[2][2];
    const char* cA = (const char*)g.A + (size_t)cur.pm * tstep; const char* cB = (const char*)g.Bt + (size_t)cur.pn * tstep;
    S.a_ready(cur);
    if constexpr (SP2) {
        PG8_STAGE(PG8_SB(0, 0), cB, voffB); PG8_STAGE(PG8_SB(0, 1), cB + hstep, voffB); PG8_STAGE(PG8_SA(0, 0), cA, voffA); PG8_STAGE(PG8_SA(0, 1), cA + hstep, voffA);
        if (wr == 1) PG8_BAR;
        PG8_WAIT_V(2); PG8_BAR;
        PG8_STAGE(PG8_SB(1, 0), cB + kstep, voffB); PG8_STAGE(PG8_SA(1, 0), cA + kstep, voffA); PG8_STAGE(PG8_SB(1, 1), cB + hstep + kstep, voffB);
        PG8_WAIT_V(6); PG8_BAR;
    } else {
        PG8_STAGE(PG8_SB(0, 0), cB, voffB); PG8_STAGE(PG8_SA(0, 0), cA, voffA); PG8_STAGE(PG8_SB(0, 1), cB + hstep, voffB); PG8_STAGE(PG8_SA(0, 1), cA + hstep, voffA);
        if (wr == 1) PG8_BAR;
        PG8_WAIT_V(4); PG8_BAR;
        PG8_STAGE(PG8_SB(1, 0), cB + kstep, voffB); PG8_STAGE(PG8_SA(1, 0), cA + kstep, voffA); PG8_STAGE(PG8_SB(1, 1), cB + hstep + kstep, voffB);
        PG8_WAIT_V(6); PG8_BAR;
    }
    for (;;) {
        const bool has_next = S.next(ui + 1, nxt);
        const char* nA = has_next ? (const char*)g.A + (size_t)nxt.pm * tstep : cA; const char* nB = has_next ? (const char*)g.Bt + (size_t)nxt.pn * tstep : cB;
#pragma nounroll
        for (int t = 0; t < nt; t += 2) {
            const bool last = (t == nt - 2);
            const char* a1 = cA + (size_t)(t + 1) * kstep;
            const char* a2 = last ? nA : cA + (size_t)(t + 2) * kstep; const char* b2 = last ? nB : cB + (size_t)(t + 2) * kstep;
            const char* a3 = a2 + kstep; const char* b3 = b2 + kstep;
            if (last && has_next) S.a_ready(nxt);
            if constexpr (SP2) {
            PG8_LDB(B0, 0, 0); PG8_LDB(B1, 0, 1); PG8_SCHED; PG8_LDA(At, 0, 0); PG8_STAGE(PG8_SA(1, 1), a1 + hstep, voffA);
            PG8_WAIT_V(8); PG8_WAIT_L(0); PG8_BAR; PG8_MMA(0, 0, At, B0); PG8_MMA(0, 1, At, B1); PG8_BAR; PG8_SCHED;
            PG8_LDA(At, 0, 1); PG8_STAGE(PG8_SB(0, 0), b2, voffB); PG8_STAGE(PG8_SB(0, 1), b2 + hstep, voffB); PG8_STAGE(PG8_SA(0, 0), a2, voffA);
            PG8_WAIT_V(8); PG8_WAIT_L(0); PG8_BAR; PG8_MMA(1, 0, At, B0); PG8_MMA(1, 1, At, B1); PG8_BAR; PG8_SCHED;
            PG8_LDB(B0, 1, 0); PG8_LDB(B1, 1, 1); PG8_SCHED; PG8_LDA(At, 1, 0); PG8_STAGE(PG8_SA(0, 1), a2 + hstep, voffA);
            PG8_WAIT_V(8); PG8_WAIT_L(0); PG8_BAR; PG8_MMA(0, 0, At, B0); PG8_MMA(0, 1, At, B1); PG8_BAR; PG8_SCHED;
            PG8_LDA(At, 1, 1); PG8_STAGE(PG8_SB(1, 0), b3, voffB); PG8_STAGE(PG8_SB(1, 1), b3 + hstep, voffB); PG8_STAGE(PG8_SA(1, 0), a3, voffA);
            PG8_WAIT_V(8); PG8_WAIT_L(0); PG8_BAR; PG8_MMA(1, 0, At, B0); PG8_MMA(1, 1, At, B1); PG8_BAR; PG8_SCHED;
            } else {
            PG8_LDB(B0, 0, 0); PG8_SCHED; PG8_LDA(At, 0, 0); PG8_STAGE(PG8_SA(1, 1), a1 + hstep, voffA);
            PG8_WAIT_L(8); PG8_BAR; PG8_WAIT_L(0); PG8_MMA(0, 0, At, B0); PG8_BAR; PG8_SCHED;
            PG8_LDB(B1, 0, 1); PG8_STAGE(PG8_SB(0, 0), b2, voffB);
            PG8_BAR; PG8_WAIT_L(0); PG8_MMA(0, 1, At, B1); PG8_BAR;
            PG8_LDA(At, 0, 1); PG8_STAGE(PG8_SA(0, 0), a2, voffA);
            PG8_BAR; PG8_WAIT_L(0); PG8_MMA(1, 0, At, B0); PG8_BAR; PG8_SCHED;
            PG8_STAGE(PG8_SB(0, 1), b2 + hstep, voffB);
            PG8_WAIT_V(6); PG8_BAR; PG8_MMA(1, 1, At, B1); PG8_BAR;
            PG8_LDB(B0, 1, 0); PG8_SCHED; PG8_LDA(At, 1, 0); PG8_STAGE(PG8_SA(0, 1), a2 + hstep, voffA);
            PG8_WAIT_L(8); PG8_BAR; PG8_WAIT_L(0); PG8_MMA(0, 0, At, B0); PG8_BAR; PG8_SCHED;
            PG8_LDB(B1, 1, 1); PG8_STAGE(PG8_SB(1, 0), b3, voffB);
            PG8_BAR; PG8_WAIT_L(0); PG8_MMA(0, 1, At, B1); PG8_BAR;
            PG8_LDA(At, 1, 1); PG8_STAGE(PG8_SA(1, 0), a3, voffA);
            PG8_BAR; PG8_WAIT_L(0); PG8_MMA(1, 0, At, B0); PG8_BAR; PG8_SCHED;
            PG8_STAGE(PG8_SB(1, 1), b3 + hstep, voffB);
            PG8_WAIT_V(6); PG8_BAR; PG8_MMA(1, 1, At, B1); PG8_BAR;
            }
        }
        if constexpr (ALIGN_EPI) { if (wr == 0) PG8_BAR; }
        if constexpr (!Epi::AFTER_DRAIN) { E(acc, cur, wr, wc, fr, fq); S.done(cur); }
        if (!has_next) break;
#pragma unroll
        for (int a = 0; a < 2; ++a)
#pragma unroll
            for (int b = 0; b < 2; ++b)
#pragma unroll
                for (int m = 0; m < 4; ++m)
#pragma unroll
                    for (int n = 0; n < 2; ++n) acc[a][b][m][n] = (f32x4){0.f, 0.f, 0.f, 0.f};
        cur = nxt; cA = nA; cB = nB; ++ui;
        if constexpr (ALIGN_EPI) { if (wr == 1) PG8_BAR; }
    }
    PG8_WAIT_V(0);
    if constexpr (!ALIGN_EPI) { if (wr == 0) PG8_BAR; }
    PG8_BAR;
    if constexpr (Epi::AFTER_DRAIN) { E.fused(acc, cur, wr, wc, fr, fq, lds, wid, lane); S.done(cur); }
#undef PG8_SA
#undef PG8_SB
#undef PG8_STAGE
#undef PG8_LDA
#undef PG8_LDB
#undef PG8_MMA
#undef PG8_WAIT_V
#undef PG8_WAIT_L
#undef PG8_BAR
#undef PG8_SCHED
}
}
namespace pg8 {
typedef unsigned u32x2 __attribute__((ext_vector_type(2)));
constexpr int ML_ROWS = 32768;
__device__ __forceinline__ float sigm(float x) { return __builtin_amdgcn_rcpf(1.0f + __builtin_amdgcn_exp2f(-1.4426950408889634f * x)); }
__device__ __forceinline__ u32x2 pack4(const f32x4 v) { u32x2 w; w.x = cvt_pk_bf16(v[0], v[1]); w.y = cvt_pk_bf16(v[2], v[3]); return w; }
__device__ __forceinline__ void rope4(f32x4& x0, f32x4& x1, const float* rope, int row, int half, int fq) {
    const int t = row & 4095, p = half ? (t & 63) : (t >> 6);
    const f32x4* tp = (const f32x4*)(rope + (p * 16 + 4 * fq) * 2);
    const f32x4 a = tp[0], b = tp[1];
    const f32x4 c = {a[0], a[2], b[0], b[2]}, s = {a[1], a[3], b[1], b[3]};
    const f32x4 y0 = x0 * c - x1 * s, y1 = x1 * c + x0 * s;
    x0 = y0; x1 = y1;
}
struct EpiWin {
    static constexpr bool PERM = true, AFTER_DRAIN = false;
    unsigned char* G; bf16_t* CQ; bf16_t* KF; bf16_t* GK; bf16_t* GV; bf16_t* GQ; bf16_t* U; const float* rope;
    __device__ __forceinline__ void operator()(const f32x4 (&acc)[2][2][4][2], const Unit& u, int wr, int wc, int fr, int fq) const {
        const int row0 = u.pm * BM + wr * 64 + fr; const bool lat = u.pm < (ML_ROWS / BM);
#pragma unroll
        for (int bj = 0; bj < 2; ++bj) {
            const int colg = u.pn * BM + bj * HALF + wc * 32;
            if (colg < 6144) {
#pragma unroll
                for (int ai = 0; ai < 2; ++ai)
#pragma unroll
                    for (int m = 0; m < 4; ++m) { const size_t row = (size_t)(row0 + ai * HALF + m * 16);
                        u32x2 gq;
#pragma unroll
                        for (int n = 0; n < 2; ++n) { const f32x4 v = acc[ai][bj][m][n];
#define SG8(x) ((unsigned)(__builtin_amdgcn_rcpf(1.0f + __builtin_amdgcn_exp2f(x)) * 255.0f + 0.5f))
                            const unsigned q0 = SG8(v[0]), q1 = SG8(v[1]), q2 = SG8(v[2]), q3 = SG8(v[3]);
#undef SG8
                            const unsigned w4 = q0 | (q1 << 8) | (q2 << 16) | (q3 << 24); if (n == 0) gq.x = w4; else gq.y = w4; }
                        *(u32x2*)(G + row * 6144 + colg + 8 * fq) = gq; }
            } else {
                const int o = colg - 6144;
                if (o < 256 || (o >= 576 && o < 1088)) {
                    const int co = (o < 256) ? o : (256 + o - 576);
#pragma unroll
                    for (int ai = 0; ai < 2; ++ai)
#pragma unroll
                        for (int m = 0; m < 4; ++m) { const size_t row = (size_t)(row0 + ai * HALF + m * 16);
#pragma unroll
                            for (int n = 0; n < 1; ++n) { const u32x2 w0 = pack4(acc[ai][bj][m][0]), w1 = pack4(acc[ai][bj][m][1]); u32x4 w; w.x = w0.x; w.y = w0.y; w.z = w1.x; w.w = w1.y; *(u32x4*)(CQ + row * 768 + co + 8 * fq) = w; } }
                } else if (o < 320) {
                    const int half = (o - 256) >> 5;
#pragma unroll
                    for (int ai = 0; ai < 2; ++ai)
#pragma unroll
                        for (int m = 0; m < 4; ++m) { const int r = row0 + ai * HALF + m * 16; f32x4 x0 = acc[ai][bj][m][0], x1 = acc[ai][bj][m][1];
                            if (lat) rope4(x0, x1, rope, r, half, fq);
                            const u32x2 w0 = pack4(x0), w1 = pack4(x1); bf16_t* p = KF + (size_t)r * 1536 + 128 + (o - 256) + 4 * fq;
#pragma unroll
                            for (int h = 0; h < 8; ++h) { *(u32x2*)(p + h * 192) = w0; *(u32x2*)(p + h * 192 + 16) = w1; } }
                } else if (o < 448 || (o >= 1088 && o < 1600)) {
                    const bool isk = o < 448; const int co = isk ? (o - 320) : (o - 1088); const int half = (co >> 5) & 1;
                    bf16_t* base = isk ? GK : GQ; const int ld = isk ? 128 : 512;
#pragma unroll
                    for (int ai = 0; ai < 2; ++ai)
#pragma unroll
                        for (int m = 0; m < 4; ++m) { const int r = row0 + ai * HALF + m * 16; f32x4 x0 = acc[ai][bj][m][0], x1 = acc[ai][bj][m][1];
                            if (lat) rope4(x0, x1, rope, r, half, fq);
                            bf16_t* p = base + (size_t)r * ld + co + 4 * fq; *(u32x2*)p = pack4(x0); *(u32x2*)(p + 16) = pack4(x1); }
                } else if (o < 576) {
#pragma unroll
                    for (int ai = 0; ai < 2; ++ai)
#pragma unroll
                        for (int m = 0; m < 4; ++m) { const size_t row = (size_t)(row0 + ai * HALF + m * 16); bf16_t* p = GV + row * 128 + (o - 448) + 8 * fq;
                            const u32x2 w0 = pack4(acc[ai][bj][m][0]), w1 = pack4(acc[ai][bj][m][1]); u32x4 w; w.x = w0.x; w.y = w0.y; w.z = w1.x; w.w = w1.y; *(u32x4*)p = w; }
                } else if (o < 2624) {
                    const int g = (o - 1600) >> 5;
#pragma unroll
                    for (int ai = 0; ai < 2; ++ai)
#pragma unroll
                        for (int m = 0; m < 4; ++m) { const size_t row = (size_t)(row0 + ai * HALF + m * 16); const f32x4 a = acc[ai][bj][m][0], b = acc[ai][bj][m][1];
                            const f32x4 uu = {a[0] * sigm(b[0]), a[1] * sigm(b[1]), a[2] * sigm(b[2]), a[3] * sigm(b[3])};
                            *(u32x2*)(U + row * 512 + 16 * g + 4 * fq) = pack4(uu); }
                }
            }
        }
    }
};
struct EpiQup {
    static constexpr bool PERM = false, AFTER_DRAIN = false;
    bf16_t* MQ; const float* rope;
    __device__ __forceinline__ void operator()(const f32x4 (&acc)[2][2][4][2], const Unit& u, int wr, int wc, int fr, int fq) const {
        const int row0 = u.pm * BM + wr * 64 + fr; const bool lat = u.pm < (ML_ROWS / BM);
#pragma unroll
        for (int bj = 0; bj < 2; ++bj) {
            const int colg = u.pn * BM + bj * HALF + wc * 32, hd = colg % 192; const bool isr = hd >= 128; const int half = (hd - 128) >> 5;
#pragma unroll
            for (int ai = 0; ai < 2; ++ai)
#pragma unroll
                for (int m = 0; m < 4; ++m) { const int r = row0 + ai * HALF + m * 16; f32x4 x0 = acc[ai][bj][m][0], x1 = acc[ai][bj][m][1];
                    if (isr && lat) rope4(x0, x1, rope, r, half, fq);
                    bf16_t* p = MQ + (size_t)r * 1536 + colg + 4 * fq; *(u32x2*)p = pack4(x0); *(u32x2*)(p + 16) = pack4(x1); }
        }
    }
};
struct EpiKV {
    static constexpr bool PERM = true, AFTER_DRAIN = false;
    bf16_t* KF; bf16_t* V;
    __device__ __forceinline__ void operator()(const f32x4 (&acc)[2][2][4][2], const Unit& u, int wr, int wc, int fr, int fq) const {
        const int row0 = u.pm * BM + wr * 64 + fr, c0 = wc * 32 + 8 * fq;
#pragma unroll
        for (int ai = 0; ai < 2; ++ai)
#pragma unroll
            for (int m = 0; m < 4; ++m) { const size_t row = (size_t)(row0 + ai * HALF + m * 16);
#pragma unroll
                for (int bj = 0; bj < 2; ++bj) { const f32x4 v0 = acc[ai][bj][m][0], v1 = acc[ai][bj][m][1];
                    u32x4 w; w.x = cvt_pk_bf16(v0[0], v0[1]); w.y = cvt_pk_bf16(v0[2], v0[3]); w.z = cvt_pk_bf16(v1[0], v1[1]); w.w = cvt_pk_bf16(v1[2], v1[3]);
                    if (bj == 0) *(u32x4*)(KF + row * 1536 + u.pn * 192 + c0) = w; else *(u32x4*)(V + row * 1024 + u.pn * 128 + c0) = w; } }
    }
};
template <int STEP> struct EpiMerge {
    static constexpr bool PERM = true, AFTER_DRAIN = false;
    const unsigned char* G; bf16_t* YF; bf16_t* Y; int wt_pm;
    __device__ __forceinline__ void operator()(const f32x4 (&acc)[2][2][4][2], const Unit& u, int wr, int wc, int fr, int fq) const {
        constexpr int NBATCH = 4;
        const int row0 = u.pm * BM + wr * 64 + fr, col0 = u.pn * BM + wc * 32 + 8 * fq;
        bf16_t* dst = (STEP < 2) ? YF : Y;
        const bool wt = (STEP < 2) && (u.pm >= wt_pm);
#pragma unroll
        for (int ai = 0; ai < 2; ++ai)
#pragma unroll
            for (int mb = 0; mb < 4; mb += NBATCH) {
                u32x2 gw[NBATCH][2]; u32x4 yv[NBATCH][2];
#pragma unroll
                for (int q = 0; q < NBATCH; ++q) { const size_t row = (size_t)(row0 + ai * HALF + (mb + q) * 16);
#pragma unroll
                    for (int bj = 0; bj < 2; ++bj) { const int c = col0 + bj * HALF;
                        gw[q][bj] = *(const u32x2*)(G + row * 6144 + STEP * 2048 + c);
                        if (STEP > 0) yv[q][bj] = *(const u32x4*)(YF + row * 2048 + c); } }
#pragma unroll
                for (int q = 0; q < NBATCH; ++q) { const size_t row = (size_t)(row0 + ai * HALF + (mb + q) * 16); const int m = mb + q;
#pragma unroll
                    for (int bj = 0; bj < 2; ++bj) { const int c = col0 + bj * HALF; const u32x2 g2 = gw[q][bj]; constexpr float I255 = 1.0f / 255.0f;
                        const f32x4 g0 = {(float)(g2.x & 255u) * I255, (float)((g2.x >> 8) & 255u) * I255, (float)((g2.x >> 16) & 255u) * I255, (float)(g2.x >> 24) * I255};
                        const f32x4 g1 = {(float)(g2.y & 255u) * I255, (float)((g2.y >> 8) & 255u) * I255, (float)((g2.y >> 16) & 255u) * I255, (float)(g2.y >> 24) * I255};
                        f32x4 a0 = acc[ai][bj][m][0] * g0, a1 = acc[ai][bj][m][1] * g1;
                        if (STEP > 0) { const u32x4 y4 = yv[q][bj];
                            a0 += (f32x4){__uint_as_float(y4.x << 16), __uint_as_float(y4.x & 0xffff0000u), __uint_as_float(y4.y << 16), __uint_as_float(y4.y & 0xffff0000u)};
                            a1 += (f32x4){__uint_as_float(y4.z << 16), __uint_as_float(y4.z & 0xffff0000u), __uint_as_float(y4.w << 16), __uint_as_float(y4.w & 0xffff0000u)}; }
                        u32x4 w; w.x = cvt_pk_bf16(a0[0], a0[1]); w.y = cvt_pk_bf16(a0[2], a0[3]); w.z = cvt_pk_bf16(a1[0], a1[1]); w.w = cvt_pk_bf16(a1[2], a1[3]);
                        if (wt) asm volatile("global_store_dwordx4 %0, %1, off sc1" :: "v"(dst + row * 2048 + c), "v"(w) : "memory");
                        else *(u32x4*)(dst + row * 2048 + c) = w; } }
                asm volatile("" ::: "memory"); }
    }
};
struct EpiResid {
    static constexpr bool PERM = true, AFTER_DRAIN = false;
    bf16_t* XB; const float* modl; int goff;
    __device__ __forceinline__ void operator()(const f32x4 (&acc)[2][2][4][2], const Unit& u, int wr, int wc, int fr, int fq) const {
        const int sel = u.pm >> 4;
        const int col0 = u.pn * BM + wc * 32 + 8 * fq; const float* gt = modl + sel * 12288 + goff + col0;
        bf16_t* base = XB + (size_t)(u.pm * BM + wr * 64 + fr) * 2048;
        f32x4 gv[2][2];
#pragma unroll
        for (int bj = 0; bj < 2; ++bj)
#pragma unroll
            for (int n = 0; n < 2; ++n) gv[bj][n] = *(const f32x4*)(gt + bj * HALF + n * 4);
#pragma unroll
        for (int ai = 0; ai < 2; ++ai) {
            u32x4 xr[4][2];
#pragma unroll
            for (int m = 0; m < 4; ++m) { const bf16_t* rowp = base + (size_t)(ai * HALF + m * 16) * 2048 + col0;
#pragma unroll
                for (int bj = 0; bj < 2; ++bj) xr[m][bj] = *(const u32x4*)(rowp + bj * HALF); }
#pragma unroll
            for (int m = 0; m < 4; ++m) { bf16_t* rowp = base + (size_t)(ai * HALF + m * 16) * 2048 + col0;
#pragma unroll
                for (int bj = 0; bj < 2; ++bj) { const u32x4 t = xr[m][bj];
                    const f32x4 x0 = {__uint_as_float(t.x << 16), __uint_as_float(t.x & 0xffff0000u), __uint_as_float(t.y << 16), __uint_as_float(t.y & 0xffff0000u)};
                    const f32x4 x1 = {__uint_as_float(t.z << 16), __uint_as_float(t.z & 0xffff0000u), __uint_as_float(t.w << 16), __uint_as_float(t.w & 0xffff0000u)};
                    const u32x2 w0 = pack4(x0 + gv[bj][0] * acc[ai][bj][m][0]), w1 = pack4(x1 + gv[bj][1] * acc[ai][bj][m][1]);
                    u32x4 w; w.x = w0.x; w.y = w0.y; w.z = w1.x; w.w = w1.y; *(u32x4*)(rowp + bj * HALF) = w; } }
            asm volatile("" ::: "memory"); }
    }
};
struct EpiSwiGLU {
    static constexpr bool PERM = true, AFTER_DRAIN = false;
    bf16_t* HID;
    __device__ __forceinline__ void operator()(const f32x4 (&acc)[2][2][4][2], const Unit& u, int wr, int wc, int fr, int fq) const {
        const int row0 = u.pm * BM + wr * 64 + fr, h0 = u.pn * 128 + wc * 32 + 8 * fq;
#pragma unroll
        for (int ai = 0; ai < 2; ++ai)
#pragma unroll
            for (int m = 0; m < 4; ++m) { bf16_t* rowp = HID + (size_t)(row0 + ai * HALF + m * 16) * 5632 + h0;
                u32x2 w2[2];
#pragma unroll
                for (int n = 0; n < 2; ++n) { const f32x4 a = acc[ai][0][m][n], b = acc[ai][1][m][n];
                    const f32x4 h = {a[0] * sigm(a[0]) * b[0], a[1] * sigm(a[1]) * b[1], a[2] * sigm(a[2]) * b[2], a[3] * sigm(a[3]) * b[3]};
                    w2[n] = pack4(h); }
                u32x4 w; w.x = w2[0].x; w.y = w2[0].y; w.z = w2[1].x; w.w = w2[1].y; *(u32x4*)rowp = w; }
    }
};
}
namespace pg8 {
struct UnitX { int pm, pn, kind; };
template <class Epi, class Sched, bool CHAIN = false>
__device__ __forceinline__ void gemm_stream(PG8_LAS unsigned char* lds, const Sched& S, const Epi& E) {
    int tid_ = threadIdx.x; asm volatile("" : "+v"(tid_));
    const int tid = tid_, wid = __builtin_amdgcn_readfirstlane(tid >> 6), lane = tid & 63, wr = wid >> 2, wc = wid & 3, fr = lane & 15, fq = lane >> 4;
    int Rn, Rp, C2; { int R, C; stage_rc(tid * 16, R, C); Rn = R; Rp = (R & ~31) + perm32(R & 31); C2 = C * 2; }
    const size_t kstep = (size_t)(BK * 2);
    const unsigned ldsw = (unsigned)wid * 1024u;
    const int aoff = lds_byte(wr * 64 + fr, fq * 8), boff = lds_byte(wc * 32 + fr, fq * 8);
#define PG8_SA(b, h) (((b) * 2 + (h)) * HTB)
#define PG8_SB(b, h) ((4 + (b) * 2 + (h)) * HTB)
#define PG8_STAGE(bufoff, gbase, voff, r64) do { \
        __builtin_amdgcn_global_load_lds((const unsigned*)((const char*)(gbase) + (voff)), (PG8_LAS unsigned*)(lds + (bufoff) + ldsw), 16, 0, 0); \
        __builtin_amdgcn_global_load_lds((const unsigned*)((const char*)(gbase) + (r64) + (voff)), (PG8_LAS unsigned*)(lds + (bufoff) + ldsw + 8192), 16, 0, 0); } while (0)
#define PG8_LDA(dst, b, h) do { _Pragma("unroll") for (int m = 0; m < 4; ++m) _Pragma("unroll") for (int k = 0; k < 2; ++k) dst[m][k] = *(const PG8_LAS bf16x8*)(lds + PG8_SA(b, h) + aoff + m * 2048 + k * 1024); } while (0)
#define PG8_LDB(dst, b, h) do { _Pragma("unroll") for (int n = 0; n < 2; ++n) _Pragma("unroll") for (int k = 0; k < 2; ++k) dst[n][k] = *(const PG8_LAS bf16x8*)(lds + PG8_SB(b, h) + boff + n * 2048 + k * 1024); } while (0)
#define PG8_MMA(ai, bj, At, Bt) do { __builtin_amdgcn_s_setprio(1); _Pragma("unroll") for (int m = 0; m < 4; ++m) _Pragma("unroll") for (int n = 0; n < 2; ++n) _Pragma("unroll") for (int k = 0; k < 2; ++k) \
        acc[ai][bj][m][n] = __builtin_amdgcn_mfma_f32_16x16x32_bf16(Bt[n][k], At[m][k], acc[ai][bj][m][n], 0, 0, 0); __builtin_amdgcn_s_setprio(0); } while (0)
#define PG8_WAIT_V(n) asm volatile("s_waitcnt vmcnt(" #n ")" ::: "memory")
#define PG8_WAIT_L(n) asm volatile("s_waitcnt lgkmcnt(" #n ")" ::: "memory")
#define PG8_BAR __builtin_amdgcn_s_barrier()
#define PG8_SCHED __builtin_amdgcn_sched_barrier(0)
    UnitX cur, nxt; int ui = 0;
    if (!S.next(0, cur)) return;
    f32x4 acc[2][2][4][2];
#pragma unroll
    for (int a = 0; a < 2; ++a)
#pragma unroll
        for (int b = 0; b < 2; ++b)
#pragma unroll
            for (int m = 0; m < 4; ++m)
#pragma unroll
                for (int n = 0; n < 2; ++n) acc[a][b][m][n] = (f32x4){0.f, 0.f, 0.f, 0.f};
    bf16x8 At[4][2], B0[2][2], B1[2][2];
    int K2 = S.gPitch(cur.kind) * 2;
    unsigned voA = (unsigned)(Rn * K2 + C2), voB = (unsigned)((S.gPerm(cur.kind) ? Rp : Rn) * K2 + C2);
    size_t r64 = (size_t)64 * K2, hstep = (size_t)HALF * K2;
    int nt = S.gNt(cur.kind);
    const char* cA = (const char*)S.gA(cur.kind) + (size_t)cur.pm * 2 * hstep + (size_t)S.gK0(cur.kind) * 2; const char* cB = (const char*)S.gB(cur.kind) + (size_t)cur.pn * 2 * hstep + (size_t)S.gK0(cur.kind) * 2;
    PG8_STAGE(PG8_SB(0, 0), cB, voB, r64); PG8_STAGE(PG8_SB(0, 1), cB + hstep, voB, r64); PG8_STAGE(PG8_SA(0, 0), cA, voA, r64); PG8_STAGE(PG8_SA(0, 1), cA + hstep, voA, r64);
    if (wr == 1) PG8_BAR;
    PG8_WAIT_V(2); PG8_BAR;
    PG8_STAGE(PG8_SB(1, 0), cB + kstep, voB, r64); PG8_STAGE(PG8_SA(1, 0), cA + kstep, voA, r64); PG8_STAGE(PG8_SB(1, 1), cB + hstep + kstep, voB, r64);
    PG8_WAIT_V(6); PG8_BAR;
    for (;;) {
        const bool has_next = S.next(ui + 1, nxt);
        const int nkind = has_next ? nxt.kind : cur.kind;
        const int nK2 = S.gPitch(nkind) * 2;
        const unsigned nvoA = (unsigned)(Rn * nK2 + C2), nvoB = (unsigned)((S.gPerm(nkind) ? Rp : Rn) * nK2 + C2);
        const size_t nr64 = (size_t)64 * nK2, nhstep = (size_t)HALF * nK2;
        const char* nA = has_next ? (const char*)S.gA(nkind) + (size_t)nxt.pm * 2 * nhstep + (size_t)S.gK0(nkind) * 2 : cA; const char* nB = has_next ? (const char*)S.gB(nkind) + (size_t)nxt.pn * 2 * nhstep + (size_t)S.gK0(nkind) * 2 : cB;
#pragma nounroll
        for (int t = 0; t < nt; t += 2) {
            const bool last = (t == nt - 2);
            const char* a1 = cA + (size_t)(t + 1) * kstep;
            const char* a2 = last ? nA : cA + (size_t)(t + 2) * kstep; const char* b2 = last ? nB : cB + (size_t)(t + 2) * kstep;
            const char* a3 = a2 + kstep; const char* b3 = b2 + kstep;
            const unsigned vA2 = last ? nvoA : voA, vB2 = last ? nvoB : voB; const size_t r2 = last ? nr64 : r64, h2 = last ? nhstep : hstep;
            PG8_LDB(B0, 0, 0); PG8_LDB(B1, 0, 1); PG8_SCHED; PG8_LDA(At, 0, 0); PG8_STAGE(PG8_SA(1, 1), a1 + hstep, voA, r64);
            PG8_WAIT_V(8); PG8_WAIT_L(0); PG8_BAR; PG8_MMA(0, 0, At, B0); PG8_MMA(0, 1, At, B1); PG8_BAR; PG8_SCHED;
            PG8_LDA(At, 0, 1); PG8_STAGE(PG8_SB(0, 0), b2, vB2, r2); PG8_STAGE(PG8_SB(0, 1), b2 + h2, vB2, r2); PG8_STAGE(PG8_SA(0, 0), a2, vA2, r2);
            PG8_WAIT_V(8); PG8_WAIT_L(0); PG8_BAR; PG8_MMA(1, 0, At, B0); PG8_MMA(1, 1, At, B1); PG8_BAR; PG8_SCHED;
            PG8_LDB(B0, 1, 0); PG8_LDB(B1, 1, 1); PG8_SCHED; PG8_LDA(At, 1, 0); PG8_STAGE(PG8_SA(0, 1), a2 + h2, vA2, r2);
            PG8_WAIT_V(8); PG8_WAIT_L(0); PG8_BAR; PG8_MMA(0, 0, At, B0); PG8_MMA(0, 1, At, B1); PG8_BAR; PG8_SCHED;
            PG8_LDA(At, 1, 1); PG8_STAGE(PG8_SB(1, 0), b3, vB2, r2); PG8_STAGE(PG8_SB(1, 1), b3 + h2, vB2, r2); PG8_STAGE(PG8_SA(1, 0), a3, vA2, r2);
            PG8_WAIT_V(8); PG8_WAIT_L(0); PG8_BAR; PG8_MMA(1, 0, At, B0); PG8_MMA(1, 1, At, B1); PG8_BAR; PG8_SCHED;
        }
        if (wr == 0) PG8_BAR;
        if constexpr (CHAIN) E.chain(acc, cur.pm, cur.pn, cur.kind, wr, wc, fr, fq); else E(acc, cur.pm, cur.pn, cur.kind, wr, wc, fr, fq);
        if (!has_next) break;
        bool clr_ = true; if constexpr (CHAIN) clr_ = (cur.kind == Epi::LAST_KIND);
        if (clr_)
#pragma unroll
        for (int a = 0; a < 2; ++a)
#pragma unroll
            for (int b = 0; b < 2; ++b)
#pragma unroll
                for (int m = 0; m < 4; ++m)
#pragma unroll
                    for (int n = 0; n < 2; ++n) acc[a][b][m][n] = (f32x4){0.f, 0.f, 0.f, 0.f};
        cur.pm = nxt.pm; cur.pn = nxt.pn; cur.kind = nxt.kind; cA = nA; cB = nB; K2 = nK2; voA = nvoA; voB = nvoB; r64 = nr64; hstep = nhstep; nt = S.gNt(nkind); ++ui;
        if (wr == 1) PG8_BAR;
    }
    PG8_WAIT_V(0);
    PG8_BAR;
#undef PG8_SA
#undef PG8_SB
#undef PG8_STAGE
#undef PG8_LDA
#undef PG8_LDB
#undef PG8_MMA
#undef PG8_WAIT_V
#undef PG8_WAIT_L
#undef PG8_BAR
#undef PG8_SCHED
}
struct SchedMerge {
    StaticOrder base; const char* a0; long da1, da2; const char* b0; long db1, db2;
    __device__ __forceinline__ bool next(int i, UnitX& u) const { Unit b; const int q = i / 3; const bool ok = base.next(q, b); u.pm = b.pm; u.pn = b.pn; u.kind = i - 3 * q; return ok; }
    __device__ __forceinline__ const bf16_t* gA(int k) const { return (const bf16_t*)(a0 + (k > 0 ? da1 : 0l) + (k > 1 ? da2 : 0l)); }
    __device__ __forceinline__ const bf16_t* gB(int k) const { return (const bf16_t*)(b0 + (k > 0 ? db1 : 0l) + (k > 1 ? db2 : 0l)); }
    __device__ __forceinline__ int gPitch(int k) const { return k == 1 ? 1024 : 512; }
    __device__ __forceinline__ int gNt(int k) const { return k == 1 ? 16 : 8; }
    __device__ __forceinline__ int gK0(int) const { return 0; }
    __device__ __forceinline__ int gPerm(int) const { return 1; }
};
struct EpiMergeAll {
    EpiMerge<0> e0; EpiMerge<1> e1; EpiMerge<2> e2;
    __device__ __forceinline__ void operator()(const f32x4 (&acc)[2][2][4][2], int pm, int pn, int kind, int wr, int wc, int fr, int fq) const {
        Unit u; u.pm = pm; u.pn = pn;
        if (kind == 0) e0(acc, u, wr, wc, fr, fq); else if (kind == 1) e1(acc, u, wr, wc, fr, fq); else e2(acc, u, wr, wc, fr, fq);
    }
};
struct EpiChain {
    static constexpr int LAST_KIND = 2;
    const unsigned char* G; bf16_t* Y;
    __device__ __forceinline__ void chain(f32x4 (&acc)[2][2][4][2], int pm, int pn, int kind, int wr, int wc, int fr, int fq) const {
        const int row0 = pm * BM + wr * 64 + fr, col0 = pn * BM + wc * 32 + 8 * fq;
        const unsigned char* ga = G + (kind == 2 ? 2 : kind) * 2048; const unsigned char* gb = G + (kind == 0 ? 1 : 2) * 2048;
#pragma unroll
        for (int ai = 0; ai < 2; ++ai) {
            u32x2 qa[4][2], qb[4][2];
#pragma unroll
            for (int m = 0; m < 4; ++m) { const size_t row = (size_t)(row0 + ai * HALF + m * 16);
#pragma unroll
                for (int bj = 0; bj < 2; ++bj) { const int c = col0 + bj * HALF; qa[m][bj] = *(const u32x2*)(ga + row * 6144 + c); qb[m][bj] = *(const u32x2*)(gb + row * 6144 + c); } }
#pragma unroll
            for (int m = 0; m < 4; ++m) { const size_t row = (size_t)(row0 + ai * HALF + m * 16);
#pragma unroll
                for (int bj = 0; bj < 2; ++bj) { const int c = col0 + bj * HALF;
                    f32x4 r[2];
#pragma unroll
                    for (int n = 0; n < 2; ++n) { const unsigned wa = n == 0 ? qa[m][bj].x : qa[m][bj].y, wb = n == 0 ? qb[m][bj].x : qb[m][bj].y;
#pragma unroll
                        for (int e = 0; e < 4; ++e) { const unsigned a8 = (wa >> (8 * e)) & 255u, b8 = (wb >> (8 * e)) & 255u;
                            const float fa = (float)(kind == 0 ? a8 : (a8 > 1u ? a8 : 1u)), fb = (float)(b8 > 1u ? b8 : 1u);
                            r[n][e] = (kind == 2) ? fa * (1.0f / 255.0f) : fa * __builtin_amdgcn_rcpf(fb); } }
                    acc[ai][bj][m][0] *= r[0]; acc[ai][bj][m][1] *= r[1];
                    if (kind == 2) { const f32x4 a0 = acc[ai][bj][m][0], a1 = acc[ai][bj][m][1];
                        u32x4 w; w.x = cvt_pk_bf16(a0[0], a0[1]); w.y = cvt_pk_bf16(a0[2], a0[3]); w.z = cvt_pk_bf16(a1[0], a1[1]); w.w = cvt_pk_bf16(a1[2], a1[3]);
                        *(u32x4*)(Y + row * 2048 + c) = w; } } }
            asm volatile("" ::: "memory"); }
    }
};
struct SchedQKV {
    int nMq, nNq, nMk, nNk, G, c; const bf16_t* Aq; const bf16_t* Bq; const bf16_t* Ak; const bf16_t* Bk;
    __device__ __forceinline__ bool next(int i, UnitX& u) const {
        const int L = i * G + c, nq = nMq * nNq;
        Unit b; b.pm = 0; b.pn = 0; bool ok = true; int kind = 0;
        if (L < nq) StaticOrder::map_entry(nMq, nNq, L, b);
        else { const int L2 = L - nq; kind = 1; ok = L2 < nMk * nNk; if (ok) StaticOrder::map_entry(nMk, nNk, L2, b); }
        u.pm = b.pm; u.pn = b.pn; u.kind = kind; return ok;
    }
    __device__ __forceinline__ const bf16_t* gA(int k) const { return k == 0 ? Aq : Ak; }
    __device__ __forceinline__ const bf16_t* gB(int k) const { return k == 0 ? Bq : Bk; }
    __device__ __forceinline__ int gPitch(int k) const { return k == 0 ? 512 : 256; }
    __device__ __forceinline__ int gNt(int k) const { return k == 0 ? 8 : 4; }
    __device__ __forceinline__ int gK0(int) const { return 0; }
    __device__ __forceinline__ int gPerm(int k) const { return k; }
};
struct EpiQKV {
    EpiQup eq; EpiKV ek;
    __device__ __forceinline__ void operator()(const f32x4 (&acc)[2][2][4][2], int pm, int pn, int kind, int wr, int wc, int fr, int fq) const {
        Unit u; u.pm = pm; u.pn = pn;
        if (kind == 0) eq(acc, u, wr, wc, fr, fq); else ek(acc, u, wr, wc, fr, fq);
    }
};
struct SchedSplit {
    const bf16_t* A; const bf16_t* Bt; int K, nlat, nctx, G, c, wgm;
    __device__ __forceinline__ bool next(int i, UnitX& u) const {
        const int L = i * G + c; Unit b; b.pm = 0; b.pn = 0; int kind = 0; bool ok = true;
        if (L < nlat) StaticOrder::map_entry(ML_ROWS / BM, 8, L, b, wgm);
        else { const int e = L - nlat; ok = e < nctx; b.pm = ML_ROWS / BM + (e >> 5); b.pn = (e >> 2) & 7; kind = 1 + (e & 3); }
        u.pm = b.pm; u.pn = b.pn; u.kind = kind; return ok;
    }
    __device__ __forceinline__ const bf16_t* gA(int) const { return A; }
    __device__ __forceinline__ const bf16_t* gB(int) const { return Bt; }
    __device__ __forceinline__ int gPitch(int) const { return K; }
    __device__ __forceinline__ int gNt(int k) const { return k == 0 ? K / BK : K / (4 * BK); }
    __device__ __forceinline__ int gK0(int k) const { return k == 0 ? 0 : (k - 1) * (K / 4); }
    __device__ __forceinline__ int gPerm(int) const { return 1; }
};
struct EpiSplit {
    EpiResid er; bf16_t* PART;
    __device__ __forceinline__ void operator()(const f32x4 (&acc)[2][2][4][2], int pm, int pn, int kind, int wr, int wc, int fr, int fq) const {
        Unit u; u.pm = pm; u.pn = pn;
        if (kind == 0) { er(acc, u, wr, wc, fr, fq); return; }
        bf16_t* base = PART + ((size_t)(kind - 1) * 2048 + (size_t)(pm * BM - ML_ROWS + wr * 64 + fr)) * 2048 + pn * BM + wc * 32 + 8 * fq;
#pragma unroll
        for (int ai = 0; ai < 2; ++ai)
#pragma unroll
            for (int m = 0; m < 4; ++m) { bf16_t* rowp = base + (size_t)(ai * HALF + m * 16) * 2048;
#pragma unroll
                for (int bj = 0; bj < 2; ++bj) { const u32x2 w0 = pack4(acc[ai][bj][m][0]), w1 = pack4(acc[ai][bj][m][1]); u32x4 w; w.x = w0.x; w.y = w0.y; w.z = w1.x; w.w = w1.y; *(u32x4*)(rowp + bj * HALF) = w; } }
    }
};
}
#define XB_TMO      128
#define XB_XCNT(j)  (256  + 64 * (j))
#define XB_XSUB(j)  (1280 + 64 * (j))
#define XB_XGEN(j)  (2304 + 64 * (j))
#define XB_TOP      3328
#define XB_TOPGEN   3392
#define XCD_BAR_WORDS 3456
#define XB_SPIN_CAP (1u << 18)

__device__ __forceinline__ unsigned xb_ld(unsigned* p)              { return __hip_atomic_load(p, __ATOMIC_RELAXED, __HIP_MEMORY_SCOPE_AGENT); }
__device__ __forceinline__ unsigned xb_add(unsigned* p, unsigned v) { return __hip_atomic_fetch_add(p, v, __ATOMIC_RELAXED, __HIP_MEMORY_SCOPE_AGENT); }
__device__ __forceinline__ unsigned xb_xcc_id() { return (unsigned)__builtin_amdgcn_s_getreg((3 << 11) | 20) & 0xFu; }
#define XB_SPIN(cond, bar) do { unsigned _sp = 0; while (cond) { __builtin_amdgcn_s_sleep(1); \
    if ((++_sp & 255u) == 0u) { if (xb_ld(&(bar)[XB_TMO])) break; if (_sp > XB_SPIN_CAP) { atomicAdd(&(bar)[XB_TMO], 1u); break; } } } } while (0)

struct XcdBarrier {
    unsigned* bar; unsigned x;
    volatile LAS unsigned* st;
};

__device__ __forceinline__ XcdBarrier xcd_barrier_post(unsigned* bar, volatile LAS unsigned* st) {
    XcdBarrier b; b.bar = bar; b.x = xb_xcc_id(); b.st = st;
    if (threadIdx.x == 0) (void)xb_add(&bar[XB_XCNT(b.x)], 1u);
    return b;
}
__device__ __forceinline__ void xcd_barrier_complete(unsigned* bar, unsigned x, unsigned& nloc, unsigned& nx) {
    const unsigned G = gridDim.x * gridDim.y * gridDim.z;
    unsigned sum, cnt, mine, sp = 0u;
    for (;;) {
        sum = 0u; cnt = 0u; mine = 0u;
#pragma unroll
        for (unsigned j = 0; j < 16; ++j) { const unsigned c = xb_ld(&bar[XB_XCNT(j)]); sum += c; cnt += (c > 0u) ? 1u : 0u; mine = (j == x) ? c : mine; }
        if (sum == G) break;
        __builtin_amdgcn_s_sleep(1);
        if ((++sp & 255u) == 0u) { if (xb_ld(&bar[XB_TMO])) break; if (sp > XB_SPIN_CAP) { atomicAdd(&bar[XB_TMO], 1u); break; } }
    }
    nloc = mine > 0u ? mine : 1u; nx = cnt > 0u ? cnt : 1u;
}

__device__ __forceinline__ void xcd_barrier(const XcdBarrier& b) {
    asm volatile("s_waitcnt vmcnt(0)" ::: "memory");
    __syncthreads();
    if (threadIdx.x == 0) {
        unsigned* bar = b.bar;
        __builtin_amdgcn_s_waitcnt(0);
        unsigned nloc = b.st[0], nx = b.st[1];
        if (nloc == 0u) { xcd_barrier_complete(bar, b.x, nloc, nx); b.st[0] = nloc; b.st[1] = nx; }
        const unsigned old = xb_add(&bar[XB_XSUB(b.x)], 1u);
        const unsigned gen = old / nloc;
        if (old + 1u == (gen + 1u) * nloc) {
            __builtin_amdgcn_fence(__ATOMIC_RELEASE, "agent");
            asm volatile("s_waitcnt vmcnt(0)" ::: "memory");
            const unsigned og = xb_add(&bar[XB_TOP], 1u);
            const unsigned tg = og / nx;
            if (og + 1u == (tg + 1u) * nx) xb_add(&bar[XB_TOPGEN], 1u);
            else XB_SPIN(xb_ld(&bar[XB_TOPGEN]) == tg, bar);
            __builtin_amdgcn_fence(__ATOMIC_ACQUIRE, "agent");
            xb_add(&bar[XB_XGEN(b.x)], 1u);
            asm volatile("s_waitcnt vmcnt(0)" ::: "memory");
        } else {
            XB_SPIN(xb_ld(&bar[XB_XGEN(b.x)]) == gen, bar);
            __builtin_amdgcn_fence(__ATOMIC_ACQUIRE, "agent");
            asm volatile("s_waitcnt vmcnt(0)" ::: "memory");
        }
    }
    __syncthreads();
}
#ifndef ATT_ILV
#define ATT_ILV 1
#endif
#ifndef ATT_DMAW
#define ATT_DMAW 4
#endif
#ifndef ATT_YOUNG_FROM
#define ATT_YOUNG_FROM (ATT_ILV ? 512 : 256)
#endif
namespace att {
typedef unsigned short bf16_t;
using bf16x8 = __attribute__((ext_vector_type(8))) short;
using s16x4  = __attribute__((ext_vector_type(4))) short;
using f32x16 = __attribute__((ext_vector_type(16))) float;
using u32x4  = __attribute__((ext_vector_type(4))) unsigned;
typedef LAS char lchar;
#define ASBAR() __builtin_amdgcn_sched_barrier(0)
__device__ __forceinline__ int crow(int r, int hi) { return (r & 3) + 8 * (r >> 2) + 4 * hi; }
__device__ __forceinline__ unsigned cvtpk(float lo, float hi) { return pg8::cvt_pk_bf16(lo, hi); }
template <int DK> __device__ __forceinline__ int koff(int row, int chunk) {
    return row * (DK * 2) + ((chunk & ~7) << 4) + (((chunk & 7) ^ ((row >> 1) & 7)) << 4);
}
template <int DV> __device__ __forceinline__ int v_st(int k, int c) { constexpr int NCB = DV / 32; const int kk = (k & ~0xC) | ((k & 4) << 1) | ((k & 8) >> 1); return ((kk >> 3) * NCB + (c >> 5)) * 512 + ((kk & 7) * 32 + (c & 31)) * 2; }
__device__ __forceinline__ int v_rd_base(int lane) { return ((lane & 3) << 3) | (((lane >> 2) & 3) << 6) | (((lane >> 4) & 1) << 5) | (((lane >> 5) & 1) << 8); }
template <int DV> constexpr int v_rd_off(int d0, int ks, int half) { return d0 * 512 + ks * (2 * (DV / 32) * 512) + half * ((DV / 32) * 512); }
#if ATT_ILV
template <int OFF> __device__ __forceinline__ s16x4 tr_read(int vb) { return __builtin_amdgcn_ds_read_tr16_b64_v4i16((LAS s16x4*)(unsigned)(vb + OFF)); }
#else
template <int OFF> __device__ __forceinline__ s16x4 tr_read(int vb) { s16x4 r; asm volatile("ds_read_b64_tr_b16 %0, %1 offset:%2" : "=&v"(r) : "v"(vb), "i"(OFF) : "memory"); return r; }
#endif

__device__ __forceinline__ void glds16(const void* gsrc, unsigned lds_dst) { unsigned keep; lds_dst = __builtin_amdgcn_readfirstlane(lds_dst);
    asm volatile("s_mov_b32 %0, m0\n\ts_mov_b32 m0, %2\n\ts_nop 0\n\tglobal_load_lds_dwordx4 %1, off\n\ts_mov_b32 m0, %0" : "=&s"(keep) : "v"(gsrc), "s"(lds_dst) : "memory"); }
__device__ __forceinline__ void glds16s(const void* sbase, unsigned voff, unsigned lds_dst) { unsigned keep; lds_dst = __builtin_amdgcn_readfirstlane(lds_dst);
    const unsigned long long b = (unsigned long long)sbase; const unsigned blo = __builtin_amdgcn_readfirstlane((unsigned)b), bhi = __builtin_amdgcn_readfirstlane((unsigned)(b >> 32));
    const unsigned long long sb = ((unsigned long long)bhi << 32) | blo;
    asm volatile("s_mov_b32 %0, m0\n\ts_mov_b32 m0, %3\n\ts_nop 0\n\tglobal_load_lds_dwordx4 %1, %2\n\ts_mov_b32 m0, %0" : "=&s"(keep) : "v"(voff), "s"(sb), "s"(lds_dst) : "memory"); }
template <bool WIN>
__device__ __forceinline__ void partialSM(f32x16& p0, f32x16& p1, float& m_reg, float& mn, float& alpha, const float C, const float thr, const bool domask, const int dq, const int hi) {
#if ATT_ILV
    if constexpr (WIN) { const int dqq = domask ? dq : 0;
#pragma unroll
        for (int r = 0; r < 16; ++r) { const int d0 = dqq + crow(r, hi), d1 = d0 + 32; p0[r] = (d0 > 128 || d0 < -128) ? -1e30f : p0[r]; p1[r] = (d1 > 128 || d1 < -128) ? -1e30f : p1[r]; } }
#else
    if constexpr (WIN) { if (domask) {
#pragma unroll
        for (int r = 0; r < 16; ++r) { const int d0 = dq + crow(r, hi), d1 = d0 + 32; if (d0 > 128 || d0 < -128) p0[r] = -1e30f; if (d1 > 128 || d1 < -128) p1[r] = -1e30f; } } }
#endif
    float pmax = p0[0];
#pragma unroll
    for (int r = 1; r < 16; ++r) pmax = fmaxf(pmax, p0[r]);
#pragma unroll
    for (int r = 0; r < 16; ++r) pmax = fmaxf(pmax, p1[r]);
    { auto rr = __builtin_amdgcn_permlane32_swap(__float_as_uint(pmax), __float_as_uint(pmax), false, false); pmax = fmaxf(__uint_as_float(rr[0]), __uint_as_float(rr[1])); }
#if ATT_ILV
    { const bool keep = __all(pmax - m_reg <= thr); mn = fmaxf(m_reg, keep ? m_reg : pmax); alpha = __builtin_amdgcn_exp2f((m_reg - mn) * C); m_reg = mn; }
#else
    if (__builtin_expect(__all(pmax - m_reg <= thr), 1)) { mn = m_reg; alpha = 1.f; }
    else { mn = fmaxf(m_reg, pmax); alpha = __builtin_amdgcn_exp2f((m_reg - mn) * C); m_reg = mn; }
#endif
    const float mnC = -mn * C;
#pragma unroll
    for (int r = 0; r < 16; ++r) p0[r] = fmaf(p0[r], C, mnC);
#pragma unroll
    for (int r = 0; r < 16; ++r) p1[r] = fmaf(p1[r], C, mnC);
#pragma unroll
    for (int r = 0; r < 16; ++r) p0[r] = __builtin_amdgcn_exp2f(p0[r]);
}
__device__ __forceinline__ void finishSM(f32x16& p0, f32x16& p1, float alpha, float& l_reg, bf16x8& pa0, bf16x8& pa1, bf16x8& pa2, bf16x8& pa3) {
#pragma unroll
    for (int r = 0; r < 16; ++r) p1[r] = __builtin_amdgcn_exp2f(p1[r]);
    float ps = 0;
#pragma unroll
    for (int r = 0; r < 16; ++r) ps += p0[r];
#pragma unroll
    for (int r = 0; r < 16; ++r) ps += p1[r];
    { auto rr = __builtin_amdgcn_permlane32_swap(__float_as_uint(ps), __float_as_uint(ps), false, false); ps = __uint_as_float(rr[0]) + __uint_as_float(rr[1]); }
    l_reg = l_reg * alpha + ps;
#define ATT_PK4(P, BASE, OUT) do { unsigned a0 = cvtpk(P[BASE + 0], P[BASE + 1]), a1 = cvtpk(P[BASE + 2], P[BASE + 3]);   \
    unsigned b0 = cvtpk(P[BASE + 4], P[BASE + 5]), b1 = cvtpk(P[BASE + 6], P[BASE + 7]);                              \
    auto r0 = __builtin_amdgcn_permlane32_swap(a0, b0, false, false); auto r1 = __builtin_amdgcn_permlane32_swap(a1, b1, false, false); \
    u32x4 w = {r0[0], r1[0], r0[1], r1[1]}; OUT = *reinterpret_cast<bf16x8*>(&w); } while (0)
    ATT_PK4(p0, 0, pa0); ATT_PK4(p0, 8, pa1); ATT_PK4(p1, 0, pa2); ATT_PK4(p1, 8, pa3);
#undef ATT_PK4
}
template <int DK> __device__ __forceinline__ void qkt(f32x16& p0, f32x16& p1, const lchar* Ks, const bf16x8 (&qr)[DK / 16], const int (&kq)[4]) {
    p0 = f32x16{}; p1 = f32x16{};
    bf16x8 c0 = *(const LAS bf16x8*)(Ks + kq[0]), c1 = *(const LAS bf16x8*)(Ks + kq[0] + 32 * DK * 2);
#pragma unroll
    for (int d0 = 0; d0 < DK / 16; ++d0) {
        bf16x8 n0 = c0, n1 = c1;
        if (d0 + 1 < DK / 16) { n0 = *(const LAS bf16x8*)(Ks + kq[(d0 + 1) & 3] + ((d0 + 1) >> 2) * 128); n1 = *(const LAS bf16x8*)(Ks + kq[(d0 + 1) & 3] + ((d0 + 1) >> 2) * 128 + 32 * DK * 2); }
        p0 = __builtin_amdgcn_mfma_f32_32x32x16_bf16(c0, qr[d0], p0, 0, 0, 0);
        p1 = __builtin_amdgcn_mfma_f32_32x32x16_bf16(c1, qr[d0], p1, 0, 0, 0);
        c0 = n0; c1 = n1; }
}
struct VFrag { s16x4 l0, h0, l1, h1, l2, h2, l3, h3; };
template <int DV, int D0> __device__ __forceinline__ void pv_reads(VFrag& f, int vb) {
    f.l0 = tr_read<v_rd_off<DV>(D0, 0, 0)>(vb); f.h0 = tr_read<v_rd_off<DV>(D0, 0, 1)>(vb); f.l1 = tr_read<v_rd_off<DV>(D0, 1, 0)>(vb); f.h1 = tr_read<v_rd_off<DV>(D0, 1, 1)>(vb);
    f.l2 = tr_read<v_rd_off<DV>(D0, 2, 0)>(vb); f.h2 = tr_read<v_rd_off<DV>(D0, 2, 1)>(vb); f.l3 = tr_read<v_rd_off<DV>(D0, 3, 0)>(vb); f.h3 = tr_read<v_rd_off<DV>(D0, 3, 1)>(vb);
}
__device__ __forceinline__ void pv_mma(f32x16& od, const VFrag& f, bf16x8 pa0, bf16x8 pa1, bf16x8 pa2, bf16x8 pa3) {
#define ATT_PK(L, H) (bf16x8){L[0], L[1], L[2], L[3], H[0], H[1], H[2], H[3]}
    od = __builtin_amdgcn_mfma_f32_32x32x16_bf16(pa0, ATT_PK(f.l0, f.h0), od, 0, 0, 0);
    od = __builtin_amdgcn_mfma_f32_32x32x16_bf16(pa1, ATT_PK(f.l1, f.h1), od, 0, 0, 0);
    od = __builtin_amdgcn_mfma_f32_32x32x16_bf16(pa2, ATT_PK(f.l2, f.h2), od, 0, 0, 0);
    od = __builtin_amdgcn_mfma_f32_32x32x16_bf16(pa3, ATT_PK(f.l3, f.h3), od, 0, 0, 0);
#undef ATT_PK
}
#define ATT_LWAIT(n) do { asm volatile("s_waitcnt lgkmcnt(" #n ")" ::: "memory"); ASBAR(); } while (0)
#if ATT_ILV
template <int DV> __device__ __forceinline__ void pv_all(f32x16 (&o)[DV / 32], int vb, bf16x8 pa0, bf16x8 pa1, bf16x8 pa2, bf16x8 pa3) {
    { VFrag f; pv_reads<DV, 0>(f, vb); pv_mma(o[0], f, pa0, pa1, pa2, pa3); }
    { VFrag f; pv_reads<DV, 1>(f, vb); pv_mma(o[1], f, pa0, pa1, pa2, pa3); }
    if constexpr (DV == 128) {
        { VFrag f; pv_reads<DV, 2>(f, vb); pv_mma(o[2], f, pa0, pa1, pa2, pa3); }
        { VFrag f; pv_reads<DV, 3>(f, vb); pv_mma(o[3], f, pa0, pa1, pa2, pa3); } }
}
#define ATT_SWAP(A, B) __builtin_amdgcn_permlane32_swap((A), (B), false, false)
#define ATT_PIN(X) asm volatile("" : "+v"(X))
template <int PT, int B> __device__ __forceinline__ void pk_step(const f32x16& P, unsigned& a0, unsigned& a1, unsigned& b0, unsigned& b1, unsigned& x0, unsigned& y0, bf16x8& OUT) {
    if constexpr (PT == 0) { a0 = cvtpk(P[B + 0], P[B + 1]); b0 = cvtpk(P[B + 4], P[B + 5]); }
    if constexpr (PT == 1) { a1 = cvtpk(P[B + 2], P[B + 3]); b1 = cvtpk(P[B + 6], P[B + 7]); }
    if constexpr (PT == 2) { auto r0 = ATT_SWAP(a0, b0); x0 = r0[0]; y0 = r0[1]; }
    if constexpr (PT == 3) { auto r1 = ATT_SWAP(a1, b1); u32x4 w = {x0, r1[0], y0, r1[1]}; OUT = *reinterpret_cast<bf16x8*>(&w); }
}
template <int K> __device__ __forceinline__ void fin_atom(f32x16& q0, f32x16& q1, float alpha, float& l_reg, float& ps0, float& ps1, unsigned& a0, unsigned& a1, unsigned& b0, unsigned& b1, unsigned& x0, unsigned& y0,
                                                          bf16x8& pa0, bf16x8& pa1, bf16x8& pa2, bf16x8& pa3) {
    if constexpr (K < 16) { q1[K] = __builtin_amdgcn_exp2f(q1[K]); ATT_PIN(q1[K]); ps0 += q0[K]; ATT_PIN(ps0); }
    if constexpr (K >= 8) { ps1 += q1[K - 8]; ATT_PIN(ps1); }
    if constexpr (K < 4) pk_step<K & 3, 0>(q0, a0, a1, b0, b1, x0, y0, pa0);
    else if constexpr (K < 8) pk_step<K & 3, 8>(q0, a0, a1, b0, b1, x0, y0, pa1);
    else if constexpr (K >= 16 && K < 20) pk_step<K & 3, 0>(q1, a0, a1, b0, b1, x0, y0, pa2);
    else if constexpr (K >= 20) pk_step<K & 3, 8>(q1, a0, a1, b0, b1, x0, y0, pa3);
    if constexpr (K == 23) { float ps = ps0 + ps1; auto rr = ATT_SWAP(__float_as_uint(ps), __float_as_uint(ps)); ps = __uint_as_float(rr[0]) + __uint_as_float(rr[1]); l_reg = l_reg * alpha + ps; }
}
template <int I, int NM, int DK> __device__ __forceinline__ void qk_step(f32x16& p0, f32x16& p1, const lchar* Ks, const bf16x8 (&qr)[DK / 16], const int (&kq)[4], bf16x8 (&F)[4],
        f32x16& q0, f32x16& q1, float alpha, float& l_reg, float& ps0, float& ps1, unsigned& a0, unsigned& a1, unsigned& b0, unsigned& b1, unsigned& x0, unsigned& y0, bf16x8& pa0, bf16x8& pa1, bf16x8& pa2, bf16x8& pa3) {
    constexpr int d0 = I >> 1, APG = 24 / NM;
    if constexpr (I == 0) p0 = __builtin_amdgcn_mfma_f32_32x32x16_bf16(F[0], qr[0], f32x16{}, 0, 0, 0);
    else if constexpr (I == 1) p1 = __builtin_amdgcn_mfma_f32_32x32x16_bf16(F[1], qr[0], f32x16{}, 0, 0, 0);
    else if constexpr ((I & 1) == 0) p0 = __builtin_amdgcn_mfma_f32_32x32x16_bf16(F[I & 3], qr[d0], p0, 0, 0, 0);
    else p1 = __builtin_amdgcn_mfma_f32_32x32x16_bf16(F[I & 3], qr[d0], p1, 0, 0, 0);
    if constexpr (I + 4 < NM) { constexpr int J = I + 4, e0 = J >> 1; F[I & 3] = *(const LAS bf16x8*)(Ks + kq[e0 & 3] + (e0 >> 2) * 128 + (J & 1) * (32 * DK * 2)); }
    fin_atom<APG * I>(q0, q1, alpha, l_reg, ps0, ps1, a0, a1, b0, b1, x0, y0, pa0, pa1, pa2, pa3);
    if constexpr (APG >= 2) fin_atom<APG * I + 1>(q0, q1, alpha, l_reg, ps0, ps1, a0, a1, b0, b1, x0, y0, pa0, pa1, pa2, pa3);
    if constexpr (APG >= 3) fin_atom<APG * I + 2>(q0, q1, alpha, l_reg, ps0, ps1, a0, a1, b0, b1, x0, y0, pa0, pa1, pa2, pa3);
    ASBAR();
    if constexpr (I + 1 < NM) qk_step<I + 1, NM, DK>(p0, p1, Ks, qr, kq, F, q0, q1, alpha, l_reg, ps0, ps1, a0, a1, b0, b1, x0, y0, pa0, pa1, pa2, pa3);
}
template <int DK> __device__ __forceinline__ void qkt_fin(f32x16& p0, f32x16& p1, const lchar* Ks, const bf16x8 (&qr)[DK / 16], const int (&kq)[4],
        f32x16& q0, f32x16& q1, float alpha, float& l_reg, bf16x8& pa0, bf16x8& pa1, bf16x8& pa2, bf16x8& pa3) {
    constexpr int NM = DK / 8;
    bf16x8 F[4];
#pragma unroll
    for (int i = 0; i < 4; ++i) F[i] = *(const LAS bf16x8*)(Ks + kq[(i >> 1) & 3] + ((i >> 1) >> 2) * 128 + (i & 1) * (32 * DK * 2));
    float ps0 = 0.f, ps1 = 0.f; unsigned a0 = 0, a1 = 0, b0 = 0, b1 = 0, x0 = 0, y0 = 0;
    ASBAR();
    qk_step<0, NM, DK>(p0, p1, Ks, qr, kq, F, q0, q1, alpha, l_reg, ps0, ps1, a0, a1, b0, b1, x0, y0, pa0, pa1, pa2, pa3);
}
template <int K, bool WIN> __device__ __forceinline__ void par_atom(f32x16& p0, f32x16& p1, float& m_reg, float& mn, float& alpha, const float C, const float thr, const int dqq, const int hi,
                                                                    float& pm0, float& pm1, float& pm2, float& pm3, float& mnC) {
    if constexpr (K < 4) { f32x16& P = (K < 2) ? p0 : p1; constexpr int B = (K & 1) * 8;
        if constexpr (WIN) {
#pragma unroll
            for (int r = B; r < B + 8; ++r) { const int d = dqq + crow(r, hi) + (K < 2 ? 0 : 32); P[r] = (d > 128 || d < -128) ? -1e30f : P[r]; } }
        const float m = fmaxf(fmaxf(fmaxf(P[B], P[B + 1]), fmaxf(P[B + 2], P[B + 3])), fmaxf(fmaxf(P[B + 4], P[B + 5]), fmaxf(P[B + 6], P[B + 7])));
        if constexpr (K == 0) pm0 = m; else if constexpr (K == 1) pm1 = m; else if constexpr (K == 2) pm2 = m; else pm3 = m; }
    if constexpr (K == 4) { float pmax = fmaxf(fmaxf(pm0, pm1), fmaxf(pm2, pm3));
        auto rr = ATT_SWAP(__float_as_uint(pmax), __float_as_uint(pmax)); pmax = fmaxf(__uint_as_float(rr[0]), __uint_as_float(rr[1]));
        const bool keep = __all(pmax - m_reg <= thr); mn = fmaxf(m_reg, keep ? m_reg : pmax); alpha = __builtin_amdgcn_exp2f((m_reg - mn) * C); m_reg = mn; mnC = -mn * C; }
    if constexpr (K >= 5 && K <= 8) { f32x16& P = (K < 7) ? p0 : p1; constexpr int B = ((K - 5) & 1) * 8;
#pragma unroll
        for (int r = B; r < B + 8; ++r) { P[r] = fmaf(P[r], C, mnC); ATT_PIN(P[r]); } }
    if constexpr (K >= 8) { p0[2 * (K - 8)] = __builtin_amdgcn_exp2f(p0[2 * (K - 8)]); p0[2 * (K - 8) + 1] = __builtin_amdgcn_exp2f(p0[2 * (K - 8) + 1]); ATT_PIN(p0[2 * (K - 8)]); ATT_PIN(p0[2 * (K - 8) + 1]); }
}
template <int I, int NM, int DV, bool WIN> __device__ __forceinline__ void pv_step(f32x16 (&o)[DV / 32], const int vb, const bf16x8 (&pa)[4], s16x4 (&L)[4], s16x4 (&H)[4],
        f32x16& p0, f32x16& p1, float& m_reg, float& mn, float& alpha, const float C, const float thr, const int dqq, const int hi, float& pm0, float& pm1, float& pm2, float& pm3, float& mnC) {
    constexpr int b = I >> 2, k = I & 3, APG = 16 / NM;
    { const s16x4 l = L[k], h = H[k]; o[b] = __builtin_amdgcn_mfma_f32_32x32x16_bf16(pa[k], (bf16x8){l[0], l[1], l[2], l[3], h[0], h[1], h[2], h[3]}, o[b], 0, 0, 0); }
    if constexpr (b + 1 < DV / 32) { L[k] = tr_read<v_rd_off<DV>(b + 1, k, 0)>(vb); H[k] = tr_read<v_rd_off<DV>(b + 1, k, 1)>(vb); }
    par_atom<APG * I, WIN>(p0, p1, m_reg, mn, alpha, C, thr, dqq, hi, pm0, pm1, pm2, pm3, mnC);
    if constexpr (APG >= 2) par_atom<APG * I + 1, WIN>(p0, p1, m_reg, mn, alpha, C, thr, dqq, hi, pm0, pm1, pm2, pm3, mnC);
    ASBAR();
    if constexpr (I + 1 < NM) pv_step<I + 1, NM, DV, WIN>(o, vb, pa, L, H, p0, p1, m_reg, mn, alpha, C, thr, dqq, hi, pm0, pm1, pm2, pm3, mnC);
}
template <int DV, bool WIN> __device__ __forceinline__ void pv_part(f32x16 (&o)[DV / 32], const int vb, bf16x8 pa0, bf16x8 pa1, bf16x8 pa2, bf16x8 pa3,
        f32x16& p0, f32x16& p1, float& m_reg, float& mn, float& alpha, const float C, const float thr, const bool domask, const int dq, const int hi) {
    constexpr int NM = DV / 8;
    const bf16x8 pa[4] = {pa0, pa1, pa2, pa3}; s16x4 L[4], H[4];
    L[0] = tr_read<v_rd_off<DV>(0, 0, 0)>(vb); H[0] = tr_read<v_rd_off<DV>(0, 0, 1)>(vb); L[1] = tr_read<v_rd_off<DV>(0, 1, 0)>(vb); H[1] = tr_read<v_rd_off<DV>(0, 1, 1)>(vb);
    L[2] = tr_read<v_rd_off<DV>(0, 2, 0)>(vb); H[2] = tr_read<v_rd_off<DV>(0, 2, 1)>(vb); L[3] = tr_read<v_rd_off<DV>(0, 3, 0)>(vb); H[3] = tr_read<v_rd_off<DV>(0, 3, 1)>(vb);
    float pm0 = 0.f, pm1 = 0.f, pm2 = 0.f, pm3 = 0.f, mnC = 0.f; const int dqq = domask ? dq : 0;
    ASBAR();
    pv_step<0, NM, DV, WIN>(o, vb, pa, L, H, p0, p1, m_reg, mn, alpha, C, thr, dqq, hi, pm0, pm1, pm2, pm3, mnC);
}
#else
template <int NM, int ND, int NV> __device__ __forceinline__ void sgb_pattern() {}
template <int DV> __device__ __forceinline__ void pv_all(f32x16 (&o)[DV / 32], int vb, bf16x8 pa0, bf16x8 pa1, bf16x8 pa2, bf16x8 pa3) {
    VFrag f;
    pv_reads<DV, 0>(f, vb); ATT_LWAIT(0); pv_mma(o[0], f, pa0, pa1, pa2, pa3);
    pv_reads<DV, 1>(f, vb); ATT_LWAIT(0); pv_mma(o[1], f, pa0, pa1, pa2, pa3);
    if constexpr (DV == 128) {
        pv_reads<DV, 2>(f, vb); ATT_LWAIT(0); pv_mma(o[2], f, pa0, pa1, pa2, pa3);
        pv_reads<DV, 3>(f, vb); ATT_LWAIT(0); pv_mma(o[3], f, pa0, pa1, pa2, pa3); }
}
#endif
template <int DK, int DV, bool WIN, bool SINK, int MODE>
__device__ __forceinline__ void attn_unit(const bf16_t* __restrict__ Qb, const int ldq, const bf16_t* __restrict__ Kb, const int ldk, const bf16_t* __restrict__ Vb, const int ldv,
                                          bf16_t* __restrict__ Ob, const int ldo, const int cbase, const int lbase, const int NT, const int qpos0, const int kpos0, const float sinkl2, lchar* lds) {
    constexpr int KI = DK / 64, VI = DV / 64, ND = DK / 16, NO = DV / 32, SHM_K = 64 * DK * 2, SHM_V = 64 * DV * 2;
    constexpr float SCALE = (DK == 192) ? 0.07216878364870322f : 0.125f, C = SCALE * 1.4426950408889634f, THRR = 8.0f / SCALE;
    int tid_ = threadIdx.x; asm volatile("" : "+v"(tid_));
    const int tid = tid_, wid = tid >> 6, lane = tid & 63, r32 = lane & 31, hi = lane >> 5;
    constexpr int NSLOT = (MODE == 2) ? 3 : 2;
    lchar* V_lds = lds; lchar* K_lds = lds + NSLOT * SHM_V;
    LAS float* wsf = (LAS float*)(lds + NSLOT * SHM_V + NSLOT * SHM_K) + wid * 64; LAS float* li_l = wsf; LAS float* al_l = wsf + 32;
    float m_reg = -1e30f, l_reg = 0.f; f32x16 o[NO]; bf16x8 qr[ND];
#pragma unroll
    for (int d = 0; d < NO; ++d) o[d] = f32x16{};
    const bf16_t* Qw = Qb + (long)(wid * 32 + r32) * ldq + hi * 8;
#pragma unroll
    for (int d0 = 0; d0 < ND; ++d0) qr[d0] = *(const bf16x8*)(Qw + d0 * 16);
    const int srow = tid >> 3, scg = tid & 7;
    const int kgo = srow * ldk + scg * 8, vgo = srow * ldv + scg * 8;
    int klo[KI];
#pragma unroll
    for (int i = 0; i < KI; ++i) klo[i] = koff<DK>(srow, scg + 8 * i);
    const int vlo = v_st<DV>(srow, scg * 8);
    const int vb0 = (int)(uintptr_t)V_lds + v_rd_base(lane);
    const int qpos = qpos0 + wid * 32 + r32;
    int kq[4];
#pragma unroll
    for (int k = 0; k < 4; ++k) kq[k] = r32 * (DK * 2) + (((2 * k) ^ hi ^ ((r32 >> 1) & 7)) << 4);
    bf16x8 ks[KI], vs[VI];
#define ATT_ROWOF(j) ((j) < 4 ? cbase + 64 * (j) : lbase + 64 * ((j) - 4))
#define ATT_SLOAD(j) do { const long rb_ = ATT_ROWOF(j); const bf16_t* kp_ = Kb + rb_ * ldk + kgo; const bf16_t* vp_ = Vb + rb_ * ldv + vgo; \
    _Pragma("unroll") for (int i_ = 0; i_ < KI; ++i_) ks[i_] = *(const bf16x8*)(kp_ + 64 * i_); \
    _Pragma("unroll") for (int i_ = 0; i_ < VI; ++i_) vs[i_] = *(const bf16x8*)(vp_ + 64 * i_); } while (0)
#define ATT_SWRITE(b) do { _Pragma("unroll") for (int i_ = 0; i_ < KI; ++i_) *(LAS bf16x8*)(K_lds + (b) * SHM_K + klo[i_]) = ks[i_]; \
    _Pragma("unroll") for (int i_ = 0; i_ < VI; ++i_) *(LAS bf16x8*)(V_lds + (b) * SHM_V + vlo + i_ * 1024) = vs[i_]; } while (0)
#define ATT_RESC(a) do { if (__any((a) < 1.f)) { if (hi == 0) al_l[r32] = (a); asm volatile("s_waitcnt lgkmcnt(0)" ::: "memory"); \
    _Pragma("unroll") for (int d_ = 0; d_ < NO; ++d_) _Pragma("unroll") for (int r_ = 0; r_ < 16; ++r_) o[d_][r_] *= al_l[crow(r_, hi)]; } } while (0)
#define ATT_DQ(j) (kpos0 + 64 * ((j) - 4) - qpos)
    f32x16 pA0, pA1, pB0, pB1; float mnA, mnB, alA, alB; bf16x8 pa0, pa1, pa2, pa3;
    __syncthreads();
    if constexpr (MODE == 2) {
        const int wu = __builtin_amdgcn_readfirstlane(wid);
        constexpr int DW = ATT_DMAW, KP = KI * 8 / DW, VP = VI * 8 / DW;
        const bool dmaw = wu < DW;
        int kgs[KP], vgs[VP];
#pragma unroll
        for (int i = 0; i < KP; ++i) { const int p = (wu * KP + i) * 64 + lane, kr = p / (DK / 8), c2 = p % (DK / 8); kgs[i] = kr * ldk + (((c2 & ~7) | ((c2 & 7) ^ ((kr >> 1) & 7))) << 3); }
#pragma unroll
        for (int i = 0; i < VP; ++i) { const int u16 = (wu * VP + i) * 64 + lane, st = u16 >> 5, kk = (st / (DV / 32)) * 8 + ((u16 >> 2) & 7), c = (st % (DV / 32)) * 32 + (u16 & 3) * 8;
            const int k = (kk & ~0xC) | ((kk & 4) << 1) | ((kk & 8) >> 1); vgs[i] = k * ldv + c; }
        const unsigned kl0 = (unsigned)(uintptr_t)K_lds + (unsigned)(wu * KP) * 1024u, vl0 = (unsigned)(uintptr_t)V_lds + (unsigned)(wu * VP) * 1024u;
#define ATT_DMAK(j, slot) do { const bf16_t* kp_ = Kb + (long)ATT_ROWOF(j) * ldk; if (dmaw) { _Pragma("unroll") for (int i_ = 0; i_ < KP; ++i_) glds16s(kp_, (unsigned)kgs[i_] * 2u, kl0 + (unsigned)(slot) * SHM_K + i_ * 1024); } } while (0)
#define ATT_DMAV(j, slot) do { const bf16_t* vp_ = Vb + (long)ATT_ROWOF(j) * ldv; if (dmaw) { _Pragma("unroll") for (int i_ = 0; i_ < VP; ++i_) glds16s(vp_, (unsigned)vgs[i_] * 2u, vl0 + (unsigned)(slot) * SHM_V + i_ * 1024); } } while (0)
#define ATT_WAITN(n) asm volatile("s_waitcnt vmcnt(" #n ") lgkmcnt(0)" ::: "memory")
#define ATT_WAIT1() do { if constexpr (KP + VP == 10) ATT_WAITN(10); else if constexpr (KP + VP == 5) ATT_WAITN(5); else if constexpr (KP + VP == 4) ATT_WAITN(4); else { static_assert(KP + VP == 2); ATT_WAITN(2); } } while (0)
#define ATT_WAIT2() do { if constexpr (KP + VP == 10) ATT_WAITN(20); else if constexpr (KP + VP == 5) ATT_WAITN(10); else if constexpr (KP + VP == 4) ATT_WAITN(8); else ATT_WAITN(4); } while (0)
#define ATT_SYNC(j) do { const int sp_ = (sc == 0) ? 2 : sc - 1; if ((j) + 2 < NT) ATT_WAIT1(); else ATT_WAITN(0); \
        __builtin_amdgcn_s_barrier(); asm volatile("" ::: "memory"); \
        if ((j) + 3 < NT) ATT_DMAK((j) + 3, sc); if ((j) + 2 < NT) ATT_DMAV((j) + 2, sp_); } while (0)
#define ATT_STEP_OLD(j, PC0, PC1, MNC, ALC, PP0, PP1, MNP, ALP) do { const int spv_ = (sc == 0) ? 2 : sc - 1; \
        ASBAR(); qkt_fin<DK>(PC0, PC1, K_lds + sc * SHM_K, qr, kq, PP0, PP1, ALP, l_reg, pa0, pa1, pa2, pa3); \
        pv_part<DV, WIN>(o, vb0 + spv_ * SHM_V, pa0, pa1, pa2, pa3, PC0, PC1, m_reg, MNC, ALC, C, THRR, (j) >= 4, ATT_DQ(j), hi); \
        ATT_SYNC(j); ATT_RESC(ALC); sc = (sc == 2) ? 0 : sc + 1; } while (0)
#define ATT_STEP_YNG(j, PC0, PC1, MNC, ALC, PP0, PP1, MNP, ALP) do { const int spv_ = (sc == 0) ? 2 : sc - 1; \
        partialSM<WIN>(PP0, PP1, m_reg, MNP, ALP, C, THRR, (j) - 1 >= 4, ATT_DQ((j) - 1), hi); ATT_RESC(ALP); \
        ASBAR(); qkt<DK>(PC0, PC1, K_lds + sc * SHM_K, qr, kq); \
        finishSM(PP0, PP1, ALP, l_reg, pa0, pa1, pa2, pa3); ASBAR(); \
        pv_all<DV>(o, vb0 + spv_ * SHM_V, pa0, pa1, pa2, pa3); \
        ATT_SYNC(j); sc = (sc == 2) ? 0 : sc + 1; } while (0)
        const bool young = (ATT_YOUNG_FROM < 512) && __builtin_amdgcn_readfirstlane(tid) >= ATT_YOUNG_FROM;
        ATT_WAITN(0); __builtin_amdgcn_s_barrier(); asm volatile("" ::: "memory");
        ATT_DMAK(0, 0); ATT_DMAK(1, 1); ATT_DMAV(0, 0); ATT_DMAK(2, 2); ATT_DMAV(1, 1);
        ATT_WAIT2(); __builtin_amdgcn_s_barrier(); asm volatile("" ::: "memory");
        int sc = 0;
        if (young) {
            qkt<DK>(pA0, pA1, K_lds, qr, kq);
            ATT_SYNC(0); sc = 1;
            for (int j = 1; j + 1 < NT; j += 2) {
                ATT_STEP_YNG(j, pB0, pB1, mnB, alB, pA0, pA1, mnA, alA);
                ATT_STEP_YNG(j + 1, pA0, pA1, mnA, alA, pB0, pB1, mnB, alB);
            }
            ATT_STEP_YNG(NT - 1, pB0, pB1, mnB, alB, pA0, pA1, mnA, alA);
            partialSM<WIN>(pB0, pB1, m_reg, mnB, alB, C, THRR, NT - 1 >= 4, ATT_DQ(NT - 1), hi); ATT_RESC(alB);
        } else {
            qkt<DK>(pA0, pA1, K_lds, qr, kq); partialSM<WIN>(pA0, pA1, m_reg, mnA, alA, C, THRR, false, 0, hi);
            ATT_SYNC(0); ATT_RESC(alA); sc = 1;
            for (int j = 1; j + 1 < NT; j += 2) {
                ATT_STEP_OLD(j, pB0, pB1, mnB, alB, pA0, pA1, mnA, alA);
                ATT_STEP_OLD(j + 1, pA0, pA1, mnA, alA, pB0, pB1, mnB, alB);
            }
            ATT_STEP_OLD(NT - 1, pB0, pB1, mnB, alB, pA0, pA1, mnA, alA);
        }
        finishSM(pB0, pB1, alB, l_reg, pa0, pa1, pa2, pa3); ASBAR();
        pv_all<DV>(o, vb0 + ((sc == 0) ? 2 : sc - 1) * SHM_V, pa0, pa1, pa2, pa3);
#undef ATT_SYNC
#undef ATT_STEP_OLD
#undef ATT_STEP_YNG
#undef ATT_DMAK
#undef ATT_DMAV
#undef ATT_WAITN
#undef ATT_WAIT1
#undef ATT_WAIT2
    } else if constexpr (MODE == 1) {
        ATT_SLOAD(0); asm volatile("s_waitcnt vmcnt(0)" ::: "memory"); ATT_SWRITE(0); __syncthreads();
        for (int j = 0; j < NT; ++j) {
            const int b = j & 1;
            if (j + 1 < NT) ATT_SLOAD(j + 1);
            ASBAR(); qkt<DK>(pA0, pA1, K_lds + b * SHM_K, qr, kq);
            partialSM<WIN>(pA0, pA1, m_reg, mnA, alA, C, THRR, j >= 4, ATT_DQ(j), hi);
            ATT_RESC(alA);
            finishSM(pA0, pA1, alA, l_reg, pa0, pa1, pa2, pa3); ASBAR();
            pv_all<DV>(o, vb0 + b * SHM_V, pa0, pa1, pa2, pa3);
            if (j + 1 < NT) { asm volatile("s_waitcnt vmcnt(0)" ::: "memory"); ATT_SWRITE(b ^ 1); }
            __syncthreads();
        }
    } else {
    ATT_SLOAD(0); asm volatile("s_waitcnt vmcnt(0)" ::: "memory"); ATT_SWRITE(0); __syncthreads();
    qkt<DK>(pA0, pA1, K_lds, qr, kq); partialSM<WIN>(pA0, pA1, m_reg, mnA, alA, C, THRR, false, 0, hi);
    ATT_SLOAD(1); asm volatile("s_waitcnt vmcnt(0)" ::: "memory"); ATT_SWRITE(1); __syncthreads();
    for (int j = 1; j + 1 < NT; j += 2) {
        ASBAR(); qkt<DK>(pB0, pB1, K_lds + SHM_K, qr, kq);
        finishSM(pA0, pA1, alA, l_reg, pa0, pa1, pa2, pa3); ASBAR();
        ATT_SLOAD(j + 1); ASBAR();
        pv_all<DV>(o, vb0, pa0, pa1, pa2, pa3); partialSM<WIN>(pB0, pB1, m_reg, mnB, alB, C, THRR, j >= 4, ATT_DQ(j), hi);
        __syncthreads(); asm volatile("s_waitcnt vmcnt(0)" ::: "memory"); ATT_SWRITE(0);
        ATT_RESC(alB); __syncthreads();
        ASBAR(); qkt<DK>(pA0, pA1, K_lds, qr, kq);
        finishSM(pB0, pB1, alB, l_reg, pa0, pa1, pa2, pa3); ASBAR();
        ATT_SLOAD(j + 2); ASBAR();
        pv_all<DV>(o, vb0 + SHM_V, pa0, pa1, pa2, pa3); partialSM<WIN>(pA0, pA1, m_reg, mnA, alA, C, THRR, j + 1 >= 4, ATT_DQ(j + 1), hi);
        __syncthreads(); asm volatile("s_waitcnt vmcnt(0)" ::: "memory"); ATT_SWRITE(1);
        ATT_RESC(alA); __syncthreads();
    }
    ASBAR(); qkt<DK>(pB0, pB1, K_lds + SHM_K, qr, kq);
    finishSM(pA0, pA1, alA, l_reg, pa0, pa1, pa2, pa3); ASBAR();
    pv_all<DV>(o, vb0, pa0, pa1, pa2, pa3); partialSM<WIN>(pB0, pB1, m_reg, mnB, alB, C, THRR, NT - 1 >= 4, ATT_DQ(NT - 1), hi);
    __syncthreads(); ATT_RESC(alB);
    finishSM(pB0, pB1, alB, l_reg, pa0, pa1, pa2, pa3); ASBAR();
    pv_all<DV>(o, vb0 + SHM_V, pa0, pa1, pa2, pa3);
    }
    if constexpr (SINK) l_reg += __builtin_amdgcn_exp2f(sinkl2 - m_reg * C);
    if (hi == 0) li_l[r32] = l_reg;
    asm volatile("s_waitcnt lgkmcnt(0)" ::: "memory");
    float rli[16];
#pragma unroll
    for (int r = 0; r < 16; ++r) rli[r] = __builtin_amdgcn_rcpf(li_l[crow(r, hi)]);
    bf16_t* Ow = Ob + (long)(wid * 32) * ldo + r32;
#pragma unroll
    for (int r = 0; r < 16; ++r) { const int orow = crow(r, hi);
#pragma unroll
        for (int d0 = 0; d0 < NO; ++d0) Ow[(long)orow * ldo + d0 * 32] = (bf16_t)(cvtpk(o[d0][r] * rli[r], 0.f) & 0xffffu); }
#undef ATT_ROWOF
#undef ATT_SLOAD
#undef ATT_SWRITE
#undef ATT_RESC
#undef ATT_DQ
}
}
typedef unsigned short bf16;
typedef unsigned v4u __attribute__((ext_vector_type(4)));
typedef unsigned v2u __attribute__((ext_vector_type(2)));
typedef float f32x4 __attribute__((ext_vector_type(4)));
typedef short bf16x8 __attribute__((ext_vector_type(8)));
typedef GAS unsigned gu32;
#define LDS_WAIT() asm volatile("s_waitcnt lgkmcnt(0)" ::: "memory")
#define VM_WAIT() asm volatile("s_waitcnt vmcnt(0)" ::: "memory")

constexpr int NWAVES = 8;
constexpr int DM = 2048, NB = 8, SEQ = 4096, DEPTH = 4, CTXL = 256, DFF = 5632;
constexpr int ML = NB * SEQ, MC = NB * CTXL, MT = ML + MC;
constexpr int NIN = 8768, NINP = 8960, NMOD = 6 * DM;
constexpr float EPS = 1e-6f;
static_assert(ML == pg8::ML_ROWS, "row split");

constexpr size_t MiB = 1u << 20;
constexpr size_t WS_CTL = 0, CTL_ZERO_BYTES = 1 * MiB;
constexpr size_t WS_MOD = 1 * MiB;
constexpr size_t WS_ROPE = 3 * MiB;
constexpr size_t WS_W = 4 * MiB;
constexpr size_t WO_IN = 0, WO_Q = WO_IN + (size_t)NINP * DM * 2, WO_KV = WO_Q + (size_t)1536 * 512 * 2, WO_C = WO_KV + (size_t)2048 * 256 * 2, WO_M = WO_C + (size_t)2048 * 512 * 2,
                 WO_G = WO_M + (size_t)2048 * 1024 * 2, WO_O = WO_G + (size_t)2048 * 512 * 2, WO_F1 = WO_O + (size_t)2048 * 2048 * 2, WO_F2 = WO_F1 + (size_t)2 * DFF * DM * 2,
                 WO_END = WO_F2 + (size_t)DM * DFF * 2;
static_assert(WO_END <= 120 * MiB, "weights");
constexpr size_t WS_XC = 124 * MiB;
constexpr size_t WS_A = 140 * MiB;
constexpr size_t WS_B = 548 * MiB;
constexpr size_t WS_C = 684 * MiB;
constexpr size_t WS_D = 786 * MiB;
constexpr size_t WD_KF = 0, WD_V = 102 * MiB, WD_GQ = 170 * MiB, WD_GK = 204 * MiB, WD_GV = 213 * MiB, WD_U = 222 * MiB;
constexpr size_t WS_E = 1058 * MiB;
constexpr size_t WE_UC = 0, WE_CKV = 34 * MiB, WE_QA = 51 * MiB;
constexpr size_t WS_XB = 1144 * MiB;
constexpr size_t WS_END = 1272 * MiB;
static_assert((size_t)MT * 6144 * 2 <= 408 * MiB && (size_t)MT * 2048 * 2 <= 136 * MiB && (size_t)MT * 768 * 4 <= 102 * MiB && (size_t)MT * 2048 * 4 <= 272 * MiB && WD_U + (size_t)MT * 512 * 2 <= 272 * MiB, "ws map");
constexpr int CW_BAR = 4096;

constexpr int RING_OFF = 0, RING_BYTES = 131072, LDSCTL_OFF = RING_BYTES, MISC_OFF = LDSCTL_OFF + 320, LDS_BYTES = 147456;

__device__ __forceinline__ unsigned f2bf(float f) { unsigned u = __builtin_bit_cast(unsigned, f); return (u + 0x7fffu + ((u >> 16) & 1u)) >> 16; }
__device__ __forceinline__ unsigned pk2(float lo, float hi) { return pg8::cvt_pk_bf16(lo, hi); }
__device__ __forceinline__ float wave_sum(float v) {
#pragma unroll
    for (int o = 1; o < 64; o <<= 1) v += __shfl_xor(v, o);
    return v;
}
__device__ __forceinline__ float bflo(unsigned w) { return __uint_as_float(w << 16); }
__device__ __forceinline__ float bfhi(unsigned w) { return __uint_as_float(w & 0xffff0000u); }
__device__ __forceinline__ float sigmf(float x) { return __builtin_amdgcn_rcpf(1.0f + __builtin_amdgcn_exp2f(-1.4426950408889634f * x)); }

__device__ __forceinline__ int srccol(int mode, int n) {
    if (mode == 0) return n;
    if (mode == 1) {
        if (n < 6144) return 2624 + n;
        if (n < 7744) { const int o = n - 6144; const bool pair = (o >= 256 && o < 448) || o >= 1088;
            if (!pair) return o; const int b0 = o & ~31, p = o & 31; return b0 + 4 * (p >> 3) + (p & 3) + 16 * ((p >> 2) & 1); }
        if (n < 8768) { const int q = n - 7744, g = q >> 5, p = q & 31, i = 4 * (p >> 3) + (p & 3); return 1600 + (((p >> 2) & 1) ? 512 : 0) + 16 * g + i; }
        return -1;
    }
    { const int t = n >> 8, j = n & 255; return j < 128 ? 128 * t + j : DFF + 128 * t + (j - 128); }
}
__device__ __forceinline__ void cvt_item(const float* W, int K, int N, bf16* WT, LAS float* scr, int item, int nblk, int lane, int mode) {
    const int kb = item / nblk, nb = item % nblk, k0 = 64 * kb, n0 = 32 * nb;
    const int sc = srccol(mode, n0 + (lane & 31));
    const float wsc = (mode == 1 && n0 < 6144) ? -1.4426950408889634f : 1.0f;
    const float* wp = W + (size_t)(k0 + (lane >> 5)) * N + (sc >= 0 ? sc : 0);
#pragma unroll 8
    for (int i = 0; i < 32; ++i) { const float v = wp[(size_t)(2 * i) * N] * wsc; scr[(2 * i + (lane >> 5)) * 33 + (lane & 31)] = sc >= 0 ? v : 0.f; }
    LDS_WAIT(); asm volatile("" ::: "memory");
    const int c = lane & 7;
#pragma unroll
    for (int j = 0; j < 4; ++j) { const int n = (lane >> 3) + 8 * j; const LAS float* s = scr + (8 * c) * 33 + n;
        v4u o; o.x = pk2(s[0 * 33], s[1 * 33]); o.y = pk2(s[2 * 33], s[3 * 33]); o.z = pk2(s[4 * 33], s[5 * 33]); o.w = pk2(s[6 * 33], s[7 * 33]);
        *(GAS v4u*)(WT + (size_t)(n0 + n) * K + k0 + 8 * c) = o; }
    LDS_WAIT(); asm volatile("" ::: "memory");
}

#ifndef ATT_MLA_MODE
#define ATT_MLA_MODE 2
#endif
#ifndef ATT_GQA_MODE
#define ATT_GQA_MODE 2
#endif
#ifndef P5_WGM
#define P5_WGM 8
#endif
#ifndef P1_WGM
#define P1_WGM 4
#endif
#ifndef P8_WGM
#define P8_WGM 4
#endif
#ifndef SPLIT_WGM
#define SPLIT_WGM 2
#endif
struct Args { const float* in[25]; float* out; unsigned char* ws; int multi, l_lo, l_hi, ph, pad0, pad1; };
enum { PH_PRE = -1, PH_POST = 10, PH_DUMP = 11 };

struct __attribute__((packed, aligned(4))) F3 { float x, y, z; };
#define PHASE_BEGIN \
    const __attribute__((address_space(4))) Args* ap = (const __attribute__((address_space(4))) Args*)__builtin_amdgcn_kernarg_segment_ptr(); asm volatile("" : "+s"(ap)); \
    unsigned char* ws = ap->ws; \
    int tid = threadIdx.x; asm volatile("" : "+v"(tid)); const int lane = tid & 63, wave = __builtin_amdgcn_readfirstlane(tid >> 6); \
    const int gw = vcu * NWAVES + wave, NGW = G * NWAVES; (void)gw; (void)NGW; (void)lane; \
    const float* in_x = ap->in[0]; const float* in_c = ap->in[1]; const float* in_ctx = ap->in[2]; const float* in_cctx = ap->in[3]; const float* w_ada = ap->in[4]; const float* b_ada = ap->in[5]; const float* g_mix = ap->in[6]; const float* w_in = ap->in[7]; const float* conv_w = ap->in[8]; const float* conv_b = ap->in[9]; const float* conv_ln_g = ap->in[10]; const float* conv_ln_b = ap->in[11]; const float* w_conv_out = ap->in[12]; const float* g_q_a = ap->in[13]; const float* w_q_up = ap->in[14]; const float* g_kv_a = ap->in[15]; const float* w_kv_up = ap->in[16]; const float* w_mla_out = ap->in[17]; const float* gqa_sink = ap->in[18]; const float* w_gqa_out = ap->in[19]; const float* w_out = ap->in[20]; const float* g_ffn = ap->in[21]; const float* w_ffn_in = ap->in[22]; const float* w_ffn_out = ap->in[23]; const float* g_final = ap->in[24]; float* XL = ap->out; bf16* XB = (bf16*)(ws + WS_XB); bf16* XCB = (bf16*)(ws + WS_XC); (void)XL; (void)XCB; float* MOD = (float*)(ws + WS_MOD); float* ROPE = (float*)(ws + WS_ROPE); float* XC = (float*)(ws + WS_XC); bf16* Win_t = (bf16*)(ws + WS_W + WO_IN); bf16* Wq_t = (bf16*)(ws + WS_W + WO_Q); bf16* Wkv_t = (bf16*)(ws + WS_W + WO_KV); bf16* Wc_t = (bf16*)(ws + WS_W + WO_C); bf16* Wm_t = (bf16*)(ws + WS_W + WO_M); bf16* Wg_t = (bf16*)(ws + WS_W + WO_G); bf16* Wo_t = (bf16*)(ws + WS_W + WO_O); bf16* Wf1_t = (bf16*)(ws + WS_W + WO_F1); bf16* Wf2_t = (bf16*)(ws + WS_W + WO_F2); unsigned char* Gb = (unsigned char*)(ws + WS_A); bf16* HID = (bf16*)(ws + WS_A); bf16* Hb = (bf16*)(ws + WS_B); bf16* MQ = (bf16*)(ws + WS_B); bf16* Yb = (bf16*)(ws + WS_B); bf16* CQ = (bf16*)(ws + WS_C); bf16* PART = (bf16*)(ws + WS_C); bf16* OM = (bf16*)(ws + WS_C); bf16* OG = (bf16*)(ws + WS_C + (size_t)MT * 1024 * 2); bf16* KF = (bf16*)(ws + WS_D + WD_KF); bf16* Vb = (bf16*)(ws + WS_D + WD_V); bf16* GQ = (bf16*)(ws + WS_D + WD_GQ); bf16* GK = (bf16*)(ws + WS_D + WD_GK); bf16* GV = (bf16*)(ws + WS_D + WD_GV); bf16* Ub = (bf16*)(ws + WS_D + WD_U); bf16* YF = (bf16*)(ws + WS_D); bf16* UC = (bf16*)(ws + WS_E + WE_UC); bf16* CKVn = (bf16*)(ws + WS_E + WE_CKV); bf16* QAn = (bf16*)(ws + WS_E + WE_QA); \
    const float* modl = MOD + (size_t)l_cur * 9 * NMOD; (void)modl;
__global__ void __launch_bounds__(NWAVES * 64, 2) mega_fwd(Args args) {
    extern __shared__ __attribute__((aligned(16))) unsigned char lds_raw[];
    LAS unsigned char* lds = (LAS unsigned char*)lds_raw;
    volatile LAS unsigned* MISC = (volatile LAS unsigned*)(lds + MISC_OFF);
    const int tid0 = threadIdx.x;
    const int G = gridDim.x; const int bx = blockIdx.x; const int vcu = (G % 8 == 0) ? (bx % 8) * (G / 8) + bx / 8 : bx;
    gu32* ctl = (gu32*)(args.ws + WS_CTL);
    int l_cur = 0;
    for (int u = tid0; u < (LDS_BYTES - LDSCTL_OFF) / 4; u += NWAVES * 64) ((LAS unsigned*)(lds + LDSCTL_OFF))[u] = 0u;
    __syncthreads();
    XcdBarrier bar = xcd_barrier_post((unsigned*)(ctl + CW_BAR), MISC + 8);
    const int multi = args.multi, ph = args.ph;
#ifndef PHASE_MASK
#define PHASE_MASK 0x1fff
#endif
#define RUN(k) ((((PHASE_MASK) >> ((k) + 1)) & 1) && (!multi || ph == (k)))
#define GRID_BAR() do { if (!multi) xcd_barrier(bar); } while (0)

    if (RUN(PH_PRE)) { PHASE_BEGIN
        LAS float* sil = (LAS float*)(lds + RING_OFF);
        LAS float* red = (LAS float*)(lds + RING_OFF + 9 * DM * 4);
        for (int i = tid; i < 9 * DM; i += NWAVES * 64) { const float v = i < 8 * DM ? in_c[i] : in_cctx[i - 8 * DM]; sil[(i & (DM - 1)) * 9 + (i >> 11)] = v * sigmf(v); }
        __syncthreads();
#define ADA_LOAD(W_, I0) do { _Pragma("unroll") for (int u = 0; u < 8; ++u) W_[u] = *(const F3*)(Wl + (size_t)((I0) + u) * 8 * NMOD); } while (0)
#define ADA_FMA(W_, I0) do { _Pragma("unroll") for (int u = 0; u < 8; ++u) { const LAS float* sp = sil + (((I0) + u) * 8 + wave) * 9; \
            _Pragma("unroll") for (int v = 0; v < 9; ++v) { const float sv = sp[v]; acc[v][0] += W_[u].x * sv; acc[v][1] += W_[u].y * sv; acc[v][2] += W_[u].z * sv; } asm volatile("" ::: "memory"); } } while (0)
        for (int s = vcu; s < DEPTH * 64; s += G) {
            const int l = s >> 6, col0 = (s & 63) * 192;
            const float* Wl = w_ada + (size_t)l * DM * NMOD + (size_t)wave * NMOD + col0 + 3 * lane;
            float acc[9][3];
#pragma unroll
            for (int v = 0; v < 9; ++v) { acc[v][0] = 0.f; acc[v][1] = 0.f; acc[v][2] = 0.f; }
            F3 wa[8], wb[8];
            ADA_LOAD(wa, 0);
#pragma nounroll
            for (int i = 0; i < DM / 8; i += 16) {
                ADA_LOAD(wb, i + 8);
                ADA_FMA(wa, i);
                { const int in_ = (i + 16 < DM / 8) ? i + 16 : 0; ADA_LOAD(wa, in_); }
                ADA_FMA(wb, i + 8);
            }
#pragma unroll
            for (int v = 0; v < 9; ++v) {
#pragma unroll
                for (int e = 0; e < 3; ++e) red[(wave * 9 + v) * 192 + 3 * lane + e] = acc[v][e]; }
            __syncthreads();
            for (int i = tid; i < 9 * 192; i += NWAVES * 64) { const int v = i / 192, cc = i - v * 192; float t = 0.f;
#pragma unroll
                for (int w8 = 0; w8 < 8; ++w8) t += red[(w8 * 9 + v) * 192 + cc];
                MOD[((size_t)l * 9 + v) * NMOD + col0 + cc] = t + b_ada[(size_t)l * NMOD + col0 + cc]; }
            __syncthreads();
        }
        { bf16* XB = (bf16*)(ws + WS_XB);
          for (size_t i = ((size_t)gw * 64 + lane) * 8; i < (size_t)ML * DM; i += (size_t)NGW * 64 * 8) { const f32x4 a = *(const f32x4*)(in_x + i), b = *(const f32x4*)(in_x + i + 4);
              v4u w; w.x = pk2(a[0], a[1]); w.y = pk2(a[2], a[3]); w.z = pk2(b[0], b[1]); w.w = pk2(b[2], b[3]); *(v4u*)(XB + i) = w; }
          bf16* XCB = (bf16*)(ws + WS_XC);
          for (size_t i = ((size_t)gw * 64 + lane) * 8; i < (size_t)MC * DM; i += (size_t)NGW * 64 * 8) { const f32x4 a = *(const f32x4*)(in_ctx + i), b = *(const f32x4*)(in_ctx + i + 4);
              v4u w; w.x = pk2(a[0], a[1]); w.y = pk2(a[2], a[3]); w.z = pk2(b[0], b[1]); w.w = pk2(b[2], b[3]); *(v4u*)(XCB + i) = w; } }
        { const int i = bx * (NWAVES * 64) + tid; if (i < 64 * 16) { const int p = i >> 4, f = i & 15; const float invf = powf(10000.0f, -(float)f / 16.0f), a = (float)p * invf;
              ROPE[2 * i] = cosf(a); ROPE[2 * i + 1] = sinf(a); } }
    }
    GRID_BAR();

    for (int l = args.l_lo; l < args.l_hi; ++l) {
        l_cur = l;
        const bool lastl = (l == DEPTH - 1); const int Mg = lastl ? ML : MT;
        if (RUN(0)) { PHASE_BEGIN
            LAS float* scr = (LAS float*)(lds + RING_OFF + wave * 16384);
            constexpr int I_IN = (DM / 64) * (NINP / 32), I_Q = (512 / 64) * (1536 / 32), I_KV = (256 / 64) * (2048 / 32), I_C = (512 / 64) * (DM / 32), I_M = (1024 / 64) * (DM / 32),
                          I_G = (512 / 64) * (DM / 32), I_O = (DM / 64) * (DM / 32), I_F1 = (DM / 64) * (2 * DFF / 32), I_F2 = (DFF / 64) * (DM / 32);
            constexpr int NITEMS = I_IN + I_Q + I_KV + I_C + I_M + I_G + I_O + I_F1 + I_F2;
            for (int it = gw; it < NITEMS; it += NGW) {
                int r = it; const float* W; bf16* WT; int K, N, nblk, mode = 0;
                if (r < I_IN) { W = w_in + (size_t)l * DM * NIN; K = DM; N = NIN; WT = Win_t; nblk = NINP / 32; mode = 1; }
                else if ((r -= I_IN) < I_Q) { W = w_q_up + (size_t)l * 512 * 1536; K = 512; N = 1536; WT = Wq_t; nblk = 1536 / 32; }
                else if ((r -= I_Q) < I_KV) { W = w_kv_up + (size_t)l * 256 * 2048; K = 256; N = 2048; WT = Wkv_t; nblk = 2048 / 32; }
                else if ((r -= I_KV) < I_C) { W = w_conv_out + (size_t)l * 512 * DM; K = 512; N = DM; WT = Wc_t; nblk = DM / 32; }
                else if ((r -= I_C) < I_M) { W = w_mla_out + (size_t)l * 1024 * DM; K = 1024; N = DM; WT = Wm_t; nblk = DM / 32; }
                else if ((r -= I_M) < I_G) { W = w_gqa_out + (size_t)l * 512 * DM; K = 512; N = DM; WT = Wg_t; nblk = DM / 32; }
                else if ((r -= I_G) < I_O) { W = w_out + (size_t)l * DM * DM; K = DM; N = DM; WT = Wo_t; nblk = DM / 32; }
                else if ((r -= I_O) < I_F1) { W = w_ffn_in + (size_t)l * DM * 2 * DFF; K = DM; N = 2 * DFF; WT = Wf1_t; nblk = 2 * DFF / 32; mode = 2; }
                else { r -= I_F1; W = w_ffn_out + (size_t)l * DFF * DM; K = DFF; N = DM; WT = Wf2_t; nblk = DM / 32; }
                cvt_item(W, K, N, WT, scr, r, nblk, lane, mode);
            }
        }
#define NORM_LDMOD(SEL, GVEC, SHOFF, SCOFF) do { const float* mp = modl + (size_t)(SEL) * NMOD; \
                _Pragma("unroll") for (int j = 0; j < 8; ++j) { const int c = 4 * ln_ + 256 * j; const f32x4 g = *(const f32x4*)((GVEC) + c), sc = *(const f32x4*)(mp + (SCOFF) + c); \
                    Aa[j] = g * (sc + 1.0f); Ss[j] = *(const f32x4*)(mp + (SHOFF) + c); } } while (0)
#define NORM_FINISH(R) do { float ss = 0.f; \
                _Pragma("unroll") for (int j = 0; j < 8; ++j) ss += (v[j][0] * v[j][0] + v[j][1] * v[j][1]) + (v[j][2] * v[j][2] + v[j][3] * v[j][3]); \
                const float rstd = 1.0f / sqrtf(wave_sum(ss) * (1.0f / DM) + EPS); \
                bf16* hp = Hb + (size_t)(R) * DM + 4 * ln_; \
                _Pragma("unroll") for (int j = 0; j < 8; ++j) { const f32x4 y = v[j] * rstd * Aa[j] + Ss[j]; v2u w; w.x = pk2(y[0], y[1]); w.y = pk2(y[2], y[3]); *(v2u*)(hp + 256 * j) = w; } } while (0)
#define NORM_ROWS(GVEC, SHOFF, SCOFF, FIRST, WITHCTX, PARTG) do { \
            int ln_ = lane; asm volatile("" : "+v"(ln_)); \
            f32x4 Aa[8], Ss[8]; \
            _Pragma("unroll") for (int j = 0; j < 8; ++j) { Aa[j] = (f32x4){0.f, 0.f, 0.f, 0.f}; Ss[j] = (f32x4){0.f, 0.f, 0.f, 0.f}; } \
            for (int gv_ = gw; gv_ < 2048; gv_ += NGW) { \
                NORM_LDMOD((gv_ * 16) >> 12, GVEC, SHOFF, SCOFF);                                   \
                _Pragma("nounroll") for (int ri = 0; ri < 16; ++ri) { int r = gv_ * 16 + ri; asm volatile("" : "+s"(r)); \
                    const bf16* sb_ = XB + (size_t)r * DM + 4 * ln_; f32x4 v[8]; \
                    _Pragma("unroll") for (int j = 0; j < 8; ++j) { const v2u t_ = *(const v2u*)(sb_ + 256 * j); v[j] = (f32x4){bflo(t_.x), bfhi(t_.x), bflo(t_.y), bfhi(t_.y)}; } \
                    NORM_FINISH(r); } \
                if (WITHCTX) { NORM_LDMOD(8, GVEC, SHOFF, SCOFF); int rc = gv_; asm volatile("" : "+s"(rc));     \
                    bf16* sb_ = XCB + (size_t)rc * DM + 4 * ln_; f32x4 v[8]; \
                    _Pragma("unroll") for (int j = 0; j < 8; ++j) { const v2u t_ = *(const v2u*)(sb_ + 256 * j); v[j] = (f32x4){bflo(t_.x), bfhi(t_.x), bflo(t_.y), bfhi(t_.y)}; } \
                    if ((PARTG) != nullptr) { const bf16* pp = PART + (size_t)rc * DM + 4 * ln_; \
                        _Pragma("unroll") for (int j = 0; j < 8; ++j) { const v2u q0_ = *(const v2u*)(pp + 256 * j), q1_ = *(const v2u*)(pp + (size_t)2048 * DM + 256 * j), q2_ = *(const v2u*)(pp + (size_t)2 * 2048 * DM + 256 * j), q3_ = *(const v2u*)(pp + (size_t)3 * 2048 * DM + 256 * j); \
                            const f32x4 p = ((f32x4){bflo(q0_.x), bfhi(q0_.x), bflo(q0_.y), bfhi(q0_.y)} + (f32x4){bflo(q1_.x), bfhi(q1_.x), bflo(q1_.y), bfhi(q1_.y)}) + ((f32x4){bflo(q2_.x), bfhi(q2_.x), bflo(q2_.y), bfhi(q2_.y)} + (f32x4){bflo(q3_.x), bfhi(q3_.x), bflo(q3_.y), bfhi(q3_.y)}); \
                            v[j] += *(const f32x4*)((PARTG) + 4 * ln_ + 256 * j) * p; } \
                        _Pragma("unroll") for (int j = 0; j < 8; ++j) { v2u w_; w_.x = pk2(v[j][0], v[j][1]); w_.y = pk2(v[j][2], v[j][3]); *(v2u*)(sb_ + 256 * j) = w_; } } \
                    NORM_FINISH(ML + rc); } } \
        } while (0)
        if (RUN(0)) { PHASE_BEGIN const float* gv = g_mix + (size_t)l * DM; const int first = (l == 0) ? 1 : 0;
            const float* pg = first ? nullptr : (MOD + ((size_t)(l - 1) * 9 + 8) * NMOD + 5 * DM);
            NORM_ROWS(gv, 0, DM, first, true, pg); }
        GRID_BAR();

        if (RUN(1)) { PHASE_BEGIN
            const bf16* A_ = Hb; const bf16* B_ = Win_t; asm volatile("" : "+s"(A_), "+s"(B_)); pg8::Gemm g{A_, B_, MT, NINP, DM}; pg8::StaticOrder S; S.init(Mg, NINP, G, bx); S.wgm = P1_WGM; if (lastl) S.set_extra(24, ML / 256, 24, 3);
            pg8::EpiWin E{Gb, CQ, KF, GK, GV, GQ, Ub, ROPE};
            pg8::gemm_phase<pg8::EpiWin, pg8::StaticOrder, true, true>(lds + RING_OFF, g, S, E);
        }
        GRID_BAR();

        if (RUN(2)) { PHASE_BEGIN
            LAS float* cw = (LAS float*)(lds + RING_OFF);
            for (int i = tid; i < 31 * 512; i += NWAVES * 64) cw[i] = conv_w[(size_t)l * 31 * 512 + i];
            __syncthreads();
            { const f32x4 gk = *(const f32x4*)(g_kv_a + (size_t)l * 256 + 4 * lane), gq0 = *(const f32x4*)(g_q_a + (size_t)l * 512 + 4 * lane), gq1 = *(const f32x4*)(g_q_a + (size_t)l * 512 + 256 + 4 * lane);
              for (int r0 = gw; r0 < MT; r0 += 2 * NGW) { const int r1 = (r0 + NGW < MT) ? r0 + NGW : r0;
                const bf16* p = CQ + (size_t)r0 * 768 + 4 * lane; const bf16* q = CQ + (size_t)r1 * 768 + 4 * lane;
#define LD4(P) ({ const v2u t_ = *(const v2u*)(P); (f32x4){bflo(t_.x), bfhi(t_.x), bflo(t_.y), bfhi(t_.y)}; })
                const f32x4 a = LD4(p), b0 = LD4(p + 256), b1 = LD4(p + 512), c = LD4(q), d0 = LD4(q + 256), d1 = LD4(q + 512);
#undef LD4
#define LR_ROW(R, A_, B0_, B1_) do { \
                const float sa = wave_sum((A_[0] * A_[0] + A_[1] * A_[1]) + (A_[2] * A_[2] + A_[3] * A_[3])); \
                const float sb = wave_sum(((B0_[0] * B0_[0] + B0_[1] * B0_[1]) + (B0_[2] * B0_[2] + B0_[3] * B0_[3])) + ((B1_[0] * B1_[0] + B1_[1] * B1_[1]) + (B1_[2] * B1_[2] + B1_[3] * B1_[3]))); \
                const float ra = 1.0f / sqrtf(sa * (1.0f / 256.0f) + EPS), rb = 1.0f / sqrtf(sb * (1.0f / 512.0f) + EPS); \
                const f32x4 ya = A_ * ra * gk, y0 = B0_ * rb * gq0, y1 = B1_ * rb * gq1; \
                v2u w; w.x = pk2(ya[0], ya[1]); w.y = pk2(ya[2], ya[3]); *(v2u*)(CKVn + (size_t)(R) * 256 + 4 * lane) = w; \
                w.x = pk2(y0[0], y0[1]); w.y = pk2(y0[2], y0[3]); *(v2u*)(QAn + (size_t)(R) * 512 + 4 * lane) = w; \
                w.x = pk2(y1[0], y1[1]); w.y = pk2(y1[2], y1[3]); *(v2u*)(QAn + (size_t)(R) * 512 + 256 + 4 * lane) = w; } while (0)
                LR_ROW(r0, a, b0, b1); LR_ROW(r1, c, d0, d1);
#undef LR_ROW
              } }
            { const int ch = 8 * lane;
              const f32x4 cb0 = *(const f32x4*)(conv_b + (size_t)l * 512 + ch), cb1 = *(const f32x4*)(conv_b + (size_t)l * 512 + ch + 4);
              const f32x4 lg0 = *(const f32x4*)(conv_ln_g + (size_t)l * 512 + ch), lg1 = *(const f32x4*)(conv_ln_g + (size_t)l * 512 + ch + 4);
              const f32x4 lb0 = *(const f32x4*)(conv_ln_b + (size_t)l * 512 + ch), lb1 = *(const f32x4*)(conv_ln_b + (size_t)l * 512 + ch + 4);
              for (int tok = gw; tok < Mg; tok += NGW) {
                int sb, pos, L; if (tok < ML) { sb = tok & ~4095; pos = tok & 4095; L = SEQ; } else { const int c = tok - ML; sb = ML + (c & ~255); pos = c & 255; L = CTXL; }
                f32x4 a0 = cb0, a1 = cb1;
                v4u xr[31];
                if (pos >= 15 && pos < L - 15) {
                    const bf16* up = Ub + (size_t)(sb + pos - 15) * 512 + ch;
#pragma unroll
                    for (int j = 0; j < 31; ++j) xr[j] = *(const v4u*)(up + (size_t)j * 512);
                    asm volatile("" ::: "memory");
#pragma unroll
                    for (int j = 0; j < 31; ++j) { const v4u x = xr[j];
                        const f32x4 w0 = *(const LAS f32x4*)(cw + j * 512 + ch), w1 = *(const LAS f32x4*)(cw + j * 512 + ch + 4);
                        const f32x4 x0 = {bflo(x.x), bfhi(x.x), bflo(x.y), bfhi(x.y)}, x1 = {bflo(x.z), bfhi(x.z), bflo(x.w), bfhi(x.w)};
                        a0 += w0 * x0; a1 += w1 * x1; if ((j & 3) == 3) asm volatile("" ::: "memory"); }
                } else {
#pragma unroll
                    for (int j = 0; j < 31; ++j) { int p = pos + j - 15; p = p < 0 ? 0 : (p >= L ? L - 1 : p); xr[j] = *(const v4u*)(Ub + (size_t)(sb + p) * 512 + ch); }
                    asm volatile("" ::: "memory");
#pragma unroll
                    for (int j = 0; j < 31; ++j) { const int p = pos + j - 15; const float ok = (p >= 0 && p < L) ? 1.0f : 0.0f; const v4u x = xr[j];
                        const f32x4 w0 = *(const LAS f32x4*)(cw + j * 512 + ch) * ok, w1 = *(const LAS f32x4*)(cw + j * 512 + ch + 4) * ok;
                        const f32x4 x0 = {bflo(x.x), bfhi(x.x), bflo(x.y), bfhi(x.y)}, x1 = {bflo(x.z), bfhi(x.z), bflo(x.w), bfhi(x.w)};
                        a0 += w0 * x0; a1 += w1 * x1; if ((j & 3) == 3) asm volatile("" ::: "memory"); }
                }
                const float mean = wave_sum((a0[0] + a0[1]) + (a0[2] + a0[3]) + (a1[0] + a1[1]) + (a1[2] + a1[3])) * (1.0f / 512.0f);
                const f32x4 d0 = a0 - mean, d1 = a1 - mean;
                const float var = wave_sum((d0[0] * d0[0] + d0[1] * d0[1]) + (d0[2] * d0[2] + d0[3] * d0[3]) + (d1[0] * d1[0] + d1[1] * d1[1]) + (d1[2] * d1[2] + d1[3] * d1[3])) * (1.0f / 512.0f);
                const float rstd = 1.0f / sqrtf(var + EPS);
                const f32x4 y0 = d0 * rstd * lg0 + lb0, y1 = d1 * rstd * lg1 + lb1;
                v4u w; w.x = pk2(y0[0] * sigmf(y0[0]), y0[1] * sigmf(y0[1])); w.y = pk2(y0[2] * sigmf(y0[2]), y0[3] * sigmf(y0[3]));
                w.z = pk2(y1[0] * sigmf(y1[0]), y1[1] * sigmf(y1[1])); w.w = pk2(y1[2] * sigmf(y1[2]), y1[3] * sigmf(y1[3]));
                *(v4u*)(UC + (size_t)tok * 512 + ch) = w; } }
        }
        GRID_BAR();

        if (RUN(3)) { PHASE_BEGIN
            const bf16* A0_ = QAn; const bf16* B0_ = Wq_t; const bf16* A1_ = CKVn; const bf16* B1_ = Wkv_t; asm volatile("" : "+s"(A0_), "+s"(B0_), "+s"(A1_), "+s"(B1_));
            pg8::SchedQKV S; S.nMq = Mg / 256; S.nNq = 1536 / 256; S.nMk = MT / 256; S.nNk = 2048 / 256; S.G = G; S.c = bx; S.Aq = A0_; S.Bq = B0_; S.Ak = A1_; S.Bk = B1_;
            pg8::EpiQKV E{pg8::EpiQup{MQ, ROPE}, pg8::EpiKV{KF, Vb}};
            pg8::gemm_stream<pg8::EpiQKV, pg8::SchedQKV>(lds + RING_OFF, S, E);
        }
        GRID_BAR();

        if (RUN(4)) { PHASE_BEGIN
            att::lchar* alds = (att::lchar*)(lds + RING_OFF);
            for (int u = vcu; u < 1024 + (lastl ? 0 : 64); u += G) {
                int b, h, q0row, NT;
                if (u < 1024) { const int bh = u >> 4, qb = u & 15; b = bh >> 3; h = bh & 7; q0row = b * SEQ + qb * 256; NT = 4 + SEQ / 64; }
                else { const int bh = u - 1024; b = bh >> 3; h = bh & 7; q0row = ML + b * CTXL; NT = 4; }
                att::attn_unit<192, 128, false, false, ATT_MLA_MODE>(MQ + (size_t)q0row * 1536 + h * 192, 1536, KF + h * 192, 1536, Vb + h * 128, 1024, OM + (size_t)q0row * 1024 + h * 128, 1024,
                                                       ML + b * CTXL, b * SEQ, NT, 0, 0, 0.f, alds);
            }
            for (int u = vcu; u < 1024 + (lastl ? 0 : 128); u += G) {
                int b, h, q0row, NT, qpos0, kpos0;
                if (u >= 1024 && u < 1088) continue;
                if (u < 1024) { const int bh = u >> 4, qb = u & 15; b = bh >> 3; h = bh & 7; q0row = b * SEQ + qb * 256; qpos0 = qb * 256;
                    const int klo = qpos0 - 128 < 0 ? 0 : qpos0 - 128, khi = qpos0 + 384 > SEQ ? SEQ : qpos0 + 384; kpos0 = klo; NT = 4 + (khi - klo) / 64; }
                else { const int bh = u - 1088; b = bh >> 3; h = bh & 7; q0row = ML + b * CTXL; NT = 4; qpos0 = 0; kpos0 = 0; }
                const float sk = gqa_sink[l * 8 + h] * 1.4426950408889634f;
                att::attn_unit<64, 64, true, true, ATT_GQA_MODE>(GQ + (size_t)q0row * 512 + h * 64, 512, GK + (h >> 2) * 64, 128, GV + (h >> 2) * 64, 128, OG + (size_t)q0row * 512 + h * 64, 512,
                                                   ML + b * CTXL, b * SEQ + kpos0, NT, qpos0, kpos0, sk, alds);
            }
            __syncthreads();
        }
        GRID_BAR();

        if (RUN(5)) { PHASE_BEGIN
            pg8::SchedMerge S; S.base.init(Mg, DM, G, bx); S.base.wgm = P5_WGM;
            { const bf16* a0_ = UC; const bf16* a1_ = OM; const bf16* a2_ = OG; const bf16* b0_ = Wc_t; const bf16* b1_ = Wm_t; const bf16* b2_ = Wg_t; asm volatile("" : "+s"(a0_), "+s"(a1_), "+s"(a2_), "+s"(b0_), "+s"(b1_), "+s"(b2_));
              S.a0 = (const char*)a0_; S.da1 = (const char*)a1_ - (const char*)a0_; S.da2 = (const char*)a2_ - (const char*)a1_; S.b0 = (const char*)b0_; S.db1 = (const char*)b1_ - (const char*)b0_; S.db2 = (const char*)b2_ - (const char*)b1_; }
            pg8::EpiChain E{Gb, Yb};
            pg8::gemm_stream<pg8::EpiChain, pg8::SchedMerge, true>(lds + RING_OFF, S, E);
        }
        GRID_BAR();

        if (RUN(6)) { PHASE_BEGIN
            const bf16* A_ = Yb; const bf16* B_ = Wo_t; asm volatile("" : "+s"(A_), "+s"(B_));
            pg8::SchedSplit S; S.A = A_; S.Bt = B_; S.K = DM; S.nlat = 1024; S.nctx = lastl ? 0 : 256; S.G = G; S.c = bx; S.wgm = SPLIT_WGM;
            pg8::EpiSplit E{pg8::EpiResid{XB, modl, 2 * DM}, PART};
            pg8::gemm_stream<pg8::EpiSplit, pg8::SchedSplit>(lds + RING_OFF, S, E);
        }
        GRID_BAR();

        if (RUN(7)) { PHASE_BEGIN const float* gv = g_ffn + (size_t)l * DM; const float* pg = lastl ? nullptr : (modl + (size_t)8 * NMOD + 2 * DM);
            const int first = (l == 0) ? 2 : 0; NORM_ROWS(gv, 3 * DM, 4 * DM, first, !lastl, pg); }
        GRID_BAR();

        if (RUN(8)) { PHASE_BEGIN
            const bf16* A_ = Hb; const bf16* B_ = Wf1_t; asm volatile("" : "+s"(A_), "+s"(B_)); pg8::Gemm g{A_, B_, MT, 2 * DFF, DM}; pg8::StaticOrder S; S.init(Mg, 2 * DFF, G, bx); S.wgm = P8_WGM; pg8::EpiSwiGLU E{HID};
            pg8::gemm_phase<pg8::EpiSwiGLU, pg8::StaticOrder, true, true>(lds + RING_OFF, g, S, E);
        }
        GRID_BAR();

        if (RUN(9)) { PHASE_BEGIN
            const bf16* A_ = HID; const bf16* B_ = Wf2_t; asm volatile("" : "+s"(A_), "+s"(B_));
            pg8::SchedSplit S; S.A = A_; S.Bt = B_; S.K = DFF; S.nlat = 1024; S.nctx = lastl ? 0 : 256; S.G = G; S.c = bx; S.wgm = SPLIT_WGM;
            pg8::EpiSplit E{pg8::EpiResid{XB, modl, 5 * DM}, PART};
            pg8::gemm_stream<pg8::EpiSplit, pg8::SchedSplit>(lds + RING_OFF, S, E);
        }
        GRID_BAR();
    }

    if (RUN(PH_POST)) { PHASE_BEGIN
        f32x4 gf[8];
#pragma unroll
        for (int j = 0; j < 8; ++j) gf[j] = *(const f32x4*)(g_final + 4 * lane + 256 * j);
        for (int r = gw; r < ML; r += NGW) { float* p = XL + (size_t)r * DM + 4 * lane; const bf16* sb = XB + (size_t)r * DM + 4 * lane; f32x4 v[8]; float ss = 0.f;
#pragma unroll
            for (int j = 0; j < 8; ++j) { const v2u t_ = *(const v2u*)(sb + 256 * j); v[j] = (f32x4){bflo(t_.x), bfhi(t_.x), bflo(t_.y), bfhi(t_.y)}; ss += (v[j][0] * v[j][0] + v[j][1] * v[j][1]) + (v[j][2] * v[j][2] + v[j][3] * v[j][3]); }
            const float rstd = 1.0f / sqrtf(wave_sum(ss) * (1.0f / DM) + EPS);
#pragma unroll
            for (int j = 0; j < 8; ++j) *(f32x4*)(p + 256 * j) = v[j] * rstd * gf[j]; }
    }

#if defined(DBG_STAGE)
    if (RUN(PH_DUMP)) { PHASE_BEGIN
        const int sel = ap->pad0; const size_t total = (size_t)G * NWAVES * 64, gt = (size_t)bx * NWAVES * 64 + tid;
        for (size_t i = gt; i < (size_t)ML * DM; i += total) { float v = 0.f;
#define DB16(bit, P, N) if (sel & (bit)) v += __uint_as_float((unsigned)(P)[i % (size_t)(N)] << 16)
            if (sel & 1) v += MOD[i % (size_t)(DEPTH * 9 * NMOD)];
            DB16(2, Hb, (size_t)MT * 2048); DB16(4, Gb, (size_t)MT * 6144); DB16(8, KF, (size_t)MT * 1536); DB16(16, Vb, (size_t)MT * 1024); DB16(32, GQ, (size_t)MT * 512);
            DB16(64, UC, (size_t)MT * 512); DB16(128, MQ, (size_t)MT * 1536); DB16(256, OM, (size_t)MT * 1024); DB16(512, OG, (size_t)MT * 512); DB16(1024, Yb, (size_t)MT * 2048);
            DB16(2048, Win_t, (size_t)NINP * 2048); DB16(4096, GK, (size_t)MT * 128); DB16(8192, GV, (size_t)MT * 128); DB16(16384, CKVn, (size_t)MT * 256); DB16(32768, QAn, (size_t)MT * 512);
            DB16(65536, Ub, (size_t)MT * 512); DB16(131072, Wf1_t, (size_t)2 * DFF * DM); DB16(262144, Wf2_t, (size_t)DM * DFF); DB16(524288, HID, (size_t)MT * DFF);
            if (sel & 1048576) v += CQ[i % ((size_t)MT * 768)];
            XL[i] = v; }
    }
#endif
#undef RUN
#undef GRID_BAR
#undef NORM_ROWS
}

#ifndef MK_MULTI
#define MK_MULTI 0
#endif
extern "C" void kernel_launch(void* const* d_in, const int* in_sizes, int n_in, void* d_out, int out_size, void* d_ws, size_t ws_size, hipStream_t stream) {
    static int grid = 0;
    if (grid == 0) {
        if (n_in != 25 || in_sizes[0] != ML * DM || out_size != ML * DM || ws_size < WS_END) {
            fprintf(stderr, "kernel_launch: shape mismatch: n_in %d in0 %d out %d ws %zu (need %zu)\n", n_in, n_in > 0 ? in_sizes[0] : -1, out_size, ws_size, (size_t)WS_END); grid = -1; return; }
        int dev = 0, cus = 0, per_cu = 0;
        if (hipGetDevice(&dev) != hipSuccess || hipDeviceGetAttribute(&cus, hipDeviceAttributeMultiprocessorCount, dev) != hipSuccess) { grid = -1; return; }
        if (hipFuncSetAttribute((const void*)mega_fwd, hipFuncAttributeMaxDynamicSharedMemorySize, LDS_BYTES) != hipSuccess) { fprintf(stderr, "kernel_launch: hipFuncSetAttribute failed\n"); grid = -1; return; }
        if (hipOccupancyMaxActiveBlocksPerMultiprocessor(&per_cu, (const void*)mega_fwd, NWAVES * 64, LDS_BYTES) != hipSuccess || per_cu < 1)
            fprintf(stderr, "kernel_launch: note: occupancy query reports %d workgroups per CU\n", per_cu);
        (void)hipGetLastError();
        grid = cus;
    }
    if (grid < 0) return;
    if (hipMemsetAsync((char*)d_ws + WS_CTL, 0, CTL_ZERO_BYTES, stream) != hipSuccess) return;
    Args a{};
    for (int i = 0; i < 25; ++i) a.in[i] = (const float*)d_in[i];
    a.out = (float*)d_out; a.ws = (unsigned char*)d_ws;
#if defined(DBG_STAGE)
    a.multi = 1;
    a.l_lo = 0; a.l_hi = 0; a.ph = PH_PRE; hipLaunchKernelGGL(mega_fwd, dim3(grid), dim3(NWAVES * 64), LDS_BYTES, stream, a);
    for (int p = 0; p <= DBG_STAGE; ++p) { a.l_lo = 0; a.l_hi = 1; a.ph = p; hipLaunchKernelGGL(mega_fwd, dim3(grid), dim3(NWAVES * 64), LDS_BYTES, stream, a); }
    a.l_lo = 0; a.l_hi = 0; a.ph = PH_DUMP; a.pad0 = DBG_SEL; hipLaunchKernelGGL(mega_fwd, dim3(grid), dim3(NWAVES * 64), LDS_BYTES, stream, a);
#elif MK_MULTI
    a.multi = 1;
    a.l_lo = 0; a.l_hi = 0; a.ph = PH_PRE; hipLaunchKernelGGL(mega_fwd, dim3(grid), dim3(NWAVES * 64), LDS_BYTES, stream, a);
    for (int l = 0; l < DEPTH; ++l) for (int p = 0; p < 10; ++p) { a.l_lo = l; a.l_hi = l + 1; a.ph = p; hipLaunchKernelGGL(mega_fwd, dim3(grid), dim3(NWAVES * 64), LDS_BYTES, stream, a); }
    a.l_lo = 0; a.l_hi = 0; a.ph = PH_POST; hipLaunchKernelGGL(mega_fwd, dim3(grid), dim3(NWAVES * 64), LDS_BYTES, stream, a);
#else
    a.multi = 0; a.l_lo = 0; a.l_hi = DEPTH; a.ph = 0;
    hipLaunchKernelGGL(mega_fwd, dim3(grid), dim3(NWAVES * 64), LDS_BYTES, stream, a);
#endif
    const hipError_t le = hipPeekAtLastError();
    if (le != hipSuccess) fprintf(stderr, "kernel_launch: launch failed: %s\n", hipGetErrorName(le));
}
```

```cpp
#include <hip/hip_runtime.h>
#include <cstdio>
#include <cstdint>
#define GAS __attribute__((address_space(1)))
#define LAS __attribute__((address_space(3)))
namespace pg8 {
#define PG8_LAS __attribute__((address_space(3)))
typedef unsigned short bf16_t;
typedef short bf16x8 __attribute__((ext_vector_type(8)));
typedef float f32x4 __attribute__((ext_vector_type(4)));
typedef unsigned u32x4 __attribute__((ext_vector_type(4)));
constexpr int BM = 256, BK = 64, HALF = 128, HTB = HALF * BK * 2  , STAGE_BYTES = 8 * HTB, NXCD = 8, WGM = 8;

__host__ __device__ __forceinline__ int lds_byte(int r, int c) { const int st = (r >> 4) * 2 + (c >> 5), rr = r & 15, cc = c & 31, ob = rr * 64 + cc * 2; return st * 1024 + (ob ^ (((ob >> 9) & 1) << 5)); }
__host__ __device__ __forceinline__ void stage_rc(int b, int& R, int& C) { const int st = b / 1024, sb = b % 1024, swz = sb ^ (((sb >> 9) & 1) << 5); R = (st >> 1) * 16 + swz / 64; C = (st & 1) * 32 + (swz % 64) / 2; }
__host__ __device__ __forceinline__ int perm32(int rho) { const int n = rho >> 4, i = rho & 15; return 8 * (i >> 2) + 4 * n + (i & 3); }

struct Unit { int pm, pn; };
struct Gemm { const bf16_t* A; const bf16_t* Bt; int M, N, K; };

struct StaticOrder {
    int nM, nN, nwg, G, c, ext_n, ext_pm0, ext_pn0, ext_w, wgm, ext_c0;
    __host__ __device__ void init(int M, int N, int G_, int c_) { nM = M / BM; nN = N / BM; nwg = nM * nN; G = G_; c = c_; ext_n = 0; ext_pm0 = 0; ext_pn0 = 0; ext_w = 1; wgm = WGM; ext_c0 = 0; }
    __host__ __device__ void set_extra(int n, int pm0, int pn0, int w) { ext_n = n; ext_pm0 = pm0; ext_pn0 = pn0; ext_w = w; }
    __host__ __device__ bool next(int i, Unit& u) const {
        const long L = (long)i * G + c;
        if (L >= nwg) { const int e = (int)(L - nwg) - ext_c0; if (e < 0 || e >= ext_n) return false; u.pm = ext_pm0 + e / ext_w; u.pn = ext_pn0 + e % ext_w; return true; }
        int wgid = (int)L; { const int q = nwg / NXCD, r = nwg % NXCD, xcd = wgid % NXCD, off = wgid / NXCD; wgid = (xcd < r ? xcd * (q + 1) : r * (q + 1) + (xcd - r) * q) + off; }
        const int nig = wgm * nN, gid = wgid / nig, fm = gid * wgm, gsz = (nM - fm) < wgm ? (nM - fm) : wgm;
        u.pm = fm + ((wgid % nig) % gsz); u.pn = (wgid % nig) / gsz; return true;
    }
    static __host__ __device__ __forceinline__ void map_entry(int nM_, int nN_, int L, Unit& u, int WGM_ = WGM) {
        const int nwg_ = nM_ * nN_; int wgid = L; { const int q = nwg_ / NXCD, r = nwg_ % NXCD, xcd = wgid % NXCD, off = wgid / NXCD; wgid = (xcd < r ? xcd * (q + 1) : r * (q + 1) + (xcd - r) * q) + off; }
        const int nig = WGM_ * nN_, gid = wgid / nig, fm = gid * WGM_, gsz = (nM_ - fm) < WGM_ ? (nM_ - fm) : WGM_;
        u.pm = fm + ((wgid % nig) % gsz); u.pn = (wgid % nig) / gsz;
    }
    __device__ __forceinline__ void a_ready(const Unit&) const {}
    __device__ __forceinline__ void done(const Unit&) const {}
};
struct MergeOrder : StaticOrder {
    const unsigned* wflag; unsigned* tmo;
    __device__ __forceinline__ void a_ready(const Unit& u) const {
        if (wflag == nullptr || ext_n == 0 || u.pm < ext_pm0) return;
        if (threadIdx.x < 64) {
            const unsigned* f = wflag + (size_t)((u.pm - ext_pm0) * ext_w + (u.pn - ext_pn0)) * 16;
            const unsigned long long t0 = __builtin_amdgcn_s_memrealtime(); unsigned polls = 0;
            while ((unsigned)__builtin_amdgcn_readfirstlane(__hip_atomic_load(f, __ATOMIC_RELAXED, __HIP_MEMORY_SCOPE_AGENT)) == 0u) {
                if ((++polls & 255u) == 0u && __builtin_amdgcn_readfirstlane(__hip_atomic_load(tmo, __ATOMIC_RELAXED, __HIP_MEMORY_SCOPE_AGENT)) != 0u) break;
                if (__builtin_amdgcn_s_memrealtime() - t0 > 2000000ull) { if (threadIdx.x == 0) __hip_atomic_store(tmo, 1u, __ATOMIC_RELAXED, __HIP_MEMORY_SCOPE_AGENT); break; }
                __builtin_amdgcn_s_sleep(2); }
            __builtin_amdgcn_fence(__ATOMIC_ACQUIRE, "agent");
            asm volatile("s_waitcnt vmcnt(0)" ::: "memory");
        }
        asm volatile("" ::: "memory"); __builtin_amdgcn_s_barrier(); asm volatile("" ::: "memory");
    }
};
typedef float f32x2_t __attribute__((ext_vector_type(2))); typedef __bf16 bf16x2_t __attribute__((ext_vector_type(2)));
__device__ __forceinline__ unsigned cvt_pk_bf16(float lo, float hi) { f32x2_t v = {lo, hi}; bf16x2_t b = __builtin_convertvector(v, bf16x2_t); return __builtin_bit_cast(unsigned, b); }
typedef float f32x2 __attribute__((ext_vector_type(2)));
template <class Epi, class Sched, bool ALIGN_EPI = false, bool SP2 = false>
__device__ __forceinline__ void gemm_phase(PG8_LAS unsigned char* lds, const Gemm g, const Sched& S, const Epi& E) {
    int tid_ = threadIdx.x; asm volatile("" : "+v"(tid_));
    const int tid = tid_, wid = __builtin_amdgcn_readfirstlane(tid >> 6), lane = tid & 63, wr = wid >> 2, wc = wid & 3, fr = lane & 15, fq = lane >> 4;
    const int K = g.K, nt = K / BK;
    unsigned voffA[2], voffB[2];
#pragma unroll
    for (int i = 0; i < 2; ++i) { int R, C; stage_rc(tid * 16 + i * 8192, R, C); const int Rb = Epi::PERM ? ((R & ~31) + perm32(R & 31)) : R;
        voffA[i] = (unsigned)(R * K + C) * 2u; voffB[i] = (unsigned)(Rb * K + C) * 2u; }
    const size_t kstep = (size_t)(BK * 2);
    const size_t hstep = (size_t)HALF * K * 2;
    const size_t tstep = 2 * hstep;
    const unsigned ldsw = (unsigned)wid * 1024u;
    const int aoff = lds_byte(wr * 64 + fr, fq * 8), boff = lds_byte(wc * 32 + fr, fq * 8);
#define PG8_SA(b, h) (((b) * 2 + (h)) * HTB)
#define PG8_SB(b, h) ((4 + (b) * 2 + (h)) * HTB)
#define PG8_STAGE(bufoff, gbase, voff) do { _Pragma("unroll") for (int _i = 0; _i < 2; ++_i) \
        __builtin_amdgcn_global_load_lds((const unsigned*)((const char*)(gbase) + (voff)[_i]), (PG8_LAS unsigned*)(lds + (bufoff) + ldsw + _i * 8192), 16, 0, 0); } while (0)
#define PG8_LDA(dst, b, h) do { _Pragma("unroll") for (int m = 0; m < 4; ++m) _Pragma("unroll") for (int k = 0; k < 2; ++k) dst[m][k] = *(const PG8_LAS bf16x8*)(lds + PG8_SA(b, h) + aoff + m * 2048 + k * 1024); } while (0)
#define PG8_LDB(dst, b, h) do { _Pragma("unroll") for (int n = 0; n < 2; ++n) _Pragma("unroll") for (int k = 0; k < 2; ++k) dst[n][k] = *(const PG8_LAS bf16x8*)(lds + PG8_SB(b, h) + boff + n * 2048 + k * 1024); } while (0)
#define PG8_MMA(ai, bj, At, Bt) do { __builtin_amdgcn_s_setprio(1); _Pragma("unroll") for (int m = 0; m < 4; ++m) _Pragma("unroll") for (int n = 0; n < 2; ++n) _Pragma("unroll") for (int k = 0; k < 2; ++k) \
        acc[ai][bj][m][n] = __builtin_amdgcn_mfma_f32_16x16x32_bf16(Bt[n][k], At[m][k], acc[ai][bj][m][n], 0, 0, 0); __builtin_amdgcn_s_setprio(0); } while (0)
#define PG8_WAIT_V(n) asm volatile("s_waitcnt vmcnt(" #n ")" ::: "memory")
#define PG8_WAIT_L(n) asm volatile("s_waitcnt lgkmcnt(" #n ")" ::: "memory")
#define PG8_BAR __builtin_amdgcn_s_barrier()
#define PG8_SCHED __builtin_amdgcn_sched_barrier(0)
    Unit cur, nxt; int ui = 0;
    if (!S.next(0, cur)) return;
    f32x4 acc[2][2][4][2];
#pragma unroll
    for (int a = 0; a < 2; ++a)
#pragma unroll
        for (int b = 0; b < 2; ++b)
#pragma unroll
            for (int m = 0; m < 4; ++m)
#pragma unroll
                for (int n = 0; n < 2; ++n) acc[a][b][m][n] = (f32x4){0.f, 0.f, 0.f, 0.f};
    bf16x8 At[4][2], B0[2][2], B1[2][2];
    const char* cA = (const char*)g.A + (size_t)cur.pm * tstep; const char* cB = (const char*)g.Bt + (size_t)cur.pn * tstep;
    S.a_ready(cur);
    if constexpr (SP2) {
        PG8_STAGE(PG8_SB(0, 0), cB, voffB); PG8_STAGE(PG8_SB(0, 1), cB + hstep, voffB); PG8_STAGE(PG8_SA(0, 0), cA, voffA); PG8_STAGE(PG8_SA(0, 1), cA + hstep, voffA);
        if (wr == 1) PG8_BAR;
        PG8_WAIT_V(2); PG8_BAR;
        PG8_STAGE(PG8_SB(1, 0), cB + kstep, voffB); PG8_STAGE(PG8_SA(1, 0), cA + kstep, voffA); PG8_STAGE(PG8_SB(1, 1), cB + hstep + kstep, voffB);
        PG8_WAIT_V(6); PG8_BAR;
    } else {
        PG8_STAGE(PG8_SB(0, 0), cB, voffB); PG8_STAGE(PG8_SA(0, 0), cA, voffA); PG8_STAGE(PG8_SB(0, 1), cB + hstep, voffB); PG8_STAGE(PG8_SA(0, 1), cA + hstep, voffA);
        if (wr == 1) PG8_BAR;
        PG8_WAIT_V(4); PG8_BAR;
        PG8_STAGE(PG8_SB(1, 0), cB + kstep, voffB); PG8_STAGE(PG8_SA(1, 0), cA + kstep, voffA); PG8_STAGE(PG8_SB(1, 1), cB + hstep + kstep, voffB);
        PG8_WAIT_V(6); PG8_BAR;
    }
    for (;;) {
        const bool has_next = S.next(ui + 1, nxt);
        const char* nA = has_next ? (const char*)g.A + (size_t)nxt.pm * tstep : cA; const char* nB = has_next ? (const char*)g.Bt + (size_t)nxt.pn * tstep : cB;
#pragma nounroll
        for (int t = 0; t < nt; t += 2) {
            const bool last = (t == nt - 2);
            const char* a1 = cA + (size_t)(t + 1) * kstep;
            const char* a2 = last ? nA : cA + (size_t)(t + 2) * kstep; const char* b2 = last ? nB : cB + (size_t)(t + 2) * kstep;
            const char* a3 = a2 + kstep; const char* b3 = b2 + kstep;
            if (last && has_next) S.a_ready(nxt);
            if constexpr (SP2) {
            PG8_LDB(B0, 0, 0); PG8_LDB(B1, 0, 1); PG8_SCHED; PG8_LDA(At, 0, 0); PG8_STAGE(PG8_SA(1, 1), a1 + hstep, voffA);
            PG8_WAIT_V(8); PG8_WAIT_L(0); PG8_BAR; PG8_MMA(0, 0, At, B0); PG8_MMA(0, 1, At, B1); PG8_BAR; PG8_SCHED;
            PG8_LDA(At, 0, 1); PG8_STAGE(PG8_SB(0, 0), b2, voffB); PG8_STAGE(PG8_SB(0, 1), b2 + hstep, voffB); PG8_STAGE(PG8_SA(0, 0), a2, voffA);
            PG8_WAIT_V(8); PG8_WAIT_L(0); PG8_BAR; PG8_MMA(1, 0, At, B0); PG8_MMA(1, 1, At, B1); PG8_BAR; PG8_SCHED;
            PG8_LDB(B0, 1, 0); PG8_LDB(B1, 1, 1); PG8_SCHED; PG8_LDA(At, 1, 0); PG8_STAGE(PG8_SA(0, 1), a2 + hstep, voffA);
            PG8_WAIT_V(8); PG8_WAIT_L(0); PG8_BAR; PG8_MMA(0, 0, At, B0); PG8_MMA(0, 1, At, B1); PG8_BAR; PG8_SCHED;
            PG8_LDA(At, 1, 1); PG8_STAGE(PG8_SB(1, 0), b3, voffB); PG8_STAGE(PG8_SB(1, 1), b3 + hstep, voffB); PG8_STAGE(PG8_SA(1, 0), a3, voffA);
            PG8_WAIT_V(8); PG8_WAIT_L(0); PG8_BAR; PG8_MMA(1, 0, At, B0); PG8_MMA(1, 1, At, B1); PG8_BAR; PG8_SCHED;
            } else {
            PG8_LDB(B0, 0, 0); PG8_SCHED; PG8_LDA(At, 0, 0); PG8_STAGE(PG8_SA(1, 1), a1 + hstep, voffA);
            PG8_WAIT_L(8); PG8_BAR; PG8_WAIT_L(0); PG8_MMA(0, 0, At, B0); PG8_BAR; PG8_SCHED;
            PG8_LDB(B1, 0, 1); PG8_STAGE(PG8_SB(0, 0), b2, voffB);
            PG8_BAR; PG8_WAIT_L(0); PG8_MMA(0, 1, At, B1); PG8_BAR;
            PG8_LDA(At, 0, 1); PG8_STAGE(PG8_SA(0, 0), a2, voffA);
            PG8_BAR; PG8_WAIT_L(0); PG8_MMA(1, 0, At, B0); PG8_BAR; PG8_SCHED;
            PG8_STAGE(PG8_SB(0, 1), b2 + hstep, voffB);
            PG8_WAIT_V(6); PG8_BAR; PG8_MMA(1, 1, At, B1); PG8_BAR;
            PG8_LDB(B0, 1, 0); PG8_SCHED; PG8_LDA(At, 1, 0); PG8_STAGE(PG8_SA(0, 1), a2 + hstep, voffA);
            PG8_WAIT_L(8); PG8_BAR; PG8_WAIT_L(0); PG8_MMA(0, 0, At, B0); PG8_BAR; PG8_SCHED;
            PG8_LDB(B1, 1, 1); PG8_STAGE(PG8_SB(1, 0), b3, voffB);
            PG8_BAR; PG8_WAIT_L(0); PG8_MMA(0, 1, At, B1); PG8_BAR;
            PG8_LDA(At, 1, 1); PG8_STAGE(PG8_SA(1, 0), a3, voffA);
            PG8_BAR; PG8_WAIT_L(0); PG8_MMA(1, 0, At, B0); PG8_BAR; PG8_SCHED;
            PG8_STAGE(PG8_SB(1, 1), b3 + hstep, voffB);
            PG8_WAIT_V(6); PG8_BAR; PG8_MMA(1, 1, At, B1); PG8_BAR;
            }
        }
        if constexpr (ALIGN_EPI) { if (wr == 0) PG8_BAR; }
        if constexpr (!Epi::AFTER_DRAIN) { E(acc, cur, wr, wc, fr, fq); S.done(cur); }
        if (!has_next) break;
#pragma unroll
        for (int a = 0; a < 2; ++a)
#pragma unroll
            for (int b = 0; b < 2; ++b)
#pragma unroll
                for (int m = 0; m < 4; ++m)
#pragma unroll
                    for (int n = 0; n < 2; ++n) acc[a][b][m][n] = (f32x4){0.f, 0.f, 0.f, 0.f};
        cur = nxt; cA = nA; cB = nB; ++ui;
        if constexpr (ALIGN_EPI) { if (wr == 1) PG8_BAR; }
    }
    PG8_WAIT_V(0);
    if constexpr (!ALIGN_EPI) { if (wr == 0) PG8_BAR; }
    PG8_BAR;
    if constexpr (Epi::AFTER_DRAIN) { E.fused(acc, cur, wr, wc, fr, fq, lds, wid, lane); S.done(cur); }
#undef PG8_SA
#undef PG8_SB
#undef PG8_STAGE
#undef PG8_LDA
#undef PG8_LDB
#undef PG8_MMA
#undef PG8_WAIT_V
#undef PG8_WAIT_L
#undef PG8_BAR
#undef PG8_SCHED
}
}
namespace pg8 {
typedef unsigned u32x2 __attribute__((ext_vector_type(2)));
constexpr int ML_ROWS = 32768;
__device__ __forceinline__ float sigm(float x) { return __builtin_amdgcn_rcpf(1.0f + __builtin_amdgcn_exp2f(-1.4426950408889634f * x)); }
__device__ __forceinline__ u32x2 pack4(const f32x4 v) { u32x2 w; w.x = cvt_pk_bf16(v[0], v[1]); w.y = cvt_pk_bf16(v[2], v[3]); return w; }
__device__ __forceinline__ void rope4(f32x4& x0, f32x4& x1, const float* rope, int row, int half, int fq) {
    const int t = row & 4095, p = half ? (t & 63) : (t >> 6);
    const f32x4* tp = (const f32x4*)(rope + (p * 16 + 4 * fq) * 2);
    const f32x4 a = tp[0], b = tp[1];
    const f32x4 c = {a[0], a[2], b[0], b[2]}, s = {a[1], a[3], b[1], b[3]};
    const f32x4 y0 = x0 * c - x1 * s, y1 = x1 * c + x0 * s;
    x0 = y0; x1 = y1;
}
struct EpiWin {
    static constexpr bool PERM = true, AFTER_DRAIN = false;
    unsigned char* G; bf16_t* CQ; bf16_t* KF; bf16_t* GK; bf16_t* GV; bf16_t* GQ; bf16_t* U; const float* rope;
    __device__ __forceinline__ void operator()(const f32x4 (&acc)[2][2][4][2], const Unit& u, int wr, int wc, int fr, int fq) const {
        const int row0 = u.pm * BM + wr * 64 + fr; const bool lat = u.pm < (ML_ROWS / BM);
#pragma unroll
        for (int bj = 0; bj < 2; ++bj) {
            const int colg = u.pn * BM + bj * HALF + wc * 32;
            if (colg < 6144) {
#pragma unroll
                for (int ai = 0; ai < 2; ++ai)
#pragma unroll
                    for (int m = 0; m < 4; ++m) { const size_t row = (size_t)(row0 + ai * HALF + m * 16);
                        u32x2 gq;
#pragma unroll
                        for (int n = 0; n < 2; ++n) { const f32x4 v = acc[ai][bj][m][n];
#define SG8(x) ((unsigned)(__builtin_amdgcn_rcpf(1.0f + __builtin_amdgcn_exp2f(x)) * 255.0f + 0.5f))
                            const unsigned q0 = SG8(v[0]), q1 = SG8(v[1]), q2 = SG8(v[2]), q3 = SG8(v[3]);
#undef SG8
                            const unsigned w4 = q0 | (q1 << 8) | (q2 << 16) | (q3 << 24); if (n == 0) gq.x = w4; else gq.y = w4; }
                        *(u32x2*)(G + row * 6144 + colg + 8 * fq) = gq; }
            } else {
                const int o = colg - 6144;
                if (o < 256 || (o >= 576 && o < 1088)) {
                    const int co = (o < 256) ? o : (256 + o - 576);
#pragma unroll
                    for (int ai = 0; ai < 2; ++ai)
#pragma unroll
                        for (int m = 0; m < 4; ++m) { const size_t row = (size_t)(row0 + ai * HALF + m * 16);
#pragma unroll
                            for (int n = 0; n < 1; ++n) { const u32x2 w0 = pack4(acc[ai][bj][m][0]), w1 = pack4(acc[ai][bj][m][1]); u32x4 w; w.x = w0.x; w.y = w0.y; w.z = w1.x; w.w = w1.y; *(u32x4*)(CQ + row * 768 + co + 8 * fq) = w; } }
                } else if (o < 320) {
                    const int half = (o - 256) >> 5;
#pragma unroll
                    for (int ai = 0; ai < 2; ++ai)
#pragma unroll
                        for (int m = 0; m < 4; ++m) { const int r = row0 + ai * HALF + m * 16; f32x4 x0 = acc[ai][bj][m][0], x1 = acc[ai][bj][m][1];
                            if (lat) rope4(x0, x1, rope, r, half, fq);
                            const u32x2 w0 = pack4(x0), w1 = pack4(x1); bf16_t* p = KF + (size_t)r * 1536 + 128 + (o - 256) + 4 * fq;
#pragma unroll
                            for (int h = 0; h < 8; ++h) { *(u32x2*)(p + h * 192) = w0; *(u32x2*)(p + h * 192 + 16) = w1; } }
                } else if (o < 448 || (o >= 1088 && o < 1600)) {
                    const bool isk = o < 448; const int co = isk ? (o - 320) : (o - 1088); const int half = (co >> 5) & 1;
                    bf16_t* base = isk ? GK : GQ; const int ld = isk ? 128 : 512;
#pragma unroll
                    for (int ai = 0; ai < 2; ++ai)
#pragma unroll
                        for (int m = 0; m < 4; ++m) { const int r = row0 + ai * HALF + m * 16; f32x4 x0 = acc[ai][bj][m][0], x1 = acc[ai][bj][m][1];
                            if (lat) rope4(x0, x1, rope, r, half, fq);
                            bf16_t* p = base + (size_t)r * ld + co + 4 * fq; *(u32x2*)p = pack4(x0); *(u32x2*)(p + 16) = pack4(x1); }
                } else if (o < 576) {
#pragma unroll
                    for (int ai = 0; ai < 2; ++ai)
#pragma unroll
                        for (int m = 0; m < 4; ++m) { const size_t row = (size_t)(row0 + ai * HALF + m * 16); bf16_t* p = GV + row * 128 + (o - 448) + 8 * fq;
                            const u32x2 w0 = pack4(acc[ai][bj][m][0]), w1 = pack4(acc[ai][bj][m][1]); u32x4 w; w.x = w0.x; w.y = w0.y; w.z = w1.x; w.w = w1.y; *(u32x4*)p = w; }
                } else if (o < 2624) {
                    const int g = (o - 1600) >> 5;
#pragma unroll
                    for (int ai = 0; ai < 2; ++ai)
#pragma unroll
                        for (int m = 0; m < 4; ++m) { const size_t row = (size_t)(row0 + ai * HALF + m * 16); const f32x4 a = acc[ai][bj][m][0], b = acc[ai][bj][m][1];
                            const f32x4 uu = {a[0] * sigm(b[0]), a[1] * sigm(b[1]), a[2] * sigm(b[2]), a[3] * sigm(b[3])};
                            *(u32x2*)(U + row * 512 + 16 * g + 4 * fq) = pack4(uu); }
                }
            }
        }
    }
};
struct EpiQup {
    static constexpr bool PERM = true, AFTER_DRAIN = false;
    bf16_t* MQ; const float* rope;
    __device__ __forceinline__ void operator()(const f32x4 (&acc)[2][2][4][2], const Unit& u, int wr, int wc, int fr, int fq) const {
        const int row0 = u.pm * BM + wr * 64 + fr; const bool lat = u.pm < (ML_ROWS / BM);
#pragma unroll
        for (int bj = 0; bj < 2; ++bj) {
            const int colg = u.pn * BM + bj * HALF + wc * 32, hd = colg % 192; const bool isr = hd >= 128; const int half = (hd - 128) >> 5;
#pragma unroll
            for (int ai = 0; ai < 2; ++ai)
#pragma unroll
                for (int m = 0; m < 4; ++m) { const int r = row0 + ai * HALF + m * 16; f32x4 x0 = acc[ai][bj][m][0], x1 = acc[ai][bj][m][1];
                    if (isr) { if (lat) rope4(x0, x1, rope, r, half, fq);
                        bf16_t* p = MQ + (size_t)r * 1536 + colg + 4 * fq; *(u32x2*)p = pack4(x0); *(u32x2*)(p + 16) = pack4(x1); }
                    else { const u32x2 w0 = pack4(x0), w1 = pack4(x1); u32x4 w; w.x = w0.x; w.y = w0.y; w.z = w1.x; w.w = w1.y; *(u32x4*)(MQ + (size_t)r * 1536 + colg + 8 * fq) = w; } }
        }
    }
};
struct EpiKV {
    static constexpr bool PERM = true, AFTER_DRAIN = false;
    bf16_t* KF; bf16_t* V;
    __device__ __forceinline__ void operator()(const f32x4 (&acc)[2][2][4][2], const Unit& u, int wr, int wc, int fr, int fq) const {
        const int row0 = u.pm * BM + wr * 64 + fr, c0 = wc * 32 + 8 * fq;
#pragma unroll
        for (int ai = 0; ai < 2; ++ai)
#pragma unroll
            for (int m = 0; m < 4; ++m) { const size_t row = (size_t)(row0 + ai * HALF + m * 16);
#pragma unroll
                for (int bj = 0; bj < 2; ++bj) { const f32x4 v0 = acc[ai][bj][m][0], v1 = acc[ai][bj][m][1];
                    u32x4 w; w.x = cvt_pk_bf16(v0[0], v0[1]); w.y = cvt_pk_bf16(v0[2], v0[3]); w.z = cvt_pk_bf16(v1[0], v1[1]); w.w = cvt_pk_bf16(v1[2], v1[3]);
                    if (bj == 0) *(u32x4*)(KF + row * 1536 + u.pn * 192 + c0) = w; else *(u32x4*)(V + row * 1024 + u.pn * 128 + c0) = w; } }
    }
};
template <int STEP> struct EpiMerge {
    static constexpr bool PERM = true, AFTER_DRAIN = false;
    const unsigned char* G; bf16_t* YF; bf16_t* Y; int wt_pm;
    __device__ __forceinline__ void operator()(const f32x4 (&acc)[2][2][4][2], const Unit& u, int wr, int wc, int fr, int fq) const {
        constexpr int NBATCH = 4;
        const int row0 = u.pm * BM + wr * 64 + fr, col0 = u.pn * BM + wc * 32 + 8 * fq;
        bf16_t* dst = (STEP < 2) ? YF : Y;
        const bool wt = (STEP < 2) && (u.pm >= wt_pm);
#pragma unroll
        for (int ai = 0; ai < 2; ++ai)
#pragma unroll
            for (int mb = 0; mb < 4; mb += NBATCH) {
                u32x2 gw[NBATCH][2]; u32x4 yv[NBATCH][2];
#pragma unroll
                for (int q = 0; q < NBATCH; ++q) { const size_t row = (size_t)(row0 + ai * HALF + (mb + q) * 16);
#pragma unroll
                    for (int bj = 0; bj < 2; ++bj) { const int c = col0 + bj * HALF;
                        gw[q][bj] = *(const u32x2*)(G + row * 6144 + STEP * 2048 + c);
                        if (STEP > 0) yv[q][bj] = *(const u32x4*)(YF + row * 2048 + c); } }
#pragma unroll
                for (int q = 0; q < NBATCH; ++q) { const size_t row = (size_t)(row0 + ai * HALF + (mb + q) * 16); const int m = mb + q;
#pragma unroll
                    for (int bj = 0; bj < 2; ++bj) { const int c = col0 + bj * HALF; const u32x2 g2 = gw[q][bj]; constexpr float I255 = 1.0f / 255.0f;
                        const f32x4 g0 = {(float)(g2.x & 255u) * I255, (float)((g2.x >> 8) & 255u) * I255, (float)((g2.x >> 16) & 255u) * I255, (float)(g2.x >> 24) * I255};
                        const f32x4 g1 = {(float)(g2.y & 255u) * I255, (float)((g2.y >> 8) & 255u) * I255, (float)((g2.y >> 16) & 255u) * I255, (float)(g2.y >> 24) * I255};
                        f32x4 a0 = acc[ai][bj][m][0] * g0, a1 = acc[ai][bj][m][1] * g1;
                        if (STEP > 0) { const u32x4 y4 = yv[q][bj];
                            a0 += (f32x4){__uint_as_float(y4.x << 16), __uint_as_float(y4.x & 0xffff0000u), __uint_as_float(y4.y << 16), __uint_as_float(y4.y & 0xffff0000u)};
                            a1 += (f32x4){__uint_as_float(y4.z << 16), __uint_as_float(y4.z & 0xffff0000u), __uint_as_float(y4.w << 16), __uint_as_float(y4.w & 0xffff0000u)}; }
                        u32x4 w; w.x = cvt_pk_bf16(a0[0], a0[1]); w.y = cvt_pk_bf16(a0[2], a0[3]); w.z = cvt_pk_bf16(a1[0], a1[1]); w.w = cvt_pk_bf16(a1[2], a1[3]);
                        if (wt) asm volatile("global_store_dwordx4 %0, %1, off sc1" :: "v"(dst + row * 2048 + c), "v"(w) : "memory");
                        else *(u32x4*)(dst + row * 2048 + c) = w; } }
                asm volatile("" ::: "memory"); }
    }
};
struct EpiResid {
    static constexpr bool PERM = true, AFTER_DRAIN = false;
    bf16_t* XB; const float* modl; int goff;
    __device__ __forceinline__ void operator()(const f32x4 (&acc)[2][2][4][2], const Unit& u, int wr, int wc, int fr, int fq) const {
        const int sel = u.pm >> 4;
        const int col0 = u.pn * BM + wc * 32 + 8 * fq; const float* gt = modl + sel * 12288 + goff + col0;
        bf16_t* base = XB + (size_t)(u.pm * BM + wr * 64 + fr) * 2048;
        f32x4 gv[2][2];
#pragma unroll
        for (int bj = 0; bj < 2; ++bj)
#pragma unroll
            for (int n = 0; n < 2; ++n) gv[bj][n] = *(const f32x4*)(gt + bj * HALF + n * 4);
#pragma unroll
        for (int ai = 0; ai < 2; ++ai) {
            u32x4 xr[4][2];
#pragma unroll
            for (int m = 0; m < 4; ++m) { const bf16_t* rowp = base + (size_t)(ai * HALF + m * 16) * 2048 + col0;
#pragma unroll
                for (int bj = 0; bj < 2; ++bj) xr[m][bj] = *(const u32x4*)(rowp + bj * HALF); }
#pragma unroll
            for (int m = 0; m < 4; ++m) { bf16_t* rowp = base + (size_t)(ai * HALF + m * 16) * 2048 + col0;
#pragma unroll
                for (int bj = 0; bj < 2; ++bj) { const u32x4 t = xr[m][bj];
                    const f32x4 x0 = {__uint_as_float(t.x << 16), __uint_as_float(t.x & 0xffff0000u), __uint_as_float(t.y << 16), __uint_as_float(t.y & 0xffff0000u)};
                    const f32x4 x1 = {__uint_as_float(t.z << 16), __uint_as_float(t.z & 0xffff0000u), __uint_as_float(t.w << 16), __uint_as_float(t.w & 0xffff0000u)};
                    const u32x2 w0 = pack4(x0 + gv[bj][0] * acc[ai][bj][m][0]), w1 = pack4(x1 + gv[bj][1] * acc[ai][bj][m][1]);
                    u32x4 w; w.x = w0.x; w.y = w0.y; w.z = w1.x; w.w = w1.y; *(u32x4*)(rowp + bj * HALF) = w; } }
            asm volatile("" ::: "memory"); }
    }
};
struct EpiSwiGLU {
    static constexpr bool PERM = true, AFTER_DRAIN = false;
    bf16_t* HID;
    __device__ __forceinline__ void operator()(const f32x4 (&acc)[2][2][4][2], const Unit& u, int wr, int wc, int fr, int fq) const {
        const int row0 = u.pm * BM + wr * 64 + fr, h0 = u.pn * 128 + wc * 32 + 8 * fq;
#pragma unroll
        for (int ai = 0; ai < 2; ++ai)
#pragma unroll
            for (int m = 0; m < 4; ++m) { bf16_t* rowp = HID + (size_t)(row0 + ai * HALF + m * 16) * 5632 + h0;
                u32x2 w2[2];
#pragma unroll
                for (int n = 0; n < 2; ++n) { const f32x4 a = acc[ai][0][m][n], b = acc[ai][1][m][n];
                    const f32x4 h = {a[0] * sigm(a[0]) * b[0], a[1] * sigm(a[1]) * b[1], a[2] * sigm(a[2]) * b[2], a[3] * sigm(a[3]) * b[3]};
                    w2[n] = pack4(h); }
                u32x4 w; w.x = w2[0].x; w.y = w2[0].y; w.z = w2[1].x; w.w = w2[1].y; *(u32x4*)rowp = w; }
    }
};
}
namespace pg8 {
struct UnitX { int pm, pn, kind; };
template <class Epi, class Sched, bool CHAIN = false>
__device__ __forceinline__ void gemm_stream(PG8_LAS unsigned char* lds, const Sched& S, const Epi& E) {
    int tid_ = threadIdx.x; asm volatile("" : "+v"(tid_));
    const int tid = tid_, wid = __builtin_amdgcn_readfirstlane(tid >> 6), lane = tid & 63, wr = wid >> 2, wc = wid & 3, fr = lane & 15, fq = lane >> 4;
    int Rn, Rp, C2; { int R, C; stage_rc(tid * 16, R, C); Rn = R; Rp = (R & ~31) + perm32(R & 31); C2 = C * 2; }
    const size_t kstep = (size_t)(BK * 2);
    const unsigned ldsw = (unsigned)wid * 1024u;
    const int aoff = lds_byte(wr * 64 + fr, fq * 8), boff = lds_byte(wc * 32 + fr, fq * 8);
#define PG8_SA(b, h) (((b) * 2 + (h)) * HTB)
#define PG8_SB(b, h) ((4 + (b) * 2 + (h)) * HTB)
#define PG8_STAGE(bufoff, gbase, voff, r64) do { \
        __builtin_amdgcn_global_load_lds((const unsigned*)((const char*)(gbase) + (voff)), (PG8_LAS unsigned*)(lds + (bufoff) + ldsw), 16, 0, 0); \
        __builtin_amdgcn_global_load_lds((const unsigned*)((const char*)(gbase) + (r64) + (voff)), (PG8_LAS unsigned*)(lds + (bufoff) + ldsw + 8192), 16, 0, 0); } while (0)
#define PG8_LDA(dst, b, h) do { _Pragma("unroll") for (int m = 0; m < 4; ++m) _Pragma("unroll") for (int k = 0; k < 2; ++k) dst[m][k] = *(const PG8_LAS bf16x8*)(lds + PG8_SA(b, h) + aoff + m * 2048 + k * 1024); } while (0)
#define PG8_LDB(dst, b, h) do { _Pragma("unroll") for (int n = 0; n < 2; ++n) _Pragma("unroll") for (int k = 0; k < 2; ++k) dst[n][k] = *(const PG8_LAS bf16x8*)(lds + PG8_SB(b, h) + boff + n * 2048 + k * 1024); } while (0)
#define PG8_MMA(ai, bj, At, Bt) do { __builtin_amdgcn_s_setprio(1); _Pragma("unroll") for (int m = 0; m < 4; ++m) _Pragma("unroll") for (int n = 0; n < 2; ++n) _Pragma("unroll") for (int k = 0; k < 2; ++k) \
        acc[ai][bj][m][n] = __builtin_amdgcn_mfma_f32_16x16x32_bf16(Bt[n][k], At[m][k], acc[ai][bj][m][n], 0, 0, 0); __builtin_amdgcn_s_setprio(0); } while (0)
#define PG8_WAIT_V(n) asm volatile("s_waitcnt vmcnt(" #n ")" ::: "memory")
#define PG8_WAIT_L(n) asm volatile("s_waitcnt lgkmcnt(" #n ")" ::: "memory")
#define PG8_BAR __builtin_amdgcn_s_barrier()
#define PG8_SCHED __builtin_amdgcn_sched_barrier(0)
    UnitX cur, nxt; int ui = 0;
    if (!S.next(0, cur)) return;
    f32x4 acc[2][2][4][2];
#pragma unroll
    for (int a = 0; a < 2; ++a)
#pragma unroll
        for (int b = 0; b < 2; ++b)
#pragma unroll
            for (int m = 0; m < 4; ++m)
#pragma unroll
                for (int n = 0; n < 2; ++n) acc[a][b][m][n] = (f32x4){0.f, 0.f, 0.f, 0.f};
    bf16x8 At[4][2], B0[2][2], B1[2][2];
    int K2 = S.gPitch(cur.kind) * 2;
    unsigned voA = (unsigned)(Rn * K2 + C2), voB = (unsigned)((S.gPerm(cur.kind) ? Rp : Rn) * K2 + C2);
    size_t r64 = (size_t)64 * K2, hstep = (size_t)HALF * K2;
    int nt = S.gNt(cur.kind);
    const char* cA = (const char*)S.gA(cur.kind) + (size_t)cur.pm * 2 * hstep + (size_t)S.gK0(cur.kind) * 2; const char* cB = (const char*)S.gB(cur.kind) + (size_t)cur.pn * 2 * hstep + (size_t)S.gK0(cur.kind) * 2;
    PG8_STAGE(PG8_SB(0, 0), cB, voB, r64); PG8_STAGE(PG8_SB(0, 1), cB + hstep, voB, r64); PG8_STAGE(PG8_SA(0, 0), cA, voA, r64); PG8_STAGE(PG8_SA(0, 1), cA + hstep, voA, r64);
    if (wr == 1) PG8_BAR;
    PG8_WAIT_V(2); PG8_BAR;
    PG8_STAGE(PG8_SB(1, 0), cB + kstep, voB, r64); PG8_STAGE(PG8_SA(1, 0), cA + kstep, voA, r64); PG8_STAGE(PG8_SB(1, 1), cB + hstep + kstep, voB, r64);
    PG8_WAIT_V(6); PG8_BAR;
    for (;;) {
        const bool has_next = S.next(ui + 1, nxt);
        const int nkind = has_next ? nxt.kind : cur.kind;
        const int nK2 = S.gPitch(nkind) * 2;
        const unsigned nvoA = (unsigned)(Rn * nK2 + C2), nvoB = (unsigned)((S.gPerm(nkind) ? Rp : Rn) * nK2 + C2);
        const size_t nr64 = (size_t)64 * nK2, nhstep = (size_t)HALF * nK2;
        const char* nA = has_next ? (const char*)S.gA(nkind) + (size_t)nxt.pm * 2 * nhstep + (size_t)S.gK0(nkind) * 2 : cA; const char* nB = has_next ? (const char*)S.gB(nkind) + (size_t)nxt.pn * 2 * nhstep + (size_t)S.gK0(nkind) * 2 : cB;
#pragma nounroll
        for (int t = 0; t < nt; t += 2) {
            const bool last = (t == nt - 2);
            const char* a1 = cA + (size_t)(t + 1) * kstep;
            const char* a2 = last ? nA : cA + (size_t)(t + 2) * kstep; const char* b2 = last ? nB : cB + (size_t)(t + 2) * kstep;
            const char* a3 = a2 + kstep; const char* b3 = b2 + kstep;
            const unsigned vA2 = last ? nvoA : voA, vB2 = last ? nvoB : voB; const size_t r2 = last ? nr64 : r64, h2 = last ? nhstep : hstep;
            PG8_LDB(B0, 0, 0); PG8_LDB(B1, 0, 1); PG8_SCHED; PG8_LDA(At, 0, 0); PG8_STAGE(PG8_SA(1, 1), a1 + hstep, voA, r64);
            PG8_WAIT_V(8); PG8_WAIT_L(0); PG8_BAR; PG8_MMA(0, 0, At, B0); PG8_MMA(0, 1, At, B1); PG8_BAR; PG8_SCHED;
            PG8_LDA(At, 0, 1); PG8_STAGE(PG8_SB(0, 0), b2, vB2, r2); PG8_STAGE(PG8_SB(0, 1), b2 + h2, vB2, r2); PG8_STAGE(PG8_SA(0, 0), a2, vA2, r2);
            PG8_WAIT_V(8); PG8_WAIT_L(0); PG8_BAR; PG8_MMA(1, 0, At, B0); PG8_MMA(1, 1, At, B1); PG8_BAR; PG8_SCHED;
            PG8_LDB(B0, 1, 0); PG8_LDB(B1, 1, 1); PG8_SCHED; PG8_LDA(At, 1, 0); PG8_STAGE(PG8_SA(0, 1), a2 + h2, vA2, r2);
            PG8_WAIT_V(8); PG8_WAIT_L(0); PG8_BAR; PG8_MMA(0, 0, At, B0); PG8_MMA(0, 1, At, B1); PG8_BAR; PG8_SCHED;
            PG8_LDA(At, 1, 1); PG8_STAGE(PG8_SB(1, 0), b3, vB2, r2); PG8_STAGE(PG8_SB(1, 1), b3 + h2, vB2, r2); PG8_STAGE(PG8_SA(1, 0), a3, vA2, r2);
            PG8_WAIT_V(8); PG8_WAIT_L(0); PG8_BAR; PG8_MMA(1, 0, At, B0); PG8_MMA(1, 1, At, B1); PG8_BAR; PG8_SCHED;
        }
        if (wr == 0) PG8_BAR;
        if constexpr (CHAIN) E.chain(acc, cur.pm, cur.pn, cur.kind, wr, wc, fr, fq); else E(acc, cur.pm, cur.pn, cur.kind, wr, wc, fr, fq);
        if (!has_next) break;
        bool clr_ = true; if constexpr (CHAIN) clr_ = (cur.kind == Epi::LAST_KIND);
        if (clr_)
#pragma unroll
        for (int a = 0; a < 2; ++a)
#pragma unroll
            for (int b = 0; b < 2; ++b)
#pragma unroll
                for (int m = 0; m < 4; ++m)
#pragma unroll
                    for (int n = 0; n < 2; ++n) acc[a][b][m][n] = (f32x4){0.f, 0.f, 0.f, 0.f};
        cur.pm = nxt.pm; cur.pn = nxt.pn; cur.kind = nxt.kind; cA = nA; cB = nB; K2 = nK2; voA = nvoA; voB = nvoB; r64 = nr64; hstep = nhstep; nt = S.gNt(nkind); ++ui;
        if (wr == 1) PG8_BAR;
    }
    PG8_WAIT_V(0);
    PG8_BAR;
#undef PG8_SA
#undef PG8_SB
#undef PG8_STAGE
#undef PG8_LDA
#undef PG8_LDB
#undef PG8_MMA
#undef PG8_WAIT_V
#undef PG8_WAIT_L
#undef PG8_BAR
#undef PG8_SCHED
}
struct SchedMerge {
    StaticOrder base; const char* a0; long da1, da2; const char* b0; long db1, db2;
    __device__ __forceinline__ bool next(int i, UnitX& u) const { Unit b; const int q = i / 3; const bool ok = base.next(q, b); u.pm = b.pm; u.pn = b.pn; u.kind = i - 3 * q; return ok; }
    __device__ __forceinline__ const bf16_t* gA(int k) const { return (const bf16_t*)(a0 + (k > 0 ? da1 : 0l) + (k > 1 ? da2 : 0l)); }
    __device__ __forceinline__ const bf16_t* gB(int k) const { return (const bf16_t*)(b0 + (k > 0 ? db1 : 0l) + (k > 1 ? db2 : 0l)); }
    __device__ __forceinline__ int gPitch(int k) const { return k == 1 ? 1024 : 512; }
    __device__ __forceinline__ int gNt(int k) const { return k == 1 ? 16 : 8; }
    __device__ __forceinline__ int gK0(int) const { return 0; }
    __device__ __forceinline__ int gPerm(int) const { return 1; }
};
struct EpiMergeAll {
    EpiMerge<0> e0; EpiMerge<1> e1; EpiMerge<2> e2;
    __device__ __forceinline__ void operator()(const f32x4 (&acc)[2][2][4][2], int pm, int pn, int kind, int wr, int wc, int fr, int fq) const {
        Unit u; u.pm = pm; u.pn = pn;
        if (kind == 0) e0(acc, u, wr, wc, fr, fq); else if (kind == 1) e1(acc, u, wr, wc, fr, fq); else e2(acc, u, wr, wc, fr, fq);
    }
};
struct EpiChain {
    static constexpr int LAST_KIND = 2;
    const unsigned char* G; bf16_t* Y;
    __device__ __forceinline__ void chain(f32x4 (&acc)[2][2][4][2], int pm, int pn, int kind, int wr, int wc, int fr, int fq) const {
        const int row0 = pm * BM + wr * 64 + fr, col0 = pn * BM + wc * 32 + 8 * fq;
        const unsigned char* ga = G + (kind == 2 ? 2 : kind) * 2048; const unsigned char* gb = G + (kind == 0 ? 1 : 2) * 2048;
#pragma unroll
        for (int ai = 0; ai < 2; ++ai) {
            u32x2 qa[4][2], qb[4][2];
#pragma unroll
            for (int m = 0; m < 4; ++m) { const size_t row = (size_t)(row0 + ai * HALF + m * 16);
#pragma unroll
                for (int bj = 0; bj < 2; ++bj) { const int c = col0 + bj * HALF; qa[m][bj] = *(const u32x2*)(ga + row * 6144 + c); qb[m][bj] = *(const u32x2*)(gb + row * 6144 + c); } }
#pragma unroll
            for (int m = 0; m < 4; ++m) { const size_t row = (size_t)(row0 + ai * HALF + m * 16);
#pragma unroll
                for (int bj = 0; bj < 2; ++bj) { const int c = col0 + bj * HALF;
                    f32x4 r[2];
#pragma unroll
                    for (int n = 0; n < 2; ++n) { const unsigned wa = n == 0 ? qa[m][bj].x : qa[m][bj].y, wb = n == 0 ? qb[m][bj].x : qb[m][bj].y;
#pragma unroll
                        for (int e = 0; e < 4; ++e) { const unsigned a8 = (wa >> (8 * e)) & 255u, b8 = (wb >> (8 * e)) & 255u;
                            const float fa = (float)(kind == 0 ? a8 : (a8 > 1u ? a8 : 1u)), fb = (float)(b8 > 1u ? b8 : 1u);
                            r[n][e] = (kind == 2) ? fa * (1.0f / 255.0f) : fa * __builtin_amdgcn_rcpf(fb); } }
                    acc[ai][bj][m][0] *= r[0]; acc[ai][bj][m][1] *= r[1];
                    if (kind == 2) { const f32x4 a0 = acc[ai][bj][m][0], a1 = acc[ai][bj][m][1];
                        u32x4 w; w.x = cvt_pk_bf16(a0[0], a0[1]); w.y = cvt_pk_bf16(a0[2], a0[3]); w.z = cvt_pk_bf16(a1[0], a1[1]); w.w = cvt_pk_bf16(a1[2], a1[3]);
                        *(u32x4*)(Y + row * 2048 + c) = w; } } }
            asm volatile("" ::: "memory"); }
    }
};
struct SchedQKV {
    int nMq, nNq, nMk, nNk, G, c; const bf16_t* Aq; const bf16_t* Bq; const bf16_t* Ak; const bf16_t* Bk;
    __device__ __forceinline__ bool next(int i, UnitX& u) const {
        const int L = i * G + c, nq = nMq * nNq;
        Unit b; b.pm = 0; b.pn = 0; bool ok = true; int kind = 0;
        if (L < nq) StaticOrder::map_entry(nMq, nNq, L, b);
        else { const int L2 = L - nq; kind = 1; ok = L2 < nMk * nNk; if (ok) StaticOrder::map_entry(nMk, nNk, L2, b); }
        u.pm = b.pm; u.pn = b.pn; u.kind = kind; return ok;
    }
    __device__ __forceinline__ const bf16_t* gA(int k) const { return k == 0 ? Aq : Ak; }
    __device__ __forceinline__ const bf16_t* gB(int k) const { return k == 0 ? Bq : Bk; }
    __device__ __forceinline__ int gPitch(int k) const { return k == 0 ? 512 : 256; }
    __device__ __forceinline__ int gNt(int k) const { return k == 0 ? 8 : 4; }
    __device__ __forceinline__ int gK0(int) const { return 0; }
    __device__ __forceinline__ int gPerm(int) const { return 1; }
};
struct EpiQKV {
    EpiQup eq; EpiKV ek;
    __device__ __forceinline__ void operator()(const f32x4 (&acc)[2][2][4][2], int pm, int pn, int kind, int wr, int wc, int fr, int fq) const {
        Unit u; u.pm = pm; u.pn = pn;
        if (kind == 0) eq(acc, u, wr, wc, fr, fq); else ek(acc, u, wr, wc, fr, fq);
    }
};
struct SchedSplit {
    const bf16_t* A; const bf16_t* Bt; int K, nlat, nctx, G, c, wgm;
    __device__ __forceinline__ bool next(int i, UnitX& u) const {
        const int L = i * G + c; Unit b; b.pm = 0; b.pn = 0; int kind = 0; bool ok = true;
        if (L < nlat) StaticOrder::map_entry(ML_ROWS / BM, 8, L, b, wgm);
        else { const int e = L - nlat; ok = e < nctx; b.pm = ML_ROWS / BM + (e >> 5); b.pn = (e >> 2) & 7; kind = 1 + (e & 3); }
        u.pm = b.pm; u.pn = b.pn; u.kind = kind; return ok;
    }
    __device__ __forceinline__ const bf16_t* gA(int) const { return A; }
    __device__ __forceinline__ const bf16_t* gB(int) const { return Bt; }
    __device__ __forceinline__ int gPitch(int) const { return K; }
    __device__ __forceinline__ int gNt(int k) const { return k == 0 ? K / BK : K / (4 * BK); }
    __device__ __forceinline__ int gK0(int k) const { return k == 0 ? 0 : (k - 1) * (K / 4); }
    __device__ __forceinline__ int gPerm(int) const { return 1; }
};
struct EpiSplit {
    EpiResid er; bf16_t* PART;
    __device__ __forceinline__ void operator()(const f32x4 (&acc)[2][2][4][2], int pm, int pn, int kind, int wr, int wc, int fr, int fq) const {
        Unit u; u.pm = pm; u.pn = pn;
        if (kind == 0) { er(acc, u, wr, wc, fr, fq); return; }
        bf16_t* base = PART + ((size_t)(kind - 1) * 2048 + (size_t)(pm * BM - ML_ROWS + wr * 64 + fr)) * 2048 + pn * BM + wc * 32 + 8 * fq;
#pragma unroll
        for (int ai = 0; ai < 2; ++ai)
#pragma unroll
            for (int m = 0; m < 4; ++m) { bf16_t* rowp = base + (size_t)(ai * HALF + m * 16) * 2048;
#pragma unroll
                for (int bj = 0; bj < 2; ++bj) { const u32x2 w0 = pack4(acc[ai][bj][m][0]), w1 = pack4(acc[ai][bj][m][1]); u32x4 w; w.x = w0.x; w.y = w0.y; w.z = w1.x; w.w = w1.y; *(u32x4*)(rowp + bj * HALF) = w; } }
    }
};
}
#define XB_TMO      128
#define XB_XCNT(j)  (256  + 64 * (j))
#define XB_XSUB(j)  (1280 + 64 * (j))
#define XB_XGEN(j)  (2304 + 64 * (j))
#define XB_TOP      3328
#define XB_TOPGEN   3392
#define XCD_BAR_WORDS 3456
#define XB_SPIN_CAP (1u << 18)

__device__ __forceinline__ unsigned xb_ld(unsigned* p)              { return __hip_atomic_load(p, __ATOMIC_RELAXED, __HIP_MEMORY_SCOPE_AGENT); }
__device__ __forceinline__ unsigned xb_add(unsigned* p, unsigned v) { return __hip_atomic_fetch_add(p, v, __ATOMIC_RELAXED, __HIP_MEMORY_SCOPE_AGENT); }
__device__ __forceinline__ unsigned xb_xcc_id() { return (unsigned)__builtin_amdgcn_s_getreg((3 << 11) | 20) & 0xFu; }
#define XB_SPIN(cond, bar) do { unsigned _sp = 0; while (cond) { __builtin_amdgcn_s_sleep(1); \
    if ((++_sp & 255u) == 0u) { if (xb_ld(&(bar)[XB_TMO])) break; if (_sp > XB_SPIN_CAP) { atomicAdd(&(bar)[XB_TMO], 1u); break; } } } } while (0)

struct XcdBarrier {
    unsigned* bar; unsigned x;
    volatile LAS unsigned* st;
};

__device__ __forceinline__ XcdBarrier xcd_barrier_post(unsigned* bar, volatile LAS unsigned* st) {
    XcdBarrier b; b.bar = bar; b.x = xb_xcc_id(); b.st = st;
    if (threadIdx.x == 0) (void)xb_add(&bar[XB_XCNT(b.x)], 1u);
    return b;
}
__device__ __forceinline__ void xcd_barrier_complete(unsigned* bar, unsigned x, unsigned& nloc, unsigned& nx) {
    const unsigned G = gridDim.x * gridDim.y * gridDim.z;
    unsigned sum, cnt, mine, sp = 0u;
    for (;;) {
        sum = 0u; cnt = 0u; mine = 0u;
#pragma unroll
        for (unsigned j = 0; j < 16; ++j) { const unsigned c = xb_ld(&bar[XB_XCNT(j)]); sum += c; cnt += (c > 0u) ? 1u : 0u; mine = (j == x) ? c : mine; }
        if (sum == G) break;
        __builtin_amdgcn_s_sleep(1);
        if ((++sp & 255u) == 0u) { if (xb_ld(&bar[XB_TMO])) break; if (sp > XB_SPIN_CAP) { atomicAdd(&bar[XB_TMO], 1u); break; } }
    }
    nloc = mine > 0u ? mine : 1u; nx = cnt > 0u ? cnt : 1u;
}

__device__ __forceinline__ void xcd_barrier(const XcdBarrier& b) {
    asm volatile("s_waitcnt vmcnt(0)" ::: "memory");
    __syncthreads();
    if (threadIdx.x == 0) {
        unsigned* bar = b.bar;
        __builtin_amdgcn_s_waitcnt(0);
        unsigned nloc = b.st[0], nx = b.st[1];
        if (nloc == 0u) { xcd_barrier_complete(bar, b.x, nloc, nx); b.st[0] = nloc; b.st[1] = nx; }
        const unsigned old = xb_add(&bar[XB_XSUB(b.x)], 1u);
        const unsigned gen = old / nloc;
        if (old + 1u == (gen + 1u) * nloc) {
            __builtin_amdgcn_fence(__ATOMIC_RELEASE, "agent");
            asm volatile("s_waitcnt vmcnt(0)" ::: "memory");
            const unsigned og = xb_add(&bar[XB_TOP], 1u);
            const unsigned tg = og / nx;
            if (og + 1u == (tg + 1u) * nx) xb_add(&bar[XB_TOPGEN], 1u);
            else XB_SPIN(xb_ld(&bar[XB_TOPGEN]) == tg, bar);
            __builtin_amdgcn_fence(__ATOMIC_ACQUIRE, "agent");
            xb_add(&bar[XB_XGEN(b.x)], 1u);
            asm volatile("s_waitcnt vmcnt(0)" ::: "memory");
        } else {
            XB_SPIN(xb_ld(&bar[XB_XGEN(b.x)]) == gen, bar);
            __builtin_amdgcn_fence(__ATOMIC_ACQUIRE, "agent");
            asm volatile("s_waitcnt vmcnt(0)" ::: "memory");
        }
    }
    __syncthreads();
}
#ifndef ATT_ILV
#define ATT_ILV 1
#endif
#ifndef ATT_DMAW
#define ATT_DMAW 4
#endif
#ifndef ATT_YOUNG_FROM
#define ATT_YOUNG_FROM (ATT_ILV ? 512 : 256)
#endif
namespace att {
typedef unsigned short bf16_t;
using bf16x8 = __attribute__((ext_vector_type(8))) short;
using s16x4  = __attribute__((ext_vector_type(4))) short;
using f32x16 = __attribute__((ext_vector_type(16))) float;
using u32x4  = __attribute__((ext_vector_type(4))) unsigned;
typedef LAS char lchar;
#define ASBAR() __builtin_amdgcn_sched_barrier(0)
__device__ __forceinline__ int crow(int r, int hi) { return (r & 3) + 8 * (r >> 2) + 4 * hi; }
__device__ __forceinline__ unsigned cvtpk(float lo, float hi) { return pg8::cvt_pk_bf16(lo, hi); }
template <int DK> __device__ __forceinline__ int koff(int row, int chunk) {
    return row * (DK * 2) + ((chunk & ~7) << 4) + (((chunk & 7) ^ ((row >> 1) & 7)) << 4);
}
template <int DV> __device__ __forceinline__ int v_st(int k, int c) { constexpr int NCB = DV / 32; const int kk = (k & ~0xC) | ((k & 4) << 1) | ((k & 8) >> 1); return ((kk >> 3) * NCB + (c >> 5)) * 512 + ((kk & 7) * 32 + (c & 31)) * 2; }
__device__ __forceinline__ int v_rd_base(int lane) { return ((lane & 3) << 3) | (((lane >> 2) & 3) << 6) | (((lane >> 4) & 1) << 5) | (((lane >> 5) & 1) << 8); }
template <int DV> constexpr int v_rd_off(int d0, int ks, int half) { return d0 * 512 + ks * (2 * (DV / 32) * 512) + half * ((DV / 32) * 512); }
#if ATT_ILV
template <int OFF> __device__ __forceinline__ s16x4 tr_read(int vb) { return __builtin_amdgcn_ds_read_tr16_b64_v4i16((LAS s16x4*)(unsigned)(vb + OFF)); }
#else
template <int OFF> __device__ __forceinline__ s16x4 tr_read(int vb) { s16x4 r; asm volatile("ds_read_b64_tr_b16 %0, %1 offset:%2" : "=&v"(r) : "v"(vb), "i"(OFF) : "memory"); return r; }
#endif

__device__ __forceinline__ void glds16(const void* gsrc, unsigned lds_dst) { unsigned keep; lds_dst = __builtin_amdgcn_readfirstlane(lds_dst);
    asm volatile("s_mov_b32 %0, m0\n\ts_mov_b32 m0, %2\n\ts_nop 0\n\tglobal_load_lds_dwordx4 %1, off\n\ts_mov_b32 m0, %0" : "=&s"(keep) : "v"(gsrc), "s"(lds_dst) : "memory"); }
__device__ __forceinline__ void glds16s(const void* sbase, unsigned voff, unsigned lds_dst) { unsigned keep; lds_dst = __builtin_amdgcn_readfirstlane(lds_dst);
    const unsigned long long b = (unsigned long long)sbase; const unsigned blo = __builtin_amdgcn_readfirstlane((unsigned)b), bhi = __builtin_amdgcn_readfirstlane((unsigned)(b >> 32));
    const unsigned long long sb = ((unsigned long long)bhi << 32) | blo;
    asm volatile("s_mov_b32 %0, m0\n\ts_mov_b32 m0, %3\n\ts_nop 0\n\tglobal_load_lds_dwordx4 %1, %2\n\ts_mov_b32 m0, %0" : "=&s"(keep) : "v"(voff), "s"(sb), "s"(lds_dst) : "memory"); }
template <bool WIN>
__device__ __forceinline__ void partialSM(f32x16& p0, f32x16& p1, float& m_reg, float& mn, float& alpha, const float C, const float thr, const bool domask, const int dq, const int hi) {
#if ATT_ILV
    if constexpr (WIN) { const int dqq = domask ? dq : 0;
#pragma unroll
        for (int r = 0; r < 16; ++r) { const int d0 = dqq + crow(r, hi), d1 = d0 + 32; p0[r] = (d0 > 128 || d0 < -128) ? -1e30f : p0[r]; p1[r] = (d1 > 128 || d1 < -128) ? -1e30f : p1[r]; } }
#else
    if constexpr (WIN) { if (domask) {
#pragma unroll
        for (int r = 0; r < 16; ++r) { const int d0 = dq + crow(r, hi), d1 = d0 + 32; if (d0 > 128 || d0 < -128) p0[r] = -1e30f; if (d1 > 128 || d1 < -128) p1[r] = -1e30f; } } }
#endif
    float pmax = p0[0];
#pragma unroll
    for (int r = 1; r < 16; ++r) pmax = fmaxf(pmax, p0[r]);
#pragma unroll
    for (int r = 0; r < 16; ++r) pmax = fmaxf(pmax, p1[r]);
    { auto rr = __builtin_amdgcn_permlane32_swap(__float_as_uint(pmax), __float_as_uint(pmax), false, false); pmax = fmaxf(__uint_as_float(rr[0]), __uint_as_float(rr[1])); }
#if ATT_ILV
    { const bool keep = __all(pmax - m_reg <= thr); mn = fmaxf(m_reg, keep ? m_reg : pmax); alpha = __builtin_amdgcn_exp2f((m_reg - mn) * C); m_reg = mn; }
#else
    if (__builtin_expect(__all(pmax - m_reg <= thr), 1)) { mn = m_reg; alpha = 1.f; }
    else { mn = fmaxf(m_reg, pmax); alpha = __builtin_amdgcn_exp2f((m_reg - mn) * C); m_reg = mn; }
#endif
    const float mnC = -mn * C;
#pragma unroll
    for (int r = 0; r < 16; ++r) p0[r] = fmaf(p0[r], C, mnC);
#pragma unroll
    for (int r = 0; r < 16; ++r) p1[r] = fmaf(p1[r], C, mnC);
#pragma unroll
    for (int r = 0; r < 16; ++r) p0[r] = __builtin_amdgcn_exp2f(p0[r]);
}
__device__ __forceinline__ void finishSM(f32x16& p0, f32x16& p1, float alpha, float& l_reg, bf16x8& pa0, bf16x8& pa1, bf16x8& pa2, bf16x8& pa3) {
#pragma unroll
    for (int r = 0; r < 16; ++r) p1[r] = __builtin_amdgcn_exp2f(p1[r]);
    float ps = 0;
#pragma unroll
    for (int r = 0; r < 16; ++r) ps += p0[r];
#pragma unroll
    for (int r = 0; r < 16; ++r) ps += p1[r];
    { auto rr = __builtin_amdgcn_permlane32_swap(__float_as_uint(ps), __float_as_uint(ps), false, false); ps = __uint_as_float(rr[0]) + __uint_as_float(rr[1]); }
    l_reg = l_reg * alpha + ps;
#define ATT_PK4(P, BASE, OUT) do { unsigned a0 = cvtpk(P[BASE + 0], P[BASE + 1]), a1 = cvtpk(P[BASE + 2], P[BASE + 3]);   \
    unsigned b0 = cvtpk(P[BASE + 4], P[BASE + 5]), b1 = cvtpk(P[BASE + 6], P[BASE + 7]);                              \
    auto r0 = __builtin_amdgcn_permlane32_swap(a0, b0, false, false); auto r1 = __builtin_amdgcn_permlane32_swap(a1, b1, false, false); \
    u32x4 w = {r0[0], r1[0], r0[1], r1[1]}; OUT = *reinterpret_cast<bf16x8*>(&w); } while (0)
    ATT_PK4(p0, 0, pa0); ATT_PK4(p0, 8, pa1); ATT_PK4(p1, 0, pa2); ATT_PK4(p1, 8, pa3);
#undef ATT_PK4
}
template <int DK> __device__ __forceinline__ void qkt(f32x16& p0, f32x16& p1, const lchar* Ks, const bf16x8 (&qr)[DK / 16], const int (&kq)[4]) {
    p0 = f32x16{}; p1 = f32x16{};
    bf16x8 c0 = *(const LAS bf16x8*)(Ks + kq[0]), c1 = *(const LAS bf16x8*)(Ks + kq[0] + 32 * DK * 2);
#pragma unroll
    for (int d0 = 0; d0 < DK / 16; ++d0) {
        bf16x8 n0 = c0, n1 = c1;
        if (d0 + 1 < DK / 16) { n0 = *(const LAS bf16x8*)(Ks + kq[(d0 + 1) & 3] + ((d0 + 1) >> 2) * 128); n1 = *(const LAS bf16x8*)(Ks + kq[(d0 + 1) & 3] + ((d0 + 1) >> 2) * 128 + 32 * DK * 2); }
        p0 = __builtin_amdgcn_mfma_f32_32x32x16_bf16(c0, qr[d0], p0, 0, 0, 0);
        p1 = __builtin_amdgcn_mfma_f32_32x32x16_bf16(c1, qr[d0], p1, 0, 0, 0);
        c0 = n0; c1 = n1; }
}
struct VFrag { s16x4 l0, h0, l1, h1, l2, h2, l3, h3; };
template <int DV, int D0> __device__ __forceinline__ void pv_reads(VFrag& f, int vb) {
    f.l0 = tr_read<v_rd_off<DV>(D0, 0, 0)>(vb); f.h0 = tr_read<v_rd_off<DV>(D0, 0, 1)>(vb); f.l1 = tr_read<v_rd_off<DV>(D0, 1, 0)>(vb); f.h1 = tr_read<v_rd_off<DV>(D0, 1, 1)>(vb);
    f.l2 = tr_read<v_rd_off<DV>(D0, 2, 0)>(vb); f.h2 = tr_read<v_rd_off<DV>(D0, 2, 1)>(vb); f.l3 = tr_read<v_rd_off<DV>(D0, 3, 0)>(vb); f.h3 = tr_read<v_rd_off<DV>(D0, 3, 1)>(vb);
}
__device__ __forceinline__ void pv_mma(f32x16& od, const VFrag& f, bf16x8 pa0, bf16x8 pa1, bf16x8 pa2, bf16x8 pa3) {
#define ATT_PK(L, H) (bf16x8){L[0], L[1], L[2], L[3], H[0], H[1], H[2], H[3]}
    od = __builtin_amdgcn_mfma_f32_32x32x16_bf16(pa0, ATT_PK(f.l0, f.h0), od, 0, 0, 0);
    od = __builtin_amdgcn_mfma_f32_32x32x16_bf16(pa1, ATT_PK(f.l1, f.h1), od, 0, 0, 0);
    od = __builtin_amdgcn_mfma_f32_32x32x16_bf16(pa2, ATT_PK(f.l2, f.h2), od, 0, 0, 0);
    od = __builtin_amdgcn_mfma_f32_32x32x16_bf16(pa3, ATT_PK(f.l3, f.h3), od, 0, 0, 0);
#undef ATT_PK
}
#define ATT_LWAIT(n) do { asm volatile("s_waitcnt lgkmcnt(" #n ")" ::: "memory"); ASBAR(); } while (0)
#if ATT_ILV
template <int DV> __device__ __forceinline__ void pv_all(f32x16 (&o)[DV / 32], int vb, bf16x8 pa0, bf16x8 pa1, bf16x8 pa2, bf16x8 pa3) {
    { VFrag f; pv_reads<DV, 0>(f, vb); pv_mma(o[0], f, pa0, pa1, pa2, pa3); }
    { VFrag f; pv_reads<DV, 1>(f, vb); pv_mma(o[1], f, pa0, pa1, pa2, pa3); }
    if constexpr (DV == 128) {
        { VFrag f; pv_reads<DV, 2>(f, vb); pv_mma(o[2], f, pa0, pa1, pa2, pa3); }
        { VFrag f; pv_reads<DV, 3>(f, vb); pv_mma(o[3], f, pa0, pa1, pa2, pa3); } }
}
#define ATT_SWAP(A, B) __builtin_amdgcn_permlane32_swap((A), (B), false, false)
#define ATT_PIN(X) asm volatile("" : "+v"(X))
template <int PT, int B> __device__ __forceinline__ void pk_step(const f32x16& P, unsigned& a0, unsigned& a1, unsigned& b0, unsigned& b1, unsigned& x0, unsigned& y0, bf16x8& OUT) {
    if constexpr (PT == 0) { a0 = cvtpk(P[B + 0], P[B + 1]); b0 = cvtpk(P[B + 4], P[B + 5]); }
    if constexpr (PT == 1) { a1 = cvtpk(P[B + 2], P[B + 3]); b1 = cvtpk(P[B + 6], P[B + 7]); }
    if constexpr (PT == 2) { auto r0 = ATT_SWAP(a0, b0); x0 = r0[0]; y0 = r0[1]; }
    if constexpr (PT == 3) { auto r1 = ATT_SWAP(a1, b1); u32x4 w = {x0, r1[0], y0, r1[1]}; OUT = *reinterpret_cast<bf16x8*>(&w); }
}
template <int K> __device__ __forceinline__ void fin_atom(f32x16& q0, f32x16& q1, float alpha, float& l_reg, float& ps0, float& ps1, unsigned& a0, unsigned& a1, unsigned& b0, unsigned& b1, unsigned& x0, unsigned& y0,
                                                          bf16x8& pa0, bf16x8& pa1, bf16x8& pa2, bf16x8& pa3) {
    if constexpr (K < 16) { q1[K] = __builtin_amdgcn_exp2f(q1[K]); ATT_PIN(q1[K]); ps0 += q0[K]; ATT_PIN(ps0); }
    if constexpr (K >= 8) { ps1 += q1[K - 8]; ATT_PIN(ps1); }
    if constexpr (K < 4) pk_step<K & 3, 0>(q0, a0, a1, b0, b1, x0, y0, pa0);
    else if constexpr (K < 8) pk_step<K & 3, 8>(q0, a0, a1, b0, b1, x0, y0, pa1);
    else if constexpr (K >= 16 && K < 20) pk_step<K & 3, 0>(q1, a0, a1, b0, b1, x0, y0, pa2);
    else if constexpr (K >= 20) pk_step<K & 3, 8>(q1, a0, a1, b0, b1, x0, y0, pa3);
    if constexpr (K == 23) { float ps = ps0 + ps1; auto rr = ATT_SWAP(__float_as_uint(ps), __float_as_uint(ps)); ps = __uint_as_float(rr[0]) + __uint_as_float(rr[1]); l_reg = l_reg * alpha + ps; }
}
template <int I, int NM, int DK> __device__ __forceinline__ void qk_step(f32x16& p0, f32x16& p1, const lchar* Ks, const bf16x8 (&qr)[DK / 16], const int (&kq)[4], bf16x8 (&F)[4],
        f32x16& q0, f32x16& q1, float alpha, float& l_reg, float& ps0, float& ps1, unsigned& a0, unsigned& a1, unsigned& b0, unsigned& b1, unsigned& x0, unsigned& y0, bf16x8& pa0, bf16x8& pa1, bf16x8& pa2, bf16x8& pa3) {
    constexpr int d0 = I >> 1, APG = 24 / NM;
    if constexpr (I == 0) p0 = __builtin_amdgcn_mfma_f32_32x32x16_bf16(F[0], qr[0], f32x16{}, 0, 0, 0);
    else if constexpr (I == 1) p1 = __builtin_amdgcn_mfma_f32_32x32x16_bf16(F[1], qr[0], f32x16{}, 0, 0, 0);
    else if constexpr ((I & 1) == 0) p0 = __builtin_amdgcn_mfma_f32_32x32x16_bf16(F[I & 3], qr[d0], p0, 0, 0, 0);
    else p1 = __builtin_amdgcn_mfma_f32_32x32x16_bf16(F[I & 3], qr[d0], p1, 0, 0, 0);
    if constexpr (I + 4 < NM) { constexpr int J = I + 4, e0 = J >> 1; F[I & 3] = *(const LAS bf16x8*)(Ks + kq[e0 & 3] + (e0 >> 2) * 128 + (J & 1) * (32 * DK * 2)); }
    fin_atom<APG * I>(q0, q1, alpha, l_reg, ps0, ps1, a0, a1, b0, b1, x0, y0, pa0, pa1, pa2, pa3);
    if constexpr (APG >= 2) fin_atom<APG * I + 1>(q0, q1, alpha, l_reg, ps0, ps1, a0, a1, b0, b1, x0, y0, pa0, pa1, pa2, pa3);
    if constexpr (APG >= 3) fin_atom<APG * I + 2>(q0, q1, alpha, l_reg, ps0, ps1, a0, a1, b0, b1, x0, y0, pa0, pa1, pa2, pa3);
    ASBAR();
    if constexpr (I + 1 < NM) qk_step<I + 1, NM, DK>(p0, p1, Ks, qr, kq, F, q0, q1, alpha, l_reg, ps0, ps1, a0, a1, b0, b1, x0, y0, pa0, pa1, pa2, pa3);
}
template <int DK> __device__ __forceinline__ void qkt_fin(f32x16& p0, f32x16& p1, const lchar* Ks, const bf16x8 (&qr)[DK / 16], const int (&kq)[4],
        f32x16& q0, f32x16& q1, float alpha, float& l_reg, bf16x8& pa0, bf16x8& pa1, bf16x8& pa2, bf16x8& pa3) {
    constexpr int NM = DK / 8;
    bf16x8 F[4];
#pragma unroll
    for (int i = 0; i < 4; ++i) F[i] = *(const LAS bf16x8*)(Ks + kq[(i >> 1) & 3] + ((i >> 1) >> 2) * 128 + (i & 1) * (32 * DK * 2));
    float ps0 = 0.f, ps1 = 0.f; unsigned a0 = 0, a1 = 0, b0 = 0, b1 = 0, x0 = 0, y0 = 0;
    ASBAR();
    qk_step<0, NM, DK>(p0, p1, Ks, qr, kq, F, q0, q1, alpha, l_reg, ps0, ps1, a0, a1, b0, b1, x0, y0, pa0, pa1, pa2, pa3);
}
template <int K, bool WIN> __device__ __forceinline__ void par_atom(f32x16& p0, f32x16& p1, float& m_reg, float& mn, float& alpha, const float C, const float thr, const int dqq, const int hi,
                                                                    float& pm0, float& pm1, float& pm2, float& pm3, float& mnC) {
    if constexpr (K < 4) { f32x16& P = (K < 2) ? p0 : p1; constexpr int B = (K & 1) * 8;
        if constexpr (WIN) {
#pragma unroll
            for (int r = B; r < B + 8; ++r) { const int d = dqq + crow(r, hi) + (K < 2 ? 0 : 32); P[r] = (d > 128 || d < -128) ? -1e30f : P[r]; } }
        const float m = fmaxf(fmaxf(fmaxf(P[B], P[B + 1]), fmaxf(P[B + 2], P[B + 3])), fmaxf(fmaxf(P[B + 4], P[B + 5]), fmaxf(P[B + 6], P[B + 7])));
        if constexpr (K == 0) pm0 = m; else if constexpr (K == 1) pm1 = m; else if constexpr (K == 2) pm2 = m; else pm3 = m; }
    if constexpr (K == 4) { float pmax = fmaxf(fmaxf(pm0, pm1), fmaxf(pm2, pm3));
        auto rr = ATT_SWAP(__float_as_uint(pmax), __float_as_uint(pmax)); pmax = fmaxf(__uint_as_float(rr[0]), __uint_as_float(rr[1]));
        const bool keep = __all(pmax - m_reg <= thr); mn = fmaxf(m_reg, keep ? m_reg : pmax); alpha = __builtin_amdgcn_exp2f((m_reg - mn) * C); m_reg = mn; mnC = -mn * C; }
    if constexpr (K >= 5 && K <= 8) { f32x16& P = (K < 7) ? p0 : p1; constexpr int B = ((K - 5) & 1) * 8;
#pragma unroll
        for (int r = B; r < B + 8; ++r) { P[r] = fmaf(P[r], C, mnC); ATT_PIN(P[r]); } }
    if constexpr (K >= 8) { p0[2 * (K - 8)] = __builtin_amdgcn_exp2f(p0[2 * (K - 8)]); p0[2 * (K - 8) + 1] = __builtin_amdgcn_exp2f(p0[2 * (K - 8) + 1]); ATT_PIN(p0[2 * (K - 8)]); ATT_PIN(p0[2 * (K - 8) + 1]); }
}
template <int I, int NM, int DV, bool WIN> __device__ __forceinline__ void pv_step(f32x16 (&o)[DV / 32], const int vb, const bf16x8 (&pa)[4], s16x4 (&L)[4], s16x4 (&H)[4],
        f32x16& p0, f32x16& p1, float& m_reg, float& mn, float& alpha, const float C, const float thr, const int dqq, const int hi, float& pm0, float& pm1, float& pm2, float& pm3, float& mnC) {
    constexpr int b = I >> 2, k = I & 3, APG = 16 / NM;
    { const s16x4 l = L[k], h = H[k]; o[b] = __builtin_amdgcn_mfma_f32_32x32x16_bf16(pa[k], (bf16x8){l[0], l[1], l[2], l[3], h[0], h[1], h[2], h[3]}, o[b], 0, 0, 0); }
    if constexpr (b + 1 < DV / 32) { L[k] = tr_read<v_rd_off<DV>(b + 1, k, 0)>(vb); H[k] = tr_read<v_rd_off<DV>(b + 1, k, 1)>(vb); }
    par_atom<APG * I, WIN>(p0, p1, m_reg, mn, alpha, C, thr, dqq, hi, pm0, pm1, pm2, pm3, mnC);
    if constexpr (APG >= 2) par_atom<APG * I + 1, WIN>(p0, p1, m_reg, mn, alpha, C, thr, dqq, hi, pm0, pm1, pm2, pm3, mnC);
    ASBAR();
    if constexpr (I + 1 < NM) pv_step<I + 1, NM, DV, WIN>(o, vb, pa, L, H, p0, p1, m_reg, mn, alpha, C, thr, dqq, hi, pm0, pm1, pm2, pm3, mnC);
}
template <int DV, bool WIN> __device__ __forceinline__ void pv_part(f32x16 (&o)[DV / 32], const int vb, bf16x8 pa0, bf16x8 pa1, bf16x8 pa2, bf16x8 pa3,
        f32x16& p0, f32x16& p1, float& m_reg, float& mn, float& alpha, const float C, const float thr, const bool domask, const int dq, const int hi) {
    constexpr int NM = DV / 8;
    const bf16x8 pa[4] = {pa0, pa1, pa2, pa3}; s16x4 L[4], H[4];
    L[0] = tr_read<v_rd_off<DV>(0, 0, 0)>(vb); H[0] = tr_read<v_rd_off<DV>(0, 0, 1)>(vb); L[1] = tr_read<v_rd_off<DV>(0, 1, 0)>(vb); H[1] = tr_read<v_rd_off<DV>(0, 1, 1)>(vb);
    L[2] = tr_read<v_rd_off<DV>(0, 2, 0)>(vb); H[2] = tr_read<v_rd_off<DV>(0, 2, 1)>(vb); L[3] = tr_read<v_rd_off<DV>(0, 3, 0)>(vb); H[3] = tr_read<v_rd_off<DV>(0, 3, 1)>(vb);
    float pm0 = 0.f, pm1 = 0.f, pm2 = 0.f, pm3 = 0.f, mnC = 0.f; const int dqq = domask ? dq : 0;
    ASBAR();
    pv_step<0, NM, DV, WIN>(o, vb, pa, L, H, p0, p1, m_reg, mn, alpha, C, thr, dqq, hi, pm0, pm1, pm2, pm3, mnC);
}
#else
template <int NM, int ND, int NV> __device__ __forceinline__ void sgb_pattern() {}
template <int DV> __device__ __forceinline__ void pv_all(f32x16 (&o)[DV / 32], int vb, bf16x8 pa0, bf16x8 pa1, bf16x8 pa2, bf16x8 pa3) {
    VFrag f;
    pv_reads<DV, 0>(f, vb); ATT_LWAIT(0); pv_mma(o[0], f, pa0, pa1, pa2, pa3);
    pv_reads<DV, 1>(f, vb); ATT_LWAIT(0); pv_mma(o[1], f, pa0, pa1, pa2, pa3);
    if constexpr (DV == 128) {
        pv_reads<DV, 2>(f, vb); ATT_LWAIT(0); pv_mma(o[2], f, pa0, pa1, pa2, pa3);
        pv_reads<DV, 3>(f, vb); ATT_LWAIT(0); pv_mma(o[3], f, pa0, pa1, pa2, pa3); }
}
#endif
template <int DK, int DV, bool WIN, bool SINK, int MODE>
__device__ __forceinline__ void attn_unit(const bf16_t* __restrict__ Qb, const int ldq, const bf16_t* __restrict__ Kb, const int ldk, const bf16_t* __restrict__ Vb, const int ldv,
                                          bf16_t* __restrict__ Ob, const int ldo, const int cbase, const int lbase, const int NT, const int qpos0, const int kpos0, const float sinkl2, lchar* lds) {
    constexpr int KI = DK / 64, VI = DV / 64, ND = DK / 16, NO = DV / 32, SHM_K = 64 * DK * 2, SHM_V = 64 * DV * 2;
    constexpr float SCALE = (DK == 192) ? 0.07216878364870322f : 0.125f, C = SCALE * 1.4426950408889634f, THRR = 8.0f / SCALE;
    int tid_ = threadIdx.x; asm volatile("" : "+v"(tid_));
    const int tid = tid_, wid = tid >> 6, lane = tid & 63, r32 = lane & 31, hi = lane >> 5;
    constexpr int NSLOT = (MODE == 2) ? 3 : 2;
    lchar* V_lds = lds; lchar* K_lds = lds + NSLOT * SHM_V;
    LAS float* wsf = (LAS float*)(lds + NSLOT * SHM_V + NSLOT * SHM_K) + wid * 64; LAS float* li_l = wsf; LAS float* al_l = wsf + 32;
    float m_reg = -1e30f, l_reg = 0.f; f32x16 o[NO]; bf16x8 qr[ND];
#pragma unroll
    for (int d = 0; d < NO; ++d) o[d] = f32x16{};
    const bf16_t* Qw = Qb + (long)(wid * 32 + r32) * ldq + hi * 8;
#pragma unroll
    for (int d0 = 0; d0 < ND; ++d0) qr[d0] = *(const bf16x8*)(Qw + d0 * 16);
    const int srow = tid >> 3, scg = tid & 7;
    const int kgo = srow * ldk + scg * 8, vgo = srow * ldv + scg * 8;
    int klo[KI];
#pragma unroll
    for (int i = 0; i < KI; ++i) klo[i] = koff<DK>(srow, scg + 8 * i);
    const int vlo = v_st<DV>(srow, scg * 8);
    const int vb0 = (int)(uintptr_t)V_lds + v_rd_base(lane);
    const int qpos = qpos0 + wid * 32 + r32;
    int kq[4];
#pragma unroll
    for (int k = 0; k < 4; ++k) kq[k] = r32 * (DK * 2) + (((2 * k) ^ hi ^ ((r32 >> 1) & 7)) << 4);
    bf16x8 ks[KI], vs[VI];
#define ATT_ROWOF(j) ((j) < 4 ? cbase + 64 * (j) : lbase + 64 * ((j) - 4))
#define ATT_SLOAD(j) do { const long rb_ = ATT_ROWOF(j); const bf16_t* kp_ = Kb + rb_ * ldk + kgo; const bf16_t* vp_ = Vb + rb_ * ldv + vgo; \
    _Pragma("unroll") for (int i_ = 0; i_ < KI; ++i_) ks[i_] = *(const bf16x8*)(kp_ + 64 * i_); \
    _Pragma("unroll") for (int i_ = 0; i_ < VI; ++i_) vs[i_] = *(const bf16x8*)(vp_ + 64 * i_); } while (0)
#define ATT_SWRITE(b) do { _Pragma("unroll") for (int i_ = 0; i_ < KI; ++i_) *(LAS bf16x8*)(K_lds + (b) * SHM_K + klo[i_]) = ks[i_]; \
    _Pragma("unroll") for (int i_ = 0; i_ < VI; ++i_) *(LAS bf16x8*)(V_lds + (b) * SHM_V + vlo + i_ * 1024) = vs[i_]; } while (0)
#define ATT_RESC(a) do { if (__any((a) < 1.f)) { if (hi == 0) al_l[r32] = (a); asm volatile("s_waitcnt lgkmcnt(0)" ::: "memory"); \
    _Pragma("unroll") for (int d_ = 0; d_ < NO; ++d_) _Pragma("unroll") for (int r_ = 0; r_ < 16; ++r_) o[d_][r_] *= al_l[crow(r_, hi)]; } } while (0)
#define ATT_DQ(j) (kpos0 + 64 * ((j) - 4) - qpos)
    f32x16 pA0, pA1, pB0, pB1; float mnA, mnB, alA, alB; bf16x8 pa0, pa1, pa2, pa3;
    __syncthreads();
    if constexpr (MODE == 2) {
        const int wu = __builtin_amdgcn_readfirstlane(wid);
        constexpr int DW = ATT_DMAW, KP = KI * 8 / DW, VP = VI * 8 / DW;
        const bool dmaw = wu < DW;
        int kgs[KP], vgs[VP];
#pragma unroll
        for (int i = 0; i < KP; ++i) { const int p = (wu * KP + i) * 64 + lane, kr = p / (DK / 8), c2 = p % (DK / 8); kgs[i] = kr * ldk + (((c2 & ~7) | ((c2 & 7) ^ ((kr >> 1) & 7))) << 3); }
#pragma unroll
        for (int i = 0; i < VP; ++i) { const int u16 = (wu * VP + i) * 64 + lane, st = u16 >> 5, kk = (st / (DV / 32)) * 8 + ((u16 >> 2) & 7), c = (st % (DV / 32)) * 32 + (u16 & 3) * 8;
            const int k = (kk & ~0xC) | ((kk & 4) << 1) | ((kk & 8) >> 1); vgs[i] = k * ldv + c; }
        const unsigned kl0 = (unsigned)(uintptr_t)K_lds + (unsigned)(wu * KP) * 1024u, vl0 = (unsigned)(uintptr_t)V_lds + (unsigned)(wu * VP) * 1024u;
#define ATT_DMAK(j, slot) do { const bf16_t* kp_ = Kb + (long)ATT_ROWOF(j) * ldk; if (dmaw) { _Pragma("unroll") for (int i_ = 0; i_ < KP; ++i_) glds16s(kp_, (unsigned)kgs[i_] * 2u, kl0 + (unsigned)(slot) * SHM_K + i_ * 1024); } } while (0)
#define ATT_DMAV(j, slot) do { const bf16_t* vp_ = Vb + (long)ATT_ROWOF(j) * ldv; if (dmaw) { _Pragma("unroll") for (int i_ = 0; i_ < VP; ++i_) glds16s(vp_, (unsigned)vgs[i_] * 2u, vl0 + (unsigned)(slot) * SHM_V + i_ * 1024); } } while (0)
#define ATT_WAITN(n) asm volatile("s_waitcnt vmcnt(" #n ") lgkmcnt(0)" ::: "memory")
#define ATT_WAIT1() do { if constexpr (KP + VP == 10) ATT_WAITN(10); else if constexpr (KP + VP == 5) ATT_WAITN(5); else if constexpr (KP + VP == 4) ATT_WAITN(4); else { static_assert(KP + VP == 2); ATT_WAITN(2); } } while (0)
#define ATT_WAIT2() do { if constexpr (KP + VP == 10) ATT_WAITN(20); else if constexpr (KP + VP == 5) ATT_WAITN(10); else if constexpr (KP + VP == 4) ATT_WAITN(8); else ATT_WAITN(4); } while (0)
#define ATT_SYNC(j) do { const int sp_ = (sc == 0) ? 2 : sc - 1; if ((j) + 2 < NT) ATT_WAIT1(); else ATT_WAITN(0); \
        __builtin_amdgcn_s_barrier(); asm volatile("" ::: "memory"); \
        if ((j) + 3 < NT) ATT_DMAK((j) + 3, sc); if ((j) + 2 < NT) ATT_DMAV((j) + 2, sp_); } while (0)
#define ATT_STEP_OLD(j, PC0, PC1, MNC, ALC, PP0, PP1, MNP, ALP) do { const int spv_ = (sc == 0) ? 2 : sc - 1; \
        ASBAR(); qkt_fin<DK>(PC0, PC1, K_lds + sc * SHM_K, qr, kq, PP0, PP1, ALP, l_reg, pa0, pa1, pa2, pa3); \
        pv_part<DV, WIN>(o, vb0 + spv_ * SHM_V, pa0, pa1, pa2, pa3, PC0, PC1, m_reg, MNC, ALC, C, THRR, (j) >= 4, ATT_DQ(j), hi); \
        ATT_SYNC(j); ATT_RESC(ALC); sc = (sc == 2) ? 0 : sc + 1; } while (0)
#define ATT_STEP_YNG(j, PC0, PC1, MNC, ALC, PP0, PP1, MNP, ALP) do { const int spv_ = (sc == 0) ? 2 : sc - 1; \
        partialSM<WIN>(PP0, PP1, m_reg, MNP, ALP, C, THRR, (j) - 1 >= 4, ATT_DQ((j) - 1), hi); ATT_RESC(ALP); \
        ASBAR(); qkt<DK>(PC0, PC1, K_lds + sc * SHM_K, qr, kq); \
        finishSM(PP0, PP1, ALP, l_reg, pa0, pa1, pa2, pa3); ASBAR(); \
        pv_all<DV>(o, vb0 + spv_ * SHM_V, pa0, pa1, pa2, pa3); \
        ATT_SYNC(j); sc = (sc == 2) ? 0 : sc + 1; } while (0)
        const bool young = (ATT_YOUNG_FROM < 512) && __builtin_amdgcn_readfirstlane(tid) >= ATT_YOUNG_FROM;
        ATT_WAITN(0); __builtin_amdgcn_s_barrier(); asm volatile("" ::: "memory");
        ATT_DMAK(0, 0); ATT_DMAK(1, 1); ATT_DMAV(0, 0); ATT_DMAK(2, 2); ATT_DMAV(1, 1);
        ATT_WAIT2(); __builtin_amdgcn_s_barrier(); asm volatile("" ::: "memory");
        int sc = 0;
        if (young) {
            qkt<DK>(pA0, pA1, K_lds, qr, kq);
            ATT_SYNC(0); sc = 1;
            for (int j = 1; j + 1 < NT; j += 2) {
                ATT_STEP_YNG(j, pB0, pB1, mnB, alB, pA0, pA1, mnA, alA);
                ATT_STEP_YNG(j + 1, pA0, pA1, mnA, alA, pB0, pB1, mnB, alB);
            }
            ATT_STEP_YNG(NT - 1, pB0, pB1, mnB, alB, pA0, pA1, mnA, alA);
            partialSM<WIN>(pB0, pB1, m_reg, mnB, alB, C, THRR, NT - 1 >= 4, ATT_DQ(NT - 1), hi); ATT_RESC(alB);
        } else {
            qkt<DK>(pA0, pA1, K_lds, qr, kq); partialSM<WIN>(pA0, pA1, m_reg, mnA, alA, C, THRR, false, 0, hi);
            ATT_SYNC(0); ATT_RESC(alA); sc = 1;
            for (int j = 1; j + 1 < NT; j += 2) {
                ATT_STEP_OLD(j, pB0, pB1, mnB, alB, pA0, pA1, mnA, alA);
                ATT_STEP_OLD(j + 1, pA0, pA1, mnA, alA, pB0, pB1, mnB, alB);
            }
            ATT_STEP_OLD(NT - 1, pB0, pB1, mnB, alB, pA0, pA1, mnA, alA);
        }
        finishSM(pB0, pB1, alB, l_reg, pa0, pa1, pa2, pa3); ASBAR();
        pv_all<DV>(o, vb0 + ((sc == 0) ? 2 : sc - 1) * SHM_V, pa0, pa1, pa2, pa3);
#undef ATT_SYNC
#undef ATT_STEP_OLD
#undef ATT_STEP_YNG
#undef ATT_DMAK
#undef ATT_DMAV
#undef ATT_WAITN
#undef ATT_WAIT1
#undef ATT_WAIT2
    } else if constexpr (MODE == 1) {
        ATT_SLOAD(0); asm volatile("s_waitcnt vmcnt(0)" ::: "memory"); ATT_SWRITE(0); __syncthreads();
        for (int j = 0; j < NT; ++j) {
            const int b = j & 1;
            if (j + 1 < NT) ATT_SLOAD(j + 1);
            ASBAR(); qkt<DK>(pA0, pA1, K_lds + b * SHM_K, qr, kq);
            partialSM<WIN>(pA0, pA1, m_reg, mnA, alA, C, THRR, j >= 4, ATT_DQ(j), hi);
            ATT_RESC(alA);
            finishSM(pA0, pA1, alA, l_reg, pa0, pa1, pa2, pa3); ASBAR();
            pv_all<DV>(o, vb0 + b * SHM_V, pa0, pa1, pa2, pa3);
            if (j + 1 < NT) { asm volatile("s_waitcnt vmcnt(0)" ::: "memory"); ATT_SWRITE(b ^ 1); }
            __syncthreads();
        }
    } else {
    ATT_SLOAD(0); asm volatile("s_waitcnt vmcnt(0)" ::: "memory"); ATT_SWRITE(0); __syncthreads();
    qkt<DK>(pA0, pA1, K_lds, qr, kq); partialSM<WIN>(pA0, pA1, m_reg, mnA, alA, C, THRR, false, 0, hi);
    ATT_SLOAD(1); asm volatile("s_waitcnt vmcnt(0)" ::: "memory"); ATT_SWRITE(1); __syncthreads();
    for (int j = 1; j + 1 < NT; j += 2) {
        ASBAR(); qkt<DK>(pB0, pB1, K_lds + SHM_K, qr, kq);
        finishSM(pA0, pA1, alA, l_reg, pa0, pa1, pa2, pa3); ASBAR();
        ATT_SLOAD(j + 1); ASBAR();
        pv_all<DV>(o, vb0, pa0, pa1, pa2, pa3); partialSM<WIN>(pB0, pB1, m_reg, mnB, alB, C, THRR, j >= 4, ATT_DQ(j), hi);
        __syncthreads(); asm volatile("s_waitcnt vmcnt(0)" ::: "memory"); ATT_SWRITE(0);
        ATT_RESC(alB); __syncthreads();
        ASBAR(); qkt<DK>(pA0, pA1, K_lds, qr, kq);
        finishSM(pB0, pB1, alB, l_reg, pa0, pa1, pa2, pa3); ASBAR();
        ATT_SLOAD(j + 2); ASBAR();
        pv_all<DV>(o, vb0 + SHM_V, pa0, pa1, pa2, pa3); partialSM<WIN>(pA0, pA1, m_reg, mnA, alA, C, THRR, j + 1 >= 4, ATT_DQ(j + 1), hi);
        __syncthreads(); asm volatile("s_waitcnt vmcnt(0)" ::: "memory"); ATT_SWRITE(1);
        ATT_RESC(alA); __syncthreads();
    }
    ASBAR(); qkt<DK>(pB0, pB1, K_lds + SHM_K, qr, kq);
    finishSM(pA0, pA1, alA, l_reg, pa0, pa1, pa2, pa3); ASBAR();
    pv_all<DV>(o, vb0, pa0, pa1, pa2, pa3); partialSM<WIN>(pB0, pB1, m_reg, mnB, alB, C, THRR, NT - 1 >= 4, ATT_DQ(NT - 1), hi);
    __syncthreads(); ATT_RESC(alB);
    finishSM(pB0, pB1, alB, l_reg, pa0, pa1, pa2, pa3); ASBAR();
    pv_all<DV>(o, vb0 + SHM_V, pa0, pa1, pa2, pa3);
    }
    if constexpr (SINK) l_reg += __builtin_amdgcn_exp2f(sinkl2 - m_reg * C);
    if (hi == 0) li_l[r32] = l_reg;
    asm volatile("s_waitcnt lgkmcnt(0)" ::: "memory");
    float rli[16];
#pragma unroll
    for (int r = 0; r < 16; ++r) rli[r] = __builtin_amdgcn_rcpf(li_l[crow(r, hi)]);
    bf16_t* Ow = Ob + (long)(wid * 32) * ldo + r32;
#pragma unroll
    for (int r = 0; r < 16; ++r) { const int orow = crow(r, hi);
#pragma unroll
        for (int d0 = 0; d0 < NO; ++d0) Ow[(long)orow * ldo + d0 * 32] = (bf16_t)(cvtpk(o[d0][r] * rli[r], 0.f) & 0xffffu); }
#undef ATT_ROWOF
#undef ATT_SLOAD
#undef ATT_SWRITE
#undef ATT_RESC
#undef ATT_DQ
}
}
typedef unsigned short bf16;
typedef unsigned v4u __attribute__((ext_vector_type(4)));
typedef unsigned v2u __attribute__((ext_vector_type(2)));
typedef float f32x4 __attribute__((ext_vector_type(4)));
typedef short bf16x8 __attribute__((ext_vector_type(8)));
typedef GAS unsigned gu32;
#define LDS_WAIT() asm volatile("s_waitcnt lgkmcnt(0)" ::: "memory")
#define VM_WAIT() asm volatile("s_waitcnt vmcnt(0)" ::: "memory")

constexpr int NWAVES = 8;
constexpr int DM = 2048, NB = 8, SEQ = 4096, DEPTH = 4, CTXL = 256, DFF = 5632;
constexpr int ML = NB * SEQ, MC = NB * CTXL, MT = ML + MC;
constexpr int NIN = 8768, NINP = 8960, NMOD = 6 * DM;
constexpr float EPS = 1e-6f;
static_assert(ML == pg8::ML_ROWS, "row split");

constexpr size_t MiB = 1u << 20;
constexpr size_t WS_CTL = 0, CTL_ZERO_BYTES = 1 * MiB;
constexpr size_t WS_MOD = 1 * MiB;
constexpr size_t WS_ROPE = 3 * MiB;
constexpr size_t WS_W = 4 * MiB;
constexpr size_t WO_IN = 0, WO_Q = WO_IN + (size_t)NINP * DM * 2, WO_KV = WO_Q + (size_t)1536 * 512 * 2, WO_C = WO_KV + (size_t)2048 * 256 * 2, WO_M = WO_C + (size_t)2048 * 512 * 2,
                 WO_G = WO_M + (size_t)2048 * 1024 * 2, WO_O = WO_G + (size_t)2048 * 512 * 2, WO_F1 = WO_O + (size_t)2048 * 2048 * 2, WO_F2 = WO_F1 + (size_t)2 * DFF * DM * 2,
                 WO_END = WO_F2 + (size_t)DM * DFF * 2;
static_assert(WO_END <= 120 * MiB, "weights");
constexpr size_t WS_XC = 124 * MiB;
constexpr size_t WS_A = 140 * MiB;
constexpr size_t WS_B = 548 * MiB;
constexpr size_t WS_C = 684 * MiB;
constexpr size_t WS_D = 786 * MiB;
constexpr size_t WD_KF = 0, WD_V = 102 * MiB, WD_GQ = 170 * MiB, WD_GK = 204 * MiB, WD_GV = 213 * MiB, WD_U = 222 * MiB;
constexpr size_t WS_E = 1058 * MiB;
constexpr size_t WE_UC = 0, WE_CKV = 34 * MiB, WE_QA = 51 * MiB;
constexpr size_t WS_XB = 1144 * MiB;
constexpr size_t WS_END = 1272 * MiB;
static_assert((size_t)MT * 6144 * 2 <= 408 * MiB && (size_t)MT * 2048 * 2 <= 136 * MiB && (size_t)MT * 768 * 4 <= 102 * MiB && (size_t)MT * 2048 * 4 <= 272 * MiB && WD_U + (size_t)MT * 512 * 2 <= 272 * MiB, "ws map");
constexpr int CW_BAR = 4096;

constexpr int RING_OFF = 0, RING_BYTES = 131072, LDSCTL_OFF = RING_BYTES, MISC_OFF = LDSCTL_OFF + 320, LDS_BYTES = 147456;

__device__ __forceinline__ unsigned f2bf(float f) { unsigned u = __builtin_bit_cast(unsigned, f); return (u + 0x7fffu + ((u >> 16) & 1u)) >> 16; }
__device__ __forceinline__ unsigned pk2(float lo, float hi) { return pg8::cvt_pk_bf16(lo, hi); }
__device__ __forceinline__ float wave_sum(float v) {
#pragma unroll
    for (int o = 1; o < 64; o <<= 1) v += __shfl_xor(v, o);
    return v;
}
__device__ __forceinline__ float bflo(unsigned w) { return __uint_as_float(w << 16); }
__device__ __forceinline__ float bfhi(unsigned w) { return __uint_as_float(w & 0xffff0000u); }
__device__ __forceinline__ float sigmf(float x) { return __builtin_amdgcn_rcpf(1.0f + __builtin_amdgcn_exp2f(-1.4426950408889634f * x)); }

__device__ __forceinline__ int srccol(int mode, int n) {
    if (mode == 0) return n;
    if (mode == 1) {
        if (n < 6144) return 2624 + n;
        if (n < 7744) { const int o = n - 6144; const bool pair = (o >= 256 && o < 448) || o >= 1088;
            if (!pair) return o; const int b0 = o & ~31, p = o & 31; return b0 + 4 * (p >> 3) + (p & 3) + 16 * ((p >> 2) & 1); }
        if (n < 8768) { const int q = n - 7744, g = q >> 5, p = q & 31, i = 4 * (p >> 3) + (p & 3); return 1600 + (((p >> 2) & 1) ? 512 : 0) + 16 * g + i; }
        return -1;
    }
    if (mode == 3) { if (n % 192 < 128) return n; const int b0 = n & ~31, p = n & 31; return b0 + 4 * (p >> 3) + (p & 3) + 16 * ((p >> 2) & 1); }
    { const int t = n >> 8, j = n & 255; return j < 128 ? 128 * t + j : DFF + 128 * t + (j - 128); }
}
__device__ __forceinline__ void cvt_item(const float* W, int K, int N, bf16* WT, LAS float* scr, int item, int nblk, int lane, int mode) {
    const int kb = item / nblk, nb = item % nblk, k0 = 64 * kb, n0 = 32 * nb;
    const int sc = srccol(mode, n0 + (lane & 31));
    const float wsc = (mode == 1 && n0 < 6144) ? -1.4426950408889634f : 1.0f;
    const float* wp = W + (size_t)(k0 + (lane >> 5)) * N + (sc >= 0 ? sc : 0);
#pragma unroll 8
    for (int i = 0; i < 32; ++i) { const float v = wp[(size_t)(2 * i) * N] * wsc; scr[(2 * i + (lane >> 5)) * 33 + (lane & 31)] = sc >= 0 ? v : 0.f; }
    LDS_WAIT(); asm volatile("" ::: "memory");
    const int c = lane & 7;
#pragma unroll
    for (int j = 0; j < 4; ++j) { const int n = (lane >> 3) + 8 * j; const LAS float* s = scr + (8 * c) * 33 + n;
        v4u o; o.x = pk2(s[0 * 33], s[1 * 33]); o.y = pk2(s[2 * 33], s[3 * 33]); o.z = pk2(s[4 * 33], s[5 * 33]); o.w = pk2(s[6 * 33], s[7 * 33]);
        *(GAS v4u*)(WT + (size_t)(n0 + n) * K + k0 + 8 * c) = o; }
    LDS_WAIT(); asm volatile("" ::: "memory");
}

#ifndef ATT_MLA_MODE
#define ATT_MLA_MODE 2
#endif
#ifndef ATT_GQA_MODE
#define ATT_GQA_MODE 2
#endif
#ifndef P5_WGM
#define P5_WGM 8
#endif
#ifndef P1_WGM
#define P1_WGM 4
#endif
#ifndef P8_WGM
#define P8_WGM 4
#endif
#ifndef SPLIT_WGM
#define SPLIT_WGM 2
#endif
struct Args { const float* in[25]; float* out; unsigned char* ws; int multi, l_lo, l_hi, ph, pad0, pad1; };
enum { PH_PRE = -1, PH_POST = 10, PH_DUMP = 11 };

struct __attribute__((packed, aligned(4))) F3 { float x, y, z; };
#define PHASE_BEGIN \
    const __attribute__((address_space(4))) Args* ap = (const __attribute__((address_space(4))) Args*)__builtin_amdgcn_kernarg_segment_ptr(); asm volatile("" : "+s"(ap)); \
    unsigned char* ws = ap->ws; \
    int tid = threadIdx.x; asm volatile("" : "+v"(tid)); const int lane = tid & 63, wave = __builtin_amdgcn_readfirstlane(tid >> 6); \
    const int gw = vcu * NWAVES + wave, NGW = G * NWAVES; (void)gw; (void)NGW; (void)lane; \
    const float* in_x = ap->in[0]; const float* in_c = ap->in[1]; const float* in_ctx = ap->in[2]; const float* in_cctx = ap->in[3]; const float* w_ada = ap->in[4]; const float* b_ada = ap->in[5]; const float* g_mix = ap->in[6]; const float* w_in = ap->in[7]; const float* conv_w = ap->in[8]; const float* conv_b = ap->in[9]; const float* conv_ln_g = ap->in[10]; const float* conv_ln_b = ap->in[11]; const float* w_conv_out = ap->in[12]; const float* g_q_a = ap->in[13]; const float* w_q_up = ap->in[14]; const float* g_kv_a = ap->in[15]; const float* w_kv_up = ap->in[16]; const float* w_mla_out = ap->in[17]; const float* gqa_sink = ap->in[18]; const float* w_gqa_out = ap->in[19]; const float* w_out = ap->in[20]; const float* g_ffn = ap->in[21]; const float* w_ffn_in = ap->in[22]; const float* w_ffn_out = ap->in[23]; const float* g_final = ap->in[24]; float* XL = ap->out; bf16* XB = (bf16*)(ws + WS_XB); bf16* XCB = (bf16*)(ws + WS_XC); (void)XL; (void)XCB; float* MOD = (float*)(ws + WS_MOD); float* ROPE = (float*)(ws + WS_ROPE); float* XC = (float*)(ws + WS_XC); bf16* Win_t = (bf16*)(ws + WS_W + WO_IN); bf16* Wq_t = (bf16*)(ws + WS_W + WO_Q); bf16* Wkv_t = (bf16*)(ws + WS_W + WO_KV); bf16* Wc_t = (bf16*)(ws + WS_W + WO_C); bf16* Wm_t = (bf16*)(ws + WS_W + WO_M); bf16* Wg_t = (bf16*)(ws + WS_W + WO_G); bf16* Wo_t = (bf16*)(ws + WS_W + WO_O); bf16* Wf1_t = (bf16*)(ws + WS_W + WO_F1); bf16* Wf2_t = (bf16*)(ws + WS_W + WO_F2); unsigned char* Gb = (unsigned char*)(ws + WS_A); bf16* HID = (bf16*)(ws + WS_A); bf16* Hb = (bf16*)(ws + WS_B); bf16* MQ = (bf16*)(ws + WS_B); bf16* Yb = (bf16*)(ws + WS_B); bf16* CQ = (bf16*)(ws + WS_C); bf16* PART = (bf16*)(ws + WS_C); bf16* OM = (bf16*)(ws + WS_C); bf16* OG = (bf16*)(ws + WS_C + (size_t)MT * 1024 * 2); bf16* KF = (bf16*)(ws + WS_D + WD_KF); bf16* Vb = (bf16*)(ws + WS_D + WD_V); bf16* GQ = (bf16*)(ws + WS_D + WD_GQ); bf16* GK = (bf16*)(ws + WS_D + WD_GK); bf16* GV = (bf16*)(ws + WS_D + WD_GV); bf16* Ub = (bf16*)(ws + WS_D + WD_U); bf16* YF = (bf16*)(ws + WS_D); bf16* UC = (bf16*)(ws + WS_E + WE_UC); bf16* CKVn = (bf16*)(ws + WS_E + WE_CKV); bf16* QAn = (bf16*)(ws + WS_E + WE_QA); \
    const float* modl = MOD + (size_t)l_cur * 9 * NMOD; (void)modl;
__global__ void __launch_bounds__(NWAVES * 64, 2) mega_fwd(Args args) {
    extern __shared__ __attribute__((aligned(16))) unsigned char lds_raw[];
    LAS unsigned char* lds = (LAS unsigned char*)lds_raw;
    volatile LAS unsigned* MISC = (volatile LAS unsigned*)(lds + MISC_OFF);
    const int tid0 = threadIdx.x;
    const int G = gridDim.x; const int bx = blockIdx.x; const int vcu = (G % 8 == 0) ? (bx % 8) * (G / 8) + bx / 8 : bx;
    gu32* ctl = (gu32*)(args.ws + WS_CTL);
    int l_cur = 0;
    for (int u = tid0; u < (LDS_BYTES - LDSCTL_OFF) / 4; u += NWAVES * 64) ((LAS unsigned*)(lds + LDSCTL_OFF))[u] = 0u;
    __syncthreads();
    XcdBarrier bar = xcd_barrier_post((unsigned*)(ctl + CW_BAR), MISC + 8);
    const int multi = args.multi, ph = args.ph;
#ifndef PHASE_MASK
#define PHASE_MASK 0x1fff
#endif
#define RUN(k) ((((PHASE_MASK) >> ((k) + 1)) & 1) && (!multi || ph == (k)))
#define GRID_BAR() do { if (!multi) xcd_barrier(bar); } while (0)

    if (RUN(PH_PRE)) { PHASE_BEGIN
        LAS float* sil = (LAS float*)(lds + RING_OFF);
        LAS float* red = (LAS float*)(lds + RING_OFF + 9 * DM * 4);
        for (int i = tid; i < 9 * DM; i += NWAVES * 64) { const float v = i < 8 * DM ? in_c[i] : in_cctx[i - 8 * DM]; sil[(i & (DM - 1)) * 9 + (i >> 11)] = v * sigmf(v); }
        __syncthreads();
#define ADA_LOAD(W_, I0) do { _Pragma("unroll") for (int u = 0; u < 8; ++u) W_[u] = *(const F3*)(Wl + (size_t)((I0) + u) * 8 * NMOD); } while (0)
#define ADA_FMA(W_, I0) do { _Pragma("unroll") for (int u = 0; u < 8; ++u) { const LAS float* sp = sil + (((I0) + u) * 8 + wave) * 9; \
            _Pragma("unroll") for (int v = 0; v < 9; ++v) { const float sv = sp[v]; acc[v][0] += W_[u].x * sv; acc[v][1] += W_[u].y * sv; acc[v][2] += W_[u].z * sv; } asm volatile("" ::: "memory"); } } while (0)
        for (int s = vcu; s < DEPTH * 64; s += G) {
            const int l = s >> 6, col0 = (s & 63) * 192;
            const float* Wl = w_ada + (size_t)l * DM * NMOD + (size_t)wave * NMOD + col0 + 3 * lane;
            float acc[9][3];
#pragma unroll
            for (int v = 0; v < 9; ++v) { acc[v][0] = 0.f; acc[v][1] = 0.f; acc[v][2] = 0.f; }
            F3 wa[8], wb[8];
            ADA_LOAD(wa, 0);
#pragma nounroll
            for (int i = 0; i < DM / 8; i += 16) {
                ADA_LOAD(wb, i + 8);
                ADA_FMA(wa, i);
                { const int in_ = (i + 16 < DM / 8) ? i + 16 : 0; ADA_LOAD(wa, in_); }
                ADA_FMA(wb, i + 8);
            }
#pragma unroll
            for (int v = 0; v < 9; ++v) {
#pragma unroll
                for (int e = 0; e < 3; ++e) red[(wave * 9 + v) * 192 + 3 * lane + e] = acc[v][e]; }
            __syncthreads();
            for (int i = tid; i < 9 * 192; i += NWAVES * 64) { const int v = i / 192, cc = i - v * 192; float t = 0.f;
#pragma unroll
                for (int w8 = 0; w8 < 8; ++w8) t += red[(w8 * 9 + v) * 192 + cc];
                MOD[((size_t)l * 9 + v) * NMOD + col0 + cc] = t + b_ada[(size_t)l * NMOD + col0 + cc]; }
            __syncthreads();
        }
        { bf16* XB = (bf16*)(ws + WS_XB);
          for (size_t i = ((size_t)gw * 64 + lane) * 8; i < (size_t)ML * DM; i += (size_t)NGW * 64 * 8) { const f32x4 a = *(const f32x4*)(in_x + i), b = *(const f32x4*)(in_x + i + 4);
              v4u w; w.x = pk2(a[0], a[1]); w.y = pk2(a[2], a[3]); w.z = pk2(b[0], b[1]); w.w = pk2(b[2], b[3]); *(v4u*)(XB + i) = w; }
          bf16* XCB = (bf16*)(ws + WS_XC);
          for (size_t i = ((size_t)gw * 64 + lane) * 8; i < (size_t)MC * DM; i += (size_t)NGW * 64 * 8) { const f32x4 a = *(const f32x4*)(in_ctx + i), b = *(const f32x4*)(in_ctx + i + 4);
              v4u w; w.x = pk2(a[0], a[1]); w.y = pk2(a[2], a[3]); w.z = pk2(b[0], b[1]); w.w = pk2(b[2], b[3]); *(v4u*)(XCB + i) = w; } }
        { const int i = bx * (NWAVES * 64) + tid; if (i < 64 * 16) { const int p = i >> 4, f = i & 15; const float invf = powf(10000.0f, -(float)f / 16.0f), a = (float)p * invf;
              ROPE[2 * i] = cosf(a); ROPE[2 * i + 1] = sinf(a); } }
    }
    GRID_BAR();

    for (int l = args.l_lo; l < args.l_hi; ++l) {
        l_cur = l;
        const bool lastl = (l == DEPTH - 1); const int Mg = lastl ? ML : MT;
        if (RUN(0)) { PHASE_BEGIN
            LAS float* scr = (LAS float*)(lds + RING_OFF + wave * 16384);
            constexpr int I_IN = (DM / 64) * (NINP / 32), I_Q = (512 / 64) * (1536 / 32), I_KV = (256 / 64) * (2048 / 32), I_C = (512 / 64) * (DM / 32), I_M = (1024 / 64) * (DM / 32),
                          I_G = (512 / 64) * (DM / 32), I_O = (DM / 64) * (DM / 32), I_F1 = (DM / 64) * (2 * DFF / 32), I_F2 = (DFF / 64) * (DM / 32);
            constexpr int NITEMS = I_IN + I_Q + I_KV + I_C + I_M + I_G + I_O + I_F1 + I_F2;
            for (int it = gw; it < NITEMS; it += NGW) {
                int r = it; const float* W; bf16* WT; int K, N, nblk, mode = 0;
                if (r < I_IN) { W = w_in + (size_t)l * DM * NIN; K = DM; N = NIN; WT = Win_t; nblk = NINP / 32; mode = 1; }
                else if ((r -= I_IN) < I_Q) { W = w_q_up + (size_t)l * 512 * 1536; K = 512; N = 1536; WT = Wq_t; nblk = 1536 / 32; mode = 3; }
                else if ((r -= I_Q) < I_KV) { W = w_kv_up + (size_t)l * 256 * 2048; K = 256; N = 2048; WT = Wkv_t; nblk = 2048 / 32; }
                else if ((r -= I_KV) < I_C) { W = w_conv_out + (size_t)l * 512 * DM; K = 512; N = DM; WT = Wc_t; nblk = DM / 32; }
                else if ((r -= I_C) < I_M) { W = w_mla_out + (size_t)l * 1024 * DM; K = 1024; N = DM; WT = Wm_t; nblk = DM / 32; }
                else if ((r -= I_M) < I_G) { W = w_gqa_out + (size_t)l * 512 * DM; K = 512; N = DM; WT = Wg_t; nblk = DM / 32; }
                else if ((r -= I_G) < I_O) { W = w_out + (size_t)l * DM * DM; K = DM; N = DM; WT = Wo_t; nblk = DM / 32; }
                else if ((r -= I_O) < I_F1) { W = w_ffn_in + (size_t)l * DM * 2 * DFF; K = DM; N = 2 * DFF; WT = Wf1_t; nblk = 2 * DFF / 32; mode = 2; }
                else { r -= I_F1; W = w_ffn_out + (size_t)l * DFF * DM; K = DFF; N = DM; WT = Wf2_t; nblk = DM / 32; }
                cvt_item(W, K, N, WT, scr, r, nblk, lane, mode);
            }
        }
#define NCOL(LN, S) (8 * (LN) + 512 * ((S) >> 1) + 4 * ((S) & 1))
#define NORM_UNPK(T, V, J) do { V[2 * (J)] = (f32x4){bflo(T.x), bfhi(T.x), bflo(T.y), bfhi(T.y)}; V[2 * (J) + 1] = (f32x4){bflo(T.z), bfhi(T.z), bflo(T.w), bfhi(T.w)}; } while (0)
#define NORM_LDMOD(SEL, GVEC, SHOFF, SCOFF) do { const float* mp = modl + (size_t)(SEL) * NMOD; \
                _Pragma("unroll") for (int j = 0; j < 8; ++j) { const int c = NCOL(ln_, j); const f32x4 g = *(const f32x4*)((GVEC) + c), sc = *(const f32x4*)(mp + (SCOFF) + c); \
                    Aa[j] = g * (sc + 1.0f); Ss[j] = *(const f32x4*)(mp + (SHOFF) + c); } } while (0)
#define NORM_FINISH(R) do { float ss = 0.f; \
                _Pragma("unroll") for (int j = 0; j < 8; ++j) ss += (v[j][0] * v[j][0] + v[j][1] * v[j][1]) + (v[j][2] * v[j][2] + v[j][3] * v[j][3]); \
                const float rstd = 1.0f / sqrtf(wave_sum(ss) * (1.0f / DM) + EPS); \
                bf16* hp = Hb + (size_t)(R) * DM + 8 * ln_; \
                _Pragma("unroll") for (int j = 0; j < 4; ++j) { const f32x4 y0 = v[2 * j] * rstd * Aa[2 * j] + Ss[2 * j], y1 = v[2 * j + 1] * rstd * Aa[2 * j + 1] + Ss[2 * j + 1]; \
                    v4u w; w.x = pk2(y0[0], y0[1]); w.y = pk2(y0[2], y0[3]); w.z = pk2(y1[0], y1[1]); w.w = pk2(y1[2], y1[3]); *(v4u*)(hp + 512 * j) = w; } } while (0)
#define NORM_ROWS(GVEC, SHOFF, SCOFF, FIRST, WITHCTX, PARTG) do { \
            int ln_ = lane; asm volatile("" : "+v"(ln_)); \
            f32x4 Aa[8], Ss[8]; \
            _Pragma("unroll") for (int j = 0; j < 8; ++j) { Aa[j] = (f32x4){0.f, 0.f, 0.f, 0.f}; Ss[j] = (f32x4){0.f, 0.f, 0.f, 0.f}; } \
            for (int gv_ = gw; gv_ < 2048; gv_ += NGW) { \
                NORM_LDMOD((gv_ * 16) >> 12, GVEC, SHOFF, SCOFF);                                   \
                _Pragma("nounroll") for (int ri = 0; ri < 16; ++ri) { int r = gv_ * 16 + ri; asm volatile("" : "+s"(r)); \
                    const bf16* sb_ = XB + (size_t)r * DM + 8 * ln_; f32x4 v[8]; \
                    _Pragma("unroll") for (int j = 0; j < 4; ++j) { const v4u t_ = *(const v4u*)(sb_ + 512 * j); NORM_UNPK(t_, v, j); } \
                    NORM_FINISH(r); } \
                if (WITHCTX) { NORM_LDMOD(8, GVEC, SHOFF, SCOFF); int rc = gv_; asm volatile("" : "+s"(rc));     \
                    bf16* sb_ = XCB + (size_t)rc * DM + 8 * ln_; f32x4 v[8]; \
                    _Pragma("unroll") for (int j = 0; j < 4; ++j) { const v4u t_ = *(const v4u*)(sb_ + 512 * j); NORM_UNPK(t_, v, j); } \
                    if ((PARTG) != nullptr) { const bf16* pp = PART + (size_t)rc * DM + 8 * ln_; \
                        _Pragma("unroll") for (int j = 0; j < 4; ++j) { f32x4 pa_[8]; \
                            { const v4u q_ = *(const v4u*)(pp + 512 * j); NORM_UNPK(q_, pa_, 0); } { const v4u q_ = *(const v4u*)(pp + (size_t)2048 * DM + 512 * j); NORM_UNPK(q_, pa_, 1); } \
                            { const v4u q_ = *(const v4u*)(pp + (size_t)2 * 2048 * DM + 512 * j); NORM_UNPK(q_, pa_, 2); } { const v4u q_ = *(const v4u*)(pp + (size_t)3 * 2048 * DM + 512 * j); NORM_UNPK(q_, pa_, 3); } \
                            v[2 * j] += *(const f32x4*)((PARTG) + NCOL(ln_, 2 * j)) * ((pa_[0] + pa_[2]) + (pa_[4] + pa_[6])); \
                            v[2 * j + 1] += *(const f32x4*)((PARTG) + NCOL(ln_, 2 * j + 1)) * ((pa_[1] + pa_[3]) + (pa_[5] + pa_[7])); } \
                        _Pragma("unroll") for (int j = 0; j < 4; ++j) { v4u w_; w_.x = pk2(v[2 * j][0], v[2 * j][1]); w_.y = pk2(v[2 * j][2], v[2 * j][3]); w_.z = pk2(v[2 * j + 1][0], v[2 * j + 1][1]); w_.w = pk2(v[2 * j + 1][2], v[2 * j + 1][3]); \
                            *(v4u*)(sb_ + 512 * j) = w_; } } \
                    NORM_FINISH(ML + rc); } } \
        } while (0)
        if (RUN(0)) { PHASE_BEGIN const float* gv = g_mix + (size_t)l * DM; const int first = (l == 0) ? 1 : 0;
            const float* pg = first ? nullptr : (MOD + ((size_t)(l - 1) * 9 + 8) * NMOD + 5 * DM);
            NORM_ROWS(gv, 0, DM, first, true, pg); }
        GRID_BAR();

        if (RUN(1)) { PHASE_BEGIN
            const bf16* A_ = Hb; const bf16* B_ = Win_t; asm volatile("" : "+s"(A_), "+s"(B_)); pg8::Gemm g{A_, B_, MT, NINP, DM}; pg8::StaticOrder S; S.init(Mg, NINP, G, bx); S.wgm = P1_WGM; if (lastl) S.set_extra(24, ML / 256, 24, 3);
            pg8::EpiWin E{Gb, CQ, KF, GK, GV, GQ, Ub, ROPE};
            pg8::gemm_phase<pg8::EpiWin, pg8::StaticOrder, true, true>(lds + RING_OFF, g, S, E);
        }
        GRID_BAR();

        if (RUN(2)) { PHASE_BEGIN
            LAS float* cw = (LAS float*)(lds + RING_OFF);
            for (int i = tid; i < 31 * 512; i += NWAVES * 64) cw[i] = conv_w[(size_t)l * 31 * 512 + i];
            __syncthreads();
            { const f32x4 gk = *(const f32x4*)(g_kv_a + (size_t)l * 256 + 4 * lane), gq0 = *(const f32x4*)(g_q_a + (size_t)l * 512 + 4 * lane), gq1 = *(const f32x4*)(g_q_a + (size_t)l * 512 + 256 + 4 * lane);
              for (int r0 = gw; r0 < MT; r0 += 2 * NGW) { const int r1 = (r0 + NGW < MT) ? r0 + NGW : r0;
                const bf16* p = CQ + (size_t)r0 * 768 + 4 * lane; const bf16* q = CQ + (size_t)r1 * 768 + 4 * lane;
#define LD4(P) ({ const v2u t_ = *(const v2u*)(P); (f32x4){bflo(t_.x), bfhi(t_.x), bflo(t_.y), bfhi(t_.y)}; })
                const f32x4 a = LD4(p), b0 = LD4(p + 256), b1 = LD4(p + 512), c = LD4(q), d0 = LD4(q + 256), d1 = LD4(q + 512);
#undef LD4
#define LR_ROW(R, A_, B0_, B1_) do { \
                const float sa = wave_sum((A_[0] * A_[0] + A_[1] * A_[1]) + (A_[2] * A_[2] + A_[3] * A_[3])); \
                const float sb = wave_sum(((B0_[0] * B0_[0] + B0_[1] * B0_[1]) + (B0_[2] * B0_[2] + B0_[3] * B0_[3])) + ((B1_[0] * B1_[0] + B1_[1] * B1_[1]) + (B1_[2] * B1_[2] + B1_[3] * B1_[3]))); \
                const float ra = 1.0f / sqrtf(sa * (1.0f / 256.0f) + EPS), rb = 1.0f / sqrtf(sb * (1.0f / 512.0f) + EPS); \
                const f32x4 ya = A_ * ra * gk, y0 = B0_ * rb * gq0, y1 = B1_ * rb * gq1; \
                v2u w; w.x = pk2(ya[0], ya[1]); w.y = pk2(ya[2], ya[3]); *(v2u*)(CKVn + (size_t)(R) * 256 + 4 * lane) = w; \
                w.x = pk2(y0[0], y0[1]); w.y = pk2(y0[2], y0[3]); *(v2u*)(QAn + (size_t)(R) * 512 + 4 * lane) = w; \
                w.x = pk2(y1[0], y1[1]); w.y = pk2(y1[2], y1[3]); *(v2u*)(QAn + (size_t)(R) * 512 + 256 + 4 * lane) = w; } while (0)
                LR_ROW(r0, a, b0, b1); LR_ROW(r1, c, d0, d1);
#undef LR_ROW
              } }
            { const int ch = 8 * lane;
              const f32x4 cb0 = *(const f32x4*)(conv_b + (size_t)l * 512 + ch), cb1 = *(const f32x4*)(conv_b + (size_t)l * 512 + ch + 4);
              const f32x4 lg0 = *(const f32x4*)(conv_ln_g + (size_t)l * 512 + ch), lg1 = *(const f32x4*)(conv_ln_g + (size_t)l * 512 + ch + 4);
              const f32x4 lb0 = *(const f32x4*)(conv_ln_b + (size_t)l * 512 + ch), lb1 = *(const f32x4*)(conv_ln_b + (size_t)l * 512 + ch + 4);
              for (int tok = gw; tok < Mg; tok += NGW) {
                int sb, pos, L; if (tok < ML) { sb = tok & ~4095; pos = tok & 4095; L = SEQ; } else { const int c = tok - ML; sb = ML + (c & ~255); pos = c & 255; L = CTXL; }
                f32x4 a0 = cb0, a1 = cb1;
                v4u xr[31];
                if (pos >= 15 && pos < L - 15) {
                    const bf16* up = Ub + (size_t)(sb + pos - 15) * 512 + ch;
#pragma unroll
                    for (int j = 0; j < 31; ++j) xr[j] = *(const v4u*)(up + (size_t)j * 512);
                    asm volatile("" ::: "memory");
#pragma unroll
                    for (int j = 0; j < 31; ++j) { const v4u x = xr[j];
                        const f32x4 w0 = *(const LAS f32x4*)(cw + j * 512 + ch), w1 = *(const LAS f32x4*)(cw + j * 512 + ch + 4);
                        const f32x4 x0 = {bflo(x.x), bfhi(x.x), bflo(x.y), bfhi(x.y)}, x1 = {bflo(x.z), bfhi(x.z), bflo(x.w), bfhi(x.w)};
                        a0 += w0 * x0; a1 += w1 * x1; if ((j & 3) == 3) asm volatile("" ::: "memory"); }
                } else {
#pragma unroll
                    for (int j = 0; j < 31; ++j) { int p = pos + j - 15; p = p < 0 ? 0 : (p >= L ? L - 1 : p); xr[j] = *(const v4u*)(Ub + (size_t)(sb + p) * 512 + ch); }
                    asm volatile("" ::: "memory");
#pragma unroll
                    for (int j = 0; j < 31; ++j) { const int p = pos + j - 15; const float ok = (p >= 0 && p < L) ? 1.0f : 0.0f; const v4u x = xr[j];
                        const f32x4 w0 = *(const LAS f32x4*)(cw + j * 512 + ch) * ok, w1 = *(const LAS f32x4*)(cw + j * 512 + ch + 4) * ok;
                        const f32x4 x0 = {bflo(x.x), bfhi(x.x), bflo(x.y), bfhi(x.y)}, x1 = {bflo(x.z), bfhi(x.z), bflo(x.w), bfhi(x.w)};
                        a0 += w0 * x0; a1 += w1 * x1; if ((j & 3) == 3) asm volatile("" ::: "memory"); }
                }
                const float mean = wave_sum((a0[0] + a0[1]) + (a0[2] + a0[3]) + (a1[0] + a1[1]) + (a1[2] + a1[3])) * (1.0f / 512.0f);
                const f32x4 d0 = a0 - mean, d1 = a1 - mean;
                const float var = wave_sum((d0[0] * d0[0] + d0[1] * d0[1]) + (d0[2] * d0[2] + d0[3] * d0[3]) + (d1[0] * d1[0] + d1[1] * d1[1]) + (d1[2] * d1[2] + d1[3] * d1[3])) * (1.0f / 512.0f);
                const float rstd = 1.0f / sqrtf(var + EPS);
                const f32x4 y0 = d0 * rstd * lg0 + lb0, y1 = d1 * rstd * lg1 + lb1;
                v4u w; w.x = pk2(y0[0] * sigmf(y0[0]), y0[1] * sigmf(y0[1])); w.y = pk2(y0[2] * sigmf(y0[2]), y0[3] * sigmf(y0[3]));
                w.z = pk2(y1[0] * sigmf(y1[0]), y1[1] * sigmf(y1[1])); w.w = pk2(y1[2] * sigmf(y1[2]), y1[3] * sigmf(y1[3]));
                *(v4u*)(UC + (size_t)tok * 512 + ch) = w; } }
        }
        GRID_BAR();

        if (RUN(3)) { PHASE_BEGIN
            const bf16* A0_ = QAn; const bf16* B0_ = Wq_t; const bf16* A1_ = CKVn; const bf16* B1_ = Wkv_t; asm volatile("" : "+s"(A0_), "+s"(B0_), "+s"(A1_), "+s"(B1_));
            pg8::SchedQKV S; S.nMq = Mg / 256; S.nNq = 1536 / 256; S.nMk = MT / 256; S.nNk = 2048 / 256; S.G = G; S.c = bx; S.Aq = A0_; S.Bq = B0_; S.Ak = A1_; S.Bk = B1_;
            pg8::EpiQKV E{pg8::EpiQup{MQ, ROPE}, pg8::EpiKV{KF, Vb}};
            pg8::gemm_stream<pg8::EpiQKV, pg8::SchedQKV>(lds + RING_OFF, S, E);
        }
        GRID_BAR();

        if (RUN(4)) { PHASE_BEGIN
            att::lchar* alds = (att::lchar*)(lds + RING_OFF);
            for (int u = vcu; u < 1024 + (lastl ? 0 : 64); u += G) {
                int b, h, q0row, NT;
                if (u < 1024) { const int bh = u >> 4, qb = u & 15; b = bh >> 3; h = bh & 7; q0row = b * SEQ + qb * 256; NT = 4 + SEQ / 64; }
                else { const int bh = u - 1024; b = bh >> 3; h = bh & 7; q0row = ML + b * CTXL; NT = 4; }
                att::attn_unit<192, 128, false, false, ATT_MLA_MODE>(MQ + (size_t)q0row * 1536 + h * 192, 1536, KF + h * 192, 1536, Vb + h * 128, 1024, OM + (size_t)q0row * 1024 + h * 128, 1024,
                                                       ML + b * CTXL, b * SEQ, NT, 0, 0, 0.f, alds);
            }
            for (int u = vcu; u < 1024 + (lastl ? 0 : 128); u += G) {
                int b, h, q0row, NT, qpos0, kpos0;
                if (u >= 1024 && u < 1088) continue;
                if (u < 1024) { const int bh = u >> 4, qb = u & 15; b = bh >> 3; h = bh & 7; q0row = b * SEQ + qb * 256; qpos0 = qb * 256;
                    const int klo = qpos0 - 128 < 0 ? 0 : qpos0 - 128, khi = qpos0 + 384 > SEQ ? SEQ : qpos0 + 384; kpos0 = klo; NT = 4 + (khi - klo) / 64; }
                else { const int bh = u - 1088; b = bh >> 3; h = bh & 7; q0row = ML + b * CTXL; NT = 4; qpos0 = 0; kpos0 = 0; }
                const float sk = gqa_sink[l * 8 + h] * 1.4426950408889634f;
                att::attn_unit<64, 64, true, true, ATT_GQA_MODE>(GQ + (size_t)q0row * 512 + h * 64, 512, GK + (h >> 2) * 64, 128, GV + (h >> 2) * 64, 128, OG + (size_t)q0row * 512 + h * 64, 512,
                                                   ML + b * CTXL, b * SEQ + kpos0, NT, qpos0, kpos0, sk, alds);
            }
            __syncthreads();
        }
        GRID_BAR();

        if (RUN(5)) { PHASE_BEGIN
            pg8::SchedMerge S; S.base.init(Mg, DM, G, bx); S.base.wgm = P5_WGM;
            { const bf16* a0_ = UC; const bf16* a1_ = OM; const bf16* a2_ = OG; const bf16* b0_ = Wc_t; const bf16* b1_ = Wm_t; const bf16* b2_ = Wg_t; asm volatile("" : "+s"(a0_), "+s"(a1_), "+s"(a2_), "+s"(b0_), "+s"(b1_), "+s"(b2_));
              S.a0 = (const char*)a0_; S.da1 = (const char*)a1_ - (const char*)a0_; S.da2 = (const char*)a2_ - (const char*)a1_; S.b0 = (const char*)b0_; S.db1 = (const char*)b1_ - (const char*)b0_; S.db2 = (const char*)b2_ - (const char*)b1_; }
            pg8::EpiChain E{Gb, Yb};
            pg8::gemm_stream<pg8::EpiChain, pg8::SchedMerge, true>(lds + RING_OFF, S, E);
        }
        GRID_BAR();

        if (RUN(6)) { PHASE_BEGIN
            const bf16* A_ = Yb; const bf16* B_ = Wo_t; asm volatile("" : "+s"(A_), "+s"(B_));
            pg8::SchedSplit S; S.A = A_; S.Bt = B_; S.K = DM; S.nlat = 1024; S.nctx = lastl ? 0 : 256; S.G = G; S.c = bx; S.wgm = SPLIT_WGM;
            pg8::EpiSplit E{pg8::EpiResid{XB, modl, 2 * DM}, PART};
            pg8::gemm_stream<pg8::EpiSplit, pg8::SchedSplit>(lds + RING_OFF, S, E);
        }
        GRID_BAR();

        if (RUN(7)) { PHASE_BEGIN const float* gv = g_ffn + (size_t)l * DM; const float* pg = lastl ? nullptr : (modl + (size_t)8 * NMOD + 2 * DM);
            const int first = (l == 0) ? 2 : 0; NORM_ROWS(gv, 3 * DM, 4 * DM, first, !lastl, pg); }
        GRID_BAR();

        if (RUN(8)) { PHASE_BEGIN
            const bf16* A_ = Hb; const bf16* B_ = Wf1_t; asm volatile("" : "+s"(A_), "+s"(B_)); pg8::Gemm g{A_, B_, MT, 2 * DFF, DM}; pg8::StaticOrder S; S.init(Mg, 2 * DFF, G, bx); S.wgm = P8_WGM; pg8::EpiSwiGLU E{HID};
            pg8::gemm_phase<pg8::EpiSwiGLU, pg8::StaticOrder, true, true>(lds + RING_OFF, g, S, E);
        }
        GRID_BAR();

        if (RUN(9)) { PHASE_BEGIN
            const bf16* A_ = HID; const bf16* B_ = Wf2_t; asm volatile("" : "+s"(A_), "+s"(B_));
            pg8::SchedSplit S; S.A = A_; S.Bt = B_; S.K = DFF; S.nlat = 1024; S.nctx = lastl ? 0 : 256; S.G = G; S.c = bx; S.wgm = SPLIT_WGM;
            pg8::EpiSplit E{pg8::EpiResid{XB, modl, 5 * DM}, PART};
            pg8::gemm_stream<pg8::EpiSplit, pg8::SchedSplit>(lds + RING_OFF, S, E);
        }
        GRID_BAR();
    }

    if (RUN(PH_POST)) { PHASE_BEGIN
        f32x4 gf[8];
#pragma unroll
        for (int j = 0; j < 8; ++j) gf[j] = *(const f32x4*)(g_final + NCOL(lane, j));
        for (int r = gw; r < ML; r += NGW) { float* p = XL + (size_t)r * DM; const bf16* sb = XB + (size_t)r * DM + 8 * lane; f32x4 v[8]; float ss = 0.f;
#pragma unroll
            for (int j = 0; j < 4; ++j) { const v4u t_ = *(const v4u*)(sb + 512 * j); NORM_UNPK(t_, v, j); }
#pragma unroll
            for (int j = 0; j < 8; ++j) ss += (v[j][0] * v[j][0] + v[j][1] * v[j][1]) + (v[j][2] * v[j][2] + v[j][3] * v[j][3]);
            const float rstd = 1.0f / sqrtf(wave_sum(ss) * (1.0f / DM) + EPS);
#pragma unroll
            for (int j = 0; j < 8; ++j) *(f32x4*)(p + NCOL(lane, j)) = v[j] * rstd * gf[j]; }
    }

#if defined(DBG_STAGE)
    if (RUN(PH_DUMP)) { PHASE_BEGIN
        const int sel = ap->pad0; const size_t total = (size_t)G * NWAVES * 64, gt = (size_t)bx * NWAVES * 64 + tid;
        for (size_t i = gt; i < (size_t)ML * DM; i += total) { float v = 0.f;
#define DB16(bit, P, N) if (sel & (bit)) v += __uint_as_float((unsigned)(P)[i % (size_t)(N)] << 16)
            if (sel & 1) v += MOD[i % (size_t)(DEPTH * 9 * NMOD)];
            DB16(2, Hb, (size_t)MT * 2048); DB16(4, Gb, (size_t)MT * 6144); DB16(8, KF, (size_t)MT * 1536); DB16(16, Vb, (size_t)MT * 1024); DB16(32, GQ, (size_t)MT * 512);
            DB16(64, UC, (size_t)MT * 512); DB16(128, MQ, (size_t)MT * 1536); DB16(256, OM, (size_t)MT * 1024); DB16(512, OG, (size_t)MT * 512); DB16(1024, Yb, (size_t)MT * 2048);
            DB16(2048, Win_t, (size_t)NINP * 2048); DB16(4096, GK, (size_t)MT * 128); DB16(8192, GV, (size_t)MT * 128); DB16(16384, CKVn, (size_t)MT * 256); DB16(32768, QAn, (size_t)MT * 512);
            DB16(65536, Ub, (size_t)MT * 512); DB16(131072, Wf1_t, (size_t)2 * DFF * DM); DB16(262144, Wf2_t, (size_t)DM * DFF); DB16(524288, HID, (size_t)MT * DFF);
            if (sel & 1048576) v += CQ[i % ((size_t)MT * 768)];
            XL[i] = v; }
    }
#endif
#undef RUN
#undef GRID_BAR
#undef NORM_ROWS
}

#ifndef MK_MULTI
#define MK_MULTI 0
#endif
extern "C" void kernel_launch(void* const* d_in, const int* in_sizes, int n_in, void* d_out, int out_size, void* d_ws, size_t ws_size, hipStream_t stream) {
    static int grid = 0;
    if (grid == 0) {
        if (n_in != 25 || in_sizes[0] != ML * DM || out_size != ML * DM || ws_size < WS_END) {
            fprintf(stderr, "kernel_launch: shape mismatch: n_in %d in0 %d out %d ws %zu (need %zu)\n", n_in, n_in > 0 ? in_sizes[0] : -1, out_size, ws_size, (size_t)WS_END); grid = -1; return; }
        int dev = 0, cus = 0, per_cu = 0;
        if (hipGetDevice(&dev) != hipSuccess || hipDeviceGetAttribute(&cus, hipDeviceAttributeMultiprocessorCount, dev) != hipSuccess) { grid = -1; return; }
        if (hipFuncSetAttribute((const void*)mega_fwd, hipFuncAttributeMaxDynamicSharedMemorySize, LDS_BYTES) != hipSuccess) { fprintf(stderr, "kernel_launch: hipFuncSetAttribute failed\n"); grid = -1; return; }
        if (hipOccupancyMaxActiveBlocksPerMultiprocessor(&per_cu, (const void*)mega_fwd, NWAVES * 64, LDS_BYTES) != hipSuccess || per_cu < 1)
            fprintf(stderr, "kernel_launch: note: occupancy query reports %d workgroups per CU\n", per_cu);
        (void)hipGetLastError();
        grid = cus;
    }
    if (grid < 0) return;
    if (hipMemsetAsync((char*)d_ws + WS_CTL, 0, CTL_ZERO_BYTES, stream) != hipSuccess) return;
    Args a{};
    for (int i = 0; i < 25; ++i) a.in[i] = (const float*)d_in[i];
    a.out = (float*)d_out; a.ws = (unsigned char*)d_ws;
#if defined(DBG_STAGE)
    a.multi = 1;
    a.l_lo = 0; a.l_hi = 0; a.ph = PH_PRE; hipLaunchKernelGGL(mega_fwd, dim3(grid), dim3(NWAVES * 64), LDS_BYTES, stream, a);
    for (int p = 0; p <= DBG_STAGE; ++p) { a.l_lo = 0; a.l_hi = 1; a.ph = p; hipLaunchKernelGGL(mega_fwd, dim3(grid), dim3(NWAVES * 64), LDS_BYTES, stream, a); }
    a.l_lo = 0; a.l_hi = 0; a.ph = PH_DUMP; a.pad0 = DBG_SEL; hipLaunchKernelGGL(mega_fwd, dim3(grid), dim3(NWAVES * 64), LDS_BYTES, stream, a);
#elif MK_MULTI
    a.multi = 1;
    a.l_lo = 0; a.l_hi = 0; a.ph = PH_PRE; hipLaunchKernelGGL(mega_fwd, dim3(grid), dim3(NWAVES * 64), LDS_BYTES, stream, a);
    for (int l = 0; l < DEPTH; ++l) for (int p = 0; p < 10; ++p) { a.l_lo = l; a.l_hi = l + 1; a.ph = p; hipLaunchKernelGGL(mega_fwd, dim3(grid), dim3(NWAVES * 64), LDS_BYTES, stream, a); }
    a.l_lo = 0; a.l_hi = 0; a.ph = PH_POST; hipLaunchKernelGGL(mega_fwd, dim3(grid), dim3(NWAVES * 64), LDS_BYTES, stream, a);
#else
    a.multi = 0; a.l_lo = 0; a.l_hi = DEPTH; a.ph = 0;
    hipLaunchKernelGGL(mega_fwd, dim3(grid), dim3(NWAVES * 64), LDS_BYTES, stream, a);
#endif
    const hipError_t le = hipPeekAtLastError();
    if (le != hipSuccess) fprintf(stderr, "kernel_launch: launch failed: %s\n", hipGetErrorName(le));
}
```

```cpp
#include <hip/hip_runtime.h>
#include <cstdio>
#include <cstdint>
#define GAS __attribute__((address_space(1)))
#define LAS __attribute__((address_space(3)))
namespace pg8 {
#define PG8_LAS __attribute__((address_space(3)))
typedef unsigned short bf16_t;
typedef short bf16x8 __attribute__((ext_vector_type(8)));
typedef float f32x4 __attribute__((ext_vector_type(4)));
typedef unsigned u32x4 __attribute__((ext_vector_type(4)));
constexpr int BM = 256, BK = 64, HALF = 128, HTB = HALF * BK * 2  , STAGE_BYTES = 8 * HTB, NXCD = 8, WGM = 8;

__host__ __device__ __forceinline__ int lds_byte(int r, int c) { const int st = (r >> 4) * 2 + (c >> 5), rr = r & 15, cc = c & 31, ob = rr * 64 + cc * 2; return st * 1024 + (ob ^ (((ob >> 9) & 1) << 5)); }
__host__ __device__ __forceinline__ void stage_rc(int b, int& R, int& C) { const int st = b / 1024, sb = b % 1024, swz = sb ^ (((sb >> 9) & 1) << 5); R = (st >> 1) * 16 + swz / 64; C = (st & 1) * 32 + (swz % 64) / 2; }
__host__ __device__ __forceinline__ int perm32(int rho) { const int n = rho >> 4, i = rho & 15; return 8 * (i >> 2) + 4 * n + (i & 3); }

struct Unit { int pm, pn; };
struct Gemm { const bf16_t* A; const bf16_t* Bt; int M, N, K; };

struct StaticOrder {
    int nM, nN, nwg, G, c, ext_n, ext_pm0, ext_pn0, ext_w, wgm, ext_c0;
    __host__ __device__ void init(int M, int N, int G_, int c_) { nM = M / BM; nN = N / BM; nwg = nM * nN; G = G_; c = c_; ext_n = 0; ext_pm0 = 0; ext_pn0 = 0; ext_w = 1; wgm = WGM; ext_c0 = 0; }
    __host__ __device__ void set_extra(int n, int pm0, int pn0, int w) { ext_n = n; ext_pm0 = pm0; ext_pn0 = pn0; ext_w = w; }
    __host__ __device__ bool next(int i, Unit& u) const {
        const long L = (long)i * G + c;
        if (L >= nwg) { const int e = (int)(L - nwg) - ext_c0; if (e < 0 || e >= ext_n) return false; u.pm = ext_pm0 + e / ext_w; u.pn = ext_pn0 + e % ext_w; return true; }
        int wgid = (int)L; { const int q = nwg / NXCD, r = nwg % NXCD, xcd = wgid % NXCD, off = wgid / NXCD; wgid = (xcd < r ? xcd * (q + 1) : r * (q + 1) + (xcd - r) * q) + off; }
        const int nig = wgm * nN, gid = wgid / nig, fm = gid * wgm, gsz = (nM - fm) < wgm ? (nM - fm) : wgm;
        u.pm = fm + ((wgid % nig) % gsz); u.pn = (wgid % nig) / gsz; return true;
    }
    static __host__ __device__ __forceinline__ void map_entry(int nM_, int nN_, int L, Unit& u, int WGM_ = WGM) {
        const int nwg_ = nM_ * nN_; int wgid = L; { const int q = nwg_ / NXCD, r = nwg_ % NXCD, xcd = wgid % NXCD, off = wgid / NXCD; wgid = (xcd < r ? xcd * (q + 1) : r * (q + 1) + (xcd - r) * q) + off; }
        const int nig = WGM_ * nN_, gid = wgid / nig, fm = gid * WGM_, gsz = (nM_ - fm) < WGM_ ? (nM_ - fm) : WGM_;
        u.pm = fm + ((wgid % nig) % gsz); u.pn = (wgid % nig) / gsz;
    }
    __device__ __forceinline__ void a_ready(const Unit&) const {}
    __device__ __forceinline__ void done(const Unit&) const {}
};
struct MergeOrder : StaticOrder {
    const unsigned* wflag; unsigned* tmo;
    __device__ __forceinline__ void a_ready(const Unit& u) const {
        if (wflag == nullptr || ext_n == 0 || u.pm < ext_pm0) return;
        if (threadIdx.x < 64) {
            const unsigned* f = wflag + (size_t)((u.pm - ext_pm0) * ext_w + (u.pn - ext_pn0)) * 16;
            const unsigned long long t0 = __builtin_amdgcn_s_memrealtime(); unsigned polls = 0;
            while ((unsigned)__builtin_amdgcn_readfirstlane(__hip_atomic_load(f, __ATOMIC_RELAXED, __HIP_MEMORY_SCOPE_AGENT)) == 0u) {
                if ((++polls & 255u) == 0u && __builtin_amdgcn_readfirstlane(__hip_atomic_load(tmo, __ATOMIC_RELAXED, __HIP_MEMORY_SCOPE_AGENT)) != 0u) break;
                if (__builtin_amdgcn_s_memrealtime() - t0 > 2000000ull) { if (threadIdx.x == 0) __hip_atomic_store(tmo, 1u, __ATOMIC_RELAXED, __HIP_MEMORY_SCOPE_AGENT); break; }
                __builtin_amdgcn_s_sleep(2); }
            __builtin_amdgcn_fence(__ATOMIC_ACQUIRE, "agent");
            asm volatile("s_waitcnt vmcnt(0)" ::: "memory");
        }
        asm volatile("" ::: "memory"); __builtin_amdgcn_s_barrier(); asm volatile("" ::: "memory");
    }
};
typedef float f32x2_t __attribute__((ext_vector_type(2))); typedef __bf16 bf16x2_t __attribute__((ext_vector_type(2)));
__device__ __forceinline__ unsigned cvt_pk_bf16(float lo, float hi) { f32x2_t v = {lo, hi}; bf16x2_t b = __builtin_convertvector(v, bf16x2_t); return __builtin_bit_cast(unsigned, b); }
typedef float f32x2 __attribute__((ext_vector_type(2)));
template <class Epi, class Sched, bool ALIGN_EPI = false, bool SP2 = false>
__device__ __forceinline__ void gemm_phase(PG8_LAS unsigned char* lds, const Gemm g, const Sched& S, const Epi& E) {
    int tid_ = threadIdx.x; asm volatile("" : "+v"(tid_));
    const int tid = tid_, wid = __builtin_amdgcn_readfirstlane(tid >> 6), lane = tid & 63, wr = wid >> 2, wc = wid & 3, fr = lane & 15, fq = lane >> 4;
    const int K = g.K, nt = K / BK;
    unsigned voffA[2], voffB[2];
#pragma unroll
    for (int i = 0; i < 2; ++i) { int R, C; stage_rc(tid * 16 + i * 8192, R, C); const int Rb = Epi::PERM ? ((R & ~31) + perm32(R & 31)) : R;
        voffA[i] = (unsigned)(R * K + C) * 2u; voffB[i] = (unsigned)(Rb * K + C) * 2u; }
    const size_t kstep = (size_t)(BK * 2);
    const size_t hstep = (size_t)HALF * K * 2;
    const size_t tstep = 2 * hstep;
    const unsigned ldsw = (unsigned)wid * 1024u;
    const int aoff = lds_byte(wr * 64 + fr, fq * 8), boff = lds_byte(wc * 32 + fr, fq * 8);
#define PG8_SA(b, h) (((b) * 2 + (h)) * HTB)
#define PG8_SB(b, h) ((4 + (b) * 2 + (h)) * HTB)
#define PG8_STAGE(bufoff, gbase, voff) do { _Pragma("unroll") for (int _i = 0; _i < 2; ++_i) \
        __builtin_amdgcn_global_load_lds((const unsigned*)((const char*)(gbase) + (voff)[_i]), (PG8_LAS unsigned*)(lds + (bufoff) + ldsw + _i * 8192), 16, 0, 0); } while (0)
#define PG8_LDA(dst, b, h) do { _Pragma("unroll") for (int m = 0; m < 4; ++m) _Pragma("unroll") for (int k = 0; k < 2; ++k) dst[m][k] = *(const PG8_LAS bf16x8*)(lds + PG8_SA(b, h) + aoff + m * 2048 + k * 1024); } while (0)
#define PG8_LDB(dst, b, h) do { _Pragma("unroll") for (int n = 0; n < 2; ++n) _Pragma("unroll") for (int k = 0; k < 2; ++k) dst[n][k] = *(const PG8_LAS bf16x8*)(lds + PG8_SB(b, h) + boff + n * 2048 + k * 1024); } while (0)
#define PG8_MMA(ai, bj, At, Bt) do { __builtin_amdgcn_s_setprio(1); _Pragma("unroll") for (int m = 0; m < 4; ++m) _Pragma("unroll") for (int n = 0; n < 2; ++n) _Pragma("unroll") for (int k = 0; k < 2; ++k) \
        acc[ai][bj][m][n] = __builtin_amdgcn_mfma_f32_16x16x32_bf16(Bt[n][k], At[m][k], acc[ai][bj][m][n], 0, 0, 0); __builtin_amdgcn_s_setprio(0); } while (0)
#define PG8_WAIT_V(n) asm volatile("s_waitcnt vmcnt(" #n ")" ::: "memory")
#define PG8_WAIT_L(n) asm volatile("s_waitcnt lgkmcnt(" #n ")" ::: "memory")
#define PG8_BAR __builtin_amdgcn_s_barrier()
#define PG8_SCHED __builtin_amdgcn_sched_barrier(0)
    Unit cur, nxt; int ui = 0;
    if (!S.next(0, cur)) return;
    f32x4 acc[2][2][4][2];
#pragma unroll
    for (int a = 0; a < 2; ++a)
#pragma unroll
        for (int b = 0; b < 2; ++b)
#pragma unroll
            for (int m = 0; m < 4; ++m)
#pragma unroll
                for (int n = 0; n < 2; ++n) acc[a][b][m][n] = (f32x4){0.f, 0.f, 0.f, 0.f};
    bf16x8 At[4][2], B0[2][2], B1[2][2];
    const char* cA = (const char*)g.A + (size_t)cur.pm * tstep; const char* cB = (const char*)g.Bt + (size_t)cur.pn * tstep;
    S.a_ready(cur);
    if constexpr (SP2) {
        PG8_STAGE(PG8_SB(0, 0), cB, voffB); PG8_STAGE(PG8_SB(0, 1), cB + hstep, voffB); PG8_STAGE(PG8_SA(0, 0), cA, voffA); PG8_STAGE(PG8_SA(0, 1), cA + hstep, voffA);
        if (wr == 1) PG8_BAR;
        PG8_WAIT_V(2); PG8_BAR;
        PG8_STAGE(PG8_SB(1, 0), cB + kstep, voffB); PG8_STAGE(PG8_SA(1, 0), cA + kstep, voffA); PG8_STAGE(PG8_SB(1, 1), cB + hstep + kstep, voffB);
        PG8_WAIT_V(6); PG8_BAR;
    } else {
        PG8_STAGE(PG8_SB(0, 0), cB, voffB); PG8_STAGE(PG8_SA(0, 0), cA, voffA); PG8_STAGE(PG8_SB(0, 1), cB + hstep, voffB); PG8_STAGE(PG8_SA(0, 1), cA + hstep, voffA);
        if (wr == 1) PG8_BAR;
        PG8_WAIT_V(4); PG8_BAR;
        PG8_STAGE(PG8_SB(1, 0), cB + kstep, voffB); PG8_STAGE(PG8_SA(1, 0), cA + kstep, voffA); PG8_STAGE(PG8_SB(1, 1), cB + hstep + kstep, voffB);
        PG8_WAIT_V(6); PG8_BAR;
    }
    for (;;) {
        const bool has_next = S.next(ui + 1, nxt);
        const char* nA = has_next ? (const char*)g.A + (size_t)nxt.pm * tstep : cA; const char* nB = has_next ? (const char*)g.Bt + (size_t)nxt.pn * tstep : cB;
#pragma nounroll
        for (int t = 0; t < nt; t += 2) {
            const bool last = (t == nt - 2);
            const char* a1 = cA + (size_t)(t + 1) * kstep;
            const char* a2 = last ? nA : cA + (size_t)(t + 2) * kstep; const char* b2 = last ? nB : cB + (size_t)(t + 2) * kstep;
            const char* a3 = a2 + kstep; const char* b3 = b2 + kstep;
            if (last && has_next) S.a_ready(nxt);
            if constexpr (SP2) {
            PG8_LDB(B0, 0, 0); PG8_LDB(B1, 0, 1); PG8_SCHED; PG8_LDA(At, 0, 0); PG8_STAGE(PG8_SA(1, 1), a1 + hstep, voffA);
            PG8_WAIT_V(8); PG8_WAIT_L(0); PG8_BAR; PG8_MMA(0, 0, At, B0); PG8_MMA(0, 1, At, B1); PG8_BAR; PG8_SCHED;
            PG8_LDA(At, 0, 1); PG8_STAGE(PG8_SB(0, 0), b2, voffB); PG8_STAGE(PG8_SB(0, 1), b2 + hstep, voffB); PG8_STAGE(PG8_SA(0, 0), a2, voffA);
            PG8_WAIT_V(8); PG8_WAIT_L(0); PG8_BAR; PG8_MMA(1, 0, At, B0); PG8_MMA(1, 1, At, B1); PG8_BAR; PG8_SCHED;
            PG8_LDB(B0, 1, 0); PG8_LDB(B1, 1, 1); PG8_SCHED; PG8_LDA(At, 1, 0); PG8_STAGE(PG8_SA(0, 1), a2 + hstep, voffA);
            PG8_WAIT_V(8); PG8_WAIT_L(0); PG8_BAR; PG8_MMA(0, 0, At, B0); PG8_MMA(0, 1, At, B1); PG8_BAR; PG8_SCHED;
            PG8_LDA(At, 1, 1); PG8_STAGE(PG8_SB(1, 0), b3, voffB); PG8_STAGE(PG8_SB(1, 1), b3 + hstep, voffB); PG8_STAGE(PG8_SA(1, 0), a3, voffA);
            PG8_WAIT_V(8); PG8_WAIT_L(0); PG8_BAR; PG8_MMA(1, 0, At, B0); PG8_MMA(1, 1, At, B1); PG8_BAR; PG8_SCHED;
            } else {
            PG8_LDB(B0, 0, 0); PG8_SCHED; PG8_LDA(At, 0, 0); PG8_STAGE(PG8_SA(1, 1), a1 + hstep, voffA);
            PG8_WAIT_L(8); PG8_BAR; PG8_WAIT_L(0); PG8_MMA(0, 0, At, B0); PG8_BAR; PG8_SCHED;
            PG8_LDB(B1, 0, 1); PG8_STAGE(PG8_SB(0, 0), b2, voffB);
            PG8_BAR; PG8_WAIT_L(0); PG8_MMA(0, 1, At, B1); PG8_BAR;
            PG8_LDA(At, 0, 1); PG8_STAGE(PG8_SA(0, 0), a2, voffA);
            PG8_BAR; PG8_WAIT_L(0); PG8_MMA(1, 0, At, B0); PG8_BAR; PG8_SCHED;
            PG8_STAGE(PG8_SB(0, 1), b2 + hstep, voffB);
            PG8_WAIT_V(6); PG8_BAR; PG8_MMA(1, 1, At, B1); PG8_BAR;
            PG8_LDB(B0, 1, 0); PG8_SCHED; PG8_LDA(At, 1, 0); PG8_STAGE(PG8_SA(0, 1), a2 + hstep, voffA);
            PG8_WAIT_L(8); PG8_BAR; PG8_WAIT_L(0); PG8_MMA(0, 0, At, B0); PG8_BAR; PG8_SCHED;
            PG8_LDB(B1, 1, 1); PG8_STAGE(PG8_SB(1, 0), b3, voffB);
            PG8_BAR; PG8_WAIT_L(0); PG8_MMA(0, 1, At, B1); PG8_BAR;
            PG8_LDA(At, 1, 1); PG8_STAGE(PG8_SA(1, 0), a3, voffA);
            PG8_BAR; PG8_WAIT_L(0); PG8_MMA(1, 0, At, B0); PG8_BAR; PG8_SCHED;
            PG8_STAGE(PG8_SB(1, 1), b3 + hstep, voffB);
            PG8_WAIT_V(6); PG8_BAR; PG8_MMA(1, 1, At, B1); PG8_BAR;
            }
        }
        if constexpr (ALIGN_EPI) { if (wr == 0) PG8_BAR; }
        if constexpr (!Epi::AFTER_DRAIN) { E(acc, cur, wr, wc, fr, fq); S.done(cur); }
        if (!has_next) break;
#pragma unroll
        for (int a = 0; a < 2; ++a)
#pragma unroll
            for (int b = 0; b < 2; ++b)
#pragma unroll
                for (int m = 0; m < 4; ++m)
#pragma unroll
                    for (int n = 0; n < 2; ++n) acc[a][b][m][n] = (f32x4){0.f, 0.f, 0.f, 0.f};
        cur = nxt; cA = nA; cB = nB; ++ui;
        if constexpr (ALIGN_EPI) { if (wr == 1) PG8_BAR; }
    }
    PG8_WAIT_V(0);
    if constexpr (!ALIGN_EPI) { if (wr == 0) PG8_BAR; }
    PG8_BAR;
    if constexpr (Epi::AFTER_DRAIN) { E.fused(acc, cur, wr, wc, fr, fq, lds, wid, lane); S.done(cur); }
#undef PG8_SA
#undef PG8_SB
#undef PG8_STAGE
#undef PG8_LDA
#undef PG8_LDB
#undef PG8_MMA
#undef PG8_WAIT_V
#undef PG8_WAIT_L
#undef PG8_BAR
#undef PG8_SCHED
}
}
namespace pg8 {
typedef unsigned u32x2 __attribute__((ext_vector_type(2)));
constexpr int ML_ROWS = 32768;
__device__ __forceinline__ float sigm(float x) { return __builtin_amdgcn_rcpf(1.0f + __builtin_amdgcn_exp2f(-1.4426950408889634f * x)); }
__device__ __forceinline__ u32x2 pack4(const f32x4 v) { u32x2 w; w.x = cvt_pk_bf16(v[0], v[1]); w.y = cvt_pk_bf16(v[2], v[3]); return w; }
__device__ __forceinline__ void rope4(f32x4& x0, f32x4& x1, const float* rope, int row, int half, int fq) {
    const int t = row & 4095, p = half ? (t & 63) : (t >> 6);
    const f32x4* tp = (const f32x4*)(rope + (p * 16 + 4 * fq) * 2);
    const f32x4 a = tp[0], b = tp[1];
    const f32x4 c = {a[0], a[2], b[0], b[2]}, s = {a[1], a[3], b[1], b[3]};
    const f32x4 y0 = x0 * c - x1 * s, y1 = x1 * c + x0 * s;
    x0 = y0; x1 = y1;
}
struct EpiWin {
    static constexpr bool PERM = true, AFTER_DRAIN = false;
    unsigned char* G; bf16_t* CQ; bf16_t* KF; bf16_t* GK; bf16_t* GV; bf16_t* GQ; bf16_t* U; const float* rope;
    __device__ __forceinline__ void operator()(const f32x4 (&acc)[2][2][4][2], const Unit& u, int wr, int wc, int fr, int fq) const {
        const int row0 = u.pm * BM + wr * 64 + fr; const bool lat = u.pm < (ML_ROWS / BM);
#pragma unroll
        for (int bj = 0; bj < 2; ++bj) {
            const int colg = u.pn * BM + bj * HALF + wc * 32;
            if (colg < 6144) {
#pragma unroll
                for (int ai = 0; ai < 2; ++ai)
#pragma unroll
                    for (int m = 0; m < 4; ++m) { const size_t row = (size_t)(row0 + ai * HALF + m * 16);
                        u32x2 gq;
#pragma unroll
                        for (int n = 0; n < 2; ++n) { const f32x4 v = acc[ai][bj][m][n];
#define SG8(x) ((unsigned)(__builtin_amdgcn_rcpf(1.0f + __builtin_amdgcn_exp2f(x)) * 255.0f + 0.5f))
                            const unsigned q0 = SG8(v[0]), q1 = SG8(v[1]), q2 = SG8(v[2]), q3 = SG8(v[3]);
#undef SG8
                            const unsigned w4 = q0 | (q1 << 8) | (q2 << 16) | (q3 << 24); if (n == 0) gq.x = w4; else gq.y = w4; }
                        *(u32x2*)(G + row * 6144 + colg + 8 * fq) = gq; }
            } else {
                const int o = colg - 6144;
                if (o < 256 || (o >= 576 && o < 1088)) {
                    const int co = (o < 256) ? o : (256 + o - 576);
#pragma unroll
                    for (int ai = 0; ai < 2; ++ai)
#pragma unroll
                        for (int m = 0; m < 4; ++m) { const size_t row = (size_t)(row0 + ai * HALF + m * 16);
#pragma unroll
                            for (int n = 0; n < 1; ++n) { const u32x2 w0 = pack4(acc[ai][bj][m][0]), w1 = pack4(acc[ai][bj][m][1]); u32x4 w; w.x = w0.x; w.y = w0.y; w.z = w1.x; w.w = w1.y; *(u32x4*)(CQ + row * 768 + co + 8 * fq) = w; } }
                } else if (o < 320) {
                    const int half = (o - 256) >> 5;
#pragma unroll
                    for (int ai = 0; ai < 2; ++ai)
#pragma unroll
                        for (int m = 0; m < 4; ++m) { const int r = row0 + ai * HALF + m * 16; f32x4 x0 = acc[ai][bj][m][0], x1 = acc[ai][bj][m][1];
                            if (lat) rope4(x0, x1, rope, r, half, fq);
                            const u32x2 w0 = pack4(x0), w1 = pack4(x1); bf16_t* p = KF + (size_t)r * 1536 + 128 + (o - 256) + 4 * fq;
#pragma unroll
                            for (int h = 0; h < 8; ++h) { *(u32x2*)(p + h * 192) = w0; *(u32x2*)(p + h * 192 + 16) = w1; } }
                } else if (o < 448 || (o >= 1088 && o < 1600)) {
                    const bool isk = o < 448; const int co = isk ? (o - 320) : (o - 1088); const int half = (co >> 5) & 1;
                    bf16_t* base = isk ? GK : GQ; const int ld = isk ? 128 : 512;
#pragma unroll
                    for (int ai = 0; ai < 2; ++ai)
#pragma unroll
                        for (int m = 0; m < 4; ++m) { const int r = row0 + ai * HALF + m * 16; f32x4 x0 = acc[ai][bj][m][0], x1 = acc[ai][bj][m][1];
                            if (lat) rope4(x0, x1, rope, r, half, fq);
                            bf16_t* p = base + (size_t)r * ld + co + 4 * fq; *(u32x2*)p = pack4(x0); *(u32x2*)(p + 16) = pack4(x1); }
                } else if (o < 576) {
#pragma unroll
                    for (int ai = 0; ai < 2; ++ai)
#pragma unroll
                        for (int m = 0; m < 4; ++m) { const size_t row = (size_t)(row0 + ai * HALF + m * 16); bf16_t* p = GV + row * 128 + (o - 448) + 8 * fq;
                            const u32x2 w0 = pack4(acc[ai][bj][m][0]), w1 = pack4(acc[ai][bj][m][1]); u32x4 w; w.x = w0.x; w.y = w0.y; w.z = w1.x; w.w = w1.y; *(u32x4*)p = w; }
                } else if (o < 2624) {
                    const int g = (o - 1600) >> 5;
#pragma unroll
                    for (int ai = 0; ai < 2; ++ai)
#pragma unroll
                        for (int m = 0; m < 4; ++m) { const size_t row = (size_t)(row0 + ai * HALF + m * 16); const f32x4 a = acc[ai][bj][m][0], b = acc[ai][bj][m][1];
                            const f32x4 uu = {a[0] * sigm(b[0]), a[1] * sigm(b[1]), a[2] * sigm(b[2]), a[3] * sigm(b[3])};
                            *(u32x2*)(U + row * 512 + 16 * g + 4 * fq) = pack4(uu); }
                }
            }
        }
    }
};
struct EpiQup {
    static constexpr bool PERM = true, AFTER_DRAIN = false;
    bf16_t* MQ; const float* rope;
    __device__ __forceinline__ void operator()(const f32x4 (&acc)[2][2][4][2], const Unit& u, int wr, int wc, int fr, int fq) const {
        const int row0 = u.pm * BM + wr * 64 + fr; const bool lat = u.pm < (ML_ROWS / BM);
#pragma unroll
        for (int bj = 0; bj < 2; ++bj) {
            const int colg = u.pn * BM + bj * HALF + wc * 32, hd = colg % 192; const bool isr = hd >= 128; const int half = (hd - 128) >> 5;
#pragma unroll
            for (int ai = 0; ai < 2; ++ai)
#pragma unroll
                for (int m = 0; m < 4; ++m) { const int r = row0 + ai * HALF + m * 16; f32x4 x0 = acc[ai][bj][m][0], x1 = acc[ai][bj][m][1];
                    if (isr) { if (lat) rope4(x0, x1, rope, r, half, fq);
                        bf16_t* p = MQ + (size_t)r * 1536 + colg + 4 * fq; *(u32x2*)p = pack4(x0); *(u32x2*)(p + 16) = pack4(x1); }
                    else { const u32x2 w0 = pack4(x0), w1 = pack4(x1); u32x4 w; w.x = w0.x; w.y = w0.y; w.z = w1.x; w.w = w1.y; *(u32x4*)(MQ + (size_t)r * 1536 + colg + 8 * fq) = w; } }
        }
    }
};
struct EpiKV {
    static constexpr bool PERM = true, AFTER_DRAIN = false;
    bf16_t* KF; bf16_t* V;
    __device__ __forceinline__ void operator()(const f32x4 (&acc)[2][2][4][2], const Unit& u, int wr, int wc, int fr, int fq) const {
        const int row0 = u.pm * BM + wr * 64 + fr, c0 = wc * 32 + 8 * fq;
#pragma unroll
        for (int ai = 0; ai < 2; ++ai)
#pragma unroll
            for (int m = 0; m < 4; ++m) { const size_t row = (size_t)(row0 + ai * HALF + m * 16);
#pragma unroll
                for (int bj = 0; bj < 2; ++bj) { const f32x4 v0 = acc[ai][bj][m][0], v1 = acc[ai][bj][m][1];
                    u32x4 w; w.x = cvt_pk_bf16(v0[0], v0[1]); w.y = cvt_pk_bf16(v0[2], v0[3]); w.z = cvt_pk_bf16(v1[0], v1[1]); w.w = cvt_pk_bf16(v1[2], v1[3]);
                    if (bj == 0) *(u32x4*)(KF + row * 1536 + u.pn * 192 + c0) = w; else *(u32x4*)(V + row * 1024 + u.pn * 128 + c0) = w; } }
    }
};
template <int STEP> struct EpiMerge {
    static constexpr bool PERM = true, AFTER_DRAIN = false;
    const unsigned char* G; bf16_t* YF; bf16_t* Y; int wt_pm;
    __device__ __forceinline__ void operator()(const f32x4 (&acc)[2][2][4][2], const Unit& u, int wr, int wc, int fr, int fq) const {
        constexpr int NBATCH = 4;
        const int row0 = u.pm * BM + wr * 64 + fr, col0 = u.pn * BM + wc * 32 + 8 * fq;
        bf16_t* dst = (STEP < 2) ? YF : Y;
        const bool wt = (STEP < 2) && (u.pm >= wt_pm);
#pragma unroll
        for (int ai = 0; ai < 2; ++ai)
#pragma unroll
            for (int mb = 0; mb < 4; mb += NBATCH) {
                u32x2 gw[NBATCH][2]; u32x4 yv[NBATCH][2];
#pragma unroll
                for (int q = 0; q < NBATCH; ++q) { const size_t row = (size_t)(row0 + ai * HALF + (mb + q) * 16);
#pragma unroll
                    for (int bj = 0; bj < 2; ++bj) { const int c = col0 + bj * HALF;
                        gw[q][bj] = *(const u32x2*)(G + row * 6144 + STEP * 2048 + c);
                        if (STEP > 0) yv[q][bj] = *(const u32x4*)(YF + row * 2048 + c); } }
#pragma unroll
                for (int q = 0; q < NBATCH; ++q) { const size_t row = (size_t)(row0 + ai * HALF + (mb + q) * 16); const int m = mb + q;
#pragma unroll
                    for (int bj = 0; bj < 2; ++bj) { const int c = col0 + bj * HALF; const u32x2 g2 = gw[q][bj]; constexpr float I255 = 1.0f / 255.0f;
                        const f32x4 g0 = {(float)(g2.x & 255u) * I255, (float)((g2.x >> 8) & 255u) * I255, (float)((g2.x >> 16) & 255u) * I255, (float)(g2.x >> 24) * I255};
                        const f32x4 g1 = {(float)(g2.y & 255u) * I255, (float)((g2.y >> 8) & 255u) * I255, (float)((g2.y >> 16) & 255u) * I255, (float)(g2.y >> 24) * I255};
                        f32x4 a0 = acc[ai][bj][m][0] * g0, a1 = acc[ai][bj][m][1] * g1;
                        if (STEP > 0) { const u32x4 y4 = yv[q][bj];
                            a0 += (f32x4){__uint_as_float(y4.x << 16), __uint_as_float(y4.x & 0xffff0000u), __uint_as_float(y4.y << 16), __uint_as_float(y4.y & 0xffff0000u)};
                            a1 += (f32x4){__uint_as_float(y4.z << 16), __uint_as_float(y4.z & 0xffff0000u), __uint_as_float(y4.w << 16), __uint_as_float(y4.w & 0xffff0000u)}; }
                        u32x4 w; w.x = cvt_pk_bf16(a0[0], a0[1]); w.y = cvt_pk_bf16(a0[2], a0[3]); w.z = cvt_pk_bf16(a1[0], a1[1]); w.w = cvt_pk_bf16(a1[2], a1[3]);
                        if (wt) asm volatile("global_store_dwordx4 %0, %1, off sc1" :: "v"(dst + row * 2048 + c), "v"(w) : "memory");
                        else *(u32x4*)(dst + row * 2048 + c) = w; } }
                asm volatile("" ::: "memory"); }
    }
};
struct EpiResid {
    static constexpr bool PERM = true, AFTER_DRAIN = false;
    bf16_t* XB; const float* modl; int goff;
    __device__ __forceinline__ void operator()(const f32x4 (&acc)[2][2][4][2], const Unit& u, int wr, int wc, int fr, int fq) const {
        const int sel = u.pm >> 4;
        const int col0 = u.pn * BM + wc * 32 + 8 * fq; const float* gt = modl + sel * 12288 + goff + col0;
        bf16_t* base = XB + (size_t)(u.pm * BM + wr * 64 + fr) * 2048;
        f32x4 gv[2][2];
#pragma unroll
        for (int bj = 0; bj < 2; ++bj)
#pragma unroll
            for (int n = 0; n < 2; ++n) gv[bj][n] = *(const f32x4*)(gt + bj * HALF + n * 4);
#pragma unroll
        for (int ai = 0; ai < 2; ++ai) {
            u32x4 xr[4][2];
#pragma unroll
            for (int m = 0; m < 4; ++m) { const bf16_t* rowp = base + (size_t)(ai * HALF + m * 16) * 2048 + col0;
#pragma unroll
                for (int bj = 0; bj < 2; ++bj) xr[m][bj] = *(const u32x4*)(rowp + bj * HALF); }
#pragma unroll
            for (int m = 0; m < 4; ++m) { bf16_t* rowp = base + (size_t)(ai * HALF + m * 16) * 2048 + col0;
#pragma unroll
                for (int bj = 0; bj < 2; ++bj) { const u32x4 t = xr[m][bj];
                    const f32x4 x0 = {__uint_as_float(t.x << 16), __uint_as_float(t.x & 0xffff0000u), __uint_as_float(t.y << 16), __uint_as_float(t.y & 0xffff0000u)};
                    const f32x4 x1 = {__uint_as_float(t.z << 16), __uint_as_float(t.z & 0xffff0000u), __uint_as_float(t.w << 16), __uint_as_float(t.w & 0xffff0000u)};
                    const u32x2 w0 = pack4(x0 + gv[bj][0] * acc[ai][bj][m][0]), w1 = pack4(x1 + gv[bj][1] * acc[ai][bj][m][1]);
                    u32x4 w; w.x = w0.x; w.y = w0.y; w.z = w1.x; w.w = w1.y; *(u32x4*)(rowp + bj * HALF) = w; } }
            asm volatile("" ::: "memory"); }
    }
};
struct EpiSwiGLU {
    static constexpr bool PERM = true, AFTER_DRAIN = false;
    bf16_t* HID;
    __device__ __forceinline__ void operator()(const f32x4 (&acc)[2][2][4][2], const Unit& u, int wr, int wc, int fr, int fq) const {
        const int row0 = u.pm * BM + wr * 64 + fr, h0 = u.pn * 128 + wc * 32 + 8 * fq;
#pragma unroll
        for (int ai = 0; ai < 2; ++ai)
#pragma unroll
            for (int m = 0; m < 4; ++m) { bf16_t* rowp = HID + (size_t)(row0 + ai * HALF + m * 16) * 5632 + h0;
                u32x2 w2[2];
#pragma unroll
                for (int n = 0; n < 2; ++n) { const f32x4 a = acc[ai][0][m][n], b = acc[ai][1][m][n];
                    const f32x4 h = {a[0] * sigm(a[0]) * b[0], a[1] * sigm(a[1]) * b[1], a[2] * sigm(a[2]) * b[2], a[3] * sigm(a[3]) * b[3]};
                    w2[n] = pack4(h); }
                u32x4 w; w.x = w2[0].x; w.y = w2[0].y; w.z = w2[1].x; w.w = w2[1].y; *(u32x4*)rowp = w; }
    }
};
}
namespace pg8 {
struct UnitX { int pm, pn, kind; };
template <class Epi, class Sched, bool CHAIN = false>
__device__ __forceinline__ void gemm_stream(PG8_LAS unsigned char* lds, const Sched& S, const Epi& E) {
    int tid_ = threadIdx.x; asm volatile("" : "+v"(tid_));
    const int tid = tid_, wid = __builtin_amdgcn_readfirstlane(tid >> 6), lane = tid & 63, wr = wid >> 2, wc = wid & 3, fr = lane & 15, fq = lane >> 4;
    int Rn, Rp, C2; { int R, C; stage_rc(tid * 16, R, C); Rn = R; Rp = (R & ~31) + perm32(R & 31); C2 = C * 2; }
    const size_t kstep = (size_t)(BK * 2);
    const unsigned ldsw = (unsigned)wid * 1024u;
    const int aoff = lds_byte(wr * 64 + fr, fq * 8), boff = lds_byte(wc * 32 + fr, fq * 8);
#define PG8_SA(b, h) (((b) * 2 + (h)) * HTB)
#define PG8_SB(b, h) ((4 + (b) * 2 + (h)) * HTB)
#define PG8_STAGE(bufoff, gbase, voff, r64) do { \
        __builtin_amdgcn_global_load_lds((const unsigned*)((const char*)(gbase) + (voff)), (PG8_LAS unsigned*)(lds + (bufoff) + ldsw), 16, 0, 0); \
        __builtin_amdgcn_global_load_lds((const unsigned*)((const char*)(gbase) + (r64) + (voff)), (PG8_LAS unsigned*)(lds + (bufoff) + ldsw + 8192), 16, 0, 0); } while (0)
#define PG8_LDA(dst, b, h) do { _Pragma("unroll") for (int m = 0; m < 4; ++m) _Pragma("unroll") for (int k = 0; k < 2; ++k) dst[m][k] = *(const PG8_LAS bf16x8*)(lds + PG8_SA(b, h) + aoff + m * 2048 + k * 1024); } while (0)
#define PG8_LDB(dst, b, h) do { _Pragma("unroll") for (int n = 0; n < 2; ++n) _Pragma("unroll") for (int k = 0; k < 2; ++k) dst[n][k] = *(const PG8_LAS bf16x8*)(lds + PG8_SB(b, h) + boff + n * 2048 + k * 1024); } while (0)
#define PG8_MMA(ai, bj, At, Bt) do { __builtin_amdgcn_s_setprio(1); _Pragma("unroll") for (int m = 0; m < 4; ++m) _Pragma("unroll") for (int n = 0; n < 2; ++n) _Pragma("unroll") for (int k = 0; k < 2; ++k) \
        acc[ai][bj][m][n] = __builtin_amdgcn_mfma_f32_16x16x32_bf16(Bt[n][k], At[m][k], acc[ai][bj][m][n], 0, 0, 0); __builtin_amdgcn_s_setprio(0); } while (0)
#define PG8_WAIT_V(n) asm volatile("s_waitcnt vmcnt(" #n ")" ::: "memory")
#define PG8_WAIT_L(n) asm volatile("s_waitcnt lgkmcnt(" #n ")" ::: "memory")
#define PG8_BAR __builtin_amdgcn_s_barrier()
#define PG8_SCHED __builtin_amdgcn_sched_barrier(0)
    UnitX cur, nxt; int ui = 0;
    if (!S.next(0, cur)) return;
    f32x4 acc[2][2][4][2];
#pragma unroll
    for (int a = 0; a < 2; ++a)
#pragma unroll
        for (int b = 0; b < 2; ++b)
#pragma unroll
            for (int m = 0; m < 4; ++m)
#pragma unroll
                for (int n = 0; n < 2; ++n) acc[a][b][m][n] = (f32x4){0.f, 0.f, 0.f, 0.f};
    bf16x8 At[4][2], B0[2][2], B1[2][2];
    int K2 = S.gPitch(cur.kind) * 2;
    unsigned voA = (unsigned)(Rn * K2 + C2), voB = (unsigned)((S.gPerm(cur.kind) ? Rp : Rn) * K2 + C2);
    size_t r64 = (size_t)64 * K2, hstep = (size_t)HALF * K2;
    int nt = S.gNt(cur.kind);
    const char* cA = (const char*)S.gA(cur.kind) + (size_t)cur.pm * 2 * hstep + (size_t)S.gK0(cur.kind) * 2; const char* cB = (const char*)S.gB(cur.kind) + (size_t)cur.pn * 2 * hstep + (size_t)S.gK0(cur.kind) * 2;
    PG8_STAGE(PG8_SB(0, 0), cB, voB, r64); PG8_STAGE(PG8_SB(0, 1), cB + hstep, voB, r64); PG8_STAGE(PG8_SA(0, 0), cA, voA, r64); PG8_STAGE(PG8_SA(0, 1), cA + hstep, voA, r64);
    if (wr == 1) PG8_BAR;
    PG8_WAIT_V(2); PG8_BAR;
    PG8_STAGE(PG8_SB(1, 0), cB + kstep, voB, r64); PG8_STAGE(PG8_SA(1, 0), cA + kstep, voA, r64); PG8_STAGE(PG8_SB(1, 1), cB + hstep + kstep, voB, r64);
    PG8_WAIT_V(6); PG8_BAR;
    for (;;) {
        const bool has_next = S.next(ui + 1, nxt);
        const int nkind = has_next ? nxt.kind : cur.kind;
        const int nK2 = S.gPitch(nkind) * 2;
        const unsigned nvoA = (unsigned)(Rn * nK2 + C2), nvoB = (unsigned)((S.gPerm(nkind) ? Rp : Rn) * nK2 + C2);
        const size_t nr64 = (size_t)64 * nK2, nhstep = (size_t)HALF * nK2;
        const char* nA = has_next ? (const char*)S.gA(nkind) + (size_t)nxt.pm * 2 * nhstep + (size_t)S.gK0(nkind) * 2 : cA; const char* nB = has_next ? (const char*)S.gB(nkind) + (size_t)nxt.pn * 2 * nhstep + (size_t)S.gK0(nkind) * 2 : cB;
#pragma nounroll
        for (int t = 0; t < nt; t += 2) {
            const bool last = (t == nt - 2);
            const char* a1 = cA + (size_t)(t + 1) * kstep;
            const char* a2 = last ? nA : cA + (size_t)(t + 2) * kstep; const char* b2 = last ? nB : cB + (size_t)(t + 2) * kstep;
            const char* a3 = a2 + kstep; const char* b3 = b2 + kstep;
            const unsigned vA2 = last ? nvoA : voA, vB2 = last ? nvoB : voB; const size_t r2 = last ? nr64 : r64, h2 = last ? nhstep : hstep;
            PG8_LDB(B0, 0, 0); PG8_LDB(B1, 0, 1); PG8_SCHED; PG8_LDA(At, 0, 0); PG8_STAGE(PG8_SA(1, 1), a1 + hstep, voA, r64);
            PG8_WAIT_V(8); PG8_WAIT_L(0); PG8_BAR; PG8_MMA(0, 0, At, B0); PG8_MMA(0, 1, At, B1); PG8_BAR; PG8_SCHED;
            PG8_LDA(At, 0, 1); PG8_STAGE(PG8_SB(0, 0), b2, vB2, r2); PG8_STAGE(PG8_SB(0, 1), b2 + h2, vB2, r2); PG8_STAGE(PG8_SA(0, 0), a2, vA2, r2);
            PG8_WAIT_V(8); PG8_WAIT_L(0); PG8_BAR; PG8_MMA(1, 0, At, B0); PG8_MMA(1, 1, At, B1); PG8_BAR; PG8_SCHED;
            PG8_LDB(B0, 1, 0); PG8_LDB(B1, 1, 1); PG8_SCHED; PG8_LDA(At, 1, 0); PG8_STAGE(PG8_SA(0, 1), a2 + h2, vA2, r2);
            PG8_WAIT_V(8); PG8_WAIT_L(0); PG8_BAR; PG8_MMA(0, 0, At, B0); PG8_MMA(0, 1, At, B1); PG8_BAR; PG8_SCHED;
            PG8_LDA(At, 1, 1); PG8_STAGE(PG8_SB(1, 0), b3, vB2, r2); PG8_STAGE(PG8_SB(1, 1), b3 + h2, vB2, r2); PG8_STAGE(PG8_SA(1, 0), a3, vA2, r2);
            PG8_WAIT_V(8); PG8_WAIT_L(0); PG8_BAR; PG8_MMA(1, 0, At, B0); PG8_MMA(1, 1, At, B1); PG8_BAR; PG8_SCHED;
        }
        if (wr == 0) PG8_BAR;
        if constexpr (CHAIN) E.chain(acc, cur.pm, cur.pn, cur.kind, wr, wc, fr, fq); else E(acc, cur.pm, cur.pn, cur.kind, wr, wc, fr, fq);
        if (!has_next) break;
        bool clr_ = true; if constexpr (CHAIN) clr_ = (cur.kind == Epi::LAST_KIND);
        if (clr_)
#pragma unroll
        for (int a = 0; a < 2; ++a)
#pragma unroll
            for (int b = 0; b < 2; ++b)
#pragma unroll
                for (int m = 0; m < 4; ++m)
#pragma unroll
                    for (int n = 0; n < 2; ++n) acc[a][b][m][n] = (f32x4){0.f, 0.f, 0.f, 0.f};
        cur.pm = nxt.pm; cur.pn = nxt.pn; cur.kind = nxt.kind; cA = nA; cB = nB; K2 = nK2; voA = nvoA; voB = nvoB; r64 = nr64; hstep = nhstep; nt = S.gNt(nkind); ++ui;
        if (wr == 1) PG8_BAR;
    }
    PG8_WAIT_V(0);
    PG8_BAR;
#undef PG8_SA
#undef PG8_SB
#undef PG8_STAGE
#undef PG8_LDA
#undef PG8_LDB
#undef PG8_MMA
#undef PG8_WAIT_V
#undef PG8_WAIT_L
#undef PG8_BAR
#undef PG8_SCHED
}
struct SchedMerge {
    StaticOrder base; const char* a0; long da1, da2; const char* b0; long db1, db2;
    __device__ __forceinline__ bool next(int i, UnitX& u) const { Unit b; const int q = i / 3; const bool ok = base.next(q, b); u.pm = b.pm; u.pn = b.pn; u.kind = i - 3 * q; return ok; }
    __device__ __forceinline__ const bf16_t* gA(int k) const { return (const bf16_t*)(a0 + (k > 0 ? da1 : 0l) + (k > 1 ? da2 : 0l)); }
    __device__ __forceinline__ const bf16_t* gB(int k) const { return (const bf16_t*)(b0 + (k > 0 ? db1 : 0l) + (k > 1 ? db2 : 0l)); }
    __device__ __forceinline__ int gPitch(int k) const { return k == 1 ? 1024 : 512; }
    __device__ __forceinline__ int gNt(int k) const { return k == 1 ? 16 : 8; }
    __device__ __forceinline__ int gK0(int) const { return 0; }
    __device__ __forceinline__ int gPerm(int) const { return 1; }
};
struct EpiMergeAll {
    EpiMerge<0> e0; EpiMerge<1> e1; EpiMerge<2> e2;
    __device__ __forceinline__ void operator()(const f32x4 (&acc)[2][2][4][2], int pm, int pn, int kind, int wr, int wc, int fr, int fq) const {
        Unit u; u.pm = pm; u.pn = pn;
        if (kind == 0) e0(acc, u, wr, wc, fr, fq); else if (kind == 1) e1(acc, u, wr, wc, fr, fq); else e2(acc, u, wr, wc, fr, fq);
    }
};
struct EpiChain {
    static constexpr int LAST_KIND = 2;
    const unsigned char* G; bf16_t* Y;
    __device__ __forceinline__ void chain(f32x4 (&acc)[2][2][4][2], int pm, int pn, int kind, int wr, int wc, int fr, int fq) const {
        const int row0 = pm * BM + wr * 64 + fr, col0 = pn * BM + wc * 32 + 8 * fq;
        const unsigned char* ga = G + (kind == 2 ? 2 : kind) * 2048; const unsigned char* gb = G + (kind == 0 ? 1 : 2) * 2048;
        const float amin = (kind == 0) ? 0.0f : 1.0f;
        const float bm = (kind == 2) ? 0.0f : 1.0f, bo = (kind == 2) ? 255.0f : 0.0f;
#pragma unroll
        for (int ai = 0; ai < 2; ++ai) {
            u32x2 qa[4][2], qb[4][2];
#pragma unroll
            for (int m = 0; m < 4; ++m) { const size_t row = (size_t)(row0 + ai * HALF + m * 16);
#pragma unroll
                for (int bj = 0; bj < 2; ++bj) { const int c = col0 + bj * HALF; qa[m][bj] = *(const u32x2*)(ga + row * 6144 + c); qb[m][bj] = *(const u32x2*)(gb + row * 6144 + c); } }
#pragma unroll
            for (int m = 0; m < 4; ++m)
#pragma unroll
                for (int bj = 0; bj < 2; ++bj)
#pragma unroll
                    for (int n = 0; n < 2; ++n) { const unsigned wa = n == 0 ? qa[m][bj].x : qa[m][bj].y, wb = n == 0 ? qb[m][bj].x : qb[m][bj].y;
                        f32x4 r;
#pragma unroll
                        for (int e = 0; e < 4; ++e) { const float fa = fmaxf((float)((wa >> (8 * e)) & 255u), amin), fb = fmaxf(fmaf((float)((wb >> (8 * e)) & 255u), bm, bo), 1.0f);
                            r[e] = fa * __builtin_amdgcn_rcpf(fb); }
                        acc[ai][bj][m][n] *= r; }
            asm volatile("" ::: "memory"); }
        if (kind == 2) {
#pragma unroll
            for (int ai = 0; ai < 2; ++ai)
#pragma unroll
                for (int m = 0; m < 4; ++m) { const size_t row = (size_t)(row0 + ai * HALF + m * 16);
#pragma unroll
                    for (int bj = 0; bj < 2; ++bj) { const int c = col0 + bj * HALF; const f32x4 a0 = acc[ai][bj][m][0], a1 = acc[ai][bj][m][1];
                        u32x4 w; w.x = cvt_pk_bf16(a0[0], a0[1]); w.y = cvt_pk_bf16(a0[2], a0[3]); w.z = cvt_pk_bf16(a1[0], a1[1]); w.w = cvt_pk_bf16(a1[2], a1[3]);
                        *(u32x4*)(Y + row * 2048 + c) = w; } }
        }
    }
};
struct SchedQKV {
    int nMq, nNq, nMk, nNk, G, c; const bf16_t* Aq; const bf16_t* Bq; const bf16_t* Ak; const bf16_t* Bk;
    __device__ __forceinline__ bool next(int i, UnitX& u) const {
        const int L = i * G + c, nq = nMq * nNq;
        Unit b; b.pm = 0; b.pn = 0; bool ok = true; int kind = 0;
        if (L < nq) StaticOrder::map_entry(nMq, nNq, L, b);
        else { const int L2 = L - nq; kind = 1; ok = L2 < nMk * nNk; if (ok) StaticOrder::map_entry(nMk, nNk, L2, b); }
        u.pm = b.pm; u.pn = b.pn; u.kind = kind; return ok;
    }
    __device__ __forceinline__ const bf16_t* gA(int k) const { return k == 0 ? Aq : Ak; }
    __device__ __forceinline__ const bf16_t* gB(int k) const { return k == 0 ? Bq : Bk; }
    __device__ __forceinline__ int gPitch(int k) const { return k == 0 ? 512 : 256; }
    __device__ __forceinline__ int gNt(int k) const { return k == 0 ? 8 : 4; }
    __device__ __forceinline__ int gK0(int) const { return 0; }
    __device__ __forceinline__ int gPerm(int) const { return 1; }
};
struct EpiQKV {
    EpiQup eq; EpiKV ek;
    __device__ __forceinline__ void operator()(const f32x4 (&acc)[2][2][4][2], int pm, int pn, int kind, int wr, int wc, int fr, int fq) const {
        Unit u; u.pm = pm; u.pn = pn;
        if (kind == 0) eq(acc, u, wr, wc, fr, fq); else ek(acc, u, wr, wc, fr, fq);
    }
};
struct SchedSplit {
    const bf16_t* A; const bf16_t* Bt; int K, nlat, nctx, G, c, wgm;
    __device__ __forceinline__ bool next(int i, UnitX& u) const {
        const int L = i * G + c; Unit b; b.pm = 0; b.pn = 0; int kind = 0; bool ok = true;
        if (L < nlat) StaticOrder::map_entry(ML_ROWS / BM, 8, L, b, wgm);
        else { const int e = L - nlat; ok = e < nctx; b.pm = ML_ROWS / BM + (e >> 5); b.pn = (e >> 2) & 7; kind = 1 + (e & 3); }
        u.pm = b.pm; u.pn = b.pn; u.kind = kind; return ok;
    }
    __device__ __forceinline__ const bf16_t* gA(int) const { return A; }
    __device__ __forceinline__ const bf16_t* gB(int) const { return Bt; }
    __device__ __forceinline__ int gPitch(int) const { return K; }
    __device__ __forceinline__ int gNt(int k) const { return k == 0 ? K / BK : K / (4 * BK); }
    __device__ __forceinline__ int gK0(int k) const { return k == 0 ? 0 : (k - 1) * (K / 4); }
    __device__ __forceinline__ int gPerm(int) const { return 1; }
};
struct EpiSplit {
    EpiResid er; bf16_t* PART;
    __device__ __forceinline__ void operator()(const f32x4 (&acc)[2][2][4][2], int pm, int pn, int kind, int wr, int wc, int fr, int fq) const {
        Unit u; u.pm = pm; u.pn = pn;
        if (kind == 0) { er(acc, u, wr, wc, fr, fq); return; }
        bf16_t* base = PART + ((size_t)(kind - 1) * 2048 + (size_t)(pm * BM - ML_ROWS + wr * 64 + fr)) * 2048 + pn * BM + wc * 32 + 8 * fq;
#pragma unroll
        for (int ai = 0; ai < 2; ++ai)
#pragma unroll
            for (int m = 0; m < 4; ++m) { bf16_t* rowp = base + (size_t)(ai * HALF + m * 16) * 2048;
#pragma unroll
                for (int bj = 0; bj < 2; ++bj) { const u32x2 w0 = pack4(acc[ai][bj][m][0]), w1 = pack4(acc[ai][bj][m][1]); u32x4 w; w.x = w0.x; w.y = w0.y; w.z = w1.x; w.w = w1.y; *(u32x4*)(rowp + bj * HALF) = w; } }
    }
};
}
#define XB_TMO      128
#define XB_XCNT(j)  (256  + 64 * (j))
#define XB_XSUB(j)  (1280 + 64 * (j))
#define XB_XGEN(j)  (2304 + 64 * (j))
#define XB_TOP      3328
#define XB_TOPGEN   3392
#define XCD_BAR_WORDS 3456
#define XB_SPIN_CAP (1u << 18)

__device__ __forceinline__ unsigned xb_ld(unsigned* p)              { return __hip_atomic_load(p, __ATOMIC_RELAXED, __HIP_MEMORY_SCOPE_AGENT); }
__device__ __forceinline__ unsigned xb_add(unsigned* p, unsigned v) { return __hip_atomic_fetch_add(p, v, __ATOMIC_RELAXED, __HIP_MEMORY_SCOPE_AGENT); }
__device__ __forceinline__ unsigned xb_xcc_id() { return (unsigned)__builtin_amdgcn_s_getreg((3 << 11) | 20) & 0xFu; }
#define XB_SPIN(cond, bar) do { unsigned _sp = 0; while (cond) { __builtin_amdgcn_s_sleep(1); \
    if ((++_sp & 255u) == 0u) { if (xb_ld(&(bar)[XB_TMO])) break; if (_sp > XB_SPIN_CAP) { atomicAdd(&(bar)[XB_TMO], 1u); break; } } } } while (0)

struct XcdBarrier {
    unsigned* bar; unsigned x;
    volatile LAS unsigned* st;
};

__device__ __forceinline__ XcdBarrier xcd_barrier_post(unsigned* bar, volatile LAS unsigned* st) {
    XcdBarrier b; b.bar = bar; b.x = xb_xcc_id(); b.st = st;
    if (threadIdx.x == 0) (void)xb_add(&bar[XB_XCNT(b.x)], 1u);
    return b;
}
__device__ __forceinline__ void xcd_barrier_complete(unsigned* bar, unsigned x, unsigned& nloc, unsigned& nx) {
    const unsigned G = gridDim.x * gridDim.y * gridDim.z;
    unsigned sum, cnt, mine, sp = 0u;
    for (;;) {
        sum = 0u; cnt = 0u; mine = 0u;
#pragma unroll
        for (unsigned j = 0; j < 16; ++j) { const unsigned c = xb_ld(&bar[XB_XCNT(j)]); sum += c; cnt += (c > 0u) ? 1u : 0u; mine = (j == x) ? c : mine; }
        if (sum == G) break;
        __builtin_amdgcn_s_sleep(1);
        if ((++sp & 255u) == 0u) { if (xb_ld(&bar[XB_TMO])) break; if (sp > XB_SPIN_CAP) { atomicAdd(&bar[XB_TMO], 1u); break; } }
    }
    nloc = mine > 0u ? mine : 1u; nx = cnt > 0u ? cnt : 1u;
}

__device__ __forceinline__ void xcd_barrier(const XcdBarrier& b) {
    asm volatile("s_waitcnt vmcnt(0)" ::: "memory");
    __syncthreads();
    if (threadIdx.x == 0) {
        unsigned* bar = b.bar;
        __builtin_amdgcn_s_waitcnt(0);
        unsigned nloc = b.st[0], nx = b.st[1];
        if (nloc == 0u) { xcd_barrier_complete(bar, b.x, nloc, nx); b.st[0] = nloc; b.st[1] = nx; }
        const unsigned old = xb_add(&bar[XB_XSUB(b.x)], 1u);
        const unsigned gen = old / nloc;
        if (old + 1u == (gen + 1u) * nloc) {
            __builtin_amdgcn_fence(__ATOMIC_RELEASE, "agent");
            asm volatile("s_waitcnt vmcnt(0)" ::: "memory");
            const unsigned og = xb_add(&bar[XB_TOP], 1u);
            const unsigned tg = og / nx;
            if (og + 1u == (tg + 1u) * nx) xb_add(&bar[XB_TOPGEN], 1u);
            else XB_SPIN(xb_ld(&bar[XB_TOPGEN]) == tg, bar);
            __builtin_amdgcn_fence(__ATOMIC_ACQUIRE, "agent");
            xb_add(&bar[XB_XGEN(b.x)], 1u);
            asm volatile("s_waitcnt vmcnt(0)" ::: "memory");
        } else {
            XB_SPIN(xb_ld(&bar[XB_XGEN(b.x)]) == gen, bar);
            __builtin_amdgcn_fence(__ATOMIC_ACQUIRE, "agent");
            asm volatile("s_waitcnt vmcnt(0)" ::: "memory");
        }
    }
    __syncthreads();
}
#ifndef ATT_ILV
#define ATT_ILV 1
#endif
#ifndef ATT_DMAW
#define ATT_DMAW 4
#endif
#ifndef ATT_YOUNG_FROM
#define ATT_YOUNG_FROM (ATT_ILV ? 512 : 256)
#endif
namespace att {
typedef unsigned short bf16_t;
using bf16x8 = __attribute__((ext_vector_type(8))) short;
using s16x4  = __attribute__((ext_vector_type(4))) short;
using f32x16 = __attribute__((ext_vector_type(16))) float;
using u32x4  = __attribute__((ext_vector_type(4))) unsigned;
typedef LAS char lchar;
#define ASBAR() __builtin_amdgcn_sched_barrier(0)
__device__ __forceinline__ int crow(int r, int hi) { return (r & 3) + 8 * (r >> 2) + 4 * hi; }
__device__ __forceinline__ unsigned cvtpk(float lo, float hi) { return pg8::cvt_pk_bf16(lo, hi); }
template <int DK> __device__ __forceinline__ int koff(int row, int chunk) {
    return row * (DK * 2) + ((chunk & ~7) << 4) + (((chunk & 7) ^ ((row >> 1) & 7)) << 4);
}
template <int DV> __device__ __forceinline__ int v_st(int k, int c) { constexpr int NCB = DV / 32; const int kk = (k & ~0xC) | ((k & 4) << 1) | ((k & 8) >> 1); return ((kk >> 3) * NCB + (c >> 5)) * 512 + ((kk & 7) * 32 + (c & 31)) * 2; }
__device__ __forceinline__ int v_rd_base(int lane) { return ((lane & 3) << 3) | (((lane >> 2) & 3) << 6) | (((lane >> 4) & 1) << 5) | (((lane >> 5) & 1) << 8); }
template <int DV> constexpr int v_rd_off(int d0, int ks, int half) { return d0 * 512 + ks * (2 * (DV / 32) * 512) + half * ((DV / 32) * 512); }
#if ATT_ILV
template <int OFF> __device__ __forceinline__ s16x4 tr_read(int vb) { return __builtin_amdgcn_ds_read_tr16_b64_v4i16((LAS s16x4*)(unsigned)(vb + OFF)); }
#else
template <int OFF> __device__ __forceinline__ s16x4 tr_read(int vb) { s16x4 r; asm volatile("ds_read_b64_tr_b16 %0, %1 offset:%2" : "=&v"(r) : "v"(vb), "i"(OFF) : "memory"); return r; }
#endif

__device__ __forceinline__ void glds16(const void* gsrc, unsigned lds_dst) { unsigned keep; lds_dst = __builtin_amdgcn_readfirstlane(lds_dst);
    asm volatile("s_mov_b32 %0, m0\n\ts_mov_b32 m0, %2\n\ts_nop 0\n\tglobal_load_lds_dwordx4 %1, off\n\ts_mov_b32 m0, %0" : "=&s"(keep) : "v"(gsrc), "s"(lds_dst) : "memory"); }
__device__ __forceinline__ void glds16s(const void* sbase, unsigned voff, unsigned lds_dst) { unsigned keep; lds_dst = __builtin_amdgcn_readfirstlane(lds_dst);
    const unsigned long long b = (unsigned long long)sbase; const unsigned blo = __builtin_amdgcn_readfirstlane((unsigned)b), bhi = __builtin_amdgcn_readfirstlane((unsigned)(b >> 32));
    const unsigned long long sb = ((unsigned long long)bhi << 32) | blo;
    asm volatile("s_mov_b32 %0, m0\n\ts_mov_b32 m0, %3\n\ts_nop 0\n\tglobal_load_lds_dwordx4 %1, %2\n\ts_mov_b32 m0, %0" : "=&s"(keep) : "v"(voff), "s"(sb), "s"(lds_dst) : "memory"); }
template <bool WIN>
__device__ __forceinline__ void partialSM(f32x16& p0, f32x16& p1, float& m_reg, float& mn, float& alpha, const float C, const float thr, const bool domask, const int dq, const int hi) {
#if ATT_ILV
    if constexpr (WIN) { const int dqq = domask ? dq : 0;
#pragma unroll
        for (int r = 0; r < 16; ++r) { const int d0 = dqq + crow(r, hi), d1 = d0 + 32; p0[r] = (d0 > 128 || d0 < -128) ? -1e30f : p0[r]; p1[r] = (d1 > 128 || d1 < -128) ? -1e30f : p1[r]; } }
#else
    if constexpr (WIN) { if (domask) {
#pragma unroll
        for (int r = 0; r < 16; ++r) { const int d0 = dq + crow(r, hi), d1 = d0 + 32; if (d0 > 128 || d0 < -128) p0[r] = -1e30f; if (d1 > 128 || d1 < -128) p1[r] = -1e30f; } } }
#endif
    float pmax = p0[0];
#pragma unroll
    for (int r = 1; r < 16; ++r) pmax = fmaxf(pmax, p0[r]);
#pragma unroll
    for (int r = 0; r < 16; ++r) pmax = fmaxf(pmax, p1[r]);
    { auto rr = __builtin_amdgcn_permlane32_swap(__float_as_uint(pmax), __float_as_uint(pmax), false, false); pmax = fmaxf(__uint_as_float(rr[0]), __uint_as_float(rr[1])); }
#if ATT_ILV
    { const bool keep = __all(pmax - m_reg <= thr); mn = fmaxf(m_reg, keep ? m_reg : pmax); alpha = __builtin_amdgcn_exp2f((m_reg - mn) * C); m_reg = mn; }
#else
    if (__builtin_expect(__all(pmax - m_reg <= thr), 1)) { mn = m_reg; alpha = 1.f; }
    else { mn = fmaxf(m_reg, pmax); alpha = __builtin_amdgcn_exp2f((m_reg - mn) * C); m_reg = mn; }
#endif
    const float mnC = -mn * C;
#pragma unroll
    for (int r = 0; r < 16; ++r) p0[r] = fmaf(p0[r], C, mnC);
#pragma unroll
    for (int r = 0; r < 16; ++r) p1[r] = fmaf(p1[r], C, mnC);
#pragma unroll
    for (int r = 0; r < 16; ++r) p0[r] = __builtin_amdgcn_exp2f(p0[r]);
}
__device__ __forceinline__ void finishSM(f32x16& p0, f32x16& p1, float alpha, float& l_reg, bf16x8& pa0, bf16x8& pa1, bf16x8& pa2, bf16x8& pa3) {
#pragma unroll
    for (int r = 0; r < 16; ++r) p1[r] = __builtin_amdgcn_exp2f(p1[r]);
    float ps = 0;
#pragma unroll
    for (int r = 0; r < 16; ++r) ps += p0[r];
#pragma unroll
    for (int r = 0; r < 16; ++r) ps += p1[r];
    { auto rr = __builtin_amdgcn_permlane32_swap(__float_as_uint(ps), __float_as_uint(ps), false, false); ps = __uint_as_float(rr[0]) + __uint_as_float(rr[1]); }
    l_reg = l_reg * alpha + ps;
#define ATT_PK4(P, BASE, OUT) do { unsigned a0 = cvtpk(P[BASE + 0], P[BASE + 1]), a1 = cvtpk(P[BASE + 2], P[BASE + 3]);   \
    unsigned b0 = cvtpk(P[BASE + 4], P[BASE + 5]), b1 = cvtpk(P[BASE + 6], P[BASE + 7]);                              \
    auto r0 = __builtin_amdgcn_permlane32_swap(a0, b0, false, false); auto r1 = __builtin_amdgcn_permlane32_swap(a1, b1, false, false); \
    u32x4 w = {r0[0], r1[0], r0[1], r1[1]}; OUT = *reinterpret_cast<bf16x8*>(&w); } while (0)
    ATT_PK4(p0, 0, pa0); ATT_PK4(p0, 8, pa1); ATT_PK4(p1, 0, pa2); ATT_PK4(p1, 8, pa3);
#undef ATT_PK4
}
template <int DK> __device__ __forceinline__ void qkt(f32x16& p0, f32x16& p1, const lchar* Ks, const bf16x8 (&qr)[DK / 16], const int (&kq)[4]) {
    p0 = f32x16{}; p1 = f32x16{};
    bf16x8 c0 = *(const LAS bf16x8*)(Ks + kq[0]), c1 = *(const LAS bf16x8*)(Ks + kq[0] + 32 * DK * 2);
#pragma unroll
    for (int d0 = 0; d0 < DK / 16; ++d0) {
        bf16x8 n0 = c0, n1 = c1;
        if (d0 + 1 < DK / 16) { n0 = *(const LAS bf16x8*)(Ks + kq[(d0 + 1) & 3] + ((d0 + 1) >> 2) * 128); n1 = *(const LAS bf16x8*)(Ks + kq[(d0 + 1) & 3] + ((d0 + 1) >> 2) * 128 + 32 * DK * 2); }
        p0 = __builtin_amdgcn_mfma_f32_32x32x16_bf16(c0, qr[d0], p0, 0, 0, 0);
        p1 = __builtin_amdgcn_mfma_f32_32x32x16_bf16(c1, qr[d0], p1, 0, 0, 0);
        c0 = n0; c1 = n1; }
}
struct VFrag { s16x4 l0, h0, l1, h1, l2, h2, l3, h3; };
template <int DV, int D0> __device__ __forceinline__ void pv_reads(VFrag& f, int vb) {
    f.l0 = tr_read<v_rd_off<DV>(D0, 0, 0)>(vb); f.h0 = tr_read<v_rd_off<DV>(D0, 0, 1)>(vb); f.l1 = tr_read<v_rd_off<DV>(D0, 1, 0)>(vb); f.h1 = tr_read<v_rd_off<DV>(D0, 1, 1)>(vb);
    f.l2 = tr_read<v_rd_off<DV>(D0, 2, 0)>(vb); f.h2 = tr_read<v_rd_off<DV>(D0, 2, 1)>(vb); f.l3 = tr_read<v_rd_off<DV>(D0, 3, 0)>(vb); f.h3 = tr_read<v_rd_off<DV>(D0, 3, 1)>(vb);
}
__device__ __forceinline__ void pv_mma(f32x16& od, const VFrag& f, bf16x8 pa0, bf16x8 pa1, bf16x8 pa2, bf16x8 pa3) {
#define ATT_PK(L, H) (bf16x8){L[0], L[1], L[2], L[3], H[0], H[1], H[2], H[3]}
    od = __builtin_amdgcn_mfma_f32_32x32x16_bf16(pa0, ATT_PK(f.l0, f.h0), od, 0, 0, 0);
    od = __builtin_amdgcn_mfma_f32_32x32x16_bf16(pa1, ATT_PK(f.l1, f.h1), od, 0, 0, 0);
    od = __builtin_amdgcn_mfma_f32_32x32x16_bf16(pa2, ATT_PK(f.l2, f.h2), od, 0, 0, 0);
    od = __builtin_amdgcn_mfma_f32_32x32x16_bf16(pa3, ATT_PK(f.l3, f.h3), od, 0, 0, 0);
#undef ATT_PK
}
#define ATT_LWAIT(n) do { asm volatile("s_waitcnt lgkmcnt(" #n ")" ::: "memory"); ASBAR(); } while (0)
#if ATT_ILV
template <int DV> __device__ __forceinline__ void pv_all(f32x16 (&o)[DV / 32], int vb, bf16x8 pa0, bf16x8 pa1, bf16x8 pa2, bf16x8 pa3) {
    { VFrag f; pv_reads<DV, 0>(f, vb); pv_mma(o[0], f, pa0, pa1, pa2, pa3); }
    { VFrag f; pv_reads<DV, 1>(f, vb); pv_mma(o[1], f, pa0, pa1, pa2, pa3); }
    if constexpr (DV == 128) {
        { VFrag f; pv_reads<DV, 2>(f, vb); pv_mma(o[2], f, pa0, pa1, pa2, pa3); }
        { VFrag f; pv_reads<DV, 3>(f, vb); pv_mma(o[3], f, pa0, pa1, pa2, pa3); } }
}
#define ATT_SWAP(A, B) __builtin_amdgcn_permlane32_swap((A), (B), false, false)
#define ATT_PIN(X) asm volatile("" : "+v"(X))
template <int PT, int B> __device__ __forceinline__ void pk_step(const f32x16& P, unsigned& a0, unsigned& a1, unsigned& b0, unsigned& b1, unsigned& x0, unsigned& y0, bf16x8& OUT) {
    if constexpr (PT == 0) { a0 = cvtpk(P[B + 0], P[B + 1]); b0 = cvtpk(P[B + 4], P[B + 5]); }
    if constexpr (PT == 1) { a1 = cvtpk(P[B + 2], P[B + 3]); b1 = cvtpk(P[B + 6], P[B + 7]); }
    if constexpr (PT == 2) { auto r0 = ATT_SWAP(a0, b0); x0 = r0[0]; y0 = r0[1]; }
    if constexpr (PT == 3) { auto r1 = ATT_SWAP(a1, b1); u32x4 w = {x0, r1[0], y0, r1[1]}; OUT = *reinterpret_cast<bf16x8*>(&w); }
}
template <int K> __device__ __forceinline__ void fin_atom(f32x16& q0, f32x16& q1, float alpha, float& l_reg, float& ps0, float& ps1, unsigned& a0, unsigned& a1, unsigned& b0, unsigned& b1, unsigned& x0, unsigned& y0,
                                                          bf16x8& pa0, bf16x8& pa1, bf16x8& pa2, bf16x8& pa3) {
    if constexpr (K < 16) { q1[K] = __builtin_amdgcn_exp2f(q1[K]); ATT_PIN(q1[K]); ps0 += q0[K]; ATT_PIN(ps0); }
    if constexpr (K >= 8) { ps1 += q1[K - 8]; ATT_PIN(ps1); }
    if constexpr (K < 4) pk_step<K & 3, 0>(q0, a0, a1, b0, b1, x0, y0, pa0);
    else if constexpr (K < 8) pk_step<K & 3, 8>(q0, a0, a1, b0, b1, x0, y0, pa1);
    else if constexpr (K >= 16 && K < 20) pk_step<K & 3, 0>(q1, a0, a1, b0, b1, x0, y0, pa2);
    else if constexpr (K >= 20) pk_step<K & 3, 8>(q1, a0, a1, b0, b1, x0, y0, pa3);
    if constexpr (K == 23) { float ps = ps0 + ps1; auto rr = ATT_SWAP(__float_as_uint(ps), __float_as_uint(ps)); ps = __uint_as_float(rr[0]) + __uint_as_float(rr[1]); l_reg = l_reg * alpha + ps; }
}
template <int I, int NM, int DK> __device__ __forceinline__ void qk_step(f32x16& p0, f32x16& p1, const lchar* Ks, const bf16x8 (&qr)[DK / 16], const int (&kq)[4], bf16x8 (&F)[4],
        f32x16& q0, f32x16& q1, float alpha, float& l_reg, float& ps0, float& ps1, unsigned& a0, unsigned& a1, unsigned& b0, unsigned& b1, unsigned& x0, unsigned& y0, bf16x8& pa0, bf16x8& pa1, bf16x8& pa2, bf16x8& pa3) {
    constexpr int d0 = I >> 1, APG = 24 / NM;
    if constexpr (I == 0) p0 = __builtin_amdgcn_mfma_f32_32x32x16_bf16(F[0], qr[0], f32x16{}, 0, 0, 0);
    else if constexpr (I == 1) p1 = __builtin_amdgcn_mfma_f32_32x32x16_bf16(F[1], qr[0], f32x16{}, 0, 0, 0);
    else if constexpr ((I & 1) == 0) p0 = __builtin_amdgcn_mfma_f32_32x32x16_bf16(F[I & 3], qr[d0], p0, 0, 0, 0);
    else p1 = __builtin_amdgcn_mfma_f32_32x32x16_bf16(F[I & 3], qr[d0], p1, 0, 0, 0);
    if constexpr (I + 4 < NM) { constexpr int J = I + 4, e0 = J >> 1; F[I & 3] = *(const LAS bf16x8*)(Ks + kq[e0 & 3] + (e0 >> 2) * 128 + (J & 1) * (32 * DK * 2)); }
    fin_atom<APG * I>(q0, q1, alpha, l_reg, ps0, ps1, a0, a1, b0, b1, x0, y0, pa0, pa1, pa2, pa3);
    if constexpr (APG >= 2) fin_atom<APG * I + 1>(q0, q1, alpha, l_reg, ps0, ps1, a0, a1, b0, b1, x0, y0, pa0, pa1, pa2, pa3);
    if constexpr (APG >= 3) fin_atom<APG * I + 2>(q0, q1, alpha, l_reg, ps0, ps1, a0, a1, b0, b1, x0, y0, pa0, pa1, pa2, pa3);
    ASBAR();
    if constexpr (I + 1 < NM) qk_step<I + 1, NM, DK>(p0, p1, Ks, qr, kq, F, q0, q1, alpha, l_reg, ps0, ps1, a0, a1, b0, b1, x0, y0, pa0, pa1, pa2, pa3);
}
template <int DK> __device__ __forceinline__ void qkt_fin(f32x16& p0, f32x16& p1, const lchar* Ks, const bf16x8 (&qr)[DK / 16], const int (&kq)[4],
        f32x16& q0, f32x16& q1, float alpha, float& l_reg, bf16x8& pa0, bf16x8& pa1, bf16x8& pa2, bf16x8& pa3) {
    constexpr int NM = DK / 8;
    bf16x8 F[4];
#pragma unroll
    for (int i = 0; i < 4; ++i) F[i] = *(const LAS bf16x8*)(Ks + kq[(i >> 1) & 3] + ((i >> 1) >> 2) * 128 + (i & 1) * (32 * DK * 2));
    float ps0 = 0.f, ps1 = 0.f; unsigned a0 = 0, a1 = 0, b0 = 0, b1 = 0, x0 = 0, y0 = 0;
    ASBAR();
    qk_step<0, NM, DK>(p0, p1, Ks, qr, kq, F, q0, q1, alpha, l_reg, ps0, ps1, a0, a1, b0, b1, x0, y0, pa0, pa1, pa2, pa3);
}
template <int K, bool WIN> __device__ __forceinline__ void par_atom(f32x16& p0, f32x16& p1, float& m_reg, float& mn, float& alpha, const float C, const float thr, const int dqq, const int hi,
                                                                    float& pm0, float& pm1, float& pm2, float& pm3, float& mnC) {
    if constexpr (K < 4) { f32x16& P = (K < 2) ? p0 : p1; constexpr int B = (K & 1) * 8;
        if constexpr (WIN) {
#pragma unroll
            for (int r = B; r < B + 8; ++r) { const int d = dqq + crow(r, hi) + (K < 2 ? 0 : 32); P[r] = (d > 128 || d < -128) ? -1e30f : P[r]; } }
        const float m = fmaxf(fmaxf(fmaxf(P[B], P[B + 1]), fmaxf(P[B + 2], P[B + 3])), fmaxf(fmaxf(P[B + 4], P[B + 5]), fmaxf(P[B + 6], P[B + 7])));
        if constexpr (K == 0) pm0 = m; else if constexpr (K == 1) pm1 = m; else if constexpr (K == 2) pm2 = m; else pm3 = m; }
    if constexpr (K == 4) { float pmax = fmaxf(fmaxf(pm0, pm1), fmaxf(pm2, pm3));
        auto rr = ATT_SWAP(__float_as_uint(pmax), __float_as_uint(pmax)); pmax = fmaxf(__uint_as_float(rr[0]), __uint_as_float(rr[1]));
        const bool keep = __all(pmax - m_reg <= thr); mn = fmaxf(m_reg, keep ? m_reg : pmax); alpha = __builtin_amdgcn_exp2f((m_reg - mn) * C); m_reg = mn; mnC = -mn * C; }
    if constexpr (K >= 5 && K <= 8) { f32x16& P = (K < 7) ? p0 : p1; constexpr int B = ((K - 5) & 1) * 8;
#pragma unroll
        for (int r = B; r < B + 8; ++r) { P[r] = fmaf(P[r], C, mnC); ATT_PIN(P[r]); } }
    if constexpr (K >= 8) { p0[2 * (K - 8)] = __builtin_amdgcn_exp2f(p0[2 * (K - 8)]); p0[2 * (K - 8) + 1] = __builtin_amdgcn_exp2f(p0[2 * (K - 8) + 1]); ATT_PIN(p0[2 * (K - 8)]); ATT_PIN(p0[2 * (K - 8) + 1]); }
}
template <int I, int NM, int DV, bool WIN> __device__ __forceinline__ void pv_step(f32x16 (&o)[DV / 32], const int vb, const bf16x8 (&pa)[4], s16x4 (&L)[4], s16x4 (&H)[4],
        f32x16& p0, f32x16& p1, float& m_reg, float& mn, float& alpha, const float C, const float thr, const int dqq, const int hi, float& pm0, float& pm1, float& pm2, float& pm3, float& mnC) {
    constexpr int b = I >> 2, k = I & 3, APG = 16 / NM;
    { const s16x4 l = L[k], h = H[k]; o[b] = __builtin_amdgcn_mfma_f32_32x32x16_bf16(pa[k], (bf16x8){l[0], l[1], l[2], l[3], h[0], h[1], h[2], h[3]}, o[b], 0, 0, 0); }
    if constexpr (b + 1 < DV / 32) { L[k] = tr_read<v_rd_off<DV>(b + 1, k, 0)>(vb); H[k] = tr_read<v_rd_off<DV>(b + 1, k, 1)>(vb); }
    par_atom<APG * I, WIN>(p0, p1, m_reg, mn, alpha, C, thr, dqq, hi, pm0, pm1, pm2, pm3, mnC);
    if constexpr (APG >= 2) par_atom<APG * I + 1, WIN>(p0, p1, m_reg, mn, alpha, C, thr, dqq, hi, pm0, pm1, pm2, pm3, mnC);
    ASBAR();
    if constexpr (I + 1 < NM) pv_step<I + 1, NM, DV, WIN>(o, vb, pa, L, H, p0, p1, m_reg, mn, alpha, C, thr, dqq, hi, pm0, pm1, pm2, pm3, mnC);
}
template <int DV, bool WIN> __device__ __forceinline__ void pv_part(f32x16 (&o)[DV / 32], const int vb, bf16x8 pa0, bf16x8 pa1, bf16x8 pa2, bf16x8 pa3,
        f32x16& p0, f32x16& p1, float& m_reg, float& mn, float& alpha, const float C, const float thr, const bool domask, const int dq, const int hi) {
    constexpr int NM = DV / 8;
    const bf16x8 pa[4] = {pa0, pa1, pa2, pa3}; s16x4 L[4], H[4];
    L[0] = tr_read<v_rd_off<DV>(0, 0, 0)>(vb); H[0] = tr_read<v_rd_off<DV>(0, 0, 1)>(vb); L[1] = tr_read<v_rd_off<DV>(0, 1, 0)>(vb); H[1] = tr_read<v_rd_off<DV>(0, 1, 1)>(vb);
    L[2] = tr_read<v_rd_off<DV>(0, 2, 0)>(vb); H[2] = tr_read<v_rd_off<DV>(0, 2, 1)>(vb); L[3] = tr_read<v_rd_off<DV>(0, 3, 0)>(vb); H[3] = tr_read<v_rd_off<DV>(0, 3, 1)>(vb);
    float pm0 = 0.f, pm1 = 0.f, pm2 = 0.f, pm3 = 0.f, mnC = 0.f; const int dqq = domask ? dq : 0;
    ASBAR();
    pv_step<0, NM, DV, WIN>(o, vb, pa, L, H, p0, p1, m_reg, mn, alpha, C, thr, dqq, hi, pm0, pm1, pm2, pm3, mnC);
}
#else
template <int NM, int ND, int NV> __device__ __forceinline__ void sgb_pattern() {}
template <int DV> __device__ __forceinline__ void pv_all(f32x16 (&o)[DV / 32], int vb, bf16x8 pa0, bf16x8 pa1, bf16x8 pa2, bf16x8 pa3) {
    VFrag f;
    pv_reads<DV, 0>(f, vb); ATT_LWAIT(0); pv_mma(o[0], f, pa0, pa1, pa2, pa3);
    pv_reads<DV, 1>(f, vb); ATT_LWAIT(0); pv_mma(o[1], f, pa0, pa1, pa2, pa3);
    if constexpr (DV == 128) {
        pv_reads<DV, 2>(f, vb); ATT_LWAIT(0); pv_mma(o[2], f, pa0, pa1, pa2, pa3);
        pv_reads<DV, 3>(f, vb); ATT_LWAIT(0); pv_mma(o[3], f, pa0, pa1, pa2, pa3); }
}
#endif
template <int DK, int DV, bool WIN, bool SINK, int MODE>
__device__ __forceinline__ void attn_unit(const bf16_t* __restrict__ Qb, const int ldq, const bf16_t* __restrict__ Kb, const int ldk, const bf16_t* __restrict__ Vb, const int ldv,
                                          bf16_t* __restrict__ Ob, const int ldo, const int cbase, const int lbase, const int NT, const int qpos0, const int kpos0, const float sinkl2, lchar* lds) {
    constexpr int KI = DK / 64, VI = DV / 64, ND = DK / 16, NO = DV / 32, SHM_K = 64 * DK * 2, SHM_V = 64 * DV * 2;
    constexpr float SCALE = (DK == 192) ? 0.07216878364870322f : 0.125f, C = SCALE * 1.4426950408889634f, THRR = 8.0f / SCALE;
    int tid_ = threadIdx.x; asm volatile("" : "+v"(tid_));
    const int tid = tid_, wid = tid >> 6, lane = tid & 63, r32 = lane & 31, hi = lane >> 5;
    constexpr int NSLOT = (MODE == 2) ? 3 : 2;
    lchar* V_lds = lds; lchar* K_lds = lds + NSLOT * SHM_V;
    LAS float* wsf = (LAS float*)(lds + NSLOT * SHM_V + NSLOT * SHM_K) + wid * 64; LAS float* li_l = wsf; LAS float* al_l = wsf + 32;
    float m_reg = -1e30f, l_reg = 0.f; f32x16 o[NO]; bf16x8 qr[ND];
#pragma unroll
    for (int d = 0; d < NO; ++d) o[d] = f32x16{};
    const bf16_t* Qw = Qb + (long)(wid * 32 + r32) * ldq + hi * 8;
#pragma unroll
    for (int d0 = 0; d0 < ND; ++d0) qr[d0] = *(const bf16x8*)(Qw + d0 * 16);
    const int srow = tid >> 3, scg = tid & 7;
    const int kgo = srow * ldk + scg * 8, vgo = srow * ldv + scg * 8;
    int klo[KI];
#pragma unroll
    for (int i = 0; i < KI; ++i) klo[i] = koff<DK>(srow, scg + 8 * i);
    const int vlo = v_st<DV>(srow, scg * 8);
    const int vb0 = (int)(uintptr_t)V_lds + v_rd_base(lane);
    const int qpos = qpos0 + wid * 32 + r32;
    int kq[4];
#pragma unroll
    for (int k = 0; k < 4; ++k) kq[k] = r32 * (DK * 2) + (((2 * k) ^ hi ^ ((r32 >> 1) & 7)) << 4);
    bf16x8 ks[KI], vs[VI];
#define ATT_ROWOF(j) ((j) < 4 ? cbase + 64 * (j) : lbase + 64 * ((j) - 4))
#define ATT_SLOAD(j) do { const long rb_ = ATT_ROWOF(j); const bf16_t* kp_ = Kb + rb_ * ldk + kgo; const bf16_t* vp_ = Vb + rb_ * ldv + vgo; \
    _Pragma("unroll") for (int i_ = 0; i_ < KI; ++i_) ks[i_] = *(const bf16x8*)(kp_ + 64 * i_); \
    _Pragma("unroll") for (int i_ = 0; i_ < VI; ++i_) vs[i_] = *(const bf16x8*)(vp_ + 64 * i_); } while (0)
#define ATT_SWRITE(b) do { _Pragma("unroll") for (int i_ = 0; i_ < KI; ++i_) *(LAS bf16x8*)(K_lds + (b) * SHM_K + klo[i_]) = ks[i_]; \
    _Pragma("unroll") for (int i_ = 0; i_ < VI; ++i_) *(LAS bf16x8*)(V_lds + (b) * SHM_V + vlo + i_ * 1024) = vs[i_]; } while (0)
#define ATT_RESC(a) do { if (__any((a) < 1.f)) { if (hi == 0) al_l[r32] = (a); asm volatile("s_waitcnt lgkmcnt(0)" ::: "memory"); \
    _Pragma("unroll") for (int d_ = 0; d_ < NO; ++d_) _Pragma("unroll") for (int r_ = 0; r_ < 16; ++r_) o[d_][r_] *= al_l[crow(r_, hi)]; } } while (0)
#define ATT_DQ(j) (kpos0 + 64 * ((j) - 4) - qpos)
    f32x16 pA0, pA1, pB0, pB1; float mnA, mnB, alA, alB; bf16x8 pa0, pa1, pa2, pa3;
    __syncthreads();
    if constexpr (MODE == 2) {
        const int wu = __builtin_amdgcn_readfirstlane(wid);
        constexpr int DW = ATT_DMAW, KP = KI * 8 / DW, VP = VI * 8 / DW;
        const bool dmaw = wu < DW;
        int kgs[KP], vgs[VP];
#pragma unroll
        for (int i = 0; i < KP; ++i) { const int p = (wu * KP + i) * 64 + lane, kr = p / (DK / 8), c2 = p % (DK / 8); kgs[i] = kr * ldk + (((c2 & ~7) | ((c2 & 7) ^ ((kr >> 1) & 7))) << 3); }
#pragma unroll
        for (int i = 0; i < VP; ++i) { const int u16 = (wu * VP + i) * 64 + lane, st = u16 >> 5, kk = (st / (DV / 32)) * 8 + ((u16 >> 2) & 7), c = (st % (DV / 32)) * 32 + (u16 & 3) * 8;
            const int k = (kk & ~0xC) | ((kk & 4) << 1) | ((kk & 8) >> 1); vgs[i] = k * ldv + c; }
        const unsigned kl0 = (unsigned)(uintptr_t)K_lds + (unsigned)(wu * KP) * 1024u, vl0 = (unsigned)(uintptr_t)V_lds + (unsigned)(wu * VP) * 1024u;
#define ATT_DMAK(j, slot) do { const bf16_t* kp_ = Kb + (long)ATT_ROWOF(j) * ldk; if (dmaw) { _Pragma("unroll") for (int i_ = 0; i_ < KP; ++i_) glds16s(kp_, (unsigned)kgs[i_] * 2u, kl0 + (unsigned)(slot) * SHM_K + i_ * 1024); } } while (0)
#define ATT_DMAV(j, slot) do { const bf16_t* vp_ = Vb + (long)ATT_ROWOF(j) * ldv; if (dmaw) { _Pragma("unroll") for (int i_ = 0; i_ < VP; ++i_) glds16s(vp_, (unsigned)vgs[i_] * 2u, vl0 + (unsigned)(slot) * SHM_V + i_ * 1024); } } while (0)
#define ATT_WAITN(n) asm volatile("s_waitcnt vmcnt(" #n ") lgkmcnt(0)" ::: "memory")
#define ATT_WAIT1() do { if constexpr (KP + VP == 10) ATT_WAITN(10); else if constexpr (KP + VP == 5) ATT_WAITN(5); else if constexpr (KP + VP == 4) ATT_WAITN(4); else { static_assert(KP + VP == 2); ATT_WAITN(2); } } while (0)
#define ATT_WAIT2() do { if constexpr (KP + VP == 10) ATT_WAITN(20); else if constexpr (KP + VP == 5) ATT_WAITN(10); else if constexpr (KP + VP == 4) ATT_WAITN(8); else ATT_WAITN(4); } while (0)
#define ATT_SYNC(j) do { const int sp_ = (sc == 0) ? 2 : sc - 1; if ((j) + 2 < NT) ATT_WAIT1(); else ATT_WAITN(0); \
        __builtin_amdgcn_s_barrier(); asm volatile("" ::: "memory"); \
        if ((j) + 3 < NT) ATT_DMAK((j) + 3, sc); if ((j) + 2 < NT) ATT_DMAV((j) + 2, sp_); } while (0)
#define ATT_STEP_OLD(j, PC0, PC1, MNC, ALC, PP0, PP1, MNP, ALP) do { const int spv_ = (sc == 0) ? 2 : sc - 1; \
        ASBAR(); qkt_fin<DK>(PC0, PC1, K_lds + sc * SHM_K, qr, kq, PP0, PP1, ALP, l_reg, pa0, pa1, pa2, pa3); \
        pv_part<DV, WIN>(o, vb0 + spv_ * SHM_V, pa0, pa1, pa2, pa3, PC0, PC1, m_reg, MNC, ALC, C, THRR, (j) >= 4, ATT_DQ(j), hi); \
        ATT_SYNC(j); ATT_RESC(ALC); sc = (sc == 2) ? 0 : sc + 1; } while (0)
#define ATT_STEP_YNG(j, PC0, PC1, MNC, ALC, PP0, PP1, MNP, ALP) do { const int spv_ = (sc == 0) ? 2 : sc - 1; \
        partialSM<WIN>(PP0, PP1, m_reg, MNP, ALP, C, THRR, (j) - 1 >= 4, ATT_DQ((j) - 1), hi); ATT_RESC(ALP); \
        ASBAR(); qkt<DK>(PC0, PC1, K_lds + sc * SHM_K, qr, kq); \
        finishSM(PP0, PP1, ALP, l_reg, pa0, pa1, pa2, pa3); ASBAR(); \
        pv_all<DV>(o, vb0 + spv_ * SHM_V, pa0, pa1, pa2, pa3); \
        ATT_SYNC(j); sc = (sc == 2) ? 0 : sc + 1; } while (0)
        const bool young = (ATT_YOUNG_FROM < 512) && __builtin_amdgcn_readfirstlane(tid) >= ATT_YOUNG_FROM;
        ATT_WAITN(0); __builtin_amdgcn_s_barrier(); asm volatile("" ::: "memory");
        ATT_DMAK(0, 0); ATT_DMAK(1, 1); ATT_DMAV(0, 0); ATT_DMAK(2, 2); ATT_DMAV(1, 1);
        ATT_WAIT2(); __builtin_amdgcn_s_barrier(); asm volatile("" ::: "memory");
        int sc = 0;
        if (young) {
            qkt<DK>(pA0, pA1, K_lds, qr, kq);
            ATT_SYNC(0); sc = 1;
            for (int j = 1; j + 1 < NT; j += 2) {
                ATT_STEP_YNG(j, pB0, pB1, mnB, alB, pA0, pA1, mnA, alA);
                ATT_STEP_YNG(j + 1, pA0, pA1, mnA, alA, pB0, pB1, mnB, alB);
            }
            ATT_STEP_YNG(NT - 1, pB0, pB1, mnB, alB, pA0, pA1, mnA, alA);
            partialSM<WIN>(pB0, pB1, m_reg, mnB, alB, C, THRR, NT - 1 >= 4, ATT_DQ(NT - 1), hi); ATT_RESC(alB);
        } else {
            qkt<DK>(pA0, pA1, K_lds, qr, kq); partialSM<WIN>(pA0, pA1, m_reg, mnA, alA, C, THRR, false, 0, hi);
            ATT_SYNC(0); ATT_RESC(alA); sc = 1;
            for (int j = 1; j + 1 < NT; j += 2) {
                ATT_STEP_OLD(j, pB0, pB1, mnB, alB, pA0, pA1, mnA, alA);
                ATT_STEP_OLD(j + 1, pA0, pA1, mnA, alA, pB0, pB1, mnB, alB);
            }
            ATT_STEP_OLD(NT - 1, pB0, pB1, mnB, alB, pA0, pA1, mnA, alA);
        }
        finishSM(pB0, pB1, alB, l_reg, pa0, pa1, pa2, pa3); ASBAR();
        pv_all<DV>(o, vb0 + ((sc == 0) ? 2 : sc - 1) * SHM_V, pa0, pa1, pa2, pa3);
#undef ATT_SYNC
#undef ATT_STEP_OLD
#undef ATT_STEP_YNG
#undef ATT_DMAK
#undef ATT_DMAV
#undef ATT_WAITN
#undef ATT_WAIT1
#undef ATT_WAIT2
    } else if constexpr (MODE == 1) {
        ATT_SLOAD(0); asm volatile("s_waitcnt vmcnt(0)" ::: "memory"); ATT_SWRITE(0); __syncthreads();
        for (int j = 0; j < NT; ++j) {
            const int b = j & 1;
            if (j + 1 < NT) ATT_SLOAD(j + 1);
            ASBAR(); qkt<DK>(pA0, pA1, K_lds + b * SHM_K, qr, kq);
            partialSM<WIN>(pA0, pA1, m_reg, mnA, alA, C, THRR, j >= 4, ATT_DQ(j), hi);
            ATT_RESC(alA);
            finishSM(pA0, pA1, alA, l_reg, pa0, pa1, pa2, pa3); ASBAR();
            pv_all<DV>(o, vb0 + b * SHM_V, pa0, pa1, pa2, pa3);
            if (j + 1 < NT) { asm volatile("s_waitcnt vmcnt(0)" ::: "memory"); ATT_SWRITE(b ^ 1); }
            __syncthreads();
        }
    } else {
    ATT_SLOAD(0); asm volatile("s_waitcnt vmcnt(0)" ::: "memory"); ATT_SWRITE(0); __syncthreads();
    qkt<DK>(pA0, pA1, K_lds, qr, kq); partialSM<WIN>(pA0, pA1, m_reg, mnA, alA, C, THRR, false, 0, hi);
    ATT_SLOAD(1); asm volatile("s_waitcnt vmcnt(0)" ::: "memory"); ATT_SWRITE(1); __syncthreads();
    for (int j = 1; j + 1 < NT; j += 2) {
        ASBAR(); qkt<DK>(pB0, pB1, K_lds + SHM_K, qr, kq);
        finishSM(pA0, pA1, alA, l_reg, pa0, pa1, pa2, pa3); ASBAR();
        ATT_SLOAD(j + 1); ASBAR();
        pv_all<DV>(o, vb0, pa0, pa1, pa2, pa3); partialSM<WIN>(pB0, pB1, m_reg, mnB, alB, C, THRR, j >= 4, ATT_DQ(j), hi);
        __syncthreads(); asm volatile("s_waitcnt vmcnt(0)" ::: "memory"); ATT_SWRITE(0);
        ATT_RESC(alB); __syncthreads();
        ASBAR(); qkt<DK>(pA0, pA1, K_lds, qr, kq);
        finishSM(pB0, pB1, alB, l_reg, pa0, pa1, pa2, pa3); ASBAR();
        ATT_SLOAD(j + 2); ASBAR();
        pv_all<DV>(o, vb0 + SHM_V, pa0, pa1, pa2, pa3); partialSM<WIN>(pA0, pA1, m_reg, mnA, alA, C, THRR, j + 1 >= 4, ATT_DQ(j + 1), hi);
        __syncthreads(); asm volatile("s_waitcnt vmcnt(0)" ::: "memory"); ATT_SWRITE(1);
        ATT_RESC(alA); __syncthreads();
    }
    ASBAR(); qkt<DK>(pB0, pB1, K_lds + SHM_K, qr, kq);
    finishSM(pA0, pA1, alA, l_reg, pa0, pa1, pa2, pa3); ASBAR();
    pv_all<DV>(o, vb0, pa0, pa1, pa2, pa3); partialSM<WIN>(pB0, pB1, m_reg, mnB, alB, C, THRR, NT - 1 >= 4, ATT_DQ(NT - 1), hi);
    __syncthreads(); ATT_RESC(alB);
    finishSM(pB0, pB1, alB, l_reg, pa0, pa1, pa2, pa3); ASBAR();
    pv_all<DV>(o, vb0 + SHM_V, pa0, pa1, pa2, pa3);
    }
    if constexpr (SINK) l_reg += __builtin_amdgcn_exp2f(sinkl2 - m_reg * C);
    if (hi == 0) li_l[r32] = l_reg;
    asm volatile("s_waitcnt lgkmcnt(0)" ::: "memory");
    float rli[16];
#pragma unroll
    for (int r = 0; r < 16; ++r) rli[r] = __builtin_amdgcn_rcpf(li_l[crow(r, hi)]);
    bf16_t* Ow = Ob + (long)(wid * 32) * ldo + r32;
#pragma unroll
    for (int r = 0; r < 16; ++r) { const int orow = crow(r, hi);
#pragma unroll
        for (int d0 = 0; d0 < NO; ++d0) Ow[(long)orow * ldo + d0 * 32] = (bf16_t)(cvtpk(o[d0][r] * rli[r], 0.f) & 0xffffu); }
#undef ATT_ROWOF
#undef ATT_SLOAD
#undef ATT_SWRITE
#undef ATT_RESC
#undef ATT_DQ
}
}
typedef unsigned short bf16;
typedef unsigned v4u __attribute__((ext_vector_type(4)));
typedef unsigned v2u __attribute__((ext_vector_type(2)));
typedef float f32x4 __attribute__((ext_vector_type(4)));
typedef short bf16x8 __attribute__((ext_vector_type(8)));
typedef GAS unsigned gu32;
#define LDS_WAIT() asm volatile("s_waitcnt lgkmcnt(0)" ::: "memory")
#define VM_WAIT() asm volatile("s_waitcnt vmcnt(0)" ::: "memory")

constexpr int NWAVES = 8;
constexpr int DM = 2048, NB = 8, SEQ = 4096, DEPTH = 4, CTXL = 256, DFF = 5632;
constexpr int ML = NB * SEQ, MC = NB * CTXL, MT = ML + MC;
constexpr int NIN = 8768, NINP = 8960, NMOD = 6 * DM;
constexpr float EPS = 1e-6f;
static_assert(ML == pg8::ML_ROWS, "row split");

constexpr size_t MiB = 1u << 20;
constexpr size_t WS_CTL = 0, CTL_ZERO_BYTES = 1 * MiB;
constexpr size_t WS_MOD = 1 * MiB;
constexpr size_t WS_ROPE = 3 * MiB;
constexpr size_t WS_W = 4 * MiB;
constexpr size_t WO_IN = 0, WO_Q = WO_IN + (size_t)NINP * DM * 2, WO_KV = WO_Q + (size_t)1536 * 512 * 2, WO_C = WO_KV + (size_t)2048 * 256 * 2, WO_M = WO_C + (size_t)2048 * 512 * 2,
                 WO_G = WO_M + (size_t)2048 * 1024 * 2, WO_O = WO_G + (size_t)2048 * 512 * 2, WO_F1 = WO_O + (size_t)2048 * 2048 * 2, WO_F2 = WO_F1 + (size_t)2 * DFF * DM * 2,
                 WO_END = WO_F2 + (size_t)DM * DFF * 2;
static_assert(WO_END <= 120 * MiB, "weights");
constexpr size_t WS_XC = 124 * MiB;
constexpr size_t WS_A = 140 * MiB;
constexpr size_t WS_B = 548 * MiB;
constexpr size_t WS_C = 684 * MiB;
constexpr size_t WS_D = 786 * MiB;
constexpr size_t WD_KF = 0, WD_V = 102 * MiB, WD_GQ = 170 * MiB, WD_GK = 204 * MiB, WD_GV = 213 * MiB, WD_U = 222 * MiB;
constexpr size_t WS_E = 1058 * MiB;
constexpr size_t WE_UC = 0, WE_CKV = 34 * MiB, WE_QA = 51 * MiB;
constexpr size_t WS_XB = 1144 * MiB;
constexpr size_t WS_END = 1272 * MiB;
static_assert((size_t)MT * 6144 * 2 <= 408 * MiB && (size_t)MT * 2048 * 2 <= 136 * MiB && (size_t)MT * 768 * 4 <= 102 * MiB && (size_t)MT * 2048 * 4 <= 272 * MiB && WD_U + (size_t)MT * 512 * 2 <= 272 * MiB, "ws map");
constexpr int CW_BAR = 4096;

constexpr int RING_OFF = 0, RING_BYTES = 131072, LDSCTL_OFF = RING_BYTES, MISC_OFF = LDSCTL_OFF + 320, LDS_BYTES = 147456;

__device__ __forceinline__ unsigned f2bf(float f) { unsigned u = __builtin_bit_cast(unsigned, f); return (u + 0x7fffu + ((u >> 16) & 1u)) >> 16; }
__device__ __forceinline__ unsigned pk2(float lo, float hi) { return pg8::cvt_pk_bf16(lo, hi); }
__device__ __forceinline__ float wave_sum(float v) {
#pragma unroll
    for (int o = 1; o < 64; o <<= 1) v += __shfl_xor(v, o);
    return v;
}
__device__ __forceinline__ float bflo(unsigned w) { return __uint_as_float(w << 16); }
__device__ __forceinline__ float bfhi(unsigned w) { return __uint_as_float(w & 0xffff0000u); }
__device__ __forceinline__ float sigmf(float x) { return __builtin_amdgcn_rcpf(1.0f + __builtin_amdgcn_exp2f(-1.4426950408889634f * x)); }

__device__ __forceinline__ int srccol(int mode, int n) {
    if (mode == 0) return n;
    if (mode == 1) {
        if (n < 6144) return 2624 + n;
        if (n < 7744) { const int o = n - 6144; const bool pair = (o >= 256 && o < 448) || o >= 1088;
            if (!pair) return o; const int b0 = o & ~31, p = o & 31; return b0 + 4 * (p >> 3) + (p & 3) + 16 * ((p >> 2) & 1); }
        if (n < 8768) { const int q = n - 7744, g = q >> 5, p = q & 31, i = 4 * (p >> 3) + (p & 3); return 1600 + (((p >> 2) & 1) ? 512 : 0) + 16 * g + i; }
        return -1;
    }
    if (mode == 3) { if (n % 192 < 128) return n; const int b0 = n & ~31, p = n & 31; return b0 + 4 * (p >> 3) + (p & 3) + 16 * ((p >> 2) & 1); }
    { const int t = n >> 8, j = n & 255; return j < 128 ? 128 * t + j : DFF + 128 * t + (j - 128); }
}
__device__ __forceinline__ void cvt_item(const float* W, int K, int N, bf16* WT, LAS float* scr, int item, int nblk, int lane, int mode) {
    const int kb = item / nblk, nb = item % nblk, k0 = 64 * kb, n0 = 32 * nb;
    const int kl = lane >> 3, nq = (lane & 7) * 4;
    const int sc = srccol(mode, n0 + nq);
    const float wsc = (mode == 1 && n0 < 6144) ? -1.4426950408889634f : 1.0f;
    const float* wp = W + (size_t)(k0 + kl) * N + (sc >= 0 ? sc : 0);
#pragma unroll
    for (int i = 0; i < 8; ++i) { const f32x4 v = *(const f32x4*)(wp + (size_t)(8 * i) * N) * wsc; LAS float* d = scr + (kl + 8 * i) * 33 + nq;
        d[0] = sc >= 0 ? v[0] : 0.f; d[1] = sc >= 0 ? v[1] : 0.f; d[2] = sc >= 0 ? v[2] : 0.f; d[3] = sc >= 0 ? v[3] : 0.f; }
    LDS_WAIT(); asm volatile("" ::: "memory");
    const int c = lane & 7;
#pragma unroll
    for (int j = 0; j < 4; ++j) { const int n = (lane >> 3) + 8 * j; const LAS float* s = scr + (8 * c) * 33 + n;
        v4u o; o.x = pk2(s[0 * 33], s[1 * 33]); o.y = pk2(s[2 * 33], s[3 * 33]); o.z = pk2(s[4 * 33], s[5 * 33]); o.w = pk2(s[6 * 33], s[7 * 33]);
        *(GAS v4u*)(WT + (size_t)(n0 + n) * K + k0 + 8 * c) = o; }
    LDS_WAIT(); asm volatile("" ::: "memory");
}

#ifndef ATT_MLA_MODE
#define ATT_MLA_MODE 2
#endif
#ifndef ATT_GQA_MODE
#define ATT_GQA_MODE 2
#endif
#ifndef P5_WGM
#define P5_WGM 8
#endif
#ifndef P1_WGM
#define P1_WGM 4
#endif
#ifndef P8_WGM
#define P8_WGM 4
#endif
#ifndef SPLIT_WGM
#define SPLIT_WGM 2
#endif
struct Args { const float* in[25]; float* out; unsigned char* ws; int multi, l_lo, l_hi, ph, pad0, pad1; };
enum { PH_PRE = -1, PH_POST = 10, PH_DUMP = 11 };

struct __attribute__((packed, aligned(4))) F3 { float x, y, z; };
#define PHASE_BEGIN \
    const __attribute__((address_space(4))) Args* ap = (const __attribute__((address_space(4))) Args*)__builtin_amdgcn_kernarg_segment_ptr(); asm volatile("" : "+s"(ap)); \
    unsigned char* ws = ap->ws; \
    int tid = threadIdx.x; asm volatile("" : "+v"(tid)); const int lane = tid & 63, wave = __builtin_amdgcn_readfirstlane(tid >> 6); \
    const int gw = vcu * NWAVES + wave, NGW = G * NWAVES; (void)gw; (void)NGW; (void)lane; \
    const float* in_x = ap->in[0]; const float* in_c = ap->in[1]; const float* in_ctx = ap->in[2]; const float* in_cctx = ap->in[3]; const float* w_ada = ap->in[4]; const float* b_ada = ap->in[5]; const float* g_mix = ap->in[6]; const float* w_in = ap->in[7]; const float* conv_w = ap->in[8]; const float* conv_b = ap->in[9]; const float* conv_ln_g = ap->in[10]; const float* conv_ln_b = ap->in[11]; const float* w_conv_out = ap->in[12]; const float* g_q_a = ap->in[13]; const float* w_q_up = ap->in[14]; const float* g_kv_a = ap->in[15]; const float* w_kv_up = ap->in[16]; const float* w_mla_out = ap->in[17]; const float* gqa_sink = ap->in[18]; const float* w_gqa_out = ap->in[19]; const float* w_out = ap->in[20]; const float* g_ffn = ap->in[21]; const float* w_ffn_in = ap->in[22]; const float* w_ffn_out = ap->in[23]; const float* g_final = ap->in[24]; float* XL = ap->out; bf16* XB = (bf16*)(ws + WS_XB); bf16* XCB = (bf16*)(ws + WS_XC); (void)XL; (void)XCB; float* MOD = (float*)(ws + WS_MOD); float* ROPE = (float*)(ws + WS_ROPE); float* XC = (float*)(ws + WS_XC); bf16* Win_t = (bf16*)(ws + WS_W + WO_IN); bf16* Wq_t = (bf16*)(ws + WS_W + WO_Q); bf16* Wkv_t = (bf16*)(ws + WS_W + WO_KV); bf16* Wc_t = (bf16*)(ws + WS_W + WO_C); bf16* Wm_t = (bf16*)(ws + WS_W + WO_M); bf16* Wg_t = (bf16*)(ws + WS_W + WO_G); bf16* Wo_t = (bf16*)(ws + WS_W + WO_O); bf16* Wf1_t = (bf16*)(ws + WS_W + WO_F1); bf16* Wf2_t = (bf16*)(ws + WS_W + WO_F2); unsigned char* Gb = (unsigned char*)(ws + WS_A); bf16* HID = (bf16*)(ws + WS_A); bf16* Hb = (bf16*)(ws + WS_B); bf16* MQ = (bf16*)(ws + WS_B); bf16* Yb = (bf16*)(ws + WS_B); bf16* CQ = (bf16*)(ws + WS_C); bf16* PART = (bf16*)(ws + WS_C); bf16* OM = (bf16*)(ws + WS_C); bf16* OG = (bf16*)(ws + WS_C + (size_t)MT * 1024 * 2); bf16* KF = (bf16*)(ws + WS_D + WD_KF); bf16* Vb = (bf16*)(ws + WS_D + WD_V); bf16* GQ = (bf16*)(ws + WS_D + WD_GQ); bf16* GK = (bf16*)(ws + WS_D + WD_GK); bf16* GV = (bf16*)(ws + WS_D + WD_GV); bf16* Ub = (bf16*)(ws + WS_D + WD_U); bf16* YF = (bf16*)(ws + WS_D); bf16* UC = (bf16*)(ws + WS_E + WE_UC); bf16* CKVn = (bf16*)(ws + WS_E + WE_CKV); bf16* QAn = (bf16*)(ws + WS_E + WE_QA); \
    const float* modl = MOD + (size_t)l_cur * 9 * NMOD; (void)modl;
__global__ void __launch_bounds__(NWAVES * 64, 2) mega_fwd(Args args) {
    extern __shared__ __attribute__((aligned(16))) unsigned char lds_raw[];
    LAS unsigned char* lds = (LAS unsigned char*)lds_raw;
    volatile LAS unsigned* MISC = (volatile LAS unsigned*)(lds + MISC_OFF);
    const int tid0 = threadIdx.x;
    const int G = gridDim.x; const int bx = blockIdx.x; const int vcu = (G % 8 == 0) ? (bx % 8) * (G / 8) + bx / 8 : bx;
    gu32* ctl = (gu32*)(args.ws + WS_CTL);
    int l_cur = 0;
    for (int u = tid0; u < (LDS_BYTES - LDSCTL_OFF) / 4; u += NWAVES * 64) ((LAS unsigned*)(lds + LDSCTL_OFF))[u] = 0u;
    __syncthreads();
    XcdBarrier bar = xcd_barrier_post((unsigned*)(ctl + CW_BAR), MISC + 8);
    const int multi = args.multi, ph = args.ph;
#ifndef PHASE_MASK
#define PHASE_MASK 0x1fff
#endif
#define RUN(k) ((((PHASE_MASK) >> ((k) + 1)) & 1) && (!multi || ph == (k)))
#define GRID_BAR() do { if (!multi) xcd_barrier(bar); } while (0)

    if (RUN(PH_PRE)) { PHASE_BEGIN
        LAS float* sil = (LAS float*)(lds + RING_OFF);
        LAS float* red = (LAS float*)(lds + RING_OFF + 9 * DM * 4);
        for (int i = tid; i < 9 * DM; i += NWAVES * 64) { const float v = i < 8 * DM ? in_c[i] : in_cctx[i - 8 * DM]; sil[(i & (DM - 1)) * 9 + (i >> 11)] = v * sigmf(v); }
        __syncthreads();
#define ADA_LOAD(W_, I0) do { _Pragma("unroll") for (int u = 0; u < 8; ++u) W_[u] = *(const F3*)(Wl + (size_t)((I0) + u) * 8 * NMOD); } while (0)
#define ADA_FMA(W_, I0) do { _Pragma("unroll") for (int u = 0; u < 8; ++u) { const LAS float* sp = sil + (((I0) + u) * 8 + wave) * 9; \
            _Pragma("unroll") for (int v = 0; v < 9; ++v) { const float sv = sp[v]; acc[v][0] += W_[u].x * sv; acc[v][1] += W_[u].y * sv; acc[v][2] += W_[u].z * sv; } asm volatile("" ::: "memory"); } } while (0)
        for (int s = vcu; s < DEPTH * 64; s += G) {
            const int l = s >> 6, col0 = (s & 63) * 192;
            const float* Wl = w_ada + (size_t)l * DM * NMOD + (size_t)wave * NMOD + col0 + 3 * lane;
            float acc[9][3];
#pragma unroll
            for (int v = 0; v < 9; ++v) { acc[v][0] = 0.f; acc[v][1] = 0.f; acc[v][2] = 0.f; }
            F3 wa[8], wb[8];
            ADA_LOAD(wa, 0);
#pragma nounroll
            for (int i = 0; i < DM / 8; i += 16) {
                ADA_LOAD(wb, i + 8);
                ADA_FMA(wa, i);
                { const int in_ = (i + 16 < DM / 8) ? i + 16 : 0; ADA_LOAD(wa, in_); }
                ADA_FMA(wb, i + 8);
            }
#pragma unroll
            for (int v = 0; v < 9; ++v) {
#pragma unroll
                for (int e = 0; e < 3; ++e) red[(wave * 9 + v) * 192 + 3 * lane + e] = acc[v][e]; }
            __syncthreads();
            for (int i = tid; i < 9 * 192; i += NWAVES * 64) { const int v = i / 192, cc = i - v * 192; float t = 0.f;
#pragma unroll
                for (int w8 = 0; w8 < 8; ++w8) t += red[(w8 * 9 + v) * 192 + cc];
                MOD[((size_t)l * 9 + v) * NMOD + col0 + cc] = t + b_ada[(size_t)l * NMOD + col0 + cc]; }
            __syncthreads();
        }
        { bf16* XB = (bf16*)(ws + WS_XB);
          for (size_t i = ((size_t)gw * 64 + lane) * 8; i < (size_t)ML * DM; i += (size_t)NGW * 64 * 8) { const f32x4 a = *(const f32x4*)(in_x + i), b = *(const f32x4*)(in_x + i + 4);
              v4u w; w.x = pk2(a[0], a[1]); w.y = pk2(a[2], a[3]); w.z = pk2(b[0], b[1]); w.w = pk2(b[2], b[3]); *(v4u*)(XB + i) = w; }
          bf16* XCB = (bf16*)(ws + WS_XC);
          for (size_t i = ((size_t)gw * 64 + lane) * 8; i < (size_t)MC * DM; i += (size_t)NGW * 64 * 8) { const f32x4 a = *(const f32x4*)(in_ctx + i), b = *(const f32x4*)(in_ctx + i + 4);
              v4u w; w.x = pk2(a[0], a[1]); w.y = pk2(a[2], a[3]); w.z = pk2(b[0], b[1]); w.w = pk2(b[2], b[3]); *(v4u*)(XCB + i) = w; } }
        { const int i = bx * (NWAVES * 64) + tid; if (i < 64 * 16) { const int p = i >> 4, f = i & 15; const float invf = powf(10000.0f, -(float)f / 16.0f), a = (float)p * invf;
              ROPE[2 * i] = cosf(a); ROPE[2 * i + 1] = sinf(a); } }
    }
    GRID_BAR();

    for (int l = args.l_lo; l < args.l_hi; ++l) {
        l_cur = l;
        const bool lastl = (l == DEPTH - 1); const int Mg = lastl ? ML : MT;
        if (RUN(0)) { PHASE_BEGIN
            LAS float* scr = (LAS float*)(lds + RING_OFF + wave * 16384);
            constexpr int I_IN = (DM / 64) * (NINP / 32), I_Q = (512 / 64) * (1536 / 32), I_KV = (256 / 64) * (2048 / 32), I_C = (512 / 64) * (DM / 32), I_M = (1024 / 64) * (DM / 32),
                          I_G = (512 / 64) * (DM / 32), I_O = (DM / 64) * (DM / 32), I_F1 = (DM / 64) * (2 * DFF / 32), I_F2 = (DFF / 64) * (DM / 32);
            constexpr int NITEMS = I_IN + I_Q + I_KV + I_C + I_M + I_G + I_O + I_F1 + I_F2;
            for (int it = gw; it < NITEMS; it += NGW) {
                int r = it; const float* W; bf16* WT; int K, N, nblk, mode = 0;
                if (r < I_IN) { W = w_in + (size_t)l * DM * NIN; K = DM; N = NIN; WT = Win_t; nblk = NINP / 32; mode = 1; }
                else if ((r -= I_IN) < I_Q) { W = w_q_up + (size_t)l * 512 * 1536; K = 512; N = 1536; WT = Wq_t; nblk = 1536 / 32; mode = 3; }
                else if ((r -= I_Q) < I_KV) { W = w_kv_up + (size_t)l * 256 * 2048; K = 256; N = 2048; WT = Wkv_t; nblk = 2048 / 32; }
                else if ((r -= I_KV) < I_C) { W = w_conv_out + (size_t)l * 512 * DM; K = 512; N = DM; WT = Wc_t; nblk = DM / 32; }
                else if ((r -= I_C) < I_M) { W = w_mla_out + (size_t)l * 1024 * DM; K = 1024; N = DM; WT = Wm_t; nblk = DM / 32; }
                else if ((r -= I_M) < I_G) { W = w_gqa_out + (size_t)l * 512 * DM; K = 512; N = DM; WT = Wg_t; nblk = DM / 32; }
                else if ((r -= I_G) < I_O) { W = w_out + (size_t)l * DM * DM; K = DM; N = DM; WT = Wo_t; nblk = DM / 32; }
                else if ((r -= I_O) < I_F1) { W = w_ffn_in + (size_t)l * DM * 2 * DFF; K = DM; N = 2 * DFF; WT = Wf1_t; nblk = 2 * DFF / 32; mode = 2; }
                else { r -= I_F1; W = w_ffn_out + (size_t)l * DFF * DM; K = DFF; N = DM; WT = Wf2_t; nblk = DM / 32; }
                cvt_item(W, K, N, WT, scr, r, nblk, lane, mode);
            }
        }
#define NCOL(LN, S) (8 * (LN) + 512 * ((S) >> 1) + 4 * ((S) & 1))
#define NORM_UNPK(T, V, J) do { V[2 * (J)] = (f32x4){bflo(T.x), bfhi(T.x), bflo(T.y), bfhi(T.y)}; V[2 * (J) + 1] = (f32x4){bflo(T.z), bfhi(T.z), bflo(T.w), bfhi(T.w)}; } while (0)
#define NORM_LDMOD(SEL, GVEC, SHOFF, SCOFF) do { const float* mp = modl + (size_t)(SEL) * NMOD; \
                _Pragma("unroll") for (int j = 0; j < 8; ++j) { const int c = NCOL(ln_, j); const f32x4 g = *(const f32x4*)((GVEC) + c), sc = *(const f32x4*)(mp + (SCOFF) + c); \
                    Aa[j] = g * (sc + 1.0f); Ss[j] = *(const f32x4*)(mp + (SHOFF) + c); } } while (0)
#define NORM_FINISH(R) do { float ss = 0.f; \
                _Pragma("unroll") for (int j = 0; j < 8; ++j) ss += (v[j][0] * v[j][0] + v[j][1] * v[j][1]) + (v[j][2] * v[j][2] + v[j][3] * v[j][3]); \
                const float rstd = 1.0f / sqrtf(wave_sum(ss) * (1.0f / DM) + EPS); \
                bf16* hp = Hb + (size_t)(R) * DM + 8 * ln_; \
                _Pragma("unroll") for (int j = 0; j < 4; ++j) { const f32x4 y0 = v[2 * j] * rstd * Aa[2 * j] + Ss[2 * j], y1 = v[2 * j + 1] * rstd * Aa[2 * j + 1] + Ss[2 * j + 1]; \
                    v4u w; w.x = pk2(y0[0], y0[1]); w.y = pk2(y0[2], y0[3]); w.z = pk2(y1[0], y1[1]); w.w = pk2(y1[2], y1[3]); *(v4u*)(hp + 512 * j) = w; } } while (0)
#define NORM_ROWS(GVEC, SHOFF, SCOFF, FIRST, WITHCTX, PARTG) do { \
            int ln_ = lane; asm volatile("" : "+v"(ln_)); \
            f32x4 Aa[8], Ss[8]; \
            _Pragma("unroll") for (int j = 0; j < 8; ++j) { Aa[j] = (f32x4){0.f, 0.f, 0.f, 0.f}; Ss[j] = (f32x4){0.f, 0.f, 0.f, 0.f}; } \
            for (int gv_ = gw; gv_ < 2048; gv_ += NGW) { \
                NORM_LDMOD((gv_ * 16) >> 12, GVEC, SHOFF, SCOFF);                                   \
                _Pragma("nounroll") for (int ri = 0; ri < 16; ++ri) { int r = gv_ * 16 + ri; asm volatile("" : "+s"(r)); \
                    const bf16* sb_ = XB + (size_t)r * DM + 8 * ln_; f32x4 v[8]; \
                    _Pragma("unroll") for (int j = 0; j < 4; ++j) { const v4u t_ = *(const v4u*)(sb_ + 512 * j); NORM_UNPK(t_, v, j); } \
                    NORM_FINISH(r); } \
                if (WITHCTX) { NORM_LDMOD(8, GVEC, SHOFF, SCOFF); int rc = gv_; asm volatile("" : "+s"(rc));     \
                    bf16* sb_ = XCB + (size_t)rc * DM + 8 * ln_; f32x4 v[8]; \
                    _Pragma("unroll") for (int j = 0; j < 4; ++j) { const v4u t_ = *(const v4u*)(sb_ + 512 * j); NORM_UNPK(t_, v, j); } \
                    if ((PARTG) != nullptr) { const bf16* pp = PART + (size_t)rc * DM + 8 * ln_; \
                        _Pragma("unroll") for (int j = 0; j < 4; ++j) { f32x4 pa_[8]; \
                            { const v4u q_ = *(const v4u*)(pp + 512 * j); NORM_UNPK(q_, pa_, 0); } { const v4u q_ = *(const v4u*)(pp + (size_t)2048 * DM + 512 * j); NORM_UNPK(q_, pa_, 1); } \
                            { const v4u q_ = *(const v4u*)(pp + (size_t)2 * 2048 * DM + 512 * j); NORM_UNPK(q_, pa_, 2); } { const v4u q_ = *(const v4u*)(pp + (size_t)3 * 2048 * DM + 512 * j); NORM_UNPK(q_, pa_, 3); } \
                            v[2 * j] += *(const f32x4*)((PARTG) + NCOL(ln_, 2 * j)) * ((pa_[0] + pa_[2]) + (pa_[4] + pa_[6])); \
                            v[2 * j + 1] += *(const f32x4*)((PARTG) + NCOL(ln_, 2 * j + 1)) * ((pa_[1] + pa_[3]) + (pa_[5] + pa_[7])); } \
                        _Pragma("unroll") for (int j = 0; j < 4; ++j) { v4u w_; w_.x = pk2(v[2 * j][0], v[2 * j][1]); w_.y = pk2(v[2 * j][2], v[2 * j][3]); w_.z = pk2(v[2 * j + 1][0], v[2 * j + 1][1]); w_.w = pk2(v[2 * j + 1][2], v[2 * j + 1][3]); \
                            *(v4u*)(sb_ + 512 * j) = w_; } } \
                    NORM_FINISH(ML + rc); } } \
        } while (0)
        if (RUN(0)) { PHASE_BEGIN const float* gv = g_mix + (size_t)l * DM; const int first = (l == 0) ? 1 : 0;
            const float* pg = first ? nullptr : (MOD + ((size_t)(l - 1) * 9 + 8) * NMOD + 5 * DM);
            NORM_ROWS(gv, 0, DM, first, true, pg); }
        GRID_BAR();

        if (RUN(1)) { PHASE_BEGIN
            const bf16* A_ = Hb; const bf16* B_ = Win_t; asm volatile("" : "+s"(A_), "+s"(B_)); pg8::Gemm g{A_, B_, MT, NINP, DM}; pg8::StaticOrder S; S.init(Mg, NINP, G, bx); S.wgm = P1_WGM; if (lastl) S.set_extra(24, ML / 256, 24, 3);
            pg8::EpiWin E{Gb, CQ, KF, GK, GV, GQ, Ub, ROPE};
            pg8::gemm_phase<pg8::EpiWin, pg8::StaticOrder, true, true>(lds + RING_OFF, g, S, E);
        }
        GRID_BAR();

        if (RUN(2)) { PHASE_BEGIN
            LAS float* cw = (LAS float*)(lds + RING_OFF);
            for (int i = tid; i < 31 * 512; i += NWAVES * 64) cw[i] = conv_w[(size_t)l * 31 * 512 + i];
            __syncthreads();
            { const f32x4 gk = *(const f32x4*)(g_kv_a + (size_t)l * 256 + 4 * lane), gq0 = *(const f32x4*)(g_q_a + (size_t)l * 512 + 4 * lane), gq1 = *(const f32x4*)(g_q_a + (size_t)l * 512 + 256 + 4 * lane);
              for (int r0 = gw; r0 < MT; r0 += 2 * NGW) { const int r1 = (r0 + NGW < MT) ? r0 + NGW : r0;
                const bf16* p = CQ + (size_t)r0 * 768 + 4 * lane; const bf16* q = CQ + (size_t)r1 * 768 + 4 * lane;
#define LD4(P) ({ const v2u t_ = *(const v2u*)(P); (f32x4){bflo(t_.x), bfhi(t_.x), bflo(t_.y), bfhi(t_.y)}; })
                const f32x4 a = LD4(p), b0 = LD4(p + 256), b1 = LD4(p + 512), c = LD4(q), d0 = LD4(q + 256), d1 = LD4(q + 512);
#undef LD4
#define LR_ROW(R, A_, B0_, B1_) do { \
                const float sa = wave_sum((A_[0] * A_[0] + A_[1] * A_[1]) + (A_[2] * A_[2] + A_[3] * A_[3])); \
                const float sb = wave_sum(((B0_[0] * B0_[0] + B0_[1] * B0_[1]) + (B0_[2] * B0_[2] + B0_[3] * B0_[3])) + ((B1_[0] * B1_[0] + B1_[1] * B1_[1]) + (B1_[2] * B1_[2] + B1_[3] * B1_[3]))); \
                const float ra = 1.0f / sqrtf(sa * (1.0f / 256.0f) + EPS), rb = 1.0f / sqrtf(sb * (1.0f / 512.0f) + EPS); \
                const f32x4 ya = A_ * ra * gk, y0 = B0_ * rb * gq0, y1 = B1_ * rb * gq1; \
                v2u w; w.x = pk2(ya[0], ya[1]); w.y = pk2(ya[2], ya[3]); *(v2u*)(CKVn + (size_t)(R) * 256 + 4 * lane) = w; \
                w.x = pk2(y0[0], y0[1]); w.y = pk2(y0[2], y0[3]); *(v2u*)(QAn + (size_t)(R) * 512 + 4 * lane) = w; \
                w.x = pk2(y1[0], y1[1]); w.y = pk2(y1[2], y1[3]); *(v2u*)(QAn + (size_t)(R) * 512 + 256 + 4 * lane) = w; } while (0)
                LR_ROW(r0, a, b0, b1); LR_ROW(r1, c, d0, d1);
#undef LR_ROW
              } }
            { const int ch = 8 * lane;
              const f32x4 cb0 = *(const f32x4*)(conv_b + (size_t)l * 512 + ch), cb1 = *(const f32x4*)(conv_b + (size_t)l * 512 + ch + 4);
              const f32x4 lg0 = *(const f32x4*)(conv_ln_g + (size_t)l * 512 + ch), lg1 = *(const f32x4*)(conv_ln_g + (size_t)l * 512 + ch + 4);
              const f32x4 lb0 = *(const f32x4*)(conv_ln_b + (size_t)l * 512 + ch), lb1 = *(const f32x4*)(conv_ln_b + (size_t)l * 512 + ch + 4);
              for (int tok = gw; tok < Mg; tok += NGW) {
                int sb, pos, L; if (tok < ML) { sb = tok & ~4095; pos = tok & 4095; L = SEQ; } else { const int c = tok - ML; sb = ML + (c & ~255); pos = c & 255; L = CTXL; }
                f32x4 a0 = cb0, a1 = cb1;
                v4u xr[31];
                if (pos >= 15 && pos < L - 15) {
                    const bf16* up = Ub + (size_t)(sb + pos - 15) * 512 + ch;
#pragma unroll
                    for (int j = 0; j < 31; ++j) xr[j] = *(const v4u*)(up + (size_t)j * 512);
                    asm volatile("" ::: "memory");
#pragma unroll
                    for (int j = 0; j < 31; ++j) { const v4u x = xr[j];
                        const f32x4 w0 = *(const LAS f32x4*)(cw + j * 512 + ch), w1 = *(const LAS f32x4*)(cw + j * 512 + ch + 4);
                        const f32x4 x0 = {bflo(x.x), bfhi(x.x), bflo(x.y), bfhi(x.y)}, x1 = {bflo(x.z), bfhi(x.z), bflo(x.w), bfhi(x.w)};
                        a0 += w0 * x0; a1 += w1 * x1; if ((j & 3) == 3) asm volatile("" ::: "memory"); }
                } else {
#pragma unroll
                    for (int j = 0; j < 31; ++j) { int p = pos + j - 15; p = p < 0 ? 0 : (p >= L ? L - 1 : p); xr[j] = *(const v4u*)(Ub + (size_t)(sb + p) * 512 + ch); }
                    asm volatile("" ::: "memory");
#pragma unroll
                    for (int j = 0; j < 31; ++j) { const int p = pos + j - 15; const float ok = (p >= 0 && p < L) ? 1.0f : 0.0f; const v4u x = xr[j];
                        const f32x4 w0 = *(const LAS f32x4*)(cw + j * 512 + ch) * ok, w1 = *(const LAS f32x4*)(cw + j * 512 + ch + 4) * ok;
                        const f32x4 x0 = {bflo(x.x), bfhi(x.x), bflo(x.y), bfhi(x.y)}, x1 = {bflo(x.z), bfhi(x.z), bflo(x.w), bfhi(x.w)};
                        a0 += w0 * x0; a1 += w1 * x1; if ((j & 3) == 3) asm volatile("" ::: "memory"); }
                }
                const float mean = wave_sum((a0[0] + a0[1]) + (a0[2] + a0[3]) + (a1[0] + a1[1]) + (a1[2] + a1[3])) * (1.0f / 512.0f);
                const f32x4 d0 = a0 - mean, d1 = a1 - mean;
                const float var = wave_sum((d0[0] * d0[0] + d0[1] * d0[1]) + (d0[2] * d0[2] + d0[3] * d0[3]) + (d1[0] * d1[0] + d1[1] * d1[1]) + (d1[2] * d1[2] + d1[3] * d1[3])) * (1.0f / 512.0f);
                const float rstd = 1.0f / sqrtf(var + EPS);
                const f32x4 y0 = d0 * rstd * lg0 + lb0, y1 = d1 * rstd * lg1 + lb1;
                v4u w; w.x = pk2(y0[0] * sigmf(y0[0]), y0[1] * sigmf(y0[1])); w.y = pk2(y0[2] * sigmf(y0[2]), y0[3] * sigmf(y0[3]));
                w.z = pk2(y1[0] * sigmf(y1[0]), y1[1] * sigmf(y1[1])); w.w = pk2(y1[2] * sigmf(y1[2]), y1[3] * sigmf(y1[3]));
                *(v4u*)(UC + (size_t)tok * 512 + ch) = w; } }
        }
        GRID_BAR();

        if (RUN(3)) { PHASE_BEGIN
            const bf16* A0_ = QAn; const bf16* B0_ = Wq_t; const bf16* A1_ = CKVn; const bf16* B1_ = Wkv_t; asm volatile("" : "+s"(A0_), "+s"(B0_), "+s"(A1_), "+s"(B1_));
            pg8::SchedQKV S; S.nMq = Mg / 256; S.nNq = 1536 / 256; S.nMk = MT / 256; S.nNk = 2048 / 256; S.G = G; S.c = bx; S.Aq = A0_; S.Bq = B0_; S.Ak = A1_; S.Bk = B1_;
            pg8::EpiQKV E{pg8::EpiQup{MQ, ROPE}, pg8::EpiKV{KF, Vb}};
            pg8::gemm_stream<pg8::EpiQKV, pg8::SchedQKV>(lds + RING_OFF, S, E);
        }
        GRID_BAR();

        if (RUN(4)) { PHASE_BEGIN
            att::lchar* alds = (att::lchar*)(lds + RING_OFF);
            for (int u = vcu; u < 1024 + (lastl ? 0 : 64); u += G) {
                int b, h, q0row, NT;
                if (u < 1024) { const int bh = u >> 4, qb = u & 15; b = bh >> 3; h = bh & 7; q0row = b * SEQ + qb * 256; NT = 4 + SEQ / 64; }
                else { const int bh = u - 1024; b = bh >> 3; h = bh & 7; q0row = ML + b * CTXL; NT = 4; }
                att::attn_unit<192, 128, false, false, ATT_MLA_MODE>(MQ + (size_t)q0row * 1536 + h * 192, 1536, KF + h * 192, 1536, Vb + h * 128, 1024, OM + (size_t)q0row * 1024 + h * 128, 1024,
                                                       ML + b * CTXL, b * SEQ, NT, 0, 0, 0.f, alds);
            }
            for (int u = vcu; u < 1024 + (lastl ? 0 : 128); u += G) {
                int b, h, q0row, NT, qpos0, kpos0;
                if (u >= 1024 && u < 1088) continue;
                if (u < 1024) { const int bh = u >> 4, qb = u & 15; b = bh >> 3; h = bh & 7; q0row = b * SEQ + qb * 256; qpos0 = qb * 256;
                    const int klo = qpos0 - 128 < 0 ? 0 : qpos0 - 128, khi = qpos0 + 384 > SEQ ? SEQ : qpos0 + 384; kpos0 = klo; NT = 4 + (khi - klo) / 64; }
                else { const int bh = u - 1088; b = bh >> 3; h = bh & 7; q0row = ML + b * CTXL; NT = 4; qpos0 = 0; kpos0 = 0; }
                const float sk = gqa_sink[l * 8 + h] * 1.4426950408889634f;
                att::attn_unit<64, 64, true, true, ATT_GQA_MODE>(GQ + (size_t)q0row * 512 + h * 64, 512, GK + (h >> 2) * 64, 128, GV + (h >> 2) * 64, 128, OG + (size_t)q0row * 512 + h * 64, 512,
                                                   ML + b * CTXL, b * SEQ + kpos0, NT, qpos0, kpos0, sk, alds);
            }
            __syncthreads();
        }
        GRID_BAR();

        if (RUN(5)) { PHASE_BEGIN
            pg8::SchedMerge S; S.base.init(Mg, DM, G, bx); S.base.wgm = P5_WGM;
            { const bf16* a0_ = UC; const bf16* a1_ = OM; const bf16* a2_ = OG; const bf16* b0_ = Wc_t; const bf16* b1_ = Wm_t; const bf16* b2_ = Wg_t; asm volatile("" : "+s"(a0_), "+s"(a1_), "+s"(a2_), "+s"(b0_), "+s"(b1_), "+s"(b2_));
              S.a0 = (const char*)a0_; S.da1 = (const char*)a1_ - (const char*)a0_; S.da2 = (const char*)a2_ - (const char*)a1_; S.b0 = (const char*)b0_; S.db1 = (const char*)b1_ - (const char*)b0_; S.db2 = (const char*)b2_ - (const char*)b1_; }
            pg8::EpiChain E{Gb, Yb};
            pg8::gemm_stream<pg8::EpiChain, pg8::SchedMerge, true>(lds + RING_OFF, S, E);
        }
        GRID_BAR();

        if (RUN(6)) { PHASE_BEGIN
            const bf16* A_ = Yb; const bf16* B_ = Wo_t; asm volatile("" : "+s"(A_), "+s"(B_));
            pg8::SchedSplit S; S.A = A_; S.Bt = B_; S.K = DM; S.nlat = 1024; S.nctx = lastl ? 0 : 256; S.G = G; S.c = bx; S.wgm = SPLIT_WGM;
            pg8::EpiSplit E{pg8::EpiResid{XB, modl, 2 * DM}, PART};
            pg8::gemm_stream<pg8::EpiSplit, pg8::SchedSplit>(lds + RING_OFF, S, E);
        }
        GRID_BAR();

        if (RUN(7)) { PHASE_BEGIN const float* gv = g_ffn + (size_t)l * DM; const float* pg = lastl ? nullptr : (modl + (size_t)8 * NMOD + 2 * DM);
            const int first = (l == 0) ? 2 : 0; NORM_ROWS(gv, 3 * DM, 4 * DM, first, !lastl, pg); }
        GRID_BAR();

        if (RUN(8)) { PHASE_BEGIN
            const bf16* A_ = Hb; const bf16* B_ = Wf1_t; asm volatile("" : "+s"(A_), "+s"(B_)); pg8::Gemm g{A_, B_, MT, 2 * DFF, DM}; pg8::StaticOrder S; S.init(Mg, 2 * DFF, G, bx); S.wgm = P8_WGM; pg8::EpiSwiGLU E{HID};
            pg8::gemm_phase<pg8::EpiSwiGLU, pg8::StaticOrder, true, true>(lds + RING_OFF, g, S, E);
        }
        GRID_BAR();

        if (RUN(9)) { PHASE_BEGIN
            const bf16* A_ = HID; const bf16* B_ = Wf2_t; asm volatile("" : "+s"(A_), "+s"(B_));
            pg8::SchedSplit S; S.A = A_; S.Bt = B_; S.K = DFF; S.nlat = 1024; S.nctx = lastl ? 0 : 256; S.G = G; S.c = bx; S.wgm = SPLIT_WGM;
            pg8::EpiSplit E{pg8::EpiResid{XB, modl, 5 * DM}, PART};
            pg8::gemm_stream<pg8::EpiSplit, pg8::SchedSplit>(lds + RING_OFF, S, E);
        }
        GRID_BAR();
    }

    if (RUN(PH_POST)) { PHASE_BEGIN
        f32x4 gf[8];
#pragma unroll
        for (int j = 0; j < 8; ++j) gf[j] = *(const f32x4*)(g_final + NCOL(lane, j));
        for (int r = gw; r < ML; r += NGW) { float* p = XL + (size_t)r * DM; const bf16* sb = XB + (size_t)r * DM + 8 * lane; f32x4 v[8]; float ss = 0.f;
#pragma unroll
            for (int j = 0; j < 4; ++j) { const v4u t_ = *(const v4u*)(sb + 512 * j); NORM_UNPK(t_, v, j); }
#pragma unroll
            for (int j = 0; j < 8; ++j) ss += (v[j][0] * v[j][0] + v[j][1] * v[j][1]) + (v[j][2] * v[j][2] + v[j][3] * v[j][3]);
            const float rstd = 1.0f / sqrtf(wave_sum(ss) * (1.0f / DM) + EPS);
#pragma unroll
            for (int j = 0; j < 8; ++j) *(f32x4*)(p + NCOL(lane, j)) = v[j] * rstd * gf[j]; }
    }

#if defined(DBG_STAGE)
    if (RUN(PH_DUMP)) { PHASE_BEGIN
        const int sel = ap->pad0; const size_t total = (size_t)G * NWAVES * 64, gt = (size_t)bx * NWAVES * 64 + tid;
        for (size_t i = gt; i < (size_t)ML * DM; i += total) { float v = 0.f;
#define DB16(bit, P, N) if (sel & (bit)) v += __uint_as_float((unsigned)(P)[i % (size_t)(N)] << 16)
            if (sel & 1) v += MOD[i % (size_t)(DEPTH * 9 * NMOD)];
            DB16(2, Hb, (size_t)MT * 2048); DB16(4, Gb, (size_t)MT * 6144); DB16(8, KF, (size_t)MT * 1536); DB16(16, Vb, (size_t)MT * 1024); DB16(32, GQ, (size_t)MT * 512);
            DB16(64, UC, (size_t)MT * 512); DB16(128, MQ, (size_t)MT * 1536); DB16(256, OM, (size_t)MT * 1024); DB16(512, OG, (size_t)MT * 512); DB16(1024, Yb, (size_t)MT * 2048);
            DB16(2048, Win_t, (size_t)NINP * 2048); DB16(4096, GK, (size_t)MT * 128); DB16(8192, GV, (size_t)MT * 128); DB16(16384, CKVn, (size_t)MT * 256); DB16(32768, QAn, (size_t)MT * 512);
            DB16(65536, Ub, (size_t)MT * 512); DB16(131072, Wf1_t, (size_t)2 * DFF * DM); DB16(262144, Wf2_t, (size_t)DM * DFF); DB16(524288, HID, (size_t)MT * DFF);
            if (sel & 1048576) v += CQ[i % ((size_t)MT * 768)];
            XL[i] = v; }
    }
#endif
#undef RUN
#undef GRID_BAR
#undef NORM_ROWS
}

#ifndef MK_MULTI
#define MK_MULTI 0
#endif
extern "C" void kernel_launch(void* const* d_in, const int* in_sizes, int n_in, void* d_out, int out_size, void* d_ws, size_t ws_size, hipStream_t stream) {
    static int grid = 0;
    if (grid == 0) {
        if (n_in != 25 || in_sizes[0] != ML * DM || out_size != ML * DM || ws_size < WS_END) {
            fprintf(stderr, "kernel_launch: shape mismatch: n_in %d in0 %d out %d ws %zu (need %zu)\n", n_in, n_in > 0 ? in_sizes[0] : -1, out_size, ws_size, (size_t)WS_END); grid = -1; return; }
        int dev = 0, cus = 0, per_cu = 0;
        if (hipGetDevice(&dev) != hipSuccess || hipDeviceGetAttribute(&cus, hipDeviceAttributeMultiprocessorCount, dev) != hipSuccess) { grid = -1; return; }
        if (hipFuncSetAttribute((const void*)mega_fwd, hipFuncAttributeMaxDynamicSharedMemorySize, LDS_BYTES) != hipSuccess) { fprintf(stderr, "kernel_launch: hipFuncSetAttribute failed\n"); grid = -1; return; }
        if (hipOccupancyMaxActiveBlocksPerMultiprocessor(&per_cu, (const void*)mega_fwd, NWAVES * 64, LDS_BYTES) != hipSuccess || per_cu < 1)
            fprintf(stderr, "kernel_launch: note: occupancy query reports %d workgroups per CU\n", per_cu);
        (void)hipGetLastError();
        grid = cus;
    }
    if (grid < 0) return;
    if (hipMemsetAsync((char*)d_ws + WS_CTL, 0, CTL_ZERO_BYTES, stream) != hipSuccess) return;
    Args a{};
    for (int i = 0; i < 25; ++i) a.in[i] = (const float*)d_in[i];
    a.out = (float*)d_out; a.ws = (unsigned char*)d_ws;
#if defined(DBG_STAGE)
    a.multi = 1;
    a.l_lo = 0; a.l_hi = 0; a.ph = PH_PRE; hipLaunchKernelGGL(mega_fwd, dim3(grid), dim3(NWAVES * 64), LDS_BYTES, stream, a);
    for (int p = 0; p <= DBG_STAGE; ++p) { a.l_lo = 0; a.l_hi = 1; a.ph = p; hipLaunchKernelGGL(mega_fwd, dim3(grid), dim3(NWAVES * 64), LDS_BYTES, stream, a); }
    a.l_lo = 0; a.l_hi = 0; a.ph = PH_DUMP; a.pad0 = DBG_SEL; hipLaunchKernelGGL(mega_fwd, dim3(grid), dim3(NWAVES * 64), LDS_BYTES, stream, a);
#elif MK_MULTI
    a.multi = 1;
    a.l_lo = 0; a.l_hi = 0; a.ph = PH_PRE; hipLaunchKernelGGL(mega_fwd, dim3(grid), dim3(NWAVES * 64), LDS_BYTES, stream, a);
    for (int l = 0; l < DEPTH; ++l) for (int p = 0; p < 10; ++p) { a.l_lo = l; a.l_hi = l + 1; a.ph = p; hipLaunchKernelGGL(mega_fwd, dim3(grid), dim3(NWAVES * 64), LDS_BYTES, stream, a); }
    a.l_lo = 0; a.l_hi = 0; a.ph = PH_POST; hipLaunchKernelGGL(mega_fwd, dim3(grid), dim3(NWAVES * 64), LDS_BYTES, stream, a);
#else
    a.multi = 0; a.l_lo = 0; a.l_hi = DEPTH; a.ph = 0;
    hipLaunchKernelGGL(mega_fwd, dim3(grid), dim3(NWAVES * 64), LDS_BYTES, stream, a);
#endif
    const hipError_t le = hipPeekAtLastError();
    if (le != hipSuccess) fprintf(stderr, "kernel_launch: launch failed: %s\n", hipGetErrorName(le));
}
```

```cpp
#include <hip/hip_runtime.h>
#include <cstdio>
#include <cstdint>
#define GAS __attribute__((address_space(1)))
#define LAS __attribute__((address_space(3)))
namespace pg8 {
#define PG8_LAS __attribute__((address_space(3)))
typedef unsigned short bf16_t;
typedef short bf16x8 __attribute__((ext_vector_type(8)));
typedef float f32x4 __attribute__((ext_vector_type(4)));
typedef unsigned u32x4 __attribute__((ext_vector_type(4)));
constexpr int BM = 256, BK = 64, HALF = 128, HTB = HALF * BK * 2  , STAGE_BYTES = 8 * HTB, NXCD = 8, WGM = 8;

__host__ __device__ __forceinline__ int lds_byte(int r, int c) { const int st = (r >> 4) * 2 + (c >> 5), rr = r & 15, cc = c & 31, ob = rr * 64 + cc * 2; return st * 1024 + (ob ^ (((ob >> 9) & 1) << 5)); }
__host__ __device__ __forceinline__ void stage_rc(int b, int& R, int& C) { const int st = b / 1024, sb = b % 1024, swz = sb ^ (((sb >> 9) & 1) << 5); R = (st >> 1) * 16 + swz / 64; C = (st & 1) * 32 + (swz % 64) / 2; }
__host__ __device__ __forceinline__ int perm32(int rho) { const int n = rho >> 4, i = rho & 15; return 8 * (i >> 2) + 4 * n + (i & 3); }

struct Unit { int pm, pn; };
struct Gemm { const bf16_t* A; const bf16_t* Bt; int M, N, K; };

struct StaticOrder {
    int nM, nN, nwg, G, c, ext_n, ext_pm0, ext_pn0, ext_w, wgm, ext_c0;
    __host__ __device__ void init(int M, int N, int G_, int c_) { nM = M / BM; nN = N / BM; nwg = nM * nN; G = G_; c = c_; ext_n = 0; ext_pm0 = 0; ext_pn0 = 0; ext_w = 1; wgm = WGM; ext_c0 = 0; }
    __host__ __device__ void set_extra(int n, int pm0, int pn0, int w) { ext_n = n; ext_pm0 = pm0; ext_pn0 = pn0; ext_w = w; }
    __host__ __device__ bool next(int i, Unit& u) const {
        const long L = (long)i * G + c;
        if (L >= nwg) { const int e = (int)(L - nwg) - ext_c0; if (e < 0 || e >= ext_n) return false; u.pm = ext_pm0 + e / ext_w; u.pn = ext_pn0 + e % ext_w; return true; }
        int wgid = (int)L; { const int q = nwg / NXCD, r = nwg % NXCD, xcd = wgid % NXCD, off = wgid / NXCD; wgid = (xcd < r ? xcd * (q + 1) : r * (q + 1) + (xcd - r) * q) + off; }
        const int nig = wgm * nN, gid = wgid / nig, fm = gid * wgm, gsz = (nM - fm) < wgm ? (nM - fm) : wgm;
        u.pm = fm + ((wgid % nig) % gsz); u.pn = (wgid % nig) / gsz; return true;
    }
    static __host__ __device__ __forceinline__ void map_entry(int nM_, int nN_, int L, Unit& u, int WGM_ = WGM) {
        const int nwg_ = nM_ * nN_; int wgid = L; { const int q = nwg_ / NXCD, r = nwg_ % NXCD, xcd = wgid % NXCD, off = wgid / NXCD; wgid = (xcd < r ? xcd * (q + 1) : r * (q + 1) + (xcd - r) * q) + off; }
        const int nig = WGM_ * nN_, gid = wgid / nig, fm = gid * WGM_, gsz = (nM_ - fm) < WGM_ ? (nM_ - fm) : WGM_;
        u.pm = fm + ((wgid % nig) % gsz); u.pn = (wgid % nig) / gsz;
    }
    __device__ __forceinline__ void a_ready(const Unit&) const {}
    __device__ __forceinline__ void done(const Unit&) const {}
};
struct MergeOrder : StaticOrder {
    const unsigned* wflag; unsigned* tmo;
    __device__ __forceinline__ void a_ready(const Unit& u) const {
        if (wflag == nullptr || ext_n == 0 || u.pm < ext_pm0) return;
        if (threadIdx.x < 64) {
            const unsigned* f = wflag + (size_t)((u.pm - ext_pm0) * ext_w + (u.pn - ext_pn0)) * 16;
            const unsigned long long t0 = __builtin_amdgcn_s_memrealtime(); unsigned polls = 0;
            while ((unsigned)__builtin_amdgcn_readfirstlane(__hip_atomic_load(f, __ATOMIC_RELAXED, __HIP_MEMORY_SCOPE_AGENT)) == 0u) {
                if ((++polls & 255u) == 0u && __builtin_amdgcn_readfirstlane(__hip_atomic_load(tmo, __ATOMIC_RELAXED, __HIP_MEMORY_SCOPE_AGENT)) != 0u) break;
                if (__builtin_amdgcn_s_memrealtime() - t0 > 2000000ull) { if (threadIdx.x == 0) __hip_atomic_store(tmo, 1u, __ATOMIC_RELAXED, __HIP_MEMORY_SCOPE_AGENT); break; }
                __builtin_amdgcn_s_sleep(2); }
            __builtin_amdgcn_fence(__ATOMIC_ACQUIRE, "agent");
            asm volatile("s_waitcnt vmcnt(0)" ::: "memory");
        }
        asm volatile("" ::: "memory"); __builtin_amdgcn_s_barrier(); asm volatile("" ::: "memory");
    }
};
typedef float f32x2_t __attribute__((ext_vector_type(2))); typedef __bf16 bf16x2_t __attribute__((ext_vector_type(2)));
__device__ __forceinline__ unsigned cvt_pk_bf16(float lo, float hi) { f32x2_t v = {lo, hi}; bf16x2_t b = __builtin_convertvector(v, bf16x2_t); return __builtin_bit_cast(unsigned, b); }
typedef float f32x2 __attribute__((ext_vector_type(2)));
template <class Epi, class Sched, bool ALIGN_EPI = false, bool SP2 = false>
__device__ __forceinline__ void gemm_phase(PG8_LAS unsigned char* lds, const Gemm g, const Sched& S, const Epi& E) {
    int tid_ = threadIdx.x; asm volatile("" : "+v"(tid_));
    const int tid = tid_, wid = __builtin_amdgcn_readfirstlane(tid >> 6), lane = tid & 63, wr = wid >> 2, wc = wid & 3, fr = lane & 15, fq = lane >> 4;
    const int K = g.K, nt = K / BK;
    unsigned voffA[2], voffB[2];
#pragma unroll
    for (int i = 0; i < 2; ++i) { int R, C; stage_rc(tid * 16 + i * 8192, R, C); const int Rb = Epi::PERM ? ((R & ~31) + perm32(R & 31)) : R;
        voffA[i] = (unsigned)(R * K + C) * 2u; voffB[i] = (unsigned)(Rb * K + C) * 2u; }
    const size_t kstep = (size_t)(BK * 2);
    const size_t hstep = (size_t)HALF * K * 2;
    const size_t tstep = 2 * hstep;
    const unsigned ldsw = (unsigned)wid * 1024u;
    const int aoff = lds_byte(wr * 64 + fr, fq * 8), boff = lds_byte(wc * 32 + fr, fq * 8);
#define PG8_SA(b, h) (((b) * 2 + (h)) * HTB)
#define PG8_SB(b, h) ((4 + (b) * 2 + (h)) * HTB)
#define PG8_STAGE(bufoff, gbase, voff) do { _Pragma("unroll") for (int _i = 0; _i < 2; ++_i) \
        __builtin_amdgcn_global_load_lds((const unsigned*)((const char*)(gbase) + (voff)[_i]), (PG8_LAS unsigned*)(lds + (bufoff) + ldsw + _i * 8192), 16, 0, 0); } while (0)
#define PG8_LDA(dst, b, h) do { _Pragma("unroll") for (int m = 0; m < 4; ++m) _Pragma("unroll") for (int k = 0; k < 2; ++k) dst[m][k] = *(const PG8_LAS bf16x8*)(lds + PG8_SA(b, h) + aoff + m * 2048 + k * 1024); } while (0)
#define PG8_LDB(dst, b, h) do { _Pragma("unroll") for (int n = 0; n < 2; ++n) _Pragma("unroll") for (int k = 0; k < 2; ++k) dst[n][k] = *(const PG8_LAS bf16x8*)(lds + PG8_SB(b, h) + boff + n * 2048 + k * 1024); } while (0)
#define PG8_MMA(ai, bj, At, Bt) do { __builtin_amdgcn_s_setprio(1); _Pragma("unroll") for (int m = 0; m < 4; ++m) _Pragma("unroll") for (int n = 0; n < 2; ++n) _Pragma("unroll") for (int k = 0; k < 2; ++k) \
        acc[ai][bj][m][n] = __builtin_amdgcn_mfma_f32_16x16x32_bf16(Bt[n][k], At[m][k], acc[ai][bj][m][n], 0, 0, 0); __builtin_amdgcn_s_setprio(0); } while (0)
#define PG8_WAIT_V(n) asm volatile("s_waitcnt vmcnt(" #n ")" ::: "memory")
#define PG8_WAIT_L(n) asm volatile("s_waitcnt lgkmcnt(" #n ")" ::: "memory")
#define PG8_BAR __builtin_amdgcn_s_barrier()
#define PG8_SCHED __builtin_amdgcn_sched_barrier(0)
    Unit cur, nxt; int ui = 0;
    if (!S.next(0, cur)) return;
    f32x4 acc[2][2][4][2];
#pragma unroll
    for (int a = 0; a < 2; ++a)
#pragma unroll
        for (int b = 0; b < 2; ++b)
#pragma unroll
            for (int m = 0; m < 4; ++m)
#pragma unroll
                for (int n = 0; n < 2; ++n) acc[a][b][m][n] = (f32x4){0.f, 0.f, 0.f, 0.f};
    bf16x8 At[4][2], B0[2][2], B1[2][2];
    const char* cA = (const char*)g.A + (size_t)cur.pm * tstep; const char* cB = (const char*)g.Bt + (size_t)cur.pn * tstep;
    S.a_ready(cur);
    if constexpr (SP2) {
        PG8_STAGE(PG8_SB(0, 0), cB, voffB); PG8_STAGE(PG8_SB(0, 1), cB + hstep, voffB); PG8_STAGE(PG8_SA(0, 0), cA, voffA); PG8_STAGE(PG8_SA(0, 1), cA + hstep, voffA);
        if (wr == 1) PG8_BAR;
        PG8_WAIT_V(2); PG8_BAR;
        PG8_STAGE(PG8_SB(1, 0), cB + kstep, voffB); PG8_STAGE(PG8_SA(1, 0), cA + kstep, voffA); PG8_STAGE(PG8_SB(1, 1), cB + hstep + kstep, voffB);
        PG8_WAIT_V(6); PG8_BAR;
    } else {
        PG8_STAGE(PG8_SB(0, 0), cB, voffB); PG8_STAGE(PG8_SA(0, 0), cA, voffA); PG8_STAGE(PG8_SB(0, 1), cB + hstep, voffB); PG8_STAGE(PG8_SA(0, 1), cA + hstep, voffA);
        if (wr == 1) PG8_BAR;
        PG8_WAIT_V(4); PG8_BAR;
        PG8_STAGE(PG8_SB(1, 0), cB + kstep, voffB); PG8_STAGE(PG8_SA(1, 0), cA + kstep, voffA); PG8_STAGE(PG8_SB(1, 1), cB + hstep + kstep, voffB);
        PG8_WAIT_V(6); PG8_BAR;
    }
    for (;;) {
        const bool has_next = S.next(ui + 1, nxt);
        const char* nA = has_next ? (const char*)g.A + (size_t)nxt.pm * tstep : cA; const char* nB = has_next ? (const char*)g.Bt + (size_t)nxt.pn * tstep : cB;
#pragma nounroll
        for (int t = 0; t < nt; t += 2) {
            const bool last = (t == nt - 2);
            const char* a1 = cA + (size_t)(t + 1) * kstep;
            const char* a2 = last ? nA : cA + (size_t)(t + 2) * kstep; const char* b2 = last ? nB : cB + (size_t)(t + 2) * kstep;
            const char* a3 = a2 + kstep; const char* b3 = b2 + kstep;
            if (last && has_next) S.a_ready(nxt);
            if constexpr (SP2) {
            PG8_LDB(B0, 0, 0); PG8_LDB(B1, 0, 1); PG8_SCHED; PG8_LDA(At, 0, 0); PG8_STAGE(PG8_SA(1, 1), a1 + hstep, voffA);
            PG8_WAIT_V(8); PG8_WAIT_L(0); PG8_BAR; PG8_MMA(0, 0, At, B0); PG8_MMA(0, 1, At, B1); PG8_BAR; PG8_SCHED;
            PG8_LDA(At, 0, 1); PG8_STAGE(PG8_SB(0, 0), b2, voffB); PG8_STAGE(PG8_SB(0, 1), b2 + hstep, voffB); PG8_STAGE(PG8_SA(0, 0), a2, voffA);
            PG8_WAIT_V(8); PG8_WAIT_L(0); PG8_BAR; PG8_MMA(1, 0, At, B0); PG8_MMA(1, 1, At, B1); PG8_BAR; PG8_SCHED;
            PG8_LDB(B0, 1, 0); PG8_LDB(B1, 1, 1); PG8_SCHED; PG8_LDA(At, 1, 0); PG8_STAGE(PG8_SA(0, 1), a2 + hstep, voffA);
            PG8_WAIT_V(8); PG8_WAIT_L(0); PG8_BAR; PG8_MMA(0, 0, At, B0); PG8_MMA(0, 1, At, B1); PG8_BAR; PG8_SCHED;
            PG8_LDA(At, 1, 1); PG8_STAGE(PG8_SB(1, 0), b3, voffB); PG8_STAGE(PG8_SB(1, 1), b3 + hstep, voffB); PG8_STAGE(PG8_SA(1, 0), a3, voffA);
            PG8_WAIT_V(8); PG8_WAIT_L(0); PG8_BAR; PG8_MMA(1, 0, At, B0); PG8_MMA(1, 1, At, B1); PG8_BAR; PG8_SCHED;
            } else {
            PG8_LDB(B0, 0, 0); PG8_SCHED; PG8_LDA(At, 0, 0); PG8_STAGE(PG8_SA(1, 1), a1 + hstep, voffA);
            PG8_WAIT_L(8); PG8_BAR; PG8_WAIT_L(0); PG8_MMA(0, 0, At, B0); PG8_BAR; PG8_SCHED;
            PG8_LDB(B1, 0, 1); PG8_STAGE(PG8_SB(0, 0), b2, voffB);
            PG8_BAR; PG8_WAIT_L(0); PG8_MMA(0, 1, At, B1); PG8_BAR;
            PG8_LDA(At, 0, 1); PG8_STAGE(PG8_SA(0, 0), a2, voffA);
            PG8_BAR; PG8_WAIT_L(0); PG8_MMA(1, 0, At, B0); PG8_BAR; PG8_SCHED;
            PG8_STAGE(PG8_SB(0, 1), b2 + hstep, voffB);
            PG8_WAIT_V(6); PG8_BAR; PG8_MMA(1, 1, At, B1); PG8_BAR;
            PG8_LDB(B0, 1, 0); PG8_SCHED; PG8_LDA(At, 1, 0); PG8_STAGE(PG8_SA(0, 1), a2 + hstep, voffA);
            PG8_WAIT_L(8); PG8_BAR; PG8_WAIT_L(0); PG8_MMA(0, 0, At, B0); PG8_BAR; PG8_SCHED;
            PG8_LDB(B1, 1, 1); PG8_STAGE(PG8_SB(1, 0), b3, voffB);
            PG8_BAR; PG8_WAIT_L(0); PG8_MMA(0, 1, At, B1); PG8_BAR;
            PG8_LDA(At, 1, 1); PG8_STAGE(PG8_SA(1, 0), a3, voffA);
            PG8_BAR; PG8_WAIT_L(0); PG8_MMA(1, 0, At, B0); PG8_BAR; PG8_SCHED;
            PG8_STAGE(PG8_SB(1, 1), b3 + hstep, voffB);
            PG8_WAIT_V(6); PG8_BAR; PG8_MMA(1, 1, At, B1); PG8_BAR;
            }
        }
        if constexpr (ALIGN_EPI) { if (wr == 0) PG8_BAR; }
        if constexpr (!Epi::AFTER_DRAIN) { E(acc, cur, wr, wc, fr, fq); S.done(cur); }
        if (!has_next) break;
#pragma unroll
        for (int a = 0; a < 2; ++a)
#pragma unroll
            for (int b = 0; b < 2; ++b)
#pragma unroll
                for (int m = 0; m < 4; ++m)
#pragma unroll
                    for (int n = 0; n < 2; ++n) acc[a][b][m][n] = (f32x4){0.f, 0.f, 0.f, 0.f};
        cur = nxt; cA = nA; cB = nB; ++ui;
        if constexpr (ALIGN_EPI) { if (wr == 1) PG8_BAR; }
    }
    PG8_WAIT_V(0);
    if constexpr (!ALIGN_EPI) { if (wr == 0) PG8_BAR; }
    PG8_BAR;
    if constexpr (Epi::AFTER_DRAIN) { E.fused(acc, cur, wr, wc, fr, fq, lds, wid, lane); S.done(cur); }
#undef PG8_SA
#undef PG8_SB
#undef PG8_STAGE
#undef PG8_LDA
#undef PG8_LDB
#undef PG8_MMA
#undef PG8_WAIT_V
#undef PG8_WAIT_L
#undef PG8_BAR
#undef PG8_SCHED
}
}
namespace pg8 {
typedef unsigned u32x2 __attribute__((ext_vector_type(2)));
constexpr int ML_ROWS = 32768;
__device__ __forceinline__ float sigm(float x) { return __builtin_amdgcn_rcpf(1.0f + __builtin_amdgcn_exp2f(-1.4426950408889634f * x)); }
__device__ __forceinline__ u32x2 pack4(const f32x4 v) { u32x2 w; w.x = cvt_pk_bf16(v[0], v[1]); w.y = cvt_pk_bf16(v[2], v[3]); return w; }
__device__ __forceinline__ void rope4(f32x4& x0, f32x4& x1, const float* rope, int row, int half, int fq) {
    const int t = row & 4095, p = half ? (t & 63) : (t >> 6);
    const f32x4* tp = (const f32x4*)(rope + (p * 16 + 4 * fq) * 2);
    const f32x4 a = tp[0], b = tp[1];
    const f32x4 c = {a[0], a[2], b[0], b[2]}, s = {a[1], a[3], b[1], b[3]};
    const f32x4 y0 = x0 * c - x1 * s, y1 = x1 * c + x0 * s;
    x0 = y0; x1 = y1;
}
struct EpiWin {
    static constexpr bool PERM = true, AFTER_DRAIN = false;
    unsigned char* G; bf16_t* CQ; bf16_t* KF; bf16_t* GK; bf16_t* GV; bf16_t* GQ; bf16_t* U; const float* rope;
    __device__ __forceinline__ void operator()(const f32x4 (&acc)[2][2][4][2], const Unit& u, int wr, int wc, int fr, int fq) const {
        const int row0 = u.pm * BM + wr * 64 + fr; const bool lat = u.pm < (ML_ROWS / BM);
#pragma unroll
        for (int bj = 0; bj < 2; ++bj) {
            const int colg = u.pn * BM + bj * HALF + wc * 32;
            if (colg < 6144) {
#pragma unroll
                for (int ai = 0; ai < 2; ++ai)
#pragma unroll
                    for (int m = 0; m < 4; ++m) { const size_t row = (size_t)(row0 + ai * HALF + m * 16);
                        u32x2 gq;
#pragma unroll
                        for (int n = 0; n < 2; ++n) { const f32x4 v = acc[ai][bj][m][n];
#define SG8(x) ((unsigned)(__builtin_amdgcn_rcpf(1.0f + __builtin_amdgcn_exp2f(x)) * 255.0f + 0.5f))
                            const unsigned q0 = SG8(v[0]), q1 = SG8(v[1]), q2 = SG8(v[2]), q3 = SG8(v[3]);
#undef SG8
                            const unsigned w4 = q0 | (q1 << 8) | (q2 << 16) | (q3 << 24); if (n == 0) gq.x = w4; else gq.y = w4; }
                        *(u32x2*)(G + row * 6144 + colg + 8 * fq) = gq; }
            } else {
                const int o = colg - 6144;
                if (o < 256 || (o >= 576 && o < 1088)) {
                    const int co = (o < 256) ? o : (256 + o - 576);
#pragma unroll
                    for (int ai = 0; ai < 2; ++ai)
#pragma unroll
                        for (int m = 0; m < 4; ++m) { const size_t row = (size_t)(row0 + ai * HALF + m * 16);
#pragma unroll
                            for (int n = 0; n < 1; ++n) { const u32x2 w0 = pack4(acc[ai][bj][m][0]), w1 = pack4(acc[ai][bj][m][1]); u32x4 w; w.x = w0.x; w.y = w0.y; w.z = w1.x; w.w = w1.y; *(u32x4*)(CQ + row * 768 + co + 8 * fq) = w; } }
                } else if (o < 320) {
                    const int half = (o - 256) >> 5;
#pragma unroll
                    for (int ai = 0; ai < 2; ++ai)
#pragma unroll
                        for (int m = 0; m < 4; ++m) { const int r = row0 + ai * HALF + m * 16; f32x4 x0 = acc[ai][bj][m][0], x1 = acc[ai][bj][m][1];
                            if (lat) rope4(x0, x1, rope, r, half, fq);
                            const u32x2 w0 = pack4(x0), w1 = pack4(x1); bf16_t* p = KF + (size_t)r * 1536 + 128 + (o - 256) + 4 * fq;
#pragma unroll
                            for (int h = 0; h < 8; ++h) { *(u32x2*)(p + h * 192) = w0; *(u32x2*)(p + h * 192 + 16) = w1; } }
                } else if (o < 448 || (o >= 1088 && o < 1600)) {
                    const bool isk = o < 448; const int co = isk ? (o - 320) : (o - 1088); const int half = (co >> 5) & 1;
                    bf16_t* base = isk ? GK : GQ; const int ld = isk ? 128 : 512;
#pragma unroll
                    for (int ai = 0; ai < 2; ++ai)
#pragma unroll
                        for (int m = 0; m < 4; ++m) { const int r = row0 + ai * HALF + m * 16; f32x4 x0 = acc[ai][bj][m][0], x1 = acc[ai][bj][m][1];
                            if (lat) rope4(x0, x1, rope, r, half, fq);
                            bf16_t* p = base + (size_t)r * ld + co + 4 * fq; *(u32x2*)p = pack4(x0); *(u32x2*)(p + 16) = pack4(x1); }
                } else if (o < 576) {
#pragma unroll
                    for (int ai = 0; ai < 2; ++ai)
#pragma unroll
                        for (int m = 0; m < 4; ++m) { const size_t row = (size_t)(row0 + ai * HALF + m * 16); bf16_t* p = GV + row * 128 + (o - 448) + 8 * fq;
                            const u32x2 w0 = pack4(acc[ai][bj][m][0]), w1 = pack4(acc[ai][bj][m][1]); u32x4 w; w.x = w0.x; w.y = w0.y; w.z = w1.x; w.w = w1.y; *(u32x4*)p = w; }
                } else if (o < 2624) {
                    const int g = (o - 1600) >> 5;
#pragma unroll
                    for (int ai = 0; ai < 2; ++ai)
#pragma unroll
                        for (int m = 0; m < 4; ++m) { const size_t row = (size_t)(row0 + ai * HALF + m * 16); const f32x4 a = acc[ai][bj][m][0], b = acc[ai][bj][m][1];
                            const f32x4 uu = {a[0] * sigm(b[0]), a[1] * sigm(b[1]), a[2] * sigm(b[2]), a[3] * sigm(b[3])};
                            *(u32x2*)(U + row * 512 + 16 * g + 4 * fq) = pack4(uu); }
                }
            }
        }
    }
};
struct EpiQup {
    static constexpr bool PERM = true, AFTER_DRAIN = false;
    bf16_t* MQ; const float* rope;
    __device__ __forceinline__ void operator()(const f32x4 (&acc)[2][2][4][2], const Unit& u, int wr, int wc, int fr, int fq) const {
        const int row0 = u.pm * BM + wr * 64 + fr; const bool lat = u.pm < (ML_ROWS / BM);
#pragma unroll
        for (int bj = 0; bj < 2; ++bj) {
            const int colg = u.pn * BM + bj * HALF + wc * 32, hd = colg % 192; const bool isr = hd >= 128; const int half = (hd - 128) >> 5;
#pragma unroll
            for (int ai = 0; ai < 2; ++ai)
#pragma unroll
                for (int m = 0; m < 4; ++m) { const int r = row0 + ai * HALF + m * 16; f32x4 x0 = acc[ai][bj][m][0], x1 = acc[ai][bj][m][1];
                    if (isr) { if (lat) rope4(x0, x1, rope, r, half, fq);
                        bf16_t* p = MQ + (size_t)r * 1536 + colg + 4 * fq; *(u32x2*)p = pack4(x0); *(u32x2*)(p + 16) = pack4(x1); }
                    else { const u32x2 w0 = pack4(x0), w1 = pack4(x1); u32x4 w; w.x = w0.x; w.y = w0.y; w.z = w1.x; w.w = w1.y; *(u32x4*)(MQ + (size_t)r * 1536 + colg + 8 * fq) = w; } }
        }
    }
};
struct EpiKV {
    static constexpr bool PERM = true, AFTER_DRAIN = false;
    bf16_t* KF; bf16_t* V;
    __device__ __forceinline__ void operator()(const f32x4 (&acc)[2][2][4][2], const Unit& u, int wr, int wc, int fr, int fq) const {
        const int row0 = u.pm * BM + wr * 64 + fr, c0 = wc * 32 + 8 * fq;
#pragma unroll
        for (int ai = 0; ai < 2; ++ai)
#pragma unroll
            for (int m = 0; m < 4; ++m) { const size_t row = (size_t)(row0 + ai * HALF + m * 16);
#pragma unroll
                for (int bj = 0; bj < 2; ++bj) { const f32x4 v0 = acc[ai][bj][m][0], v1 = acc[ai][bj][m][1];
                    u32x4 w; w.x = cvt_pk_bf16(v0[0], v0[1]); w.y = cvt_pk_bf16(v0[2], v0[3]); w.z = cvt_pk_bf16(v1[0], v1[1]); w.w = cvt_pk_bf16(v1[2], v1[3]);
                    if (bj == 0) *(u32x4*)(KF + row * 1536 + u.pn * 192 + c0) = w; else *(u32x4*)(V + row * 1024 + u.pn * 128 + c0) = w; } }
    }
};
template <int STEP> struct EpiMerge {
    static constexpr bool PERM = true, AFTER_DRAIN = false;
    const unsigned char* G; bf16_t* YF; bf16_t* Y; int wt_pm;
    __device__ __forceinline__ void operator()(const f32x4 (&acc)[2][2][4][2], const Unit& u, int wr, int wc, int fr, int fq) const {
        constexpr int NBATCH = 4;
        const int row0 = u.pm * BM + wr * 64 + fr, col0 = u.pn * BM + wc * 32 + 8 * fq;
        bf16_t* dst = (STEP < 2) ? YF : Y;
        const bool wt = (STEP < 2) && (u.pm >= wt_pm);
#pragma unroll
        for (int ai = 0; ai < 2; ++ai)
#pragma unroll
            for (int mb = 0; mb < 4; mb += NBATCH) {
                u32x2 gw[NBATCH][2]; u32x4 yv[NBATCH][2];
#pragma unroll
                for (int q = 0; q < NBATCH; ++q) { const size_t row = (size_t)(row0 + ai * HALF + (mb + q) * 16);
#pragma unroll
                    for (int bj = 0; bj < 2; ++bj) { const int c = col0 + bj * HALF;
                        gw[q][bj] = *(const u32x2*)(G + row * 6144 + STEP * 2048 + c);
                        if (STEP > 0) yv[q][bj] = *(const u32x4*)(YF + row * 2048 + c); } }
#pragma unroll
                for (int q = 0; q < NBATCH; ++q) { const size_t row = (size_t)(row0 + ai * HALF + (mb + q) * 16); const int m = mb + q;
#pragma unroll
                    for (int bj = 0; bj < 2; ++bj) { const int c = col0 + bj * HALF; const u32x2 g2 = gw[q][bj]; constexpr float I255 = 1.0f / 255.0f;
                        const f32x4 g0 = {(float)(g2.x & 255u) * I255, (float)((g2.x >> 8) & 255u) * I255, (float)((g2.x >> 16) & 255u) * I255, (float)(g2.x >> 24) * I255};
                        const f32x4 g1 = {(float)(g2.y & 255u) * I255, (float)((g2.y >> 8) & 255u) * I255, (float)((g2.y >> 16) & 255u) * I255, (float)(g2.y >> 24) * I255};
                        f32x4 a0 = acc[ai][bj][m][0] * g0, a1 = acc[ai][bj][m][1] * g1;
                        if (STEP > 0) { const u32x4 y4 = yv[q][bj];
                            a0 += (f32x4){__uint_as_float(y4.x << 16), __uint_as_float(y4.x & 0xffff0000u), __uint_as_float(y4.y << 16), __uint_as_float(y4.y & 0xffff0000u)};
                            a1 += (f32x4){__uint_as_float(y4.z << 16), __uint_as_float(y4.z & 0xffff0000u), __uint_as_float(y4.w << 16), __uint_as_float(y4.w & 0xffff0000u)}; }
                        u32x4 w; w.x = cvt_pk_bf16(a0[0], a0[1]); w.y = cvt_pk_bf16(a0[2], a0[3]); w.z = cvt_pk_bf16(a1[0], a1[1]); w.w = cvt_pk_bf16(a1[2], a1[3]);
                        if (wt) asm volatile("global_store_dwordx4 %0, %1, off sc1" :: "v"(dst + row * 2048 + c), "v"(w) : "memory");
                        else *(u32x4*)(dst + row * 2048 + c) = w; } }
                asm volatile("" ::: "memory"); }
    }
};
struct EpiResid {
    static constexpr bool PERM = true, AFTER_DRAIN = false;
    bf16_t* XB; const float* modl; int goff;
    __device__ __forceinline__ void operator()(const f32x4 (&acc)[2][2][4][2], const Unit& u, int wr, int wc, int fr, int fq) const {
        const int sel = u.pm >> 4;
        const int col0 = u.pn * BM + wc * 32 + 8 * fq; const float* gt = modl + sel * 12288 + goff + col0;
        bf16_t* base = XB + (size_t)(u.pm * BM + wr * 64 + fr) * 2048;
        f32x4 gv[2][2];
#pragma unroll
        for (int bj = 0; bj < 2; ++bj)
#pragma unroll
            for (int n = 0; n < 2; ++n) gv[bj][n] = *(const f32x4*)(gt + bj * HALF + n * 4);
#pragma unroll
        for (int ai = 0; ai < 2; ++ai) {
            u32x4 xr[4][2];
#pragma unroll
            for (int m = 0; m < 4; ++m) { const bf16_t* rowp = base + (size_t)(ai * HALF + m * 16) * 2048 + col0;
#pragma unroll
                for (int bj = 0; bj < 2; ++bj) xr[m][bj] = *(const u32x4*)(rowp + bj * HALF); }
#pragma unroll
            for (int m = 0; m < 4; ++m) { bf16_t* rowp = base + (size_t)(ai * HALF + m * 16) * 2048 + col0;
#pragma unroll
                for (int bj = 0; bj < 2; ++bj) { const u32x4 t = xr[m][bj];
                    const f32x4 x0 = {__uint_as_float(t.x << 16), __uint_as_float(t.x & 0xffff0000u), __uint_as_float(t.y << 16), __uint_as_float(t.y & 0xffff0000u)};
                    const f32x4 x1 = {__uint_as_float(t.z << 16), __uint_as_float(t.z & 0xffff0000u), __uint_as_float(t.w << 16), __uint_as_float(t.w & 0xffff0000u)};
                    const u32x2 w0 = pack4(x0 + gv[bj][0] * acc[ai][bj][m][0]), w1 = pack4(x1 + gv[bj][1] * acc[ai][bj][m][1]);
                    u32x4 w; w.x = w0.x; w.y = w0.y; w.z = w1.x; w.w = w1.y; *(u32x4*)(rowp + bj * HALF) = w; } }
            asm volatile("" ::: "memory"); }
    }
};
struct EpiSwiGLU {
    static constexpr bool PERM = true, AFTER_DRAIN = false;
    bf16_t* HID;
    __device__ __forceinline__ void operator()(const f32x4 (&acc)[2][2][4][2], const Unit& u, int wr, int wc, int fr, int fq) const {
        const int row0 = u.pm * BM + wr * 64 + fr, h0 = u.pn * 128 + wc * 32 + 8 * fq;
#pragma unroll
        for (int ai = 0; ai < 2; ++ai)
#pragma unroll
            for (int m = 0; m < 4; ++m) { bf16_t* rowp = HID + (size_t)(row0 + ai * HALF + m * 16) * 5632 + h0;
                u32x2 w2[2];
#pragma unroll
                for (int n = 0; n < 2; ++n) { const f32x4 a = acc[ai][0][m][n], b = acc[ai][1][m][n];
                    const f32x4 h = {a[0] * sigm(a[0]) * b[0], a[1] * sigm(a[1]) * b[1], a[2] * sigm(a[2]) * b[2], a[3] * sigm(a[3]) * b[3]};
                    w2[n] = pack4(h); }
                u32x4 w; w.x = w2[0].x; w.y = w2[0].y; w.z = w2[1].x; w.w = w2[1].y; *(u32x4*)rowp = w; }
    }
};
}
namespace pg8 {
struct UnitX { int pm, pn, kind; };
template <class Epi, class Sched, bool CHAIN = false>
__device__ __forceinline__ void gemm_stream(PG8_LAS unsigned char* lds, const Sched& S, const Epi& E) {
    int tid_ = threadIdx.x; asm volatile("" : "+v"(tid_));
    const int tid = tid_, wid = __builtin_amdgcn_readfirstlane(tid >> 6), lane = tid & 63, wr = wid >> 2, wc = wid & 3, fr = lane & 15, fq = lane >> 4;
    int Rn, Rp, C2; { int R, C; stage_rc(tid * 16, R, C); Rn = R; Rp = (R & ~31) + perm32(R & 31); C2 = C * 2; }
    const size_t kstep = (size_t)(BK * 2);
    const unsigned ldsw = (unsigned)wid * 1024u;
    const int aoff = lds_byte(wr * 64 + fr, fq * 8), boff = lds_byte(wc * 32 + fr, fq * 8);
#define PG8_SA(b, h) (((b) * 2 + (h)) * HTB)
#define PG8_SB(b, h) ((4 + (b) * 2 + (h)) * HTB)
#define PG8_STAGE(bufoff, gbase, voff, r64) do { \
        __builtin_amdgcn_global_load_lds((const unsigned*)((const char*)(gbase) + (voff)), (PG8_LAS unsigned*)(lds + (bufoff) + ldsw), 16, 0, 0); \
        __builtin_amdgcn_global_load_lds((const unsigned*)((const char*)(gbase) + (r64) + (voff)), (PG8_LAS unsigned*)(lds + (bufoff) + ldsw + 8192), 16, 0, 0); } while (0)
#define PG8_LDA(dst, b, h) do { _Pragma("unroll") for (int m = 0; m < 4; ++m) _Pragma("unroll") for (int k = 0; k < 2; ++k) dst[m][k] = *(const PG8_LAS bf16x8*)(lds + PG8_SA(b, h) + aoff + m * 2048 + k * 1024); } while (0)
#define PG8_LDB(dst, b, h) do { _Pragma("unroll") for (int n = 0; n < 2; ++n) _Pragma("unroll") for (int k = 0; k < 2; ++k) dst[n][k] = *(const PG8_LAS bf16x8*)(lds + PG8_SB(b, h) + boff + n * 2048 + k * 1024); } while (0)
#define PG8_MMA(ai, bj, At, Bt) do { __builtin_amdgcn_s_setprio(1); _Pragma("unroll") for (int m = 0; m < 4; ++m) _Pragma("unroll") for (int n = 0; n < 2; ++n) _Pragma("unroll") for (int k = 0; k < 2; ++k) \
        acc[ai][bj][m][n] = __builtin_amdgcn_mfma_f32_16x16x32_bf16(Bt[n][k], At[m][k], acc[ai][bj][m][n], 0, 0, 0); __builtin_amdgcn_s_setprio(0); } while (0)
#define PG8_WAIT_V(n) asm volatile("s_waitcnt vmcnt(" #n ")" ::: "memory")
#define PG8_WAIT_L(n) asm volatile("s_waitcnt lgkmcnt(" #n ")" ::: "memory")
#define PG8_BAR __builtin_amdgcn_s_barrier()
#define PG8_SCHED __builtin_amdgcn_sched_barrier(0)
    UnitX cur, nxt; int ui = 0;
    if (!S.next(0, cur)) return;
    f32x4 acc[2][2][4][2];
#pragma unroll
    for (int a = 0; a < 2; ++a)
#pragma unroll
        for (int b = 0; b < 2; ++b)
#pragma unroll
            for (int m = 0; m < 4; ++m)
#pragma unroll
                for (int n = 0; n < 2; ++n) acc[a][b][m][n] = (f32x4){0.f, 0.f, 0.f, 0.f};
    bf16x8 At[4][2], B0[2][2], B1[2][2];
    int K2 = S.gPitch(cur.kind) * 2;
    unsigned voA = (unsigned)(Rn * K2 + C2), voB = (unsigned)((S.gPerm(cur.kind) ? Rp : Rn) * K2 + C2);
    size_t r64 = (size_t)64 * K2, hstep = (size_t)HALF * K2;
    int nt = S.gNt(cur.kind);
    const char* cA = (const char*)S.gA(cur.kind) + (size_t)cur.pm * 2 * hstep + (size_t)S.gK0(cur.kind) * 2; const char* cB = (const char*)S.gB(cur.kind) + (size_t)cur.pn * 2 * hstep + (size_t)S.gK0(cur.kind) * 2;
    PG8_STAGE(PG8_SB(0, 0), cB, voB, r64); PG8_STAGE(PG8_SB(0, 1), cB + hstep, voB, r64); PG8_STAGE(PG8_SA(0, 0), cA, voA, r64); PG8_STAGE(PG8_SA(0, 1), cA + hstep, voA, r64);
    if (wr == 1) PG8_BAR;
    PG8_WAIT_V(2); PG8_BAR;
    PG8_STAGE(PG8_SB(1, 0), cB + kstep, voB, r64); PG8_STAGE(PG8_SA(1, 0), cA + kstep, voA, r64); PG8_STAGE(PG8_SB(1, 1), cB + hstep + kstep, voB, r64);
    PG8_WAIT_V(6); PG8_BAR;
    for (;;) {
        const bool has_next = S.next(ui + 1, nxt);
        const int nkind = has_next ? nxt.kind : cur.kind;
        const int nK2 = S.gPitch(nkind) * 2;
        const unsigned nvoA = (unsigned)(Rn * nK2 + C2), nvoB = (unsigned)((S.gPerm(nkind) ? Rp : Rn) * nK2 + C2);
        const size_t nr64 = (size_t)64 * nK2, nhstep = (size_t)HALF * nK2;
        const char* nA = has_next ? (const char*)S.gA(nkind) + (size_t)nxt.pm * 2 * nhstep + (size_t)S.gK0(nkind) * 2 : cA; const char* nB = has_next ? (const char*)S.gB(nkind) + (size_t)nxt.pn * 2 * nhstep + (size_t)S.gK0(nkind) * 2 : cB;
#pragma nounroll
        for (int t = 0; t < nt; t += 2) {
            const bool last = (t == nt - 2);
            const char* a1 = cA + (size_t)(t + 1) * kstep;
            const char* a2 = last ? nA : cA + (size_t)(t + 2) * kstep; const char* b2 = last ? nB : cB + (size_t)(t + 2) * kstep;
            const char* a3 = a2 + kstep; const char* b3 = b2 + kstep;
            const unsigned vA2 = last ? nvoA : voA, vB2 = last ? nvoB : voB; const size_t r2 = last ? nr64 : r64, h2 = last ? nhstep : hstep;
            PG8_LDB(B0, 0, 0); PG8_LDB(B1, 0, 1); PG8_SCHED; PG8_LDA(At, 0, 0); PG8_STAGE(PG8_SA(1, 1), a1 + hstep, voA, r64);
            PG8_WAIT_V(8); PG8_WAIT_L(0); PG8_BAR; PG8_MMA(0, 0, At, B0); PG8_MMA(0, 1, At, B1); PG8_BAR; PG8_SCHED;
            PG8_LDA(At, 0, 1); PG8_STAGE(PG8_SB(0, 0), b2, vB2, r2); PG8_STAGE(PG8_SB(0, 1), b2 + h2, vB2, r2); PG8_STAGE(PG8_SA(0, 0), a2, vA2, r2);
            PG8_WAIT_V(8); PG8_WAIT_L(0); PG8_BAR; PG8_MMA(1, 0, At, B0); PG8_MMA(1, 1, At, B1); PG8_BAR; PG8_SCHED;
            PG8_LDB(B0, 1, 0); PG8_LDB(B1, 1, 1); PG8_SCHED; PG8_LDA(At, 1, 0); PG8_STAGE(PG8_SA(0, 1), a2 + h2, vA2, r2);
            PG8_WAIT_V(8); PG8_WAIT_L(0); PG8_BAR; PG8_MMA(0, 0, At, B0); PG8_MMA(0, 1, At, B1); PG8_BAR; PG8_SCHED;
            PG8_LDA(At, 1, 1); PG8_STAGE(PG8_SB(1, 0), b3, vB2, r2); PG8_STAGE(PG8_SB(1, 1), b3 + h2, vB2, r2); PG8_STAGE(PG8_SA(1, 0), a3, vA2, r2);
            PG8_WAIT_V(8); PG8_WAIT_L(0); PG8_BAR; PG8_MMA(1, 0, At, B0); PG8_MMA(1, 1, At, B1); PG8_BAR; PG8_SCHED;
        }
        if (wr == 0) PG8_BAR;
        if constexpr (CHAIN) E.chain(acc, cur.pm, cur.pn, cur.kind, wr, wc, fr, fq); else E(acc, cur.pm, cur.pn, cur.kind, wr, wc, fr, fq);
        if (!has_next) break;
        bool clr_ = true; if constexpr (CHAIN) clr_ = (cur.kind == Epi::LAST_KIND);
        if (clr_)
#pragma unroll
        for (int a = 0; a < 2; ++a)
#pragma unroll
            for (int b = 0; b < 2; ++b)
#pragma unroll
                for (int m = 0; m < 4; ++m)
#pragma unroll
                    for (int n = 0; n < 2; ++n) acc[a][b][m][n] = (f32x4){0.f, 0.f, 0.f, 0.f};
        cur.pm = nxt.pm; cur.pn = nxt.pn; cur.kind = nxt.kind; cA = nA; cB = nB; K2 = nK2; voA = nvoA; voB = nvoB; r64 = nr64; hstep = nhstep; nt = S.gNt(nkind); ++ui;
        if (wr == 1) PG8_BAR;
    }
    PG8_WAIT_V(0);
    PG8_BAR;
#undef PG8_SA
#undef PG8_SB
#undef PG8_STAGE
#undef PG8_LDA
#undef PG8_LDB
#undef PG8_MMA
#undef PG8_WAIT_V
#undef PG8_WAIT_L
#undef PG8_BAR
#undef PG8_SCHED
}
struct SchedMerge {
    StaticOrder base; const char* a0; long da1, da2; const char* b0; long db1, db2;
    __device__ __forceinline__ bool next(int i, UnitX& u) const { Unit b; const int q = i / 3; const bool ok = base.next(q, b); u.pm = b.pm; u.pn = b.pn; u.kind = i - 3 * q; return ok; }
    __device__ __forceinline__ const bf16_t* gA(int k) const { return (const bf16_t*)(a0 + (k > 0 ? da1 : 0l) + (k > 1 ? da2 : 0l)); }
    __device__ __forceinline__ const bf16_t* gB(int k) const { return (const bf16_t*)(b0 + (k > 0 ? db1 : 0l) + (k > 1 ? db2 : 0l)); }
    __device__ __forceinline__ int gPitch(int k) const { return k == 1 ? 1024 : 512; }
    __device__ __forceinline__ int gNt(int k) const { return k == 1 ? 16 : 8; }
    __device__ __forceinline__ int gK0(int) const { return 0; }
    __device__ __forceinline__ int gPerm(int) const { return 1; }
};
struct EpiMergeAll {
    EpiMerge<0> e0; EpiMerge<1> e1; EpiMerge<2> e2;
    __device__ __forceinline__ void operator()(const f32x4 (&acc)[2][2][4][2], int pm, int pn, int kind, int wr, int wc, int fr, int fq) const {
        Unit u; u.pm = pm; u.pn = pn;
        if (kind == 0) e0(acc, u, wr, wc, fr, fq); else if (kind == 1) e1(acc, u, wr, wc, fr, fq); else e2(acc, u, wr, wc, fr, fq);
    }
};
struct EpiChain {
    static constexpr int LAST_KIND = 2;
    const unsigned char* G; bf16_t* Y;
    __device__ __forceinline__ void chain(f32x4 (&acc)[2][2][4][2], int pm, int pn, int kind, int wr, int wc, int fr, int fq) const {
        const int row0 = pm * BM + wr * 64 + fr, col0 = pn * BM + wc * 32 + 8 * fq;
        const unsigned char* ga = G + (kind == 2 ? 2 : kind) * 2048; const unsigned char* gb = G + (kind == 0 ? 1 : 2) * 2048;
        const float amin = (kind == 0) ? 0.0f : 1.0f;
        const float bm = (kind == 2) ? 0.0f : 1.0f, bo = (kind == 2) ? 255.0f : 0.0f;
#pragma unroll
        for (int ai = 0; ai < 2; ++ai) {
            u32x2 qa[4][2], qb[4][2];
#pragma unroll
            for (int m = 0; m < 4; ++m) { const size_t row = (size_t)(row0 + ai * HALF + m * 16);
#pragma unroll
                for (int bj = 0; bj < 2; ++bj) { const int c = col0 + bj * HALF; qa[m][bj] = *(const u32x2*)(ga + row * 6144 + c); qb[m][bj] = *(const u32x2*)(gb + row * 6144 + c); } }
#pragma unroll
            for (int m = 0; m < 4; ++m)
#pragma unroll
                for (int bj = 0; bj < 2; ++bj)
#pragma unroll
                    for (int n = 0; n < 2; ++n) { const unsigned wa = n == 0 ? qa[m][bj].x : qa[m][bj].y, wb = n == 0 ? qb[m][bj].x : qb[m][bj].y;
                        f32x4 r;
#pragma unroll
                        for (int e = 0; e < 4; ++e) { const float fa = fmaxf((float)((wa >> (8 * e)) & 255u), amin), fb = fmaxf(fmaf((float)((wb >> (8 * e)) & 255u), bm, bo), 1.0f);
                            r[e] = fa * __builtin_amdgcn_rcpf(fb); }
                        acc[ai][bj][m][n] *= r; }
            asm volatile("" ::: "memory"); }
        if (kind == 2) {
#pragma unroll
            for (int ai = 0; ai < 2; ++ai)
#pragma unroll
                for (int m = 0; m < 4; ++m) { const size_t row = (size_t)(row0 + ai * HALF + m * 16);
#pragma unroll
                    for (int bj = 0; bj < 2; ++bj) { const int c = col0 + bj * HALF; const f32x4 a0 = acc[ai][bj][m][0], a1 = acc[ai][bj][m][1];
                        u32x4 w; w.x = cvt_pk_bf16(a0[0], a0[1]); w.y = cvt_pk_bf16(a0[2], a0[3]); w.z = cvt_pk_bf16(a1[0], a1[1]); w.w = cvt_pk_bf16(a1[2], a1[3]);
                        *(u32x4*)(Y + row * 2048 + c) = w; } }
        }
    }
};
struct SchedQKV {
    int nMq, nNq, nMk, nNk, G, c; const bf16_t* Aq; const bf16_t* Bq; const bf16_t* Ak; const bf16_t* Bk;
    __device__ __forceinline__ bool next(int i, UnitX& u) const {
        const int L = i * G + c, nq = nMq * nNq;
        Unit b; b.pm = 0; b.pn = 0; bool ok = true; int kind = 0;
        if (L < nq) StaticOrder::map_entry(nMq, nNq, L, b);
        else { const int L2 = L - nq; kind = 1; ok = L2 < nMk * nNk; if (ok) StaticOrder::map_entry(nMk, nNk, L2, b); }
        u.pm = b.pm; u.pn = b.pn; u.kind = kind; return ok;
    }
    __device__ __forceinline__ const bf16_t* gA(int k) const { return k == 0 ? Aq : Ak; }
    __device__ __forceinline__ const bf16_t* gB(int k) const { return k == 0 ? Bq : Bk; }
    __device__ __forceinline__ int gPitch(int k) const { return k == 0 ? 512 : 256; }
    __device__ __forceinline__ int gNt(int k) const { return k == 0 ? 8 : 4; }
    __device__ __forceinline__ int gK0(int) const { return 0; }
    __device__ __forceinline__ int gPerm(int) const { return 1; }
};
struct EpiQKV {
    EpiQup eq; EpiKV ek;
    __device__ __forceinline__ void operator()(const f32x4 (&acc)[2][2][4][2], int pm, int pn, int kind, int wr, int wc, int fr, int fq) const {
        Unit u; u.pm = pm; u.pn = pn;
        if (kind == 0) eq(acc, u, wr, wc, fr, fq); else ek(acc, u, wr, wc, fr, fq);
    }
};
struct SchedSplit {
    const bf16_t* A; const bf16_t* Bt; int K, nlat, nctx, G, c, wgm;
    __device__ __forceinline__ bool next(int i, UnitX& u) const {
        const int L = i * G + c; Unit b; b.pm = 0; b.pn = 0; int kind = 0; bool ok = true;
        if (L < nlat) StaticOrder::map_entry(ML_ROWS / BM, 8, L, b, wgm);
        else { const int e = L - nlat; ok = e < nctx; b.pm = ML_ROWS / BM + (e >> 5); b.pn = (e >> 2) & 7; kind = 1 + (e & 3); }
        u.pm = b.pm; u.pn = b.pn; u.kind = kind; return ok;
    }
    __device__ __forceinline__ const bf16_t* gA(int) const { return A; }
    __device__ __forceinline__ const bf16_t* gB(int) const { return Bt; }
    __device__ __forceinline__ int gPitch(int) const { return K; }
    __device__ __forceinline__ int gNt(int k) const { return k == 0 ? K / BK : K / (4 * BK); }
    __device__ __forceinline__ int gK0(int k) const { return k == 0 ? 0 : (k - 1) * (K / 4); }
    __device__ __forceinline__ int gPerm(int) const { return 1; }
};
struct EpiSplit {
    EpiResid er; bf16_t* PART;
    __device__ __forceinline__ void operator()(const f32x4 (&acc)[2][2][4][2], int pm, int pn, int kind, int wr, int wc, int fr, int fq) const {
        Unit u; u.pm = pm; u.pn = pn;
        if (kind == 0) { er(acc, u, wr, wc, fr, fq); return; }
        bf16_t* base = PART + ((size_t)(kind - 1) * 2048 + (size_t)(pm * BM - ML_ROWS + wr * 64 + fr)) * 2048 + pn * BM + wc * 32 + 8 * fq;
#pragma unroll
        for (int ai = 0; ai < 2; ++ai)
#pragma unroll
            for (int m = 0; m < 4; ++m) { bf16_t* rowp = base + (size_t)(ai * HALF + m * 16) * 2048;
#pragma unroll
                for (int bj = 0; bj < 2; ++bj) { const u32x2 w0 = pack4(acc[ai][bj][m][0]), w1 = pack4(acc[ai][bj][m][1]); u32x4 w; w.x = w0.x; w.y = w0.y; w.z = w1.x; w.w = w1.y; *(u32x4*)(rowp + bj * HALF) = w; } }
    }
};
}
#define XB_TMO      128
#define XB_XCNT(j)  (256  + 64 * (j))
#define XB_XSUB(j)  (1280 + 64 * (j))
#define XB_XGEN(j)  (2304 + 64 * (j))
#define XB_TOP      3328
#define XB_TOPGEN   3392
#define XCD_BAR_WORDS 3456
#define XB_SPIN_CAP (1u << 18)

__device__ __forceinline__ unsigned xb_ld(unsigned* p)              { return __hip_atomic_load(p, __ATOMIC_RELAXED, __HIP_MEMORY_SCOPE_AGENT); }
__device__ __forceinline__ unsigned xb_add(unsigned* p, unsigned v) { return __hip_atomic_fetch_add(p, v, __ATOMIC_RELAXED, __HIP_MEMORY_SCOPE_AGENT); }
__device__ __forceinline__ unsigned xb_xcc_id() { return (unsigned)__builtin_amdgcn_s_getreg((3 << 11) | 20) & 0xFu; }
#define XB_SPIN(cond, bar) do { unsigned _sp = 0; while (cond) { __builtin_amdgcn_s_sleep(1); \
    if ((++_sp & 255u) == 0u) { if (xb_ld(&(bar)[XB_TMO])) break; if (_sp > XB_SPIN_CAP) { atomicAdd(&(bar)[XB_TMO], 1u); break; } } } } while (0)

struct XcdBarrier {
    unsigned* bar; unsigned x;
    volatile LAS unsigned* st;
};

__device__ __forceinline__ XcdBarrier xcd_barrier_post(unsigned* bar, volatile LAS unsigned* st) {
    XcdBarrier b; b.bar = bar; b.x = xb_xcc_id(); b.st = st;
    if (threadIdx.x == 0) (void)xb_add(&bar[XB_XCNT(b.x)], 1u);
    return b;
}
__device__ __forceinline__ void xcd_barrier_complete(unsigned* bar, unsigned x, unsigned& nloc, unsigned& nx) {
    const unsigned G = gridDim.x * gridDim.y * gridDim.z;
    unsigned sum, cnt, mine, sp = 0u;
    for (;;) {
        sum = 0u; cnt = 0u; mine = 0u;
#pragma unroll
        for (unsigned j = 0; j < 16; ++j) { const unsigned c = xb_ld(&bar[XB_XCNT(j)]); sum += c; cnt += (c > 0u) ? 1u : 0u; mine = (j == x) ? c : mine; }
        if (sum == G) break;
        __builtin_amdgcn_s_sleep(1);
        if ((++sp & 255u) == 0u) { if (xb_ld(&bar[XB_TMO])) break; if (sp > XB_SPIN_CAP) { atomicAdd(&bar[XB_TMO], 1u); break; } }
    }
    nloc = mine > 0u ? mine : 1u; nx = cnt > 0u ? cnt : 1u;
}

__device__ __forceinline__ void xcd_barrier(const XcdBarrier& b) {
    asm volatile("s_waitcnt vmcnt(0)" ::: "memory");
    __syncthreads();
    if (threadIdx.x == 0) {
        unsigned* bar = b.bar;
        __builtin_amdgcn_s_waitcnt(0);
        unsigned nloc = b.st[0], nx = b.st[1];
        if (nloc == 0u) { xcd_barrier_complete(bar, b.x, nloc, nx); b.st[0] = nloc; b.st[1] = nx; }
        const unsigned old = xb_add(&bar[XB_XSUB(b.x)], 1u);
        const unsigned gen = old / nloc;
        if (old + 1u == (gen + 1u) * nloc) {
            __builtin_amdgcn_fence(__ATOMIC_RELEASE, "agent");
            asm volatile("s_waitcnt vmcnt(0)" ::: "memory");
            const unsigned og = xb_add(&bar[XB_TOP], 1u);
            const unsigned tg = og / nx;
            if (og + 1u == (tg + 1u) * nx) xb_add(&bar[XB_TOPGEN], 1u);
            else XB_SPIN(xb_ld(&bar[XB_TOPGEN]) == tg, bar);
            __builtin_amdgcn_fence(__ATOMIC_ACQUIRE, "agent");
            xb_add(&bar[XB_XGEN(b.x)], 1u);
            asm volatile("s_waitcnt vmcnt(0)" ::: "memory");
        } else {
            XB_SPIN(xb_ld(&bar[XB_XGEN(b.x)]) == gen, bar);
            __builtin_amdgcn_fence(__ATOMIC_ACQUIRE, "agent");
            asm volatile("s_waitcnt vmcnt(0)" ::: "memory");
        }
    }
    __syncthreads();
}
#ifndef ATT_ILV
#define ATT_ILV 1
#endif
#ifndef ATT_V4
#define ATT_V4 1
#endif
#ifndef ATT_DMAW
#define ATT_DMAW 4
#endif
#ifndef ATT_YOUNG_FROM
#define ATT_YOUNG_FROM (ATT_ILV ? 512 : 256)
#endif
namespace att {
typedef unsigned short bf16_t;
using bf16x8 = __attribute__((ext_vector_type(8))) short;
using s16x4  = __attribute__((ext_vector_type(4))) short;
using f32x16 = __attribute__((ext_vector_type(16))) float;
using u32x4  = __attribute__((ext_vector_type(4))) unsigned;
typedef LAS char lchar;
#define ASBAR() __builtin_amdgcn_sched_barrier(0)
__device__ __forceinline__ int crow(int r, int hi) { return (r & 3) + 8 * (r >> 2) + 4 * hi; }
__device__ __forceinline__ unsigned cvtpk(float lo, float hi) { return pg8::cvt_pk_bf16(lo, hi); }
template <int DK> __device__ __forceinline__ int koff(int row, int chunk) {
    return row * (DK * 2) + ((chunk & ~7) << 4) + (((chunk & 7) ^ ((row >> 1) & 7)) << 4);
}
template <int DV> __device__ __forceinline__ int v_st(int k, int c) { constexpr int NCB = DV / 32; const int kk = (k & ~0xC) | ((k & 4) << 1) | ((k & 8) >> 1); return ((kk >> 3) * NCB + (c >> 5)) * 512 + ((kk & 7) * 32 + (c & 31)) * 2; }
__device__ __forceinline__ int v_rd_base(int lane) { return ((lane & 3) << 3) | (((lane >> 2) & 3) << 6) | (((lane >> 4) & 1) << 5) | (((lane >> 5) & 1) << 8); }
template <int DV> constexpr int v_rd_off(int d0, int ks, int half) { return d0 * 512 + ks * (2 * (DV / 32) * 512) + half * ((DV / 32) * 512); }
#if ATT_ILV
template <int OFF> __device__ __forceinline__ s16x4 tr_read(int vb) { return __builtin_amdgcn_ds_read_tr16_b64_v4i16((LAS s16x4*)(unsigned)(vb + OFF)); }
#else
template <int OFF> __device__ __forceinline__ s16x4 tr_read(int vb) { s16x4 r; asm volatile("ds_read_b64_tr_b16 %0, %1 offset:%2" : "=&v"(r) : "v"(vb), "i"(OFF) : "memory"); return r; }
#endif

__device__ __forceinline__ void glds16(const void* gsrc, unsigned lds_dst) { unsigned keep; lds_dst = __builtin_amdgcn_readfirstlane(lds_dst);
    asm volatile("s_mov_b32 %0, m0\n\ts_mov_b32 m0, %2\n\ts_nop 0\n\tglobal_load_lds_dwordx4 %1, off\n\ts_mov_b32 m0, %0" : "=&s"(keep) : "v"(gsrc), "s"(lds_dst) : "memory"); }
__device__ __forceinline__ void glds16s(const void* sbase, unsigned voff, unsigned lds_dst) { unsigned keep; lds_dst = __builtin_amdgcn_readfirstlane(lds_dst);
    const unsigned long long b = (unsigned long long)sbase; const unsigned blo = __builtin_amdgcn_readfirstlane((unsigned)b), bhi = __builtin_amdgcn_readfirstlane((unsigned)(b >> 32));
    const unsigned long long sb = ((unsigned long long)bhi << 32) | blo;
    asm volatile("s_mov_b32 %0, m0\n\ts_mov_b32 m0, %3\n\ts_nop 0\n\tglobal_load_lds_dwordx4 %1, %2\n\ts_mov_b32 m0, %0" : "=&s"(keep) : "v"(voff), "s"(sb), "s"(lds_dst) : "memory"); }
template <bool WIN>
__device__ __forceinline__ void partialSM(f32x16& p0, f32x16& p1, float& m_reg, float& mn, float& alpha, const float C, const float thr, const bool domask, const int dq, const int hi) {
#if ATT_ILV
    if constexpr (WIN) { const int dqq = domask ? dq : 0;
#pragma unroll
        for (int r = 0; r < 16; ++r) { const int d0 = dqq + crow(r, hi), d1 = d0 + 32; p0[r] = (d0 > 128 || d0 < -128) ? -1e30f : p0[r]; p1[r] = (d1 > 128 || d1 < -128) ? -1e30f : p1[r]; } }
#else
    if constexpr (WIN) { if (domask) {
#pragma unroll
        for (int r = 0; r < 16; ++r) { const int d0 = dq + crow(r, hi), d1 = d0 + 32; if (d0 > 128 || d0 < -128) p0[r] = -1e30f; if (d1 > 128 || d1 < -128) p1[r] = -1e30f; } } }
#endif
    float pmax = p0[0];
#pragma unroll
    for (int r = 1; r < 16; ++r) pmax = fmaxf(pmax, p0[r]);
#pragma unroll
    for (int r = 0; r < 16; ++r) pmax = fmaxf(pmax, p1[r]);
    { auto rr = __builtin_amdgcn_permlane32_swap(__float_as_uint(pmax), __float_as_uint(pmax), false, false); pmax = fmaxf(__uint_as_float(rr[0]), __uint_as_float(rr[1])); }
#if ATT_ILV
    { const bool keep = __all(pmax - m_reg <= thr); mn = fmaxf(m_reg, keep ? m_reg : pmax); alpha = __builtin_amdgcn_exp2f((m_reg - mn) * C); m_reg = mn; }
#else
    if (__builtin_expect(__all(pmax - m_reg <= thr), 1)) { mn = m_reg; alpha = 1.f; }
    else { mn = fmaxf(m_reg, pmax); alpha = __builtin_amdgcn_exp2f((m_reg - mn) * C); m_reg = mn; }
#endif
    const float mnC = -mn * C;
#pragma unroll
    for (int r = 0; r < 16; ++r) p0[r] = fmaf(p0[r], C, mnC);
#pragma unroll
    for (int r = 0; r < 16; ++r) p1[r] = fmaf(p1[r], C, mnC);
#pragma unroll
    for (int r = 0; r < 16; ++r) p0[r] = __builtin_amdgcn_exp2f(p0[r]);
}
__device__ __forceinline__ void finishSM(f32x16& p0, f32x16& p1, float alpha, float& l_reg, bf16x8& pa0, bf16x8& pa1, bf16x8& pa2, bf16x8& pa3) {
#pragma unroll
    for (int r = 0; r < 16; ++r) p1[r] = __builtin_amdgcn_exp2f(p1[r]);
    float ps = 0;
#pragma unroll
    for (int r = 0; r < 16; ++r) ps += p0[r];
#pragma unroll
    for (int r = 0; r < 16; ++r) ps += p1[r];
    { auto rr = __builtin_amdgcn_permlane32_swap(__float_as_uint(ps), __float_as_uint(ps), false, false); ps = __uint_as_float(rr[0]) + __uint_as_float(rr[1]); }
    l_reg = l_reg * alpha + ps;
#define ATT_PK4(P, BASE, OUT) do { unsigned a0 = cvtpk(P[BASE + 0], P[BASE + 1]), a1 = cvtpk(P[BASE + 2], P[BASE + 3]);   \
    unsigned b0 = cvtpk(P[BASE + 4], P[BASE + 5]), b1 = cvtpk(P[BASE + 6], P[BASE + 7]);                              \
    auto r0 = __builtin_amdgcn_permlane32_swap(a0, b0, false, false); auto r1 = __builtin_amdgcn_permlane32_swap(a1, b1, false, false); \
    u32x4 w = {r0[0], r1[0], r0[1], r1[1]}; OUT = *reinterpret_cast<bf16x8*>(&w); } while (0)
    ATT_PK4(p0, 0, pa0); ATT_PK4(p0, 8, pa1); ATT_PK4(p1, 0, pa2); ATT_PK4(p1, 8, pa3);
#undef ATT_PK4
}
template <int DK> __device__ __forceinline__ void qkt(f32x16& p0, f32x16& p1, const lchar* Ks, const bf16x8 (&qr)[DK / 16], const int (&kq)[4]) {
    p0 = f32x16{}; p1 = f32x16{};
    bf16x8 c0 = *(const LAS bf16x8*)(Ks + kq[0]), c1 = *(const LAS bf16x8*)(Ks + kq[0] + 32 * DK * 2);
#pragma unroll
    for (int d0 = 0; d0 < DK / 16; ++d0) {
        bf16x8 n0 = c0, n1 = c1;
        if (d0 + 1 < DK / 16) { n0 = *(const LAS bf16x8*)(Ks + kq[(d0 + 1) & 3] + ((d0 + 1) >> 2) * 128); n1 = *(const LAS bf16x8*)(Ks + kq[(d0 + 1) & 3] + ((d0 + 1) >> 2) * 128 + 32 * DK * 2); }
        p0 = __builtin_amdgcn_mfma_f32_32x32x16_bf16(c0, qr[d0], p0, 0, 0, 0);
        p1 = __builtin_amdgcn_mfma_f32_32x32x16_bf16(c1, qr[d0], p1, 0, 0, 0);
        c0 = n0; c1 = n1; }
}
struct VFrag { s16x4 l0, h0, l1, h1, l2, h2, l3, h3; };
template <int DV, int D0> __device__ __forceinline__ void pv_reads(VFrag& f, int vb) {
    f.l0 = tr_read<v_rd_off<DV>(D0, 0, 0)>(vb); f.h0 = tr_read<v_rd_off<DV>(D0, 0, 1)>(vb); f.l1 = tr_read<v_rd_off<DV>(D0, 1, 0)>(vb); f.h1 = tr_read<v_rd_off<DV>(D0, 1, 1)>(vb);
    f.l2 = tr_read<v_rd_off<DV>(D0, 2, 0)>(vb); f.h2 = tr_read<v_rd_off<DV>(D0, 2, 1)>(vb); f.l3 = tr_read<v_rd_off<DV>(D0, 3, 0)>(vb); f.h3 = tr_read<v_rd_off<DV>(D0, 3, 1)>(vb);
}
__device__ __forceinline__ void pv_mma(f32x16& od, const VFrag& f, bf16x8 pa0, bf16x8 pa1, bf16x8 pa2, bf16x8 pa3) {
#define ATT_PK(L, H) (bf16x8){L[0], L[1], L[2], L[3], H[0], H[1], H[2], H[3]}
    od = __builtin_amdgcn_mfma_f32_32x32x16_bf16(pa0, ATT_PK(f.l0, f.h0), od, 0, 0, 0);
    od = __builtin_amdgcn_mfma_f32_32x32x16_bf16(pa1, ATT_PK(f.l1, f.h1), od, 0, 0, 0);
    od = __builtin_amdgcn_mfma_f32_32x32x16_bf16(pa2, ATT_PK(f.l2, f.h2), od, 0, 0, 0);
    od = __builtin_amdgcn_mfma_f32_32x32x16_bf16(pa3, ATT_PK(f.l3, f.h3), od, 0, 0, 0);
#undef ATT_PK
}
#define ATT_LWAIT(n) do { asm volatile("s_waitcnt lgkmcnt(" #n ")" ::: "memory"); ASBAR(); } while (0)
#if ATT_ILV
template <int DV> __device__ __forceinline__ void pv_all(f32x16 (&o)[DV / 32], int vb, bf16x8 pa0, bf16x8 pa1, bf16x8 pa2, bf16x8 pa3) {
    { VFrag f; pv_reads<DV, 0>(f, vb); pv_mma(o[0], f, pa0, pa1, pa2, pa3); }
    { VFrag f; pv_reads<DV, 1>(f, vb); pv_mma(o[1], f, pa0, pa1, pa2, pa3); }
    if constexpr (DV == 128) {
        { VFrag f; pv_reads<DV, 2>(f, vb); pv_mma(o[2], f, pa0, pa1, pa2, pa3); }
        { VFrag f; pv_reads<DV, 3>(f, vb); pv_mma(o[3], f, pa0, pa1, pa2, pa3); } }
}
#define ATT_SWAP(A, B) __builtin_amdgcn_permlane32_swap((A), (B), false, false)
#define ATT_PIN(X) asm volatile("" : "+v"(X))
template <int PT, int B> __device__ __forceinline__ void pk_step(const f32x16& P, unsigned& a0, unsigned& a1, unsigned& b0, unsigned& b1, unsigned& x0, unsigned& y0, bf16x8& OUT) {
    if constexpr (PT == 0) { a0 = cvtpk(P[B + 0], P[B + 1]); b0 = cvtpk(P[B + 4], P[B + 5]); }
    if constexpr (PT == 1) { a1 = cvtpk(P[B + 2], P[B + 3]); b1 = cvtpk(P[B + 6], P[B + 7]); }
    if constexpr (PT == 2) { auto r0 = ATT_SWAP(a0, b0); x0 = r0[0]; y0 = r0[1]; }
    if constexpr (PT == 3) { auto r1 = ATT_SWAP(a1, b1); u32x4 w = {x0, r1[0], y0, r1[1]}; OUT = *reinterpret_cast<bf16x8*>(&w); }
}
template <int K> __device__ __forceinline__ void fin_atom(f32x16& q0, f32x16& q1, float alpha, float& l_reg, float& ps0, float& ps1, unsigned& a0, unsigned& a1, unsigned& b0, unsigned& b1, unsigned& x0, unsigned& y0,
                                                          bf16x8& pa0, bf16x8& pa1, bf16x8& pa2, bf16x8& pa3) {
    if constexpr (K < 16) { q1[K] = __builtin_amdgcn_exp2f(q1[K]); ATT_PIN(q1[K]); ps0 += q0[K]; ATT_PIN(ps0); }
    if constexpr (K >= 8) { ps1 += q1[K - 8]; ATT_PIN(ps1); }
    if constexpr (K < 4) pk_step<K & 3, 0>(q0, a0, a1, b0, b1, x0, y0, pa0);
    else if constexpr (K < 8) pk_step<K & 3, 8>(q0, a0, a1, b0, b1, x0, y0, pa1);
    else if constexpr (K >= 16 && K < 20) pk_step<K & 3, 0>(q1, a0, a1, b0, b1, x0, y0, pa2);
    else if constexpr (K >= 20) pk_step<K & 3, 8>(q1, a0, a1, b0, b1, x0, y0, pa3);
    if constexpr (K == 23) { float ps = ps0 + ps1; auto rr = ATT_SWAP(__float_as_uint(ps), __float_as_uint(ps)); ps = __uint_as_float(rr[0]) + __uint_as_float(rr[1]); l_reg = l_reg * alpha + ps; }
}
template <int I, int NM, int DK> __device__ __forceinline__ void qk_step(f32x16& p0, f32x16& p1, const lchar* Ks, const bf16x8 (&qr)[DK / 16], const int (&kq)[4], bf16x8 (&F)[4],
        f32x16& q0, f32x16& q1, float alpha, float& l_reg, float& ps0, float& ps1, unsigned& a0, unsigned& a1, unsigned& b0, unsigned& b1, unsigned& x0, unsigned& y0, bf16x8& pa0, bf16x8& pa1, bf16x8& pa2, bf16x8& pa3) {
    constexpr int d0 = I >> 1, APG = 24 / NM;
    if constexpr (I == 0) p0 = __builtin_amdgcn_mfma_f32_32x32x16_bf16(F[0], qr[0], f32x16{}, 0, 0, 0);
    else if constexpr (I == 1) p1 = __builtin_amdgcn_mfma_f32_32x32x16_bf16(F[1], qr[0], f32x16{}, 0, 0, 0);
    else if constexpr ((I & 1) == 0) p0 = __builtin_amdgcn_mfma_f32_32x32x16_bf16(F[I & 3], qr[d0], p0, 0, 0, 0);
    else p1 = __builtin_amdgcn_mfma_f32_32x32x16_bf16(F[I & 3], qr[d0], p1, 0, 0, 0);
    if constexpr (I + 4 < NM) { constexpr int J = I + 4, e0 = J >> 1; F[I & 3] = *(const LAS bf16x8*)(Ks + kq[e0 & 3] + (e0 >> 2) * 128 + (J & 1) * (32 * DK * 2)); }
    fin_atom<APG * I>(q0, q1, alpha, l_reg, ps0, ps1, a0, a1, b0, b1, x0, y0, pa0, pa1, pa2, pa3);
    if constexpr (APG >= 2) fin_atom<APG * I + 1>(q0, q1, alpha, l_reg, ps0, ps1, a0, a1, b0, b1, x0, y0, pa0, pa1, pa2, pa3);
    if constexpr (APG >= 3) fin_atom<APG * I + 2>(q0, q1, alpha, l_reg, ps0, ps1, a0, a1, b0, b1, x0, y0, pa0, pa1, pa2, pa3);
    ASBAR();
    if constexpr (I + 1 < NM) qk_step<I + 1, NM, DK>(p0, p1, Ks, qr, kq, F, q0, q1, alpha, l_reg, ps0, ps1, a0, a1, b0, b1, x0, y0, pa0, pa1, pa2, pa3);
}
template <int DK> __device__ __forceinline__ void qkt_fin(f32x16& p0, f32x16& p1, const lchar* Ks, const bf16x8 (&qr)[DK / 16], const int (&kq)[4],
        f32x16& q0, f32x16& q1, float alpha, float& l_reg, bf16x8& pa0, bf16x8& pa1, bf16x8& pa2, bf16x8& pa3) {
    constexpr int NM = DK / 8;
    bf16x8 F[4];
#pragma unroll
    for (int i = 0; i < 4; ++i) F[i] = *(const LAS bf16x8*)(Ks + kq[(i >> 1) & 3] + ((i >> 1) >> 2) * 128 + (i & 1) * (32 * DK * 2));
    float ps0 = 0.f, ps1 = 0.f; unsigned a0 = 0, a1 = 0, b0 = 0, b1 = 0, x0 = 0, y0 = 0;
    ASBAR();
    qk_step<0, NM, DK>(p0, p1, Ks, qr, kq, F, q0, q1, alpha, l_reg, ps0, ps1, a0, a1, b0, b1, x0, y0, pa0, pa1, pa2, pa3);
}
template <int K, bool WIN> __device__ __forceinline__ void par_atom(f32x16& p0, f32x16& p1, float& m_reg, float& mn, float& alpha, const float C, const float thr, const int dqq, const int hi,
                                                                    float& pm0, float& pm1, float& pm2, float& pm3, float& mnC) {
    if constexpr (K < 4) { f32x16& P = (K < 2) ? p0 : p1; constexpr int B = (K & 1) * 8;
        if constexpr (WIN) {
#pragma unroll
            for (int r = B; r < B + 8; ++r) { const int d = dqq + crow(r, hi) + (K < 2 ? 0 : 32); P[r] = (d > 128 || d < -128) ? -1e30f : P[r]; } }
        const float m = fmaxf(fmaxf(fmaxf(P[B], P[B + 1]), fmaxf(P[B + 2], P[B + 3])), fmaxf(fmaxf(P[B + 4], P[B + 5]), fmaxf(P[B + 6], P[B + 7])));
        if constexpr (K == 0) pm0 = m; else if constexpr (K == 1) pm1 = m; else if constexpr (K == 2) pm2 = m; else pm3 = m; }
    if constexpr (K == 4) { float pmax = fmaxf(fmaxf(pm0, pm1), fmaxf(pm2, pm3));
        auto rr = ATT_SWAP(__float_as_uint(pmax), __float_as_uint(pmax)); pmax = fmaxf(__uint_as_float(rr[0]), __uint_as_float(rr[1]));
        const bool keep = __all(pmax - m_reg <= thr); mn = fmaxf(m_reg, keep ? m_reg : pmax); alpha = __builtin_amdgcn_exp2f((m_reg - mn) * C); m_reg = mn; mnC = -mn * C; }
    if constexpr (K >= 5 && K <= 8) { f32x16& P = (K < 7) ? p0 : p1; constexpr int B = ((K - 5) & 1) * 8;
#pragma unroll
        for (int r = B; r < B + 8; ++r) { P[r] = fmaf(P[r], C, mnC); ATT_PIN(P[r]); } }
    if constexpr (K >= 8) { p0[2 * (K - 8)] = __builtin_amdgcn_exp2f(p0[2 * (K - 8)]); p0[2 * (K - 8) + 1] = __builtin_amdgcn_exp2f(p0[2 * (K - 8) + 1]); ATT_PIN(p0[2 * (K - 8)]); ATT_PIN(p0[2 * (K - 8) + 1]); }
}
template <int I, int NM, int DV, bool WIN> __device__ __forceinline__ void pv_step(f32x16 (&o)[DV / 32], const int vb, const bf16x8 (&pa)[4], s16x4 (&L)[4], s16x4 (&H)[4],
        f32x16& p0, f32x16& p1, float& m_reg, float& mn, float& alpha, const float C, const float thr, const int dqq, const int hi, float& pm0, float& pm1, float& pm2, float& pm3, float& mnC) {
    constexpr int b = I >> 2, k = I & 3, APG = 16 / NM;
    { const s16x4 l = L[k], h = H[k]; o[b] = __builtin_amdgcn_mfma_f32_32x32x16_bf16(pa[k], (bf16x8){l[0], l[1], l[2], l[3], h[0], h[1], h[2], h[3]}, o[b], 0, 0, 0); }
    if constexpr (b + 1 < DV / 32) { L[k] = tr_read<v_rd_off<DV>(b + 1, k, 0)>(vb); H[k] = tr_read<v_rd_off<DV>(b + 1, k, 1)>(vb); }
    par_atom<APG * I, WIN>(p0, p1, m_reg, mn, alpha, C, thr, dqq, hi, pm0, pm1, pm2, pm3, mnC);
    if constexpr (APG >= 2) par_atom<APG * I + 1, WIN>(p0, p1, m_reg, mn, alpha, C, thr, dqq, hi, pm0, pm1, pm2, pm3, mnC);
    ASBAR();
    if constexpr (I + 1 < NM) pv_step<I + 1, NM, DV, WIN>(o, vb, pa, L, H, p0, p1, m_reg, mn, alpha, C, thr, dqq, hi, pm0, pm1, pm2, pm3, mnC);
}
template <int DV, bool WIN> __device__ __forceinline__ void pv_part(f32x16 (&o)[DV / 32], const int vb, bf16x8 pa0, bf16x8 pa1, bf16x8 pa2, bf16x8 pa3,
        f32x16& p0, f32x16& p1, float& m_reg, float& mn, float& alpha, const float C, const float thr, const bool domask, const int dq, const int hi) {
    constexpr int NM = DV / 8;
    const bf16x8 pa[4] = {pa0, pa1, pa2, pa3}; s16x4 L[4], H[4];
    L[0] = tr_read<v_rd_off<DV>(0, 0, 0)>(vb); H[0] = tr_read<v_rd_off<DV>(0, 0, 1)>(vb); L[1] = tr_read<v_rd_off<DV>(0, 1, 0)>(vb); H[1] = tr_read<v_rd_off<DV>(0, 1, 1)>(vb);
    L[2] = tr_read<v_rd_off<DV>(0, 2, 0)>(vb); H[2] = tr_read<v_rd_off<DV>(0, 2, 1)>(vb); L[3] = tr_read<v_rd_off<DV>(0, 3, 0)>(vb); H[3] = tr_read<v_rd_off<DV>(0, 3, 1)>(vb);
    float pm0 = 0.f, pm1 = 0.f, pm2 = 0.f, pm3 = 0.f, mnC = 0.f; const int dqq = domask ? dq : 0;
    ASBAR();
    pv_step<0, NM, DV, WIN>(o, vb, pa, L, H, p0, p1, m_reg, mn, alpha, C, thr, dqq, hi, pm0, pm1, pm2, pm3, mnC);
}
#else
template <int NM, int ND, int NV> __device__ __forceinline__ void sgb_pattern() {}
template <int DV> __device__ __forceinline__ void pv_all(f32x16 (&o)[DV / 32], int vb, bf16x8 pa0, bf16x8 pa1, bf16x8 pa2, bf16x8 pa3) {
    VFrag f;
    pv_reads<DV, 0>(f, vb); ATT_LWAIT(0); pv_mma(o[0], f, pa0, pa1, pa2, pa3);
    pv_reads<DV, 1>(f, vb); ATT_LWAIT(0); pv_mma(o[1], f, pa0, pa1, pa2, pa3);
    if constexpr (DV == 128) {
        pv_reads<DV, 2>(f, vb); ATT_LWAIT(0); pv_mma(o[2], f, pa0, pa1, pa2, pa3);
        pv_reads<DV, 3>(f, vb); ATT_LWAIT(0); pv_mma(o[3], f, pa0, pa1, pa2, pa3); }
}
#endif
template <int DK, int DV, bool WIN, bool SINK, int MODE>
__device__ __forceinline__ void attn_unit(const bf16_t* __restrict__ Qb, const int ldq, const bf16_t* __restrict__ Kb, const int ldk, const bf16_t* __restrict__ Vb, const int ldv,
                                          bf16_t* __restrict__ Ob, const int ldo, const int cbase, const int lbase, const int NT, const int qpos0, const int kpos0, const float sinkl2, lchar* lds) {
    constexpr int KI = DK / 64, VI = DV / 64, ND = DK / 16, NO = DV / 32, SHM_K = 64 * DK * 2, SHM_V = 64 * DV * 2;
    constexpr float SCALE = (DK == 192) ? 0.07216878364870322f : 0.125f, C = SCALE * 1.4426950408889634f, THRR = 8.0f / SCALE;
    int tid_ = threadIdx.x; asm volatile("" : "+v"(tid_));
    const int tid = tid_, wid = tid >> 6, lane = tid & 63, r32 = lane & 31, hi = lane >> 5;
    constexpr int NSLOT = (MODE == 2) ? 3 : 2, NSV = (MODE == 2 && ATT_V4) ? 4 : NSLOT;
    lchar* V_lds = lds; lchar* K_lds = lds + NSV * SHM_V;
    LAS float* wsf = (LAS float*)(lds + NSV * SHM_V + NSLOT * SHM_K) + wid * 64; LAS float* li_l = wsf; LAS float* al_l = wsf + 32;
    float m_reg = -1e30f, l_reg = 0.f; f32x16 o[NO]; bf16x8 qr[ND];
#pragma unroll
    for (int d = 0; d < NO; ++d) o[d] = f32x16{};
    const bf16_t* Qw = Qb + (long)(wid * 32 + r32) * ldq + hi * 8;
#pragma unroll
    for (int d0 = 0; d0 < ND; ++d0) qr[d0] = *(const bf16x8*)(Qw + d0 * 16);
    const int srow = tid >> 3, scg = tid & 7;
    const int kgo = srow * ldk + scg * 8, vgo = srow * ldv + scg * 8;
    int klo[KI];
#pragma unroll
    for (int i = 0; i < KI; ++i) klo[i] = koff<DK>(srow, scg + 8 * i);
    const int vlo = v_st<DV>(srow, scg * 8);
    const int vb0 = (int)(uintptr_t)V_lds + v_rd_base(lane);
    const int qpos = qpos0 + wid * 32 + r32;
    int kq[4];
#pragma unroll
    for (int k = 0; k < 4; ++k) kq[k] = r32 * (DK * 2) + (((2 * k) ^ hi ^ ((r32 >> 1) & 7)) << 4);
    bf16x8 ks[KI], vs[VI];
#define ATT_ROWOF(j) ((j) < 4 ? cbase + 64 * (j) : lbase + 64 * ((j) - 4))
#define ATT_SLOAD(j) do { const long rb_ = ATT_ROWOF(j); const bf16_t* kp_ = Kb + rb_ * ldk + kgo; const bf16_t* vp_ = Vb + rb_ * ldv + vgo; \
    _Pragma("unroll") for (int i_ = 0; i_ < KI; ++i_) ks[i_] = *(const bf16x8*)(kp_ + 64 * i_); \
    _Pragma("unroll") for (int i_ = 0; i_ < VI; ++i_) vs[i_] = *(const bf16x8*)(vp_ + 64 * i_); } while (0)
#define ATT_SWRITE(b) do { _Pragma("unroll") for (int i_ = 0; i_ < KI; ++i_) *(LAS bf16x8*)(K_lds + (b) * SHM_K + klo[i_]) = ks[i_]; \
    _Pragma("unroll") for (int i_ = 0; i_ < VI; ++i_) *(LAS bf16x8*)(V_lds + (b) * SHM_V + vlo + i_ * 1024) = vs[i_]; } while (0)
#define ATT_RESC(a) do { if (__any((a) < 1.f)) { if (hi == 0) al_l[r32] = (a); asm volatile("s_waitcnt lgkmcnt(0)" ::: "memory"); \
    _Pragma("unroll") for (int d_ = 0; d_ < NO; ++d_) _Pragma("unroll") for (int r_ = 0; r_ < 16; ++r_) o[d_][r_] *= al_l[crow(r_, hi)]; } } while (0)
#define ATT_DQ(j) (kpos0 + 64 * ((j) - 4) - qpos)
    f32x16 pA0, pA1, pB0, pB1; float mnA, mnB, alA, alB; bf16x8 pa0, pa1, pa2, pa3;
    __syncthreads();
    if constexpr (MODE == 2) {
        const int wu = __builtin_amdgcn_readfirstlane(wid);
        constexpr int DW = ATT_DMAW, KP = KI * 8 / DW, VP = VI * 8 / DW;
        const bool dmaw = wu < DW; const bool vw = ATT_V4 ? (wu >= 4) : dmaw; const int wdv = ATT_V4 ? (wu & 3) : wu;
        int kgs[KP], vgs[VP];
#pragma unroll
        for (int i = 0; i < KP; ++i) { const int p = ((wu & (DW - 1)) * KP + i) * 64 + lane, kr = p / (DK / 8), c2 = p % (DK / 8); kgs[i] = kr * ldk + (((c2 & ~7) | ((c2 & 7) ^ ((kr >> 1) & 7))) << 3); }
#pragma unroll
        for (int i = 0; i < VP; ++i) { const int u16 = (wdv * VP + i) * 64 + lane, st = u16 >> 5, kk = (st / (DV / 32)) * 8 + ((u16 >> 2) & 7), c = (st % (DV / 32)) * 32 + (u16 & 3) * 8;
            const int k = (kk & ~0xC) | ((kk & 4) << 1) | ((kk & 8) >> 1); vgs[i] = k * ldv + c; }
        const unsigned kl0 = (unsigned)(uintptr_t)K_lds + (unsigned)((wu & (DW - 1)) * KP) * 1024u, vl0 = (unsigned)(uintptr_t)V_lds + (unsigned)(wdv * VP) * 1024u;
#define ATT_DMAK(j, slot) do { const bf16_t* kp_ = Kb + (long)ATT_ROWOF(j) * ldk; if (dmaw) { _Pragma("unroll") for (int i_ = 0; i_ < KP; ++i_) glds16s(kp_, (unsigned)kgs[i_] * 2u, kl0 + (unsigned)(slot) * SHM_K + i_ * 1024); } } while (0)
#define ATT_DMAV(j, slot) do { const bf16_t* vp_ = Vb + (long)ATT_ROWOF(j) * ldv; if (vw) { _Pragma("unroll") for (int i_ = 0; i_ < VP; ++i_) glds16s(vp_, (unsigned)vgs[i_] * 2u, vl0 + (unsigned)(slot) * SHM_V + i_ * 1024); } } while (0)
#define ATT_WAITN(n) asm volatile("s_waitcnt vmcnt(" #n ") lgkmcnt(0)" ::: "memory")
#define ATT_WAIT1() do { if constexpr (KP + VP == 10) ATT_WAITN(10); else if constexpr (KP + VP == 5) ATT_WAITN(5); else if constexpr (KP + VP == 4) ATT_WAITN(4); else { static_assert(KP + VP == 2); ATT_WAITN(2); } } while (0)
#define ATT_WAIT2() do { if constexpr (KP + VP == 10) ATT_WAITN(20); else if constexpr (KP + VP == 5) ATT_WAITN(10); else if constexpr (KP + VP == 4) ATT_WAITN(8); else ATT_WAITN(4); } while (0)
#if ATT_V4
#define ATT_WAITS() do { if (!vw) { if constexpr (KP == 6) ATT_WAITN(6); else { static_assert(KP == 2); ATT_WAITN(2); } } else { if constexpr (VP == 4) ATT_WAITN(8); else { static_assert(VP == 2); ATT_WAITN(4); } } } while (0)
#define ATT_SYNC(j) do { if ((j) + 2 < NT) ATT_DMAV((j) + 2, ((j) + 2) & 3);                            \
        if ((j) + 2 < NT) ATT_WAITS(); else ATT_WAITN(0); \
        __builtin_amdgcn_s_barrier(); asm volatile("" ::: "memory"); \
        if ((j) + 3 < NT) ATT_DMAK((j) + 3, sc); } while (0)
#define ATT_VSLOT(t) ((t) & 3)
#else
#define ATT_SYNC(j) do { const int sp_ = (sc == 0) ? 2 : sc - 1; if ((j) + 2 < NT) ATT_WAIT1(); else ATT_WAITN(0); \
        __builtin_amdgcn_s_barrier(); asm volatile("" ::: "memory"); \
        if ((j) + 3 < NT) ATT_DMAK((j) + 3, sc); if ((j) + 2 < NT) ATT_DMAV((j) + 2, sp_); } while (0)
#define ATT_VSLOT(t) ((t) % 3)
#endif
#define ATT_STEP_OLD(j, PC0, PC1, MNC, ALC, PP0, PP1, MNP, ALP) do { const int spv_ = ATT_VSLOT((j) - 1); \
        ASBAR(); qkt_fin<DK>(PC0, PC1, K_lds + sc * SHM_K, qr, kq, PP0, PP1, ALP, l_reg, pa0, pa1, pa2, pa3); \
        pv_part<DV, WIN>(o, vb0 + spv_ * SHM_V, pa0, pa1, pa2, pa3, PC0, PC1, m_reg, MNC, ALC, C, THRR, (j) >= 4, ATT_DQ(j), hi); \
        ATT_SYNC(j); ATT_RESC(ALC); sc = (sc == 2) ? 0 : sc + 1; } while (0)
#define ATT_STEP_YNG(j, PC0, PC1, MNC, ALC, PP0, PP1, MNP, ALP) do { const int spv_ = (sc == 0) ? 2 : sc - 1; \
        partialSM<WIN>(PP0, PP1, m_reg, MNP, ALP, C, THRR, (j) - 1 >= 4, ATT_DQ((j) - 1), hi); ATT_RESC(ALP); \
        ASBAR(); qkt<DK>(PC0, PC1, K_lds + sc * SHM_K, qr, kq); \
        finishSM(PP0, PP1, ALP, l_reg, pa0, pa1, pa2, pa3); ASBAR(); \
        pv_all<DV>(o, vb0 + spv_ * SHM_V, pa0, pa1, pa2, pa3); \
        ATT_SYNC(j); sc = (sc == 2) ? 0 : sc + 1; } while (0)
        const bool young = (ATT_YOUNG_FROM < 512) && __builtin_amdgcn_readfirstlane(tid) >= ATT_YOUNG_FROM;
        ATT_WAITN(0); __builtin_amdgcn_s_barrier(); asm volatile("" ::: "memory");
        ATT_DMAK(0, 0); ATT_DMAK(1, 1); ATT_DMAV(0, 0); ATT_DMAK(2, 2); ATT_DMAV(1, 1);
#if ATT_V4
        if (!vw) { if constexpr (KP == 6) ATT_WAITN(12); else ATT_WAITN(4); }
        __builtin_amdgcn_s_barrier(); asm volatile("" ::: "memory");
#else
        ATT_WAIT2(); __builtin_amdgcn_s_barrier(); asm volatile("" ::: "memory");
#endif
        int sc = 0;
        if (young) {
            qkt<DK>(pA0, pA1, K_lds, qr, kq);
            ATT_SYNC(0); sc = 1;
            for (int j = 1; j + 1 < NT; j += 2) {
                ATT_STEP_YNG(j, pB0, pB1, mnB, alB, pA0, pA1, mnA, alA);
                ATT_STEP_YNG(j + 1, pA0, pA1, mnA, alA, pB0, pB1, mnB, alB);
            }
            ATT_STEP_YNG(NT - 1, pB0, pB1, mnB, alB, pA0, pA1, mnA, alA);
            partialSM<WIN>(pB0, pB1, m_reg, mnB, alB, C, THRR, NT - 1 >= 4, ATT_DQ(NT - 1), hi); ATT_RESC(alB);
        } else {
            qkt<DK>(pA0, pA1, K_lds, qr, kq); partialSM<WIN>(pA0, pA1, m_reg, mnA, alA, C, THRR, false, 0, hi);
            ATT_SYNC(0); ATT_RESC(alA); sc = 1;
            for (int j = 1; j + 1 < NT; j += 2) {
                ATT_STEP_OLD(j, pB0, pB1, mnB, alB, pA0, pA1, mnA, alA);
                ATT_STEP_OLD(j + 1, pA0, pA1, mnA, alA, pB0, pB1, mnB, alB);
            }
            ATT_STEP_OLD(NT - 1, pB0, pB1, mnB, alB, pA0, pA1, mnA, alA);
        }
        finishSM(pB0, pB1, alB, l_reg, pa0, pa1, pa2, pa3); ASBAR();
        pv_all<DV>(o, vb0 + ATT_VSLOT(NT - 1) * SHM_V, pa0, pa1, pa2, pa3);
#undef ATT_SYNC
#undef ATT_STEP_OLD
#undef ATT_STEP_YNG
#undef ATT_DMAK
#undef ATT_DMAV
#undef ATT_WAITN
#undef ATT_WAIT1
#undef ATT_WAIT2
    } else if constexpr (MODE == 1) {
        ATT_SLOAD(0); asm volatile("s_waitcnt vmcnt(0)" ::: "memory"); ATT_SWRITE(0); __syncthreads();
        for (int j = 0; j < NT; ++j) {
            const int b = j & 1;
            if (j + 1 < NT) ATT_SLOAD(j + 1);
            ASBAR(); qkt<DK>(pA0, pA1, K_lds + b * SHM_K, qr, kq);
            partialSM<WIN>(pA0, pA1, m_reg, mnA, alA, C, THRR, j >= 4, ATT_DQ(j), hi);
            ATT_RESC(alA);
            finishSM(pA0, pA1, alA, l_reg, pa0, pa1, pa2, pa3); ASBAR();
            pv_all<DV>(o, vb0 + b * SHM_V, pa0, pa1, pa2, pa3);
            if (j + 1 < NT) { asm volatile("s_waitcnt vmcnt(0)" ::: "memory"); ATT_SWRITE(b ^ 1); }
            __syncthreads();
        }
    } else {
    ATT_SLOAD(0); asm volatile("s_waitcnt vmcnt(0)" ::: "memory"); ATT_SWRITE(0); __syncthreads();
    qkt<DK>(pA0, pA1, K_lds, qr, kq); partialSM<WIN>(pA0, pA1, m_reg, mnA, alA, C, THRR, false, 0, hi);
    ATT_SLOAD(1); asm volatile("s_waitcnt vmcnt(0)" ::: "memory"); ATT_SWRITE(1); __syncthreads();
    for (int j = 1; j + 1 < NT; j += 2) {
        ASBAR(); qkt<DK>(pB0, pB1, K_lds + SHM_K, qr, kq);
        finishSM(pA0, pA1, alA, l_reg, pa0, pa1, pa2, pa3); ASBAR();
        ATT_SLOAD(j + 1); ASBAR();
        pv_all<DV>(o, vb0, pa0, pa1, pa2, pa3); partialSM<WIN>(pB0, pB1, m_reg, mnB, alB, C, THRR, j >= 4, ATT_DQ(j), hi);
        __syncthreads(); asm volatile("s_waitcnt vmcnt(0)" ::: "memory"); ATT_SWRITE(0);
        ATT_RESC(alB); __syncthreads();
        ASBAR(); qkt<DK>(pA0, pA1, K_lds, qr, kq);
        finishSM(pB0, pB1, alB, l_reg, pa0, pa1, pa2, pa3); ASBAR();
        ATT_SLOAD(j + 2); ASBAR();
        pv_all<DV>(o, vb0 + SHM_V, pa0, pa1, pa2, pa3); partialSM<WIN>(pA0, pA1, m_reg, mnA, alA, C, THRR, j + 1 >= 4, ATT_DQ(j + 1), hi);
        __syncthreads(); asm volatile("s_waitcnt vmcnt(0)" ::: "memory"); ATT_SWRITE(1);
        ATT_RESC(alA); __syncthreads();
    }
    ASBAR(); qkt<DK>(pB0, pB1, K_lds + SHM_K, qr, kq);
    finishSM(pA0, pA1, alA, l_reg, pa0, pa1, pa2, pa3); ASBAR();
    pv_all<DV>(o, vb0, pa0, pa1, pa2, pa3); partialSM<WIN>(pB0, pB1, m_reg, mnB, alB, C, THRR, NT - 1 >= 4, ATT_DQ(NT - 1), hi);
    __syncthreads(); ATT_RESC(alB);
    finishSM(pB0, pB1, alB, l_reg, pa0, pa1, pa2, pa3); ASBAR();
    pv_all<DV>(o, vb0 + SHM_V, pa0, pa1, pa2, pa3);
    }
    if constexpr (SINK) l_reg += __builtin_amdgcn_exp2f(sinkl2 - m_reg * C);
    if (hi == 0) li_l[r32] = l_reg;
    asm volatile("s_waitcnt lgkmcnt(0)" ::: "memory");
    float rli[16];
#pragma unroll
    for (int r = 0; r < 16; ++r) rli[r] = __builtin_amdgcn_rcpf(li_l[crow(r, hi)]);
    bf16_t* Ow = Ob + (long)(wid * 32) * ldo + r32;
#pragma unroll
    for (int r = 0; r < 16; ++r) { const int orow = crow(r, hi);
#pragma unroll
        for (int d0 = 0; d0 < NO; ++d0) Ow[(long)orow * ldo + d0 * 32] = (bf16_t)(cvtpk(o[d0][r] * rli[r], 0.f) & 0xffffu); }
#undef ATT_ROWOF
#undef ATT_SLOAD
#undef ATT_SWRITE
#undef ATT_RESC
#undef ATT_DQ
}
}
typedef unsigned short bf16;
typedef unsigned v4u __attribute__((ext_vector_type(4)));
typedef unsigned v2u __attribute__((ext_vector_type(2)));
typedef float f32x4 __attribute__((ext_vector_type(4)));
typedef short bf16x8 __attribute__((ext_vector_type(8)));
typedef GAS unsigned gu32;
#define LDS_WAIT() asm volatile("s_waitcnt lgkmcnt(0)" ::: "memory")
#define VM_WAIT() asm volatile("s_waitcnt vmcnt(0)" ::: "memory")

constexpr int NWAVES = 8;
constexpr int DM = 2048, NB = 8, SEQ = 4096, DEPTH = 4, CTXL = 256, DFF = 5632;
constexpr int ML = NB * SEQ, MC = NB * CTXL, MT = ML + MC;
constexpr int NIN = 8768, NINP = 8960, NMOD = 6 * DM;
constexpr float EPS = 1e-6f;
static_assert(ML == pg8::ML_ROWS, "row split");

constexpr size_t MiB = 1u << 20;
constexpr size_t WS_CTL = 0, CTL_ZERO_BYTES = 1 * MiB;
constexpr size_t WS_MOD = 1 * MiB;
constexpr size_t WS_ROPE = 3 * MiB;
constexpr size_t WS_W = 4 * MiB;
constexpr size_t WO_IN = 0, WO_Q = WO_IN + (size_t)NINP * DM * 2, WO_KV = WO_Q + (size_t)1536 * 512 * 2, WO_C = WO_KV + (size_t)2048 * 256 * 2, WO_M = WO_C + (size_t)2048 * 512 * 2,
                 WO_G = WO_M + (size_t)2048 * 1024 * 2, WO_O = WO_G + (size_t)2048 * 512 * 2, WO_F1 = WO_O + (size_t)2048 * 2048 * 2, WO_F2 = WO_F1 + (size_t)2 * DFF * DM * 2,
                 WO_END = WO_F2 + (size_t)DM * DFF * 2;
static_assert(WO_END <= 120 * MiB, "weights");
constexpr size_t WS_XC = 124 * MiB;
constexpr size_t WS_A = 140 * MiB;
constexpr size_t WS_B = 548 * MiB;
constexpr size_t WS_C = 684 * MiB;
constexpr size_t WS_D = 786 * MiB;
constexpr size_t WD_KF = 0, WD_V = 102 * MiB, WD_GQ = 170 * MiB, WD_GK = 204 * MiB, WD_GV = 213 * MiB, WD_U = 222 * MiB;
constexpr size_t WS_E = 1058 * MiB;
constexpr size_t WE_UC = 0, WE_CKV = 34 * MiB, WE_QA = 51 * MiB;
constexpr size_t WS_XB = 1144 * MiB;
constexpr size_t WS_END = 1272 * MiB;
static_assert((size_t)MT * 6144 * 2 <= 408 * MiB && (size_t)MT * 2048 * 2 <= 136 * MiB && (size_t)MT * 768 * 4 <= 102 * MiB && (size_t)MT * 2048 * 4 <= 272 * MiB && WD_U + (size_t)MT * 512 * 2 <= 272 * MiB, "ws map");
constexpr int CW_BAR = 4096;

constexpr int RING_OFF = 0, RING_BYTES = 147456, LDSCTL_OFF = RING_BYTES, MISC_OFF = LDSCTL_OFF + 320, LDS_BYTES = 163840;

__device__ __forceinline__ unsigned f2bf(float f) { unsigned u = __builtin_bit_cast(unsigned, f); return (u + 0x7fffu + ((u >> 16) & 1u)) >> 16; }
__device__ __forceinline__ unsigned pk2(float lo, float hi) { return pg8::cvt_pk_bf16(lo, hi); }
__device__ __forceinline__ float wave_sum(float v) {
#pragma unroll
    for (int o = 1; o < 64; o <<= 1) v += __shfl_xor(v, o);
    return v;
}
__device__ __forceinline__ float bflo(unsigned w) { return __uint_as_float(w << 16); }
__device__ __forceinline__ float bfhi(unsigned w) { return __uint_as_float(w & 0xffff0000u); }
__device__ __forceinline__ float sigmf(float x) { return __builtin_amdgcn_rcpf(1.0f + __builtin_amdgcn_exp2f(-1.4426950408889634f * x)); }

__device__ __forceinline__ int srccol(int mode, int n) {
    if (mode == 0) return n;
    if (mode == 1) {
        if (n < 6144) return 2624 + n;
        if (n < 7744) { const int o = n - 6144; const bool pair = (o >= 256 && o < 448) || o >= 1088;
            if (!pair) return o; const int b0 = o & ~31, p = o & 31; return b0 + 4 * (p >> 3) + (p & 3) + 16 * ((p >> 2) & 1); }
        if (n < 8768) { const int q = n - 7744, g = q >> 5, p = q & 31, i = 4 * (p >> 3) + (p & 3); return 1600 + (((p >> 2) & 1) ? 512 : 0) + 16 * g + i; }
        return -1;
    }
    if (mode == 3) { if (n % 192 < 128) return n; const int b0 = n & ~31, p = n & 31; return b0 + 4 * (p >> 3) + (p & 3) + 16 * ((p >> 2) & 1); }
    { const int t = n >> 8, j = n & 255; return j < 128 ? 128 * t + j : DFF + 128 * t + (j - 128); }
}
__device__ __forceinline__ void cvt_item(const float* W, int K, int N, bf16* WT, LAS float* scr, int item, int nblk, int lane, int mode) {
    const int kb = item / nblk, nb = item % nblk, k0 = 64 * kb, n0 = 32 * nb;
    const int kl = lane >> 3, nq = (lane & 7) * 4;
    const int sc = srccol(mode, n0 + nq);
    const float wsc = (mode == 1 && n0 < 6144) ? -1.4426950408889634f : 1.0f;
    const float* wp = W + (size_t)(k0 + kl) * N + (sc >= 0 ? sc : 0);
#pragma unroll
    for (int i = 0; i < 8; ++i) { const f32x4 v = *(const f32x4*)(wp + (size_t)(8 * i) * N) * wsc; LAS float* d = scr + (kl + 8 * i) * 33 + nq;
        d[0] = sc >= 0 ? v[0] : 0.f; d[1] = sc >= 0 ? v[1] : 0.f; d[2] = sc >= 0 ? v[2] : 0.f; d[3] = sc >= 0 ? v[3] : 0.f; }
    LDS_WAIT(); asm volatile("" ::: "memory");
    const int c = lane & 7;
#pragma unroll
    for (int j = 0; j < 4; ++j) { const int n = (lane >> 3) + 8 * j; const LAS float* s = scr + (8 * c) * 33 + n;
        v4u o; o.x = pk2(s[0 * 33], s[1 * 33]); o.y = pk2(s[2 * 33], s[3 * 33]); o.z = pk2(s[4 * 33], s[5 * 33]); o.w = pk2(s[6 * 33], s[7 * 33]);
        *(GAS v4u*)(WT + (size_t)(n0 + n) * K + k0 + 8 * c) = o; }
    LDS_WAIT(); asm volatile("" ::: "memory");
}

#ifndef ATT_MLA_MODE
#define ATT_MLA_MODE 2
#endif
#ifndef ATT_GQA_MODE
#define ATT_GQA_MODE 2
#endif
#ifndef P5_WGM
#define P5_WGM 8
#endif
#ifndef P1_WGM
#define P1_WGM 4
#endif
#ifndef P8_WGM
#define P8_WGM 4
#endif
#ifndef SPLIT_WGM
#define SPLIT_WGM 2
#endif
struct Args { const float* in[25]; float* out; unsigned char* ws; int multi, l_lo, l_hi, ph, pad0, pad1; };
enum { PH_PRE = -1, PH_POST = 10, PH_DUMP = 11 };

struct __attribute__((packed, aligned(4))) F3 { float x, y, z; };
#define PHASE_BEGIN \
    const __attribute__((address_space(4))) Args* ap = (const __attribute__((address_space(4))) Args*)__builtin_amdgcn_kernarg_segment_ptr(); asm volatile("" : "+s"(ap)); \
    unsigned char* ws = ap->ws; \
    int tid = threadIdx.x; asm volatile("" : "+v"(tid)); const int lane = tid & 63, wave = __builtin_amdgcn_readfirstlane(tid >> 6); \
    const int gw = vcu * NWAVES + wave, NGW = G * NWAVES; (void)gw; (void)NGW; (void)lane; \
    const float* in_x = ap->in[0]; const float* in_c = ap->in[1]; const float* in_ctx = ap->in[2]; const float* in_cctx = ap->in[3]; const float* w_ada = ap->in[4]; const float* b_ada = ap->in[5]; const float* g_mix = ap->in[6]; const float* w_in = ap->in[7]; const float* conv_w = ap->in[8]; const float* conv_b = ap->in[9]; const float* conv_ln_g = ap->in[10]; const float* conv_ln_b = ap->in[11]; const float* w_conv_out = ap->in[12]; const float* g_q_a = ap->in[13]; const float* w_q_up = ap->in[14]; const float* g_kv_a = ap->in[15]; const float* w_kv_up = ap->in[16]; const float* w_mla_out = ap->in[17]; const float* gqa_sink = ap->in[18]; const float* w_gqa_out = ap->in[19]; const float* w_out = ap->in[20]; const float* g_ffn = ap->in[21]; const float* w_ffn_in = ap->in[22]; const float* w_ffn_out = ap->in[23]; const float* g_final = ap->in[24]; float* XL = ap->out; bf16* XB = (bf16*)(ws + WS_XB); bf16* XCB = (bf16*)(ws + WS_XC); (void)XL; (void)XCB; float* MOD = (float*)(ws + WS_MOD); float* ROPE = (float*)(ws + WS_ROPE); float* XC = (float*)(ws + WS_XC); bf16* Win_t = (bf16*)(ws + WS_W + WO_IN); bf16* Wq_t = (bf16*)(ws + WS_W + WO_Q); bf16* Wkv_t = (bf16*)(ws + WS_W + WO_KV); bf16* Wc_t = (bf16*)(ws + WS_W + WO_C); bf16* Wm_t = (bf16*)(ws + WS_W + WO_M); bf16* Wg_t = (bf16*)(ws + WS_W + WO_G); bf16* Wo_t = (bf16*)(ws + WS_W + WO_O); bf16* Wf1_t = (bf16*)(ws + WS_W + WO_F1); bf16* Wf2_t = (bf16*)(ws + WS_W + WO_F2); unsigned char* Gb = (unsigned char*)(ws + WS_A); bf16* HID = (bf16*)(ws + WS_A); bf16* Hb = (bf16*)(ws + WS_B); bf16* MQ = (bf16*)(ws + WS_B); bf16* Yb = (bf16*)(ws + WS_B); bf16* CQ = (bf16*)(ws + WS_C); bf16* PART = (bf16*)(ws + WS_C); bf16* OM = (bf16*)(ws + WS_C); bf16* OG = (bf16*)(ws + WS_C + (size_t)MT * 1024 * 2); bf16* KF = (bf16*)(ws + WS_D + WD_KF); bf16* Vb = (bf16*)(ws + WS_D + WD_V); bf16* GQ = (bf16*)(ws + WS_D + WD_GQ); bf16* GK = (bf16*)(ws + WS_D + WD_GK); bf16* GV = (bf16*)(ws + WS_D + WD_GV); bf16* Ub = (bf16*)(ws + WS_D + WD_U); bf16* YF = (bf16*)(ws + WS_D); bf16* UC = (bf16*)(ws + WS_E + WE_UC); bf16* CKVn = (bf16*)(ws + WS_E + WE_CKV); bf16* QAn = (bf16*)(ws + WS_E + WE_QA); \
    const float* modl = MOD + (size_t)l_cur * 9 * NMOD; (void)modl;
__global__ void __launch_bounds__(NWAVES * 64, 2) mega_fwd(Args args) {
    extern __shared__ __attribute__((aligned(16))) unsigned char lds_raw[];
    LAS unsigned char* lds = (LAS unsigned char*)lds_raw;
    volatile LAS unsigned* MISC = (volatile LAS unsigned*)(lds + MISC_OFF);
    const int tid0 = threadIdx.x;
    const int G = gridDim.x; const int bx = blockIdx.x; const int vcu = (G % 8 == 0) ? (bx % 8) * (G / 8) + bx / 8 : bx;
    gu32* ctl = (gu32*)(args.ws + WS_CTL);
    int l_cur = 0;
    for (int u = tid0; u < (LDS_BYTES - LDSCTL_OFF) / 4; u += NWAVES * 64) ((LAS unsigned*)(lds + LDSCTL_OFF))[u] = 0u;
    __syncthreads();
    XcdBarrier bar = xcd_barrier_post((unsigned*)(ctl + CW_BAR), MISC + 8);
    const int multi = args.multi, ph = args.ph;
#ifndef PHASE_MASK
#define PHASE_MASK 0x1fff
#endif
#define RUN(k) ((((PHASE_MASK) >> ((k) + 1)) & 1) && (!multi || ph == (k)))
#define GRID_BAR() do { if (!multi) xcd_barrier(bar); } while (0)

    if (RUN(PH_PRE)) { PHASE_BEGIN
        LAS float* sil = (LAS float*)(lds + RING_OFF);
        LAS float* red = (LAS float*)(lds + RING_OFF + 9 * DM * 4);
        for (int i = tid; i < 9 * DM; i += NWAVES * 64) { const float v = i < 8 * DM ? in_c[i] : in_cctx[i - 8 * DM]; sil[(i & (DM - 1)) * 9 + (i >> 11)] = v * sigmf(v); }
        __syncthreads();
#define ADA_LOAD(W_, I0) do { _Pragma("unroll") for (int u = 0; u < 8; ++u) W_[u] = *(const F3*)(Wl + (size_t)((I0) + u) * 8 * NMOD); } while (0)
#define ADA_FMA(W_, I0) do { _Pragma("unroll") for (int u = 0; u < 8; ++u) { const LAS float* sp = sil + (((I0) + u) * 8 + wave) * 9; \
            _Pragma("unroll") for (int v = 0; v < 9; ++v) { const float sv = sp[v]; acc[v][0] += W_[u].x * sv; acc[v][1] += W_[u].y * sv; acc[v][2] += W_[u].z * sv; } asm volatile("" ::: "memory"); } } while (0)
        for (int s = vcu; s < DEPTH * 64; s += G) {
            const int l = s >> 6, col0 = (s & 63) * 192;
            const float* Wl = w_ada + (size_t)l * DM * NMOD + (size_t)wave * NMOD + col0 + 3 * lane;
            float acc[9][3];
#pragma unroll
            for (int v = 0; v < 9; ++v) { acc[v][0] = 0.f; acc[v][1] = 0.f; acc[v][2] = 0.f; }
            F3 wa[8], wb[8];
            ADA_LOAD(wa, 0);
#pragma nounroll
            for (int i = 0; i < DM / 8; i += 16) {
                ADA_LOAD(wb, i + 8);
                ADA_FMA(wa, i);
                { const int in_ = (i + 16 < DM / 8) ? i + 16 : 0; ADA_LOAD(wa, in_); }
                ADA_FMA(wb, i + 8);
            }
#pragma unroll
            for (int v = 0; v < 9; ++v) {
#pragma unroll
                for (int e = 0; e < 3; ++e) red[(wave * 9 + v) * 192 + 3 * lane + e] = acc[v][e]; }
            __syncthreads();
            for (int i = tid; i < 9 * 192; i += NWAVES * 64) { const int v = i / 192, cc = i - v * 192; float t = 0.f;
#pragma unroll
                for (int w8 = 0; w8 < 8; ++w8) t += red[(w8 * 9 + v) * 192 + cc];
                MOD[((size_t)l * 9 + v) * NMOD + col0 + cc] = t + b_ada[(size_t)l * NMOD + col0 + cc]; }
            __syncthreads();
        }
        { bf16* XB = (bf16*)(ws + WS_XB);
          for (size_t i = ((size_t)gw * 64 + lane) * 8; i < (size_t)ML * DM; i += (size_t)NGW * 64 * 8) { const f32x4 a = *(const f32x4*)(in_x + i), b = *(const f32x4*)(in_x + i + 4);
              v4u w; w.x = pk2(a[0], a[1]); w.y = pk2(a[2], a[3]); w.z = pk2(b[0], b[1]); w.w = pk2(b[2], b[3]); *(v4u*)(XB + i) = w; }
          bf16* XCB = (bf16*)(ws + WS_XC);
          for (size_t i = ((size_t)gw * 64 + lane) * 8; i < (size_t)MC * DM; i += (size_t)NGW * 64 * 8) { const f32x4 a = *(const f32x4*)(in_ctx + i), b = *(const f32x4*)(in_ctx + i + 4);
              v4u w; w.x = pk2(a[0], a[1]); w.y = pk2(a[2], a[3]); w.z = pk2(b[0], b[1]); w.w = pk2(b[2], b[3]); *(v4u*)(XCB + i) = w; } }
        { const int i = bx * (NWAVES * 64) + tid; if (i < 64 * 16) { const int p = i >> 4, f = i & 15; const float invf = powf(10000.0f, -(float)f / 16.0f), a = (float)p * invf;
              ROPE[2 * i] = cosf(a); ROPE[2 * i + 1] = sinf(a); } }
    }
    GRID_BAR();

    for (int l = args.l_lo; l < args.l_hi; ++l) {
        l_cur = l;
        const bool lastl = (l == DEPTH - 1); const int Mg = lastl ? ML : MT;
        if (RUN(0)) { PHASE_BEGIN
            LAS float* scr = (LAS float*)(lds + RING_OFF + wave * 16384);
            constexpr int I_IN = (DM / 64) * (NINP / 32), I_Q = (512 / 64) * (1536 / 32), I_KV = (256 / 64) * (2048 / 32), I_C = (512 / 64) * (DM / 32), I_M = (1024 / 64) * (DM / 32),
                          I_G = (512 / 64) * (DM / 32), I_O = (DM / 64) * (DM / 32), I_F1 = (DM / 64) * (2 * DFF / 32), I_F2 = (DFF / 64) * (DM / 32);
            constexpr int NITEMS = I_IN + I_Q + I_KV + I_C + I_M + I_G + I_O + I_F1 + I_F2;
            for (int it = gw; it < NITEMS; it += NGW) {
                int r = it; const float* W; bf16* WT; int K, N, nblk, mode = 0;
                if (r < I_IN) { W = w_in + (size_t)l * DM * NIN; K = DM; N = NIN; WT = Win_t; nblk = NINP / 32; mode = 1; }
                else if ((r -= I_IN) < I_Q) { W = w_q_up + (size_t)l * 512 * 1536; K = 512; N = 1536; WT = Wq_t; nblk = 1536 / 32; mode = 3; }
                else if ((r -= I_Q) < I_KV) { W = w_kv_up + (size_t)l * 256 * 2048; K = 256; N = 2048; WT = Wkv_t; nblk = 2048 / 32; }
                else if ((r -= I_KV) < I_C) { W = w_conv_out + (size_t)l * 512 * DM; K = 512; N = DM; WT = Wc_t; nblk = DM / 32; }
                else if ((r -= I_C) < I_M) { W = w_mla_out + (size_t)l * 1024 * DM; K = 1024; N = DM; WT = Wm_t; nblk = DM / 32; }
                else if ((r -= I_M) < I_G) { W = w_gqa_out + (size_t)l * 512 * DM; K = 512; N = DM; WT = Wg_t; nblk = DM / 32; }
                else if ((r -= I_G) < I_O) { W = w_out + (size_t)l * DM * DM; K = DM; N = DM; WT = Wo_t; nblk = DM / 32; }
                else if ((r -= I_O) < I_F1) { W = w_ffn_in + (size_t)l * DM * 2 * DFF; K = DM; N = 2 * DFF; WT = Wf1_t; nblk = 2 * DFF / 32; mode = 2; }
                else { r -= I_F1; W = w_ffn_out + (size_t)l * DFF * DM; K = DFF; N = DM; WT = Wf2_t; nblk = DM / 32; }
                cvt_item(W, K, N, WT, scr, r, nblk, lane, mode);
            }
        }
#define NCOL(LN, S) (8 * (LN) + 512 * ((S) >> 1) + 4 * ((S) & 1))
#define NORM_UNPK(T, V, J) do { V[2 * (J)] = (f32x4){bflo(T.x), bfhi(T.x), bflo(T.y), bfhi(T.y)}; V[2 * (J) + 1] = (f32x4){bflo(T.z), bfhi(T.z), bflo(T.w), bfhi(T.w)}; } while (0)
#define NORM_LDMOD(SEL, GVEC, SHOFF, SCOFF) do { const float* mp = modl + (size_t)(SEL) * NMOD; \
                _Pragma("unroll") for (int j = 0; j < 8; ++j) { const int c = NCOL(ln_, j); const f32x4 g = *(const f32x4*)((GVEC) + c), sc = *(const f32x4*)(mp + (SCOFF) + c); \
                    Aa[j] = g * (sc + 1.0f); Ss[j] = *(const f32x4*)(mp + (SHOFF) + c); } } while (0)
#define NORM_FINISH(R) do { float ss = 0.f; \
                _Pragma("unroll") for (int j = 0; j < 8; ++j) ss += (v[j][0] * v[j][0] + v[j][1] * v[j][1]) + (v[j][2] * v[j][2] + v[j][3] * v[j][3]); \
                const float rstd = 1.0f / sqrtf(wave_sum(ss) * (1.0f / DM) + EPS); \
                bf16* hp = Hb + (size_t)(R) * DM + 8 * ln_; \
                _Pragma("unroll") for (int j = 0; j < 4; ++j) { const f32x4 y0 = v[2 * j] * rstd * Aa[2 * j] + Ss[2 * j], y1 = v[2 * j + 1] * rstd * Aa[2 * j + 1] + Ss[2 * j + 1]; \
                    v4u w; w.x = pk2(y0[0], y0[1]); w.y = pk2(y0[2], y0[3]); w.z = pk2(y1[0], y1[1]); w.w = pk2(y1[2], y1[3]); *(v4u*)(hp + 512 * j) = w; } } while (0)
#define NORM_ROWS(GVEC, SHOFF, SCOFF, FIRST, WITHCTX, PARTG) do { \
            int ln_ = lane; asm volatile("" : "+v"(ln_)); \
            f32x4 Aa[8], Ss[8]; \
            _Pragma("unroll") for (int j = 0; j < 8; ++j) { Aa[j] = (f32x4){0.f, 0.f, 0.f, 0.f}; Ss[j] = (f32x4){0.f, 0.f, 0.f, 0.f}; } \
            for (int gv_ = gw; gv_ < 2048; gv_ += NGW) { \
                NORM_LDMOD((gv_ * 16) >> 12, GVEC, SHOFF, SCOFF);                                   \
                _Pragma("nounroll") for (int ri = 0; ri < 16; ++ri) { int r = gv_ * 16 + ri; asm volatile("" : "+s"(r)); \
                    const bf16* sb_ = XB + (size_t)r * DM + 8 * ln_; f32x4 v[8]; \
                    _Pragma("unroll") for (int j = 0; j < 4; ++j) { const v4u t_ = *(const v4u*)(sb_ + 512 * j); NORM_UNPK(t_, v, j); } \
                    NORM_FINISH(r); } \
                if (WITHCTX) { NORM_LDMOD(8, GVEC, SHOFF, SCOFF); int rc = gv_; asm volatile("" : "+s"(rc));     \
                    bf16* sb_ = XCB + (size_t)rc * DM + 8 * ln_; f32x4 v[8]; \
                    _Pragma("unroll") for (int j = 0; j < 4; ++j) { const v4u t_ = *(const v4u*)(sb_ + 512 * j); NORM_UNPK(t_, v, j); } \
                    if ((PARTG) != nullptr) { const bf16* pp = PART + (size_t)rc * DM + 8 * ln_; \
                        _Pragma("unroll") for (int j = 0; j < 4; ++j) { f32x4 pa_[8]; \
                            { const v4u q_ = *(const v4u*)(pp + 512 * j); NORM_UNPK(q_, pa_, 0); } { const v4u q_ = *(const v4u*)(pp + (size_t)2048 * DM + 512 * j); NORM_UNPK(q_, pa_, 1); } \
                            { const v4u q_ = *(const v4u*)(pp + (size_t)2 * 2048 * DM + 512 * j); NORM_UNPK(q_, pa_, 2); } { const v4u q_ = *(const v4u*)(pp + (size_t)3 * 2048 * DM + 512 * j); NORM_UNPK(q_, pa_, 3); } \
                            v[2 * j] += *(const f32x4*)((PARTG) + NCOL(ln_, 2 * j)) * ((pa_[0] + pa_[2]) + (pa_[4] + pa_[6])); \
                            v[2 * j + 1] += *(const f32x4*)((PARTG) + NCOL(ln_, 2 * j + 1)) * ((pa_[1] + pa_[3]) + (pa_[5] + pa_[7])); } \
                        _Pragma("unroll") for (int j = 0; j < 4; ++j) { v4u w_; w_.x = pk2(v[2 * j][0], v[2 * j][1]); w_.y = pk2(v[2 * j][2], v[2 * j][3]); w_.z = pk2(v[2 * j + 1][0], v[2 * j + 1][1]); w_.w = pk2(v[2 * j + 1][2], v[2 * j + 1][3]); \
                            *(v4u*)(sb_ + 512 * j) = w_; } } \
                    NORM_FINISH(ML + rc); } } \
        } while (0)
        if (RUN(0)) { PHASE_BEGIN const float* gv = g_mix + (size_t)l * DM; const int first = (l == 0) ? 1 : 0;
            const float* pg = first ? nullptr : (MOD + ((size_t)(l - 1) * 9 + 8) * NMOD + 5 * DM);
            NORM_ROWS(gv, 0, DM, first, true, pg); }
        GRID_BAR();

        if (RUN(1)) { PHASE_BEGIN
            const bf16* A_ = Hb; const bf16* B_ = Win_t; asm volatile("" : "+s"(A_), "+s"(B_)); pg8::Gemm g{A_, B_, MT, NINP, DM}; pg8::StaticOrder S; S.init(Mg, NINP, G, bx); S.wgm = P1_WGM; if (lastl) S.set_extra(24, ML / 256, 24, 3);
            pg8::EpiWin E{Gb, CQ, KF, GK, GV, GQ, Ub, ROPE};
            pg8::gemm_phase<pg8::EpiWin, pg8::StaticOrder, true, true>(lds + RING_OFF, g, S, E);
        }
        GRID_BAR();

        if (RUN(2)) { PHASE_BEGIN
            LAS float* cw = (LAS float*)(lds + RING_OFF);
            for (int i = tid; i < 31 * 512; i += NWAVES * 64) cw[i] = conv_w[(size_t)l * 31 * 512 + i];
            __syncthreads();
            { const f32x4 gk = *(const f32x4*)(g_kv_a + (size_t)l * 256 + 4 * lane), gq0 = *(const f32x4*)(g_q_a + (size_t)l * 512 + 4 * lane), gq1 = *(const f32x4*)(g_q_a + (size_t)l * 512 + 256 + 4 * lane);
              for (int r0 = gw; r0 < MT; r0 += 2 * NGW) { const int r1 = (r0 + NGW < MT) ? r0 + NGW : r0;
                const bf16* p = CQ + (size_t)r0 * 768 + 4 * lane; const bf16* q = CQ + (size_t)r1 * 768 + 4 * lane;
#define LD4(P) ({ const v2u t_ = *(const v2u*)(P); (f32x4){bflo(t_.x), bfhi(t_.x), bflo(t_.y), bfhi(t_.y)}; })
                const f32x4 a = LD4(p), b0 = LD4(p + 256), b1 = LD4(p + 512), c = LD4(q), d0 = LD4(q + 256), d1 = LD4(q + 512);
#undef LD4
#define LR_ROW(R, A_, B0_, B1_) do { \
                const float sa = wave_sum((A_[0] * A_[0] + A_[1] * A_[1]) + (A_[2] * A_[2] + A_[3] * A_[3])); \
                const float sb = wave_sum(((B0_[0] * B0_[0] + B0_[1] * B0_[1]) + (B0_[2] * B0_[2] + B0_[3] * B0_[3])) + ((B1_[0] * B1_[0] + B1_[1] * B1_[1]) + (B1_[2] * B1_[2] + B1_[3] * B1_[3]))); \
                const float ra = 1.0f / sqrtf(sa * (1.0f / 256.0f) + EPS), rb = 1.0f / sqrtf(sb * (1.0f / 512.0f) + EPS); \
                const f32x4 ya = A_ * ra * gk, y0 = B0_ * rb * gq0, y1 = B1_ * rb * gq1; \
                v2u w; w.x = pk2(ya[0], ya[1]); w.y = pk2(ya[2], ya[3]); *(v2u*)(CKVn + (size_t)(R) * 256 + 4 * lane) = w; \
                w.x = pk2(y0[0], y0[1]); w.y = pk2(y0[2], y0[3]); *(v2u*)(QAn + (size_t)(R) * 512 + 4 * lane) = w; \
                w.x = pk2(y1[0], y1[1]); w.y = pk2(y1[2], y1[3]); *(v2u*)(QAn + (size_t)(R) * 512 + 256 + 4 * lane) = w; } while (0)
                LR_ROW(r0, a, b0, b1); LR_ROW(r1, c, d0, d1);
#undef LR_ROW
              } }
            { const int ch = 8 * lane;
              const f32x4 cb0 = *(const f32x4*)(conv_b + (size_t)l * 512 + ch), cb1 = *(const f32x4*)(conv_b + (size_t)l * 512 + ch + 4);
              const f32x4 lg0 = *(const f32x4*)(conv_ln_g + (size_t)l * 512 + ch), lg1 = *(const f32x4*)(conv_ln_g + (size_t)l * 512 + ch + 4);
              const f32x4 lb0 = *(const f32x4*)(conv_ln_b + (size_t)l * 512 + ch), lb1 = *(const f32x4*)(conv_ln_b + (size_t)l * 512 + ch + 4);
              for (int tok = gw; tok < Mg; tok += NGW) {
                int sb, pos, L; if (tok < ML) { sb = tok & ~4095; pos = tok & 4095; L = SEQ; } else { const int c = tok - ML; sb = ML + (c & ~255); pos = c & 255; L = CTXL; }
                f32x4 a0 = cb0, a1 = cb1;
                v4u xr[31];
                if (pos >= 15 && pos < L - 15) {
                    const bf16* up = Ub + (size_t)(sb + pos - 15) * 512 + ch;
#pragma unroll
                    for (int j = 0; j < 31; ++j) xr[j] = *(const v4u*)(up + (size_t)j * 512);
                    asm volatile("" ::: "memory");
#pragma unroll
                    for (int j = 0; j < 31; ++j) { const v4u x = xr[j];
                        const f32x4 w0 = *(const LAS f32x4*)(cw + j * 512 + ch), w1 = *(const LAS f32x4*)(cw + j * 512 + ch + 4);
                        const f32x4 x0 = {bflo(x.x), bfhi(x.x), bflo(x.y), bfhi(x.y)}, x1 = {bflo(x.z), bfhi(x.z), bflo(x.w), bfhi(x.w)};
                        a0 += w0 * x0; a1 += w1 * x1; if ((j & 3) == 3) asm volatile("" ::: "memory"); }
                } else {
#pragma unroll
                    for (int j = 0; j < 31; ++j) { int p = pos + j - 15; p = p < 0 ? 0 : (p >= L ? L - 1 : p); xr[j] = *(const v4u*)(Ub + (size_t)(sb + p) * 512 + ch); }
                    asm volatile("" ::: "memory");
#pragma unroll
                    for (int j = 0; j < 31; ++j) { const int p = pos + j - 15; const float ok = (p >= 0 && p < L) ? 1.0f : 0.0f; const v4u x = xr[j];
                        const f32x4 w0 = *(const LAS f32x4*)(cw + j * 512 + ch) * ok, w1 = *(const LAS f32x4*)(cw + j * 512 + ch + 4) * ok;
                        const f32x4 x0 = {bflo(x.x), bfhi(x.x), bflo(x.y), bfhi(x.y)}, x1 = {bflo(x.z), bfhi(x.z), bflo(x.w), bfhi(x.w)};
                        a0 += w0 * x0; a1 += w1 * x1; if ((j & 3) == 3) asm volatile("" ::: "memory"); }
                }
                const float mean = wave_sum((a0[0] + a0[1]) + (a0[2] + a0[3]) + (a1[0] + a1[1]) + (a1[2] + a1[3])) * (1.0f / 512.0f);
                const f32x4 d0 = a0 - mean, d1 = a1 - mean;
                const float var = wave_sum((d0[0] * d0[0] + d0[1] * d0[1]) + (d0[2] * d0[2] + d0[3] * d0[3]) + (d1[0] * d1[0] + d1[1] * d1[1]) + (d1[2] * d1[2] + d1[3] * d1[3])) * (1.0f / 512.0f);
                const float rstd = 1.0f / sqrtf(var + EPS);
                const f32x4 y0 = d0 * rstd * lg0 + lb0, y1 = d1 * rstd * lg1 + lb1;
                v4u w; w.x = pk2(y0[0] * sigmf(y0[0]), y0[1] * sigmf(y0[1])); w.y = pk2(y0[2] * sigmf(y0[2]), y0[3] * sigmf(y0[3]));
                w.z = pk2(y1[0] * sigmf(y1[0]), y1[1] * sigmf(y1[1])); w.w = pk2(y1[2] * sigmf(y1[2]), y1[3] * sigmf(y1[3]));
                *(v4u*)(UC + (size_t)tok * 512 + ch) = w; } }
        }
        GRID_BAR();

        if (RUN(3)) { PHASE_BEGIN
            const bf16* A0_ = QAn; const bf16* B0_ = Wq_t; const bf16* A1_ = CKVn; const bf16* B1_ = Wkv_t; asm volatile("" : "+s"(A0_), "+s"(B0_), "+s"(A1_), "+s"(B1_));
            pg8::SchedQKV S; S.nMq = Mg / 256; S.nNq = 1536 / 256; S.nMk = MT / 256; S.nNk = 2048 / 256; S.G = G; S.c = bx; S.Aq = A0_; S.Bq = B0_; S.Ak = A1_; S.Bk = B1_;
            pg8::EpiQKV E{pg8::EpiQup{MQ, ROPE}, pg8::EpiKV{KF, Vb}};
            pg8::gemm_stream<pg8::EpiQKV, pg8::SchedQKV>(lds + RING_OFF, S, E);
        }
        GRID_BAR();

        if (RUN(4)) { PHASE_BEGIN
            att::lchar* alds = (att::lchar*)(lds + RING_OFF);
            for (int u = vcu; u < 1024 + (lastl ? 0 : 64); u += G) {
                int b, h, q0row, NT;
                if (u < 1024) { const int bh = u >> 4, qb = u & 15; b = bh >> 3; h = bh & 7; q0row = b * SEQ + qb * 256; NT = 4 + SEQ / 64; }
                else { const int bh = u - 1024; b = bh >> 3; h = bh & 7; q0row = ML + b * CTXL; NT = 4; }
                att::attn_unit<192, 128, false, false, ATT_MLA_MODE>(MQ + (size_t)q0row * 1536 + h * 192, 1536, KF + h * 192, 1536, Vb + h * 128, 1024, OM + (size_t)q0row * 1024 + h * 128, 1024,
                                                       ML + b * CTXL, b * SEQ, NT, 0, 0, 0.f, alds);
            }
            for (int u = vcu; u < 1024 + (lastl ? 0 : 128); u += G) {
                int b, h, q0row, NT, qpos0, kpos0;
                if (u >= 1024 && u < 1088) continue;
                if (u < 1024) { const int bh = u >> 4, qb = u & 15; b = bh >> 3; h = bh & 7; q0row = b * SEQ + qb * 256; qpos0 = qb * 256;
                    const int klo = qpos0 - 128 < 0 ? 0 : qpos0 - 128, khi = qpos0 + 384 > SEQ ? SEQ : qpos0 + 384; kpos0 = klo; NT = 4 + (khi - klo) / 64; }
                else { const int bh = u - 1088; b = bh >> 3; h = bh & 7; q0row = ML + b * CTXL; NT = 4; qpos0 = 0; kpos0 = 0; }
                const float sk = gqa_sink[l * 8 + h] * 1.4426950408889634f;
                att::attn_unit<64, 64, true, true, ATT_GQA_MODE>(GQ + (size_t)q0row * 512 + h * 64, 512, GK + (h >> 2) * 64, 128, GV + (h >> 2) * 64, 128, OG + (size_t)q0row * 512 + h * 64, 512,
                                                   ML + b * CTXL, b * SEQ + kpos0, NT, qpos0, kpos0, sk, alds);
            }
            __syncthreads();
        }
        GRID_BAR();

        if (RUN(5)) { PHASE_BEGIN
            pg8::SchedMerge S; S.base.init(Mg, DM, G, bx); S.base.wgm = P5_WGM;
            { const bf16* a0_ = UC; const bf16* a1_ = OM; const bf16* a2_ = OG; const bf16* b0_ = Wc_t; const bf16* b1_ = Wm_t; const bf16* b2_ = Wg_t; asm volatile("" : "+s"(a0_), "+s"(a1_), "+s"(a2_), "+s"(b0_), "+s"(b1_), "+s"(b2_));
              S.a0 = (const char*)a0_; S.da1 = (const char*)a1_ - (const char*)a0_; S.da2 = (const char*)a2_ - (const char*)a1_; S.b0 = (const char*)b0_; S.db1 = (const char*)b1_ - (const char*)b0_; S.db2 = (const char*)b2_ - (const char*)b1_; }
            pg8::EpiChain E{Gb, Yb};
            pg8::gemm_stream<pg8::EpiChain, pg8::SchedMerge, true>(lds + RING_OFF, S, E);
        }
        GRID_BAR();

        if (RUN(6)) { PHASE_BEGIN
            const bf16* A_ = Yb; const bf16* B_ = Wo_t; asm volatile("" : "+s"(A_), "+s"(B_));
            pg8::SchedSplit S; S.A = A_; S.Bt = B_; S.K = DM; S.nlat = 1024; S.nctx = lastl ? 0 : 256; S.G = G; S.c = bx; S.wgm = SPLIT_WGM;
            pg8::EpiSplit E{pg8::EpiResid{XB, modl, 2 * DM}, PART};
            pg8::gemm_stream<pg8::EpiSplit, pg8::SchedSplit>(lds + RING_OFF, S, E);
        }
        GRID_BAR();

        if (RUN(7)) { PHASE_BEGIN const float* gv = g_ffn + (size_t)l * DM; const float* pg = lastl ? nullptr : (modl + (size_t)8 * NMOD + 2 * DM);
            const int first = (l == 0) ? 2 : 0; NORM_ROWS(gv, 3 * DM, 4 * DM, first, !lastl, pg); }
        GRID_BAR();

        if (RUN(8)) { PHASE_BEGIN
            const bf16* A_ = Hb; const bf16* B_ = Wf1_t; asm volatile("" : "+s"(A_), "+s"(B_)); pg8::Gemm g{A_, B_, MT, 2 * DFF, DM}; pg8::StaticOrder S; S.init(Mg, 2 * DFF, G, bx); S.wgm = P8_WGM; pg8::EpiSwiGLU E{HID};
            pg8::gemm_phase<pg8::EpiSwiGLU, pg8::StaticOrder, true, true>(lds + RING_OFF, g, S, E);
        }
        GRID_BAR();

        if (RUN(9)) { PHASE_BEGIN
            const bf16* A_ = HID; const bf16* B_ = Wf2_t; asm volatile("" : "+s"(A_), "+s"(B_));
            pg8::SchedSplit S; S.A = A_; S.Bt = B_; S.K = DFF; S.nlat = 1024; S.nctx = lastl ? 0 : 256; S.G = G; S.c = bx; S.wgm = SPLIT_WGM;
            pg8::EpiSplit E{pg8::EpiResid{XB, modl, 5 * DM}, PART};
            pg8::gemm_stream<pg8::EpiSplit, pg8::SchedSplit>(lds + RING_OFF, S, E);
        }
        GRID_BAR();
    }

    if (RUN(PH_POST)) { PHASE_BEGIN
        f32x4 gf[8];
#pragma unroll
        for (int j = 0; j < 8; ++j) gf[j] = *(const f32x4*)(g_final + NCOL(lane, j));
        for (int r = gw; r < ML; r += NGW) { float* p = XL + (size_t)r * DM; const bf16* sb = XB + (size_t)r * DM + 8 * lane; f32x4 v[8]; float ss = 0.f;
#pragma unroll
            for (int j = 0; j < 4; ++j) { const v4u t_ = *(const v4u*)(sb + 512 * j); NORM_UNPK(t_, v, j); }
#pragma unroll
            for (int j = 0; j < 8; ++j) ss += (v[j][0] * v[j][0] + v[j][1] * v[j][1]) + (v[j][2] * v[j][2] + v[j][3] * v[j][3]);
            const float rstd = 1.0f / sqrtf(wave_sum(ss) * (1.0f / DM) + EPS);
#pragma unroll
            for (int j = 0; j < 8; ++j) *(f32x4*)(p + NCOL(lane, j)) = v[j] * rstd * gf[j]; }
    }

#if defined(DBG_STAGE)
    if (RUN(PH_DUMP)) { PHASE_BEGIN
        const int sel = ap->pad0; const size_t total = (size_t)G * NWAVES * 64, gt = (size_t)bx * NWAVES * 64 + tid;
        for (size_t i = gt; i < (size_t)ML * DM; i += total) { float v = 0.f;
#define DB16(bit, P, N) if (sel & (bit)) v += __uint_as_float((unsigned)(P)[i % (size_t)(N)] << 16)
            if (sel & 1) v += MOD[i % (size_t)(DEPTH * 9 * NMOD)];
            DB16(2, Hb, (size_t)MT * 2048); DB16(4, Gb, (size_t)MT * 6144); DB16(8, KF, (size_t)MT * 1536); DB16(16, Vb, (size_t)MT * 1024); DB16(32, GQ, (size_t)MT * 512);
            DB16(64, UC, (size_t)MT * 512); DB16(128, MQ, (size_t)MT * 1536); DB16(256, OM, (size_t)MT * 1024); DB16(512, OG, (size_t)MT * 512); DB16(1024, Yb, (size_t)MT * 2048);
            DB16(2048, Win_t, (size_t)NINP * 2048); DB16(4096, GK, (size_t)MT * 128); DB16(8192, GV, (size_t)MT * 128); DB16(16384, CKVn, (size_t)MT * 256); DB16(32768, QAn, (size_t)MT * 512);
            DB16(65536, Ub, (size_t)MT * 512); DB16(131072, Wf1_t, (size_t)2 * DFF * DM); DB16(262144, Wf2_t, (size_t)DM * DFF); DB16(524288, HID, (size_t)MT * DFF);
            if (sel & 1048576) v += CQ[i % ((size_t)MT * 768)];
            XL[i] = v; }
    }
#endif
#undef RUN
#undef GRID_BAR
#undef NORM_ROWS
}

#ifndef MK_MULTI
#define MK_MULTI 0
#endif
extern "C" void kernel_launch(void* const* d_in, const int* in_sizes, int n_in, void* d_out, int out_size, void* d_ws, size_t ws_size, hipStream_t stream) {
    static int grid = 0;
    if (grid == 0) {
        if (n_in != 25 || in_sizes[0] != ML * DM || out_size != ML * DM || ws_size < WS_END) {
            fprintf(stderr, "kernel_launch: shape mismatch: n_in %d in0 %d out %d ws %zu (need %zu)\n", n_in, n_in > 0 ? in_sizes[0] : -1, out_size, ws_size, (size_t)WS_END); grid = -1; return; }
        int dev = 0, cus = 0, per_cu = 0;
        if (hipGetDevice(&dev) != hipSuccess || hipDeviceGetAttribute(&cus, hipDeviceAttributeMultiprocessorCount, dev) != hipSuccess) { grid = -1; return; }
        if (hipFuncSetAttribute((const void*)mega_fwd, hipFuncAttributeMaxDynamicSharedMemorySize, LDS_BYTES) != hipSuccess) { fprintf(stderr, "kernel_launch: hipFuncSetAttribute failed\n"); grid = -1; return; }
        if (hipOccupancyMaxActiveBlocksPerMultiprocessor(&per_cu, (const void*)mega_fwd, NWAVES * 64, LDS_BYTES) != hipSuccess || per_cu < 1)
            fprintf(stderr, "kernel_launch: note: occupancy query reports %d workgroups per CU\n", per_cu);
        (void)hipGetLastError();
        grid = cus;
    }
    if (grid < 0) return;
    if (hipMemsetAsync((char*)d_ws + WS_CTL, 0, CTL_ZERO_BYTES, stream) != hipSuccess) return;
    Args a{};
    for (int i = 0; i < 25; ++i) a.in[i] = (const float*)d_in[i];
    a.out = (float*)d_out; a.ws = (unsigned char*)d_ws;
#if defined(DBG_STAGE)
    a.multi = 1;
    a.l_lo = 0; a.l_hi = 0; a.ph = PH_PRE; hipLaunchKernelGGL(mega_fwd, dim3(grid), dim3(NWAVES * 64), LDS_BYTES, stream, a);
    for (int p = 0; p <= DBG_STAGE; ++p) { a.l_lo = 0; a.l_hi = 1; a.ph = p; hipLaunchKernelGGL(mega_fwd, dim3(grid), dim3(NWAVES * 64), LDS_BYTES, stream, a); }
    a.l_lo = 0; a.l_hi = 0; a.ph = PH_DUMP; a.pad0 = DBG_SEL; hipLaunchKernelGGL(mega_fwd, dim3(grid), dim3(NWAVES * 64), LDS_BYTES, stream, a);
#elif MK_MULTI
    a.multi = 1;
    a.l_lo = 0; a.l_hi = 0; a.ph = PH_PRE; hipLaunchKernelGGL(mega_fwd, dim3(grid), dim3(NWAVES * 64), LDS_BYTES, stream, a);
    for (int l = 0; l < DEPTH; ++l) for (int p = 0; p < 10; ++p) { a.l_lo = l; a.l_hi = l + 1; a.ph = p; hipLaunchKernelGGL(mega_fwd, dim3(grid), dim3(NWAVES * 64), LDS_BYTES, stream, a); }
    a.l_lo = 0; a.l_hi = 0; a.ph = PH_POST; hipLaunchKernelGGL(mega_fwd, dim3(grid), dim3(NWAVES * 64), LDS_BYTES, stream, a);
#else
    a.multi = 0; a.l_lo = 0; a.l_hi = DEPTH; a.ph = 0;
    hipLaunchKernelGGL(mega_fwd, dim3(grid), dim3(NWAVES * 64), LDS_BYTES, stream, a);
#endif
    const hipError_t le = hipPeekAtLastError();
    if (le != hipSuccess) fprintf(stderr, "kernel_launch: launch failed: %s\n", hipGetErrorName(le));
}
```
